# Optimizing an MI355X kernel written in HIP

```python
import jax, jax.numpy as jnp
from jax import lax
import numpy as np

D_MODEL = 1024
BATCH = 8
SEQ = 4096
DEPTH = 1

CTX_LEN = 256
GRID_W = 64
HEAD_DIM = 128
N_Q_HEADS = D_MODEL // HEAD_DIM
N_KV_HEADS = N_Q_HEADS // 4
GQA_GROUP = N_Q_HEADS // N_KV_HEADS
ROPE_AXIS_DIM = HEAD_DIM // 2
ROPE_THETA = 10000.0
Q_BLOCK = 128
CONV_DIM = D_MODEL
CONV_WIDTH = 31
PEER_HEADS = 8
PEER_N_KEYS = 128
PEER_EXPERTS = PEER_N_KEYS * PEER_N_KEYS
PEER_TOPK = 16
PEER_KEY_DIM = 256
PEER_HALF = PEER_KEY_DIM // 2
PEER_CHUNK = 128
N_MOD = 6
EPS = 1e-6
Q_W = N_Q_HEADS * HEAD_DIM
KV_W = N_KV_HEADS * HEAD_DIM
IN_SPLITS = (Q_W, Q_W + KV_W, Q_W + 2 * KV_W, Q_W + 2 * KV_W + 2 * CONV_DIM, Q_W + 2 * KV_W + 2 * CONV_DIM + D_MODEL)
IN_W = IN_SPLITS[-1] + D_MODEL

kernel_name = 'hybrid_gqa_conformer_peer_dit_layer'


def rmsnorm(x, g):
    xf = x.astype(jnp.float32)
    y = xf * lax.rsqrt(jnp.mean(xf * xf, axis=-1, keepdims=True) + EPS)
    return (y * g.astype(jnp.float32)).astype(x.dtype)


def layernorm(x, g, b):
    xf = x.astype(jnp.float32)
    mu = jnp.mean(xf, axis=-1, keepdims=True)
    var = jnp.mean(jnp.square(xf - mu), axis=-1, keepdims=True)
    y = (xf - mu) * lax.rsqrt(var + EPS) * g.astype(jnp.float32) + b.astype(jnp.float32)
    return y.astype(x.dtype)


def modulate(h, shift, scale):
    return h * (1 + scale) + shift


def axial_rope_tables(n_tokens, dtype):
    rows = n_tokens // GRID_W
    row = jnp.repeat(jnp.arange(rows, dtype=jnp.float32), GRID_W)
    col = jnp.tile(jnp.arange(GRID_W, dtype=jnp.float32), rows)
    inv = ROPE_THETA ** (-jnp.arange(0, ROPE_AXIS_DIM, 2, dtype=jnp.float32) / ROPE_AXIS_DIM)
    ang_r = row[:, None] * inv
    ang_c = col[:, None] * inv
    return (jnp.cos(ang_r)[:, None, :].astype(dtype), jnp.sin(ang_r)[:, None, :].astype(dtype),
            jnp.cos(ang_c)[:, None, :].astype(dtype), jnp.sin(ang_c)[:, None, :].astype(dtype))


def rotate(xa, cos, sin):
    x1, x2 = jnp.split(xa, 2, axis=-1)
    return jnp.concatenate([x1 * cos - x2 * sin, x1 * sin + x2 * cos], axis=-1)


def apply_rope(x, rope):
    cos_r, sin_r, cos_c, sin_c = rope
    xr, xc = jnp.split(x, 2, axis=-1)
    return jnp.concatenate([rotate(xr, cos_r, sin_r), rotate(xc, cos_c, sin_c)], axis=-1)


def attend(q, k, v):
    B, T = q.shape[0], q.shape[1]
    nb = T // Q_BLOCK
    scale = HEAD_DIM ** -0.5
    qb = q.reshape(B, nb, Q_BLOCK, N_KV_HEADS, GQA_GROUP, HEAD_DIM).transpose(1, 0, 2, 3, 4, 5)

    def block(qi):
        s = jnp.einsum('bqkgd,bskd->bkgqs', qi, k).astype(jnp.float32) * scale
        p = jax.nn.softmax(s, axis=-1).astype(v.dtype)
        return jnp.einsum('bkgqs,bskd->bqkgd', p, v)

    o = lax.map(block, qb)
    return o.transpose(1, 0, 2, 3, 4, 5).reshape(B, T, Q_W)


def conformer_conv(u, lw):
    a, b = jnp.split(u, 2, axis=-1)
    g = a * jax.nn.sigmoid(b)
    pad = CONV_WIDTH // 2
    g = lax.conv_general_dilated(g, lw['conv_dw'][:, None, :], window_strides=(1,), padding=[(pad, pad)],
                                 dimension_numbers=('NWC', 'WIO', 'NWC'), feature_group_count=CONV_DIM)
    g = layernorm(g + lw['conv_b'], lw['conv_ln_g'], lw['conv_ln_b'])
    return jax.nn.silu(g) @ lw['w_conv_o']


def context_kv(h, lw):
    B, T, _ = h.shape
    kv = h @ lw['w_in'][:, Q_W:Q_W + 2 * KV_W]
    k, v = jnp.split(kv, 2, axis=-1)
    k = rmsnorm(k.reshape(B, T, N_KV_HEADS, HEAD_DIM), lw['k_norm_g'])
    return k, v.reshape(B, T, N_KV_HEADS, HEAD_DIM)


def token_mixer(h, lw, rope, k_ctx, v_ctx):
    B, T, _ = h.shape
    q, k, v, u, ga, gc = jnp.split(h @ lw['w_in'], IN_SPLITS, axis=-1)
    q = rmsnorm(q.reshape(B, T, N_Q_HEADS, HEAD_DIM), lw['q_norm_g'])
    k = rmsnorm(k.reshape(B, T, N_KV_HEADS, HEAD_DIM), lw['k_norm_g'])
    v = v.reshape(B, T, N_KV_HEADS, HEAD_DIM)
    if rope is not None:
        q = apply_rope(q, rope)
        k = jnp.concatenate([apply_rope(k, rope), k_ctx], axis=1)
        v = jnp.concatenate([v, v_ctx], axis=1)
    y_att = attend(q, k, v) @ lw['w_attn_o']
    y_conv = conformer_conv(u, lw)
    merged = jax.nn.sigmoid(ga) * y_att + jax.nn.sigmoid(gc) * y_conv
    return merged @ lw['w_out']


def peer_ffn(h, lw):
    B, T, D = h.shape
    wq, keys, u_tab, v_tab = lw['peer_wq'], lw['peer_keys'], lw['peer_u'], lw['peer_v']

    def chunk(xc):
        q = (xc @ wq).reshape(PEER_CHUNK, PEER_HEADS, 2, PEER_HALF)
        s = jnp.einsum('thpd,hpnd->thpn', q, keys)
        s_top, i_top = lax.top_k(s, PEER_TOPK)
        n_cand = PEER_TOPK * PEER_TOPK
        cand_s = (s_top[:, :, 0, :, None] + s_top[:, :, 1, None, :]).reshape(PEER_CHUNK, PEER_HEADS, n_cand)
        cand_i = (i_top[:, :, 0, :, None] * PEER_N_KEYS + i_top[:, :, 1, None, :]).reshape(PEER_CHUNK, PEER_HEADS, n_cand)
        best_s, best_pos = lax.top_k(cand_s, PEER_TOPK)
        eid = jnp.take_along_axis(cand_i, best_pos, axis=-1)
        w = jax.nn.softmax(best_s.astype(jnp.float32), axis=-1).astype(xc.dtype)
        act = jax.nn.gelu(jnp.einsum('thkd,td->thk', jnp.take(u_tab, eid, axis=0), xc), approximate=False)
        return jnp.einsum('thk,thkd->td', w * act, jnp.take(v_tab, eid, axis=0))

    y = lax.map(chunk, h.reshape(-1, PEER_CHUNK, D))
    return y.reshape(B, T, D)


def setup_inputs(seed: int = 0) -> dict:
    key = jax.random.key(seed)
    ks = jax.random.split(key, 24)
    L, D = DEPTH, D_MODEL

    def nrm(k, shape, scale):
        return jax.random.normal(k, shape, jnp.float32) * scale

    return {
        'x': nrm(ks[0], (BATCH, SEQ, D), 1.0),
        'c': nrm(ks[1], (BATCH, D), 1.0),
        'ctx': nrm(ks[2], (BATCH, CTX_LEN, D), 1.0),
        'c_ctx': nrm(ks[3], (D,), 1.0),
        'w_mod': nrm(ks[4], (L, D, N_MOD * D), 0.5 * D ** -0.5),
        'b_mod': nrm(ks[5], (L, N_MOD * D), 0.01),
        'norm1_g': 1.0 + nrm(ks[6], (L, D), 0.1),
        'norm2_g': 1.0 + nrm(ks[7], (L, D), 0.1),
        'w_in': nrm(ks[8], (L, D, IN_W), D ** -0.5),
        'q_norm_g': 1.0 + nrm(ks[9], (L, HEAD_DIM), 0.1),
        'k_norm_g': 1.0 + nrm(ks[10], (L, HEAD_DIM), 0.1),
        'w_attn_o': nrm(ks[11], (L, Q_W, D), Q_W ** -0.5),
        'conv_dw': nrm(ks[12], (L, CONV_WIDTH, CONV_DIM), CONV_WIDTH ** -0.5),
        'conv_b': nrm(ks[13], (L, CONV_DIM), 0.01),
        'conv_ln_g': 1.0 + nrm(ks[14], (L, CONV_DIM), 0.1),
        'conv_ln_b': nrm(ks[15], (L, CONV_DIM), 0.01),
        'w_conv_o': nrm(ks[16], (L, CONV_DIM, D), CONV_DIM ** -0.5),
        'w_out': nrm(ks[17], (L, D, D), D ** -0.5),
        'peer_wq': nrm(ks[18], (L, D, PEER_HEADS * PEER_KEY_DIM), D ** -0.5),
        'peer_keys': nrm(ks[19], (L, PEER_HEADS, 2, PEER_N_KEYS, PEER_HALF), PEER_HALF ** -0.5),
        'peer_u': nrm(ks[20], (L, PEER_EXPERTS, D), D ** -0.5),
        'peer_v': nrm(ks[21], (L, PEER_EXPERTS, D), 0.5),
        'final_norm_g': 1.0 + nrm(ks[22], (D,), 0.1),
    }


def reference(x, c, ctx, c_ctx, w_mod, b_mod, norm1_g, norm2_g, w_in, q_norm_g, k_norm_g,
              w_attn_o, conv_dw, conv_b, conv_ln_g, conv_ln_b, w_conv_o, w_out,
              peer_wq, peer_keys, peer_u, peer_v, final_norm_g):
    S = x.shape[1]
    rope = axial_rope_tables(S, x.dtype)
    xs, cs = x, ctx
    for l in range(DEPTH):
        lw = {'w_in': w_in[l], 'q_norm_g': q_norm_g[l], 'k_norm_g': k_norm_g[l], 'w_attn_o': w_attn_o[l],
              'conv_dw': conv_dw[l], 'conv_b': conv_b[l], 'conv_ln_g': conv_ln_g[l], 'conv_ln_b': conv_ln_b[l],
              'w_conv_o': w_conv_o[l], 'w_out': w_out[l], 'peer_wq': peer_wq[l], 'peer_keys': peer_keys[l],
              'peer_u': peer_u[l], 'peer_v': peer_v[l]}
        last = l == DEPTH - 1
        sh1, sc1, g1, sh2, sc2, g2 = [m[:, None, :] for m in
                                      jnp.split(jax.nn.silu(c) @ w_mod[l] + b_mod[l], N_MOD, axis=-1)]
        csh1, csc1, cg1, csh2, csc2, cg2 = jnp.split(jax.nn.silu(c_ctx) @ w_mod[l] + b_mod[l], N_MOD, axis=-1)
        hc = modulate(rmsnorm(cs, norm1_g[l]), csh1, csc1)
        k_c, v_c = context_kv(hc, lw)
        hx = modulate(rmsnorm(xs, norm1_g[l]), sh1, sc1)
        xs = xs + g1 * token_mixer(hx, lw, rope, k_c, v_c)
        if not last:
            cs = cs + cg1 * token_mixer(hc, lw, None, None, None)
        hx = modulate(rmsnorm(xs, norm2_g[l]), sh2, sc2)
        xs = xs + g2 * peer_ffn(hx, lw)
        if not last:
            hc = modulate(rmsnorm(cs, norm2_g[l]), csh2, csc2)
            cs = cs + cg2 * peer_ffn(hc, lw)
    return rmsnorm(xs, final_norm_g)
```

```cpp
#include <hip/hip_runtime.h>
#include <math.h>
#include <stdint.h>

namespace nv {
constexpr int D = 1024, B = 8, S = 4096, CTX = 256, SKV = S + CTX, HD = 128, HQ = 8, HKV = 2;
constexpr int INW = 5632, NMOD = 6144, NE = 16384;
constexpr float EPS = 1e-6f;

__device__ __forceinline__ float siluf(float x) { return x / (1.f + expf(-x)); }
__device__ __forceinline__ float sigmf(float x) { return 1.f / (1.f + expf(-x)); }

__device__ __forceinline__ float block_sum(float v, float* red) {
    for (int o = 32; o > 0; o >>= 1) v += __shfl_xor(v, o);
    const int w = threadIdx.x >> 6, nw = blockDim.x >> 6;
    __syncthreads();
    if ((threadIdx.x & 63) == 0) red[w] = v;
    __syncthreads();
    float s = 0.f;
    for (int i = 0; i < nw; ++i) s += red[i];
    return s;
}

__global__ void mod_kernel(const float* c, const float* c_ctx, const float* w_mod, const float* b_mod, float* mod) {
    const int n = blockIdx.x * blockDim.x + threadIdx.x, r = blockIdx.y;
    const float* cc = r < 8 ? c + r * D : c_ctx;
    float acc = 0.f;
    for (int k = 0; k < D; ++k) acc += siluf(cc[k]) * w_mod[(size_t)k * NMOD + n];
    mod[r * NMOD + n] = acc + b_mod[n];
}
__global__ void rope_table(float* cs, float* sn) {
    const int i = threadIdx.x & 31, p = blockIdx.x * 2 + (threadIdx.x >> 5);
    const float inv = powf(10000.f, -(float)(2 * i) / 64.f);
    const float a = (float)p * inv;
    cs[p * 32 + i] = cosf(a); sn[p * 32 + i] = sinf(a);
}
__global__ void normmod(const float* in, const float* g, const float* mod, int sh_off, int sc_off, int rows_per_mod, int mod_row0, int fixed_row, float* out) {
    __shared__ float red[16];
    const int row = blockIdx.x; const float* x = in + (size_t)row * D;
    const int mr = fixed_row >= 0 ? fixed_row : mod_row0 + row / rows_per_mod;
    float v[4], ss = 0.f;
    for (int j = 0; j < 4; ++j) { v[j] = x[threadIdx.x + 256 * j]; ss += v[j] * v[j]; }
    ss = block_sum(ss, red);
    const float r = rsqrtf(ss / D + EPS);
    for (int j = 0; j < 4; ++j) { const int k = threadIdx.x + 256 * j;
        out[(size_t)row * D + k] = v[j] * r * g[k] * (1.f + mod[mr * NMOD + sc_off + k]) + mod[mr * NMOD + sh_off + k]; }
}
template <bool BT> __global__ void __launch_bounds__(256) sgemm(const float* A, int lda, const float* Bm, int ldb, float* C, int ldc, int M, int N, int K) {
    __shared__ float As[16][132], Bs[16][132];
    const int tid = threadIdx.x, tx = tid & 15, ty = tid >> 4;
    const int m0 = blockIdx.y * 128, n0 = blockIdx.x * 128;
    float acc[8][8];
    for (int i = 0; i < 8; ++i) for (int j = 0; j < 8; ++j) acc[i][j] = 0.f;
    for (int k0 = 0; k0 < K; k0 += 16) {
        for (int i = 0; i < 2; ++i) { const int e = tid + i * 256, r = e >> 2, kq = (e & 3) * 4;
            const float4 a = *(const float4*)(A + (size_t)(m0 + r) * lda + k0 + kq);
            As[kq + 0][r] = a.x; As[kq + 1][r] = a.y; As[kq + 2][r] = a.z; As[kq + 3][r] = a.w; }
        if (BT) { for (int i = 0; i < 2; ++i) { const int e = tid + i * 256, r = e >> 2, kq = (e & 3) * 4;
            const float4 b = *(const float4*)(Bm + (size_t)(n0 + r) * ldb + k0 + kq);
            Bs[kq + 0][r] = b.x; Bs[kq + 1][r] = b.y; Bs[kq + 2][r] = b.z; Bs[kq + 3][r] = b.w; } }
        else { for (int i = 0; i < 2; ++i) { const int e = tid + i * 256, kk = e >> 5, c4 = (e & 31) * 4;
            const float4 b = *(const float4*)(Bm + (size_t)(k0 + kk) * ldb + n0 + c4);
            *(float4*)&Bs[kk][c4] = b; } }
        __syncthreads();
#pragma unroll
        for (int k = 0; k < 16; ++k) {
            float a[8], b[8];
            *(float4*)&a[0] = *(const float4*)&As[k][ty * 4]; *(float4*)&a[4] = *(const float4*)&As[k][64 + ty * 4];
            *(float4*)&b[0] = *(const float4*)&Bs[k][tx * 4]; *(float4*)&b[4] = *(const float4*)&Bs[k][64 + tx * 4];
#pragma unroll
            for (int i = 0; i < 8; ++i)
#pragma unroll
                for (int j = 0; j < 8; ++j) acc[i][j] += a[i] * b[j];
        }
        __syncthreads();
    }
#pragma unroll
    for (int i = 0; i < 8; ++i) { const int r = m0 + (i >> 2) * 64 + ty * 4 + (i & 3);
        *(float4*)(C + (size_t)r * ldc + n0 + tx * 4) = make_float4(acc[i][0], acc[i][1], acc[i][2], acc[i][3]);
        *(float4*)(C + (size_t)r * ldc + n0 + 64 + tx * 4) = make_float4(acc[i][4], acc[i][5], acc[i][6], acc[i][7]); }
}
__global__ void headnorm_rope(float* buf, int ld, int nheads, const float* g, const float* cs, const float* sn, int do_rope, int S_) {
    const int row = blockIdx.x / nheads, h = blockIdx.x % nheads, d = threadIdx.x;
    __shared__ float red[16]; __shared__ float xs[128];
    float* p = buf + (size_t)row * ld + h * HD;
    const float v = p[d];
    const float ss = block_sum(v * v, red);
    const float y = v * rsqrtf(ss / HD + EPS) * g[d];
    xs[d] = y; __syncthreads();
    float o = y;
    if (do_rope) {
        const int t = row % S_, pos = (d < 64) ? (t / 64) : (t % 64), dd = d & 63, i = dd & 31;
        const float c = cs[pos * 32 + i], s = sn[pos * 32 + i];
        const int base = d & 64;
        const float x1 = xs[base + i], x2 = xs[base + 32 + i];
        o = (dd < 32) ? (x1 * c - x2 * s) : (x1 * s + x2 * c);
    }
    p[d] = o;
}
__global__ void softmax_rows(float* Sm, int N, float scale) {
    __shared__ float red[16];
    float* r = Sm + (size_t)blockIdx.x * N;
    float mx = -1e30f;
    for (int j = threadIdx.x; j < N; j += 256) mx = fmaxf(mx, r[j] * scale);
    for (int o = 32; o > 0; o >>= 1) mx = fmaxf(mx, __shfl_xor(mx, o));
    if ((threadIdx.x & 63) == 0) red[threadIdx.x >> 6] = mx;
    __syncthreads();
    mx = fmaxf(fmaxf(red[0], red[1]), fmaxf(red[2], red[3]));
    float s = 0.f;
    for (int j = threadIdx.x; j < N; j += 256) { const float e = expf(r[j] * scale - mx); r[j] = e; s += e; }
    s = block_sum(s, red + 8);
    const float inv = 1.f / s;
    for (int j = threadIdx.x; j < N; j += 256) r[j] *= inv;
}
__global__ void glu_kernel(float* a, const float* b, size_t n) {
    const size_t i = (size_t)blockIdx.x * 256 + threadIdx.x; if (i < n) a[i] = a[i] * sigmf(b[i]);
}
__global__ void dwconv(const float* g, const float* w, const float* bias, float* out, int S_) {
    const int row = blockIdx.x, t = row % S_;
    for (int c = threadIdx.x; c < D; c += 256) {
        float acc = bias[c];
        for (int j = 0; j < 31; ++j) { const int tt = t + j - 15; if (tt >= 0 && tt < S_) acc += g[(size_t)(row + j - 15) * D + c] * w[j * D + c]; }
        out[(size_t)row * D + c] = acc;
    }
}
__global__ void ln_silu(float* buf, const float* g, const float* b) {
    __shared__ float red[32];
    float* x = buf + (size_t)blockIdx.x * D;
    float v[4], s = 0.f;
    for (int j = 0; j < 4; ++j) { v[j] = x[threadIdx.x + 256 * j]; s += v[j]; }
    const float mu = block_sum(s, red) / D;
    float q = 0.f;
    for (int j = 0; j < 4; ++j) { v[j] -= mu; q += v[j] * v[j]; }
    const float var = block_sum(q, red + 16) / D;
    const float r = rsqrtf(var + EPS);
    for (int j = 0; j < 4; ++j) { const int k = threadIdx.x + 256 * j; x[k] = siluf(v[j] * r * g[k] + b[k]); }
}
__global__ void gate_mul(float* y, const float* gate, size_t n) {
    const size_t i = (size_t)blockIdx.x * 256 + threadIdx.x; if (i < n) y[i] = sigmf(gate[i]) * y[i];
}
__global__ void gate_fma(float* m, const float* gate, const float* y, size_t n) {
    const size_t i = (size_t)blockIdx.x * 256 + threadIdx.x; if (i < n) m[i] += sigmf(gate[i]) * y[i];
}
__global__ void resid(const float* x, const float* o, const float* mod, int g_off, int row0, float* xs, size_t n) {
    const size_t i = (size_t)blockIdx.x * 256 + threadIdx.x; if (i >= n) return;
    const int row = (int)(i / D), k = (int)(i % D), b = (row0 + row) / S;
    xs[i] = x[i] + mod[b * NMOD + g_off + k] * o[i];
}
__global__ void peer_topk(const float* sc, int* eid, float* wgt, int T) {
    __shared__ float tv[64][33]; __shared__ int ti[64][33];
    const int gid = blockIdx.x * 64 + threadIdx.x; if (gid >= T * 8) return;
    const int t = gid / 8, h = gid % 8, l = threadIdx.x;
    for (int p = 0; p < 2; ++p) {
        const float* s = sc + (size_t)t * 2048 + h * 256 + p * 128;
        float pv = 3e38f; int pi = -1;
        for (int k = 0; k < 16; ++k) {
            float bv = -3e38f; int bi = 1 << 30;
            for (int n = 0; n < 128; ++n) { const float v = s[n];
                const bool elig = (v < pv) || (v == pv && n > pi);
                if (elig && (v > bv || (v == bv && n < bi))) { bv = v; bi = n; } }
            tv[l][p * 16 + k] = bv; ti[l][p * 16 + k] = bi; pv = bv; pi = bi;
        }
    }
    float pv = 3e38f; int pi = -1; float bs[16]; int be[16];
    float mx = 0.f;
#pragma unroll
    for (int k = 0; k < 16; ++k) {
        float bv = -3e38f; int bi = 1 << 30;
        for (int c = 0; c < 256; ++c) { const float v = tv[l][c >> 4] + tv[l][16 + (c & 15)];
            const bool elig = (v < pv) || (v == pv && c > pi);
            if (elig && (v > bv || (v == bv && c < bi))) { bv = v; bi = c; } }
        bs[k] = bv; be[k] = ti[l][bi >> 4] * 128 + ti[l][16 + (bi & 15)]; pv = bv; pi = bi;
        if (k == 0) mx = bv;
    }
    float sum = 0.f;
#pragma unroll
    for (int k = 0; k < 16; ++k) { bs[k] = expf(bs[k] - mx); sum += bs[k]; }
    const float inv = 1.f / sum;
#pragma unroll
    for (int k = 0; k < 16; ++k) { eid[(size_t)t * 128 + h * 16 + k] = be[k]; wgt[(size_t)t * 128 + h * 16 + k] = bs[k] * inv; }
}
__global__ void peer_gather_final(const float* hx2, const int* eid, const float* wgt, const float* ut, const float* vt, const float* xs,
                                  const float* mod, int g_off, int row0, const float* fg, float* out) {
    __shared__ float xr[D]; __shared__ float coef[128]; __shared__ int ids[128]; __shared__ float red[16];
    const int t = blockIdx.x, tid = threadIdx.x, lane = tid & 63, w = tid >> 6;
    for (int j = tid; j < D; j += 256) xr[j] = hx2[(size_t)t * D + j];
    if (tid < 128) ids[tid] = eid[(size_t)t * 128 + tid];
    __syncthreads();
    for (int k = w; k < 128; k += 4) {
        const float* u = ut + (size_t)ids[k] * D;
        float s = 0.f;
        for (int j = lane; j < D; j += 64) s += u[j] * xr[j];
        for (int o = 32; o > 0; o >>= 1) s += __shfl_xor(s, o);
        if (lane == 0) coef[k] = wgt[(size_t)t * 128 + k] * 0.5f * s * (1.f + erff(s * 0.70710678118654752f));
    }
    __syncthreads();
    float y[4] = {0.f, 0.f, 0.f, 0.f};
    for (int k = 0; k < 128; ++k) { const float* v = vt + (size_t)ids[k] * D; const float cf = coef[k];
        for (int j = 0; j < 4; ++j) y[j] += cf * v[tid + 256 * j]; }
    const int b = (row0 + t) / S;
    float z[4], ss = 0.f;
    for (int j = 0; j < 4; ++j) { const int k = tid + 256 * j; z[j] = xs[(size_t)t * D + k] + mod[b * NMOD + g_off + k] * y[j]; ss += z[j] * z[j]; }
    ss = block_sum(ss, red);
    const float r = rsqrtf(ss / D + EPS);
    for (int j = 0; j < 4; ++j) { const int k = tid + 256 * j; out[(size_t)t * D + k] = z[j] * r * fg[k]; }
}

template <bool BT> static void gemm(hipStream_t st, const float* A, int lda, const float* Bm, int ldb, float* C, int ldc, int M, int N, int K) {
    hipLaunchKernelGGL(sgemm<BT>, dim3(N / 128, M / 128), dim3(256), 0, st, A, lda, Bm, ldb, C, ldc, M, N, K);
}

static void run(void* const* d_in, float* out, char* ws, hipStream_t st) {
    const float* x = (const float*)d_in[0]; const float* c = (const float*)d_in[1]; const float* ctx = (const float*)d_in[2]; const float* c_ctx = (const float*)d_in[3];
    const float* w_mod = (const float*)d_in[4]; const float* b_mod = (const float*)d_in[5]; const float* n1g = (const float*)d_in[6]; const float* n2g = (const float*)d_in[7];
    const float* w_in = (const float*)d_in[8]; const float* qng = (const float*)d_in[9]; const float* kng = (const float*)d_in[10]; const float* w_ao = (const float*)d_in[11];
    const float* cdw = (const float*)d_in[12]; const float* cb = (const float*)d_in[13]; const float* clg = (const float*)d_in[14]; const float* clb = (const float*)d_in[15];
    const float* w_co = (const float*)d_in[16]; const float* w_o = (const float*)d_in[17]; const float* wq = (const float*)d_in[18]; const float* keys = (const float*)d_in[19];
    const float* ut = (const float*)d_in[20]; const float* vt = (const float*)d_in[21]; const float* fg = (const float*)d_in[22];
    constexpr size_t MiB = 1u << 20;
    constexpr int NB = 2, TH = NB * S;
    constexpr size_t RB = (size_t)TH * D * 4;
    float* R0 = (float*)(ws); float* R1 = (float*)(ws + RB); float* R2 = (float*)(ws + 2 * RB); float* R3 = (float*)(ws + 3 * RB);
    float* KB = (float*)(ws + 4 * RB);
    float* VB = KB + (size_t)NB * SKV * 256;
    float* SM = (float*)(ws + 5 * RB);
    char* small = ws + 5 * RB + 72 * MiB;
    float* mod = (float*)small; float* cs = mod + 9 * NMOD; float* sn = cs + 2048; float* Wp = sn + 2048;
    float* hc = Wp + (size_t)D * 2048;
    int* eid = (int*)(hc + (size_t)NB * CTX * D); float* wgt = (float*)(eid + (size_t)TH * 128);
    hipLaunchKernelGGL(mod_kernel, dim3(NMOD / 256, 9), dim3(256), 0, st, c, c_ctx, w_mod, b_mod, mod);
    hipLaunchKernelGGL(rope_table, dim3(32), dim3(64), 0, st, cs, sn);
    for (int hp = 0; hp < 16; ++hp) gemm<true>(st, wq + hp * 128, 2048, keys + (size_t)hp * 128 * 128, 128, Wp + hp * 128, 2048, D, 128, 128);
    const size_t n = (size_t)TH * D; const int eg = (int)((n + 255) / 256);
    for (int pass = 0; pass < B / NB; ++pass) {
        const int b0 = pass * NB, row0 = b0 * S;
        const float* xp = x + (size_t)row0 * D; float* outp = out + (size_t)row0 * D;
        hipLaunchKernelGGL(normmod, dim3(TH), dim3(256), 0, st, xp, n1g, mod, 0, D, S, b0, -1, R0);
        hipLaunchKernelGGL(normmod, dim3(NB * CTX), dim3(256), 0, st, ctx + (size_t)b0 * CTX * D, n1g, mod, 0, D, 1, 0, 8, hc);
        gemm<false>(st, R0, D, w_in, INW, R1, D, TH, 1024, D);
        for (int b = 0; b < NB; ++b) {
            gemm<false>(st, R0 + (size_t)b * S * D, D, w_in + 1024, INW, KB + (size_t)b * SKV * 256, 256, S, 256, D);
            gemm<false>(st, R0 + (size_t)b * S * D, D, w_in + 1280, INW, VB + (size_t)b * SKV * 256, 256, S, 256, D);
            gemm<false>(st, hc + (size_t)b * CTX * D, D, w_in + 1024, INW, KB + ((size_t)b * SKV + S) * 256, 256, CTX, 256, D);
            gemm<false>(st, hc + (size_t)b * CTX * D, D, w_in + 1280, INW, VB + ((size_t)b * SKV + S) * 256, 256, CTX, 256, D);
            hipLaunchKernelGGL(headnorm_rope, dim3(S * HKV), dim3(128), 0, st, KB + (size_t)b * SKV * 256, 256, HKV, kng, cs, sn, 1, S);
            hipLaunchKernelGGL(headnorm_rope, dim3(CTX * HKV), dim3(128), 0, st, KB + ((size_t)b * SKV + S) * 256, 256, HKV, kng, cs, sn, 0, S);
        }
        hipLaunchKernelGGL(headnorm_rope, dim3(TH * HQ), dim3(128), 0, st, R1, D, HQ, qng, cs, sn, 1, S);
        for (int b = 0; b < NB; ++b) for (int h = 0; h < HQ; ++h) {
            const int kv = h / 4;
            gemm<true>(st, R1 + (size_t)b * S * D + h * HD, D, KB + (size_t)b * SKV * 256 + kv * HD, 256, SM, SKV, S, SKV, HD);
            hipLaunchKernelGGL(softmax_rows, dim3(S), dim3(256), 0, st, SM, SKV, 0.08838834764831845f);
            gemm<false>(st, SM, SKV, VB + (size_t)b * SKV * 256 + kv * HD, 256, R3 + (size_t)b * S * D + h * HD, D, S, HD, SKV);
        }
        gemm<false>(st, R3, D, w_ao, D, R1, D, TH, D, D);
        gemm<false>(st, R0, D, w_in + 1536, INW, R2, D, TH, D, D);
        gemm<false>(st, R0, D, w_in + 2560, INW, R3, D, TH, D, D);
        hipLaunchKernelGGL(glu_kernel, dim3(eg), dim3(256), 0, st, R2, R3, n);
        hipLaunchKernelGGL(dwconv, dim3(TH), dim3(256), 0, st, R2, cdw, cb, R3, S);
        hipLaunchKernelGGL(ln_silu, dim3(TH), dim3(256), 0, st, R3, clg, clb);
        gemm<false>(st, R0, D, w_in + 3584, INW, R2, D, TH, D, D);
        hipLaunchKernelGGL(gate_mul, dim3(eg), dim3(256), 0, st, R1, R2, n);
        gemm<false>(st, R0, D, w_in + 4608, INW, R2, D, TH, D, D);
        gemm<false>(st, R3, D, w_co, D, outp, D, TH, D, D);
        hipLaunchKernelGGL(gate_fma, dim3(eg), dim3(256), 0, st, R1, R2, outp, n);
        gemm<false>(st, R1, D, w_o, D, R0, D, TH, D, D);
        hipLaunchKernelGGL(resid, dim3(eg), dim3(256), 0, st, xp, R0, mod, 2 * D, row0, outp, n);
        hipLaunchKernelGGL(normmod, dim3(TH), dim3(256), 0, st, outp, n2g, mod, 3 * D, 4 * D, S, b0, -1, R0);
        gemm<false>(st, R0, D, Wp, 2048, R1, 2048, TH, 2048, D);
        hipLaunchKernelGGL(peer_topk, dim3(TH * 8 / 64), dim3(64), 0, st, R1, eid, wgt, TH);
        hipLaunchKernelGGL(peer_gather_final, dim3(TH), dim3(256), 0, st, R0, eid, wgt, ut, vt, outp, mod, 5 * D, row0, fg, outp);
    }
}
}

extern "C" void kernel_launch(void* const* d_in, const int* in_sizes, int n_in, void* d_out, int out_size, void* d_ws, size_t ws_size, hipStream_t stream) {
    nv::run(d_in, (float*)d_out, (char*)d_ws, stream);
}
```

```cpp
#include <hip/hip_runtime.h>
#include <hip/hip_cooperative_groups.h>
#include <cstdio>
#include <cstdint>
namespace cg = cooperative_groups;

#define LAS __attribute__((address_space(3)))
typedef unsigned short bf16_t;
typedef short bf16x8 __attribute__((ext_vector_type(8)));
typedef short s16x4 __attribute__((ext_vector_type(4)));
typedef float f32x2 __attribute__((ext_vector_type(2)));
typedef float f32x4 __attribute__((ext_vector_type(4)));
typedef float f32x16 __attribute__((ext_vector_type(16)));
typedef unsigned u32x2 __attribute__((ext_vector_type(2)));
typedef unsigned u32x4 __attribute__((ext_vector_type(4)));
typedef __bf16 bf16x2_t __attribute__((ext_vector_type(2)));

constexpr int D = 1024, NB = 8, S = 4096, CTXL = 256, SKV = S + CTXL, HD = 128, HQ = 8, HKV = 2;
constexpr int M = NB * S;
constexpr int MC = NB * CTXL;
constexpr int INW = 5632, NMOD = 6144, NEXP = 16384, PW = 2048;
constexpr float EPS = 1e-6f;

__device__ __forceinline__ unsigned cvt_pk_bf16(float lo, float hi) { f32x2 v = {lo, hi}; bf16x2_t b = __builtin_convertvector(v, bf16x2_t); return __builtin_bit_cast(unsigned, b); }
__device__ __forceinline__ float bf_lo(unsigned u) { return __uint_as_float(u << 16); }
__device__ __forceinline__ float bf_hi(unsigned u) { return __uint_as_float(u & 0xffff0000u); }
__device__ __forceinline__ float fast_sigmoid(float x) { return __builtin_amdgcn_rcpf(1.f + __builtin_amdgcn_exp2f(-1.4426950408889634f * x)); }
__device__ __forceinline__ float wave_sum(float v) {
#pragma unroll
    for (int o = 1; o < 64; o <<= 1) v += __shfl_xor(v, o);
    return v;
}

namespace pg8 {
constexpr int BM = 256, BK = 64, HALF = 128, HTB = HALF * BK * 2  , STAGE_BYTES = 8 * HTB, NXCD = 8, WGM = 8;
__host__ __device__ __forceinline__ int lds_byte(int r, int c) { const int st = (r >> 4) * 2 + (c >> 5), rr = r & 15, cc = c & 31, ob = rr * 64 + cc * 2; return st * 1024 + (ob ^ (((ob >> 9) & 1) << 5)); }
__host__ __device__ __forceinline__ void stage_rc(int b, int& R, int& C) { const int st = b / 1024, sb = b % 1024, swz = sb ^ (((sb >> 9) & 1) << 5); R = (st >> 1) * 16 + swz / 64; C = (st & 1) * 32 + (swz % 64) / 2; }
__host__ __device__ __forceinline__ int perm32(int rho) { const int n = rho >> 4, i = rho & 15; return 8 * (i >> 2) + 4 * n + (i & 3); }

struct Unit { const char* a; const char* b; int pm, pn, kind, keep; };

__device__ __forceinline__ void tile_of(int L, int nM, int nN, int& pm, int& pn) {
    const int nwg = nM * nN; int wgid = L;
    { const int q = nwg / NXCD, r = nwg % NXCD, xcd = wgid % NXCD, off = wgid / NXCD; wgid = (xcd < r ? xcd * (q + 1) : r * (q + 1) + (xcd - r) * q) + off; }
    const int nig = WGM * nN, gid = wgid / nig, fm = gid * WGM, gsz = (nM - fm) < WGM ? (nM - fm) : WGM;
    pm = fm + ((wgid % nig) % gsz); pn = (wgid % nig) / gsz;
}

template <class Epi, class Sched, bool ALIGN_EPI>
__device__ __forceinline__ void gemm_phase(LAS unsigned char* lds, const int K, const Sched& S, const Epi& E) {
    const int tid = threadIdx.x, wid = __builtin_amdgcn_readfirstlane(tid >> 6), lane = tid & 63, wr = wid >> 2, wc = wid & 3, fr = lane & 15, fq = lane >> 4;
    const int nt = K / BK;
    unsigned voffA[2], voffB[2];
#pragma unroll
    for (int i = 0; i < 2; ++i) { int R, C; stage_rc(tid * 16 + i * 8192, R, C); const int Rb = Epi::PERM ? ((R & ~31) + perm32(R & 31)) : R;
        voffA[i] = (unsigned)(R * K + C) * 2u; voffB[i] = (unsigned)(Rb * K + C) * 2u; }
    const size_t kstep = (size_t)(BK * 2);
    const size_t hstep = (size_t)HALF * K * 2;
    const unsigned ldsw = (unsigned)wid * 1024u;
    const int aoff = lds_byte(wr * 64 + fr, fq * 8), boff = lds_byte(wc * 32 + fr, fq * 8);
#define PG8_SA(b, h) (((b) * 2 + (h)) * HTB)
#define PG8_SB(b, h) ((4 + (b) * 2 + (h)) * HTB)
#define PG8_STAGE(bufoff, gbase, voff) do { _Pragma("unroll") for (int _i = 0; _i < 2; ++_i) \
        __builtin_amdgcn_global_load_lds((const unsigned*)((const char*)(gbase) + (voff)[_i]), (LAS unsigned*)(lds + (bufoff) + ldsw + _i * 8192), 16, 0, 0); } while (0)
#define PG8_LDA(dst, b, h) do { _Pragma("unroll") for (int m = 0; m < 4; ++m) _Pragma("unroll") for (int k = 0; k < 2; ++k) dst[m][k] = *(const LAS bf16x8*)(lds + PG8_SA(b, h) + aoff + m * 2048 + k * 1024); } while (0)
#define PG8_LDB(dst, b, h) do { _Pragma("unroll") for (int n = 0; n < 2; ++n) _Pragma("unroll") for (int k = 0; k < 2; ++k) dst[n][k] = *(const LAS bf16x8*)(lds + PG8_SB(b, h) + boff + n * 2048 + k * 1024); } while (0)
#define PG8_MMA(ai, bj, At, Bt) do { __builtin_amdgcn_s_setprio(1); _Pragma("unroll") for (int m = 0; m < 4; ++m) _Pragma("unroll") for (int n = 0; n < 2; ++n) _Pragma("unroll") for (int k = 0; k < 2; ++k) \
        acc[ai][bj][m][n] = __builtin_amdgcn_mfma_f32_16x16x32_bf16(Bt[n][k], At[m][k], acc[ai][bj][m][n], 0, 0, 0); __builtin_amdgcn_s_setprio(0); } while (0)
#define PG8_WAIT_V(n) asm volatile("s_waitcnt vmcnt(" #n ")" ::: "memory")
#define PG8_WAIT_L(n) asm volatile("s_waitcnt lgkmcnt(" #n ")" ::: "memory")
#define PG8_BAR __builtin_amdgcn_s_barrier()
#define PG8_SCHED __builtin_amdgcn_sched_barrier(0)
    Unit cur, nxt; int ui = 0;
    if (!S.next(0, cur)) return;
    f32x4 acc[2][2][4][2];
#pragma unroll
    for (int a = 0; a < 2; ++a)
#pragma unroll
        for (int b = 0; b < 2; ++b)
#pragma unroll
            for (int m = 0; m < 4; ++m)
#pragma unroll
                for (int n = 0; n < 2; ++n) acc[a][b][m][n] = (f32x4){0.f, 0.f, 0.f, 0.f};
    bf16x8 At[4][2], B0[2][2], B1[2][2];
    const char* cA = cur.a; const char* cB = cur.b;
    PG8_STAGE(PG8_SB(0, 0), cB, voffB); PG8_STAGE(PG8_SB(0, 1), cB + hstep, voffB); PG8_STAGE(PG8_SA(0, 0), cA, voffA); PG8_STAGE(PG8_SA(0, 1), cA + hstep, voffA);
    if (wr == 1) PG8_BAR;
    PG8_WAIT_V(2); PG8_BAR;
    PG8_STAGE(PG8_SB(1, 0), cB + kstep, voffB); PG8_STAGE(PG8_SA(1, 0), cA + kstep, voffA); PG8_STAGE(PG8_SB(1, 1), cB + hstep + kstep, voffB);
    PG8_WAIT_V(6); PG8_BAR;
    for (;;) {
        const bool has_next = S.next(ui + 1, nxt);
        const char* nA = has_next ? nxt.a : cA; const char* nB = has_next ? nxt.b : cB;
        for (int t = 0; t < nt; t += 2) {
            const bool last = (t == nt - 2);
            const char* a1 = cA + (size_t)(t + 1) * kstep;
            const char* a2 = last ? nA : cA + (size_t)(t + 2) * kstep; const char* b2 = last ? nB : cB + (size_t)(t + 2) * kstep;
            const char* a3 = a2 + kstep; const char* b3 = b2 + kstep;
            PG8_LDB(B0, 0, 0); PG8_LDB(B1, 0, 1); PG8_SCHED; PG8_LDA(At, 0, 0); PG8_STAGE(PG8_SA(1, 1), a1 + hstep, voffA);
            PG8_WAIT_V(8); PG8_WAIT_L(0); PG8_BAR; PG8_MMA(0, 0, At, B0); PG8_MMA(0, 1, At, B1); PG8_BAR; PG8_SCHED;
            PG8_LDA(At, 0, 1); PG8_STAGE(PG8_SB(0, 0), b2, voffB); PG8_STAGE(PG8_SB(0, 1), b2 + hstep, voffB); PG8_STAGE(PG8_SA(0, 0), a2, voffA);
            PG8_WAIT_V(8); PG8_WAIT_L(0); PG8_BAR; PG8_MMA(1, 0, At, B0); PG8_MMA(1, 1, At, B1); PG8_BAR; PG8_SCHED;
            PG8_LDB(B0, 1, 0); PG8_LDB(B1, 1, 1); PG8_SCHED; PG8_LDA(At, 1, 0); PG8_STAGE(PG8_SA(0, 1), a2 + hstep, voffA);
            PG8_WAIT_V(8); PG8_WAIT_L(0); PG8_BAR; PG8_MMA(0, 0, At, B0); PG8_MMA(0, 1, At, B1); PG8_BAR; PG8_SCHED;
            PG8_LDA(At, 1, 1); PG8_STAGE(PG8_SB(1, 0), b3, voffB); PG8_STAGE(PG8_SB(1, 1), b3 + hstep, voffB); PG8_STAGE(PG8_SA(1, 0), a3, voffA);
            PG8_WAIT_V(8); PG8_WAIT_L(0); PG8_BAR; PG8_MMA(1, 0, At, B0); PG8_MMA(1, 1, At, B1); PG8_BAR; PG8_SCHED;
        }
        if constexpr (ALIGN_EPI) { if (wr == 0) PG8_BAR; }
        E(acc, cur, wr, wc, fr, fq);
        if (!has_next) break;
        if (!cur.keep) {
#pragma unroll
        for (int a = 0; a < 2; ++a)
#pragma unroll
            for (int b = 0; b < 2; ++b)
#pragma unroll
                for (int m = 0; m < 4; ++m)
#pragma unroll
                    for (int n = 0; n < 2; ++n) acc[a][b][m][n] = (f32x4){0.f, 0.f, 0.f, 0.f};
        }
        cur = nxt; cA = nA; cB = nB; ++ui;
        if constexpr (ALIGN_EPI) { if (wr == 1) PG8_BAR; }
    }
    PG8_WAIT_V(0);
    if constexpr (!ALIGN_EPI) { if (wr == 0) PG8_BAR; }
    PG8_BAR;
#undef PG8_SA
#undef PG8_SB
#undef PG8_STAGE
#undef PG8_LDA
#undef PG8_LDB
#undef PG8_MMA
#undef PG8_WAIT_V
#undef PG8_WAIT_L
#undef PG8_BAR
#undef PG8_SCHED
}
}
namespace att {
constexpr int NW = 8, QBLK = 32, KVBLK = 64;
constexpr float SCALE = 0.088388347648318440f;
constexpr float THR = 8.f;
constexpr int LDQ = D, LDK = HKV * HD, LDO = D;
constexpr int SHM_V = KVBLK * HD * 2, SHM_K = KVBLK * HD * 2, SHM_ATTN = 2 * SHM_V + 2 * SHM_K + NW * 64 * 4;
constexpr int OST_OFF = SHM_ATTN, LDS_TOTAL = OST_OFF + NW * 8192;
#define KSWZ(row, colB) ((row) * 256 + ((colB) ^ (((row) & 7) << 4)))
#define SBAR() __builtin_amdgcn_sched_barrier(0)
__device__ __forceinline__ int crow(int r, int hi) { return (r & 3) + 8 * (r >> 2) + 4 * hi; }
__device__ __forceinline__ unsigned cvtpk(float lo, float hi) { unsigned r; asm volatile("v_cvt_pk_bf16_f32 %0, %1, %2" : "=v"(r) : "v"(lo), "v"(hi)); return r; }

__device__ __forceinline__ void partialSM(f32x16& p0, f32x16& p1, float& m_reg, float& mn, float& alpha) {
  constexpr float C = SCALE * 1.4426950408889634f;
  float pmax = p0[0]; for (int r = 1; r < 16; ++r) pmax = fmaxf(pmax, p0[r]); for (int r = 0; r < 16; ++r) pmax = fmaxf(pmax, p1[r]);
  { auto rr = __builtin_amdgcn_permlane32_swap(__float_as_uint(pmax), __float_as_uint(pmax), false, false);
    pmax = fmaxf(__uint_as_float(rr[0]), __uint_as_float(rr[1])); }
  if (__builtin_expect(__all(pmax - m_reg <= THR / SCALE), 1)) { mn = m_reg; alpha = 1.f; }
  else { mn = fmaxf(m_reg, pmax); alpha = __builtin_amdgcn_exp2f((m_reg - mn) * C); m_reg = mn; }
  float mnC = -mn * C;
  for (int r = 0; r < 16; ++r) p0[r] = fmaf(p0[r], C, mnC); for (int r = 0; r < 16; ++r) p1[r] = fmaf(p1[r], C, mnC);
  for (int r = 0; r < 16; ++r) p0[r] = __builtin_amdgcn_exp2f(p0[r]);
}
__device__ __forceinline__ void finishSM(f32x16& p0, f32x16& p1, float alpha, float& l_reg, bf16x8& pa0, bf16x8& pa1, bf16x8& pa2, bf16x8& pa3) {
  for (int r = 0; r < 16; ++r) p1[r] = __builtin_amdgcn_exp2f(p1[r]);
  float ps = 0; for (int r = 0; r < 16; ++r) ps += p0[r]; for (int r = 0; r < 16; ++r) ps += p1[r];
  { auto rr = __builtin_amdgcn_permlane32_swap(__float_as_uint(ps), __float_as_uint(ps), false, false);
    ps = __uint_as_float(rr[0]) + __uint_as_float(rr[1]); }
  l_reg = l_reg * alpha + ps;
#define PK4(P, BASE, OUT) do { unsigned a0 = cvtpk(P[BASE + 0], P[BASE + 1]), a1 = cvtpk(P[BASE + 2], P[BASE + 3]);   \
    unsigned b0 = cvtpk(P[BASE + 4], P[BASE + 5]), b1 = cvtpk(P[BASE + 6], P[BASE + 7]);                              \
    auto r0 = __builtin_amdgcn_permlane32_swap(a0, b0, false, false); auto r1 = __builtin_amdgcn_permlane32_swap(a1, b1, false, false); \
    u32x4 w = {r0[0], r1[0], r0[1], r1[1]}; OUT = *reinterpret_cast<bf16x8*>(&w); } while (0)
  PK4(p0, 0, pa0); PK4(p0, 8, pa1); PK4(p1, 0, pa2); PK4(p1, 8, pa3);
#undef PK4
}
__device__ __forceinline__ void qkt(f32x16& p0, f32x16& p1, const bf16_t* Ks, const bf16x8* qr, int r32, int hi) {
  p0 = f32x16{}; p1 = f32x16{};
  for (int d0 = 0; d0 < 8; ++d0) { int cb = (d0 * 16 + hi * 8) * 2;
    bf16x8 b0 = *reinterpret_cast<const bf16x8*>((const char*)Ks + KSWZ(r32, cb));
    bf16x8 b1 = *reinterpret_cast<const bf16x8*>((const char*)Ks + KSWZ(32 + r32, cb));
    p0 = __builtin_amdgcn_mfma_f32_32x32x16_bf16(b0, qr[d0], p0, 0, 0, 0);
    p1 = __builtin_amdgcn_mfma_f32_32x32x16_bf16(b1, qr[d0], p1, 0, 0, 0); }
}
__device__ __forceinline__ int v_st(int k, int c) { const int kk = (k & ~0xC) | ((k & 4) << 1) | ((k & 8) >> 1); return ((kk >> 3) * 4 + (c >> 5)) * 512 + ((kk & 7) * 32 + (c & 31)) * 2; }
__device__ __forceinline__ int v_rd_base(int lane) { return ((lane & 3) << 3) | (((lane >> 2) & 3) << 6) | (((lane >> 4) & 1) << 5) | (((lane >> 5) & 1) << 8); }
constexpr int v_rd_off(int d0, int ks, int half) { return d0 * 512 + ks * 4096 + half * 2048; }
template <int OFF> __device__ __forceinline__ s16x4 tr_read(int vb) {
  s16x4 r; asm volatile("ds_read_b64_tr_b16 %0, %1 offset:%2" : "=&v"(r) : "v"(vb), "i"(OFF) : "memory"); return r;
}
template <int D0> __device__ __forceinline__ void pv_one(f32x16& od, int vb, bf16x8 pa0, bf16x8 pa1, bf16x8 pa2, bf16x8 pa3) {
  const s16x4 l0 = tr_read<v_rd_off(D0, 0, 0)>(vb), h0 = tr_read<v_rd_off(D0, 0, 1)>(vb), l1 = tr_read<v_rd_off(D0, 1, 0)>(vb), h1 = tr_read<v_rd_off(D0, 1, 1)>(vb);
  const s16x4 l2 = tr_read<v_rd_off(D0, 2, 0)>(vb), h2 = tr_read<v_rd_off(D0, 2, 1)>(vb), l3 = tr_read<v_rd_off(D0, 3, 0)>(vb), h3 = tr_read<v_rd_off(D0, 3, 1)>(vb);
  asm volatile("s_waitcnt lgkmcnt(0)" ::: "memory"); SBAR();
#define PK(L, H) (bf16x8){L[0], L[1], L[2], L[3], H[0], H[1], H[2], H[3]}
  od = __builtin_amdgcn_mfma_f32_32x32x16_bf16(pa0, PK(l0, h0), od, 0, 0, 0);
  od = __builtin_amdgcn_mfma_f32_32x32x16_bf16(pa1, PK(l1, h1), od, 0, 0, 0);
  od = __builtin_amdgcn_mfma_f32_32x32x16_bf16(pa2, PK(l2, h2), od, 0, 0, 0);
  od = __builtin_amdgcn_mfma_f32_32x32x16_bf16(pa3, PK(l3, h3), od, 0, 0, 0);
#undef PK
}
__device__ __forceinline__ void pv_d0(f32x16* o, int vb, bf16x8 pa0, bf16x8 pa1, bf16x8 pa2, bf16x8 pa3) {
  pv_one<0>(o[0], vb, pa0, pa1, pa2, pa3); pv_one<1>(o[1], vb, pa0, pa1, pa2, pa3); pv_one<2>(o[2], vb, pa0, pa1, pa2, pa3); pv_one<3>(o[3], vb, pa0, pa1, pa2, pa3);
}

__device__ __forceinline__ void attn_unit(const bf16_t* Qb, const bf16_t* __restrict__ Kh, const bf16_t* __restrict__ Vh, bf16_t* Ob, int t0, int seq,
                                          const float* __restrict__ qng, const float* __restrict__ cst, const float* __restrict__ snt, char* lds) {
  int tid_ = threadIdx.x; asm volatile("" : "+v"(tid_));
  const int tid = tid_, wid = tid >> 6, lane = tid & 63, r32 = lane & 31, hi = lane >> 5;
  bf16_t* V_lds = (bf16_t*)lds; bf16_t* K_lds = (bf16_t*)(lds + 2 * SHM_V);
  float* ws = (float*)(lds + 2 * SHM_V + 2 * SHM_K) + wid * 64; float* li_l = ws; float* al_l = ws + 32;
  float m_reg = -1e30f, l_reg = 0; f32x16 o[4] = {}; bf16x8 qr[8];
  {
    const bf16_t* Qw = Qb + (long)(wid * QBLK + r32) * LDQ + hi * 8;
    float y[8][8]; float ss = 0.f;
#pragma unroll
    for (int d0 = 0; d0 < 8; ++d0) { const u32x4 w = *reinterpret_cast<const u32x4*>(Qw + d0 * 16);
#pragma unroll
      for (int j = 0; j < 4; ++j) { y[d0][2 * j] = bf_lo(w[j]); y[d0][2 * j + 1] = bf_hi(w[j]); ss += y[d0][2 * j] * y[d0][2 * j] + y[d0][2 * j + 1] * y[d0][2 * j + 1]; } }
    ss += __shfl_xor(ss, 32);
    const float rstd = rsqrtf(ss * (1.f / HD) + EPS);
#pragma unroll
    for (int d0 = 0; d0 < 8; ++d0) { const f32x4 g0 = *reinterpret_cast<const f32x4*>(qng + d0 * 16 + hi * 8), g1 = *reinterpret_cast<const f32x4*>(qng + d0 * 16 + hi * 8 + 4);
#pragma unroll
      for (int j = 0; j < 4; ++j) { y[d0][j] *= rstd * g0[j]; y[d0][4 + j] *= rstd * g1[j]; } }
    const int t = t0 + wid * QBLK + r32;
#pragma unroll
    for (int blk = 0; blk < 2; ++blk) { const int pos = blk == 0 ? (t >> 6) : (t & 63);
#pragma unroll
      for (int dd = 0; dd < 2; ++dd) { const int da = blk * 4 + dd, db = da + 2;
#pragma unroll
        for (int j4 = 0; j4 < 2; ++j4) { const f32x4 c4 = *reinterpret_cast<const f32x4*>(cst + pos * 32 + dd * 16 + hi * 8 + j4 * 4), s4 = *reinterpret_cast<const f32x4*>(snt + pos * 32 + dd * 16 + hi * 8 + j4 * 4);
#pragma unroll
          for (int j = 0; j < 4; ++j) { const float x1 = y[da][j4 * 4 + j], x2 = y[db][j4 * 4 + j]; y[da][j4 * 4 + j] = x1 * c4[j] - x2 * s4[j]; y[db][j4 * 4 + j] = x1 * s4[j] + x2 * c4[j]; } } } }
#pragma unroll
    for (int d0 = 0; d0 < 8; ++d0) { u32x4 w = {cvt_pk_bf16(y[d0][0], y[d0][1]), cvt_pk_bf16(y[d0][2], y[d0][3]), cvt_pk_bf16(y[d0][4], y[d0][5]), cvt_pk_bf16(y[d0][6], y[d0][7])}; qr[d0] = *reinterpret_cast<bf16x8*>(&w); }
  }
  const int sr = tid >> 4, sc = (tid & 15) * 8, vst0 = v_st(sr, sc), vst1 = v_st(32 + sr, sc);
  const int vb0 = (int)(uintptr_t)V_lds + v_rd_base(lane);
  struct { bf16x8 vs0, vs1, ks0, ks1; } sr_[2];
#define LD8(p) (*reinterpret_cast<const bf16x8*>(p))
#define SLOAD(i, k0) do { sr_[i].vs0 = LD8(&Vh[(long)((k0) + sr) * LDK + sc]); sr_[i].vs1 = LD8(&Vh[(long)((k0) + 32 + sr) * LDK + sc]); \
    sr_[i].ks0 = LD8(&Kh[(long)((k0) + sr) * LDK + sc]); sr_[i].ks1 = LD8(&Kh[(long)((k0) + 32 + sr) * LDK + sc]); } while (0)
#define SWRITE(b, i) do { *(bf16x8*)((char*)V_lds + (b) * SHM_V + vst0) = sr_[i].vs0;          \
    *(bf16x8*)((char*)V_lds + (b) * SHM_V + vst1) = sr_[i].vs1; int kc = sc * 2;               \
    *(bf16x8*)((char*)K_lds + (b) * SHM_K + KSWZ(sr, kc)) = sr_[i].ks0;                       \
    *(bf16x8*)((char*)K_lds + (b) * SHM_K + KSWZ(32 + sr, kc)) = sr_[i].ks1; } while (0)
#define SWAIT() asm volatile("s_waitcnt vmcnt(4)" ::: "memory")
#define RESC(a) do { if (__any((a) < 1.f)) { if (hi == 0) al_l[r32] = (a); asm volatile("s_waitcnt lgkmcnt(0)" ::: "memory"); \
    for (int d = 0; d < 4; ++d) for (int r = 0; r < 16; ++r) o[d][r] *= al_l[crow(r, hi)]; } } while (0)
  f32x16 pA0, pA1, pB0, pB1; float mnA, mnB, alA, alB; bf16x8 pa0, pa1, pa2, pa3; const int NT = seq / KVBLK;
  constexpr int SE = 0, SO = 1;
  SLOAD(SE, 0); asm volatile("s_waitcnt vmcnt(0)" ::: "memory"); SWRITE(0, SE); __syncthreads();
  qkt(pA0, pA1, K_lds, qr, r32, hi); partialSM(pA0, pA1, m_reg, mnA, alA);
  SLOAD(SO, KVBLK); if (2 < NT) SLOAD(SE, 2 * KVBLK);
  SWAIT(); SWRITE(1, SO); __syncthreads();
  for (int j = 1; j + 1 < NT; j += 2) {
    SBAR(); qkt(pB0, pB1, (bf16_t*)((char*)K_lds + SHM_K), qr, r32, hi);
    finishSM(pA0, pA1, alA, l_reg, pa0, pa1, pa2, pa3); SBAR();
    SLOAD(SO, (j + 2) * KVBLK); SBAR();
    pv_d0(o, vb0, pa0, pa1, pa2, pa3); partialSM(pB0, pB1, m_reg, mnB, alB);
    __syncthreads(); SWAIT(); SWRITE(0, SE);
    RESC(alB); __syncthreads();
    SBAR(); qkt(pA0, pA1, K_lds, qr, r32, hi);
    finishSM(pB0, pB1, alB, l_reg, pa0, pa1, pa2, pa3); SBAR();
    if (j + 3 < NT) SLOAD(SE, (j + 3) * KVBLK); SBAR();
    pv_d0(o, vb0 + (int)SHM_V, pa0, pa1, pa2, pa3); partialSM(pA0, pA1, m_reg, mnA, alA);
    __syncthreads(); SWAIT(); SWRITE(1, SO);
    RESC(alA); __syncthreads();
  }
  SBAR(); qkt(pB0, pB1, (bf16_t*)((char*)K_lds + SHM_K), qr, r32, hi);
  finishSM(pA0, pA1, alA, l_reg, pa0, pa1, pa2, pa3); SBAR();
  pv_d0(o, vb0, pa0, pa1, pa2, pa3); partialSM(pB0, pB1, m_reg, mnB, alB);
  __syncthreads(); RESC(alB);
  finishSM(pB0, pB1, alB, l_reg, pa0, pa1, pa2, pa3); SBAR();
  pv_d0(o, vb0 + (int)SHM_V, pa0, pa1, pa2, pa3);
  if (hi == 0) li_l[r32] = l_reg; asm volatile("s_waitcnt lgkmcnt(0)" ::: "memory");
  float rli[16];
#pragma unroll
  for (int r = 0; r < 16; ++r) rli[r] = __builtin_amdgcn_rcpf(li_l[crow(r, hi)]);
  { bf16_t* stg = (bf16_t*)(lds + OST_OFF) + wid * 4096;
#pragma unroll
    for (int r = 0; r < 16; ++r) { const int orow = crow(r, hi);
#pragma unroll
      for (int d0 = 0; d0 < 4; ++d0) stg[orow * 128 + d0 * 32 + r32] = (bf16_t)(cvt_pk_bf16(o[d0][r] * rli[r], 0.f) & 0xffffu); }
    asm volatile("s_waitcnt lgkmcnt(0)" ::: "memory");
    bf16_t* Ow = Ob + (long)(wid * QBLK) * LDO;
#pragma unroll
    for (int i = 0; i < 8; ++i) { const int row = i * 4 + (lane >> 4), ch = lane & 15; const u32x4 v = *(const u32x4*)(stg + row * 128 + ch * 8); *(u32x4*)(Ow + (long)row * LDO + ch * 8) = v; }
  }
#undef LD8
#undef SLOAD
#undef SWRITE
#undef SWAIT
#undef RESC
}
#undef KSWZ
#undef SBAR
}
constexpr size_t MiB = 1u << 20;
constexpr size_t WS_CTL = 0, CTL_ZERO_BYTES = 64 * 1024;
constexpr size_t WS_MOD = 1 * MiB;
constexpr size_t WS_ROPE = WS_MOD + 256 * 1024;
constexpr size_t WS_HC = 2 * MiB;
constexpr size_t WS_WIN = 6 * MiB;
constexpr size_t WS_WA = 17 * MiB, WS_WC = 19 * MiB, WS_WO = 21 * MiB;
constexpr size_t WS_WP = 23 * MiB;
constexpr size_t WS_UT = 27 * MiB, WS_VT = 59 * MiB;
constexpr size_t WS_KB = 91 * MiB, WS_VB = 108 * MiB;
constexpr size_t WS_HX = 125 * MiB;
constexpr size_t WS_Q = 189 * MiB;
constexpr size_t WS_G = 253 * MiB;
constexpr size_t WS_RT = 317 * MiB;
constexpr size_t WS_SGC = 381 * MiB;
constexpr size_t WS_SC = 189 * MiB;
constexpr size_t WS_END = 445 * MiB;

constexpr int NWAVES = 8;
constexpr int LDS_BYTES = 147456;

struct Args {
    const float *x, *c, *ctx, *c_ctx, *w_mod, *b_mod, *n1g, *n2g, *w_in, *qng, *kng, *w_ao, *cdw, *cb, *clg, *clb, *w_co, *w_o, *wq, *keys, *ut, *vt, *fg;
    float* out; unsigned char* ws; int ph_lo, ph_hi;
};

__host__ __device__ __forceinline__ int win_row(int n) {
    if (n < 1536) return n;
    const int base = n < 3584 ? 1536 : 3584, m = n - base, half = m >> 10, idx = m & 1023;
    return base + (idx >> 7) * 256 + half * 128 + (idx & 127);
}

__device__ __forceinline__ void task_mod(const Args& A, int task, int lane, const LAS float* sc) {
    const int n0 = task * 8, col = lane & 7, kg = lane >> 3;
    float acc[9];
#pragma unroll
    for (int b = 0; b < 9; ++b) acc[b] = 0.f;
    const float* wp = A.w_mod + (size_t)kg * NMOD + n0 + col;
    for (int i0 = 0; i0 < 128; i0 += 8) {
        float w[8];
#pragma unroll
        for (int u = 0; u < 8; ++u) w[u] = wp[(size_t)(i0 + u) * 8 * NMOD];
#pragma unroll
        for (int u = 0; u < 8; ++u) { const int k = kg + 8 * (i0 + u);
#pragma unroll
            for (int b = 0; b < 9; ++b) acc[b] += sc[b * D + k] * w[u]; }
    }
#pragma unroll
    for (int b = 0; b < 9; ++b) { float v = acc[b]; v += __shfl_xor(v, 8); v += __shfl_xor(v, 16); v += __shfl_xor(v, 32); acc[b] = v; }
    if (lane < 8) { float* mod = (float*)(A.ws + WS_MOD); const float bm = A.b_mod[n0 + col];
#pragma unroll
        for (int b = 0; b < 9; ++b) mod[b * NMOD + n0 + col] = acc[b] + bm; }
}
__device__ __forceinline__ void task_transpose(const float* W, int K, int N, bf16_t* WT, int k0, int n0, int row0, LAS float* scr, int lane) {
#pragma unroll 8
    for (int i = 0; i < 32; ++i) { const int kk = 2 * i + (lane >> 5); scr[kk * 33 + (lane & 31)] = W[(size_t)(k0 + kk) * N + n0 + (lane & 31)]; }
    asm volatile("s_waitcnt lgkmcnt(0)" ::: "memory");
    const int c = lane & 7;
#pragma unroll
    for (int j = 0; j < 4; ++j) { const int n = (lane >> 3) + 8 * j; const LAS float* s = scr + (8 * c) * 33 + n;
        u32x4 o; o.x = cvt_pk_bf16(s[0 * 33], s[1 * 33]); o.y = cvt_pk_bf16(s[2 * 33], s[3 * 33]); o.z = cvt_pk_bf16(s[4 * 33], s[5 * 33]); o.w = cvt_pk_bf16(s[6 * 33], s[7 * 33]);
        *(u32x4*)(WT + (size_t)(row0 + n) * K + k0 + 8 * c) = o; }
    asm volatile("s_waitcnt lgkmcnt(0)" ::: "memory");
}
__device__ __forceinline__ void task_cvt_row(const float* src, bf16_t* dst, int lane) {
#pragma unroll
    for (int i = 0; i < 4; ++i) { const f32x4 v = *(const f32x4*)(src + (i * 64 + lane) * 4); u32x2 o = {cvt_pk_bf16(v[0], v[1]), cvt_pk_bf16(v[2], v[3])}; *(u32x2*)(dst + (i * 64 + lane) * 4) = o; }
}
__device__ __forceinline__ bf16x8 ld8_f32_bf16(const float* p) { const f32x4 a = *(const f32x4*)p, b = *(const f32x4*)(p + 4); u32x4 w = {cvt_pk_bf16(a[0], a[1]), cvt_pk_bf16(a[2], a[3]), cvt_pk_bf16(b[0], b[1]), cvt_pk_bf16(b[2], b[3])}; return *reinterpret_cast<bf16x8*>(&w); }
__device__ __forceinline__ void task_wprime(const Args& A, int id, int lane) {
    const int hp = id >> 7, rem = id & 127, n0 = (rem >> 5) * 32, k0 = (rem & 31) * 32, r32 = lane & 31, hi = lane >> 5;
    f32x16 acc = {};
    const float* ka = A.keys + ((size_t)(hp * 128 + n0 + r32)) * 128 + hi * 8;
    const float* wb = A.wq + (size_t)(k0 + r32) * PW + hp * 128 + hi * 8;
#pragma unroll
    for (int s = 0; s < 8; ++s) acc = __builtin_amdgcn_mfma_f32_32x32x16_bf16(ld8_f32_bf16(ka + s * 16), ld8_f32_bf16(wb + s * 16), acc, 0, 0, 0);
    bf16_t* o = (bf16_t*)(A.ws + WS_WP);
#pragma unroll
    for (int r = 0; r < 16; ++r) { const int n = (r & 3) + 8 * (r >> 2) + 4 * hi; o[(size_t)(hp * 128 + n0 + n) * D + k0 + r32] = (bf16_t)(cvt_pk_bf16(acc[r], 0.f) & 0xffffu); }
}
__device__ __forceinline__ void phase_prologue(const Args& A, LAS unsigned char* lds) {
    const int tid = threadIdx.x, lane = tid & 63, wave = __builtin_amdgcn_readfirstlane(tid >> 6);
    LAS float* sc = (LAS float*)lds;
    for (int i = tid; i < 9 * D; i += 512) { const float v = i < 8 * D ? A.c[i] : A.c_ctx[i - 8 * D]; sc[i] = v / (1.f + __expf(-v)); }
    __syncthreads();
    LAS float* scr = (LAS float*)(lds + 36864 + wave * 8448);
    constexpr int T_MOD = NMOD / 8, T_WIN = (D / 64) * (INW / 32), T_SQ = (D / 64) * (D / 32), T_UV = 2 * NEXP, T_WP = 2048, T_ROPE = 1;
    constexpr int NT = T_MOD + T_WIN + 3 * T_SQ + T_UV + T_WP + T_ROPE;
    const int G = gridDim.x;
    for (int task = wave * G + blockIdx.x; task < NT; task += NWAVES * G) {
        int r = task;
        if (r < T_MOD) { task_mod(A, r, lane, sc); continue; } r -= T_MOD;
        if (r < T_WIN) { const int nblk = INW / 32, kb = r / nblk, nb = r % nblk; task_transpose(A.w_in, D, INW, (bf16_t*)(A.ws + WS_WIN), 64 * kb, 32 * nb, win_row(32 * nb), scr, lane); continue; } r -= T_WIN;
        if (r < 3 * T_SQ) { const int wsel = r / T_SQ, q = r % T_SQ, kb = q / 32, nb = q % 32;
            const float* W = wsel == 0 ? A.w_ao : (wsel == 1 ? A.w_co : A.w_o); bf16_t* WT = (bf16_t*)(A.ws + (wsel == 0 ? WS_WA : (wsel == 1 ? WS_WC : WS_WO)));
            task_transpose(W, D, D, WT, 64 * kb, 32 * nb, 32 * nb, scr, lane); continue; } r -= 3 * T_SQ;
        if (r < T_UV) { const int tb = r / NEXP, row = r % NEXP; task_cvt_row((tb ? A.vt : A.ut) + (size_t)row * D, (bf16_t*)(A.ws + (tb ? WS_VT : WS_UT)) + (size_t)row * D, lane); continue; } r -= T_UV;
        if (r < T_WP) { task_wprime(A, r, lane); continue; } r -= T_WP;
        { float* cs = (float*)(A.ws + WS_ROPE); float* sn = cs + 2048;
          for (int e = lane; e < 2048; e += 64) { const int p = e >> 5, i = e & 31; const float inv = powf(10000.f, -(float)(2 * i) / 64.f); const float a = (float)p * inv; cs[e] = cosf(a); sn[e] = sinf(a); } }
    }
}
__device__ __forceinline__ void normmod_row(const float* xr, const float* g, const float* modr, int sh_off, int sc_off, bf16_t* orow, int lane) {
    f32x4 v[4]; float ss = 0.f;
#pragma unroll
    for (int i = 0; i < 4; ++i) { v[i] = *(const f32x4*)(xr + (i * 64 + lane) * 4); ss += (v[i][0] * v[i][0] + v[i][1] * v[i][1]) + (v[i][2] * v[i][2] + v[i][3] * v[i][3]); }
    const float r = rsqrtf(wave_sum(ss) * (1.f / D) + EPS);
#pragma unroll
    for (int i = 0; i < 4; ++i) { const int k = (i * 64 + lane) * 4; const f32x4 gg = *(const f32x4*)(g + k), s1 = *(const f32x4*)(modr + sc_off + k), h1 = *(const f32x4*)(modr + sh_off + k);
        float y[4];
#pragma unroll
        for (int j = 0; j < 4; ++j) y[j] = v[i][j] * r * gg[j] * (1.f + s1[j]) + h1[j];
        u32x2 o = {cvt_pk_bf16(y[0], y[1]), cvt_pk_bf16(y[2], y[3])}; *(u32x2*)(orow + k) = o; }
}
__device__ __forceinline__ void phase_hx(const Args& A) {
    const int lane = threadIdx.x & 63, gw = blockIdx.x * NWAVES + (threadIdx.x >> 6), NGW = gridDim.x * NWAVES;
    const float* mod = (const float*)(A.ws + WS_MOD);
    for (int m = gw; m < M + MC; m += NGW) {
        if (m < M) normmod_row(A.x + (size_t)m * D, A.n1g, mod + (m >> 12) * NMOD, 0, D, (bf16_t*)(A.ws + WS_HX) + (size_t)m * D, lane);
        else { const int r = m - M; normmod_row(A.ctx + (size_t)r * D, A.n1g, mod + 8 * NMOD, 0, D, (bf16_t*)(A.ws + WS_HC) + (size_t)r * D, lane); }
    }
}
__device__ __forceinline__ void phase_hx2(const Args& A) {
    const int lane = threadIdx.x & 63, gw = blockIdx.x * NWAVES + (threadIdx.x >> 6), NGW = gridDim.x * NWAVES;
    const float* mod = (const float*)(A.ws + WS_MOD);
    for (int m = gw; m < M; m += NGW) normmod_row(A.out + (size_t)m * D, A.n2g, mod + (m >> 12) * NMOD, 3 * D, 4 * D, (bf16_t*)(A.ws + WS_HX) + (size_t)m * D, lane);
}
__device__ __forceinline__ void phase_kfix(const Args& A) {
    const int lane = threadIdx.x & 63, gw = blockIdx.x * NWAVES + (threadIdx.x >> 6), NGW = gridDim.x * NWAVES, li = lane & 15, sub = lane >> 4;
    bf16_t* KB = (bf16_t*)(A.ws + WS_KB); const float* cs = (const float*)(A.ws + WS_ROPE); const float* sn = cs + 2048;
    constexpr int NITEM = NB * SKV * HKV;
    const f32x4 g0 = *(const f32x4*)(A.kng + li * 8), g1 = *(const f32x4*)(A.kng + li * 8 + 4);
    const f32x4 p0 = *(const f32x4*)(A.kng + (li ^ 4) * 8), p1 = *(const f32x4*)(A.kng + (li ^ 4) * 8 + 4);
    for (int it = gw * 4 + sub; it < NITEM; it += NGW * 4) {
        const int row = it >> 1, h = it & 1, t = row % SKV;
        bf16_t* p = KB + (size_t)row * 256 + h * HD + li * 8;
        const u32x4 w = *(const u32x4*)p;
        float x[8], xp[8]; float ss = 0.f;
#pragma unroll
        for (int j = 0; j < 4; ++j) { x[2 * j] = bf_lo(w[j]); x[2 * j + 1] = bf_hi(w[j]); ss += x[2 * j] * x[2 * j] + x[2 * j + 1] * x[2 * j + 1];
            const unsigned pw = (unsigned)__shfl_xor((int)w[j], 4); xp[2 * j] = bf_lo(pw); xp[2 * j + 1] = bf_hi(pw); }
        ss += __shfl_xor(ss, 1); ss += __shfl_xor(ss, 2); ss += __shfl_xor(ss, 4); ss += __shfl_xor(ss, 8);
        const float r = rsqrtf(ss * (1.f / HD) + EPS);
        float y[8];
#pragma unroll
        for (int j = 0; j < 8; ++j) { x[j] *= r * (j < 4 ? g0[j] : g1[j - 4]); xp[j] *= r * (j < 4 ? p0[j] : p1[j - 4]); y[j] = x[j]; }
        if (t < S) {
            const int blk = li >> 3, pos = blk == 0 ? (t >> 6) : (t & 63), second = (li >> 2) & 1, i0 = (li & 3) * 8;
            const f32x4 c0 = *(const f32x4*)(cs + pos * 32 + i0), c1 = *(const f32x4*)(cs + pos * 32 + i0 + 4), s0 = *(const f32x4*)(sn + pos * 32 + i0), s1 = *(const f32x4*)(sn + pos * 32 + i0 + 4);
#pragma unroll
            for (int j = 0; j < 8; ++j) { const float c = j < 4 ? c0[j] : c1[j - 4], s = j < 4 ? s0[j] : s1[j - 4];
                y[j] = second ? (xp[j] * s + x[j] * c) : (x[j] * c - xp[j] * s); }
        }
        u32x4 o = {cvt_pk_bf16(y[0], y[1]), cvt_pk_bf16(y[2], y[3]), cvt_pk_bf16(y[4], y[5]), cvt_pk_bf16(y[6], y[7])};
        *(u32x4*)p = o;
    }
}
template <int R> struct ConvRow {
    static __device__ __forceinline__ void run(const unsigned* gp, int tl0, float (&acc)[32][2], const float (&w)[31][2]) {
        const int tl = tl0 + R - 15;
        unsigned v = 0u; if (tl >= 0 && tl < S) v = gp[(long)(R - 15) * (D / 2)];
        const float a = bf_lo(v), b = bf_hi(v);
#pragma unroll
        for (int t = (R - 30 > 0 ? R - 30 : 0); t <= (R < 31 ? R : 31); ++t) { acc[t][0] += w[R - t][0] * a; acc[t][1] += w[R - t][1] * b; }
        if constexpr (R + 1 < 62) ConvRow<R + 1>::run(gp, tl0, acc, w);
    }
};
__device__ __forceinline__ void phase_conv(const Args& A, LAS unsigned char* lds) {
    const int tid = threadIdx.x, lane = tid & 63, wave = tid >> 6;
    LAS float* tile = (LAS float*)lds;
    const bf16_t* G = (const bf16_t*)(A.ws + WS_G); bf16_t* CV = (bf16_t*)(A.ws + WS_HX);
    float w[31][2];
#pragma unroll
    for (int j = 0; j < 31; ++j) { const f32x2 t = *(const f32x2*)(A.cdw + j * D + 2 * tid); w[j][0] = t[0]; w[j][1] = t[1]; }
    const f32x2 bias = *(const f32x2*)(A.cb + 2 * tid);
    for (int tileid = blockIdx.x; tileid < M / 32; tileid += gridDim.x) {
        const int row0 = tileid * 32, tl0 = row0 & (S - 1);
        float acc[32][2];
#pragma unroll
        for (int t = 0; t < 32; ++t) { acc[t][0] = bias[0]; acc[t][1] = bias[1]; }
        ConvRow<0>::run((const unsigned*)(G + (size_t)row0 * D) + tid, tl0, acc, w);
        __syncthreads();
#pragma unroll
        for (int t = 0; t < 32; ++t) *(LAS f32x2*)(tile + t * D + 2 * tid) = (f32x2){acc[t][0], acc[t][1]};
        __syncthreads();
#pragma unroll
        for (int q = 0; q < 4; ++q) { const int t = wave * 4 + q; const LAS float* tr = tile + t * D;
            f32x4 v[4]; float s = 0.f;
#pragma unroll
            for (int i = 0; i < 4; ++i) { v[i] = *(const LAS f32x4*)(tr + (i * 64 + lane) * 4); s += (v[i][0] + v[i][1]) + (v[i][2] + v[i][3]); }
            const float mu = wave_sum(s) * (1.f / D); float qq = 0.f;
#pragma unroll
            for (int i = 0; i < 4; ++i) { v[i] = v[i] - mu; qq += (v[i][0] * v[i][0] + v[i][1] * v[i][1]) + (v[i][2] * v[i][2] + v[i][3] * v[i][3]); }
            const float rs = rsqrtf(wave_sum(qq) * (1.f / D) + EPS);
#pragma unroll
            for (int i = 0; i < 4; ++i) { const int k = (i * 64 + lane) * 4; const f32x4 gg = *(const f32x4*)(A.clg + k), bb = *(const f32x4*)(A.clb + k); float y[4];
#pragma unroll
                for (int j = 0; j < 4; ++j) { const float z = v[i][j] * rs * gg[j] + bb[j]; y[j] = z * fast_sigmoid(z); }
                u32x2 o = {cvt_pk_bf16(y[0], y[1]), cvt_pk_bf16(y[2], y[3])}; *(u32x2*)(CV + (size_t)(row0 + t) * D + k) = o; }
        }
    }
}
struct EpiInProj {
    static constexpr bool PERM = true;
    unsigned char* ws;
    __device__ __forceinline__ void operator()(f32x4 (&acc)[2][2][4][2], const pg8::Unit& u, int wr, int wc, int fr, int fq) const {
        const int c8 = wc * 32 + 8 * fq;
#pragma unroll
        for (int ai = 0; ai < 2; ++ai)
#pragma unroll
            for (int m = 0; m < 4; ++m) {
                const int row = u.pm * 256 + ai * 128 + wr * 64 + m * 16 + fr;
                if (u.kind == 0) {
                    bf16_t* p = (bf16_t*)(ws + WS_Q) + (size_t)row * D + u.pn * 256 + c8;
#pragma unroll
                    for (int bj = 0; bj < 2; ++bj) { const f32x4 v0 = acc[ai][bj][m][0], v1 = acc[ai][bj][m][1];
                        u32x4 w = {cvt_pk_bf16(v0[0], v0[1]), cvt_pk_bf16(v0[2], v0[3]), cvt_pk_bf16(v1[0], v1[1]), cvt_pk_bf16(v1[2], v1[3])}; *(u32x4*)(p + bj * 128) = w; }
                } else if (u.kind == 1 || u.kind == 2 || u.kind == 5 || u.kind == 6) {
                    const bool ctxu = u.kind >= 5;
                    const int kvrow = ctxu ? (row >> 8) * SKV + S + (row & 255) : (row >> 12) * SKV + (row & (S - 1));
                    bf16_t* p = (bf16_t*)(ws + ((u.kind == 1 || u.kind == 5) ? WS_KB : WS_VB)) + (size_t)kvrow * 256 + c8;
#pragma unroll
                    for (int bj = 0; bj < 2; ++bj) { const f32x4 v0 = acc[ai][bj][m][0], v1 = acc[ai][bj][m][1];
                        u32x4 w = {cvt_pk_bf16(v0[0], v0[1]), cvt_pk_bf16(v0[2], v0[3]), cvt_pk_bf16(v1[0], v1[1]), cvt_pk_bf16(v1[2], v1[3])}; *(u32x4*)(p + bj * 128) = w; }
                } else if (u.kind == 3) {
                    float g[8];
#pragma unroll
                    for (int n = 0; n < 2; ++n)
#pragma unroll
                        for (int j = 0; j < 4; ++j) g[4 * n + j] = acc[ai][0][m][n][j] * fast_sigmoid(acc[ai][1][m][n][j]);
                    u32x4 w = {cvt_pk_bf16(g[0], g[1]), cvt_pk_bf16(g[2], g[3]), cvt_pk_bf16(g[4], g[5]), cvt_pk_bf16(g[6], g[7])};
                    *(u32x4*)((bf16_t*)(ws + WS_G) + (size_t)row * D + (u.pn - 6) * 128 + c8) = w;
                } else {
                    float rt[8], sg[8];
#pragma unroll
                    for (int n = 0; n < 2; ++n)
#pragma unroll
                        for (int j = 0; j < 4; ++j) { const float ea = __builtin_amdgcn_exp2f(-1.4426950408889634f * acc[ai][0][m][n][j]), ec = __builtin_amdgcn_exp2f(-1.4426950408889634f * acc[ai][1][m][n][j]);
                            sg[4 * n + j] = __builtin_amdgcn_rcpf(1.f + ec); rt[4 * n + j] = (1.f + ec) * __builtin_amdgcn_rcpf(1.f + ea); }
                    const size_t off = (size_t)row * D + (u.pn - 14) * 128 + c8;
                    u32x4 w = {cvt_pk_bf16(rt[0], rt[1]), cvt_pk_bf16(rt[2], rt[3]), cvt_pk_bf16(rt[4], rt[5]), cvt_pk_bf16(rt[6], rt[7])}; *(u32x4*)((bf16_t*)(ws + WS_RT) + off) = w;
                    u32x4 w2 = {cvt_pk_bf16(sg[0], sg[1]), cvt_pk_bf16(sg[2], sg[3]), cvt_pk_bf16(sg[4], sg[5]), cvt_pk_bf16(sg[6], sg[7])}; *(u32x4*)((bf16_t*)(ws + WS_SGC) + off) = w2;
                }
            }
    }
};
struct SchedInProj {
    const char* hx; const char* hc; const char* w; int G, c;
    __device__ __forceinline__ bool next(int i, pg8::Unit& u) const {
        constexpr int nM = M / 256, nN = INW / 256, NMAIN = nM * nN, NCTX = (MC / 256) * 2;
        const int L = i * G + c; if (L >= NMAIN + NCTX) return false;
        if (L < NMAIN) { pg8::tile_of(L, nM, nN, u.pm, u.pn); u.a = hx + (size_t)u.pm * 256 * D * 2; u.kind = u.pn < 4 ? 0 : (u.pn == 4 ? 1 : (u.pn == 5 ? 2 : (u.pn < 14 ? 3 : 4))); }
        else { const int j = L - NMAIN; u.pm = j >> 1; u.pn = 4 + (j & 1); u.a = hc + (size_t)u.pm * 256 * D * 2; u.kind = 5 + (j & 1); }
        u.b = w + (size_t)u.pn * 256 * D * 2; u.keep = 0; return true;
    }
};
struct EpiMerge {
    static constexpr bool PERM = true;
    unsigned char* ws;
    __device__ __forceinline__ void operator()(f32x4 (&acc)[2][2][4][2], const pg8::Unit& u, int wr, int wc, int fr, int fq) const {
        const int c8 = u.pn * 256 + wc * 32 + 8 * fq;
        const bf16_t* F = (const bf16_t*)(ws + (u.kind == 0 ? WS_RT : WS_SGC));
#pragma unroll
        for (int ai = 0; ai < 2; ++ai)
#pragma unroll
            for (int m = 0; m < 4; ++m) { const size_t off = (size_t)(u.pm * 256 + ai * 128 + wr * 64 + m * 16 + fr) * D + c8;
#pragma unroll
                for (int bj = 0; bj < 2; ++bj) { const u32x4 f = *(const u32x4*)(F + off + bj * 128);
                    f32x4 v0 = acc[ai][bj][m][0], v1 = acc[ai][bj][m][1];
                    v0[0] *= bf_lo(f[0]); v0[1] *= bf_hi(f[0]); v0[2] *= bf_lo(f[1]); v0[3] *= bf_hi(f[1]); v1[0] *= bf_lo(f[2]); v1[1] *= bf_hi(f[2]); v1[2] *= bf_lo(f[3]); v1[3] *= bf_hi(f[3]);
                    if (u.kind == 0) { acc[ai][bj][m][0] = v0; acc[ai][bj][m][1] = v1; }
                    else { u32x4 w = {cvt_pk_bf16(v0[0], v0[1]), cvt_pk_bf16(v0[2], v0[3]), cvt_pk_bf16(v1[0], v1[1]), cvt_pk_bf16(v1[2], v1[3])}; *(u32x4*)((bf16_t*)(ws + WS_G) + off + bj * 128) = w; } } }
    }
};
struct SchedMerge {
    const char* att; const char* cv; const char* wa; const char* wc; int G, c;
    __device__ __forceinline__ bool next(int i, pg8::Unit& u) const {
        constexpr int nM = M / 256, nN = D / 256;
        const int L = (i >> 1) * G + c, sub = i & 1; if (L >= nM * nN) return false;
        pg8::tile_of(L, nM, nN, u.pm, u.pn);
        u.a = (sub ? cv : att) + (size_t)u.pm * 256 * D * 2; u.b = (sub ? wc : wa) + (size_t)u.pn * 256 * D * 2; u.kind = sub; u.keep = sub ^ 1; return true;
    }
};
struct SchedPlain {
    const char* a; const char* b; int nM, nN, G, c;
    __device__ __forceinline__ bool next(int i, pg8::Unit& u) const {
        const int L = i * G + c; if (L >= nM * nN) return false;
        pg8::tile_of(L, nM, nN, u.pm, u.pn); u.a = a + (size_t)u.pm * 256 * D * 2; u.b = b + (size_t)u.pn * 256 * D * 2; u.kind = 0; u.keep = 0; return true;
    }
};
struct EpiOut {
    static constexpr bool PERM = false;
    const float* x; const float* mod; float* xs;
    __device__ __forceinline__ void operator()(f32x4 (&acc)[2][2][4][2], const pg8::Unit& u, int wr, int wc, int fr, int fq) const {
        const int col0 = u.pn * 256 + wc * 32 + 4 * fq; const float* g1 = mod + ((u.pm * 256) >> 12) * NMOD + 2 * D;
        f32x4 gv[2][2];
#pragma unroll
        for (int bj = 0; bj < 2; ++bj)
#pragma unroll
            for (int n = 0; n < 2; ++n) gv[bj][n] = *(const f32x4*)(g1 + col0 + bj * 128 + n * 16);
#pragma unroll
        for (int ai = 0; ai < 2; ++ai)
#pragma unroll
            for (int m = 0; m < 4; ++m) { const size_t off = (size_t)(u.pm * 256 + ai * 128 + wr * 64 + m * 16 + fr) * D + col0;
#pragma unroll
                for (int bj = 0; bj < 2; ++bj)
#pragma unroll
                    for (int n = 0; n < 2; ++n) { const f32x4 xv = *(const f32x4*)(x + off + bj * 128 + n * 16); *(f32x4*)(xs + off + bj * 128 + n * 16) = xv + gv[bj][n] * acc[ai][bj][m][n]; } }
    }
};
struct EpiScores {
    static constexpr bool PERM = false;
    float* sc;
    __device__ __forceinline__ void operator()(f32x4 (&acc)[2][2][4][2], const pg8::Unit& u, int wr, int wc, int fr, int fq) const {
        const int col0 = u.pn * 256 + wc * 32 + 4 * fq;
#pragma unroll
        for (int ai = 0; ai < 2; ++ai)
#pragma unroll
            for (int m = 0; m < 4; ++m) { float* p = sc + (size_t)(u.pm * 256 + ai * 128 + wr * 64 + m * 16 + fr) * PW + col0;
#pragma unroll
                for (int bj = 0; bj < 2; ++bj)
#pragma unroll
                    for (int n = 0; n < 2; ++n) *(f32x4*)(p + bj * 128 + n * 16) = acc[ai][bj][m][n]; }
    }
};

__device__ __forceinline__ void phase_attn(const Args& A, unsigned char* lds) {
    const int G = gridDim.x, X = blockIdx.x & 7, j = blockIdx.x >> 3, perx = G >> 3;
    bf16_t* Q = (bf16_t*)(A.ws + WS_Q); const bf16_t* KB = (const bf16_t*)(A.ws + WS_KB); const bf16_t* VB = (const bf16_t*)(A.ws + WS_VB);
    const float* cs = (const float*)(A.ws + WS_ROPE); const float* sn = cs + 2048;
    for (int idx = j; idx < 128; idx += perx) {
        const int grp = 2 * X + (idx >> 6), uu = idx & 63, b = grp >> 1, kv = grp & 1, h = kv * 4 + (uu >> 4), qb = uu & 15;
        bf16_t* qp = Q + ((size_t)b * S + qb * 256) * D + h * HD;
        att::attn_unit(qp, KB + (size_t)b * SKV * 256 + kv * HD, VB + (size_t)b * SKV * 256 + kv * HD, qp, qb * 256, SKV, A.qng, cs, sn, (char*)lds);
    }
}

__device__ __forceinline__ float max4(float a, float b, float c, float d) { return fmaxf(fmaxf(a, b), fmaxf(c, d)); }
__device__ __forceinline__ float gelu_exact(float v) { return 0.5f * v * (1.f + erff(v * 0.70710678118654752f)); }
__device__ __forceinline__ void phase_peer(const Args& A, LAS unsigned char* lds) {
    const int lane = threadIdx.x & 63, wave = threadIdx.x >> 6, gw = blockIdx.x * NWAVES + wave, NGW = gridDim.x * NWAVES;
    LAS unsigned* wl = (LAS unsigned*)(lds + wave * 2048);
    LAS float* abL = (LAS float*)wl; LAS int* eidL = (LAS int*)(wl + 32); LAS float* wgtL = (LAS float*)(wl + 160); LAS float* coefL = (LAS float*)(wl + 288);
    const float* SC = (const float*)(A.ws + WS_SC); const bf16_t* HX = (const bf16_t*)(A.ws + WS_HX);
    const bf16_t* UT = (const bf16_t*)(A.ws + WS_UT); const bf16_t* VT = (const bf16_t*)(A.ws + WS_VT); const float* mod = (const float*)(A.ws + WS_MOD);
    const float NEG = -3.0e38f;
    for (int t = gw; t < M; t += NGW) {
#ifdef PEER_EXT_TOPK
        { const int* ge = (const int*)(A.ws + ((size_t)448 << 20)) + (size_t)t * 128; const float* gwt = (const float*)(A.ws + ((size_t)464 << 20)) + (size_t)t * 128;
          eidL[lane] = ge[lane]; eidL[64 + lane] = ge[64 + lane]; wgtL[lane] = gwt[lane]; wgtL[64 + lane] = gwt[64 + lane]; asm volatile("s_waitcnt vmcnt(0) lgkmcnt(0)" ::: "memory"); }
#else
        f32x4 sv[8];
#pragma unroll
        for (int h = 0; h < 8; ++h) sv[h] = *(const f32x4*)(SC + (size_t)t * PW + h * 256 + lane * 4);
#pragma unroll
        for (int h = 0; h < 8; ++h) {
            float k0, k1, k2, k3;
            { const unsigned nb = 127u - (unsigned)((lane & 31) * 4);
              k0 = __uint_as_float((__float_as_uint(sv[h][0]) & ~127u) | nb); k1 = __uint_as_float((__float_as_uint(sv[h][1]) & ~127u) | (nb - 1u));
              k2 = __uint_as_float((__float_as_uint(sv[h][2]) & ~127u) | (nb - 2u)); k3 = __uint_as_float((__float_as_uint(sv[h][3]) & ~127u) | (nb - 3u)); }
            float mytop = 0.f;
#pragma unroll
            for (int it = 0; it < 16; ++it) {
                float mx = max4(k0, k1, k2, k3);
                mx = fmaxf(mx, __shfl_xor(mx, 1)); mx = fmaxf(mx, __shfl_xor(mx, 2)); mx = fmaxf(mx, __shfl_xor(mx, 4)); mx = fmaxf(mx, __shfl_xor(mx, 8)); mx = fmaxf(mx, __shfl_xor(mx, 16));
                k0 = k0 == mx ? NEG : k0; k1 = k1 == mx ? NEG : k1; k2 = k2 == mx ? NEG : k2; k3 = k3 == mx ? NEG : k3;
                if ((lane & 31) == it) mytop = mx;
            }
            if ((lane & 31) < 16) abL[(lane >> 5) * 16 + (lane & 31)] = mytop;
            asm volatile("s_waitcnt lgkmcnt(0)" ::: "memory");
            const float ai = abL[lane >> 2]; const f32x4 bj = *(const LAS f32x4*)(abL + 16 + (lane & 3) * 4);
            { const unsigned cb = 255u - (unsigned)(lane * 4);
              k0 = __uint_as_float((__float_as_uint(ai + bj[0]) & ~255u) | cb); k1 = __uint_as_float((__float_as_uint(ai + bj[1]) & ~255u) | (cb - 1u));
              k2 = __uint_as_float((__float_as_uint(ai + bj[2]) & ~255u) | (cb - 2u)); k3 = __uint_as_float((__float_as_uint(ai + bj[3]) & ~255u) | (cb - 3u)); }
            mytop = NEG;
#pragma unroll
            for (int it = 0; it < 16; ++it) {
                float mx = max4(k0, k1, k2, k3);
                mx = fmaxf(mx, __shfl_xor(mx, 1)); mx = fmaxf(mx, __shfl_xor(mx, 2)); mx = fmaxf(mx, __shfl_xor(mx, 4)); mx = fmaxf(mx, __shfl_xor(mx, 8)); mx = fmaxf(mx, __shfl_xor(mx, 16)); mx = fmaxf(mx, __shfl_xor(mx, 32));
                k0 = k0 == mx ? NEG : k0; k1 = k1 == mx ? NEG : k1; k2 = k2 == mx ? NEG : k2; k3 = k3 == mx ? NEG : k3;
                if (lane == it) mytop = mx;
            }
            const float smax = __shfl(mytop, 0);
            float e = lane < 16 ? __expf(mytop - smax) : 0.f;
            float es = e; es += __shfl_xor(es, 1); es += __shfl_xor(es, 2); es += __shfl_xor(es, 4); es += __shfl_xor(es, 8);
            if (lane < 16) { const unsigned c = 255u - (__float_as_uint(mytop) & 255u);
                const unsigned ia = 127u - (__float_as_uint(abL[c >> 4]) & 127u), ib = 127u - (__float_as_uint(abL[16 + (c & 15)]) & 127u);
                eidL[h * 16 + lane] = (int)(ia * 128u + ib); wgtL[h * 16 + lane] = e / es; }
            asm volatile("s_waitcnt lgkmcnt(0)" ::: "memory");
        }
#endif
        const u32x4 xlo = *(const u32x4*)(HX + (size_t)t * D + lane * 8), xhi = *(const u32x4*)(HX + (size_t)t * D + 512 + lane * 8);
#pragma unroll 1
        for (int kb = 0; kb < 8; ++kb) {
            float p[16];
#pragma unroll
            for (int e = 0; e < 16; ++e) { const int id = eidL[kb * 16 + e]; const bf16_t* ur = UT + (size_t)id * D + lane * 8;
                const u32x4 a = *(const u32x4*)ur, b = *(const u32x4*)(ur + 512);
                float s = 0.f;
#pragma unroll
                for (int j = 0; j < 4; ++j) { const unsigned aj = a[j], bj = b[j], xl = xlo[j], xh = xhi[j];
                    s = __builtin_amdgcn_fdot2_f32_bf16(__builtin_bit_cast(bf16x2_t, aj), __builtin_bit_cast(bf16x2_t, xl), s, false);
                    s = __builtin_amdgcn_fdot2_f32_bf16(__builtin_bit_cast(bf16x2_t, bj), __builtin_bit_cast(bf16x2_t, xh), s, false); }
                p[e] = s; }
#pragma unroll
            for (int e = 0; e < 8; ++e) { const bool up = lane & 32; const float keep = up ? p[e + 8] : p[e], send = up ? p[e] : p[e + 8]; p[e] = keep + __shfl_xor(send, 32); }
#pragma unroll
            for (int e = 0; e < 4; ++e) { const bool up = lane & 16; const float keep = up ? p[e + 4] : p[e], send = up ? p[e] : p[e + 4]; p[e] = keep + __shfl_xor(send, 16); }
#pragma unroll
            for (int e = 0; e < 2; ++e) { const bool up = lane & 8; const float keep = up ? p[e + 2] : p[e], send = up ? p[e] : p[e + 2]; p[e] = keep + __shfl_xor(send, 8); }
            { const bool up = lane & 4; const float keep = up ? p[1] : p[0], send = up ? p[0] : p[1]; p[0] = keep + __shfl_xor(send, 4); }
            float hsum = p[0]; hsum += __shfl_xor(hsum, 2); hsum += __shfl_xor(hsum, 1);
            const int ke = kb * 16 + ((lane >> 2) & 15);
            const float cf = wgtL[ke] * gelu_exact(hsum);
            if ((lane & 3) == 0) coefL[ke] = cf;
        }
        asm volatile("s_waitcnt lgkmcnt(0)" ::: "memory");
        float y[16];
#pragma unroll
        for (int j = 0; j < 16; ++j) y[j] = 0.f;
#pragma unroll 1
        for (int kb = 0; kb < 8; ++kb) {
#pragma unroll
            for (int e = 0; e < 16; ++e) { const int id = eidL[kb * 16 + e]; const float cf = coefL[kb * 16 + e]; const bf16_t* vr = VT + (size_t)id * D + lane * 8;
                const u32x4 a = *(const u32x4*)vr, b = *(const u32x4*)(vr + 512);
#pragma unroll
                for (int j = 0; j < 4; ++j) { y[2 * j] += cf * bf_lo(a[j]); y[2 * j + 1] += cf * bf_hi(a[j]); y[8 + 2 * j] += cf * bf_lo(b[j]); y[8 + 2 * j + 1] += cf * bf_hi(b[j]); } }
        }
        const float* g2 = mod + (t >> 12) * NMOD + 5 * D; float* orow = A.out + (size_t)t * D;
        float z[16]; float ss = 0.f;
#pragma unroll
        for (int q = 0; q < 4; ++q) { const int k = (q >> 1) * 512 + lane * 8 + (q & 1) * 4; const f32x4 xv = *(const f32x4*)(orow + k), gv = *(const f32x4*)(g2 + k);
#pragma unroll
            for (int j = 0; j < 4; ++j) { const float zz = xv[j] + gv[j] * y[q * 4 + j]; z[q * 4 + j] = zz; ss += zz * zz; } }
        const float r = rsqrtf(wave_sum(ss) * (1.f / D) + EPS);
#pragma unroll
        for (int q = 0; q < 4; ++q) { const int k = (q >> 1) * 512 + lane * 8 + (q & 1) * 4; const f32x4 fv = *(const f32x4*)(A.fg + k);
            f32x4 o;
#pragma unroll
            for (int j = 0; j < 4; ++j) o[j] = z[q * 4 + j] * r * fv[j];
            *(f32x4*)(orow + k) = o; }
    }
}
constexpr int N_PHASES = 10;
__global__ void __launch_bounds__(NWAVES * 64, 2) mega_fwd(Args A) {
    extern __shared__ __attribute__((aligned(16))) unsigned char lds[];
    LAS unsigned char* L = (LAS unsigned char*)lds;
    cg::grid_group grid = cg::this_grid();
    const int lo = A.ph_lo, hi = A.ph_hi, G = gridDim.x, c = blockIdx.x;
#ifndef PH_MASK
#define PH_MASK 0x3FF
#endif
#define IN(k) (((PH_MASK >> (k)) & 1) && lo <= (k) && (k) < hi)
#define SEAM(k) do { if (IN(k) && IN((k) + 1)) grid.sync(); } while (0)
    if (IN(0)) phase_prologue(A, L);
    SEAM(0);
    if (IN(1)) phase_hx(A);
    SEAM(1);
    if (IN(2)) { SchedInProj Sd{(const char*)(A.ws + WS_HX), (const char*)(A.ws + WS_HC), (const char*)(A.ws + WS_WIN), G, c}; EpiInProj E{A.ws};
        pg8::gemm_phase<EpiInProj, SchedInProj, true>(L, D, Sd, E); }
    SEAM(2);
    if (IN(3)) { phase_kfix(A); phase_conv(A, L); }
    SEAM(3);
    if (IN(4)) phase_attn(A, lds);
    SEAM(4);
    if (IN(5)) { SchedMerge Sd{(const char*)(A.ws + WS_Q), (const char*)(A.ws + WS_HX), (const char*)(A.ws + WS_WA), (const char*)(A.ws + WS_WC), G, c}; EpiMerge E{A.ws};
        pg8::gemm_phase<EpiMerge, SchedMerge, true>(L, D, Sd, E); }
    SEAM(5);
    if (IN(6)) { SchedPlain Sd{(const char*)(A.ws + WS_G), (const char*)(A.ws + WS_WO), M / 256, D / 256, G, c}; EpiOut E{A.x, (const float*)(A.ws + WS_MOD), A.out};
        pg8::gemm_phase<EpiOut, SchedPlain, true>(L, D, Sd, E); }
    SEAM(6);
    if (IN(7)) phase_hx2(A);
    SEAM(7);
    if (IN(8)) { SchedPlain Sd{(const char*)(A.ws + WS_HX), (const char*)(A.ws + WS_WP), M / 256, PW / 256, G, c}; EpiScores E{(float*)(A.ws + WS_SC)};
        pg8::gemm_phase<EpiScores, SchedPlain, true>(L, D, Sd, E); }
    SEAM(8);
    if (IN(9)) phase_peer(A, L);
#undef IN
#undef SEAM
}

#ifndef MK_ONE_LAUNCH
#define MK_ONE_LAUNCH 0
#endif
extern "C" void kernel_launch(void* const* d_in, const int* in_sizes, int n_in, void* d_out, int out_size, void* d_ws, size_t ws_size, hipStream_t stream) {
    static int grid = 0;
    if (grid == 0) {
        if (n_in != 23 || out_size != M * D || ws_size < WS_END) { fprintf(stderr, "kernel_launch: unexpected shapes (n_in %d out %d ws %zu)\n", n_in, out_size, ws_size); grid = -1; return; }
        int dev = 0, cus = 0, per_cu = 0;
        hipGetDevice(&dev); hipDeviceGetAttribute(&cus, hipDeviceAttributeMultiprocessorCount, dev);
        if (hipFuncSetAttribute((const void*)mega_fwd, hipFuncAttributeMaxDynamicSharedMemorySize, LDS_BYTES) != hipSuccess) { fprintf(stderr, "kernel_launch: hipFuncSetAttribute failed\n"); grid = -1; return; }
        if (hipOccupancyMaxActiveBlocksPerMultiprocessor(&per_cu, (const void*)mega_fwd, NWAVES * 64, LDS_BYTES) != hipSuccess || per_cu < 1) { fprintf(stderr, "kernel_launch: occupancy query says %d\n", per_cu); per_cu = 1; }
        (void)hipGetLastError();
        grid = cus * 1;
        if (per_cu < 1) grid = -1;
    }
    if (grid < 0) return;
    Args a{};
    const float** f = (const float**)&a;
    for (int i = 0; i < 23; ++i) f[i] = (const float*)d_in[i];
    a.out = (float*)d_out; a.ws = (unsigned char*)d_ws;
#if MK_ONE_LAUNCH
    a.ph_lo = 0; a.ph_hi = N_PHASES;
    void* args[] = {&a};
    hipError_t e = hipLaunchCooperativeKernel((const void*)mega_fwd, dim3(grid), dim3(NWAVES * 64), args, LDS_BYTES, stream);
    if (e != hipSuccess) fprintf(stderr, "cooperative launch failed: %s (grid %d)\n", hipGetErrorString(e), grid);
#else
    for (int p = 0; p < N_PHASES; ++p) { a.ph_lo = p; a.ph_hi = p + 1; hipLaunchKernelGGL(mega_fwd, dim3(grid), dim3(NWAVES * 64), LDS_BYTES, stream, a); }
#endif
}
```

```cpp
#include <hip/hip_runtime.h>
#include <hip/hip_cooperative_groups.h>
#include <cstdio>
#include <cstdint>
namespace cg = cooperative_groups;

#define LAS __attribute__((address_space(3)))
typedef unsigned short bf16_t;
typedef short bf16x8 __attribute__((ext_vector_type(8)));
typedef short s16x4 __attribute__((ext_vector_type(4)));
typedef float f32x2 __attribute__((ext_vector_type(2)));
typedef float f32x4 __attribute__((ext_vector_type(4)));
typedef float f32x16 __attribute__((ext_vector_type(16)));
typedef unsigned u32x2 __attribute__((ext_vector_type(2)));
typedef unsigned u32x4 __attribute__((ext_vector_type(4)));
typedef __bf16 bf16x2_t __attribute__((ext_vector_type(2)));

constexpr int D = 1024, NB = 8, S = 4096, CTXL = 256, SKV = S + CTXL, HD = 128, HQ = 8, HKV = 2;
constexpr int M = NB * S;
constexpr int MC = NB * CTXL;
constexpr int INW = 5632, NMOD = 6144, NEXP = 16384, PW = 2048;
constexpr float EPS = 1e-6f;

__device__ __forceinline__ unsigned cvt_pk_bf16(float lo, float hi) { f32x2 v = {lo, hi}; bf16x2_t b = __builtin_convertvector(v, bf16x2_t); return __builtin_bit_cast(unsigned, b); }
__device__ __forceinline__ float bf_lo(unsigned u) { return __uint_as_float(u << 16); }
__device__ __forceinline__ float bf_hi(unsigned u) { return __uint_as_float(u & 0xffff0000u); }
__device__ __forceinline__ float fast_sigmoid(float x) { return __builtin_amdgcn_rcpf(1.f + __builtin_amdgcn_exp2f(-1.4426950408889634f * x)); }
__device__ __forceinline__ float wave_sum(float v) {
#pragma unroll
    for (int o = 1; o < 64; o <<= 1) v += __shfl_xor(v, o);
    return v;
}

namespace pg8 {
constexpr int BM = 256, BK = 64, HALF = 128, HTB = HALF * BK * 2  , STAGE_BYTES = 8 * HTB, NXCD = 8, WGM = 8;
__host__ __device__ __forceinline__ int lds_byte(int r, int c) { const int st = (r >> 4) * 2 + (c >> 5), rr = r & 15, cc = c & 31, ob = rr * 64 + cc * 2; return st * 1024 + (ob ^ (((ob >> 9) & 1) << 5)); }
__host__ __device__ __forceinline__ void stage_rc(int b, int& R, int& C) { const int st = b / 1024, sb = b % 1024, swz = sb ^ (((sb >> 9) & 1) << 5); R = (st >> 1) * 16 + swz / 64; C = (st & 1) * 32 + (swz % 64) / 2; }
__host__ __device__ __forceinline__ int perm32(int rho) { const int n = rho >> 4, i = rho & 15; return 8 * (i >> 2) + 4 * n + (i & 3); }

struct Unit { const char* a; const char* b; int pm, pn, kind, keep; };

__device__ __forceinline__ void tile_of(int L, int nM, int nN, int& pm, int& pn) {
    const int nwg = nM * nN; int wgid = L;
    { const int q = nwg / NXCD, r = nwg % NXCD, xcd = wgid % NXCD, off = wgid / NXCD; wgid = (xcd < r ? xcd * (q + 1) : r * (q + 1) + (xcd - r) * q) + off; }
    const int nig = WGM * nN, gid = wgid / nig, fm = gid * WGM, gsz = (nM - fm) < WGM ? (nM - fm) : WGM;
    pm = fm + ((wgid % nig) % gsz); pn = (wgid % nig) / gsz;
}

template <class Epi, class Sched, bool ALIGN_EPI>
__device__ __forceinline__ void gemm_phase(LAS unsigned char* lds, const int K, const Sched& S, const Epi& E) {
    const int tid = threadIdx.x, wid = __builtin_amdgcn_readfirstlane(tid >> 6), lane = tid & 63, wr = wid >> 2, wc = wid & 3, fr = lane & 15, fq = lane >> 4;
    const int nt = K / BK;
    unsigned voffA[2], voffB[2];
#pragma unroll
    for (int i = 0; i < 2; ++i) { int R, C; stage_rc(tid * 16 + i * 8192, R, C); const int Rb = Epi::PERM ? ((R & ~31) + perm32(R & 31)) : R;
        voffA[i] = (unsigned)(R * K + C) * 2u; voffB[i] = (unsigned)(Rb * K + C) * 2u; }
    const size_t kstep = (size_t)(BK * 2);
    const size_t hstep = (size_t)HALF * K * 2;
    const unsigned ldsw = (unsigned)wid * 1024u;
    const int aoff = lds_byte(wr * 64 + fr, fq * 8), boff = lds_byte(wc * 32 + fr, fq * 8);
#define PG8_SA(b, h) (((b) * 2 + (h)) * HTB)
#define PG8_SB(b, h) ((4 + (b) * 2 + (h)) * HTB)
#define PG8_STAGE(bufoff, gbase, voff) do { _Pragma("unroll") for (int _i = 0; _i < 2; ++_i) \
        __builtin_amdgcn_global_load_lds((const unsigned*)((const char*)(gbase) + (voff)[_i]), (LAS unsigned*)(lds + (bufoff) + ldsw + _i * 8192), 16, 0, 0); } while (0)
#define PG8_LDA(dst, b, h) do { _Pragma("unroll") for (int m = 0; m < 4; ++m) _Pragma("unroll") for (int k = 0; k < 2; ++k) dst[m][k] = *(const LAS bf16x8*)(lds + PG8_SA(b, h) + aoff + m * 2048 + k * 1024); } while (0)
#define PG8_LDB(dst, b, h) do { _Pragma("unroll") for (int n = 0; n < 2; ++n) _Pragma("unroll") for (int k = 0; k < 2; ++k) dst[n][k] = *(const LAS bf16x8*)(lds + PG8_SB(b, h) + boff + n * 2048 + k * 1024); } while (0)
#define PG8_MMA(ai, bj, At, Bt) do { __builtin_amdgcn_s_setprio(1); _Pragma("unroll") for (int m = 0; m < 4; ++m) _Pragma("unroll") for (int n = 0; n < 2; ++n) _Pragma("unroll") for (int k = 0; k < 2; ++k) \
        acc[ai][bj][m][n] = __builtin_amdgcn_mfma_f32_16x16x32_bf16(Bt[n][k], At[m][k], acc[ai][bj][m][n], 0, 0, 0); __builtin_amdgcn_s_setprio(0); } while (0)
#define PG8_WAIT_V(n) asm volatile("s_waitcnt vmcnt(" #n ")" ::: "memory")
#define PG8_WAIT_L(n) asm volatile("s_waitcnt lgkmcnt(" #n ")" ::: "memory")
#define PG8_BAR __builtin_amdgcn_s_barrier()
#define PG8_SCHED __builtin_amdgcn_sched_barrier(0)
    Unit cur, nxt; int ui = 0;
    if (!S.next(0, cur)) return;
    f32x4 acc[2][2][4][2];
#pragma unroll
    for (int a = 0; a < 2; ++a)
#pragma unroll
        for (int b = 0; b < 2; ++b)
#pragma unroll
            for (int m = 0; m < 4; ++m)
#pragma unroll
                for (int n = 0; n < 2; ++n) acc[a][b][m][n] = (f32x4){0.f, 0.f, 0.f, 0.f};
    bf16x8 At[4][2], B0[2][2], B1[2][2];
    const char* cA = cur.a; const char* cB = cur.b;
    PG8_STAGE(PG8_SB(0, 0), cB, voffB); PG8_STAGE(PG8_SB(0, 1), cB + hstep, voffB); PG8_STAGE(PG8_SA(0, 0), cA, voffA); PG8_STAGE(PG8_SA(0, 1), cA + hstep, voffA);
    if (wr == 1) PG8_BAR;
    PG8_WAIT_V(2); PG8_BAR;
    PG8_STAGE(PG8_SB(1, 0), cB + kstep, voffB); PG8_STAGE(PG8_SA(1, 0), cA + kstep, voffA); PG8_STAGE(PG8_SB(1, 1), cB + hstep + kstep, voffB);
    PG8_WAIT_V(6); PG8_BAR;
    for (;;) {
        const bool has_next = S.next(ui + 1, nxt);
        const char* nA = has_next ? nxt.a : cA; const char* nB = has_next ? nxt.b : cB;
        for (int t = 0; t < nt; t += 2) {
            const bool last = (t == nt - 2);
            const char* a1 = cA + (size_t)(t + 1) * kstep;
            const char* a2 = last ? nA : cA + (size_t)(t + 2) * kstep; const char* b2 = last ? nB : cB + (size_t)(t + 2) * kstep;
            const char* a3 = a2 + kstep; const char* b3 = b2 + kstep;
            PG8_LDB(B0, 0, 0); PG8_LDB(B1, 0, 1); PG8_SCHED; PG8_LDA(At, 0, 0); PG8_STAGE(PG8_SA(1, 1), a1 + hstep, voffA);
            PG8_WAIT_V(8); PG8_WAIT_L(0); PG8_BAR; PG8_MMA(0, 0, At, B0); PG8_MMA(0, 1, At, B1); PG8_BAR; PG8_SCHED;
            PG8_LDA(At, 0, 1); PG8_STAGE(PG8_SB(0, 0), b2, voffB); PG8_STAGE(PG8_SB(0, 1), b2 + hstep, voffB); PG8_STAGE(PG8_SA(0, 0), a2, voffA);
            PG8_WAIT_V(8); PG8_WAIT_L(0); PG8_BAR; PG8_MMA(1, 0, At, B0); PG8_MMA(1, 1, At, B1); PG8_BAR; PG8_SCHED;
            PG8_LDB(B0, 1, 0); PG8_LDB(B1, 1, 1); PG8_SCHED; PG8_LDA(At, 1, 0); PG8_STAGE(PG8_SA(0, 1), a2 + hstep, voffA);
            PG8_WAIT_V(8); PG8_WAIT_L(0); PG8_BAR; PG8_MMA(0, 0, At, B0); PG8_MMA(0, 1, At, B1); PG8_BAR; PG8_SCHED;
            PG8_LDA(At, 1, 1); PG8_STAGE(PG8_SB(1, 0), b3, voffB); PG8_STAGE(PG8_SB(1, 1), b3 + hstep, voffB); PG8_STAGE(PG8_SA(1, 0), a3, voffA);
            PG8_WAIT_V(8); PG8_WAIT_L(0); PG8_BAR; PG8_MMA(1, 0, At, B0); PG8_MMA(1, 1, At, B1); PG8_BAR; PG8_SCHED;
        }
        if constexpr (ALIGN_EPI) { if (wr == 0) PG8_BAR; }
        E(acc, cur, wr, wc, fr, fq);
        if (!has_next) break;
        if (!cur.keep) {
#pragma unroll
        for (int a = 0; a < 2; ++a)
#pragma unroll
            for (int b = 0; b < 2; ++b)
#pragma unroll
                for (int m = 0; m < 4; ++m)
#pragma unroll
                    for (int n = 0; n < 2; ++n) acc[a][b][m][n] = (f32x4){0.f, 0.f, 0.f, 0.f};
        }
        cur = nxt; cA = nA; cB = nB; ++ui;
        if constexpr (ALIGN_EPI) { if (wr == 1) PG8_BAR; }
    }
    PG8_WAIT_V(0);
    if constexpr (!ALIGN_EPI) { if (wr == 0) PG8_BAR; }
    PG8_BAR;
#undef PG8_SA
#undef PG8_SB
#undef PG8_STAGE
#undef PG8_LDA
#undef PG8_LDB
#undef PG8_MMA
#undef PG8_WAIT_V
#undef PG8_WAIT_L
#undef PG8_BAR
#undef PG8_SCHED
}
}
namespace att {
constexpr int NW = 8, QBLK = 32, KVBLK = 64;
constexpr float SCALE = 0.088388347648318440f;
constexpr float THR = 8.f;
constexpr int LDQ = D, LDK = HKV * HD, LDO = D;
constexpr int SHM_V = KVBLK * HD * 2, SHM_K = KVBLK * HD * 2, SHM_ATTN = 2 * SHM_V + 2 * SHM_K + NW * 64 * 4;
constexpr int OST_OFF = SHM_ATTN, LDS_TOTAL = OST_OFF + NW * 8192;
#define KSWZ(row, colB) ((row) * 256 + ((colB) ^ (((row) & 7) << 4)))
#define SBAR() __builtin_amdgcn_sched_barrier(0)
__device__ __forceinline__ int crow(int r, int hi) { return (r & 3) + 8 * (r >> 2) + 4 * hi; }
__device__ __forceinline__ unsigned cvtpk(float lo, float hi) { unsigned r; asm volatile("v_cvt_pk_bf16_f32 %0, %1, %2" : "=v"(r) : "v"(lo), "v"(hi)); return r; }

__device__ __forceinline__ void partialSM(f32x16& p0, f32x16& p1, float& m_reg, float& mn, float& alpha) {
  constexpr float C = SCALE * 1.4426950408889634f;
  float pmax = p0[0]; for (int r = 1; r < 16; ++r) pmax = fmaxf(pmax, p0[r]); for (int r = 0; r < 16; ++r) pmax = fmaxf(pmax, p1[r]);
  { auto rr = __builtin_amdgcn_permlane32_swap(__float_as_uint(pmax), __float_as_uint(pmax), false, false);
    pmax = fmaxf(__uint_as_float(rr[0]), __uint_as_float(rr[1])); }
  if (__builtin_expect(__all(pmax - m_reg <= THR / SCALE), 1)) { mn = m_reg; alpha = 1.f; }
  else { mn = fmaxf(m_reg, pmax); alpha = __builtin_amdgcn_exp2f((m_reg - mn) * C); m_reg = mn; }
  float mnC = -mn * C;
  for (int r = 0; r < 16; ++r) p0[r] = fmaf(p0[r], C, mnC); for (int r = 0; r < 16; ++r) p1[r] = fmaf(p1[r], C, mnC);
  for (int r = 0; r < 16; ++r) p0[r] = __builtin_amdgcn_exp2f(p0[r]);
}
__device__ __forceinline__ void finishSM(f32x16& p0, f32x16& p1, float alpha, float& l_reg, bf16x8& pa0, bf16x8& pa1, bf16x8& pa2, bf16x8& pa3) {
  for (int r = 0; r < 16; ++r) p1[r] = __builtin_amdgcn_exp2f(p1[r]);
  float ps = 0; for (int r = 0; r < 16; ++r) ps += p0[r]; for (int r = 0; r < 16; ++r) ps += p1[r];
  { auto rr = __builtin_amdgcn_permlane32_swap(__float_as_uint(ps), __float_as_uint(ps), false, false);
    ps = __uint_as_float(rr[0]) + __uint_as_float(rr[1]); }
  l_reg = l_reg * alpha + ps;
#define PK4(P, BASE, OUT) do { unsigned a0 = cvtpk(P[BASE + 0], P[BASE + 1]), a1 = cvtpk(P[BASE + 2], P[BASE + 3]);   \
    unsigned b0 = cvtpk(P[BASE + 4], P[BASE + 5]), b1 = cvtpk(P[BASE + 6], P[BASE + 7]);                              \
    auto r0 = __builtin_amdgcn_permlane32_swap(a0, b0, false, false); auto r1 = __builtin_amdgcn_permlane32_swap(a1, b1, false, false); \
    u32x4 w = {r0[0], r1[0], r0[1], r1[1]}; OUT = *reinterpret_cast<bf16x8*>(&w); } while (0)
  PK4(p0, 0, pa0); PK4(p0, 8, pa1); PK4(p1, 0, pa2); PK4(p1, 8, pa3);
#undef PK4
}
__device__ __forceinline__ void qkt(f32x16& p0, f32x16& p1, const bf16_t* Ks, const bf16x8* qr, int r32, int hi) {
  p0 = f32x16{}; p1 = f32x16{};
  for (int d0 = 0; d0 < 8; ++d0) { int cb = (d0 * 16 + hi * 8) * 2;
    bf16x8 b0 = *reinterpret_cast<const bf16x8*>((const char*)Ks + KSWZ(r32, cb));
    bf16x8 b1 = *reinterpret_cast<const bf16x8*>((const char*)Ks + KSWZ(32 + r32, cb));
    p0 = __builtin_amdgcn_mfma_f32_32x32x16_bf16(b0, qr[d0], p0, 0, 0, 0);
    p1 = __builtin_amdgcn_mfma_f32_32x32x16_bf16(b1, qr[d0], p1, 0, 0, 0); }
}
__device__ __forceinline__ int v_st(int k, int c) { const int kk = (k & ~0xC) | ((k & 4) << 1) | ((k & 8) >> 1); return ((kk >> 3) * 4 + (c >> 5)) * 512 + ((kk & 7) * 32 + (c & 31)) * 2; }
__device__ __forceinline__ int v_rd_base(int lane) { return ((lane & 3) << 3) | (((lane >> 2) & 3) << 6) | (((lane >> 4) & 1) << 5) | (((lane >> 5) & 1) << 8); }
constexpr int v_rd_off(int d0, int ks, int half) { return d0 * 512 + ks * 4096 + half * 2048; }
template <int OFF> __device__ __forceinline__ s16x4 tr_read(int vb) {
  s16x4 r; asm volatile("ds_read_b64_tr_b16 %0, %1 offset:%2" : "=&v"(r) : "v"(vb), "i"(OFF) : "memory"); return r;
}
template <int D0> __device__ __forceinline__ void pv_one(f32x16& od, int vb, bf16x8 pa0, bf16x8 pa1, bf16x8 pa2, bf16x8 pa3) {
  const s16x4 l0 = tr_read<v_rd_off(D0, 0, 0)>(vb), h0 = tr_read<v_rd_off(D0, 0, 1)>(vb), l1 = tr_read<v_rd_off(D0, 1, 0)>(vb), h1 = tr_read<v_rd_off(D0, 1, 1)>(vb);
  const s16x4 l2 = tr_read<v_rd_off(D0, 2, 0)>(vb), h2 = tr_read<v_rd_off(D0, 2, 1)>(vb), l3 = tr_read<v_rd_off(D0, 3, 0)>(vb), h3 = tr_read<v_rd_off(D0, 3, 1)>(vb);
  asm volatile("s_waitcnt lgkmcnt(0)" ::: "memory"); SBAR();
#define PK(L, H) (bf16x8){L[0], L[1], L[2], L[3], H[0], H[1], H[2], H[3]}
  od = __builtin_amdgcn_mfma_f32_32x32x16_bf16(pa0, PK(l0, h0), od, 0, 0, 0);
  od = __builtin_amdgcn_mfma_f32_32x32x16_bf16(pa1, PK(l1, h1), od, 0, 0, 0);
  od = __builtin_amdgcn_mfma_f32_32x32x16_bf16(pa2, PK(l2, h2), od, 0, 0, 0);
  od = __builtin_amdgcn_mfma_f32_32x32x16_bf16(pa3, PK(l3, h3), od, 0, 0, 0);
#undef PK
}
__device__ __forceinline__ void pv_d0(f32x16* o, int vb, bf16x8 pa0, bf16x8 pa1, bf16x8 pa2, bf16x8 pa3) {
  pv_one<0>(o[0], vb, pa0, pa1, pa2, pa3); pv_one<1>(o[1], vb, pa0, pa1, pa2, pa3); pv_one<2>(o[2], vb, pa0, pa1, pa2, pa3); pv_one<3>(o[3], vb, pa0, pa1, pa2, pa3);
}

__device__ __forceinline__ void attn_unit(const bf16_t* Qb, const bf16_t* __restrict__ Kh, const bf16_t* __restrict__ Vh, bf16_t* Ob, int t0, int seq,
                                          const float* __restrict__ qng, const float* __restrict__ cst, const float* __restrict__ snt, char* lds) {
  int tid_ = threadIdx.x; asm volatile("" : "+v"(tid_));
  const int tid = tid_, wid = tid >> 6, lane = tid & 63, r32 = lane & 31, hi = lane >> 5;
  bf16_t* V_lds = (bf16_t*)lds; bf16_t* K_lds = (bf16_t*)(lds + 2 * SHM_V);
  float* ws = (float*)(lds + 2 * SHM_V + 2 * SHM_K) + wid * 64; float* li_l = ws; float* al_l = ws + 32;
  float m_reg = -1e30f, l_reg = 0; f32x16 o[4] = {}; bf16x8 qr[8];
  {
    const bf16_t* Qw = Qb + (long)(wid * QBLK + r32) * LDQ + hi * 8;
    float y[8][8]; float ss = 0.f;
#pragma unroll
    for (int d0 = 0; d0 < 8; ++d0) { const u32x4 w = *reinterpret_cast<const u32x4*>(Qw + d0 * 16);
#pragma unroll
      for (int j = 0; j < 4; ++j) { y[d0][2 * j] = bf_lo(w[j]); y[d0][2 * j + 1] = bf_hi(w[j]); ss += y[d0][2 * j] * y[d0][2 * j] + y[d0][2 * j + 1] * y[d0][2 * j + 1]; } }
    ss += __shfl_xor(ss, 32);
    const float rstd = rsqrtf(ss * (1.f / HD) + EPS);
#pragma unroll
    for (int d0 = 0; d0 < 8; ++d0) { const f32x4 g0 = *reinterpret_cast<const f32x4*>(qng + d0 * 16 + hi * 8), g1 = *reinterpret_cast<const f32x4*>(qng + d0 * 16 + hi * 8 + 4);
#pragma unroll
      for (int j = 0; j < 4; ++j) { y[d0][j] *= rstd * g0[j]; y[d0][4 + j] *= rstd * g1[j]; } }
    const int t = t0 + wid * QBLK + r32;
#pragma unroll
    for (int blk = 0; blk < 2; ++blk) { const int pos = blk == 0 ? (t >> 6) : (t & 63);
#pragma unroll
      for (int dd = 0; dd < 2; ++dd) { const int da = blk * 4 + dd, db = da + 2;
#pragma unroll
        for (int j4 = 0; j4 < 2; ++j4) { const f32x4 c4 = *reinterpret_cast<const f32x4*>(cst + pos * 32 + dd * 16 + hi * 8 + j4 * 4), s4 = *reinterpret_cast<const f32x4*>(snt + pos * 32 + dd * 16 + hi * 8 + j4 * 4);
#pragma unroll
          for (int j = 0; j < 4; ++j) { const float x1 = y[da][j4 * 4 + j], x2 = y[db][j4 * 4 + j]; y[da][j4 * 4 + j] = x1 * c4[j] - x2 * s4[j]; y[db][j4 * 4 + j] = x1 * s4[j] + x2 * c4[j]; } } } }
#pragma unroll
    for (int d0 = 0; d0 < 8; ++d0) { u32x4 w = {cvt_pk_bf16(y[d0][0], y[d0][1]), cvt_pk_bf16(y[d0][2], y[d0][3]), cvt_pk_bf16(y[d0][4], y[d0][5]), cvt_pk_bf16(y[d0][6], y[d0][7])}; qr[d0] = *reinterpret_cast<bf16x8*>(&w); }
  }
  const int sr = tid >> 4, sc = (tid & 15) * 8, vst0 = v_st(sr, sc), vst1 = v_st(32 + sr, sc);
  const int vb0 = (int)(uintptr_t)V_lds + v_rd_base(lane);
  struct { bf16x8 vs0, vs1, ks0, ks1; } sr_[2];
#define LD8(p) (*reinterpret_cast<const bf16x8*>(p))
#define SLOAD(i, k0) do { sr_[i].vs0 = LD8(&Vh[(long)((k0) + sr) * LDK + sc]); sr_[i].vs1 = LD8(&Vh[(long)((k0) + 32 + sr) * LDK + sc]); \
    sr_[i].ks0 = LD8(&Kh[(long)((k0) + sr) * LDK + sc]); sr_[i].ks1 = LD8(&Kh[(long)((k0) + 32 + sr) * LDK + sc]); } while (0)
#define SWRITE(b, i) do { *(bf16x8*)((char*)V_lds + (b) * SHM_V + vst0) = sr_[i].vs0;          \
    *(bf16x8*)((char*)V_lds + (b) * SHM_V + vst1) = sr_[i].vs1; int kc = sc * 2;               \
    *(bf16x8*)((char*)K_lds + (b) * SHM_K + KSWZ(sr, kc)) = sr_[i].ks0;                       \
    *(bf16x8*)((char*)K_lds + (b) * SHM_K + KSWZ(32 + sr, kc)) = sr_[i].ks1; } while (0)
#define SWAIT() asm volatile("s_waitcnt vmcnt(4)" ::: "memory")
#define RESC(a) do { if (__any((a) < 1.f)) { if (hi == 0) al_l[r32] = (a); asm volatile("s_waitcnt lgkmcnt(0)" ::: "memory"); \
    for (int d = 0; d < 4; ++d) for (int r = 0; r < 16; ++r) o[d][r] *= al_l[crow(r, hi)]; } } while (0)
  f32x16 pA0, pA1, pB0, pB1; float mnA, mnB, alA, alB; bf16x8 pa0, pa1, pa2, pa3; const int NT = seq / KVBLK;
  constexpr int SE = 0, SO = 1;
  SLOAD(SE, 0); asm volatile("s_waitcnt vmcnt(0)" ::: "memory"); SWRITE(0, SE); __syncthreads();
  qkt(pA0, pA1, K_lds, qr, r32, hi); partialSM(pA0, pA1, m_reg, mnA, alA);
  SLOAD(SO, KVBLK); if (2 < NT) SLOAD(SE, 2 * KVBLK);
  SWAIT(); SWRITE(1, SO); __syncthreads();
  for (int j = 1; j + 1 < NT; j += 2) {
    SBAR(); qkt(pB0, pB1, (bf16_t*)((char*)K_lds + SHM_K), qr, r32, hi);
    finishSM(pA0, pA1, alA, l_reg, pa0, pa1, pa2, pa3); SBAR();
    SLOAD(SO, (j + 2) * KVBLK); SBAR();
    pv_d0(o, vb0, pa0, pa1, pa2, pa3); partialSM(pB0, pB1, m_reg, mnB, alB);
    __syncthreads(); SWAIT(); SWRITE(0, SE);
    RESC(alB); __syncthreads();
    SBAR(); qkt(pA0, pA1, K_lds, qr, r32, hi);
    finishSM(pB0, pB1, alB, l_reg, pa0, pa1, pa2, pa3); SBAR();
    if (j + 3 < NT) SLOAD(SE, (j + 3) * KVBLK); SBAR();
    pv_d0(o, vb0 + (int)SHM_V, pa0, pa1, pa2, pa3); partialSM(pA0, pA1, m_reg, mnA, alA);
    __syncthreads(); SWAIT(); SWRITE(1, SO);
    RESC(alA); __syncthreads();
  }
  SBAR(); qkt(pB0, pB1, (bf16_t*)((char*)K_lds + SHM_K), qr, r32, hi);
  finishSM(pA0, pA1, alA, l_reg, pa0, pa1, pa2, pa3); SBAR();
  pv_d0(o, vb0, pa0, pa1, pa2, pa3); partialSM(pB0, pB1, m_reg, mnB, alB);
  __syncthreads(); RESC(alB);
  finishSM(pB0, pB1, alB, l_reg, pa0, pa1, pa2, pa3); SBAR();
  pv_d0(o, vb0 + (int)SHM_V, pa0, pa1, pa2, pa3);
  if (hi == 0) li_l[r32] = l_reg; asm volatile("s_waitcnt lgkmcnt(0)" ::: "memory");
  float rli[16];
#pragma unroll
  for (int r = 0; r < 16; ++r) rli[r] = __builtin_amdgcn_rcpf(li_l[crow(r, hi)]);
  { bf16_t* stg = (bf16_t*)(lds + OST_OFF) + wid * 4096;
#pragma unroll
    for (int r = 0; r < 16; ++r) { const int orow = crow(r, hi);
#pragma unroll
      for (int d0 = 0; d0 < 4; ++d0) stg[orow * 128 + d0 * 32 + r32] = (bf16_t)(cvt_pk_bf16(o[d0][r] * rli[r], 0.f) & 0xffffu); }
    asm volatile("s_waitcnt lgkmcnt(0)" ::: "memory");
    bf16_t* Ow = Ob + (long)(wid * QBLK) * LDO;
#pragma unroll
    for (int i = 0; i < 8; ++i) { const int row = i * 4 + (lane >> 4), ch = lane & 15; const u32x4 v = *(const u32x4*)(stg + row * 128 + ch * 8); *(u32x4*)(Ow + (long)row * LDO + ch * 8) = v; }
  }
#undef LD8
#undef SLOAD
#undef SWRITE
#undef SWAIT
#undef RESC
}
#undef KSWZ
#undef SBAR
}
constexpr size_t MiB = 1u << 20;
constexpr size_t WS_CTL = 0, CTL_ZERO_BYTES = 64 * 1024;
constexpr size_t WS_MOD = 1 * MiB;
constexpr size_t WS_ROPE = WS_MOD + 256 * 1024;
constexpr size_t WS_HC = 2 * MiB;
constexpr size_t WS_WIN = 6 * MiB;
constexpr size_t WS_WA = 17 * MiB, WS_WC = 19 * MiB, WS_WO = 21 * MiB;
constexpr size_t WS_WP = 23 * MiB;
constexpr size_t WS_UT = 27 * MiB, WS_VT = 59 * MiB;
constexpr size_t WS_KB = 91 * MiB, WS_VB = 108 * MiB;
constexpr size_t WS_HX = 125 * MiB;
constexpr size_t WS_Q = 189 * MiB;
constexpr size_t WS_G = 253 * MiB;
constexpr size_t WS_RT = 317 * MiB;
constexpr size_t WS_SGC = 381 * MiB;
constexpr size_t WS_SC = 189 * MiB;
constexpr size_t WS_END = 445 * MiB;

constexpr int NWAVES = 8;
constexpr int LDS_BYTES = 147456;

struct Args {
    const float *x, *c, *ctx, *c_ctx, *w_mod, *b_mod, *n1g, *n2g, *w_in, *qng, *kng, *w_ao, *cdw, *cb, *clg, *clb, *w_co, *w_o, *wq, *keys, *ut, *vt, *fg;
    float* out; unsigned char* ws; int ph_lo, ph_hi;
};

__host__ __device__ __forceinline__ int win_row(int n) {
    if (n < 1536) return n;
    const int base = n < 3584 ? 1536 : 3584, m = n - base, half = m >> 10, idx = m & 1023;
    return base + (idx >> 7) * 256 + half * 128 + (idx & 127);
}

__device__ __forceinline__ void task_mod(const Args& A, int task, int lane, const LAS float* sc) {
    const int n0 = task * 8, col = lane & 7, kg = lane >> 3;
    float acc[9];
#pragma unroll
    for (int b = 0; b < 9; ++b) acc[b] = 0.f;
    const float* wp = A.w_mod + (size_t)kg * NMOD + n0 + col;
    for (int i0 = 0; i0 < 128; i0 += 8) {
        float w[8];
#pragma unroll
        for (int u = 0; u < 8; ++u) w[u] = wp[(size_t)(i0 + u) * 8 * NMOD];
#pragma unroll
        for (int u = 0; u < 8; ++u) { const int k = kg + 8 * (i0 + u);
#pragma unroll
            for (int b = 0; b < 9; ++b) acc[b] += sc[b * D + k] * w[u]; }
    }
#pragma unroll
    for (int b = 0; b < 9; ++b) { float v = acc[b]; v += __shfl_xor(v, 8); v += __shfl_xor(v, 16); v += __shfl_xor(v, 32); acc[b] = v; }
    if (lane < 8) { float* mod = (float*)(A.ws + WS_MOD); const float bm = A.b_mod[n0 + col];
#pragma unroll
        for (int b = 0; b < 9; ++b) mod[b * NMOD + n0 + col] = acc[b] + bm; }
}
__device__ __forceinline__ void task_transpose(const float* W, int K, int N, bf16_t* WT, int k0, int n0, int row0, LAS float* scr, int lane) {
#pragma unroll 8
    for (int i = 0; i < 32; ++i) { const int kk = 2 * i + (lane >> 5); scr[kk * 33 + (lane & 31)] = W[(size_t)(k0 + kk) * N + n0 + (lane & 31)]; }
    asm volatile("s_waitcnt lgkmcnt(0)" ::: "memory");
    const int c = lane & 7;
#pragma unroll
    for (int j = 0; j < 4; ++j) { const int n = (lane >> 3) + 8 * j; const LAS float* s = scr + (8 * c) * 33 + n;
        u32x4 o; o.x = cvt_pk_bf16(s[0 * 33], s[1 * 33]); o.y = cvt_pk_bf16(s[2 * 33], s[3 * 33]); o.z = cvt_pk_bf16(s[4 * 33], s[5 * 33]); o.w = cvt_pk_bf16(s[6 * 33], s[7 * 33]);
        *(u32x4*)(WT + (size_t)(row0 + n) * K + k0 + 8 * c) = o; }
    asm volatile("s_waitcnt lgkmcnt(0)" ::: "memory");
}
__device__ __forceinline__ void task_cvt_row(const float* src, bf16_t* dst, int lane) {
#pragma unroll
    for (int i = 0; i < 4; ++i) { const f32x4 v = *(const f32x4*)(src + (i * 64 + lane) * 4); u32x2 o = {cvt_pk_bf16(v[0], v[1]), cvt_pk_bf16(v[2], v[3])}; *(u32x2*)(dst + (i * 64 + lane) * 4) = o; }
}
__device__ __forceinline__ bf16x8 ld8_f32_bf16(const float* p) { const f32x4 a = *(const f32x4*)p, b = *(const f32x4*)(p + 4); u32x4 w = {cvt_pk_bf16(a[0], a[1]), cvt_pk_bf16(a[2], a[3]), cvt_pk_bf16(b[0], b[1]), cvt_pk_bf16(b[2], b[3])}; return *reinterpret_cast<bf16x8*>(&w); }
__device__ __forceinline__ void task_wprime(const Args& A, int id, int lane) {
    const int hp = id >> 7, rem = id & 127, n0 = (rem >> 5) * 32, k0 = (rem & 31) * 32, r32 = lane & 31, hi = lane >> 5;
    f32x16 acc = {};
    const float* ka = A.keys + ((size_t)(hp * 128 + n0 + r32)) * 128 + hi * 8;
    const float* wb = A.wq + (size_t)(k0 + r32) * PW + hp * 128 + hi * 8;
#pragma unroll
    for (int s = 0; s < 8; ++s) acc = __builtin_amdgcn_mfma_f32_32x32x16_bf16(ld8_f32_bf16(ka + s * 16), ld8_f32_bf16(wb + s * 16), acc, 0, 0, 0);
    bf16_t* o = (bf16_t*)(A.ws + WS_WP);
#pragma unroll
    for (int r = 0; r < 16; ++r) { const int n = (r & 3) + 8 * (r >> 2) + 4 * hi; o[(size_t)(hp * 128 + n0 + n) * D + k0 + r32] = (bf16_t)(cvt_pk_bf16(acc[r], 0.f) & 0xffffu); }
}
__device__ __forceinline__ void phase_prologue(const Args& A, LAS unsigned char* lds) {
    const int tid = threadIdx.x, lane = tid & 63, wave = __builtin_amdgcn_readfirstlane(tid >> 6);
    LAS float* sc = (LAS float*)lds;
    for (int i = tid; i < 9 * D; i += 512) { const float v = i < 8 * D ? A.c[i] : A.c_ctx[i - 8 * D]; sc[i] = v / (1.f + __expf(-v)); }
    __syncthreads();
    LAS float* scr = (LAS float*)(lds + 36864 + wave * 8448);
    constexpr int T_MOD = NMOD / 8, T_WIN = (D / 64) * (INW / 32), T_SQ = (D / 64) * (D / 32), T_UV = 2 * NEXP, T_WP = 2048, T_ROPE = 1;
    constexpr int NT = T_MOD + T_WIN + 3 * T_SQ + T_UV + T_WP + T_ROPE;
    const int G = gridDim.x;
    for (int task = wave * G + blockIdx.x; task < NT; task += NWAVES * G) {
        int r = task;
        if (r < T_MOD) { task_mod(A, r, lane, sc); continue; } r -= T_MOD;
        if (r < T_WIN) { const int nblk = INW / 32, kb = r / nblk, nb = r % nblk; task_transpose(A.w_in, D, INW, (bf16_t*)(A.ws + WS_WIN), 64 * kb, 32 * nb, win_row(32 * nb), scr, lane); continue; } r -= T_WIN;
        if (r < 3 * T_SQ) { const int wsel = r / T_SQ, q = r % T_SQ, kb = q / 32, nb = q % 32;
            const float* W = wsel == 0 ? A.w_ao : (wsel == 1 ? A.w_co : A.w_o); bf16_t* WT = (bf16_t*)(A.ws + (wsel == 0 ? WS_WA : (wsel == 1 ? WS_WC : WS_WO)));
            task_transpose(W, D, D, WT, 64 * kb, 32 * nb, 32 * nb, scr, lane); continue; } r -= 3 * T_SQ;
        if (r < T_UV) { const int tb = r / NEXP, row = r % NEXP; task_cvt_row((tb ? A.vt : A.ut) + (size_t)row * D, (bf16_t*)(A.ws + (tb ? WS_VT : WS_UT)) + (size_t)row * D, lane); continue; } r -= T_UV;
        if (r < T_WP) { task_wprime(A, r, lane); continue; } r -= T_WP;
        { float* cs = (float*)(A.ws + WS_ROPE); float* sn = cs + 2048;
          for (int e = lane; e < 2048; e += 64) { const int p = e >> 5, i = e & 31; const float inv = powf(10000.f, -(float)(2 * i) / 64.f); const float a = (float)p * inv; cs[e] = cosf(a); sn[e] = sinf(a); } }
    }
}
__device__ __forceinline__ void normmod_row(const float* xr, const float* g, const float* modr, int sh_off, int sc_off, bf16_t* orow, int lane) {
    f32x4 v[4]; float ss = 0.f;
#pragma unroll
    for (int i = 0; i < 4; ++i) { v[i] = *(const f32x4*)(xr + (i * 64 + lane) * 4); ss += (v[i][0] * v[i][0] + v[i][1] * v[i][1]) + (v[i][2] * v[i][2] + v[i][3] * v[i][3]); }
    const float r = rsqrtf(wave_sum(ss) * (1.f / D) + EPS);
#pragma unroll
    for (int i = 0; i < 4; ++i) { const int k = (i * 64 + lane) * 4; const f32x4 gg = *(const f32x4*)(g + k), s1 = *(const f32x4*)(modr + sc_off + k), h1 = *(const f32x4*)(modr + sh_off + k);
        float y[4];
#pragma unroll
        for (int j = 0; j < 4; ++j) y[j] = v[i][j] * r * gg[j] * (1.f + s1[j]) + h1[j];
        u32x2 o = {cvt_pk_bf16(y[0], y[1]), cvt_pk_bf16(y[2], y[3])}; *(u32x2*)(orow + k) = o; }
}
__device__ __forceinline__ void phase_hx(const Args& A) {
    const int lane = threadIdx.x & 63, gw = blockIdx.x * NWAVES + (threadIdx.x >> 6), NGW = gridDim.x * NWAVES;
    const float* mod = (const float*)(A.ws + WS_MOD);
    for (int m = gw; m < M + MC; m += NGW) {
        if (m < M) normmod_row(A.x + (size_t)m * D, A.n1g, mod + (m >> 12) * NMOD, 0, D, (bf16_t*)(A.ws + WS_HX) + (size_t)m * D, lane);
        else { const int r = m - M; normmod_row(A.ctx + (size_t)r * D, A.n1g, mod + 8 * NMOD, 0, D, (bf16_t*)(A.ws + WS_HC) + (size_t)r * D, lane); }
    }
}
__device__ __forceinline__ void phase_hx2(const Args& A) {
    const int lane = threadIdx.x & 63, gw = blockIdx.x * NWAVES + (threadIdx.x >> 6), NGW = gridDim.x * NWAVES;
    const float* mod = (const float*)(A.ws + WS_MOD);
    for (int m = gw; m < M; m += NGW) normmod_row(A.out + (size_t)m * D, A.n2g, mod + (m >> 12) * NMOD, 3 * D, 4 * D, (bf16_t*)(A.ws + WS_HX) + (size_t)m * D, lane);
}
__device__ __forceinline__ void phase_kfix(const Args& A) {
    const int lane = threadIdx.x & 63, gw = blockIdx.x * NWAVES + (threadIdx.x >> 6), NGW = gridDim.x * NWAVES, li = lane & 15, sub = lane >> 4;
    bf16_t* KB = (bf16_t*)(A.ws + WS_KB); const float* cs = (const float*)(A.ws + WS_ROPE); const float* sn = cs + 2048;
    constexpr int NITEM = NB * SKV * HKV;
    const f32x4 g0 = *(const f32x4*)(A.kng + li * 8), g1 = *(const f32x4*)(A.kng + li * 8 + 4);
    const f32x4 p0 = *(const f32x4*)(A.kng + (li ^ 4) * 8), p1 = *(const f32x4*)(A.kng + (li ^ 4) * 8 + 4);
    for (int it = gw * 4 + sub; it < NITEM; it += NGW * 4) {
        const int row = it >> 1, h = it & 1, t = row % SKV;
        bf16_t* p = KB + (size_t)row * 256 + h * HD + li * 8;
        const u32x4 w = *(const u32x4*)p;
        float x[8], xp[8]; float ss = 0.f;
#pragma unroll
        for (int j = 0; j < 4; ++j) { x[2 * j] = bf_lo(w[j]); x[2 * j + 1] = bf_hi(w[j]); ss += x[2 * j] * x[2 * j] + x[2 * j + 1] * x[2 * j + 1];
            const unsigned pw = (unsigned)__shfl_xor((int)w[j], 4); xp[2 * j] = bf_lo(pw); xp[2 * j + 1] = bf_hi(pw); }
        ss += __shfl_xor(ss, 1); ss += __shfl_xor(ss, 2); ss += __shfl_xor(ss, 4); ss += __shfl_xor(ss, 8);
        const float r = rsqrtf(ss * (1.f / HD) + EPS);
        float y[8];
#pragma unroll
        for (int j = 0; j < 8; ++j) { x[j] *= r * (j < 4 ? g0[j] : g1[j - 4]); xp[j] *= r * (j < 4 ? p0[j] : p1[j - 4]); y[j] = x[j]; }
        if (t < S) {
            const int blk = li >> 3, pos = blk == 0 ? (t >> 6) : (t & 63), second = (li >> 2) & 1, i0 = (li & 3) * 8;
            const f32x4 c0 = *(const f32x4*)(cs + pos * 32 + i0), c1 = *(const f32x4*)(cs + pos * 32 + i0 + 4), s0 = *(const f32x4*)(sn + pos * 32 + i0), s1 = *(const f32x4*)(sn + pos * 32 + i0 + 4);
#pragma unroll
            for (int j = 0; j < 8; ++j) { const float c = j < 4 ? c0[j] : c1[j - 4], s = j < 4 ? s0[j] : s1[j - 4];
                y[j] = second ? (xp[j] * s + x[j] * c) : (x[j] * c - xp[j] * s); }
        }
        u32x4 o = {cvt_pk_bf16(y[0], y[1]), cvt_pk_bf16(y[2], y[3]), cvt_pk_bf16(y[4], y[5]), cvt_pk_bf16(y[6], y[7])};
        *(u32x4*)p = o;
    }
}
template <int R> struct ConvRow {
    static __device__ __forceinline__ void run(const unsigned* gp, int tl0, float (&acc)[32][2], const float (&w)[31][2]) {
        const int tl = tl0 + R - 15;
        unsigned v = 0u; if (tl >= 0 && tl < S) v = gp[(long)(R - 15) * (D / 2)];
        const float a = bf_lo(v), b = bf_hi(v);
#pragma unroll
        for (int t = (R - 30 > 0 ? R - 30 : 0); t <= (R < 31 ? R : 31); ++t) { acc[t][0] += w[R - t][0] * a; acc[t][1] += w[R - t][1] * b; }
        if constexpr (R + 1 < 62) ConvRow<R + 1>::run(gp, tl0, acc, w);
    }
};
__device__ __forceinline__ void phase_conv(const Args& A, LAS unsigned char* lds) {
    const int tid = threadIdx.x, lane = tid & 63, wave = tid >> 6;
    LAS float* tile = (LAS float*)lds;
    const bf16_t* G = (const bf16_t*)(A.ws + WS_G); bf16_t* CV = (bf16_t*)(A.ws + WS_HX);
    float w[31][2];
#pragma unroll
    for (int j = 0; j < 31; ++j) { const f32x2 t = *(const f32x2*)(A.cdw + j * D + 2 * tid); w[j][0] = t[0]; w[j][1] = t[1]; }
    const f32x2 bias = *(const f32x2*)(A.cb + 2 * tid);
    for (int tileid = blockIdx.x; tileid < M / 32; tileid += gridDim.x) {
        const int row0 = tileid * 32, tl0 = row0 & (S - 1);
        float acc[32][2];
#pragma unroll
        for (int t = 0; t < 32; ++t) { acc[t][0] = bias[0]; acc[t][1] = bias[1]; }
        ConvRow<0>::run((const unsigned*)(G + (size_t)row0 * D) + tid, tl0, acc, w);
        __syncthreads();
#pragma unroll
        for (int t = 0; t < 32; ++t) *(LAS f32x2*)(tile + t * D + 2 * tid) = (f32x2){acc[t][0], acc[t][1]};
        __syncthreads();
#pragma unroll
        for (int q = 0; q < 4; ++q) { const int t = wave * 4 + q; const LAS float* tr = tile + t * D;
            f32x4 v[4]; float s = 0.f;
#pragma unroll
            for (int i = 0; i < 4; ++i) { v[i] = *(const LAS f32x4*)(tr + (i * 64 + lane) * 4); s += (v[i][0] + v[i][1]) + (v[i][2] + v[i][3]); }
            const float mu = wave_sum(s) * (1.f / D); float qq = 0.f;
#pragma unroll
            for (int i = 0; i < 4; ++i) { v[i] = v[i] - mu; qq += (v[i][0] * v[i][0] + v[i][1] * v[i][1]) + (v[i][2] * v[i][2] + v[i][3] * v[i][3]); }
            const float rs = rsqrtf(wave_sum(qq) * (1.f / D) + EPS);
#pragma unroll
            for (int i = 0; i < 4; ++i) { const int k = (i * 64 + lane) * 4; const f32x4 gg = *(const f32x4*)(A.clg + k), bb = *(const f32x4*)(A.clb + k); float y[4];
#pragma unroll
                for (int j = 0; j < 4; ++j) { const float z = v[i][j] * rs * gg[j] + bb[j]; y[j] = z * fast_sigmoid(z); }
                u32x2 o = {cvt_pk_bf16(y[0], y[1]), cvt_pk_bf16(y[2], y[3])}; *(u32x2*)(CV + (size_t)(row0 + t) * D + k) = o; }
        }
    }
}
struct EpiInProj {
    static constexpr bool PERM = true;
    unsigned char* ws;
    __device__ __forceinline__ void operator()(f32x4 (&acc)[2][2][4][2], const pg8::Unit& u, int wr, int wc, int fr, int fq) const {
        const int c8 = wc * 32 + 8 * fq;
#pragma unroll
        for (int ai = 0; ai < 2; ++ai)
#pragma unroll
            for (int m = 0; m < 4; ++m) {
                const int row = u.pm * 256 + ai * 128 + wr * 64 + m * 16 + fr;
                if (u.kind == 0) {
                    bf16_t* p = (bf16_t*)(ws + WS_Q) + (size_t)row * D + u.pn * 256 + c8;
#pragma unroll
                    for (int bj = 0; bj < 2; ++bj) { const f32x4 v0 = acc[ai][bj][m][0], v1 = acc[ai][bj][m][1];
                        u32x4 w = {cvt_pk_bf16(v0[0], v0[1]), cvt_pk_bf16(v0[2], v0[3]), cvt_pk_bf16(v1[0], v1[1]), cvt_pk_bf16(v1[2], v1[3])}; *(u32x4*)(p + bj * 128) = w; }
                } else if (u.kind == 1 || u.kind == 2 || u.kind == 5 || u.kind == 6) {
                    const bool ctxu = u.kind >= 5;
                    const int kvrow = ctxu ? (row >> 8) * SKV + S + (row & 255) : (row >> 12) * SKV + (row & (S - 1));
                    bf16_t* p = (bf16_t*)(ws + ((u.kind == 1 || u.kind == 5) ? WS_KB : WS_VB)) + (size_t)kvrow * 256 + c8;
#pragma unroll
                    for (int bj = 0; bj < 2; ++bj) { const f32x4 v0 = acc[ai][bj][m][0], v1 = acc[ai][bj][m][1];
                        u32x4 w = {cvt_pk_bf16(v0[0], v0[1]), cvt_pk_bf16(v0[2], v0[3]), cvt_pk_bf16(v1[0], v1[1]), cvt_pk_bf16(v1[2], v1[3])}; *(u32x4*)(p + bj * 128) = w; }
                } else if (u.kind == 3) {
                    float g[8];
#pragma unroll
                    for (int n = 0; n < 2; ++n)
#pragma unroll
                        for (int j = 0; j < 4; ++j) g[4 * n + j] = acc[ai][0][m][n][j] * fast_sigmoid(acc[ai][1][m][n][j]);
                    u32x4 w = {cvt_pk_bf16(g[0], g[1]), cvt_pk_bf16(g[2], g[3]), cvt_pk_bf16(g[4], g[5]), cvt_pk_bf16(g[6], g[7])};
                    *(u32x4*)((bf16_t*)(ws + WS_G) + (size_t)row * D + (u.pn - 6) * 128 + c8) = w;
                } else {
                    float rt[8], sg[8];
#pragma unroll
                    for (int n = 0; n < 2; ++n)
#pragma unroll
                        for (int j = 0; j < 4; ++j) { const float ea = __builtin_amdgcn_exp2f(-1.4426950408889634f * acc[ai][0][m][n][j]), ec = __builtin_amdgcn_exp2f(-1.4426950408889634f * acc[ai][1][m][n][j]);
                            sg[4 * n + j] = __builtin_amdgcn_rcpf(1.f + ec); rt[4 * n + j] = (1.f + ec) * __builtin_amdgcn_rcpf(1.f + ea); }
                    const size_t off = (size_t)row * D + (u.pn - 14) * 128 + c8;
                    u32x4 w = {cvt_pk_bf16(rt[0], rt[1]), cvt_pk_bf16(rt[2], rt[3]), cvt_pk_bf16(rt[4], rt[5]), cvt_pk_bf16(rt[6], rt[7])}; *(u32x4*)((bf16_t*)(ws + WS_RT) + off) = w;
                    u32x4 w2 = {cvt_pk_bf16(sg[0], sg[1]), cvt_pk_bf16(sg[2], sg[3]), cvt_pk_bf16(sg[4], sg[5]), cvt_pk_bf16(sg[6], sg[7])}; *(u32x4*)((bf16_t*)(ws + WS_SGC) + off) = w2;
                }
            }
    }
};
struct SchedInProj {
    const char* hx; const char* hc; const char* w; int G, c;
    __device__ __forceinline__ bool next(int i, pg8::Unit& u) const {
        constexpr int nM = M / 256, nN = INW / 256, NMAIN = nM * nN, NCTX = (MC / 256) * 2;
        const int L = i * G + c; if (L >= NMAIN + NCTX) return false;
        if (L < NMAIN) { pg8::tile_of(L, nM, nN, u.pm, u.pn); u.a = hx + (size_t)u.pm * 256 * D * 2; u.kind = u.pn < 4 ? 0 : (u.pn == 4 ? 1 : (u.pn == 5 ? 2 : (u.pn < 14 ? 3 : 4))); }
        else { const int j = L - NMAIN; u.pm = j >> 1; u.pn = 4 + (j & 1); u.a = hc + (size_t)u.pm * 256 * D * 2; u.kind = 5 + (j & 1); }
        u.b = w + (size_t)u.pn * 256 * D * 2; u.keep = 0; return true;
    }
};
struct EpiMerge {
    static constexpr bool PERM = true;
    unsigned char* ws;
    __device__ __forceinline__ void operator()(f32x4 (&acc)[2][2][4][2], const pg8::Unit& u, int wr, int wc, int fr, int fq) const {
        const int c8 = u.pn * 256 + wc * 32 + 8 * fq;
        const bf16_t* F = (const bf16_t*)(ws + (u.kind == 0 ? WS_RT : WS_SGC));
#pragma unroll
        for (int ai = 0; ai < 2; ++ai)
#pragma unroll
            for (int m = 0; m < 4; ++m) { const size_t off = (size_t)(u.pm * 256 + ai * 128 + wr * 64 + m * 16 + fr) * D + c8;
#pragma unroll
                for (int bj = 0; bj < 2; ++bj) { const u32x4 f = *(const u32x4*)(F + off + bj * 128);
                    f32x4 v0 = acc[ai][bj][m][0], v1 = acc[ai][bj][m][1];
                    v0[0] *= bf_lo(f[0]); v0[1] *= bf_hi(f[0]); v0[2] *= bf_lo(f[1]); v0[3] *= bf_hi(f[1]); v1[0] *= bf_lo(f[2]); v1[1] *= bf_hi(f[2]); v1[2] *= bf_lo(f[3]); v1[3] *= bf_hi(f[3]);
                    if (u.kind == 0) { acc[ai][bj][m][0] = v0; acc[ai][bj][m][1] = v1; }
                    else { u32x4 w = {cvt_pk_bf16(v0[0], v0[1]), cvt_pk_bf16(v0[2], v0[3]), cvt_pk_bf16(v1[0], v1[1]), cvt_pk_bf16(v1[2], v1[3])}; *(u32x4*)((bf16_t*)(ws + WS_G) + off + bj * 128) = w; } } }
    }
};
struct SchedMerge {
    const char* att; const char* cv; const char* wa; const char* wc; int G, c;
    __device__ __forceinline__ bool next(int i, pg8::Unit& u) const {
        constexpr int nM = M / 256, nN = D / 256;
        const int L = (i >> 1) * G + c, sub = i & 1; if (L >= nM * nN) return false;
        pg8::tile_of(L, nM, nN, u.pm, u.pn);
        u.a = (sub ? cv : att) + (size_t)u.pm * 256 * D * 2; u.b = (sub ? wc : wa) + (size_t)u.pn * 256 * D * 2; u.kind = sub; u.keep = sub ^ 1; return true;
    }
};
struct SchedPlain {
    const char* a; const char* b; int nM, nN, G, c;
    __device__ __forceinline__ bool next(int i, pg8::Unit& u) const {
        const int L = i * G + c; if (L >= nM * nN) return false;
        pg8::tile_of(L, nM, nN, u.pm, u.pn); u.a = a + (size_t)u.pm * 256 * D * 2; u.b = b + (size_t)u.pn * 256 * D * 2; u.kind = 0; u.keep = 0; return true;
    }
};
struct EpiOut {
    static constexpr bool PERM = false;
    const float* x; const float* mod; float* xs;
    __device__ __forceinline__ void operator()(f32x4 (&acc)[2][2][4][2], const pg8::Unit& u, int wr, int wc, int fr, int fq) const {
        const int col0 = u.pn * 256 + wc * 32 + 4 * fq; const float* g1 = mod + ((u.pm * 256) >> 12) * NMOD + 2 * D;
        f32x4 gv[2][2];
#pragma unroll
        for (int bj = 0; bj < 2; ++bj)
#pragma unroll
            for (int n = 0; n < 2; ++n) gv[bj][n] = *(const f32x4*)(g1 + col0 + bj * 128 + n * 16);
#pragma unroll
        for (int ai = 0; ai < 2; ++ai)
#pragma unroll
            for (int m = 0; m < 4; ++m) { const size_t off = (size_t)(u.pm * 256 + ai * 128 + wr * 64 + m * 16 + fr) * D + col0;
#pragma unroll
                for (int bj = 0; bj < 2; ++bj)
#pragma unroll
                    for (int n = 0; n < 2; ++n) { const f32x4 xv = *(const f32x4*)(x + off + bj * 128 + n * 16); *(f32x4*)(xs + off + bj * 128 + n * 16) = xv + gv[bj][n] * acc[ai][bj][m][n]; } }
    }
};
struct EpiScores {
    static constexpr bool PERM = false;
    float* sc;
    __device__ __forceinline__ void operator()(f32x4 (&acc)[2][2][4][2], const pg8::Unit& u, int wr, int wc, int fr, int fq) const {
        const int col0 = u.pn * 256 + wc * 32 + 4 * fq;
#pragma unroll
        for (int ai = 0; ai < 2; ++ai)
#pragma unroll
            for (int m = 0; m < 4; ++m) { float* p = sc + (size_t)(u.pm * 256 + ai * 128 + wr * 64 + m * 16 + fr) * PW + col0;
#pragma unroll
                for (int bj = 0; bj < 2; ++bj)
#pragma unroll
                    for (int n = 0; n < 2; ++n) *(f32x4*)(p + bj * 128 + n * 16) = acc[ai][bj][m][n]; }
    }
};

__device__ __forceinline__ void phase_attn(const Args& A, unsigned char* lds) {
    const int G = gridDim.x, X = blockIdx.x & 7, j = blockIdx.x >> 3, perx = G >> 3;
    bf16_t* Q = (bf16_t*)(A.ws + WS_Q); const bf16_t* KB = (const bf16_t*)(A.ws + WS_KB); const bf16_t* VB = (const bf16_t*)(A.ws + WS_VB);
    const float* cs = (const float*)(A.ws + WS_ROPE); const float* sn = cs + 2048;
    for (int idx = j; idx < 128; idx += perx) {
        const int grp = 2 * X + (idx >> 6), uu = idx & 63, b = grp >> 1, kv = grp & 1, h = kv * 4 + (uu >> 4), qb = uu & 15;
        bf16_t* qp = Q + ((size_t)b * S + qb * 256) * D + h * HD;
        att::attn_unit(qp, KB + (size_t)b * SKV * 256 + kv * HD, VB + (size_t)b * SKV * 256 + kv * HD, qp, qb * 256, SKV, A.qng, cs, sn, (char*)lds);
    }
}

__device__ __forceinline__ float max4(float a, float b, float c, float d) { return fmaxf(fmaxf(a, b), fmaxf(c, d)); }
__device__ __forceinline__ float gelu_exact(float v) { return 0.5f * v * (1.f + erff(v * 0.70710678118654752f)); }
__device__ __forceinline__ void phase_peer(const Args& A, LAS unsigned char* lds) {
    const int lane = threadIdx.x & 63, wave = threadIdx.x >> 6, gw = blockIdx.x * NWAVES + wave, NGW = gridDim.x * NWAVES;
    LAS unsigned* wl = (LAS unsigned*)(lds + wave * 2048);
    LAS float* abL = (LAS float*)wl; LAS int* eidL = (LAS int*)(wl + 32); LAS float* wgtL = (LAS float*)(wl + 160); LAS float* coefL = (LAS float*)(wl + 288);
    const float* SC = (const float*)(A.ws + WS_SC); const bf16_t* HX = (const bf16_t*)(A.ws + WS_HX);
    const bf16_t* UT = (const bf16_t*)(A.ws + WS_UT); const bf16_t* VT = (const bf16_t*)(A.ws + WS_VT); const float* mod = (const float*)(A.ws + WS_MOD);
    const float NEG = -3.0e38f;
    for (int t = gw; t < M; t += NGW) {
#ifdef PEER_EXT_TOPK
        { const int* ge = (const int*)(A.ws + ((size_t)448 << 20)) + (size_t)t * 128; const float* gwt = (const float*)(A.ws + ((size_t)464 << 20)) + (size_t)t * 128;
          eidL[lane] = ge[lane]; eidL[64 + lane] = ge[64 + lane]; wgtL[lane] = gwt[lane]; wgtL[64 + lane] = gwt[64 + lane]; asm volatile("s_waitcnt vmcnt(0) lgkmcnt(0)" ::: "memory"); }
#else
        f32x4 sv[8];
#pragma unroll
        for (int h = 0; h < 8; ++h) sv[h] = *(const f32x4*)(SC + (size_t)t * PW + h * 256 + lane * 4);
#pragma unroll
        for (int h = 0; h < 8; ++h) {
            float k0, k1, k2, k3;
            { const unsigned nb = 127u - (unsigned)((lane & 31) * 4);
              k0 = __uint_as_float((__float_as_uint(sv[h][0]) & ~127u) | nb); k1 = __uint_as_float((__float_as_uint(sv[h][1]) & ~127u) | (nb - 1u));
              k2 = __uint_as_float((__float_as_uint(sv[h][2]) & ~127u) | (nb - 2u)); k3 = __uint_as_float((__float_as_uint(sv[h][3]) & ~127u) | (nb - 3u)); }
            float mytop = 0.f;
#pragma unroll
            for (int it = 0; it < 16; ++it) {
                float mx = max4(k0, k1, k2, k3);
                mx = fmaxf(mx, __shfl_xor(mx, 1)); mx = fmaxf(mx, __shfl_xor(mx, 2)); mx = fmaxf(mx, __shfl_xor(mx, 4)); mx = fmaxf(mx, __shfl_xor(mx, 8)); mx = fmaxf(mx, __shfl_xor(mx, 16));
                k0 = k0 == mx ? NEG : k0; k1 = k1 == mx ? NEG : k1; k2 = k2 == mx ? NEG : k2; k3 = k3 == mx ? NEG : k3;
                if ((lane & 31) == it) mytop = mx;
            }
            if ((lane & 31) < 16) abL[(lane >> 5) * 16 + (lane & 31)] = mytop;
            asm volatile("s_waitcnt lgkmcnt(0)" ::: "memory");
            const float ai = abL[lane >> 2]; const f32x4 bj = *(const LAS f32x4*)(abL + 16 + (lane & 3) * 4);
            { const unsigned cb = 255u - (unsigned)(lane * 4);
              k0 = __uint_as_float((__float_as_uint(ai + bj[0]) & ~255u) | cb); k1 = __uint_as_float((__float_as_uint(ai + bj[1]) & ~255u) | (cb - 1u));
              k2 = __uint_as_float((__float_as_uint(ai + bj[2]) & ~255u) | (cb - 2u)); k3 = __uint_as_float((__float_as_uint(ai + bj[3]) & ~255u) | (cb - 3u)); }
            mytop = NEG;
#pragma unroll
            for (int it = 0; it < 16; ++it) {
                float mx = max4(k0, k1, k2, k3);
                mx = fmaxf(mx, __shfl_xor(mx, 1)); mx = fmaxf(mx, __shfl_xor(mx, 2)); mx = fmaxf(mx, __shfl_xor(mx, 4)); mx = fmaxf(mx, __shfl_xor(mx, 8)); mx = fmaxf(mx, __shfl_xor(mx, 16)); mx = fmaxf(mx, __shfl_xor(mx, 32));
                k0 = k0 == mx ? NEG : k0; k1 = k1 == mx ? NEG : k1; k2 = k2 == mx ? NEG : k2; k3 = k3 == mx ? NEG : k3;
                if (lane == it) mytop = mx;
            }
            const float smax = __shfl(mytop, 0);
            float e = lane < 16 ? __expf(mytop - smax) : 0.f;
            float es = e; es += __shfl_xor(es, 1); es += __shfl_xor(es, 2); es += __shfl_xor(es, 4); es += __shfl_xor(es, 8);
            if (lane < 16) { const unsigned c = 255u - (__float_as_uint(mytop) & 255u);
                const unsigned ia = 127u - (__float_as_uint(abL[c >> 4]) & 127u), ib = 127u - (__float_as_uint(abL[16 + (c & 15)]) & 127u);
                eidL[h * 16 + lane] = (int)(ia * 128u + ib); wgtL[h * 16 + lane] = e / es; }
            asm volatile("s_waitcnt lgkmcnt(0)" ::: "memory");
        }
#endif
        const u32x4 xlo = *(const u32x4*)(HX + (size_t)t * D + lane * 8), xhi = *(const u32x4*)(HX + (size_t)t * D + 512 + lane * 8);
#pragma unroll 1
        for (int kb = 0; kb < 8; ++kb) {
            float p[16];
#pragma unroll
            for (int e = 0; e < 16; ++e) { const int id = eidL[kb * 16 + e]; const bf16_t* ur = UT + (size_t)id * D + lane * 8;
                const u32x4 a = *(const u32x4*)ur, b = *(const u32x4*)(ur + 512);
                float s = 0.f;
#pragma unroll
                for (int j = 0; j < 4; ++j) { const unsigned aj = a[j], bj = b[j], xl = xlo[j], xh = xhi[j];
                    s = __builtin_amdgcn_fdot2_f32_bf16(__builtin_bit_cast(bf16x2_t, aj), __builtin_bit_cast(bf16x2_t, xl), s, false);
                    s = __builtin_amdgcn_fdot2_f32_bf16(__builtin_bit_cast(bf16x2_t, bj), __builtin_bit_cast(bf16x2_t, xh), s, false); }
                p[e] = s; }
#pragma unroll
            for (int e = 0; e < 8; ++e) { const bool up = lane & 32; const float keep = up ? p[e + 8] : p[e], send = up ? p[e] : p[e + 8]; p[e] = keep + __shfl_xor(send, 32); }
#pragma unroll
            for (int e = 0; e < 4; ++e) { const bool up = lane & 16; const float keep = up ? p[e + 4] : p[e], send = up ? p[e] : p[e + 4]; p[e] = keep + __shfl_xor(send, 16); }
#pragma unroll
            for (int e = 0; e < 2; ++e) { const bool up = lane & 8; const float keep = up ? p[e + 2] : p[e], send = up ? p[e] : p[e + 2]; p[e] = keep + __shfl_xor(send, 8); }
            { const bool up = lane & 4; const float keep = up ? p[1] : p[0], send = up ? p[0] : p[1]; p[0] = keep + __shfl_xor(send, 4); }
            float hsum = p[0]; hsum += __shfl_xor(hsum, 2); hsum += __shfl_xor(hsum, 1);
            const int ke = kb * 16 + ((lane >> 2) & 15);
            const float cf = wgtL[ke] * gelu_exact(hsum);
            if ((lane & 3) == 0) coefL[ke] = cf;
        }
        asm volatile("s_waitcnt lgkmcnt(0)" ::: "memory");
        float y[16];
#pragma unroll
        for (int j = 0; j < 16; ++j) y[j] = 0.f;
#pragma unroll 1
        for (int kb = 0; kb < 8; ++kb) {
#pragma unroll
            for (int e = 0; e < 16; ++e) { const int id = eidL[kb * 16 + e]; const float cf = coefL[kb * 16 + e]; const bf16_t* vr = VT + (size_t)id * D + lane * 8;
                const u32x4 a = *(const u32x4*)vr, b = *(const u32x4*)(vr + 512);
#pragma unroll
                for (int j = 0; j < 4; ++j) { y[2 * j] += cf * bf_lo(a[j]); y[2 * j + 1] += cf * bf_hi(a[j]); y[8 + 2 * j] += cf * bf_lo(b[j]); y[8 + 2 * j + 1] += cf * bf_hi(b[j]); } }
        }
        const float* g2 = mod + (t >> 12) * NMOD + 5 * D; float* orow = A.out + (size_t)t * D;
        float z[16]; float ss = 0.f;
#pragma unroll
        for (int q = 0; q < 4; ++q) { const int k = (q >> 1) * 512 + lane * 8 + (q & 1) * 4; const f32x4 xv = *(const f32x4*)(orow + k), gv = *(const f32x4*)(g2 + k);
#pragma unroll
            for (int j = 0; j < 4; ++j) { const float zz = xv[j] + gv[j] * y[q * 4 + j]; z[q * 4 + j] = zz; ss += zz * zz; } }
        const float r = rsqrtf(wave_sum(ss) * (1.f / D) + EPS);
#pragma unroll
        for (int q = 0; q < 4; ++q) { const int k = (q >> 1) * 512 + lane * 8 + (q & 1) * 4; const f32x4 fv = *(const f32x4*)(A.fg + k);
            f32x4 o;
#pragma unroll
            for (int j = 0; j < 4; ++j) o[j] = z[q * 4 + j] * r * fv[j];
            *(f32x4*)(orow + k) = o; }
    }
}
constexpr int N_PHASES = 10;
__global__ void __launch_bounds__(NWAVES * 64, 2) mega_fwd(Args A) {
    extern __shared__ __attribute__((aligned(16))) unsigned char lds[];
    LAS unsigned char* L = (LAS unsigned char*)lds;
    cg::grid_group grid = cg::this_grid();
    const int lo = A.ph_lo, hi = A.ph_hi, G = gridDim.x, c = blockIdx.x;
#ifndef PH_MASK
#define PH_MASK 0x3FF
#endif
#define IN(k) (((PH_MASK >> (k)) & 1) && lo <= (k) && (k) < hi)
#define SEAM(k) do { if (IN(k) && IN((k) + 1)) grid.sync(); } while (0)
    if (IN(0)) phase_prologue(A, L);
    SEAM(0);
    if (IN(1)) phase_hx(A);
    SEAM(1);
    if (IN(2)) { SchedInProj Sd{(const char*)(A.ws + WS_HX), (const char*)(A.ws + WS_HC), (const char*)(A.ws + WS_WIN), G, c}; EpiInProj E{A.ws};
        pg8::gemm_phase<EpiInProj, SchedInProj, true>(L, D, Sd, E); }
    SEAM(2);
    if (IN(3)) { phase_kfix(A); phase_conv(A, L); }
    SEAM(3);
    if (IN(4)) phase_attn(A, lds);
    SEAM(4);
    if (IN(5)) { SchedMerge Sd{(const char*)(A.ws + WS_Q), (const char*)(A.ws + WS_HX), (const char*)(A.ws + WS_WA), (const char*)(A.ws + WS_WC), G, c}; EpiMerge E{A.ws};
        pg8::gemm_phase<EpiMerge, SchedMerge, true>(L, D, Sd, E); }
    SEAM(5);
    if (IN(6)) { SchedPlain Sd{(const char*)(A.ws + WS_G), (const char*)(A.ws + WS_WO), M / 256, D / 256, G, c}; EpiOut E{A.x, (const float*)(A.ws + WS_MOD), A.out};
        pg8::gemm_phase<EpiOut, SchedPlain, true>(L, D, Sd, E); }
    SEAM(6);
    if (IN(7)) phase_hx2(A);
    SEAM(7);
    if (IN(8)) { SchedPlain Sd{(const char*)(A.ws + WS_HX), (const char*)(A.ws + WS_WP), M / 256, PW / 256, G, c}; EpiScores E{(float*)(A.ws + WS_SC)};
        pg8::gemm_phase<EpiScores, SchedPlain, true>(L, D, Sd, E); }
    SEAM(8);
    if (IN(9)) phase_peer(A, L);
#undef IN
#undef SEAM
}

#ifndef MK_ONE_LAUNCH
#define MK_ONE_LAUNCH 1
#endif
extern "C" void kernel_launch(void* const* d_in, const int* in_sizes, int n_in, void* d_out, int out_size, void* d_ws, size_t ws_size, hipStream_t stream) {
    static int grid = 0;
    if (grid == 0) {
        if (n_in != 23 || out_size != M * D || ws_size < WS_END) { fprintf(stderr, "kernel_launch: unexpected shapes (n_in %d out %d ws %zu)\n", n_in, out_size, ws_size); grid = -1; return; }
        int dev = 0, cus = 0, per_cu = 0;
        hipGetDevice(&dev); hipDeviceGetAttribute(&cus, hipDeviceAttributeMultiprocessorCount, dev);
        if (hipFuncSetAttribute((const void*)mega_fwd, hipFuncAttributeMaxDynamicSharedMemorySize, LDS_BYTES) != hipSuccess) { fprintf(stderr, "kernel_launch: hipFuncSetAttribute failed\n"); grid = -1; return; }
        if (hipOccupancyMaxActiveBlocksPerMultiprocessor(&per_cu, (const void*)mega_fwd, NWAVES * 64, LDS_BYTES) != hipSuccess || per_cu < 1) { fprintf(stderr, "kernel_launch: occupancy query says %d\n", per_cu); per_cu = 1; }
        (void)hipGetLastError();
        grid = cus * 1;
        if (per_cu < 1) grid = -1;
    }
    if (grid < 0) return;
    Args a{};
    const float** f = (const float**)&a;
    for (int i = 0; i < 23; ++i) f[i] = (const float*)d_in[i];
    a.out = (float*)d_out; a.ws = (unsigned char*)d_ws;
#if MK_ONE_LAUNCH
    a.ph_lo = 0; a.ph_hi = N_PHASES;
    void* args[] = {&a};
    hipError_t e = hipLaunchCooperativeKernel((const void*)mega_fwd, dim3(grid), dim3(NWAVES * 64), args, LDS_BYTES, stream);
    if (e != hipSuccess) fprintf(stderr, "cooperative launch failed: %s (grid %d)\n", hipGetErrorString(e), grid);
#else
    for (int p = 0; p < N_PHASES; ++p) { a.ph_lo = p; a.ph_hi = p + 1; hipLaunchKernelGGL(mega_fwd, dim3(grid), dim3(NWAVES * 64), LDS_BYTES, stream, a); }
#endif
}
```

```cpp
#include <hip/hip_runtime.h>
#include <hip/hip_cooperative_groups.h>
#include <cstdio>
#include <cstdint>
namespace cg = cooperative_groups;

#define LAS __attribute__((address_space(3)))
typedef unsigned short bf16_t;
typedef short bf16x8 __attribute__((ext_vector_type(8)));
typedef short s16x4 __attribute__((ext_vector_type(4)));
typedef float f32x2 __attribute__((ext_vector_type(2)));
typedef float f32x4 __attribute__((ext_vector_type(4)));
typedef float f32x16 __attribute__((ext_vector_type(16)));
typedef unsigned u32x2 __attribute__((ext_vector_type(2)));
typedef unsigned u32x4 __attribute__((ext_vector_type(4)));
typedef __bf16 bf16x2_t __attribute__((ext_vector_type(2)));

constexpr int D = 1024, NB = 8, S = 4096, CTXL = 256, SKV = S + CTXL, HD = 128, HQ = 8, HKV = 2;
constexpr int M = NB * S;
constexpr int MC = NB * CTXL;
constexpr int INW = 5632, NMOD = 6144, NEXP = 16384, PW = 2048;
constexpr float EPS = 1e-6f;

__device__ __forceinline__ unsigned cvt_pk_bf16(float lo, float hi) { f32x2 v = {lo, hi}; bf16x2_t b = __builtin_convertvector(v, bf16x2_t); return __builtin_bit_cast(unsigned, b); }
__device__ __forceinline__ float bf_lo(unsigned u) { return __uint_as_float(u << 16); }
__device__ __forceinline__ float bf_hi(unsigned u) { return __uint_as_float(u & 0xffff0000u); }
__device__ __forceinline__ float fast_sigmoid(float x) { return __builtin_amdgcn_rcpf(1.f + __builtin_amdgcn_exp2f(-1.4426950408889634f * x)); }
__device__ __forceinline__ float wave_sum(float v) {
#pragma unroll
    for (int o = 1; o < 64; o <<= 1) v += __shfl_xor(v, o);
    return v;
}

namespace pg8 {
constexpr int BM = 256, BK = 64, HALF = 128, HTB = HALF * BK * 2  , STAGE_BYTES = 8 * HTB, NXCD = 8, WGM = 8;
__host__ __device__ __forceinline__ int lds_byte(int r, int c) { const int st = (r >> 4) * 2 + (c >> 5), rr = r & 15, cc = c & 31, ob = rr * 64 + cc * 2; return st * 1024 + (ob ^ (((ob >> 9) & 1) << 5)); }
__host__ __device__ __forceinline__ void stage_rc(int b, int& R, int& C) { const int st = b / 1024, sb = b % 1024, swz = sb ^ (((sb >> 9) & 1) << 5); R = (st >> 1) * 16 + swz / 64; C = (st & 1) * 32 + (swz % 64) / 2; }
__host__ __device__ __forceinline__ int perm32(int rho) { const int n = rho >> 4, i = rho & 15; return 8 * (i >> 2) + 4 * n + (i & 3); }

struct Unit { const char* a; const char* b; int pm, pn, kind, keep; };

__device__ __forceinline__ void tile_of(int L, int nM, int nN, int& pm, int& pn) {
    const int nwg = nM * nN; int wgid = L;
    { const int q = nwg / NXCD, r = nwg % NXCD, xcd = wgid % NXCD, off = wgid / NXCD; wgid = (xcd < r ? xcd * (q + 1) : r * (q + 1) + (xcd - r) * q) + off; }
    const int nig = WGM * nN, gid = wgid / nig, fm = gid * WGM, gsz = (nM - fm) < WGM ? (nM - fm) : WGM;
    pm = fm + ((wgid % nig) % gsz); pn = (wgid % nig) / gsz;
}

template <class Epi, class Sched, bool ALIGN_EPI>
__device__ __forceinline__ void gemm_phase(LAS unsigned char* lds, const int K, const Sched& S, const Epi& E) {
    const int tid = threadIdx.x, wid = __builtin_amdgcn_readfirstlane(tid >> 6), lane = tid & 63, wr = wid >> 2, wc = wid & 3, fr = lane & 15, fq = lane >> 4;
    const int nt = K / BK;
    unsigned voffA[2], voffB[2];
#pragma unroll
    for (int i = 0; i < 2; ++i) { int R, C; stage_rc(tid * 16 + i * 8192, R, C); const int Rb = Epi::PERM ? ((R & ~31) + perm32(R & 31)) : R;
        voffA[i] = (unsigned)(R * K + C) * 2u; voffB[i] = (unsigned)(Rb * K + C) * 2u; }
    const size_t kstep = (size_t)(BK * 2);
    const size_t hstep = (size_t)HALF * K * 2;
    const unsigned ldsw = (unsigned)wid * 1024u;
    const int aoff = lds_byte(wr * 64 + fr, fq * 8), boff = lds_byte(wc * 32 + fr, fq * 8);
#define PG8_SA(b, h) (((b) * 2 + (h)) * HTB)
#define PG8_SB(b, h) ((4 + (b) * 2 + (h)) * HTB)
#define PG8_STAGE(bufoff, gbase, voff) do { _Pragma("unroll") for (int _i = 0; _i < 2; ++_i) \
        __builtin_amdgcn_global_load_lds((const unsigned*)((const char*)(gbase) + (voff)[_i]), (LAS unsigned*)(lds + (bufoff) + ldsw + _i * 8192), 16, 0, 0); } while (0)
#define PG8_LDA(dst, b, h) do { _Pragma("unroll") for (int m = 0; m < 4; ++m) _Pragma("unroll") for (int k = 0; k < 2; ++k) dst[m][k] = *(const LAS bf16x8*)(lds + PG8_SA(b, h) + aoff + m * 2048 + k * 1024); } while (0)
#define PG8_LDB(dst, b, h) do { _Pragma("unroll") for (int n = 0; n < 2; ++n) _Pragma("unroll") for (int k = 0; k < 2; ++k) dst[n][k] = *(const LAS bf16x8*)(lds + PG8_SB(b, h) + boff + n * 2048 + k * 1024); } while (0)
#define PG8_MMA(ai, bj, At, Bt) do { __builtin_amdgcn_s_setprio(1); _Pragma("unroll") for (int m = 0; m < 4; ++m) _Pragma("unroll") for (int n = 0; n < 2; ++n) _Pragma("unroll") for (int k = 0; k < 2; ++k) \
        acc[ai][bj][m][n] = __builtin_amdgcn_mfma_f32_16x16x32_bf16(Bt[n][k], At[m][k], acc[ai][bj][m][n], 0, 0, 0); __builtin_amdgcn_s_setprio(0); } while (0)
#define PG8_WAIT_V(n) asm volatile("s_waitcnt vmcnt(" #n ")" ::: "memory")
#define PG8_WAIT_L(n) asm volatile("s_waitcnt lgkmcnt(" #n ")" ::: "memory")
#define PG8_BAR __builtin_amdgcn_s_barrier()
#define PG8_SCHED __builtin_amdgcn_sched_barrier(0)
    Unit cur, nxt; int ui = 0;
    if (!S.next(0, cur)) return;
    f32x4 acc[2][2][4][2];
#pragma unroll
    for (int a = 0; a < 2; ++a)
#pragma unroll
        for (int b = 0; b < 2; ++b)
#pragma unroll
            for (int m = 0; m < 4; ++m)
#pragma unroll
                for (int n = 0; n < 2; ++n) acc[a][b][m][n] = (f32x4){0.f, 0.f, 0.f, 0.f};
    bf16x8 At[4][2], B0[2][2], B1[2][2];
    const char* cA = cur.a; const char* cB = cur.b;
    PG8_STAGE(PG8_SB(0, 0), cB, voffB); PG8_STAGE(PG8_SB(0, 1), cB + hstep, voffB); PG8_STAGE(PG8_SA(0, 0), cA, voffA); PG8_STAGE(PG8_SA(0, 1), cA + hstep, voffA);
    if (wr == 1) PG8_BAR;
    PG8_WAIT_V(2); PG8_BAR;
    PG8_STAGE(PG8_SB(1, 0), cB + kstep, voffB); PG8_STAGE(PG8_SA(1, 0), cA + kstep, voffA); PG8_STAGE(PG8_SB(1, 1), cB + hstep + kstep, voffB);
    PG8_WAIT_V(6); PG8_BAR;
    for (;;) {
        const bool has_next = S.next(ui + 1, nxt);
        const char* nA = has_next ? nxt.a : cA; const char* nB = has_next ? nxt.b : cB;
        for (int t = 0; t < nt; t += 2) {
            const bool last = (t == nt - 2);
            const char* a1 = cA + (size_t)(t + 1) * kstep;
            const char* a2 = last ? nA : cA + (size_t)(t + 2) * kstep; const char* b2 = last ? nB : cB + (size_t)(t + 2) * kstep;
            const char* a3 = a2 + kstep; const char* b3 = b2 + kstep;
            PG8_LDB(B0, 0, 0); PG8_LDB(B1, 0, 1); PG8_SCHED; PG8_LDA(At, 0, 0); PG8_STAGE(PG8_SA(1, 1), a1 + hstep, voffA);
            PG8_WAIT_V(8); PG8_WAIT_L(0); PG8_BAR; PG8_MMA(0, 0, At, B0); PG8_MMA(0, 1, At, B1); PG8_BAR; PG8_SCHED;
            PG8_LDA(At, 0, 1); PG8_STAGE(PG8_SB(0, 0), b2, voffB); PG8_STAGE(PG8_SB(0, 1), b2 + hstep, voffB); PG8_STAGE(PG8_SA(0, 0), a2, voffA);
            PG8_WAIT_V(8); PG8_WAIT_L(0); PG8_BAR; PG8_MMA(1, 0, At, B0); PG8_MMA(1, 1, At, B1); PG8_BAR; PG8_SCHED;
            PG8_LDB(B0, 1, 0); PG8_LDB(B1, 1, 1); PG8_SCHED; PG8_LDA(At, 1, 0); PG8_STAGE(PG8_SA(0, 1), a2 + hstep, voffA);
            PG8_WAIT_V(8); PG8_WAIT_L(0); PG8_BAR; PG8_MMA(0, 0, At, B0); PG8_MMA(0, 1, At, B1); PG8_BAR; PG8_SCHED;
            PG8_LDA(At, 1, 1); PG8_STAGE(PG8_SB(1, 0), b3, voffB); PG8_STAGE(PG8_SB(1, 1), b3 + hstep, voffB); PG8_STAGE(PG8_SA(1, 0), a3, voffA);
            PG8_WAIT_V(8); PG8_WAIT_L(0); PG8_BAR; PG8_MMA(1, 0, At, B0); PG8_MMA(1, 1, At, B1); PG8_BAR; PG8_SCHED;
        }
        if constexpr (ALIGN_EPI) { if (wr == 0) PG8_BAR; }
        E(acc, cur, wr, wc, fr, fq);
        if (!has_next) break;
        if (!cur.keep) {
#pragma unroll
        for (int a = 0; a < 2; ++a)
#pragma unroll
            for (int b = 0; b < 2; ++b)
#pragma unroll
                for (int m = 0; m < 4; ++m)
#pragma unroll
                    for (int n = 0; n < 2; ++n) acc[a][b][m][n] = (f32x4){0.f, 0.f, 0.f, 0.f};
        }
        cur = nxt; cA = nA; cB = nB; ++ui;
        if constexpr (ALIGN_EPI) { if (wr == 1) PG8_BAR; }
    }
    PG8_WAIT_V(0);
    if constexpr (!ALIGN_EPI) { if (wr == 0) PG8_BAR; }
    PG8_BAR;
#undef PG8_SA
#undef PG8_SB
#undef PG8_STAGE
#undef PG8_LDA
#undef PG8_LDB
#undef PG8_MMA
#undef PG8_WAIT_V
#undef PG8_WAIT_L
#undef PG8_BAR
#undef PG8_SCHED
}
}
namespace att {
constexpr int NW = 8, QBLK = 32, KVBLK = 64;
constexpr float SCALE = 0.088388347648318440f;
constexpr float THR = 8.f;
constexpr int LDQ = D, LDK = HKV * HD, LDO = D;
constexpr int SHM_V = KVBLK * HD * 2, SHM_K = KVBLK * HD * 2, SHM_ATTN = 2 * SHM_V + 2 * SHM_K + NW * 64 * 4;
constexpr int OST_OFF = SHM_ATTN, LDS_TOTAL = OST_OFF + NW * 8192;
#define KSWZ(row, colB) ((row) * 256 + ((colB) ^ (((row) & 7) << 4)))
#define SBAR() __builtin_amdgcn_sched_barrier(0)
__device__ __forceinline__ int crow(int r, int hi) { return (r & 3) + 8 * (r >> 2) + 4 * hi; }
__device__ __forceinline__ unsigned cvtpk(float lo, float hi) { unsigned r; asm volatile("v_cvt_pk_bf16_f32 %0, %1, %2" : "=v"(r) : "v"(lo), "v"(hi)); return r; }

__device__ __forceinline__ void partialSM(f32x16& p0, f32x16& p1, float& m_reg, float& mn, float& alpha) {
  constexpr float C = SCALE * 1.4426950408889634f;
  float pmax = p0[0]; for (int r = 1; r < 16; ++r) pmax = fmaxf(pmax, p0[r]); for (int r = 0; r < 16; ++r) pmax = fmaxf(pmax, p1[r]);
  { auto rr = __builtin_amdgcn_permlane32_swap(__float_as_uint(pmax), __float_as_uint(pmax), false, false);
    pmax = fmaxf(__uint_as_float(rr[0]), __uint_as_float(rr[1])); }
  if (__builtin_expect(__all(pmax - m_reg <= THR / SCALE), 1)) { mn = m_reg; alpha = 1.f; }
  else { mn = fmaxf(m_reg, pmax); alpha = __builtin_amdgcn_exp2f((m_reg - mn) * C); m_reg = mn; }
  float mnC = -mn * C;
  for (int r = 0; r < 16; ++r) p0[r] = fmaf(p0[r], C, mnC); for (int r = 0; r < 16; ++r) p1[r] = fmaf(p1[r], C, mnC);
  for (int r = 0; r < 16; ++r) p0[r] = __builtin_amdgcn_exp2f(p0[r]);
}
__device__ __forceinline__ void finishSM(f32x16& p0, f32x16& p1, float alpha, float& l_reg, bf16x8& pa0, bf16x8& pa1, bf16x8& pa2, bf16x8& pa3) {
  for (int r = 0; r < 16; ++r) p1[r] = __builtin_amdgcn_exp2f(p1[r]);
  float ps = 0; for (int r = 0; r < 16; ++r) ps += p0[r]; for (int r = 0; r < 16; ++r) ps += p1[r];
  { auto rr = __builtin_amdgcn_permlane32_swap(__float_as_uint(ps), __float_as_uint(ps), false, false);
    ps = __uint_as_float(rr[0]) + __uint_as_float(rr[1]); }
  l_reg = l_reg * alpha + ps;
#define PK4(P, BASE, OUT) do { unsigned a0 = cvtpk(P[BASE + 0], P[BASE + 1]), a1 = cvtpk(P[BASE + 2], P[BASE + 3]);   \
    unsigned b0 = cvtpk(P[BASE + 4], P[BASE + 5]), b1 = cvtpk(P[BASE + 6], P[BASE + 7]);                              \
    auto r0 = __builtin_amdgcn_permlane32_swap(a0, b0, false, false); auto r1 = __builtin_amdgcn_permlane32_swap(a1, b1, false, false); \
    u32x4 w = {r0[0], r1[0], r0[1], r1[1]}; OUT = *reinterpret_cast<bf16x8*>(&w); } while (0)
  PK4(p0, 0, pa0); PK4(p0, 8, pa1); PK4(p1, 0, pa2); PK4(p1, 8, pa3);
#undef PK4
}
__device__ __forceinline__ void qkt(f32x16& p0, f32x16& p1, const bf16_t* Ks, const bf16x8* qr, int r32, int hi) {
  p0 = f32x16{}; p1 = f32x16{};
  for (int d0 = 0; d0 < 8; ++d0) { int cb = (d0 * 16 + hi * 8) * 2;
    bf16x8 b0 = *reinterpret_cast<const bf16x8*>((const char*)Ks + KSWZ(r32, cb));
    bf16x8 b1 = *reinterpret_cast<const bf16x8*>((const char*)Ks + KSWZ(32 + r32, cb));
    p0 = __builtin_amdgcn_mfma_f32_32x32x16_bf16(b0, qr[d0], p0, 0, 0, 0);
    p1 = __builtin_amdgcn_mfma_f32_32x32x16_bf16(b1, qr[d0], p1, 0, 0, 0); }
}
__device__ __forceinline__ int v_st(int k, int c) { const int kk = (k & ~0xC) | ((k & 4) << 1) | ((k & 8) >> 1); return ((kk >> 3) * 4 + (c >> 5)) * 512 + ((kk & 7) * 32 + (c & 31)) * 2; }
__device__ __forceinline__ int v_rd_base(int lane) { return ((lane & 3) << 3) | (((lane >> 2) & 3) << 6) | (((lane >> 4) & 1) << 5) | (((lane >> 5) & 1) << 8); }
constexpr int v_rd_off(int d0, int ks, int half) { return d0 * 512 + ks * 4096 + half * 2048; }
template <int OFF> __device__ __forceinline__ s16x4 tr_read(int vb) {
  s16x4 r; asm volatile("ds_read_b64_tr_b16 %0, %1 offset:%2" : "=&v"(r) : "v"(vb), "i"(OFF) : "memory"); return r;
}
template <int D0> __device__ __forceinline__ void pv_one(f32x16& od, int vb, bf16x8 pa0, bf16x8 pa1, bf16x8 pa2, bf16x8 pa3) {
  const s16x4 l0 = tr_read<v_rd_off(D0, 0, 0)>(vb), h0 = tr_read<v_rd_off(D0, 0, 1)>(vb), l1 = tr_read<v_rd_off(D0, 1, 0)>(vb), h1 = tr_read<v_rd_off(D0, 1, 1)>(vb);
  const s16x4 l2 = tr_read<v_rd_off(D0, 2, 0)>(vb), h2 = tr_read<v_rd_off(D0, 2, 1)>(vb), l3 = tr_read<v_rd_off(D0, 3, 0)>(vb), h3 = tr_read<v_rd_off(D0, 3, 1)>(vb);
  asm volatile("s_waitcnt lgkmcnt(0)" ::: "memory"); SBAR();
#define PK(L, H) (bf16x8){L[0], L[1], L[2], L[3], H[0], H[1], H[2], H[3]}
  od = __builtin_amdgcn_mfma_f32_32x32x16_bf16(pa0, PK(l0, h0), od, 0, 0, 0);
  od = __builtin_amdgcn_mfma_f32_32x32x16_bf16(pa1, PK(l1, h1), od, 0, 0, 0);
  od = __builtin_amdgcn_mfma_f32_32x32x16_bf16(pa2, PK(l2, h2), od, 0, 0, 0);
  od = __builtin_amdgcn_mfma_f32_32x32x16_bf16(pa3, PK(l3, h3), od, 0, 0, 0);
#undef PK
}
__device__ __forceinline__ void pv_d0(f32x16* o, int vb, bf16x8 pa0, bf16x8 pa1, bf16x8 pa2, bf16x8 pa3) {
  pv_one<0>(o[0], vb, pa0, pa1, pa2, pa3); pv_one<1>(o[1], vb, pa0, pa1, pa2, pa3); pv_one<2>(o[2], vb, pa0, pa1, pa2, pa3); pv_one<3>(o[3], vb, pa0, pa1, pa2, pa3);
}

__device__ __forceinline__ void attn_unit(const bf16_t* Qb, const bf16_t* __restrict__ Kh, const bf16_t* __restrict__ Vh, bf16_t* Ob, int t0, int seq,
                                          const float* __restrict__ qng, const float* __restrict__ cst, const float* __restrict__ snt, char* lds) {
  int tid_ = threadIdx.x; asm volatile("" : "+v"(tid_));
  const int tid = tid_, wid = tid >> 6, lane = tid & 63, r32 = lane & 31, hi = lane >> 5;
  bf16_t* V_lds = (bf16_t*)lds; bf16_t* K_lds = (bf16_t*)(lds + 2 * SHM_V);
  float* ws = (float*)(lds + 2 * SHM_V + 2 * SHM_K) + wid * 64; float* li_l = ws; float* al_l = ws + 32;
  float m_reg = -1e30f, l_reg = 0; f32x16 o[4] = {}; bf16x8 qr[8];
  {
    const bf16_t* Qw = Qb + (long)(wid * QBLK + r32) * LDQ + hi * 8;
    float y[8][8]; float ss = 0.f;
#pragma unroll
    for (int d0 = 0; d0 < 8; ++d0) { const u32x4 w = *reinterpret_cast<const u32x4*>(Qw + d0 * 16);
#pragma unroll
      for (int j = 0; j < 4; ++j) { y[d0][2 * j] = bf_lo(w[j]); y[d0][2 * j + 1] = bf_hi(w[j]); ss += y[d0][2 * j] * y[d0][2 * j] + y[d0][2 * j + 1] * y[d0][2 * j + 1]; } }
    ss += __shfl_xor(ss, 32);
    const float rstd = rsqrtf(ss * (1.f / HD) + EPS);
#pragma unroll
    for (int d0 = 0; d0 < 8; ++d0) { const f32x4 g0 = *reinterpret_cast<const f32x4*>(qng + d0 * 16 + hi * 8), g1 = *reinterpret_cast<const f32x4*>(qng + d0 * 16 + hi * 8 + 4);
#pragma unroll
      for (int j = 0; j < 4; ++j) { y[d0][j] *= rstd * g0[j]; y[d0][4 + j] *= rstd * g1[j]; } }
    const int t = t0 + wid * QBLK + r32;
#pragma unroll
    for (int blk = 0; blk < 2; ++blk) { const int pos = blk == 0 ? (t >> 6) : (t & 63);
#pragma unroll
      for (int dd = 0; dd < 2; ++dd) { const int da = blk * 4 + dd, db = da + 2;
#pragma unroll
        for (int j4 = 0; j4 < 2; ++j4) { const f32x4 c4 = *reinterpret_cast<const f32x4*>(cst + pos * 32 + dd * 16 + hi * 8 + j4 * 4), s4 = *reinterpret_cast<const f32x4*>(snt + pos * 32 + dd * 16 + hi * 8 + j4 * 4);
#pragma unroll
          for (int j = 0; j < 4; ++j) { const float x1 = y[da][j4 * 4 + j], x2 = y[db][j4 * 4 + j]; y[da][j4 * 4 + j] = x1 * c4[j] - x2 * s4[j]; y[db][j4 * 4 + j] = x1 * s4[j] + x2 * c4[j]; } } } }
#pragma unroll
    for (int d0 = 0; d0 < 8; ++d0) { u32x4 w = {cvt_pk_bf16(y[d0][0], y[d0][1]), cvt_pk_bf16(y[d0][2], y[d0][3]), cvt_pk_bf16(y[d0][4], y[d0][5]), cvt_pk_bf16(y[d0][6], y[d0][7])}; qr[d0] = *reinterpret_cast<bf16x8*>(&w); }
  }
  const int sr = tid >> 4, sc = (tid & 15) * 8, vst0 = v_st(sr, sc), vst1 = v_st(32 + sr, sc);
  const int vb0 = (int)(uintptr_t)V_lds + v_rd_base(lane);
  struct { bf16x8 vs0, vs1, ks0, ks1; } sr_[2];
#define LD8(p) (*reinterpret_cast<const bf16x8*>(p))
#define SLOAD(i, k0) do { sr_[i].vs0 = LD8(&Vh[(long)((k0) + sr) * LDK + sc]); sr_[i].vs1 = LD8(&Vh[(long)((k0) + 32 + sr) * LDK + sc]); \
    sr_[i].ks0 = LD8(&Kh[(long)((k0) + sr) * LDK + sc]); sr_[i].ks1 = LD8(&Kh[(long)((k0) + 32 + sr) * LDK + sc]); } while (0)
#define SWRITE(b, i) do { *(bf16x8*)((char*)V_lds + (b) * SHM_V + vst0) = sr_[i].vs0;          \
    *(bf16x8*)((char*)V_lds + (b) * SHM_V + vst1) = sr_[i].vs1; int kc = sc * 2;               \
    *(bf16x8*)((char*)K_lds + (b) * SHM_K + KSWZ(sr, kc)) = sr_[i].ks0;                       \
    *(bf16x8*)((char*)K_lds + (b) * SHM_K + KSWZ(32 + sr, kc)) = sr_[i].ks1; } while (0)
#define SWAIT() asm volatile("s_waitcnt vmcnt(4)" ::: "memory")
#define RESC(a) do { if (__any((a) < 1.f)) { if (hi == 0) al_l[r32] = (a); asm volatile("s_waitcnt lgkmcnt(0)" ::: "memory"); \
    for (int d = 0; d < 4; ++d) for (int r = 0; r < 16; ++r) o[d][r] *= al_l[crow(r, hi)]; } } while (0)
  f32x16 pA0, pA1, pB0, pB1; float mnA, mnB, alA, alB; bf16x8 pa0, pa1, pa2, pa3; const int NT = seq / KVBLK;
  constexpr int SE = 0, SO = 1;
  SLOAD(SE, 0); asm volatile("s_waitcnt vmcnt(0)" ::: "memory"); SWRITE(0, SE); __syncthreads();
  qkt(pA0, pA1, K_lds, qr, r32, hi); partialSM(pA0, pA1, m_reg, mnA, alA);
  SLOAD(SO, KVBLK); if (2 < NT) SLOAD(SE, 2 * KVBLK);
  SWAIT(); SWRITE(1, SO); __syncthreads();
  for (int j = 1; j + 1 < NT; j += 2) {
    SBAR(); qkt(pB0, pB1, (bf16_t*)((char*)K_lds + SHM_K), qr, r32, hi);
    finishSM(pA0, pA1, alA, l_reg, pa0, pa1, pa2, pa3); SBAR();
    SLOAD(SO, (j + 2) * KVBLK); SBAR();
    pv_d0(o, vb0, pa0, pa1, pa2, pa3); partialSM(pB0, pB1, m_reg, mnB, alB);
    __syncthreads(); SWAIT(); SWRITE(0, SE);
    RESC(alB); __syncthreads();
    SBAR(); qkt(pA0, pA1, K_lds, qr, r32, hi);
    finishSM(pB0, pB1, alB, l_reg, pa0, pa1, pa2, pa3); SBAR();
    if (j + 3 < NT) SLOAD(SE, (j + 3) * KVBLK); SBAR();
    pv_d0(o, vb0 + (int)SHM_V, pa0, pa1, pa2, pa3); partialSM(pA0, pA1, m_reg, mnA, alA);
    __syncthreads(); SWAIT(); SWRITE(1, SO);
    RESC(alA); __syncthreads();
  }
  SBAR(); qkt(pB0, pB1, (bf16_t*)((char*)K_lds + SHM_K), qr, r32, hi);
  finishSM(pA0, pA1, alA, l_reg, pa0, pa1, pa2, pa3); SBAR();
  pv_d0(o, vb0, pa0, pa1, pa2, pa3); partialSM(pB0, pB1, m_reg, mnB, alB);
  __syncthreads(); RESC(alB);
  finishSM(pB0, pB1, alB, l_reg, pa0, pa1, pa2, pa3); SBAR();
  pv_d0(o, vb0 + (int)SHM_V, pa0, pa1, pa2, pa3);
  if (hi == 0) li_l[r32] = l_reg; asm volatile("s_waitcnt lgkmcnt(0)" ::: "memory");
  float rli[16];
#pragma unroll
  for (int r = 0; r < 16; ++r) rli[r] = __builtin_amdgcn_rcpf(li_l[crow(r, hi)]);
  { bf16_t* stg = (bf16_t*)(lds + OST_OFF) + wid * 4096;
#pragma unroll
    for (int r = 0; r < 16; ++r) { const int orow = crow(r, hi);
#pragma unroll
      for (int d0 = 0; d0 < 4; ++d0) stg[orow * 128 + d0 * 32 + r32] = (bf16_t)(cvt_pk_bf16(o[d0][r] * rli[r], 0.f) & 0xffffu); }
    asm volatile("s_waitcnt lgkmcnt(0)" ::: "memory");
    bf16_t* Ow = Ob + (long)(wid * QBLK) * LDO;
#pragma unroll
    for (int i = 0; i < 8; ++i) { const int row = i * 4 + (lane >> 4), ch = lane & 15; const u32x4 v = *(const u32x4*)(stg + row * 128 + ch * 8); *(u32x4*)(Ow + (long)row * LDO + ch * 8) = v; }
  }
#undef LD8
#undef SLOAD
#undef SWRITE
#undef SWAIT
#undef RESC
}
#undef KSWZ
#undef SBAR
}
constexpr size_t MiB = 1u << 20;
constexpr size_t WS_CTL = 0, CTL_ZERO_BYTES = 64 * 1024;
constexpr size_t WS_MOD = 1 * MiB;
constexpr size_t WS_ROPE = WS_MOD + 256 * 1024;
constexpr size_t WS_HC = 2 * MiB;
constexpr size_t WS_WIN = 6 * MiB;
constexpr size_t WS_WA = 17 * MiB, WS_WC = 19 * MiB, WS_WO = 21 * MiB;
constexpr size_t WS_WP = 23 * MiB;
constexpr size_t WS_UT = 27 * MiB, WS_VT = 59 * MiB;
constexpr size_t WS_TSCALE = 16 * MiB;
constexpr size_t WS_KB = 91 * MiB, WS_VB = 108 * MiB;
constexpr size_t WS_HX = 125 * MiB;
constexpr size_t WS_Q = 189 * MiB;
constexpr size_t WS_G = 253 * MiB;
constexpr size_t WS_RT = 317 * MiB;
constexpr size_t WS_SGC = 381 * MiB;
constexpr size_t WS_SC = 189 * MiB;
constexpr size_t WS_END = 445 * MiB;

constexpr int NWAVES = 8;
constexpr int LDS_BYTES = 147456;

struct Args {
    const float *x, *c, *ctx, *c_ctx, *w_mod, *b_mod, *n1g, *n2g, *w_in, *qng, *kng, *w_ao, *cdw, *cb, *clg, *clb, *w_co, *w_o, *wq, *keys, *ut, *vt, *fg;
    float* out; unsigned char* ws; int ph_lo, ph_hi, dry, pad;
};

__host__ __device__ __forceinline__ int win_row(int n) {
    if (n < 1536) return n;
    const int base = n < 3584 ? 1536 : 3584, m = n - base, half = m >> 10, idx = m & 1023;
    return base + (idx >> 7) * 256 + half * 128 + (idx & 127);
}

__device__ __forceinline__ void task_mod(const Args& A, int task, int lane, const LAS float* sc) {
    const int n0 = task * 8, col = lane & 7, kg = lane >> 3;
    float acc[9];
#pragma unroll
    for (int b = 0; b < 9; ++b) acc[b] = 0.f;
    const float* wp = A.w_mod + (size_t)kg * NMOD + n0 + col;
    for (int i0 = 0; i0 < 128; i0 += 8) {
        float w[8];
#pragma unroll
        for (int u = 0; u < 8; ++u) w[u] = wp[(size_t)(i0 + u) * 8 * NMOD];
#pragma unroll
        for (int u = 0; u < 8; ++u) { const int k = kg + 8 * (i0 + u);
#pragma unroll
            for (int b = 0; b < 9; ++b) acc[b] += sc[b * D + k] * w[u]; }
    }
#pragma unroll
    for (int b = 0; b < 9; ++b) { float v = acc[b]; v += __shfl_xor(v, 8); v += __shfl_xor(v, 16); v += __shfl_xor(v, 32); acc[b] = v; }
    if (lane < 8) { float* mod = (float*)(A.ws + WS_MOD); const float bm = A.b_mod[n0 + col];
#pragma unroll
        for (int b = 0; b < 9; ++b) mod[b * NMOD + n0 + col] = acc[b] + bm; }
}
__device__ __forceinline__ void task_transpose(const float* W, int K, int N, bf16_t* WT, int k0, int n0, int row0, LAS float* scr, int lane) {
#pragma unroll 8
    for (int i = 0; i < 32; ++i) { const int kk = 2 * i + (lane >> 5); scr[kk * 33 + (lane & 31)] = W[(size_t)(k0 + kk) * N + n0 + (lane & 31)]; }
    asm volatile("s_waitcnt lgkmcnt(0)" ::: "memory");
    const int c = lane & 7;
#pragma unroll
    for (int j = 0; j < 4; ++j) { const int n = (lane >> 3) + 8 * j; const LAS float* s = scr + (8 * c) * 33 + n;
        u32x4 o; o.x = cvt_pk_bf16(s[0 * 33], s[1 * 33]); o.y = cvt_pk_bf16(s[2 * 33], s[3 * 33]); o.z = cvt_pk_bf16(s[4 * 33], s[5 * 33]); o.w = cvt_pk_bf16(s[6 * 33], s[7 * 33]);
        *(u32x4*)(WT + (size_t)(row0 + n) * K + k0 + 8 * c) = o; }
    asm volatile("s_waitcnt lgkmcnt(0)" ::: "memory");
}
__device__ __forceinline__ void task_quant_row(const float* src, unsigned char* dst, float* scale_out, int lane) {
    f32x4 v[4]; float am = 0.f;
#pragma unroll
    for (int i = 0; i < 4; ++i) { v[i] = *(const f32x4*)(src + (i * 64 + lane) * 4); am = fmaxf(fmaxf(am, fmaxf(fabsf(v[i][0]), fabsf(v[i][1]))), fmaxf(fabsf(v[i][2]), fabsf(v[i][3]))); }
#pragma unroll
    for (int o = 1; o < 64; o <<= 1) am = fmaxf(am, __shfl_xor(am, o));
    const float inv = am > 0.f ? 448.f / am : 0.f;
#pragma unroll
    for (int i = 0; i < 4; ++i) { int p = __builtin_amdgcn_cvt_pk_fp8_f32(v[i][0] * inv, v[i][1] * inv, 0, false); p = __builtin_amdgcn_cvt_pk_fp8_f32(v[i][2] * inv, v[i][3] * inv, p, true);
        *(int*)(dst + (i * 64 + lane) * 4) = p; }
    if (lane == 0) *scale_out = am * (1.f / 448.f);
}
__device__ __forceinline__ bf16x8 ld8_f32_bf16(const float* p) { const f32x4 a = *(const f32x4*)p, b = *(const f32x4*)(p + 4); u32x4 w = {cvt_pk_bf16(a[0], a[1]), cvt_pk_bf16(a[2], a[3]), cvt_pk_bf16(b[0], b[1]), cvt_pk_bf16(b[2], b[3])}; return *reinterpret_cast<bf16x8*>(&w); }
__device__ __forceinline__ void task_wprime(const Args& A, int id, int lane) {
    const int hp = id >> 7, rem = id & 127, n0 = (rem >> 5) * 32, k0 = (rem & 31) * 32, r32 = lane & 31, hi = lane >> 5;
    f32x16 acc = {};
    const float* ka = A.keys + ((size_t)(hp * 128 + n0 + r32)) * 128 + hi * 8;
    const float* wb = A.wq + (size_t)(k0 + r32) * PW + hp * 128 + hi * 8;
#pragma unroll
    for (int s = 0; s < 8; ++s) acc = __builtin_amdgcn_mfma_f32_32x32x16_bf16(ld8_f32_bf16(ka + s * 16), ld8_f32_bf16(wb + s * 16), acc, 0, 0, 0);
    bf16_t* o = (bf16_t*)(A.ws + WS_WP);
#pragma unroll
    for (int r = 0; r < 16; ++r) { const int n = (r & 3) + 8 * (r >> 2) + 4 * hi; o[(size_t)(hp * 128 + n0 + n) * D + k0 + r32] = (bf16_t)(cvt_pk_bf16(acc[r], 0.f) & 0xffffu); }
}
__device__ __forceinline__ void phase_prologue(const Args& A, LAS unsigned char* lds) {
    const int tid = threadIdx.x, lane = tid & 63, wave = __builtin_amdgcn_readfirstlane(tid >> 6);
    LAS float* sc = (LAS float*)lds;
    for (int i = tid; i < 9 * D; i += 512) { const float v = i < 8 * D ? A.c[i] : A.c_ctx[i - 8 * D]; sc[i] = v / (1.f + __expf(-v)); }
    __syncthreads();
    LAS float* scr = (LAS float*)(lds + 36864 + wave * 8448);
    constexpr int T_MOD = NMOD / 8, T_WIN = (D / 64) * (INW / 32), T_SQ = (D / 64) * (D / 32), T_UV = 2 * NEXP, T_WP = 2048, T_ROPE = 1;
    constexpr int NT = T_MOD + T_WIN + 3 * T_SQ + T_UV + T_WP + T_ROPE;
    const int G = gridDim.x;
    for (int task = wave * G + blockIdx.x; task < NT; task += NWAVES * G) {
        int r = task;
        if (r < T_MOD) { task_mod(A, r, lane, sc); continue; } r -= T_MOD;
        if (r < T_WIN) { const int nblk = INW / 32, kb = r / nblk, nb = r % nblk; task_transpose(A.w_in, D, INW, (bf16_t*)(A.ws + WS_WIN), 64 * kb, 32 * nb, win_row(32 * nb), scr, lane); continue; } r -= T_WIN;
        if (r < 3 * T_SQ) { const int wsel = r / T_SQ, q = r % T_SQ, kb = q / 32, nb = q % 32;
            const float* W = wsel == 0 ? A.w_ao : (wsel == 1 ? A.w_co : A.w_o); bf16_t* WT = (bf16_t*)(A.ws + (wsel == 0 ? WS_WA : (wsel == 1 ? WS_WC : WS_WO)));
            task_transpose(W, D, D, WT, 64 * kb, 32 * nb, 32 * nb, scr, lane); continue; } r -= 3 * T_SQ;
        if (r < T_UV) { const int tb = r / NEXP, row = r % NEXP; unsigned char* tbase = A.ws + (tb ? WS_VT : WS_UT);
            task_quant_row((tb ? A.vt : A.ut) + (size_t)row * D, tbase + (size_t)row * D, (float*)(tbase + WS_TSCALE) + row, lane); continue; } r -= T_UV;
        if (r < T_WP) { task_wprime(A, r, lane); continue; } r -= T_WP;
        { float* cs = (float*)(A.ws + WS_ROPE); float* sn = cs + 2048;
          for (int e = lane; e < 2048; e += 64) { const int p = e >> 5, i = e & 31; const float inv = powf(10000.f, -(float)(2 * i) / 64.f); const float a = (float)p * inv; cs[e] = cosf(a); sn[e] = sinf(a); } }
    }
}
__device__ __forceinline__ void normmod_row(const float* xr, const float* g, const float* modr, int sh_off, int sc_off, bf16_t* orow, int lane) {
    f32x4 v[4]; float ss = 0.f;
#pragma unroll
    for (int i = 0; i < 4; ++i) { v[i] = *(const f32x4*)(xr + (i * 64 + lane) * 4); ss += (v[i][0] * v[i][0] + v[i][1] * v[i][1]) + (v[i][2] * v[i][2] + v[i][3] * v[i][3]); }
    const float r = rsqrtf(wave_sum(ss) * (1.f / D) + EPS);
#pragma unroll
    for (int i = 0; i < 4; ++i) { const int k = (i * 64 + lane) * 4; const f32x4 gg = *(const f32x4*)(g + k), s1 = *(const f32x4*)(modr + sc_off + k), h1 = *(const f32x4*)(modr + sh_off + k);
        float y[4];
#pragma unroll
        for (int j = 0; j < 4; ++j) y[j] = v[i][j] * r * gg[j] * (1.f + s1[j]) + h1[j];
        u32x2 o = {cvt_pk_bf16(y[0], y[1]), cvt_pk_bf16(y[2], y[3])}; *(u32x2*)(orow + k) = o; }
}
__device__ __forceinline__ void phase_hx(const Args& A) {
    const int lane = threadIdx.x & 63, gw = blockIdx.x * NWAVES + (threadIdx.x >> 6), NGW = gridDim.x * NWAVES;
    const float* mod = (const float*)(A.ws + WS_MOD);
    for (int m = gw; m < M + MC; m += NGW) {
        if (m < M) normmod_row(A.x + (size_t)m * D, A.n1g, mod + (m >> 12) * NMOD, 0, D, (bf16_t*)(A.ws + WS_HX) + (size_t)m * D, lane);
        else { const int r = m - M; normmod_row(A.ctx + (size_t)r * D, A.n1g, mod + 8 * NMOD, 0, D, (bf16_t*)(A.ws + WS_HC) + (size_t)r * D, lane); }
    }
}
__device__ __forceinline__ void phase_hx2(const Args& A) {
    const int lane = threadIdx.x & 63, gw = blockIdx.x * NWAVES + (threadIdx.x >> 6), NGW = gridDim.x * NWAVES;
    const float* mod = (const float*)(A.ws + WS_MOD);
    for (int m = gw; m < M; m += NGW) normmod_row(A.out + (size_t)m * D, A.n2g, mod + (m >> 12) * NMOD, 3 * D, 4 * D, (bf16_t*)(A.ws + WS_HX) + (size_t)m * D, lane);
}
__device__ __forceinline__ void phase_kfix(const Args& A) {
    const int lane = threadIdx.x & 63, gw = blockIdx.x * NWAVES + (threadIdx.x >> 6), NGW = gridDim.x * NWAVES, li = lane & 15, sub = lane >> 4;
    bf16_t* KB = (bf16_t*)(A.ws + WS_KB); const float* cs = (const float*)(A.ws + WS_ROPE); const float* sn = cs + 2048;
    constexpr int NITEM = NB * SKV * HKV;
    const f32x4 g0 = *(const f32x4*)(A.kng + li * 8), g1 = *(const f32x4*)(A.kng + li * 8 + 4);
    const f32x4 p0 = *(const f32x4*)(A.kng + (li ^ 4) * 8), p1 = *(const f32x4*)(A.kng + (li ^ 4) * 8 + 4);
    for (int it = gw * 4 + sub; it < NITEM; it += NGW * 4) {
        const int row = it >> 1, h = it & 1, t = row % SKV;
        bf16_t* p = KB + (size_t)row * 256 + h * HD + li * 8;
        const u32x4 w = *(const u32x4*)p;
        float x[8], xp[8]; float ss = 0.f;
#pragma unroll
        for (int j = 0; j < 4; ++j) { x[2 * j] = bf_lo(w[j]); x[2 * j + 1] = bf_hi(w[j]); ss += x[2 * j] * x[2 * j] + x[2 * j + 1] * x[2 * j + 1];
            const unsigned pw = (unsigned)__shfl_xor((int)w[j], 4); xp[2 * j] = bf_lo(pw); xp[2 * j + 1] = bf_hi(pw); }
        ss += __shfl_xor(ss, 1); ss += __shfl_xor(ss, 2); ss += __shfl_xor(ss, 4); ss += __shfl_xor(ss, 8);
        const float r = rsqrtf(ss * (1.f / HD) + EPS);
        float y[8];
#pragma unroll
        for (int j = 0; j < 8; ++j) { x[j] *= r * (j < 4 ? g0[j] : g1[j - 4]); xp[j] *= r * (j < 4 ? p0[j] : p1[j - 4]); y[j] = x[j]; }
        if (t < S) {
            const int blk = li >> 3, pos = blk == 0 ? (t >> 6) : (t & 63), second = (li >> 2) & 1, i0 = (li & 3) * 8;
            const f32x4 c0 = *(const f32x4*)(cs + pos * 32 + i0), c1 = *(const f32x4*)(cs + pos * 32 + i0 + 4), s0 = *(const f32x4*)(sn + pos * 32 + i0), s1 = *(const f32x4*)(sn + pos * 32 + i0 + 4);
#pragma unroll
            for (int j = 0; j < 8; ++j) { const float c = j < 4 ? c0[j] : c1[j - 4], s = j < 4 ? s0[j] : s1[j - 4];
                y[j] = second ? (xp[j] * s + x[j] * c) : (x[j] * c - xp[j] * s); }
        }
        u32x4 o = {cvt_pk_bf16(y[0], y[1]), cvt_pk_bf16(y[2], y[3]), cvt_pk_bf16(y[4], y[5]), cvt_pk_bf16(y[6], y[7])};
        *(u32x4*)p = o;
    }
}
template <int R> struct ConvRow {
    static __device__ __forceinline__ void run(const unsigned* gp, int tl0, float (&acc)[32][2], const float (&w)[31][2]) {
        const int tl = tl0 + R - 15;
        unsigned v = 0u; if (tl >= 0 && tl < S) v = gp[(long)(R - 15) * (D / 2)];
        const float a = bf_lo(v), b = bf_hi(v);
#pragma unroll
        for (int t = (R - 30 > 0 ? R - 30 : 0); t <= (R < 31 ? R : 31); ++t) { acc[t][0] += w[R - t][0] * a; acc[t][1] += w[R - t][1] * b; }
        if constexpr (R + 1 < 62) ConvRow<R + 1>::run(gp, tl0, acc, w);
    }
};
__device__ __forceinline__ void phase_conv(const Args& A, LAS unsigned char* lds) {
    const int tid = threadIdx.x, lane = tid & 63, wave = tid >> 6;
    LAS float* tile = (LAS float*)lds;
    const bf16_t* G = (const bf16_t*)(A.ws + WS_G); bf16_t* CV = (bf16_t*)(A.ws + WS_HX);
    float w[31][2];
#pragma unroll
    for (int j = 0; j < 31; ++j) { const f32x2 t = *(const f32x2*)(A.cdw + j * D + 2 * tid); w[j][0] = t[0]; w[j][1] = t[1]; }
    const f32x2 bias = *(const f32x2*)(A.cb + 2 * tid);
    for (int tileid = blockIdx.x; tileid < M / 32; tileid += gridDim.x) {
        const int row0 = tileid * 32, tl0 = row0 & (S - 1);
        float acc[32][2];
#pragma unroll
        for (int t = 0; t < 32; ++t) { acc[t][0] = bias[0]; acc[t][1] = bias[1]; }
        ConvRow<0>::run((const unsigned*)(G + (size_t)row0 * D) + tid, tl0, acc, w);
        __syncthreads();
#pragma unroll
        for (int t = 0; t < 32; ++t) *(LAS f32x2*)(tile + t * D + 2 * tid) = (f32x2){acc[t][0], acc[t][1]};
        __syncthreads();
#pragma unroll
        for (int q = 0; q < 4; ++q) { const int t = wave * 4 + q; const LAS float* tr = tile + t * D;
            f32x4 v[4]; float s = 0.f;
#pragma unroll
            for (int i = 0; i < 4; ++i) { v[i] = *(const LAS f32x4*)(tr + (i * 64 + lane) * 4); s += (v[i][0] + v[i][1]) + (v[i][2] + v[i][3]); }
            const float mu = wave_sum(s) * (1.f / D); float qq = 0.f;
#pragma unroll
            for (int i = 0; i < 4; ++i) { v[i] = v[i] - mu; qq += (v[i][0] * v[i][0] + v[i][1] * v[i][1]) + (v[i][2] * v[i][2] + v[i][3] * v[i][3]); }
            const float rs = rsqrtf(wave_sum(qq) * (1.f / D) + EPS);
#pragma unroll
            for (int i = 0; i < 4; ++i) { const int k = (i * 64 + lane) * 4; const f32x4 gg = *(const f32x4*)(A.clg + k), bb = *(const f32x4*)(A.clb + k); float y[4];
#pragma unroll
                for (int j = 0; j < 4; ++j) { const float z = v[i][j] * rs * gg[j] + bb[j]; y[j] = z * fast_sigmoid(z); }
                u32x2 o = {cvt_pk_bf16(y[0], y[1]), cvt_pk_bf16(y[2], y[3])}; *(u32x2*)(CV + (size_t)(row0 + t) * D + k) = o; }
        }
    }
}
struct EpiInProj {
    static constexpr bool PERM = true;
    unsigned char* ws;
    __device__ __forceinline__ void operator()(f32x4 (&acc)[2][2][4][2], const pg8::Unit& u, int wr, int wc, int fr, int fq) const {
        const int c8 = wc * 32 + 8 * fq;
#pragma unroll
        for (int ai = 0; ai < 2; ++ai)
#pragma unroll
            for (int m = 0; m < 4; ++m) {
                const int row = u.pm * 256 + ai * 128 + wr * 64 + m * 16 + fr;
                if (u.kind == 0) {
                    bf16_t* p = (bf16_t*)(ws + WS_Q) + (size_t)row * D + u.pn * 256 + c8;
#pragma unroll
                    for (int bj = 0; bj < 2; ++bj) { const f32x4 v0 = acc[ai][bj][m][0], v1 = acc[ai][bj][m][1];
                        u32x4 w = {cvt_pk_bf16(v0[0], v0[1]), cvt_pk_bf16(v0[2], v0[3]), cvt_pk_bf16(v1[0], v1[1]), cvt_pk_bf16(v1[2], v1[3])}; *(u32x4*)(p + bj * 128) = w; }
                } else if (u.kind == 1 || u.kind == 2 || u.kind == 5 || u.kind == 6) {
                    const bool ctxu = u.kind >= 5;
                    const int kvrow = ctxu ? (row >> 8) * SKV + S + (row & 255) : (row >> 12) * SKV + (row & (S - 1));
                    bf16_t* p = (bf16_t*)(ws + ((u.kind == 1 || u.kind == 5) ? WS_KB : WS_VB)) + (size_t)kvrow * 256 + c8;
#pragma unroll
                    for (int bj = 0; bj < 2; ++bj) { const f32x4 v0 = acc[ai][bj][m][0], v1 = acc[ai][bj][m][1];
                        u32x4 w = {cvt_pk_bf16(v0[0], v0[1]), cvt_pk_bf16(v0[2], v0[3]), cvt_pk_bf16(v1[0], v1[1]), cvt_pk_bf16(v1[2], v1[3])}; *(u32x4*)(p + bj * 128) = w; }
                } else if (u.kind == 3) {
                    float g[8];
#pragma unroll
                    for (int n = 0; n < 2; ++n)
#pragma unroll
                        for (int j = 0; j < 4; ++j) g[4 * n + j] = acc[ai][0][m][n][j] * fast_sigmoid(acc[ai][1][m][n][j]);
                    u32x4 w = {cvt_pk_bf16(g[0], g[1]), cvt_pk_bf16(g[2], g[3]), cvt_pk_bf16(g[4], g[5]), cvt_pk_bf16(g[6], g[7])};
                    *(u32x4*)((bf16_t*)(ws + WS_G) + (size_t)row * D + (u.pn - 6) * 128 + c8) = w;
                } else {
                    float rt[8], sg[8];
#pragma unroll
                    for (int n = 0; n < 2; ++n)
#pragma unroll
                        for (int j = 0; j < 4; ++j) { const float ea = __builtin_amdgcn_exp2f(-1.4426950408889634f * acc[ai][0][m][n][j]), ec = __builtin_amdgcn_exp2f(-1.4426950408889634f * acc[ai][1][m][n][j]);
                            sg[4 * n + j] = __builtin_amdgcn_rcpf(1.f + ec); rt[4 * n + j] = (1.f + ec) * __builtin_amdgcn_rcpf(1.f + ea); }
                    const size_t off = (size_t)row * D + (u.pn - 14) * 128 + c8;
                    u32x4 w = {cvt_pk_bf16(rt[0], rt[1]), cvt_pk_bf16(rt[2], rt[3]), cvt_pk_bf16(rt[4], rt[5]), cvt_pk_bf16(rt[6], rt[7])}; *(u32x4*)((bf16_t*)(ws + WS_RT) + off) = w;
                    u32x4 w2 = {cvt_pk_bf16(sg[0], sg[1]), cvt_pk_bf16(sg[2], sg[3]), cvt_pk_bf16(sg[4], sg[5]), cvt_pk_bf16(sg[6], sg[7])}; *(u32x4*)((bf16_t*)(ws + WS_SGC) + off) = w2;
                }
            }
    }
};
struct SchedInProj {
    const char* hx; const char* hc; const char* w; int G, c;
    __device__ __forceinline__ bool next(int i, pg8::Unit& u) const {
        constexpr int nM = M / 256, nN = INW / 256, NMAIN = nM * nN, NCTX = (MC / 256) * 2;
        const int L = i * G + c; if (L >= NMAIN + NCTX) return false;
        if (L < NMAIN) { pg8::tile_of(L, nM, nN, u.pm, u.pn); u.a = hx + (size_t)u.pm * 256 * D * 2; u.kind = u.pn < 4 ? 0 : (u.pn == 4 ? 1 : (u.pn == 5 ? 2 : (u.pn < 14 ? 3 : 4))); }
        else { const int j = L - NMAIN; u.pm = j >> 1; u.pn = 4 + (j & 1); u.a = hc + (size_t)u.pm * 256 * D * 2; u.kind = 5 + (j & 1); }
        u.b = w + (size_t)u.pn * 256 * D * 2; u.keep = 0; return true;
    }
};
struct EpiMerge {
    static constexpr bool PERM = true;
    unsigned char* ws;
    __device__ __forceinline__ void operator()(f32x4 (&acc)[2][2][4][2], const pg8::Unit& u, int wr, int wc, int fr, int fq) const {
        const int c8 = u.pn * 256 + wc * 32 + 8 * fq;
        const bf16_t* F = (const bf16_t*)(ws + (u.kind == 0 ? WS_RT : WS_SGC));
#pragma unroll
        for (int ai = 0; ai < 2; ++ai)
#pragma unroll
            for (int m = 0; m < 4; ++m) { const size_t off = (size_t)(u.pm * 256 + ai * 128 + wr * 64 + m * 16 + fr) * D + c8;
#pragma unroll
                for (int bj = 0; bj < 2; ++bj) { const u32x4 f = *(const u32x4*)(F + off + bj * 128);
                    f32x4 v0 = acc[ai][bj][m][0], v1 = acc[ai][bj][m][1];
                    v0[0] *= bf_lo(f[0]); v0[1] *= bf_hi(f[0]); v0[2] *= bf_lo(f[1]); v0[3] *= bf_hi(f[1]); v1[0] *= bf_lo(f[2]); v1[1] *= bf_hi(f[2]); v1[2] *= bf_lo(f[3]); v1[3] *= bf_hi(f[3]);
                    if (u.kind == 0) { acc[ai][bj][m][0] = v0; acc[ai][bj][m][1] = v1; }
                    else { u32x4 w = {cvt_pk_bf16(v0[0], v0[1]), cvt_pk_bf16(v0[2], v0[3]), cvt_pk_bf16(v1[0], v1[1]), cvt_pk_bf16(v1[2], v1[3])}; *(u32x4*)((bf16_t*)(ws + WS_G) + off + bj * 128) = w; } } }
    }
};
struct SchedMerge {
    const char* att; const char* cv; const char* wa; const char* wc; int G, c;
    __device__ __forceinline__ bool next(int i, pg8::Unit& u) const {
        constexpr int nM = M / 256, nN = D / 256;
        const int L = (i >> 1) * G + c, sub = i & 1; if (L >= nM * nN) return false;
        pg8::tile_of(L, nM, nN, u.pm, u.pn);
        u.a = (sub ? cv : att) + (size_t)u.pm * 256 * D * 2; u.b = (sub ? wc : wa) + (size_t)u.pn * 256 * D * 2; u.kind = sub; u.keep = sub ^ 1; return true;
    }
};
struct SchedPlain {
    const char* a; const char* b; int nM, nN, G, c;
    __device__ __forceinline__ bool next(int i, pg8::Unit& u) const {
        const int L = i * G + c; if (L >= nM * nN) return false;
        pg8::tile_of(L, nM, nN, u.pm, u.pn); u.a = a + (size_t)u.pm * 256 * D * 2; u.b = b + (size_t)u.pn * 256 * D * 2; u.kind = 0; u.keep = 0; return true;
    }
};
struct EpiOut {
    static constexpr bool PERM = false;
    const float* x; const float* mod; float* xs;
    __device__ __forceinline__ void operator()(f32x4 (&acc)[2][2][4][2], const pg8::Unit& u, int wr, int wc, int fr, int fq) const {
        const int col0 = u.pn * 256 + wc * 32 + 4 * fq; const float* g1 = mod + ((u.pm * 256) >> 12) * NMOD + 2 * D;
        f32x4 gv[2][2];
#pragma unroll
        for (int bj = 0; bj < 2; ++bj)
#pragma unroll
            for (int n = 0; n < 2; ++n) gv[bj][n] = *(const f32x4*)(g1 + col0 + bj * 128 + n * 16);
#pragma unroll
        for (int ai = 0; ai < 2; ++ai)
#pragma unroll
            for (int m = 0; m < 4; ++m) { const size_t off = (size_t)(u.pm * 256 + ai * 128 + wr * 64 + m * 16 + fr) * D + col0;
#pragma unroll
                for (int bj = 0; bj < 2; ++bj)
#pragma unroll
                    for (int n = 0; n < 2; ++n) { const f32x4 xv = *(const f32x4*)(x + off + bj * 128 + n * 16); *(f32x4*)(xs + off + bj * 128 + n * 16) = xv + gv[bj][n] * acc[ai][bj][m][n]; } }
    }
};
struct EpiScores {
    static constexpr bool PERM = false;
    float* sc;
    __device__ __forceinline__ void operator()(f32x4 (&acc)[2][2][4][2], const pg8::Unit& u, int wr, int wc, int fr, int fq) const {
        const int col0 = u.pn * 256 + wc * 32 + 4 * fq;
#pragma unroll
        for (int ai = 0; ai < 2; ++ai)
#pragma unroll
            for (int m = 0; m < 4; ++m) { float* p = sc + (size_t)(u.pm * 256 + ai * 128 + wr * 64 + m * 16 + fr) * PW + col0;
#pragma unroll
                for (int bj = 0; bj < 2; ++bj)
#pragma unroll
                    for (int n = 0; n < 2; ++n) *(f32x4*)(p + bj * 128 + n * 16) = acc[ai][bj][m][n]; }
    }
};

__device__ __forceinline__ void phase_attn(const Args& A, unsigned char* lds) {
    const int G = gridDim.x, X = blockIdx.x & 7, j = blockIdx.x >> 3, perx = G >> 3;
    bf16_t* Q = (bf16_t*)(A.ws + WS_Q); const bf16_t* KB = (const bf16_t*)(A.ws + WS_KB); const bf16_t* VB = (const bf16_t*)(A.ws + WS_VB);
    const float* cs = (const float*)(A.ws + WS_ROPE); const float* sn = cs + 2048;
    for (int idx = j; idx < 128; idx += perx) {
        const int grp = 2 * X + (idx >> 6), uu = idx & 63, b = grp >> 1, kv = grp & 1, h = kv * 4 + (uu >> 4), qb = uu & 15;
        bf16_t* qp = Q + ((size_t)b * S + qb * 256) * D + h * HD;
        bf16_t* op = A.dry ? (bf16_t*)(A.ws + ((size_t)445 << 20)) + ((size_t)b * S + qb * 256) * D + h * HD : qp;
        att::attn_unit(qp, KB + (size_t)b * SKV * 256 + kv * HD, VB + (size_t)b * SKV * 256 + kv * HD, op, qb * 256, SKV, A.qng, cs, sn, (char*)lds);
    }
}

__device__ __forceinline__ float max4(float a, float b, float c, float d) { return fmaxf(fmaxf(a, b), fmaxf(c, d)); }
__device__ __forceinline__ float gelu_exact(float v) { return 0.5f * v * (1.f + erff(v * 0.70710678118654752f)); }
__device__ __forceinline__ void phase_peer(const Args& A, LAS unsigned char* lds) {
    const int lane = threadIdx.x & 63, wave = threadIdx.x >> 6, gw = blockIdx.x * NWAVES + wave, NGW = gridDim.x * NWAVES;
    LAS unsigned* wl = (LAS unsigned*)(lds + wave * 2048);
    LAS float* abL = (LAS float*)wl; LAS int* eidL = (LAS int*)(wl + 32); LAS float* wgtL = (LAS float*)(wl + 160); LAS float* coefL = (LAS float*)(wl + 288);
    const float* SC = (const float*)(A.ws + WS_SC); const bf16_t* HX = (const bf16_t*)(A.ws + WS_HX);
    const unsigned char* UT = A.ws + WS_UT; const unsigned char* VT = A.ws + WS_VT; const float* SU = (const float*)(A.ws + WS_UT + WS_TSCALE); const float* SVs = (const float*)(A.ws + WS_VT + WS_TSCALE);
    const float* mod = (const float*)(A.ws + WS_MOD);
    const float NEG = -3.0e38f;
    for (int t = gw; t < M; t += NGW) {
#ifdef PEER_EXT_TOPK
        { const int* ge = (const int*)(A.ws + ((size_t)448 << 20)) + (size_t)t * 128; const float* gwt = (const float*)(A.ws + ((size_t)464 << 20)) + (size_t)t * 128;
          eidL[lane] = ge[lane]; eidL[64 + lane] = ge[64 + lane]; wgtL[lane] = gwt[lane]; wgtL[64 + lane] = gwt[64 + lane]; asm volatile("s_waitcnt vmcnt(0) lgkmcnt(0)" ::: "memory"); }
#else
        f32x4 sv[8];
#pragma unroll
        for (int h = 0; h < 8; ++h) sv[h] = *(const f32x4*)(SC + (size_t)t * PW + h * 256 + lane * 4);
#pragma unroll
        for (int h = 0; h < 8; ++h) {
            float k0, k1, k2, k3;
            { const unsigned nb = 127u - (unsigned)((lane & 31) * 4);
              k0 = __uint_as_float((__float_as_uint(sv[h][0]) & ~127u) | nb); k1 = __uint_as_float((__float_as_uint(sv[h][1]) & ~127u) | (nb - 1u));
              k2 = __uint_as_float((__float_as_uint(sv[h][2]) & ~127u) | (nb - 2u)); k3 = __uint_as_float((__float_as_uint(sv[h][3]) & ~127u) | (nb - 3u)); }
            float mytop = 0.f;
#pragma unroll
            for (int it = 0; it < 16; ++it) {
                float mx = max4(k0, k1, k2, k3);
                mx = fmaxf(mx, __shfl_xor(mx, 1)); mx = fmaxf(mx, __shfl_xor(mx, 2)); mx = fmaxf(mx, __shfl_xor(mx, 4)); mx = fmaxf(mx, __shfl_xor(mx, 8)); mx = fmaxf(mx, __shfl_xor(mx, 16));
                k0 = k0 == mx ? NEG : k0; k1 = k1 == mx ? NEG : k1; k2 = k2 == mx ? NEG : k2; k3 = k3 == mx ? NEG : k3;
                if ((lane & 31) == it) mytop = mx;
            }
            if ((lane & 31) < 16) abL[(lane >> 5) * 16 + (lane & 31)] = mytop;
            asm volatile("s_waitcnt lgkmcnt(0)" ::: "memory");
            const float ai = abL[lane >> 2]; const f32x4 bj = *(const LAS f32x4*)(abL + 16 + (lane & 3) * 4);
            { const unsigned cb = 255u - (unsigned)(lane * 4);
              k0 = __uint_as_float((__float_as_uint(ai + bj[0]) & ~255u) | cb); k1 = __uint_as_float((__float_as_uint(ai + bj[1]) & ~255u) | (cb - 1u));
              k2 = __uint_as_float((__float_as_uint(ai + bj[2]) & ~255u) | (cb - 2u)); k3 = __uint_as_float((__float_as_uint(ai + bj[3]) & ~255u) | (cb - 3u)); }
            mytop = NEG;
#pragma unroll
            for (int it = 0; it < 16; ++it) {
                float mx = max4(k0, k1, k2, k3);
                mx = fmaxf(mx, __shfl_xor(mx, 1)); mx = fmaxf(mx, __shfl_xor(mx, 2)); mx = fmaxf(mx, __shfl_xor(mx, 4)); mx = fmaxf(mx, __shfl_xor(mx, 8)); mx = fmaxf(mx, __shfl_xor(mx, 16)); mx = fmaxf(mx, __shfl_xor(mx, 32));
                k0 = k0 == mx ? NEG : k0; k1 = k1 == mx ? NEG : k1; k2 = k2 == mx ? NEG : k2; k3 = k3 == mx ? NEG : k3;
                if (lane == it) mytop = mx;
            }
            const float smax = __shfl(mytop, 0);
            float e = lane < 16 ? __expf(mytop - smax) : 0.f;
            float es = e; es += __shfl_xor(es, 1); es += __shfl_xor(es, 2); es += __shfl_xor(es, 4); es += __shfl_xor(es, 8);
            if (lane < 16) { const unsigned c = 255u - (__float_as_uint(mytop) & 255u);
                const unsigned ia = 127u - (__float_as_uint(abL[c >> 4]) & 127u), ib = 127u - (__float_as_uint(abL[16 + (c & 15)]) & 127u);
                eidL[h * 16 + lane] = (int)(ia * 128u + ib); wgtL[h * 16 + lane] = e / es; }
            asm volatile("s_waitcnt lgkmcnt(0)" ::: "memory");
        }
#endif
        float xf[16];
        { const u32x4 x0 = *(const u32x4*)(HX + (size_t)t * D + lane * 16), x1 = *(const u32x4*)(HX + (size_t)t * D + lane * 16 + 8);
#pragma unroll
          for (int j = 0; j < 4; ++j) { xf[2 * j] = bf_lo(x0[j]); xf[2 * j + 1] = bf_hi(x0[j]); xf[8 + 2 * j] = bf_lo(x1[j]); xf[8 + 2 * j + 1] = bf_hi(x1[j]); } }
#pragma unroll 1
        for (int kb = 0; kb < 8; ++kb) {
            float p[16];
            const int ke = kb * 16 + ((lane >> 2) & 15); const int myid = eidL[ke];
            const float su = SU[myid], sv = SVs[myid];
#pragma unroll
            for (int e = 0; e < 16; ++e) { const int id = eidL[kb * 16 + e];
                const u32x4 a = *(const u32x4*)(UT + (size_t)id * D + lane * 16);
                float s = 0.f;
#pragma unroll
                for (int j = 0; j < 4; ++j) { const int aj = (int)a[j]; const f32x2 lo = __builtin_amdgcn_cvt_pk_f32_fp8(aj, false), hi = __builtin_amdgcn_cvt_pk_f32_fp8(aj, true);
                    s += lo[0] * xf[4 * j]; s += lo[1] * xf[4 * j + 1]; s += hi[0] * xf[4 * j + 2]; s += hi[1] * xf[4 * j + 3]; }
                p[e] = s; }
#pragma unroll
            for (int e = 0; e < 8; ++e) { const bool up = lane & 32; const float keep = up ? p[e + 8] : p[e], send = up ? p[e] : p[e + 8]; p[e] = keep + __shfl_xor(send, 32); }
#pragma unroll
            for (int e = 0; e < 4; ++e) { const bool up = lane & 16; const float keep = up ? p[e + 4] : p[e], send = up ? p[e] : p[e + 4]; p[e] = keep + __shfl_xor(send, 16); }
#pragma unroll
            for (int e = 0; e < 2; ++e) { const bool up = lane & 8; const float keep = up ? p[e + 2] : p[e], send = up ? p[e] : p[e + 2]; p[e] = keep + __shfl_xor(send, 8); }
            { const bool up = lane & 4; const float keep = up ? p[1] : p[0], send = up ? p[0] : p[1]; p[0] = keep + __shfl_xor(send, 4); }
            float hsum = p[0]; hsum += __shfl_xor(hsum, 2); hsum += __shfl_xor(hsum, 1);
            const float cf = wgtL[ke] * gelu_exact(hsum * su) * sv;
            if ((lane & 3) == 0) coefL[ke] = cf;
        }
        asm volatile("s_waitcnt lgkmcnt(0)" ::: "memory");
        float y[16];
#pragma unroll
        for (int j = 0; j < 16; ++j) y[j] = 0.f;
#pragma unroll 1
        for (int kb = 0; kb < 8; ++kb) {
#pragma unroll
            for (int e = 0; e < 16; ++e) { const int id = eidL[kb * 16 + e]; const float cf = coefL[kb * 16 + e];
                const u32x4 a = *(const u32x4*)(VT + (size_t)id * D + lane * 16);
#pragma unroll
                for (int j = 0; j < 4; ++j) { const int aj = (int)a[j]; const f32x2 lo = __builtin_amdgcn_cvt_pk_f32_fp8(aj, false), hi = __builtin_amdgcn_cvt_pk_f32_fp8(aj, true);
                    y[4 * j] += cf * lo[0]; y[4 * j + 1] += cf * lo[1]; y[4 * j + 2] += cf * hi[0]; y[4 * j + 3] += cf * hi[1]; } }
        }
        const float* g2 = mod + (t >> 12) * NMOD + 5 * D; float* orow = A.out + (size_t)t * D;
        float z[16]; float ss = 0.f;
#pragma unroll
        for (int q = 0; q < 4; ++q) { const int k = lane * 16 + q * 4; const f32x4 xv = *(const f32x4*)(orow + k), gv = *(const f32x4*)(g2 + k);
#pragma unroll
            for (int j = 0; j < 4; ++j) { const float zz = xv[j] + gv[j] * y[q * 4 + j]; z[q * 4 + j] = zz; ss += zz * zz; } }
        const float r = rsqrtf(wave_sum(ss) * (1.f / D) + EPS);
#pragma unroll
        for (int q = 0; q < 4; ++q) { const int k = lane * 16 + q * 4; const f32x4 fv = *(const f32x4*)(A.fg + k);
            f32x4 o;
#pragma unroll
            for (int j = 0; j < 4; ++j) o[j] = z[q * 4 + j] * r * fv[j];
            if (!A.dry || r < 0.f) *(f32x4*)(orow + k) = o; }
    }
}
constexpr int N_PHASES = 10;
__global__ void __launch_bounds__(NWAVES * 64, 2) mega_fwd(Args A) {
    extern __shared__ __attribute__((aligned(16))) unsigned char lds[];
    LAS unsigned char* L = (LAS unsigned char*)lds;
    cg::grid_group grid = cg::this_grid();
    const int lo = A.ph_lo, hi = A.ph_hi, G = gridDim.x, c = blockIdx.x;
#ifndef PH_MASK
#define PH_MASK 0x3FF
#endif
#define IN(k) (((PH_MASK >> (k)) & 1) && lo <= (k) && (k) < hi)
#define SEAM(k) do { if (IN(k) && IN((k) + 1)) grid.sync(); } while (0)
    if (IN(0)) phase_prologue(A, L);
    SEAM(0);
    if (IN(1)) phase_hx(A);
    SEAM(1);
    if (IN(2)) { SchedInProj Sd{(const char*)(A.ws + WS_HX), (const char*)(A.ws + WS_HC), (const char*)(A.ws + WS_WIN), G, c}; EpiInProj E{A.ws};
        pg8::gemm_phase<EpiInProj, SchedInProj, true>(L, D, Sd, E); }
    SEAM(2);
    if (IN(3)) { if (!A.dry) phase_kfix(A); phase_conv(A, L); }
    SEAM(3);
    if (IN(4)) phase_attn(A, lds);
    SEAM(4);
    if (IN(5)) { SchedMerge Sd{(const char*)(A.ws + WS_Q), (const char*)(A.ws + WS_HX), (const char*)(A.ws + WS_WA), (const char*)(A.ws + WS_WC), G, c}; EpiMerge E{A.ws};
        pg8::gemm_phase<EpiMerge, SchedMerge, true>(L, D, Sd, E); }
    SEAM(5);
    if (IN(6)) { SchedPlain Sd{(const char*)(A.ws + WS_G), (const char*)(A.ws + WS_WO), M / 256, D / 256, G, c}; EpiOut E{A.x, (const float*)(A.ws + WS_MOD), A.out};
        pg8::gemm_phase<EpiOut, SchedPlain, true>(L, D, Sd, E); }
    SEAM(6);
    if (IN(7)) phase_hx2(A);
    SEAM(7);
    if (IN(8)) { SchedPlain Sd{(const char*)(A.ws + WS_HX), (const char*)(A.ws + WS_WP), M / 256, PW / 256, G, c}; EpiScores E{(float*)(A.ws + WS_SC)};
        pg8::gemm_phase<EpiScores, SchedPlain, true>(L, D, Sd, E); }
    SEAM(8);
    if (IN(9)) phase_peer(A, L);
#undef IN
#undef SEAM
}

#ifndef MK_ONE_LAUNCH
#define MK_ONE_LAUNCH 1
#endif
extern "C" void kernel_launch(void* const* d_in, const int* in_sizes, int n_in, void* d_out, int out_size, void* d_ws, size_t ws_size, hipStream_t stream) {
    static int grid = 0;
    if (grid == 0) {
        if (n_in != 23 || out_size != M * D || ws_size < WS_END) { fprintf(stderr, "kernel_launch: unexpected shapes (n_in %d out %d ws %zu)\n", n_in, out_size, ws_size); grid = -1; return; }
        int dev = 0, cus = 0, per_cu = 0;
        hipGetDevice(&dev); hipDeviceGetAttribute(&cus, hipDeviceAttributeMultiprocessorCount, dev);
        if (hipFuncSetAttribute((const void*)mega_fwd, hipFuncAttributeMaxDynamicSharedMemorySize, LDS_BYTES) != hipSuccess) { fprintf(stderr, "kernel_launch: hipFuncSetAttribute failed\n"); grid = -1; return; }
        if (hipOccupancyMaxActiveBlocksPerMultiprocessor(&per_cu, (const void*)mega_fwd, NWAVES * 64, LDS_BYTES) != hipSuccess || per_cu < 1) { fprintf(stderr, "kernel_launch: occupancy query says %d\n", per_cu); per_cu = 1; }
        (void)hipGetLastError();
        grid = cus * 1;
        if (per_cu < 1) grid = -1;
    }
    if (grid < 0) return;
    Args a{};
    const float** f = (const float**)&a;
    for (int i = 0; i < 23; ++i) f[i] = (const float*)d_in[i];
    a.out = (float*)d_out; a.ws = (unsigned char*)d_ws;
#if MK_ONE_LAUNCH
    a.ph_lo = 0; a.ph_hi = N_PHASES;
    void* args[] = {&a};
    hipError_t e = hipLaunchCooperativeKernel((const void*)mega_fwd, dim3(grid), dim3(NWAVES * 64), args, LDS_BYTES, stream);
    if (e != hipSuccess) fprintf(stderr, "cooperative launch failed: %s (grid %d)\n", hipGetErrorString(e), grid);
#else
#ifndef REPEAT_PH
#define REPEAT_PH -1
#endif
    for (int p = 0; p < N_PHASES; ++p) { a.ph_lo = p; a.ph_hi = p + 1;
        if (p == REPEAT_PH) { a.dry = 1; hipLaunchKernelGGL(mega_fwd, dim3(grid), dim3(NWAVES * 64), LDS_BYTES, stream, a); a.dry = 0; }
        hipLaunchKernelGGL(mega_fwd, dim3(grid), dim3(NWAVES * 64), LDS_BYTES, stream, a); }
#endif
}
```

```cpp
#include <hip/hip_runtime.h>
#include <hip/hip_cooperative_groups.h>
#include <cstdio>
#include <cstdint>
namespace cg = cooperative_groups;

#define LAS __attribute__((address_space(3)))
typedef unsigned short bf16_t;
typedef short bf16x8 __attribute__((ext_vector_type(8)));
typedef short s16x4 __attribute__((ext_vector_type(4)));
typedef float f32x2 __attribute__((ext_vector_type(2)));
typedef float f32x4 __attribute__((ext_vector_type(4)));
typedef float f32x16 __attribute__((ext_vector_type(16)));
typedef unsigned u32x2 __attribute__((ext_vector_type(2)));
typedef unsigned u32x4 __attribute__((ext_vector_type(4)));
typedef __bf16 bf16x2_t __attribute__((ext_vector_type(2)));

constexpr int D = 1024, NB = 8, S = 4096, CTXL = 256, SKV = S + CTXL, HD = 128, HQ = 8, HKV = 2;
constexpr int M = NB * S;
constexpr int MC = NB * CTXL;
constexpr int INW = 5632, NMOD = 6144, NEXP = 16384, PW = 2048;
constexpr float EPS = 1e-6f;

__device__ __forceinline__ unsigned cvt_pk_bf16(float lo, float hi) { f32x2 v = {lo, hi}; bf16x2_t b = __builtin_convertvector(v, bf16x2_t); return __builtin_bit_cast(unsigned, b); }
__device__ __forceinline__ float bf_lo(unsigned u) { return __uint_as_float(u << 16); }
__device__ __forceinline__ float bf_hi(unsigned u) { return __uint_as_float(u & 0xffff0000u); }
__device__ __forceinline__ float fast_sigmoid(float x) { return __builtin_amdgcn_rcpf(1.f + __builtin_amdgcn_exp2f(-1.4426950408889634f * x)); }
__device__ __forceinline__ float wave_sum(float v) {
#pragma unroll
    for (int o = 1; o < 64; o <<= 1) v += __shfl_xor(v, o);
    return v;
}

namespace pg8 {
constexpr int BM = 256, BK = 64, HALF = 128, HTB = HALF * BK * 2  , STAGE_BYTES = 8 * HTB, NXCD = 8, WGM = 8;
__host__ __device__ __forceinline__ int lds_byte(int r, int c) { const int st = (r >> 4) * 2 + (c >> 5), rr = r & 15, cc = c & 31, ob = rr * 64 + cc * 2; return st * 1024 + (ob ^ (((ob >> 9) & 1) << 5)); }
__host__ __device__ __forceinline__ void stage_rc(int b, int& R, int& C) { const int st = b / 1024, sb = b % 1024, swz = sb ^ (((sb >> 9) & 1) << 5); R = (st >> 1) * 16 + swz / 64; C = (st & 1) * 32 + (swz % 64) / 2; }
__host__ __device__ __forceinline__ int perm32(int rho) { const int n = rho >> 4, i = rho & 15; return 8 * (i >> 2) + 4 * n + (i & 3); }

struct Unit { const char* a; const char* b; int pm, pn, kind, keep; };

__device__ __forceinline__ void tile_of(int L, int nM, int nN, int& pm, int& pn) {
    const int nwg = nM * nN; int wgid = L;
    { const int q = nwg / NXCD, r = nwg % NXCD, xcd = wgid % NXCD, off = wgid / NXCD; wgid = (xcd < r ? xcd * (q + 1) : r * (q + 1) + (xcd - r) * q) + off; }
    const int nig = WGM * nN, gid = wgid / nig, fm = gid * WGM, gsz = (nM - fm) < WGM ? (nM - fm) : WGM;
    pm = fm + ((wgid % nig) % gsz); pn = (wgid % nig) / gsz;
}

template <class Epi, class Sched, bool ALIGN_EPI>
__device__ __forceinline__ void gemm_phase(LAS unsigned char* lds, const int K, const Sched& S, const Epi& E) {
    const int tid = threadIdx.x, wid = __builtin_amdgcn_readfirstlane(tid >> 6), lane = tid & 63, wr = wid >> 2, wc = wid & 3, fr = lane & 15, fq = lane >> 4;
    const int nt = K / BK;
    unsigned voffA[2], voffB[2];
#pragma unroll
    for (int i = 0; i < 2; ++i) { int R, C; stage_rc(tid * 16 + i * 8192, R, C); const int Rb = Epi::PERM ? ((R & ~31) + perm32(R & 31)) : R;
        voffA[i] = (unsigned)(R * K + C) * 2u; voffB[i] = (unsigned)(Rb * K + C) * 2u; }
    const size_t kstep = (size_t)(BK * 2);
    const size_t hstep = (size_t)HALF * K * 2;
    const unsigned ldsw = (unsigned)wid * 1024u;
    const int aoff = lds_byte(wr * 64 + fr, fq * 8), boff = lds_byte(wc * 32 + fr, fq * 8);
#define PG8_SA(b, h) (((b) * 2 + (h)) * HTB)
#define PG8_SB(b, h) ((4 + (b) * 2 + (h)) * HTB)
#define PG8_STAGE(bufoff, gbase, voff) do { _Pragma("unroll") for (int _i = 0; _i < 2; ++_i) \
        __builtin_amdgcn_global_load_lds((const unsigned*)((const char*)(gbase) + (voff)[_i]), (LAS unsigned*)(lds + (bufoff) + ldsw + _i * 8192), 16, 0, 0); } while (0)
#define PG8_LDA(dst, b, h) do { _Pragma("unroll") for (int m = 0; m < 4; ++m) _Pragma("unroll") for (int k = 0; k < 2; ++k) dst[m][k] = *(const LAS bf16x8*)(lds + PG8_SA(b, h) + aoff + m * 2048 + k * 1024); } while (0)
#define PG8_LDB(dst, b, h) do { _Pragma("unroll") for (int n = 0; n < 2; ++n) _Pragma("unroll") for (int k = 0; k < 2; ++k) dst[n][k] = *(const LAS bf16x8*)(lds + PG8_SB(b, h) + boff + n * 2048 + k * 1024); } while (0)
#define PG8_MMA(ai, bj, At, Bt) do { __builtin_amdgcn_s_setprio(1); _Pragma("unroll") for (int m = 0; m < 4; ++m) _Pragma("unroll") for (int n = 0; n < 2; ++n) _Pragma("unroll") for (int k = 0; k < 2; ++k) \
        acc[ai][bj][m][n] = __builtin_amdgcn_mfma_f32_16x16x32_bf16(Bt[n][k], At[m][k], acc[ai][bj][m][n], 0, 0, 0); __builtin_amdgcn_s_setprio(0); } while (0)
#define PG8_WAIT_V(n) asm volatile("s_waitcnt vmcnt(" #n ")" ::: "memory")
#define PG8_WAIT_L(n) asm volatile("s_waitcnt lgkmcnt(" #n ")" ::: "memory")
#define PG8_BAR __builtin_amdgcn_s_barrier()
#define PG8_SCHED __builtin_amdgcn_sched_barrier(0)
    Unit cur, nxt; int ui = 0;
    if (!S.next(0, cur)) return;
    f32x4 acc[2][2][4][2];
#pragma unroll
    for (int a = 0; a < 2; ++a)
#pragma unroll
        for (int b = 0; b < 2; ++b)
#pragma unroll
            for (int m = 0; m < 4; ++m)
#pragma unroll
                for (int n = 0; n < 2; ++n) acc[a][b][m][n] = (f32x4){0.f, 0.f, 0.f, 0.f};
    bf16x8 At[4][2], B0[2][2], B1[2][2];
    const char* cA = cur.a; const char* cB = cur.b;
    PG8_STAGE(PG8_SB(0, 0), cB, voffB); PG8_STAGE(PG8_SB(0, 1), cB + hstep, voffB); PG8_STAGE(PG8_SA(0, 0), cA, voffA); PG8_STAGE(PG8_SA(0, 1), cA + hstep, voffA);
    if (wr == 1) PG8_BAR;
    PG8_WAIT_V(2); PG8_BAR;
    PG8_STAGE(PG8_SB(1, 0), cB + kstep, voffB); PG8_STAGE(PG8_SA(1, 0), cA + kstep, voffA); PG8_STAGE(PG8_SB(1, 1), cB + hstep + kstep, voffB);
    PG8_WAIT_V(6); PG8_BAR;
    for (;;) {
        const bool has_next = S.next(ui + 1, nxt);
        const char* nA = has_next ? nxt.a : cA; const char* nB = has_next ? nxt.b : cB;
        for (int t = 0; t < nt; t += 2) {
            const bool last = (t == nt - 2);
            const char* a1 = cA + (size_t)(t + 1) * kstep;
            const char* a2 = last ? nA : cA + (size_t)(t + 2) * kstep; const char* b2 = last ? nB : cB + (size_t)(t + 2) * kstep;
            const char* a3 = a2 + kstep; const char* b3 = b2 + kstep;
            PG8_LDB(B0, 0, 0); PG8_LDB(B1, 0, 1); PG8_SCHED; PG8_LDA(At, 0, 0); PG8_STAGE(PG8_SA(1, 1), a1 + hstep, voffA);
            PG8_WAIT_V(8); PG8_WAIT_L(0); PG8_BAR; PG8_MMA(0, 0, At, B0); PG8_MMA(0, 1, At, B1); PG8_BAR; PG8_SCHED;
            PG8_LDA(At, 0, 1); PG8_STAGE(PG8_SB(0, 0), b2, voffB); PG8_STAGE(PG8_SB(0, 1), b2 + hstep, voffB); PG8_STAGE(PG8_SA(0, 0), a2, voffA);
            PG8_WAIT_V(8); PG8_WAIT_L(0); PG8_BAR; PG8_MMA(1, 0, At, B0); PG8_MMA(1, 1, At, B1); PG8_BAR; PG8_SCHED;
            PG8_LDB(B0, 1, 0); PG8_LDB(B1, 1, 1); PG8_SCHED; PG8_LDA(At, 1, 0); PG8_STAGE(PG8_SA(0, 1), a2 + hstep, voffA);
            PG8_WAIT_V(8); PG8_WAIT_L(0); PG8_BAR; PG8_MMA(0, 0, At, B0); PG8_MMA(0, 1, At, B1); PG8_BAR; PG8_SCHED;
            PG8_LDA(At, 1, 1); PG8_STAGE(PG8_SB(1, 0), b3, voffB); PG8_STAGE(PG8_SB(1, 1), b3 + hstep, voffB); PG8_STAGE(PG8_SA(1, 0), a3, voffA);
            PG8_WAIT_V(8); PG8_WAIT_L(0); PG8_BAR; PG8_MMA(1, 0, At, B0); PG8_MMA(1, 1, At, B1); PG8_BAR; PG8_SCHED;
        }
        if constexpr (ALIGN_EPI) { if (wr == 0) PG8_BAR; }
        E(acc, cur, wr, wc, fr, fq);
        if (!has_next) break;
        if (!cur.keep) {
#pragma unroll
        for (int a = 0; a < 2; ++a)
#pragma unroll
            for (int b = 0; b < 2; ++b)
#pragma unroll
                for (int m = 0; m < 4; ++m)
#pragma unroll
                    for (int n = 0; n < 2; ++n) acc[a][b][m][n] = (f32x4){0.f, 0.f, 0.f, 0.f};
        }
        cur = nxt; cA = nA; cB = nB; ++ui;
        if constexpr (ALIGN_EPI) { if (wr == 1) PG8_BAR; }
    }
    PG8_WAIT_V(0);
    if constexpr (!ALIGN_EPI) { if (wr == 0) PG8_BAR; }
    PG8_BAR;
#undef PG8_SA
#undef PG8_SB
#undef PG8_STAGE
#undef PG8_LDA
#undef PG8_LDB
#undef PG8_MMA
#undef PG8_WAIT_V
#undef PG8_WAIT_L
#undef PG8_BAR
#undef PG8_SCHED
}
}
namespace att {
constexpr int NW = 8, QBLK = 32, KVBLK = 64;
constexpr float SCALE = 0.088388347648318440f;
constexpr float THR = 8.f;
constexpr int LDQ = D, LDK = HKV * HD, LDO = D;
constexpr int SHM_V = KVBLK * HD * 2, SHM_K = KVBLK * HD * 2, SHM_ATTN = 2 * SHM_V + 2 * SHM_K + NW * 64 * 4;
constexpr int OST_OFF = SHM_ATTN, LDS_TOTAL = OST_OFF + NW * 8192;
#define KSWZ(row, colB) ((row) * 256 + ((colB) ^ (((row) & 7) << 4)))
#define SBAR() __builtin_amdgcn_sched_barrier(0)
__device__ __forceinline__ int crow(int r, int hi) { return (r & 3) + 8 * (r >> 2) + 4 * hi; }
__device__ __forceinline__ unsigned cvtpk(float lo, float hi) { unsigned r; asm volatile("v_cvt_pk_bf16_f32 %0, %1, %2" : "=v"(r) : "v"(lo), "v"(hi)); return r; }

__device__ __forceinline__ void partialSM(f32x16& p0, f32x16& p1, float& m_reg, float& mn, float& alpha) {
  constexpr float C = SCALE * 1.4426950408889634f;
  float pmax = p0[0]; for (int r = 1; r < 16; ++r) pmax = fmaxf(pmax, p0[r]); for (int r = 0; r < 16; ++r) pmax = fmaxf(pmax, p1[r]);
  { auto rr = __builtin_amdgcn_permlane32_swap(__float_as_uint(pmax), __float_as_uint(pmax), false, false);
    pmax = fmaxf(__uint_as_float(rr[0]), __uint_as_float(rr[1])); }
  if (__builtin_expect(__all(pmax - m_reg <= THR / SCALE), 1)) { mn = m_reg; alpha = 1.f; }
  else { mn = fmaxf(m_reg, pmax); alpha = __builtin_amdgcn_exp2f((m_reg - mn) * C); m_reg = mn; }
  float mnC = -mn * C;
  for (int r = 0; r < 16; ++r) p0[r] = fmaf(p0[r], C, mnC); for (int r = 0; r < 16; ++r) p1[r] = fmaf(p1[r], C, mnC);
  for (int r = 0; r < 16; ++r) p0[r] = __builtin_amdgcn_exp2f(p0[r]);
}
__device__ __forceinline__ void finishSM(f32x16& p0, f32x16& p1, float alpha, float& l_reg, bf16x8& pa0, bf16x8& pa1, bf16x8& pa2, bf16x8& pa3) {
  for (int r = 0; r < 16; ++r) p1[r] = __builtin_amdgcn_exp2f(p1[r]);
  float ps = 0; for (int r = 0; r < 16; ++r) ps += p0[r]; for (int r = 0; r < 16; ++r) ps += p1[r];
  { auto rr = __builtin_amdgcn_permlane32_swap(__float_as_uint(ps), __float_as_uint(ps), false, false);
    ps = __uint_as_float(rr[0]) + __uint_as_float(rr[1]); }
  l_reg = l_reg * alpha + ps;
#define PK4(P, BASE, OUT) do { unsigned a0 = cvtpk(P[BASE + 0], P[BASE + 1]), a1 = cvtpk(P[BASE + 2], P[BASE + 3]);   \
    unsigned b0 = cvtpk(P[BASE + 4], P[BASE + 5]), b1 = cvtpk(P[BASE + 6], P[BASE + 7]);                              \
    auto r0 = __builtin_amdgcn_permlane32_swap(a0, b0, false, false); auto r1 = __builtin_amdgcn_permlane32_swap(a1, b1, false, false); \
    u32x4 w = {r0[0], r1[0], r0[1], r1[1]}; OUT = *reinterpret_cast<bf16x8*>(&w); } while (0)
  PK4(p0, 0, pa0); PK4(p0, 8, pa1); PK4(p1, 0, pa2); PK4(p1, 8, pa3);
#undef PK4
}
__device__ __forceinline__ void qkt(f32x16& p0, f32x16& p1, const bf16_t* Ks, const bf16x8* qr, int r32, int hi) {
  p0 = f32x16{}; p1 = f32x16{};
  for (int d0 = 0; d0 < 8; ++d0) { int cb = (d0 * 16 + hi * 8) * 2;
    bf16x8 b0 = *reinterpret_cast<const bf16x8*>((const char*)Ks + KSWZ(r32, cb));
    bf16x8 b1 = *reinterpret_cast<const bf16x8*>((const char*)Ks + KSWZ(32 + r32, cb));
    p0 = __builtin_amdgcn_mfma_f32_32x32x16_bf16(b0, qr[d0], p0, 0, 0, 0);
    p1 = __builtin_amdgcn_mfma_f32_32x32x16_bf16(b1, qr[d0], p1, 0, 0, 0); }
}
__device__ __forceinline__ int v_st(int k, int c) { const int kk = (k & ~0xC) | ((k & 4) << 1) | ((k & 8) >> 1); return ((kk >> 3) * 4 + (c >> 5)) * 512 + ((kk & 7) * 32 + (c & 31)) * 2; }
__device__ __forceinline__ int v_rd_base(int lane) { return ((lane & 3) << 3) | (((lane >> 2) & 3) << 6) | (((lane >> 4) & 1) << 5) | (((lane >> 5) & 1) << 8); }
constexpr int v_rd_off(int d0, int ks, int half) { return d0 * 512 + ks * 4096 + half * 2048; }
template <int OFF> __device__ __forceinline__ s16x4 tr_read(int vb) {
  s16x4 r; asm volatile("ds_read_b64_tr_b16 %0, %1 offset:%2" : "=&v"(r) : "v"(vb), "i"(OFF) : "memory"); return r;
}
template <int D0> __device__ __forceinline__ void pv_one(f32x16& od, int vb, bf16x8 pa0, bf16x8 pa1, bf16x8 pa2, bf16x8 pa3) {
  const s16x4 l0 = tr_read<v_rd_off(D0, 0, 0)>(vb), h0 = tr_read<v_rd_off(D0, 0, 1)>(vb), l1 = tr_read<v_rd_off(D0, 1, 0)>(vb), h1 = tr_read<v_rd_off(D0, 1, 1)>(vb);
  const s16x4 l2 = tr_read<v_rd_off(D0, 2, 0)>(vb), h2 = tr_read<v_rd_off(D0, 2, 1)>(vb), l3 = tr_read<v_rd_off(D0, 3, 0)>(vb), h3 = tr_read<v_rd_off(D0, 3, 1)>(vb);
  asm volatile("s_waitcnt lgkmcnt(0)" ::: "memory"); SBAR();
#define PK(L, H) (bf16x8){L[0], L[1], L[2], L[3], H[0], H[1], H[2], H[3]}
  od = __builtin_amdgcn_mfma_f32_32x32x16_bf16(pa0, PK(l0, h0), od, 0, 0, 0);
  od = __builtin_amdgcn_mfma_f32_32x32x16_bf16(pa1, PK(l1, h1), od, 0, 0, 0);
  od = __builtin_amdgcn_mfma_f32_32x32x16_bf16(pa2, PK(l2, h2), od, 0, 0, 0);
  od = __builtin_amdgcn_mfma_f32_32x32x16_bf16(pa3, PK(l3, h3), od, 0, 0, 0);
#undef PK
}
__device__ __forceinline__ void pv_d0(f32x16* o, int vb, bf16x8 pa0, bf16x8 pa1, bf16x8 pa2, bf16x8 pa3) {
  pv_one<0>(o[0], vb, pa0, pa1, pa2, pa3); pv_one<1>(o[1], vb, pa0, pa1, pa2, pa3); pv_one<2>(o[2], vb, pa0, pa1, pa2, pa3); pv_one<3>(o[3], vb, pa0, pa1, pa2, pa3);
}

__device__ __forceinline__ void attn_unit(const bf16_t* Qb, const bf16_t* __restrict__ Kh, const bf16_t* __restrict__ Vh, bf16_t* Ob, int t0, int seq,
                                          const float* __restrict__ qng, const float* __restrict__ cst, const float* __restrict__ snt, char* lds) {
  int tid_ = threadIdx.x; asm volatile("" : "+v"(tid_));
  const int tid = tid_, wid = tid >> 6, lane = tid & 63, r32 = lane & 31, hi = lane >> 5;
  bf16_t* V_lds = (bf16_t*)lds; bf16_t* K_lds = (bf16_t*)(lds + 2 * SHM_V);
  float* ws = (float*)(lds + 2 * SHM_V + 2 * SHM_K) + wid * 64; float* li_l = ws; float* al_l = ws + 32;
  float m_reg = -1e30f, l_reg = 0; f32x16 o[4] = {}; bf16x8 qr[8];
  {
    const bf16_t* Qw = Qb + (long)(wid * QBLK + r32) * LDQ + hi * 8;
    float y[8][8]; float ss = 0.f;
#pragma unroll
    for (int d0 = 0; d0 < 8; ++d0) { const u32x4 w = *reinterpret_cast<const u32x4*>(Qw + d0 * 16);
#pragma unroll
      for (int j = 0; j < 4; ++j) { y[d0][2 * j] = bf_lo(w[j]); y[d0][2 * j + 1] = bf_hi(w[j]); ss += y[d0][2 * j] * y[d0][2 * j] + y[d0][2 * j + 1] * y[d0][2 * j + 1]; } }
    ss += __shfl_xor(ss, 32);
    const float rstd = rsqrtf(ss * (1.f / HD) + EPS);
#pragma unroll
    for (int d0 = 0; d0 < 8; ++d0) { const f32x4 g0 = *reinterpret_cast<const f32x4*>(qng + d0 * 16 + hi * 8), g1 = *reinterpret_cast<const f32x4*>(qng + d0 * 16 + hi * 8 + 4);
#pragma unroll
      for (int j = 0; j < 4; ++j) { y[d0][j] *= rstd * g0[j]; y[d0][4 + j] *= rstd * g1[j]; } }
    const int t = t0 + wid * QBLK + r32;
#pragma unroll
    for (int blk = 0; blk < 2; ++blk) { const int pos = blk == 0 ? (t >> 6) : (t & 63);
#pragma unroll
      for (int dd = 0; dd < 2; ++dd) { const int da = blk * 4 + dd, db = da + 2;
#pragma unroll
        for (int j4 = 0; j4 < 2; ++j4) { const f32x4 c4 = *reinterpret_cast<const f32x4*>(cst + pos * 32 + dd * 16 + hi * 8 + j4 * 4), s4 = *reinterpret_cast<const f32x4*>(snt + pos * 32 + dd * 16 + hi * 8 + j4 * 4);
#pragma unroll
          for (int j = 0; j < 4; ++j) { const float x1 = y[da][j4 * 4 + j], x2 = y[db][j4 * 4 + j]; y[da][j4 * 4 + j] = x1 * c4[j] - x2 * s4[j]; y[db][j4 * 4 + j] = x1 * s4[j] + x2 * c4[j]; } } } }
#pragma unroll
    for (int d0 = 0; d0 < 8; ++d0) { u32x4 w = {cvt_pk_bf16(y[d0][0], y[d0][1]), cvt_pk_bf16(y[d0][2], y[d0][3]), cvt_pk_bf16(y[d0][4], y[d0][5]), cvt_pk_bf16(y[d0][6], y[d0][7])}; qr[d0] = *reinterpret_cast<bf16x8*>(&w); }
  }
  const int sr = tid >> 4, sc = (tid & 15) * 8, vst0 = v_st(sr, sc), vst1 = v_st(32 + sr, sc);
  const int vb0 = (int)(uintptr_t)V_lds + v_rd_base(lane);
  struct { bf16x8 vs0, vs1, ks0, ks1; } sr_[2];
#define LD8(p) (*reinterpret_cast<const bf16x8*>(p))
#define SLOAD(i, k0) do { sr_[i].vs0 = LD8(&Vh[(long)((k0) + sr) * LDK + sc]); sr_[i].vs1 = LD8(&Vh[(long)((k0) + 32 + sr) * LDK + sc]); \
    sr_[i].ks0 = LD8(&Kh[(long)((k0) + sr) * LDK + sc]); sr_[i].ks1 = LD8(&Kh[(long)((k0) + 32 + sr) * LDK + sc]); } while (0)
#define SWRITE(b, i) do { *(bf16x8*)((char*)V_lds + (b) * SHM_V + vst0) = sr_[i].vs0;          \
    *(bf16x8*)((char*)V_lds + (b) * SHM_V + vst1) = sr_[i].vs1; int kc = sc * 2;               \
    *(bf16x8*)((char*)K_lds + (b) * SHM_K + KSWZ(sr, kc)) = sr_[i].ks0;                       \
    *(bf16x8*)((char*)K_lds + (b) * SHM_K + KSWZ(32 + sr, kc)) = sr_[i].ks1; } while (0)
#define SWAIT() asm volatile("s_waitcnt vmcnt(4)" ::: "memory")
#define RESC(a) do { if (__any((a) < 1.f)) { if (hi == 0) al_l[r32] = (a); asm volatile("s_waitcnt lgkmcnt(0)" ::: "memory"); \
    for (int d = 0; d < 4; ++d) for (int r = 0; r < 16; ++r) o[d][r] *= al_l[crow(r, hi)]; } } while (0)
  f32x16 pA0, pA1, pB0, pB1; float mnA, mnB, alA, alB; bf16x8 pa0, pa1, pa2, pa3; const int NT = seq / KVBLK;
  constexpr int SE = 0, SO = 1;
  SLOAD(SE, 0); asm volatile("s_waitcnt vmcnt(0)" ::: "memory"); SWRITE(0, SE); __syncthreads();
  qkt(pA0, pA1, K_lds, qr, r32, hi); partialSM(pA0, pA1, m_reg, mnA, alA);
  SLOAD(SO, KVBLK); if (2 < NT) SLOAD(SE, 2 * KVBLK);
  SWAIT(); SWRITE(1, SO); __syncthreads();
  for (int j = 1; j + 1 < NT; j += 2) {
    SBAR(); qkt(pB0, pB1, (bf16_t*)((char*)K_lds + SHM_K), qr, r32, hi);
    finishSM(pA0, pA1, alA, l_reg, pa0, pa1, pa2, pa3); SBAR();
    SLOAD(SO, (j + 2) * KVBLK); SBAR();
    pv_d0(o, vb0, pa0, pa1, pa2, pa3); partialSM(pB0, pB1, m_reg, mnB, alB);
    __syncthreads(); SWAIT(); SWRITE(0, SE);
    RESC(alB); __syncthreads();
    SBAR(); qkt(pA0, pA1, K_lds, qr, r32, hi);
    finishSM(pB0, pB1, alB, l_reg, pa0, pa1, pa2, pa3); SBAR();
    if (j + 3 < NT) SLOAD(SE, (j + 3) * KVBLK); SBAR();
    pv_d0(o, vb0 + (int)SHM_V, pa0, pa1, pa2, pa3); partialSM(pA0, pA1, m_reg, mnA, alA);
    __syncthreads(); SWAIT(); SWRITE(1, SO);
    RESC(alA); __syncthreads();
  }
  SBAR(); qkt(pB0, pB1, (bf16_t*)((char*)K_lds + SHM_K), qr, r32, hi);
  finishSM(pA0, pA1, alA, l_reg, pa0, pa1, pa2, pa3); SBAR();
  pv_d0(o, vb0, pa0, pa1, pa2, pa3); partialSM(pB0, pB1, m_reg, mnB, alB);
  __syncthreads(); RESC(alB);
  finishSM(pB0, pB1, alB, l_reg, pa0, pa1, pa2, pa3); SBAR();
  pv_d0(o, vb0 + (int)SHM_V, pa0, pa1, pa2, pa3);
  if (hi == 0) li_l[r32] = l_reg; asm volatile("s_waitcnt lgkmcnt(0)" ::: "memory");
  float rli[16];
#pragma unroll
  for (int r = 0; r < 16; ++r) rli[r] = __builtin_amdgcn_rcpf(li_l[crow(r, hi)]);
  { bf16_t* stg = (bf16_t*)(lds + OST_OFF) + wid * 4096;
#pragma unroll
    for (int r = 0; r < 16; ++r) { const int orow = crow(r, hi);
#pragma unroll
      for (int d0 = 0; d0 < 4; ++d0) stg[orow * 128 + d0 * 32 + r32] = (bf16_t)(cvt_pk_bf16(o[d0][r] * rli[r], 0.f) & 0xffffu); }
    asm volatile("s_waitcnt lgkmcnt(0)" ::: "memory");
    bf16_t* Ow = Ob + (long)(wid * QBLK) * LDO;
#pragma unroll
    for (int i = 0; i < 8; ++i) { const int row = i * 4 + (lane >> 4), ch = lane & 15; const u32x4 v = *(const u32x4*)(stg + row * 128 + ch * 8); *(u32x4*)(Ow + (long)row * LDO + ch * 8) = v; }
  }
#undef LD8
#undef SLOAD
#undef SWRITE
#undef SWAIT
#undef RESC
}
#undef KSWZ
#undef SBAR
}
constexpr size_t MiB = 1u << 20;
constexpr size_t WS_CTL = 0, CTL_ZERO_BYTES = 64 * 1024;
constexpr size_t WS_MOD = 1 * MiB;
constexpr size_t WS_ROPE = WS_MOD + 256 * 1024;
constexpr size_t WS_HC = 2 * MiB;
constexpr size_t WS_WIN = 6 * MiB;
constexpr size_t WS_WA = 17 * MiB, WS_WC = 19 * MiB, WS_WO = 21 * MiB;
constexpr size_t WS_WP = 23 * MiB;
constexpr size_t WS_UT = 27 * MiB, WS_VT = 59 * MiB;
constexpr size_t WS_TSCALE = 16 * MiB;
constexpr size_t WS_KB = 91 * MiB, WS_VB = 108 * MiB;
constexpr size_t WS_HX = 125 * MiB;
constexpr size_t WS_Q = 189 * MiB;
constexpr size_t WS_G = 253 * MiB;
constexpr size_t WS_RT = 317 * MiB;
constexpr size_t WS_SGC = 381 * MiB;
constexpr size_t WS_SC = 189 * MiB;
constexpr size_t WS_END = 445 * MiB;

constexpr int NWAVES = 8;
constexpr int LDS_BYTES = 147456;

struct Args {
    const float *x, *c, *ctx, *c_ctx, *w_mod, *b_mod, *n1g, *n2g, *w_in, *qng, *kng, *w_ao, *cdw, *cb, *clg, *clb, *w_co, *w_o, *wq, *keys, *ut, *vt, *fg;
    float* out; unsigned char* ws; int ph_lo, ph_hi, dry, pad;
};

__host__ __device__ __forceinline__ int win_row(int n) {
    if (n < 1536) return n;
    const int base = n < 3584 ? 1536 : 3584, m = n - base, half = m >> 10, idx = m & 1023;
    return base + (idx >> 7) * 256 + half * 128 + (idx & 127);
}

__device__ __forceinline__ void task_mod(const Args& A, int task, int lane, const LAS float* sc) {
    const int n0 = task * 8, col = lane & 7, kg = lane >> 3;
    float acc[9];
#pragma unroll
    for (int b = 0; b < 9; ++b) acc[b] = 0.f;
    const float* wp = A.w_mod + (size_t)kg * NMOD + n0 + col;
    for (int i0 = 0; i0 < 128; i0 += 8) {
        float w[8];
#pragma unroll
        for (int u = 0; u < 8; ++u) w[u] = wp[(size_t)(i0 + u) * 8 * NMOD];
#pragma unroll
        for (int u = 0; u < 8; ++u) { const int k = kg + 8 * (i0 + u);
#pragma unroll
            for (int b = 0; b < 9; ++b) acc[b] += sc[b * D + k] * w[u]; }
    }
#pragma unroll
    for (int b = 0; b < 9; ++b) { float v = acc[b]; v += __shfl_xor(v, 8); v += __shfl_xor(v, 16); v += __shfl_xor(v, 32); acc[b] = v; }
    if (lane < 8) { float* mod = (float*)(A.ws + WS_MOD); const float bm = A.b_mod[n0 + col];
#pragma unroll
        for (int b = 0; b < 9; ++b) mod[b * NMOD + n0 + col] = acc[b] + bm; }
}
__device__ __forceinline__ void task_transpose(const float* W, int K, int N, bf16_t* WT, int k0, int n0, int row0, LAS float* scr, int lane) {
#pragma unroll 8
    for (int i = 0; i < 32; ++i) { const int kk = 2 * i + (lane >> 5); scr[kk * 33 + (lane & 31)] = W[(size_t)(k0 + kk) * N + n0 + (lane & 31)]; }
    asm volatile("s_waitcnt lgkmcnt(0)" ::: "memory");
    const int c = lane & 7;
#pragma unroll
    for (int j = 0; j < 4; ++j) { const int n = (lane >> 3) + 8 * j; const LAS float* s = scr + (8 * c) * 33 + n;
        u32x4 o; o.x = cvt_pk_bf16(s[0 * 33], s[1 * 33]); o.y = cvt_pk_bf16(s[2 * 33], s[3 * 33]); o.z = cvt_pk_bf16(s[4 * 33], s[5 * 33]); o.w = cvt_pk_bf16(s[6 * 33], s[7 * 33]);
        *(u32x4*)(WT + (size_t)(row0 + n) * K + k0 + 8 * c) = o; }
    asm volatile("s_waitcnt lgkmcnt(0)" ::: "memory");
}
__device__ __forceinline__ void task_quant_row(const float* src, unsigned char* dst, float* scale_out, int lane) {
    f32x4 v[4]; float am = 0.f;
#pragma unroll
    for (int i = 0; i < 4; ++i) { v[i] = *(const f32x4*)(src + (i * 64 + lane) * 4); am = fmaxf(fmaxf(am, fmaxf(fabsf(v[i][0]), fabsf(v[i][1]))), fmaxf(fabsf(v[i][2]), fabsf(v[i][3]))); }
#pragma unroll
    for (int o = 1; o < 64; o <<= 1) am = fmaxf(am, __shfl_xor(am, o));
    const float inv = am > 0.f ? 448.f / am : 0.f;
#pragma unroll
    for (int i = 0; i < 4; ++i) { int p = __builtin_amdgcn_cvt_pk_fp8_f32(v[i][0] * inv, v[i][1] * inv, 0, false); p = __builtin_amdgcn_cvt_pk_fp8_f32(v[i][2] * inv, v[i][3] * inv, p, true);
        *(int*)(dst + (i * 64 + lane) * 4) = p; }
    if (lane == 0) *scale_out = am * (1.f / 448.f);
}
__device__ __forceinline__ bf16x8 ld8_f32_bf16(const float* p) { const f32x4 a = *(const f32x4*)p, b = *(const f32x4*)(p + 4); u32x4 w = {cvt_pk_bf16(a[0], a[1]), cvt_pk_bf16(a[2], a[3]), cvt_pk_bf16(b[0], b[1]), cvt_pk_bf16(b[2], b[3])}; return *reinterpret_cast<bf16x8*>(&w); }
__device__ __forceinline__ void task_wprime(const Args& A, int id, int lane) {
    const int hp = id >> 7, rem = id & 127, n0 = (rem >> 5) * 32, k0 = (rem & 31) * 32, r32 = lane & 31, hi = lane >> 5;
    f32x16 acc = {};
    const float* ka = A.keys + ((size_t)(hp * 128 + n0 + r32)) * 128 + hi * 8;
    const float* wb = A.wq + (size_t)(k0 + r32) * PW + hp * 128 + hi * 8;
#pragma unroll
    for (int s = 0; s < 8; ++s) acc = __builtin_amdgcn_mfma_f32_32x32x16_bf16(ld8_f32_bf16(ka + s * 16), ld8_f32_bf16(wb + s * 16), acc, 0, 0, 0);
    bf16_t* o = (bf16_t*)(A.ws + WS_WP);
#pragma unroll
    for (int r = 0; r < 16; ++r) { const int n = (r & 3) + 8 * (r >> 2) + 4 * hi; o[(size_t)(hp * 128 + n0 + n) * D + k0 + r32] = (bf16_t)(cvt_pk_bf16(acc[r], 0.f) & 0xffffu); }
}
__device__ __forceinline__ void phase_prologue(const Args& A, LAS unsigned char* lds) {
    const int tid = threadIdx.x, lane = tid & 63, wave = __builtin_amdgcn_readfirstlane(tid >> 6);
    LAS float* sc = (LAS float*)lds;
    for (int i = tid; i < 9 * D; i += 512) { const float v = i < 8 * D ? A.c[i] : A.c_ctx[i - 8 * D]; sc[i] = v / (1.f + __expf(-v)); }
    __syncthreads();
    LAS float* scr = (LAS float*)(lds + 36864 + wave * 8448);
    constexpr int T_MOD = NMOD / 8, T_WIN = (D / 64) * (INW / 32), T_SQ = (D / 64) * (D / 32), T_UV = 2 * NEXP, T_WP = 2048, T_ROPE = 1;
    constexpr int NT = T_MOD + T_WIN + 3 * T_SQ + T_UV + T_WP + T_ROPE;
    const int G = gridDim.x;
    for (int task = wave * G + blockIdx.x; task < NT; task += NWAVES * G) {
        int r = task;
        if (r < T_MOD) { task_mod(A, r, lane, sc); continue; } r -= T_MOD;
        if (r < T_WIN) { const int nblk = INW / 32, kb = r / nblk, nb = r % nblk; task_transpose(A.w_in, D, INW, (bf16_t*)(A.ws + WS_WIN), 64 * kb, 32 * nb, win_row(32 * nb), scr, lane); continue; } r -= T_WIN;
        if (r < 3 * T_SQ) { const int wsel = r / T_SQ, q = r % T_SQ, kb = q / 32, nb = q % 32;
            const float* W = wsel == 0 ? A.w_ao : (wsel == 1 ? A.w_co : A.w_o); bf16_t* WT = (bf16_t*)(A.ws + (wsel == 0 ? WS_WA : (wsel == 1 ? WS_WC : WS_WO)));
            task_transpose(W, D, D, WT, 64 * kb, 32 * nb, 32 * nb, scr, lane); continue; } r -= 3 * T_SQ;
        if (r < T_UV) { const int tb = r / NEXP, row = r % NEXP; unsigned char* tbase = A.ws + (tb ? WS_VT : WS_UT);
            task_quant_row((tb ? A.vt : A.ut) + (size_t)row * D, tbase + (size_t)row * D, (float*)(tbase + WS_TSCALE) + row, lane); continue; } r -= T_UV;
        if (r < T_WP) { task_wprime(A, r, lane); continue; } r -= T_WP;
        { float* cs = (float*)(A.ws + WS_ROPE); float* sn = cs + 2048;
          for (int e = lane; e < 2048; e += 64) { const int p = e >> 5, i = e & 31; const float inv = powf(10000.f, -(float)(2 * i) / 64.f); const float a = (float)p * inv; cs[e] = cosf(a); sn[e] = sinf(a); } }
    }
}
__device__ __forceinline__ void normmod_row(const float* xr, const float* g, const float* modr, int sh_off, int sc_off, bf16_t* orow, int lane) {
    f32x4 v[4]; float ss = 0.f;
#pragma unroll
    for (int i = 0; i < 4; ++i) { v[i] = *(const f32x4*)(xr + (i * 64 + lane) * 4); ss += (v[i][0] * v[i][0] + v[i][1] * v[i][1]) + (v[i][2] * v[i][2] + v[i][3] * v[i][3]); }
    const float r = rsqrtf(wave_sum(ss) * (1.f / D) + EPS);
#pragma unroll
    for (int i = 0; i < 4; ++i) { const int k = (i * 64 + lane) * 4; const f32x4 gg = *(const f32x4*)(g + k), s1 = *(const f32x4*)(modr + sc_off + k), h1 = *(const f32x4*)(modr + sh_off + k);
        float y[4];
#pragma unroll
        for (int j = 0; j < 4; ++j) y[j] = v[i][j] * r * gg[j] * (1.f + s1[j]) + h1[j];
        u32x2 o = {cvt_pk_bf16(y[0], y[1]), cvt_pk_bf16(y[2], y[3])}; *(u32x2*)(orow + k) = o; }
}
__device__ __forceinline__ void phase_hx(const Args& A) {
    const int lane = threadIdx.x & 63, gw = blockIdx.x * NWAVES + (threadIdx.x >> 6), NGW = gridDim.x * NWAVES;
    const float* mod = (const float*)(A.ws + WS_MOD);
    for (int m = gw; m < M + MC; m += NGW) {
        if (m < M) normmod_row(A.x + (size_t)m * D, A.n1g, mod + (m >> 12) * NMOD, 0, D, (bf16_t*)(A.ws + WS_HX) + (size_t)m * D, lane);
        else { const int r = m - M; normmod_row(A.ctx + (size_t)r * D, A.n1g, mod + 8 * NMOD, 0, D, (bf16_t*)(A.ws + WS_HC) + (size_t)r * D, lane); }
    }
}
__device__ __forceinline__ void phase_hx2(const Args& A) {
    const int lane = threadIdx.x & 63, gw = blockIdx.x * NWAVES + (threadIdx.x >> 6), NGW = gridDim.x * NWAVES;
    const float* mod = (const float*)(A.ws + WS_MOD);
    for (int m = gw; m < M; m += NGW) normmod_row(A.out + (size_t)m * D, A.n2g, mod + (m >> 12) * NMOD, 3 * D, 4 * D, (bf16_t*)(A.ws + WS_HX) + (size_t)m * D, lane);
}
__device__ __forceinline__ void phase_kfix(const Args& A) {
    const int lane = threadIdx.x & 63, gw = blockIdx.x * NWAVES + (threadIdx.x >> 6), NGW = gridDim.x * NWAVES, li = lane & 15, sub = lane >> 4;
    bf16_t* KB = (bf16_t*)(A.ws + WS_KB); const float* cs = (const float*)(A.ws + WS_ROPE); const float* sn = cs + 2048;
    constexpr int NITEM = NB * SKV * HKV;
    const f32x4 g0 = *(const f32x4*)(A.kng + li * 8), g1 = *(const f32x4*)(A.kng + li * 8 + 4);
    const f32x4 p0 = *(const f32x4*)(A.kng + (li ^ 4) * 8), p1 = *(const f32x4*)(A.kng + (li ^ 4) * 8 + 4);
    for (int it = gw * 4 + sub; it < NITEM; it += NGW * 4) {
        const int row = it >> 1, h = it & 1, t = row % SKV;
        bf16_t* p = KB + (size_t)row * 256 + h * HD + li * 8;
        const u32x4 w = *(const u32x4*)p;
        float x[8], xp[8]; float ss = 0.f;
#pragma unroll
        for (int j = 0; j < 4; ++j) { x[2 * j] = bf_lo(w[j]); x[2 * j + 1] = bf_hi(w[j]); ss += x[2 * j] * x[2 * j] + x[2 * j + 1] * x[2 * j + 1];
            const unsigned pw = (unsigned)__shfl_xor((int)w[j], 4); xp[2 * j] = bf_lo(pw); xp[2 * j + 1] = bf_hi(pw); }
        ss += __shfl_xor(ss, 1); ss += __shfl_xor(ss, 2); ss += __shfl_xor(ss, 4); ss += __shfl_xor(ss, 8);
        const float r = rsqrtf(ss * (1.f / HD) + EPS);
        float y[8];
#pragma unroll
        for (int j = 0; j < 8; ++j) { x[j] *= r * (j < 4 ? g0[j] : g1[j - 4]); xp[j] *= r * (j < 4 ? p0[j] : p1[j - 4]); y[j] = x[j]; }
        if (t < S) {
            const int blk = li >> 3, pos = blk == 0 ? (t >> 6) : (t & 63), second = (li >> 2) & 1, i0 = (li & 3) * 8;
            const f32x4 c0 = *(const f32x4*)(cs + pos * 32 + i0), c1 = *(const f32x4*)(cs + pos * 32 + i0 + 4), s0 = *(const f32x4*)(sn + pos * 32 + i0), s1 = *(const f32x4*)(sn + pos * 32 + i0 + 4);
#pragma unroll
            for (int j = 0; j < 8; ++j) { const float c = j < 4 ? c0[j] : c1[j - 4], s = j < 4 ? s0[j] : s1[j - 4];
                y[j] = second ? (xp[j] * s + x[j] * c) : (x[j] * c - xp[j] * s); }
        }
        u32x4 o = {cvt_pk_bf16(y[0], y[1]), cvt_pk_bf16(y[2], y[3]), cvt_pk_bf16(y[4], y[5]), cvt_pk_bf16(y[6], y[7])};
        *(u32x4*)p = o;
    }
}
template <int R> struct ConvRow {
    static __device__ __forceinline__ void run(const unsigned* gp, int tl0, float (&acc)[32][2], const float (&w)[31][2]) {
        const int tl = tl0 + R - 15;
        unsigned v = 0u; if (tl >= 0 && tl < S) v = gp[(long)(R - 15) * (D / 2)];
        const float a = bf_lo(v), b = bf_hi(v);
#pragma unroll
        for (int t = (R - 30 > 0 ? R - 30 : 0); t <= (R < 31 ? R : 31); ++t) { acc[t][0] += w[R - t][0] * a; acc[t][1] += w[R - t][1] * b; }
        if constexpr (R + 1 < 62) ConvRow<R + 1>::run(gp, tl0, acc, w);
    }
};
__device__ __forceinline__ void phase_conv(const Args& A, LAS unsigned char* lds) {
    const int tid = threadIdx.x, lane = tid & 63, wave = tid >> 6;
    LAS float* tile = (LAS float*)lds;
    const bf16_t* G = (const bf16_t*)(A.ws + WS_G); bf16_t* CV = (bf16_t*)(A.ws + WS_HX);
    float w[31][2];
#pragma unroll
    for (int j = 0; j < 31; ++j) { const f32x2 t = *(const f32x2*)(A.cdw + j * D + 2 * tid); w[j][0] = t[0]; w[j][1] = t[1]; }
    const f32x2 bias = *(const f32x2*)(A.cb + 2 * tid);
    for (int tileid = blockIdx.x; tileid < M / 32; tileid += gridDim.x) {
        const int row0 = tileid * 32, tl0 = row0 & (S - 1);
        float acc[32][2];
#pragma unroll
        for (int t = 0; t < 32; ++t) { acc[t][0] = bias[0]; acc[t][1] = bias[1]; }
        ConvRow<0>::run((const unsigned*)(G + (size_t)row0 * D) + tid, tl0, acc, w);
        __syncthreads();
#pragma unroll
        for (int t = 0; t < 32; ++t) *(LAS f32x2*)(tile + t * D + 2 * tid) = (f32x2){acc[t][0], acc[t][1]};
        __syncthreads();
#pragma unroll
        for (int q = 0; q < 4; ++q) { const int t = wave * 4 + q; const LAS float* tr = tile + t * D;
            f32x4 v[4]; float s = 0.f;
#pragma unroll
            for (int i = 0; i < 4; ++i) { v[i] = *(const LAS f32x4*)(tr + (i * 64 + lane) * 4); s += (v[i][0] + v[i][1]) + (v[i][2] + v[i][3]); }
            const float mu = wave_sum(s) * (1.f / D); float qq = 0.f;
#pragma unroll
            for (int i = 0; i < 4; ++i) { v[i] = v[i] - mu; qq += (v[i][0] * v[i][0] + v[i][1] * v[i][1]) + (v[i][2] * v[i][2] + v[i][3] * v[i][3]); }
            const float rs = rsqrtf(wave_sum(qq) * (1.f / D) + EPS);
#pragma unroll
            for (int i = 0; i < 4; ++i) { const int k = (i * 64 + lane) * 4; const f32x4 gg = *(const f32x4*)(A.clg + k), bb = *(const f32x4*)(A.clb + k); float y[4];
#pragma unroll
                for (int j = 0; j < 4; ++j) { const float z = v[i][j] * rs * gg[j] + bb[j]; y[j] = z * fast_sigmoid(z); }
                u32x2 o = {cvt_pk_bf16(y[0], y[1]), cvt_pk_bf16(y[2], y[3])}; *(u32x2*)(CV + (size_t)(row0 + t) * D + k) = o; }
        }
    }
}
struct EpiInProj {
    static constexpr bool PERM = true;
    unsigned char* ws;
    __device__ __forceinline__ void operator()(f32x4 (&acc)[2][2][4][2], const pg8::Unit& u, int wr, int wc, int fr, int fq) const {
        const int c8 = wc * 32 + 8 * fq;
#pragma unroll
        for (int ai = 0; ai < 2; ++ai)
#pragma unroll
            for (int m = 0; m < 4; ++m) {
                const int row = u.pm * 256 + ai * 128 + wr * 64 + m * 16 + fr;
                if (u.kind == 0) {
                    bf16_t* p = (bf16_t*)(ws + WS_Q) + (size_t)row * D + u.pn * 256 + c8;
#pragma unroll
                    for (int bj = 0; bj < 2; ++bj) { const f32x4 v0 = acc[ai][bj][m][0], v1 = acc[ai][bj][m][1];
                        u32x4 w = {cvt_pk_bf16(v0[0], v0[1]), cvt_pk_bf16(v0[2], v0[3]), cvt_pk_bf16(v1[0], v1[1]), cvt_pk_bf16(v1[2], v1[3])}; *(u32x4*)(p + bj * 128) = w; }
                } else if (u.kind == 1 || u.kind == 2 || u.kind == 5 || u.kind == 6) {
                    const bool ctxu = u.kind >= 5;
                    const int kvrow = ctxu ? (row >> 8) * SKV + S + (row & 255) : (row >> 12) * SKV + (row & (S - 1));
                    bf16_t* p = (bf16_t*)(ws + ((u.kind == 1 || u.kind == 5) ? WS_KB : WS_VB)) + (size_t)kvrow * 256 + c8;
#pragma unroll
                    for (int bj = 0; bj < 2; ++bj) { const f32x4 v0 = acc[ai][bj][m][0], v1 = acc[ai][bj][m][1];
                        u32x4 w = {cvt_pk_bf16(v0[0], v0[1]), cvt_pk_bf16(v0[2], v0[3]), cvt_pk_bf16(v1[0], v1[1]), cvt_pk_bf16(v1[2], v1[3])}; *(u32x4*)(p + bj * 128) = w; }
                } else if (u.kind == 3) {
                    float g[8];
#pragma unroll
                    for (int n = 0; n < 2; ++n)
#pragma unroll
                        for (int j = 0; j < 4; ++j) g[4 * n + j] = acc[ai][0][m][n][j] * fast_sigmoid(acc[ai][1][m][n][j]);
                    u32x4 w = {cvt_pk_bf16(g[0], g[1]), cvt_pk_bf16(g[2], g[3]), cvt_pk_bf16(g[4], g[5]), cvt_pk_bf16(g[6], g[7])};
                    *(u32x4*)((bf16_t*)(ws + WS_G) + (size_t)row * D + (u.pn - 6) * 128 + c8) = w;
                } else {
                    float rt[8], sg[8];
#pragma unroll
                    for (int n = 0; n < 2; ++n)
#pragma unroll
                        for (int j = 0; j < 4; ++j) { const float ea = __builtin_amdgcn_exp2f(-1.4426950408889634f * acc[ai][0][m][n][j]), ec = __builtin_amdgcn_exp2f(-1.4426950408889634f * acc[ai][1][m][n][j]);
                            sg[4 * n + j] = __builtin_amdgcn_rcpf(1.f + ec); rt[4 * n + j] = (1.f + ec) * __builtin_amdgcn_rcpf(1.f + ea); }
                    const size_t off = (size_t)row * D + (u.pn - 14) * 128 + c8;
                    u32x4 w = {cvt_pk_bf16(rt[0], rt[1]), cvt_pk_bf16(rt[2], rt[3]), cvt_pk_bf16(rt[4], rt[5]), cvt_pk_bf16(rt[6], rt[7])}; *(u32x4*)((bf16_t*)(ws + WS_RT) + off) = w;
                    u32x4 w2 = {cvt_pk_bf16(sg[0], sg[1]), cvt_pk_bf16(sg[2], sg[3]), cvt_pk_bf16(sg[4], sg[5]), cvt_pk_bf16(sg[6], sg[7])}; *(u32x4*)((bf16_t*)(ws + WS_SGC) + off) = w2;
                }
            }
    }
};
struct SchedInProj {
    const char* hx; const char* hc; const char* w; int G, c;
    __device__ __forceinline__ bool next(int i, pg8::Unit& u) const {
        constexpr int nM = M / 256, nN = INW / 256, NMAIN = nM * nN, NCTX = (MC / 256) * 2;
        const int L = i * G + c; if (L >= NMAIN + NCTX) return false;
        if (L < NMAIN) { pg8::tile_of(L, nM, nN, u.pm, u.pn); u.a = hx + (size_t)u.pm * 256 * D * 2; u.kind = u.pn < 4 ? 0 : (u.pn == 4 ? 1 : (u.pn == 5 ? 2 : (u.pn < 14 ? 3 : 4))); }
        else { const int j = L - NMAIN; u.pm = j >> 1; u.pn = 4 + (j & 1); u.a = hc + (size_t)u.pm * 256 * D * 2; u.kind = 5 + (j & 1); }
        u.b = w + (size_t)u.pn * 256 * D * 2; u.keep = 0; return true;
    }
};
struct EpiMerge {
    static constexpr bool PERM = true;
    unsigned char* ws;
    __device__ __forceinline__ void operator()(f32x4 (&acc)[2][2][4][2], const pg8::Unit& u, int wr, int wc, int fr, int fq) const {
        const int c8 = u.pn * 256 + wc * 32 + 8 * fq;
        const bf16_t* F = (const bf16_t*)(ws + (u.kind == 0 ? WS_RT : WS_SGC));
#pragma unroll
        for (int ai = 0; ai < 2; ++ai)
#pragma unroll
            for (int m = 0; m < 4; ++m) { const size_t off = (size_t)(u.pm * 256 + ai * 128 + wr * 64 + m * 16 + fr) * D + c8;
#pragma unroll
                for (int bj = 0; bj < 2; ++bj) { const u32x4 f = *(const u32x4*)(F + off + bj * 128);
                    f32x4 v0 = acc[ai][bj][m][0], v1 = acc[ai][bj][m][1];
                    v0[0] *= bf_lo(f[0]); v0[1] *= bf_hi(f[0]); v0[2] *= bf_lo(f[1]); v0[3] *= bf_hi(f[1]); v1[0] *= bf_lo(f[2]); v1[1] *= bf_hi(f[2]); v1[2] *= bf_lo(f[3]); v1[3] *= bf_hi(f[3]);
                    if (u.kind == 0) { acc[ai][bj][m][0] = v0; acc[ai][bj][m][1] = v1; }
                    else { u32x4 w = {cvt_pk_bf16(v0[0], v0[1]), cvt_pk_bf16(v0[2], v0[3]), cvt_pk_bf16(v1[0], v1[1]), cvt_pk_bf16(v1[2], v1[3])}; *(u32x4*)((bf16_t*)(ws + WS_G) + off + bj * 128) = w; } } }
    }
};
struct SchedMerge {
    const char* att; const char* cv; const char* wa; const char* wc; int G, c;
    __device__ __forceinline__ bool next(int i, pg8::Unit& u) const {
        constexpr int nM = M / 256, nN = D / 256;
        const int L = (i >> 1) * G + c, sub = i & 1; if (L >= nM * nN) return false;
        pg8::tile_of(L, nM, nN, u.pm, u.pn);
        u.a = (sub ? cv : att) + (size_t)u.pm * 256 * D * 2; u.b = (sub ? wc : wa) + (size_t)u.pn * 256 * D * 2; u.kind = sub; u.keep = sub ^ 1; return true;
    }
};
struct SchedPlain {
    const char* a; const char* b; int nM, nN, G, c;
    __device__ __forceinline__ bool next(int i, pg8::Unit& u) const {
        const int L = i * G + c; if (L >= nM * nN) return false;
        pg8::tile_of(L, nM, nN, u.pm, u.pn); u.a = a + (size_t)u.pm * 256 * D * 2; u.b = b + (size_t)u.pn * 256 * D * 2; u.kind = 0; u.keep = 0; return true;
    }
};
struct EpiOut {
    static constexpr bool PERM = false;
    const float* x; const float* mod; float* xs;
    __device__ __forceinline__ void operator()(f32x4 (&acc)[2][2][4][2], const pg8::Unit& u, int wr, int wc, int fr, int fq) const {
        const int col0 = u.pn * 256 + wc * 32 + 4 * fq; const float* g1 = mod + ((u.pm * 256) >> 12) * NMOD + 2 * D;
        f32x4 gv[2][2];
#pragma unroll
        for (int bj = 0; bj < 2; ++bj)
#pragma unroll
            for (int n = 0; n < 2; ++n) gv[bj][n] = *(const f32x4*)(g1 + col0 + bj * 128 + n * 16);
#pragma unroll
        for (int ai = 0; ai < 2; ++ai)
#pragma unroll
            for (int m = 0; m < 4; ++m) { const size_t off = (size_t)(u.pm * 256 + ai * 128 + wr * 64 + m * 16 + fr) * D + col0;
#pragma unroll
                for (int bj = 0; bj < 2; ++bj)
#pragma unroll
                    for (int n = 0; n < 2; ++n) { const f32x4 xv = *(const f32x4*)(x + off + bj * 128 + n * 16); *(f32x4*)(xs + off + bj * 128 + n * 16) = xv + gv[bj][n] * acc[ai][bj][m][n]; } }
    }
};
struct EpiScores {
    static constexpr bool PERM = false;
    float* sc;
    __device__ __forceinline__ void operator()(f32x4 (&acc)[2][2][4][2], const pg8::Unit& u, int wr, int wc, int fr, int fq) const {
#pragma unroll
        for (int ai = 0; ai < 2; ++ai)
#pragma unroll
            for (int m = 0; m < 4; ++m) { const int row = u.pm * 256 + ai * 128 + wr * 64 + m * 16 + fr; float* p = sc + (size_t)(row >> 2) * 8192 + (row & 3) * 4;
#pragma unroll
                for (int bj = 0; bj < 2; ++bj)
#pragma unroll
                    for (int n = 0; n < 2; ++n) { const int grp = u.pn * 2 + bj, nq = wc * 8 + n * 4 + fq; *(f32x4*)(p + (grp * 32 + nq) * 16) = acc[ai][bj][m][n]; } }
    }
};

__device__ __forceinline__ void phase_attn(const Args& A, unsigned char* lds) {
    const int G = gridDim.x, X = blockIdx.x & 7, j = blockIdx.x >> 3, perx = G >> 3;
    bf16_t* Q = (bf16_t*)(A.ws + WS_Q); const bf16_t* KB = (const bf16_t*)(A.ws + WS_KB); const bf16_t* VB = (const bf16_t*)(A.ws + WS_VB);
    const float* cs = (const float*)(A.ws + WS_ROPE); const float* sn = cs + 2048;
    for (int idx = j; idx < 128; idx += perx) {
        const int grp = 2 * X + (idx >> 6), uu = idx & 63, b = grp >> 1, kv = grp & 1, h = kv * 4 + (uu >> 4), qb = uu & 15;
        bf16_t* qp = Q + ((size_t)b * S + qb * 256) * D + h * HD;
        bf16_t* op = A.dry ? (bf16_t*)(A.ws + ((size_t)445 << 20)) + ((size_t)b * S + qb * 256) * D + h * HD : qp;
        att::attn_unit(qp, KB + (size_t)b * SKV * 256 + kv * HD, VB + (size_t)b * SKV * 256 + kv * HD, op, qb * 256, SKV, A.qng, cs, sn, (char*)lds);
    }
}

__device__ __forceinline__ float gelu_exact(float v) { return 0.5f * v * (1.f + erff(v * 0.70710678118654752f)); }
__device__ __forceinline__ void ins16(float (&t)[16], float v) {
#pragma unroll
    for (int i = 15; i >= 1; --i) t[i] = __builtin_amdgcn_fmed3f(t[i - 1], t[i], v);
    t[0] = fmaxf(t[0], v);
}
__device__ __forceinline__ float key_tag(float v, unsigned keepmask, unsigned tag) { return __uint_as_float((__float_as_uint(v) & keepmask) | tag); }
template <int I, int J> struct CandLoop {
    static __device__ __forceinline__ void run(const float (&a)[16], const float (&b)[16], float (&c)[16]) {
        if constexpr ((I + 1) * (J + 1) <= 16) { ins16(c, key_tag(a[I] + b[J], ~255u, 255u - (unsigned)(I * 16 + J))); CandLoop<I, J + 1>::run(a, b, c); }
        else if constexpr (I + 1 < 16) CandLoop<I + 1, 0>::run(a, b, c);
    }
};
__device__ __forceinline__ void phase_peer(const Args& A, LAS unsigned char* lds) {
    const int lane = threadIdx.x & 63, wave = threadIdx.x >> 6, gw = blockIdx.x * NWAVES + wave, NGW = gridDim.x * NWAVES;
    LAS unsigned char* wl = lds + wave * 9216;
    LAS float* topL = (LAS float*)wl; LAS int* eidA = (LAS int*)(wl + 4096); LAS float* wgtA = (LAS float*)(wl + 6144); LAS float* coefL = (LAS float*)(wl + 8192);
    const float* SC = (const float*)(A.ws + WS_SC); const bf16_t* HX = (const bf16_t*)(A.ws + WS_HX);
    const unsigned char* UT = A.ws + WS_UT; const unsigned char* VT = A.ws + WS_VT; const float* SU = (const float*)(A.ws + WS_UT + WS_TSCALE); const float* SVs = (const float*)(A.ws + WS_VT + WS_TSCALE);
    const float* mod = (const float*)(A.ws + WS_MOD);
    const float NEG = -3.0e38f;
    const int h = lane >> 3, tk = (lane >> 1) & 3, p = lane & 1, grp = 2 * h + p;
    for (int pass = gw; pass < M / 4; pass += NGW) {
        {
            float t[16];
#pragma unroll
            for (int i = 0; i < 16; ++i) t[i] = NEG;
            const float* sp = SC + (size_t)pass * 8192 + (grp * 128 + tk) * 4;
#pragma unroll 4
            for (int i = 0; i < 32; ++i) { const f32x4 v = *(const f32x4*)(sp + i * 16); const unsigned tg = 127u - 4u * (unsigned)i;
                ins16(t, key_tag(v[0], ~127u, tg)); ins16(t, key_tag(v[1], ~127u, tg - 1u)); ins16(t, key_tag(v[2], ~127u, tg - 2u)); ins16(t, key_tag(v[3], ~127u, tg - 3u)); }
            float pb[16];
#pragma unroll
            for (int i = 0; i < 16; ++i) { pb[i] = __shfl_xor(t[i], 1); topL[lane * 16 + i] = t[i]; }
            float c[16];
#pragma unroll
            for (int i = 0; i < 16; ++i) c[i] = NEG;
            CandLoop<0, 0>::run(t, pb, c);
            float e[16]; float es = 0.f;
#pragma unroll
            for (int k = 0; k < 16; ++k) { e[k] = __expf(c[k] - c[0]); es += e[k]; }
            const float inv = __builtin_amdgcn_rcpf(es);
            asm volatile("s_waitcnt lgkmcnt(0)" ::: "memory");
            if (p == 0) {
#pragma unroll
                for (int k = 0; k < 16; ++k) { const unsigned code = 255u - (__float_as_uint(c[k]) & 255u);
                    const unsigned ia = 127u - (__float_as_uint(topL[lane * 16 + (code >> 4)]) & 127u), ib = 127u - (__float_as_uint(topL[(lane + 1) * 16 + (code & 15u)]) & 127u);
                    eidA[tk * 128 + h * 16 + k] = (int)(ia * 128u + ib); wgtA[tk * 128 + h * 16 + k] = e[k] * inv; }
            }
            asm volatile("s_waitcnt lgkmcnt(0)" ::: "memory");
        }
#pragma unroll 1
        for (int tq = 0; tq < 4; ++tq) {
            const int t = pass * 4 + tq; const LAS int* eidL = eidA + tq * 128; const LAS float* wgtL = wgtA + tq * 128;
            f32x2 x2[8];
            { const u32x4 x0 = *(const u32x4*)(HX + (size_t)t * D + lane * 16), x1 = *(const u32x4*)(HX + (size_t)t * D + lane * 16 + 8);
#pragma unroll
              for (int j = 0; j < 4; ++j) { x2[j] = (f32x2){bf_lo(x0[j]), bf_hi(x0[j])}; x2[4 + j] = (f32x2){bf_lo(x1[j]), bf_hi(x1[j])}; } }
            u32x4 bufA[8], bufB[8];
#define LOAD8(buf, TB, hb) do { _Pragma("unroll") for (int e = 0; e < 8; ++e) { const int id = eidL[(hb) * 8 + e]; buf[e] = *(const u32x4*)((TB) + (size_t)id * D + lane * 16); } } while (0)
#define DOT8(buf, off) do { _Pragma("unroll") for (int e = 0; e < 8; ++e) { f32x2 s2 = {0.f, 0.f}; \
                _Pragma("unroll") for (int j = 0; j < 4; ++j) { const int aj = (int)buf[e][j]; s2 += __builtin_amdgcn_cvt_pk_f32_fp8(aj, false) * x2[2 * j]; s2 += __builtin_amdgcn_cvt_pk_f32_fp8(aj, true) * x2[2 * j + 1]; } \
                pp[(off) + e] = s2[0] + s2[1]; } } while (0)
#define REDUCE16(kb) do { const int ke = (kb) * 16 + ((lane >> 2) & 15); const int myid = eidL[ke]; const float su = SU[myid], sv = SVs[myid]; \
            _Pragma("unroll") for (int e = 0; e < 8; ++e) { const bool up = lane & 32; const float keep = up ? pp[e + 8] : pp[e], send = up ? pp[e] : pp[e + 8]; pp[e] = keep + __shfl_xor(send, 32); } \
            _Pragma("unroll") for (int e = 0; e < 4; ++e) { const bool up = lane & 16; const float keep = up ? pp[e + 4] : pp[e], send = up ? pp[e] : pp[e + 4]; pp[e] = keep + __shfl_xor(send, 16); } \
            _Pragma("unroll") for (int e = 0; e < 2; ++e) { const bool up = lane & 8; const float keep = up ? pp[e + 2] : pp[e], send = up ? pp[e] : pp[e + 2]; pp[e] = keep + __shfl_xor(send, 8); } \
            { const bool up = lane & 4; const float keep = up ? pp[1] : pp[0], send = up ? pp[0] : pp[1]; pp[0] = keep + __shfl_xor(send, 4); } \
            float hsum = pp[0]; hsum += __shfl_xor(hsum, 2); hsum += __shfl_xor(hsum, 1); \
            const float cf = wgtL[ke] * gelu_exact(hsum * su) * sv; if ((lane & 3) == 0) coefL[ke] = cf; } while (0)
            LOAD8(bufA, UT, 0);
#pragma unroll 1
            for (int kb = 0; kb < 8; ++kb) {
                float pp[16];
                LOAD8(bufB, UT, 2 * kb + 1);
                DOT8(bufA, 0);
                if (kb < 7) LOAD8(bufA, UT, 2 * kb + 2); else LOAD8(bufA, VT, 0);
                DOT8(bufB, 8);
                REDUCE16(kb);
            }
            asm volatile("s_waitcnt lgkmcnt(0)" ::: "memory");
            f32x2 y2[8];
#pragma unroll
            for (int j = 0; j < 8; ++j) y2[j] = (f32x2){0.f, 0.f};
#define VACC8(buf, hb) do { _Pragma("unroll") for (int e = 0; e < 8; ++e) { const float cf = coefL[(hb) * 8 + e]; const f32x2 cf2 = {cf, cf}; \
                _Pragma("unroll") for (int j = 0; j < 4; ++j) { const int aj = (int)buf[e][j]; y2[2 * j] += cf2 * __builtin_amdgcn_cvt_pk_f32_fp8(aj, false); y2[2 * j + 1] += cf2 * __builtin_amdgcn_cvt_pk_f32_fp8(aj, true); } } } while (0)
#pragma unroll 1
            for (int kb = 0; kb < 8; ++kb) {
                LOAD8(bufB, VT, 2 * kb + 1);
                VACC8(bufA, 2 * kb);
                if (kb < 7) LOAD8(bufA, VT, 2 * kb + 2);
                VACC8(bufB, 2 * kb + 1);
            }
#undef LOAD8
#undef DOT8
#undef REDUCE16
#undef VACC8
            const float* g2 = mod + (t >> 12) * NMOD + 5 * D; float* orow = A.out + (size_t)t * D;
            float z[16]; float ss = 0.f;
#pragma unroll
            for (int q = 0; q < 4; ++q) { const int k = lane * 16 + q * 4; const f32x4 xv = *(const f32x4*)(orow + k), gv = *(const f32x4*)(g2 + k);
                const float yy[4] = {y2[2 * q][0], y2[2 * q][1], y2[2 * q + 1][0], y2[2 * q + 1][1]};
#pragma unroll
                for (int j = 0; j < 4; ++j) { const float zz = xv[j] + gv[j] * yy[j]; z[q * 4 + j] = zz; ss += zz * zz; } }
            const float r = rsqrtf(wave_sum(ss) * (1.f / D) + EPS);
#pragma unroll
            for (int q = 0; q < 4; ++q) { const int k = lane * 16 + q * 4; const f32x4 fv = *(const f32x4*)(A.fg + k);
                f32x4 o;
#pragma unroll
                for (int j = 0; j < 4; ++j) o[j] = z[q * 4 + j] * r * fv[j];
                if (!A.dry || r < 0.f) *(f32x4*)(orow + k) = o; }
        }
    }
}
constexpr int N_PHASES = 10;
__global__ void __launch_bounds__(NWAVES * 64, 2) mega_fwd(Args A) {
    extern __shared__ __attribute__((aligned(16))) unsigned char lds[];
    LAS unsigned char* L = (LAS unsigned char*)lds;
    cg::grid_group grid = cg::this_grid();
    const int lo = A.ph_lo, hi = A.ph_hi, G = gridDim.x, c = blockIdx.x;
#ifndef PH_MASK
#define PH_MASK 0x3FF
#endif
#define IN(k) (((PH_MASK >> (k)) & 1) && lo <= (k) && (k) < hi)
#define SEAM(k) do { if (IN(k) && IN((k) + 1)) grid.sync(); } while (0)
    if (IN(0)) phase_prologue(A, L);
    SEAM(0);
    if (IN(1)) phase_hx(A);
    SEAM(1);
    if (IN(2)) { SchedInProj Sd{(const char*)(A.ws + WS_HX), (const char*)(A.ws + WS_HC), (const char*)(A.ws + WS_WIN), G, c}; EpiInProj E{A.ws};
        pg8::gemm_phase<EpiInProj, SchedInProj, true>(L, D, Sd, E); }
    SEAM(2);
    if (IN(3)) { if (!A.dry) phase_kfix(A); phase_conv(A, L); }
    SEAM(3);
    if (IN(4)) phase_attn(A, lds);
    SEAM(4);
    if (IN(5)) { SchedMerge Sd{(const char*)(A.ws + WS_Q), (const char*)(A.ws + WS_HX), (const char*)(A.ws + WS_WA), (const char*)(A.ws + WS_WC), G, c}; EpiMerge E{A.ws};
        pg8::gemm_phase<EpiMerge, SchedMerge, true>(L, D, Sd, E); }
    SEAM(5);
    if (IN(6)) { SchedPlain Sd{(const char*)(A.ws + WS_G), (const char*)(A.ws + WS_WO), M / 256, D / 256, G, c}; EpiOut E{A.x, (const float*)(A.ws + WS_MOD), A.out};
        pg8::gemm_phase<EpiOut, SchedPlain, true>(L, D, Sd, E); }
    SEAM(6);
    if (IN(7)) phase_hx2(A);
    SEAM(7);
    if (IN(8)) { SchedPlain Sd{(const char*)(A.ws + WS_HX), (const char*)(A.ws + WS_WP), M / 256, PW / 256, G, c}; EpiScores E{(float*)(A.ws + WS_SC)};
        pg8::gemm_phase<EpiScores, SchedPlain, true>(L, D, Sd, E); }
    SEAM(8);
    if (IN(9)) phase_peer(A, L);
#undef IN
#undef SEAM
}

#ifndef MK_ONE_LAUNCH
#define MK_ONE_LAUNCH 1
#endif
extern "C" void kernel_launch(void* const* d_in, const int* in_sizes, int n_in, void* d_out, int out_size, void* d_ws, size_t ws_size, hipStream_t stream) {
    static int grid = 0;
    if (grid == 0) {
        if (n_in != 23 || out_size != M * D || ws_size < WS_END) { fprintf(stderr, "kernel_launch: unexpected shapes (n_in %d out %d ws %zu)\n", n_in, out_size, ws_size); grid = -1; return; }
        int dev = 0, cus = 0, per_cu = 0;
        hipGetDevice(&dev); hipDeviceGetAttribute(&cus, hipDeviceAttributeMultiprocessorCount, dev);
        if (hipFuncSetAttribute((const void*)mega_fwd, hipFuncAttributeMaxDynamicSharedMemorySize, LDS_BYTES) != hipSuccess) { fprintf(stderr, "kernel_launch: hipFuncSetAttribute failed\n"); grid = -1; return; }
        if (hipOccupancyMaxActiveBlocksPerMultiprocessor(&per_cu, (const void*)mega_fwd, NWAVES * 64, LDS_BYTES) != hipSuccess || per_cu < 1) { fprintf(stderr, "kernel_launch: occupancy query says %d\n", per_cu); per_cu = 1; }
        (void)hipGetLastError();
        grid = cus * 1;
        if (per_cu < 1) grid = -1;
    }
    if (grid < 0) return;
    Args a{};
    const float** f = (const float**)&a;
    for (int i = 0; i < 23; ++i) f[i] = (const float*)d_in[i];
    a.out = (float*)d_out; a.ws = (unsigned char*)d_ws;
#if MK_ONE_LAUNCH
    a.ph_lo = 0; a.ph_hi = N_PHASES;
    void* args[] = {&a};
    hipError_t e = hipLaunchCooperativeKernel((const void*)mega_fwd, dim3(grid), dim3(NWAVES * 64), args, LDS_BYTES, stream);
    if (e != hipSuccess) fprintf(stderr, "cooperative launch failed: %s (grid %d)\n", hipGetErrorString(e), grid);
#else
#ifndef REPEAT_PH
#define REPEAT_PH -1
#endif
    for (int p = 0; p < N_PHASES; ++p) { a.ph_lo = p; a.ph_hi = p + 1;
        if (p == REPEAT_PH) { a.dry = 1; hipLaunchKernelGGL(mega_fwd, dim3(grid), dim3(NWAVES * 64), LDS_BYTES, stream, a); a.dry = 0; }
        hipLaunchKernelGGL(mega_fwd, dim3(grid), dim3(NWAVES * 64), LDS_BYTES, stream, a); }
#endif
}
```

```cpp
#include <hip/hip_runtime.h>
#include <hip/hip_cooperative_groups.h>
#include <cstdio>
#include <cstdint>
namespace cg = cooperative_groups;

#define LAS __attribute__((address_space(3)))
typedef unsigned short bf16_t;
typedef short bf16x8 __attribute__((ext_vector_type(8)));
typedef short s16x4 __attribute__((ext_vector_type(4)));
typedef float f32x2 __attribute__((ext_vector_type(2)));
typedef float f32x4 __attribute__((ext_vector_type(4)));
typedef float f32x16 __attribute__((ext_vector_type(16)));
typedef unsigned u32x2 __attribute__((ext_vector_type(2)));
typedef unsigned u32x4 __attribute__((ext_vector_type(4)));
typedef __bf16 bf16x2_t __attribute__((ext_vector_type(2)));

constexpr int D = 1024, NB = 8, S = 4096, CTXL = 256, SKV = S + CTXL, HD = 128, HQ = 8, HKV = 2;
constexpr int M = NB * S;
constexpr int MC = NB * CTXL;
constexpr int INW = 5632, NMOD = 6144, NEXP = 16384, PW = 2048;
constexpr float EPS = 1e-6f;

__device__ __forceinline__ unsigned cvt_pk_bf16(float lo, float hi) { f32x2 v = {lo, hi}; bf16x2_t b = __builtin_convertvector(v, bf16x2_t); return __builtin_bit_cast(unsigned, b); }
__device__ __forceinline__ float bf_lo(unsigned u) { return __uint_as_float(u << 16); }
__device__ __forceinline__ float bf_hi(unsigned u) { return __uint_as_float(u & 0xffff0000u); }
__device__ __forceinline__ float fast_sigmoid(float x) { return __builtin_amdgcn_rcpf(1.f + __builtin_amdgcn_exp2f(-1.4426950408889634f * x)); }
__device__ __forceinline__ float wave_sum(float v) {
#pragma unroll
    for (int o = 1; o < 64; o <<= 1) v += __shfl_xor(v, o);
    return v;
}

namespace pg8 {
constexpr int BM = 256, BK = 64, HALF = 128, HTB = HALF * BK * 2  , STAGE_BYTES = 8 * HTB, NXCD = 8, WGM = 8;
__host__ __device__ __forceinline__ int lds_byte(int r, int c) { const int st = (r >> 4) * 2 + (c >> 5), rr = r & 15, cc = c & 31, ob = rr * 64 + cc * 2; return st * 1024 + (ob ^ (((ob >> 9) & 1) << 5)); }
__host__ __device__ __forceinline__ void stage_rc(int b, int& R, int& C) { const int st = b / 1024, sb = b % 1024, swz = sb ^ (((sb >> 9) & 1) << 5); R = (st >> 1) * 16 + swz / 64; C = (st & 1) * 32 + (swz % 64) / 2; }
__host__ __device__ __forceinline__ int perm32(int rho) { const int n = rho >> 4, i = rho & 15; return 8 * (i >> 2) + 4 * n + (i & 3); }

struct Unit { const char* a; const char* b; int pm, pn, kind, keep; };

__device__ __forceinline__ void tile_of(int L, int nM, int nN, int& pm, int& pn) {
    const int nwg = nM * nN; int wgid = L;
    { const int q = nwg / NXCD, r = nwg % NXCD, xcd = wgid % NXCD, off = wgid / NXCD; wgid = (xcd < r ? xcd * (q + 1) : r * (q + 1) + (xcd - r) * q) + off; }
    const int nig = WGM * nN, gid = wgid / nig, fm = gid * WGM, gsz = (nM - fm) < WGM ? (nM - fm) : WGM;
    pm = fm + ((wgid % nig) % gsz); pn = (wgid % nig) / gsz;
}

template <class Epi, class Sched, bool ALIGN_EPI>
__device__ __forceinline__ void gemm_phase(LAS unsigned char* lds, const int K, const Sched& S, const Epi& E) {
    const int tid = threadIdx.x, wid = __builtin_amdgcn_readfirstlane(tid >> 6), lane = tid & 63, wr = wid >> 2, wc = wid & 3, fr = lane & 15, fq = lane >> 4;
    const int nt = K / BK;
    unsigned voffA[2], voffB[2];
#pragma unroll
    for (int i = 0; i < 2; ++i) { int R, C; stage_rc(tid * 16 + i * 8192, R, C); const int Rb = Epi::PERM ? ((R & ~31) + perm32(R & 31)) : R;
        voffA[i] = (unsigned)(R * K + C) * 2u; voffB[i] = (unsigned)(Rb * K + C) * 2u; }
    const size_t kstep = (size_t)(BK * 2);
    const size_t hstep = (size_t)HALF * K * 2;
    const unsigned ldsw = (unsigned)wid * 1024u;
    const int aoff = lds_byte(wr * 64 + fr, fq * 8), boff = lds_byte(wc * 32 + fr, fq * 8);
#define PG8_SA(b, h) (((b) * 2 + (h)) * HTB)
#define PG8_SB(b, h) ((4 + (b) * 2 + (h)) * HTB)
#define PG8_STAGE(bufoff, gbase, voff) do { _Pragma("unroll") for (int _i = 0; _i < 2; ++_i) \
        __builtin_amdgcn_global_load_lds((const unsigned*)((const char*)(gbase) + (voff)[_i]), (LAS unsigned*)(lds + (bufoff) + ldsw + _i * 8192), 16, 0, 0); } while (0)
#define PG8_LDA(dst, b, h) do { _Pragma("unroll") for (int m = 0; m < 4; ++m) _Pragma("unroll") for (int k = 0; k < 2; ++k) dst[m][k] = *(const LAS bf16x8*)(lds + PG8_SA(b, h) + aoff + m * 2048 + k * 1024); } while (0)
#define PG8_LDB(dst, b, h) do { _Pragma("unroll") for (int n = 0; n < 2; ++n) _Pragma("unroll") for (int k = 0; k < 2; ++k) dst[n][k] = *(const LAS bf16x8*)(lds + PG8_SB(b, h) + boff + n * 2048 + k * 1024); } while (0)
#define PG8_MMA(ai, bj, At, Bt) do { __builtin_amdgcn_s_setprio(1); _Pragma("unroll") for (int m = 0; m < 4; ++m) _Pragma("unroll") for (int n = 0; n < 2; ++n) _Pragma("unroll") for (int k = 0; k < 2; ++k) \
        acc[ai][bj][m][n] = __builtin_amdgcn_mfma_f32_16x16x32_bf16(Bt[n][k], At[m][k], acc[ai][bj][m][n], 0, 0, 0); __builtin_amdgcn_s_setprio(0); } while (0)
#define PG8_WAIT_V(n) asm volatile("s_waitcnt vmcnt(" #n ")" ::: "memory")
#define PG8_WAIT_L(n) asm volatile("s_waitcnt lgkmcnt(" #n ")" ::: "memory")
#define PG8_BAR __builtin_amdgcn_s_barrier()
#define PG8_SCHED __builtin_amdgcn_sched_barrier(0)
    Unit cur, nxt; int ui = 0;
    if (!S.next(0, cur)) return;
    f32x4 acc[2][2][4][2];
#pragma unroll
    for (int a = 0; a < 2; ++a)
#pragma unroll
        for (int b = 0; b < 2; ++b)
#pragma unroll
            for (int m = 0; m < 4; ++m)
#pragma unroll
                for (int n = 0; n < 2; ++n) acc[a][b][m][n] = (f32x4){0.f, 0.f, 0.f, 0.f};
    bf16x8 At[4][2], B0[2][2], B1[2][2];
    const char* cA = cur.a; const char* cB = cur.b;
    PG8_STAGE(PG8_SB(0, 0), cB, voffB); PG8_STAGE(PG8_SB(0, 1), cB + hstep, voffB); PG8_STAGE(PG8_SA(0, 0), cA, voffA); PG8_STAGE(PG8_SA(0, 1), cA + hstep, voffA);
    if (wr == 1) PG8_BAR;
    PG8_WAIT_V(2); PG8_BAR;
    PG8_STAGE(PG8_SB(1, 0), cB + kstep, voffB); PG8_STAGE(PG8_SA(1, 0), cA + kstep, voffA); PG8_STAGE(PG8_SB(1, 1), cB + hstep + kstep, voffB);
    PG8_WAIT_V(6); PG8_BAR;
    for (;;) {
        const bool has_next = S.next(ui + 1, nxt);
        const char* nA = has_next ? nxt.a : cA; const char* nB = has_next ? nxt.b : cB;
        for (int t = 0; t < nt; t += 2) {
            const bool last = (t == nt - 2);
            const char* a1 = cA + (size_t)(t + 1) * kstep;
            const char* a2 = last ? nA : cA + (size_t)(t + 2) * kstep; const char* b2 = last ? nB : cB + (size_t)(t + 2) * kstep;
            const char* a3 = a2 + kstep; const char* b3 = b2 + kstep;
            PG8_LDB(B0, 0, 0); PG8_LDB(B1, 0, 1); PG8_SCHED; PG8_LDA(At, 0, 0); PG8_STAGE(PG8_SA(1, 1), a1 + hstep, voffA);
            PG8_WAIT_V(8); PG8_WAIT_L(0); PG8_BAR; PG8_MMA(0, 0, At, B0); PG8_MMA(0, 1, At, B1); PG8_BAR; PG8_SCHED;
            PG8_LDA(At, 0, 1); PG8_STAGE(PG8_SB(0, 0), b2, voffB); PG8_STAGE(PG8_SB(0, 1), b2 + hstep, voffB); PG8_STAGE(PG8_SA(0, 0), a2, voffA);
            PG8_WAIT_V(8); PG8_WAIT_L(0); PG8_BAR; PG8_MMA(1, 0, At, B0); PG8_MMA(1, 1, At, B1); PG8_BAR; PG8_SCHED;
            PG8_LDB(B0, 1, 0); PG8_LDB(B1, 1, 1); PG8_SCHED; PG8_LDA(At, 1, 0); PG8_STAGE(PG8_SA(0, 1), a2 + hstep, voffA);
            PG8_WAIT_V(8); PG8_WAIT_L(0); PG8_BAR; PG8_MMA(0, 0, At, B0); PG8_MMA(0, 1, At, B1); PG8_BAR; PG8_SCHED;
            PG8_LDA(At, 1, 1); PG8_STAGE(PG8_SB(1, 0), b3, voffB); PG8_STAGE(PG8_SB(1, 1), b3 + hstep, voffB); PG8_STAGE(PG8_SA(1, 0), a3, voffA);
            PG8_WAIT_V(8); PG8_WAIT_L(0); PG8_BAR; PG8_MMA(1, 0, At, B0); PG8_MMA(1, 1, At, B1); PG8_BAR; PG8_SCHED;
        }
        if constexpr (ALIGN_EPI) { if (wr == 0) PG8_BAR; }
        E(acc, cur, wr, wc, fr, fq);
        if (!has_next) break;
        if (!cur.keep) {
#pragma unroll
        for (int a = 0; a < 2; ++a)
#pragma unroll
            for (int b = 0; b < 2; ++b)
#pragma unroll
                for (int m = 0; m < 4; ++m)
#pragma unroll
                    for (int n = 0; n < 2; ++n) acc[a][b][m][n] = (f32x4){0.f, 0.f, 0.f, 0.f};
        }
        cur = nxt; cA = nA; cB = nB; ++ui;
        if constexpr (ALIGN_EPI) { if (wr == 1) PG8_BAR; }
    }
    PG8_WAIT_V(0);
    if constexpr (!ALIGN_EPI) { if (wr == 0) PG8_BAR; }
    PG8_BAR;
#undef PG8_SA
#undef PG8_SB
#undef PG8_STAGE
#undef PG8_LDA
#undef PG8_LDB
#undef PG8_MMA
#undef PG8_WAIT_V
#undef PG8_WAIT_L
#undef PG8_BAR
#undef PG8_SCHED
}
}
namespace att {
constexpr int NW = 8, QBLK = 32, KVBLK = 64;
constexpr float SCALE = 0.088388347648318440f;
constexpr float THR = 8.f;
constexpr int LDQ = D, LDK = HKV * HD, LDO = D;
constexpr int SHM_V = KVBLK * HD * 2, SHM_K = KVBLK * HD * 2, SHM_ATTN = 2 * SHM_V + 2 * SHM_K + NW * 64 * 4;
constexpr int OST_OFF = SHM_ATTN, LDS_TOTAL = OST_OFF + NW * 8192;
#define KSWZ(row, colB) ((row) * 256 + ((colB) ^ (((row) & 7) << 4)))
#define SBAR() __builtin_amdgcn_sched_barrier(0)
__device__ __forceinline__ int crow(int r, int hi) { return (r & 3) + 8 * (r >> 2) + 4 * hi; }
__device__ __forceinline__ unsigned cvtpk(float lo, float hi) { unsigned r; asm volatile("v_cvt_pk_bf16_f32 %0, %1, %2" : "=v"(r) : "v"(lo), "v"(hi)); return r; }

__device__ __forceinline__ void partialSM(f32x16& p0, f32x16& p1, float& m_reg, float& mn, float& alpha) {
  constexpr float C = SCALE * 1.4426950408889634f;
  float pmax = p0[0]; for (int r = 1; r < 16; ++r) pmax = fmaxf(pmax, p0[r]); for (int r = 0; r < 16; ++r) pmax = fmaxf(pmax, p1[r]);
  { auto rr = __builtin_amdgcn_permlane32_swap(__float_as_uint(pmax), __float_as_uint(pmax), false, false);
    pmax = fmaxf(__uint_as_float(rr[0]), __uint_as_float(rr[1])); }
  if (__builtin_expect(__all(pmax - m_reg <= THR / SCALE), 1)) { mn = m_reg; alpha = 1.f; }
  else { mn = fmaxf(m_reg, pmax); alpha = __builtin_amdgcn_exp2f((m_reg - mn) * C); m_reg = mn; }
  float mnC = -mn * C;
  for (int r = 0; r < 16; ++r) p0[r] = fmaf(p0[r], C, mnC); for (int r = 0; r < 16; ++r) p1[r] = fmaf(p1[r], C, mnC);
  for (int r = 0; r < 16; ++r) p0[r] = __builtin_amdgcn_exp2f(p0[r]);
}
__device__ __forceinline__ void finishSM(f32x16& p0, f32x16& p1, float alpha, float& l_reg, bf16x8& pa0, bf16x8& pa1, bf16x8& pa2, bf16x8& pa3) {
  for (int r = 0; r < 16; ++r) p1[r] = __builtin_amdgcn_exp2f(p1[r]);
  float ps = 0; for (int r = 0; r < 16; ++r) ps += p0[r]; for (int r = 0; r < 16; ++r) ps += p1[r];
  { auto rr = __builtin_amdgcn_permlane32_swap(__float_as_uint(ps), __float_as_uint(ps), false, false);
    ps = __uint_as_float(rr[0]) + __uint_as_float(rr[1]); }
  l_reg = l_reg * alpha + ps;
#define PK4(P, BASE, OUT) do { unsigned a0 = cvtpk(P[BASE + 0], P[BASE + 1]), a1 = cvtpk(P[BASE + 2], P[BASE + 3]);   \
    unsigned b0 = cvtpk(P[BASE + 4], P[BASE + 5]), b1 = cvtpk(P[BASE + 6], P[BASE + 7]);                              \
    auto r0 = __builtin_amdgcn_permlane32_swap(a0, b0, false, false); auto r1 = __builtin_amdgcn_permlane32_swap(a1, b1, false, false); \
    u32x4 w = {r0[0], r1[0], r0[1], r1[1]}; OUT = *reinterpret_cast<bf16x8*>(&w); } while (0)
  PK4(p0, 0, pa0); PK4(p0, 8, pa1); PK4(p1, 0, pa2); PK4(p1, 8, pa3);
#undef PK4
}
__device__ __forceinline__ void qkt(f32x16& p0, f32x16& p1, const bf16_t* Ks, const bf16x8* qr, int r32, int hi) {
  p0 = f32x16{}; p1 = f32x16{};
  for (int d0 = 0; d0 < 8; ++d0) { int cb = (d0 * 16 + hi * 8) * 2;
    bf16x8 b0 = *reinterpret_cast<const bf16x8*>((const char*)Ks + KSWZ(r32, cb));
    bf16x8 b1 = *reinterpret_cast<const bf16x8*>((const char*)Ks + KSWZ(32 + r32, cb));
    p0 = __builtin_amdgcn_mfma_f32_32x32x16_bf16(b0, qr[d0], p0, 0, 0, 0);
    p1 = __builtin_amdgcn_mfma_f32_32x32x16_bf16(b1, qr[d0], p1, 0, 0, 0); }
}
__device__ __forceinline__ int v_st(int k, int c) { const int kk = (k & ~0xC) | ((k & 4) << 1) | ((k & 8) >> 1); return ((kk >> 3) * 4 + (c >> 5)) * 512 + ((kk & 7) * 32 + (c & 31)) * 2; }
__device__ __forceinline__ int v_rd_base(int lane) { return ((lane & 3) << 3) | (((lane >> 2) & 3) << 6) | (((lane >> 4) & 1) << 5) | (((lane >> 5) & 1) << 8); }
constexpr int v_rd_off(int d0, int ks, int half) { return d0 * 512 + ks * 4096 + half * 2048; }
template <int OFF> __device__ __forceinline__ s16x4 tr_read(int vb) {
  s16x4 r; asm volatile("ds_read_b64_tr_b16 %0, %1 offset:%2" : "=&v"(r) : "v"(vb), "i"(OFF) : "memory"); return r;
}
template <int D0> __device__ __forceinline__ void pv_one(f32x16& od, int vb, bf16x8 pa0, bf16x8 pa1, bf16x8 pa2, bf16x8 pa3) {
  const s16x4 l0 = tr_read<v_rd_off(D0, 0, 0)>(vb), h0 = tr_read<v_rd_off(D0, 0, 1)>(vb), l1 = tr_read<v_rd_off(D0, 1, 0)>(vb), h1 = tr_read<v_rd_off(D0, 1, 1)>(vb);
  const s16x4 l2 = tr_read<v_rd_off(D0, 2, 0)>(vb), h2 = tr_read<v_rd_off(D0, 2, 1)>(vb), l3 = tr_read<v_rd_off(D0, 3, 0)>(vb), h3 = tr_read<v_rd_off(D0, 3, 1)>(vb);
  asm volatile("s_waitcnt lgkmcnt(0)" ::: "memory"); SBAR();
#define PK(L, H) (bf16x8){L[0], L[1], L[2], L[3], H[0], H[1], H[2], H[3]}
  od = __builtin_amdgcn_mfma_f32_32x32x16_bf16(pa0, PK(l0, h0), od, 0, 0, 0);
  od = __builtin_amdgcn_mfma_f32_32x32x16_bf16(pa1, PK(l1, h1), od, 0, 0, 0);
  od = __builtin_amdgcn_mfma_f32_32x32x16_bf16(pa2, PK(l2, h2), od, 0, 0, 0);
  od = __builtin_amdgcn_mfma_f32_32x32x16_bf16(pa3, PK(l3, h3), od, 0, 0, 0);
#undef PK
}
__device__ __forceinline__ void pv_d0(f32x16* o, int vb, bf16x8 pa0, bf16x8 pa1, bf16x8 pa2, bf16x8 pa3) {
  pv_one<0>(o[0], vb, pa0, pa1, pa2, pa3); pv_one<1>(o[1], vb, pa0, pa1, pa2, pa3); pv_one<2>(o[2], vb, pa0, pa1, pa2, pa3); pv_one<3>(o[3], vb, pa0, pa1, pa2, pa3);
}

__device__ __forceinline__ void attn_unit(const bf16_t* Qb, const bf16_t* __restrict__ Kh, const bf16_t* __restrict__ Vh, bf16_t* Ob, int t0, int seq,
                                          const float* __restrict__ qng, const float* __restrict__ cst, const float* __restrict__ snt, char* lds) {
  int tid_ = threadIdx.x; asm volatile("" : "+v"(tid_));
  const int tid = tid_, wid = tid >> 6, lane = tid & 63, r32 = lane & 31, hi = lane >> 5;
  bf16_t* V_lds = (bf16_t*)lds; bf16_t* K_lds = (bf16_t*)(lds + 2 * SHM_V);
  float* ws = (float*)(lds + 2 * SHM_V + 2 * SHM_K) + wid * 64; float* li_l = ws; float* al_l = ws + 32;
  float m_reg = -1e30f, l_reg = 0; f32x16 o[4] = {}; bf16x8 qr[8];
  {
    const bf16_t* Qw = Qb + (long)(wid * QBLK + r32) * LDQ + hi * 8;
    float y[8][8]; float ss = 0.f;
#pragma unroll
    for (int d0 = 0; d0 < 8; ++d0) { const u32x4 w = *reinterpret_cast<const u32x4*>(Qw + d0 * 16);
#pragma unroll
      for (int j = 0; j < 4; ++j) { y[d0][2 * j] = bf_lo(w[j]); y[d0][2 * j + 1] = bf_hi(w[j]); ss += y[d0][2 * j] * y[d0][2 * j] + y[d0][2 * j + 1] * y[d0][2 * j + 1]; } }
    ss += __shfl_xor(ss, 32);
    const float rstd = rsqrtf(ss * (1.f / HD) + EPS);
#pragma unroll
    for (int d0 = 0; d0 < 8; ++d0) { const f32x4 g0 = *reinterpret_cast<const f32x4*>(qng + d0 * 16 + hi * 8), g1 = *reinterpret_cast<const f32x4*>(qng + d0 * 16 + hi * 8 + 4);
#pragma unroll
      for (int j = 0; j < 4; ++j) { y[d0][j] *= rstd * g0[j]; y[d0][4 + j] *= rstd * g1[j]; } }
    const int t = t0 + wid * QBLK + r32;
#pragma unroll
    for (int blk = 0; blk < 2; ++blk) { const int pos = blk == 0 ? (t >> 6) : (t & 63);
#pragma unroll
      for (int dd = 0; dd < 2; ++dd) { const int da = blk * 4 + dd, db = da + 2;
#pragma unroll
        for (int j4 = 0; j4 < 2; ++j4) { const f32x4 c4 = *reinterpret_cast<const f32x4*>(cst + pos * 32 + dd * 16 + hi * 8 + j4 * 4), s4 = *reinterpret_cast<const f32x4*>(snt + pos * 32 + dd * 16 + hi * 8 + j4 * 4);
#pragma unroll
          for (int j = 0; j < 4; ++j) { const float x1 = y[da][j4 * 4 + j], x2 = y[db][j4 * 4 + j]; y[da][j4 * 4 + j] = x1 * c4[j] - x2 * s4[j]; y[db][j4 * 4 + j] = x1 * s4[j] + x2 * c4[j]; } } } }
#pragma unroll
    for (int d0 = 0; d0 < 8; ++d0) { u32x4 w = {cvt_pk_bf16(y[d0][0], y[d0][1]), cvt_pk_bf16(y[d0][2], y[d0][3]), cvt_pk_bf16(y[d0][4], y[d0][5]), cvt_pk_bf16(y[d0][6], y[d0][7])}; qr[d0] = *reinterpret_cast<bf16x8*>(&w); }
  }
  const int sr = tid >> 4, sc = (tid & 15) * 8, vst0 = v_st(sr, sc), vst1 = v_st(32 + sr, sc);
  const int vb0 = (int)(uintptr_t)V_lds + v_rd_base(lane);
  struct { bf16x8 vs0, vs1, ks0, ks1; } sr_[2];
#define LD8(p) (*reinterpret_cast<const bf16x8*>(p))
#define SLOAD(i, k0) do { sr_[i].vs0 = LD8(&Vh[(long)((k0) + sr) * LDK + sc]); sr_[i].vs1 = LD8(&Vh[(long)((k0) + 32 + sr) * LDK + sc]); \
    sr_[i].ks0 = LD8(&Kh[(long)((k0) + sr) * LDK + sc]); sr_[i].ks1 = LD8(&Kh[(long)((k0) + 32 + sr) * LDK + sc]); } while (0)
#define SWRITE(b, i) do { *(bf16x8*)((char*)V_lds + (b) * SHM_V + vst0) = sr_[i].vs0;          \
    *(bf16x8*)((char*)V_lds + (b) * SHM_V + vst1) = sr_[i].vs1; int kc = sc * 2;               \
    *(bf16x8*)((char*)K_lds + (b) * SHM_K + KSWZ(sr, kc)) = sr_[i].ks0;                       \
    *(bf16x8*)((char*)K_lds + (b) * SHM_K + KSWZ(32 + sr, kc)) = sr_[i].ks1; } while (0)
#define SWAIT() asm volatile("s_waitcnt vmcnt(4)" ::: "memory")
#define RESC(a) do { if (__any((a) < 1.f)) { if (hi == 0) al_l[r32] = (a); asm volatile("s_waitcnt lgkmcnt(0)" ::: "memory"); \
    for (int d = 0; d < 4; ++d) for (int r = 0; r < 16; ++r) o[d][r] *= al_l[crow(r, hi)]; } } while (0)
  f32x16 pA0, pA1, pB0, pB1; float mnA, mnB, alA, alB; bf16x8 pa0, pa1, pa2, pa3; const int NT = seq / KVBLK;
  constexpr int SE = 0, SO = 1;
  SLOAD(SE, 0); asm volatile("s_waitcnt vmcnt(0)" ::: "memory"); SWRITE(0, SE); __syncthreads();
  qkt(pA0, pA1, K_lds, qr, r32, hi); partialSM(pA0, pA1, m_reg, mnA, alA);
  SLOAD(SO, KVBLK); if (2 < NT) SLOAD(SE, 2 * KVBLK);
  SWAIT(); SWRITE(1, SO); __syncthreads();
  for (int j = 1; j + 1 < NT; j += 2) {
    SBAR(); qkt(pB0, pB1, (bf16_t*)((char*)K_lds + SHM_K), qr, r32, hi);
    finishSM(pA0, pA1, alA, l_reg, pa0, pa1, pa2, pa3); SBAR();
    SLOAD(SO, (j + 2) * KVBLK); SBAR();
    pv_d0(o, vb0, pa0, pa1, pa2, pa3); partialSM(pB0, pB1, m_reg, mnB, alB);
    __syncthreads(); SWAIT(); SWRITE(0, SE);
    RESC(alB); __syncthreads();
    SBAR(); qkt(pA0, pA1, K_lds, qr, r32, hi);
    finishSM(pB0, pB1, alB, l_reg, pa0, pa1, pa2, pa3); SBAR();
    if (j + 3 < NT) SLOAD(SE, (j + 3) * KVBLK); SBAR();
    pv_d0(o, vb0 + (int)SHM_V, pa0, pa1, pa2, pa3); partialSM(pA0, pA1, m_reg, mnA, alA);
    __syncthreads(); SWAIT(); SWRITE(1, SO);
    RESC(alA); __syncthreads();
  }
  SBAR(); qkt(pB0, pB1, (bf16_t*)((char*)K_lds + SHM_K), qr, r32, hi);
  finishSM(pA0, pA1, alA, l_reg, pa0, pa1, pa2, pa3); SBAR();
  pv_d0(o, vb0, pa0, pa1, pa2, pa3); partialSM(pB0, pB1, m_reg, mnB, alB);
  __syncthreads(); RESC(alB);
  finishSM(pB0, pB1, alB, l_reg, pa0, pa1, pa2, pa3); SBAR();
  pv_d0(o, vb0 + (int)SHM_V, pa0, pa1, pa2, pa3);
  if (hi == 0) li_l[r32] = l_reg; asm volatile("s_waitcnt lgkmcnt(0)" ::: "memory");
  float rli[16];
#pragma unroll
  for (int r = 0; r < 16; ++r) rli[r] = __builtin_amdgcn_rcpf(li_l[crow(r, hi)]);
  { bf16_t* stg = (bf16_t*)(lds + OST_OFF) + wid * 4096;
#pragma unroll
    for (int r = 0; r < 16; ++r) { const int orow = crow(r, hi);
#pragma unroll
      for (int d0 = 0; d0 < 4; ++d0) stg[orow * 128 + d0 * 32 + r32] = (bf16_t)(cvt_pk_bf16(o[d0][r] * rli[r], 0.f) & 0xffffu); }
    asm volatile("s_waitcnt lgkmcnt(0)" ::: "memory");
    bf16_t* Ow = Ob + (long)(wid * QBLK) * LDO;
#pragma unroll
    for (int i = 0; i < 8; ++i) { const int row = i * 4 + (lane >> 4), ch = lane & 15; const u32x4 v = *(const u32x4*)(stg + row * 128 + ch * 8); *(u32x4*)(Ow + (long)row * LDO + ch * 8) = v; }
  }
#undef LD8
#undef SLOAD
#undef SWRITE
#undef SWAIT
#undef RESC
}
#undef KSWZ
#undef SBAR
}
constexpr size_t MiB = 1u << 20;
constexpr size_t WS_CTL = 0, CTL_ZERO_BYTES = 64 * 1024;
constexpr size_t WS_MOD = 1 * MiB;
constexpr size_t WS_ROPE = WS_MOD + 256 * 1024;
constexpr size_t WS_HC = 2 * MiB;
constexpr size_t WS_WIN = 6 * MiB;
constexpr size_t WS_WA = 17 * MiB, WS_WC = 19 * MiB, WS_WO = 21 * MiB;
constexpr size_t WS_WP = 23 * MiB;
constexpr size_t WS_UT = 27 * MiB, WS_VT = 59 * MiB;
constexpr size_t WS_TSCALE = 16 * MiB;
constexpr size_t WS_KB = 91 * MiB, WS_VB = 108 * MiB;
constexpr size_t WS_HX = 125 * MiB;
constexpr size_t WS_Q = 189 * MiB;
constexpr size_t WS_G = 253 * MiB;
constexpr size_t WS_RT = 317 * MiB;
constexpr size_t WS_SGC = 381 * MiB;
constexpr size_t WS_SC = 189 * MiB;
constexpr size_t WS_END = 445 * MiB;

constexpr int NWAVES = 8;
constexpr int LDS_BYTES = 147456;

struct Args {
    const float *x, *c, *ctx, *c_ctx, *w_mod, *b_mod, *n1g, *n2g, *w_in, *qng, *kng, *w_ao, *cdw, *cb, *clg, *clb, *w_co, *w_o, *wq, *keys, *ut, *vt, *fg;
    float* out; unsigned char* ws; int ph_lo, ph_hi, dry, pad;
};

__host__ __device__ __forceinline__ int win_row(int n) {
    if (n < 1536) return n;
    const int base = n < 3584 ? 1536 : 3584, m = n - base, half = m >> 10, idx = m & 1023;
    return base + (idx >> 7) * 256 + half * 128 + (idx & 127);
}

__device__ __forceinline__ void task_mod(const Args& A, int task, int lane, const LAS float* sc) {
    const int n0 = task * 8, col = lane & 7, kg = lane >> 3;
    float acc[9];
#pragma unroll
    for (int b = 0; b < 9; ++b) acc[b] = 0.f;
    const float* wp = A.w_mod + (size_t)kg * NMOD + n0 + col;
    for (int i0 = 0; i0 < 128; i0 += 8) {
        float w[8];
#pragma unroll
        for (int u = 0; u < 8; ++u) w[u] = wp[(size_t)(i0 + u) * 8 * NMOD];
#pragma unroll
        for (int u = 0; u < 8; ++u) { const int k = kg + 8 * (i0 + u);
#pragma unroll
            for (int b = 0; b < 9; ++b) acc[b] += sc[b * D + k] * w[u]; }
    }
#pragma unroll
    for (int b = 0; b < 9; ++b) { float v = acc[b]; v += __shfl_xor(v, 8); v += __shfl_xor(v, 16); v += __shfl_xor(v, 32); acc[b] = v; }
    if (lane < 8) { float* mod = (float*)(A.ws + WS_MOD); const float bm = A.b_mod[n0 + col];
#pragma unroll
        for (int b = 0; b < 9; ++b) mod[b * NMOD + n0 + col] = acc[b] + bm; }
}
__device__ __forceinline__ void task_transpose(const float* W, int K, int N, bf16_t* WT, int k0, int n0, int row0, LAS float* scr, int lane) {
#pragma unroll 8
    for (int i = 0; i < 32; ++i) { const int kk = 2 * i + (lane >> 5); scr[kk * 33 + (lane & 31)] = W[(size_t)(k0 + kk) * N + n0 + (lane & 31)]; }
    asm volatile("s_waitcnt lgkmcnt(0)" ::: "memory");
    const int c = lane & 7;
#pragma unroll
    for (int j = 0; j < 4; ++j) { const int n = (lane >> 3) + 8 * j; const LAS float* s = scr + (8 * c) * 33 + n;
        u32x4 o; o.x = cvt_pk_bf16(s[0 * 33], s[1 * 33]); o.y = cvt_pk_bf16(s[2 * 33], s[3 * 33]); o.z = cvt_pk_bf16(s[4 * 33], s[5 * 33]); o.w = cvt_pk_bf16(s[6 * 33], s[7 * 33]);
        *(u32x4*)(WT + (size_t)(row0 + n) * K + k0 + 8 * c) = o; }
    asm volatile("s_waitcnt lgkmcnt(0)" ::: "memory");
}
__device__ __forceinline__ void task_quant_row(const float* src, unsigned char* dst, float* scale_out, int lane) {
    f32x4 v[4]; float am = 0.f;
#pragma unroll
    for (int i = 0; i < 4; ++i) { v[i] = *(const f32x4*)(src + (i * 64 + lane) * 4); am = fmaxf(fmaxf(am, fmaxf(fabsf(v[i][0]), fabsf(v[i][1]))), fmaxf(fabsf(v[i][2]), fabsf(v[i][3]))); }
#pragma unroll
    for (int o = 1; o < 64; o <<= 1) am = fmaxf(am, __shfl_xor(am, o));
    const float inv = am > 0.f ? 448.f / am : 0.f;
#pragma unroll
    for (int i = 0; i < 4; ++i) { int p = __builtin_amdgcn_cvt_pk_fp8_f32(v[i][0] * inv, v[i][1] * inv, 0, false); p = __builtin_amdgcn_cvt_pk_fp8_f32(v[i][2] * inv, v[i][3] * inv, p, true);
        *(int*)(dst + (i * 64 + lane) * 4) = p; }
    if (lane == 0) *scale_out = am * (1.f / 448.f);
}
__device__ __forceinline__ bf16x8 ld8_f32_bf16(const float* p) { const f32x4 a = *(const f32x4*)p, b = *(const f32x4*)(p + 4); u32x4 w = {cvt_pk_bf16(a[0], a[1]), cvt_pk_bf16(a[2], a[3]), cvt_pk_bf16(b[0], b[1]), cvt_pk_bf16(b[2], b[3])}; return *reinterpret_cast<bf16x8*>(&w); }
__device__ __forceinline__ void task_wprime(const Args& A, int id, int lane) {
    const int hp = id >> 7, rem = id & 127, n0 = (rem >> 5) * 32, k0 = (rem & 31) * 32, r32 = lane & 31, hi = lane >> 5;
    f32x16 acc = {};
    const float* ka = A.keys + ((size_t)(hp * 128 + n0 + r32)) * 128 + hi * 8;
    const float* wb = A.wq + (size_t)(k0 + r32) * PW + hp * 128 + hi * 8;
#pragma unroll
    for (int s = 0; s < 8; ++s) acc = __builtin_amdgcn_mfma_f32_32x32x16_bf16(ld8_f32_bf16(ka + s * 16), ld8_f32_bf16(wb + s * 16), acc, 0, 0, 0);
    bf16_t* o = (bf16_t*)(A.ws + WS_WP);
#pragma unroll
    for (int r = 0; r < 16; ++r) { const int n = (r & 3) + 8 * (r >> 2) + 4 * hi; o[(size_t)(hp * 128 + n0 + n) * D + k0 + r32] = (bf16_t)(cvt_pk_bf16(acc[r], 0.f) & 0xffffu); }
}
__device__ __forceinline__ void phase_prologue(const Args& A, LAS unsigned char* lds) {
    const int tid = threadIdx.x, lane = tid & 63, wave = __builtin_amdgcn_readfirstlane(tid >> 6);
    LAS float* sc = (LAS float*)lds;
    for (int i = tid; i < 9 * D; i += 512) { const float v = i < 8 * D ? A.c[i] : A.c_ctx[i - 8 * D]; sc[i] = v / (1.f + __expf(-v)); }
    __syncthreads();
    LAS float* scr = (LAS float*)(lds + 36864 + wave * 8448);
    constexpr int T_MOD = NMOD / 8, T_WIN = (D / 64) * (INW / 32), T_SQ = (D / 64) * (D / 32), T_UV = 2 * NEXP, T_WP = 2048, T_ROPE = 1;
    constexpr int NT = T_MOD + T_WIN + 3 * T_SQ + T_UV + T_WP + T_ROPE;
    const int G = gridDim.x;
    for (int task = wave * G + blockIdx.x; task < NT; task += NWAVES * G) {
        int r = task;
        if (r < T_MOD) { task_mod(A, r, lane, sc); continue; } r -= T_MOD;
        if (r < T_WIN) { const int nblk = INW / 32, kb = r / nblk, nb = r % nblk; task_transpose(A.w_in, D, INW, (bf16_t*)(A.ws + WS_WIN), 64 * kb, 32 * nb, win_row(32 * nb), scr, lane); continue; } r -= T_WIN;
        if (r < 3 * T_SQ) { const int wsel = r / T_SQ, q = r % T_SQ, kb = q / 32, nb = q % 32;
            const float* W = wsel == 0 ? A.w_ao : (wsel == 1 ? A.w_co : A.w_o); bf16_t* WT = (bf16_t*)(A.ws + (wsel == 0 ? WS_WA : (wsel == 1 ? WS_WC : WS_WO)));
            task_transpose(W, D, D, WT, 64 * kb, 32 * nb, 32 * nb, scr, lane); continue; } r -= 3 * T_SQ;
        if (r < T_UV) { const int tb = r / NEXP, row = r % NEXP; unsigned char* tbase = A.ws + (tb ? WS_VT : WS_UT);
            task_quant_row((tb ? A.vt : A.ut) + (size_t)row * D, tbase + (size_t)row * D, (float*)(tbase + WS_TSCALE) + row, lane); continue; } r -= T_UV;
        if (r < T_WP) { task_wprime(A, r, lane); continue; } r -= T_WP;
        { float* cs = (float*)(A.ws + WS_ROPE); float* sn = cs + 2048;
          for (int e = lane; e < 2048; e += 64) { const int p = e >> 5, i = e & 31; const float inv = powf(10000.f, -(float)(2 * i) / 64.f); const float a = (float)p * inv; cs[e] = cosf(a); sn[e] = sinf(a); } }
    }
}
__device__ __forceinline__ void normmod_row(const float* xr, const float* g, const float* modr, int sh_off, int sc_off, bf16_t* orow, int lane) {
    f32x4 v[4]; float ss = 0.f;
#pragma unroll
    for (int i = 0; i < 4; ++i) { v[i] = *(const f32x4*)(xr + (i * 64 + lane) * 4); ss += (v[i][0] * v[i][0] + v[i][1] * v[i][1]) + (v[i][2] * v[i][2] + v[i][3] * v[i][3]); }
    const float r = rsqrtf(wave_sum(ss) * (1.f / D) + EPS);
#pragma unroll
    for (int i = 0; i < 4; ++i) { const int k = (i * 64 + lane) * 4; const f32x4 gg = *(const f32x4*)(g + k), s1 = *(const f32x4*)(modr + sc_off + k), h1 = *(const f32x4*)(modr + sh_off + k);
        float y[4];
#pragma unroll
        for (int j = 0; j < 4; ++j) y[j] = v[i][j] * r * gg[j] * (1.f + s1[j]) + h1[j];
        u32x2 o = {cvt_pk_bf16(y[0], y[1]), cvt_pk_bf16(y[2], y[3])}; *(u32x2*)(orow + k) = o; }
}
__device__ __forceinline__ void phase_hx(const Args& A) {
    const int lane = threadIdx.x & 63, gw = blockIdx.x * NWAVES + (threadIdx.x >> 6), NGW = gridDim.x * NWAVES;
    const float* mod = (const float*)(A.ws + WS_MOD);
    for (int m = gw; m < M + MC; m += NGW) {
        if (m < M) normmod_row(A.x + (size_t)m * D, A.n1g, mod + (m >> 12) * NMOD, 0, D, (bf16_t*)(A.ws + WS_HX) + (size_t)m * D, lane);
        else { const int r = m - M; normmod_row(A.ctx + (size_t)r * D, A.n1g, mod + 8 * NMOD, 0, D, (bf16_t*)(A.ws + WS_HC) + (size_t)r * D, lane); }
    }
}
__device__ __forceinline__ void phase_hx2(const Args& A) {
    const int lane = threadIdx.x & 63, gw = blockIdx.x * NWAVES + (threadIdx.x >> 6), NGW = gridDim.x * NWAVES;
    const float* mod = (const float*)(A.ws + WS_MOD);
    for (int m = gw; m < M; m += NGW) normmod_row(A.out + (size_t)m * D, A.n2g, mod + (m >> 12) * NMOD, 3 * D, 4 * D, (bf16_t*)(A.ws + WS_HX) + (size_t)m * D, lane);
}
__device__ __forceinline__ void phase_kfix(const Args& A) {
    const int lane = threadIdx.x & 63, gw = blockIdx.x * NWAVES + (threadIdx.x >> 6), NGW = gridDim.x * NWAVES, li = lane & 15, sub = lane >> 4;
    bf16_t* KB = (bf16_t*)(A.ws + WS_KB); const float* cs = (const float*)(A.ws + WS_ROPE); const float* sn = cs + 2048;
    constexpr int NITEM = NB * SKV * HKV;
    const f32x4 g0 = *(const f32x4*)(A.kng + li * 8), g1 = *(const f32x4*)(A.kng + li * 8 + 4);
    const f32x4 p0 = *(const f32x4*)(A.kng + (li ^ 4) * 8), p1 = *(const f32x4*)(A.kng + (li ^ 4) * 8 + 4);
    for (int it = gw * 4 + sub; it < NITEM; it += NGW * 4) {
        const int row = it >> 1, h = it & 1, t = row % SKV;
        bf16_t* p = KB + (size_t)row * 256 + h * HD + li * 8;
        const u32x4 w = *(const u32x4*)p;
        float x[8], xp[8]; float ss = 0.f;
#pragma unroll
        for (int j = 0; j < 4; ++j) { x[2 * j] = bf_lo(w[j]); x[2 * j + 1] = bf_hi(w[j]); ss += x[2 * j] * x[2 * j] + x[2 * j + 1] * x[2 * j + 1];
            const unsigned pw = (unsigned)__shfl_xor((int)w[j], 4); xp[2 * j] = bf_lo(pw); xp[2 * j + 1] = bf_hi(pw); }
        ss += __shfl_xor(ss, 1); ss += __shfl_xor(ss, 2); ss += __shfl_xor(ss, 4); ss += __shfl_xor(ss, 8);
        const float r = rsqrtf(ss * (1.f / HD) + EPS);
        float y[8];
#pragma unroll
        for (int j = 0; j < 8; ++j) { x[j] *= r * (j < 4 ? g0[j] : g1[j - 4]); xp[j] *= r * (j < 4 ? p0[j] : p1[j - 4]); y[j] = x[j]; }
        if (t < S) {
            const int blk = li >> 3, pos = blk == 0 ? (t >> 6) : (t & 63), second = (li >> 2) & 1, i0 = (li & 3) * 8;
            const f32x4 c0 = *(const f32x4*)(cs + pos * 32 + i0), c1 = *(const f32x4*)(cs + pos * 32 + i0 + 4), s0 = *(const f32x4*)(sn + pos * 32 + i0), s1 = *(const f32x4*)(sn + pos * 32 + i0 + 4);
#pragma unroll
            for (int j = 0; j < 8; ++j) { const float c = j < 4 ? c0[j] : c1[j - 4], s = j < 4 ? s0[j] : s1[j - 4];
                y[j] = second ? (xp[j] * s + x[j] * c) : (x[j] * c - xp[j] * s); }
        }
        u32x4 o = {cvt_pk_bf16(y[0], y[1]), cvt_pk_bf16(y[2], y[3]), cvt_pk_bf16(y[4], y[5]), cvt_pk_bf16(y[6], y[7])};
        *(u32x4*)p = o;
    }
}
template <int R> struct ConvRow {
    static __device__ __forceinline__ void run(const unsigned* gp, int tl0, float (&acc)[32][2], const float (&w)[31][2]) {
        const int tl = tl0 + R - 15;
        unsigned v = 0u; if (tl >= 0 && tl < S) v = gp[(long)(R - 15) * (D / 2)];
        const float a = bf_lo(v), b = bf_hi(v);
#pragma unroll
        for (int t = (R - 30 > 0 ? R - 30 : 0); t <= (R < 31 ? R : 31); ++t) { acc[t][0] += w[R - t][0] * a; acc[t][1] += w[R - t][1] * b; }
        if constexpr (R + 1 < 62) ConvRow<R + 1>::run(gp, tl0, acc, w);
    }
};
__device__ __forceinline__ void phase_conv(const Args& A, LAS unsigned char* lds) {
    const int tid = threadIdx.x, lane = tid & 63, wave = tid >> 6;
    LAS float* tile = (LAS float*)lds;
    const bf16_t* G = (const bf16_t*)(A.ws + WS_G); bf16_t* CV = (bf16_t*)(A.ws + WS_HX);
    float w[31][2];
#pragma unroll
    for (int j = 0; j < 31; ++j) { const f32x2 t = *(const f32x2*)(A.cdw + j * D + 2 * tid); w[j][0] = t[0]; w[j][1] = t[1]; }
    const f32x2 bias = *(const f32x2*)(A.cb + 2 * tid);
    for (int tileid = blockIdx.x; tileid < M / 32; tileid += gridDim.x) {
        const int row0 = tileid * 32, tl0 = row0 & (S - 1);
        float acc[32][2];
#pragma unroll
        for (int t = 0; t < 32; ++t) { acc[t][0] = bias[0]; acc[t][1] = bias[1]; }
        ConvRow<0>::run((const unsigned*)(G + (size_t)row0 * D) + tid, tl0, acc, w);
        __syncthreads();
#pragma unroll
        for (int t = 0; t < 32; ++t) *(LAS f32x2*)(tile + t * D + 2 * tid) = (f32x2){acc[t][0], acc[t][1]};
        __syncthreads();
#pragma unroll
        for (int q = 0; q < 4; ++q) { const int t = wave * 4 + q; const LAS float* tr = tile + t * D;
            f32x4 v[4]; float s = 0.f;
#pragma unroll
            for (int i = 0; i < 4; ++i) { v[i] = *(const LAS f32x4*)(tr + (i * 64 + lane) * 4); s += (v[i][0] + v[i][1]) + (v[i][2] + v[i][3]); }
            const float mu = wave_sum(s) * (1.f / D); float qq = 0.f;
#pragma unroll
            for (int i = 0; i < 4; ++i) { v[i] = v[i] - mu; qq += (v[i][0] * v[i][0] + v[i][1] * v[i][1]) + (v[i][2] * v[i][2] + v[i][3] * v[i][3]); }
            const float rs = rsqrtf(wave_sum(qq) * (1.f / D) + EPS);
#pragma unroll
            for (int i = 0; i < 4; ++i) { const int k = (i * 64 + lane) * 4; const f32x4 gg = *(const f32x4*)(A.clg + k), bb = *(const f32x4*)(A.clb + k); float y[4];
#pragma unroll
                for (int j = 0; j < 4; ++j) { const float z = v[i][j] * rs * gg[j] + bb[j]; y[j] = z * fast_sigmoid(z); }
                u32x2 o = {cvt_pk_bf16(y[0], y[1]), cvt_pk_bf16(y[2], y[3])}; *(u32x2*)(CV + (size_t)(row0 + t) * D + k) = o; }
        }
    }
}
struct EpiInProj {
    static constexpr bool PERM = true;
    unsigned char* ws;
    __device__ __forceinline__ void operator()(f32x4 (&acc)[2][2][4][2], const pg8::Unit& u, int wr, int wc, int fr, int fq) const {
        const int c8 = wc * 32 + 8 * fq;
#pragma unroll
        for (int ai = 0; ai < 2; ++ai)
#pragma unroll
            for (int m = 0; m < 4; ++m) {
                const int row = u.pm * 256 + ai * 128 + wr * 64 + m * 16 + fr;
                if (u.kind == 0) {
                    bf16_t* p = (bf16_t*)(ws + WS_Q) + (size_t)row * D + u.pn * 256 + c8;
#pragma unroll
                    for (int bj = 0; bj < 2; ++bj) { const f32x4 v0 = acc[ai][bj][m][0], v1 = acc[ai][bj][m][1];
                        u32x4 w = {cvt_pk_bf16(v0[0], v0[1]), cvt_pk_bf16(v0[2], v0[3]), cvt_pk_bf16(v1[0], v1[1]), cvt_pk_bf16(v1[2], v1[3])}; *(u32x4*)(p + bj * 128) = w; }
                } else if (u.kind == 1 || u.kind == 2 || u.kind == 5 || u.kind == 6) {
                    const bool ctxu = u.kind >= 5;
                    const int kvrow = ctxu ? (row >> 8) * SKV + S + (row & 255) : (row >> 12) * SKV + (row & (S - 1));
                    bf16_t* p = (bf16_t*)(ws + ((u.kind == 1 || u.kind == 5) ? WS_KB : WS_VB)) + (size_t)kvrow * 256 + c8;
#pragma unroll
                    for (int bj = 0; bj < 2; ++bj) { const f32x4 v0 = acc[ai][bj][m][0], v1 = acc[ai][bj][m][1];
                        u32x4 w = {cvt_pk_bf16(v0[0], v0[1]), cvt_pk_bf16(v0[2], v0[3]), cvt_pk_bf16(v1[0], v1[1]), cvt_pk_bf16(v1[2], v1[3])}; *(u32x4*)(p + bj * 128) = w; }
                } else if (u.kind == 3) {
                    float g[8];
#pragma unroll
                    for (int n = 0; n < 2; ++n)
#pragma unroll
                        for (int j = 0; j < 4; ++j) g[4 * n + j] = acc[ai][0][m][n][j] * fast_sigmoid(acc[ai][1][m][n][j]);
                    u32x4 w = {cvt_pk_bf16(g[0], g[1]), cvt_pk_bf16(g[2], g[3]), cvt_pk_bf16(g[4], g[5]), cvt_pk_bf16(g[6], g[7])};
                    *(u32x4*)((bf16_t*)(ws + WS_G) + (size_t)row * D + (u.pn - 6) * 128 + c8) = w;
                } else {
                    float rt[8], sg[8];
#pragma unroll
                    for (int n = 0; n < 2; ++n)
#pragma unroll
                        for (int j = 0; j < 4; ++j) { const float ea = __builtin_amdgcn_exp2f(-1.4426950408889634f * acc[ai][0][m][n][j]), ec = __builtin_amdgcn_exp2f(-1.4426950408889634f * acc[ai][1][m][n][j]);
                            sg[4 * n + j] = __builtin_amdgcn_rcpf(1.f + ec); rt[4 * n + j] = (1.f + ec) * __builtin_amdgcn_rcpf(1.f + ea); }
                    const size_t off = (size_t)row * D + (u.pn - 14) * 128 + c8;
                    u32x4 w = {cvt_pk_bf16(rt[0], rt[1]), cvt_pk_bf16(rt[2], rt[3]), cvt_pk_bf16(rt[4], rt[5]), cvt_pk_bf16(rt[6], rt[7])}; *(u32x4*)((bf16_t*)(ws + WS_RT) + off) = w;
                    u32x4 w2 = {cvt_pk_bf16(sg[0], sg[1]), cvt_pk_bf16(sg[2], sg[3]), cvt_pk_bf16(sg[4], sg[5]), cvt_pk_bf16(sg[6], sg[7])}; *(u32x4*)((bf16_t*)(ws + WS_SGC) + off) = w2;
                }
            }
    }
};
struct SchedInProj {
    const char* hx; const char* hc; const char* w; int G, c;
    __device__ __forceinline__ bool next(int i, pg8::Unit& u) const {
        constexpr int nM = M / 256, nN = INW / 256, NMAIN = nM * nN, NCTX = (MC / 256) * 2;
        const int L = i * G + c; if (L >= NMAIN + NCTX) return false;
        if (L < NMAIN) { pg8::tile_of(L, nM, nN, u.pm, u.pn); u.a = hx + (size_t)u.pm * 256 * D * 2; u.kind = u.pn < 4 ? 0 : (u.pn == 4 ? 1 : (u.pn == 5 ? 2 : (u.pn < 14 ? 3 : 4))); }
        else { const int j = L - NMAIN; u.pm = j >> 1; u.pn = 4 + (j & 1); u.a = hc + (size_t)u.pm * 256 * D * 2; u.kind = 5 + (j & 1); }
        u.b = w + (size_t)u.pn * 256 * D * 2; u.keep = 0; return true;
    }
};
struct EpiMerge {
    static constexpr bool PERM = true;
    unsigned char* ws;
    __device__ __forceinline__ void operator()(f32x4 (&acc)[2][2][4][2], const pg8::Unit& u, int wr, int wc, int fr, int fq) const {
        const int c8 = u.pn * 256 + wc * 32 + 8 * fq;
        const bf16_t* F = (const bf16_t*)(ws + (u.kind == 0 ? WS_RT : WS_SGC));
#pragma unroll
        for (int ai = 0; ai < 2; ++ai)
#pragma unroll
            for (int m = 0; m < 4; ++m) { const size_t off = (size_t)(u.pm * 256 + ai * 128 + wr * 64 + m * 16 + fr) * D + c8;
#pragma unroll
                for (int bj = 0; bj < 2; ++bj) { const u32x4 f = *(const u32x4*)(F + off + bj * 128);
                    f32x4 v0 = acc[ai][bj][m][0], v1 = acc[ai][bj][m][1];
                    v0[0] *= bf_lo(f[0]); v0[1] *= bf_hi(f[0]); v0[2] *= bf_lo(f[1]); v0[3] *= bf_hi(f[1]); v1[0] *= bf_lo(f[2]); v1[1] *= bf_hi(f[2]); v1[2] *= bf_lo(f[3]); v1[3] *= bf_hi(f[3]);
                    if (u.kind == 0) { acc[ai][bj][m][0] = v0; acc[ai][bj][m][1] = v1; }
                    else { u32x4 w = {cvt_pk_bf16(v0[0], v0[1]), cvt_pk_bf16(v0[2], v0[3]), cvt_pk_bf16(v1[0], v1[1]), cvt_pk_bf16(v1[2], v1[3])}; *(u32x4*)((bf16_t*)(ws + WS_G) + off + bj * 128) = w; } } }
    }
};
struct SchedMerge {
    const char* att; const char* cv; const char* wa; const char* wc; int G, c;
    __device__ __forceinline__ bool next(int i, pg8::Unit& u) const {
        constexpr int nM = M / 256, nN = D / 256;
        const int L = (i >> 1) * G + c, sub = i & 1; if (L >= nM * nN) return false;
        pg8::tile_of(L, nM, nN, u.pm, u.pn);
        u.a = (sub ? cv : att) + (size_t)u.pm * 256 * D * 2; u.b = (sub ? wc : wa) + (size_t)u.pn * 256 * D * 2; u.kind = sub; u.keep = sub ^ 1; return true;
    }
};
struct SchedPlain {
    const char* a; const char* b; int nM, nN, G, c;
    __device__ __forceinline__ bool next(int i, pg8::Unit& u) const {
        const int L = i * G + c; if (L >= nM * nN) return false;
        pg8::tile_of(L, nM, nN, u.pm, u.pn); u.a = a + (size_t)u.pm * 256 * D * 2; u.b = b + (size_t)u.pn * 256 * D * 2; u.kind = 0; u.keep = 0; return true;
    }
};
struct EpiOut {
    static constexpr bool PERM = false;
    const float* x; const float* mod; float* xs;
    __device__ __forceinline__ void operator()(f32x4 (&acc)[2][2][4][2], const pg8::Unit& u, int wr, int wc, int fr, int fq) const {
        const int col0 = u.pn * 256 + wc * 32 + 4 * fq; const float* g1 = mod + ((u.pm * 256) >> 12) * NMOD + 2 * D;
        f32x4 gv[2][2];
#pragma unroll
        for (int bj = 0; bj < 2; ++bj)
#pragma unroll
            for (int n = 0; n < 2; ++n) gv[bj][n] = *(const f32x4*)(g1 + col0 + bj * 128 + n * 16);
#pragma unroll
        for (int ai = 0; ai < 2; ++ai)
#pragma unroll
            for (int m = 0; m < 4; ++m) { const size_t off = (size_t)(u.pm * 256 + ai * 128 + wr * 64 + m * 16 + fr) * D + col0;
#pragma unroll
                for (int bj = 0; bj < 2; ++bj)
#pragma unroll
                    for (int n = 0; n < 2; ++n) { const f32x4 xv = *(const f32x4*)(x + off + bj * 128 + n * 16); *(f32x4*)(xs + off + bj * 128 + n * 16) = xv + gv[bj][n] * acc[ai][bj][m][n]; } }
    }
};
struct EpiScores {
    static constexpr bool PERM = false;
    float* sc;
    __device__ __forceinline__ void operator()(f32x4 (&acc)[2][2][4][2], const pg8::Unit& u, int wr, int wc, int fr, int fq) const {
#pragma unroll
        for (int ai = 0; ai < 2; ++ai)
#pragma unroll
            for (int m = 0; m < 4; ++m) { const int row = u.pm * 256 + ai * 128 + wr * 64 + m * 16 + fr; float* p = sc + (size_t)(row >> 2) * 8192 + (row & 3) * 4;
#pragma unroll
                for (int bj = 0; bj < 2; ++bj)
#pragma unroll
                    for (int n = 0; n < 2; ++n) { const int grp = u.pn * 2 + bj, nq = wc * 8 + n * 4 + fq; *(f32x4*)(p + (grp * 32 + nq) * 16) = acc[ai][bj][m][n]; } }
    }
};

__device__ __forceinline__ void phase_attn(const Args& A, unsigned char* lds) {
    const int G = gridDim.x, X = blockIdx.x & 7, j = blockIdx.x >> 3, perx = G >> 3;
    bf16_t* Q = (bf16_t*)(A.ws + WS_Q); const bf16_t* KB = (const bf16_t*)(A.ws + WS_KB); const bf16_t* VB = (const bf16_t*)(A.ws + WS_VB);
    const float* cs = (const float*)(A.ws + WS_ROPE); const float* sn = cs + 2048;
    for (int idx = j; idx < 128; idx += perx) {
        const int grp = 2 * X + (idx >> 6), uu = idx & 63, b = grp >> 1, kv = grp & 1, h = kv * 4 + (uu >> 4), qb = uu & 15;
        bf16_t* qp = Q + ((size_t)b * S + qb * 256) * D + h * HD;
        bf16_t* op = A.dry ? (bf16_t*)(A.ws + ((size_t)445 << 20)) + ((size_t)b * S + qb * 256) * D + h * HD : qp;
        att::attn_unit(qp, KB + (size_t)b * SKV * 256 + kv * HD, VB + (size_t)b * SKV * 256 + kv * HD, op, qb * 256, SKV, A.qng, cs, sn, (char*)lds);
    }
}

__device__ __forceinline__ float gelu_exact(float v) { return 0.5f * v * (1.f + erff(v * 0.70710678118654752f)); }
__device__ __forceinline__ void ins16(float (&t)[16], float v) {
#pragma unroll
    for (int i = 15; i >= 1; --i) t[i] = __builtin_amdgcn_fmed3f(t[i - 1], t[i], v);
    t[0] = fmaxf(t[0], v);
}
__device__ __forceinline__ float key_tag(float v, unsigned keepmask, unsigned tag) { return __uint_as_float((__float_as_uint(v) & keepmask) | tag); }
template <int I, int J> struct CandLoop {
    static __device__ __forceinline__ void run(const float (&a)[16], const float (&b)[16], float (&c)[16]) {
        if constexpr ((I + 1) * (J + 1) <= 16) { ins16(c, key_tag(a[I] + b[J], ~255u, 255u - (unsigned)(I * 16 + J))); CandLoop<I, J + 1>::run(a, b, c); }
        else if constexpr (I + 1 < 16) CandLoop<I + 1, 0>::run(a, b, c);
    }
};
__device__ __forceinline__ void phase_peer(const Args& A, LAS unsigned char* lds) {
    const int lane = threadIdx.x & 63, wave = threadIdx.x >> 6, gw = blockIdx.x * NWAVES + wave, NGW = gridDim.x * NWAVES;
    LAS unsigned char* wl = lds + wave * 9216;
    LAS float* topL = (LAS float*)wl; LAS int* eidA = (LAS int*)(wl + 4096); LAS float* wgtA = (LAS float*)(wl + 6144); LAS float* coefL = (LAS float*)(wl + 8192);
    const float* SC = (const float*)(A.ws + WS_SC); const bf16_t* HX = (const bf16_t*)(A.ws + WS_HX);
    const unsigned char* UT = A.ws + WS_UT; const unsigned char* VT = A.ws + WS_VT; const float* SU = (const float*)(A.ws + WS_UT + WS_TSCALE); const float* SVs = (const float*)(A.ws + WS_VT + WS_TSCALE);
    const float* mod = (const float*)(A.ws + WS_MOD);
    const float NEG = -3.0e38f;
    const int h = lane >> 3, tk = (lane >> 1) & 3, p = lane & 1, grp = 2 * h + p;
    for (int pass = gw; pass < M / 4; pass += NGW) {
        {
            float t[16];
#pragma unroll
            for (int i = 0; i < 16; ++i) t[i] = NEG;
            const float* sp = SC + (size_t)pass * 8192 + (grp * 128 + tk) * 4;
#pragma unroll 4
            for (int i = 0; i < 32; ++i) { const f32x4 v = *(const f32x4*)(sp + i * 16); const unsigned tg = 127u - 4u * (unsigned)i;
                ins16(t, key_tag(v[0], ~127u, tg)); ins16(t, key_tag(v[1], ~127u, tg - 1u)); ins16(t, key_tag(v[2], ~127u, tg - 2u)); ins16(t, key_tag(v[3], ~127u, tg - 3u)); }
            float pb[16];
#pragma unroll
            for (int i = 0; i < 16; ++i) { pb[i] = __shfl_xor(t[i], 1); topL[lane * 16 + i] = t[i]; }
            float c[16];
#pragma unroll
            for (int i = 0; i < 16; ++i) c[i] = NEG;
            CandLoop<0, 0>::run(t, pb, c);
            float e[16]; float es = 0.f;
#pragma unroll
            for (int k = 0; k < 16; ++k) { e[k] = __expf(c[k] - c[0]); es += e[k]; }
            const float inv = __builtin_amdgcn_rcpf(es);
            asm volatile("s_waitcnt lgkmcnt(0)" ::: "memory");
            if (p == 0) {
#pragma unroll
                for (int k = 0; k < 16; ++k) { const unsigned code = 255u - (__float_as_uint(c[k]) & 255u);
                    const unsigned ia = 127u - (__float_as_uint(topL[lane * 16 + (code >> 4)]) & 127u), ib = 127u - (__float_as_uint(topL[(lane + 1) * 16 + (code & 15u)]) & 127u);
                    eidA[tk * 128 + h * 16 + k] = (int)(ia * 128u + ib); wgtA[tk * 128 + h * 16 + k] = e[k] * inv; }
            }
            asm volatile("s_waitcnt lgkmcnt(0)" ::: "memory");
        }
#pragma unroll 1
        for (int tq = 0; tq < 4; ++tq) {
            const int t = pass * 4 + tq; const LAS int* eidL = eidA + tq * 128; const LAS float* wgtL = wgtA + tq * 128;
            f32x2 x2[8];
            { const u32x4 x0 = *(const u32x4*)(HX + (size_t)t * D + lane * 16), x1 = *(const u32x4*)(HX + (size_t)t * D + lane * 16 + 8);
#pragma unroll
              for (int j = 0; j < 4; ++j) { x2[j] = (f32x2){bf_lo(x0[j]), bf_hi(x0[j])}; x2[4 + j] = (f32x2){bf_lo(x1[j]), bf_hi(x1[j])}; } }
            u32x4 bufA[8], bufB[8];
#define LOAD8(buf, TB, hb) do { _Pragma("unroll") for (int e = 0; e < 8; ++e) { const int id = eidL[(hb) * 8 + e]; buf[e] = *(const u32x4*)((TB) + (size_t)id * D + lane * 16); } } while (0)
#define DOT8(buf, off) do { _Pragma("unroll") for (int e = 0; e < 8; ++e) { f32x2 s2 = {0.f, 0.f}; \
                _Pragma("unroll") for (int j = 0; j < 4; ++j) { const int aj = (int)buf[e][j]; s2 += __builtin_amdgcn_cvt_pk_f32_fp8(aj, false) * x2[2 * j]; s2 += __builtin_amdgcn_cvt_pk_f32_fp8(aj, true) * x2[2 * j + 1]; } \
                pp[(off) + e] = s2[0] + s2[1]; } } while (0)
#define REDUCE16(kb) do { const int ke = (kb) * 16 + ((lane >> 2) & 15); const int myid = eidL[ke]; const float su = SU[myid], sv = SVs[myid]; \
            _Pragma("unroll") for (int e = 0; e < 8; ++e) { const bool up = lane & 32; const float keep = up ? pp[e + 8] : pp[e], send = up ? pp[e] : pp[e + 8]; pp[e] = keep + __shfl_xor(send, 32); } \
            _Pragma("unroll") for (int e = 0; e < 4; ++e) { const bool up = lane & 16; const float keep = up ? pp[e + 4] : pp[e], send = up ? pp[e] : pp[e + 4]; pp[e] = keep + __shfl_xor(send, 16); } \
            _Pragma("unroll") for (int e = 0; e < 2; ++e) { const bool up = lane & 8; const float keep = up ? pp[e + 2] : pp[e], send = up ? pp[e] : pp[e + 2]; pp[e] = keep + __shfl_xor(send, 8); } \
            { const bool up = lane & 4; const float keep = up ? pp[1] : pp[0], send = up ? pp[0] : pp[1]; pp[0] = keep + __shfl_xor(send, 4); } \
            float hsum = pp[0]; hsum += __shfl_xor(hsum, 2); hsum += __shfl_xor(hsum, 1); \
            const float cf = wgtL[ke] * gelu_exact(hsum * su) * sv; if ((lane & 3) == 0) coefL[ke] = cf; } while (0)
            LOAD8(bufA, UT, 0);
#pragma unroll 1
            for (int kb = 0; kb < 8; ++kb) {
                float pp[16];
                LOAD8(bufB, UT, 2 * kb + 1);
                DOT8(bufA, 0);
                if (kb < 7) LOAD8(bufA, UT, 2 * kb + 2); else LOAD8(bufA, VT, 0);
                DOT8(bufB, 8);
                REDUCE16(kb);
            }
            asm volatile("s_waitcnt lgkmcnt(0)" ::: "memory");
            f32x2 y2[8];
#pragma unroll
            for (int j = 0; j < 8; ++j) y2[j] = (f32x2){0.f, 0.f};
#define VACC8(buf, hb) do { _Pragma("unroll") for (int e = 0; e < 8; ++e) { const float cf = coefL[(hb) * 8 + e]; const f32x2 cf2 = {cf, cf}; \
                _Pragma("unroll") for (int j = 0; j < 4; ++j) { const int aj = (int)buf[e][j]; y2[2 * j] += cf2 * __builtin_amdgcn_cvt_pk_f32_fp8(aj, false); y2[2 * j + 1] += cf2 * __builtin_amdgcn_cvt_pk_f32_fp8(aj, true); } } } while (0)
#pragma unroll 1
            for (int kb = 0; kb < 8; ++kb) {
                LOAD8(bufB, VT, 2 * kb + 1);
                VACC8(bufA, 2 * kb);
                if (kb < 7) LOAD8(bufA, VT, 2 * kb + 2);
                VACC8(bufB, 2 * kb + 1);
            }
#undef LOAD8
#undef DOT8
#undef REDUCE16
#undef VACC8
            const float* g2 = mod + (t >> 12) * NMOD + 5 * D; float* orow = A.out + (size_t)t * D;
            float z[16]; float ss = 0.f;
#pragma unroll
            for (int q = 0; q < 4; ++q) { const int k = lane * 16 + q * 4; const f32x4 xv = *(const f32x4*)(orow + k), gv = *(const f32x4*)(g2 + k);
                const float yy[4] = {y2[2 * q][0], y2[2 * q][1], y2[2 * q + 1][0], y2[2 * q + 1][1]};
#pragma unroll
                for (int j = 0; j < 4; ++j) { const float zz = xv[j] + gv[j] * yy[j]; z[q * 4 + j] = zz; ss += zz * zz; } }
            const float r = rsqrtf(wave_sum(ss) * (1.f / D) + EPS);
#pragma unroll
            for (int q = 0; q < 4; ++q) { const int k = lane * 16 + q * 4; const f32x4 fv = *(const f32x4*)(A.fg + k);
                f32x4 o;
#pragma unroll
                for (int j = 0; j < 4; ++j) o[j] = z[q * 4 + j] * r * fv[j];
                if (!A.dry || r < 0.f) *(f32x4*)(orow + k) = o; }
        }
    }
}
#define XB_TMO      128
#define XB_XCNT(j)  (256  + 64 * (j))
#define XB_XSUB(j)  (1280 + 64 * (j))
#define XB_XGEN(j)  (2304 + 64 * (j))
#define XB_TOP      3328
#define XB_TOPGEN   3392
#define XCD_BAR_WORDS 3456
#define XB_SPIN_CAP (1u << 22)
__device__ __forceinline__ unsigned xb_ld(unsigned* p)              { return __hip_atomic_load(p, __ATOMIC_RELAXED, __HIP_MEMORY_SCOPE_AGENT); }
__device__ __forceinline__ unsigned xb_add(unsigned* p, unsigned v) { return __hip_atomic_fetch_add(p, v, __ATOMIC_RELAXED, __HIP_MEMORY_SCOPE_AGENT); }
__device__ __forceinline__ unsigned xb_xcc_id() { return (unsigned)__builtin_amdgcn_s_getreg((3 << 11) | 20) & 0xFu; }
#define XB_SPIN(cond, bar) do { unsigned _sp = 0; while (cond) { __builtin_amdgcn_s_sleep(1); \
    if ((++_sp & 255u) == 0u) { if (xb_ld(&(bar)[XB_TMO])) break; if (_sp > XB_SPIN_CAP) { atomicAdd(&(bar)[XB_TMO], 1u); break; } } } } while (0)
struct XcdBarrier { unsigned* bar; unsigned x; volatile LAS unsigned* st; };
__device__ __forceinline__ XcdBarrier xcd_barrier_post(unsigned* bar, volatile LAS unsigned* st) {
    XcdBarrier b; b.bar = bar; b.x = xb_xcc_id(); b.st = st;
    if (threadIdx.x == 0) (void)xb_add(&bar[XB_XCNT(b.x)], 1u);
    return b;
}
__device__ __forceinline__ void xcd_barrier_complete(unsigned* bar, unsigned x, unsigned& nloc, unsigned& nx) {
    const unsigned G = gridDim.x * gridDim.y * gridDim.z;
    unsigned sum, cnt, mine, sp = 0u;
    for (;;) {
        sum = 0u; cnt = 0u; mine = 0u;
#pragma unroll
        for (unsigned j = 0; j < 16; ++j) { const unsigned c = xb_ld(&bar[XB_XCNT(j)]); sum += c; cnt += (c > 0u) ? 1u : 0u; mine = (j == x) ? c : mine; }
        if (sum == G) break;
        __builtin_amdgcn_s_sleep(1);
        if ((++sp & 255u) == 0u) { if (xb_ld(&bar[XB_TMO])) break; if (sp > XB_SPIN_CAP) { atomicAdd(&bar[XB_TMO], 1u); break; } }
    }
    nloc = mine > 0u ? mine : 1u; nx = cnt > 0u ? cnt : 1u;
}
__device__ __forceinline__ void xcd_barrier(const XcdBarrier& b) {
    asm volatile("s_waitcnt vmcnt(0)" ::: "memory");
    __syncthreads();
    if (threadIdx.x == 0) {
        unsigned* bar = b.bar;
        __builtin_amdgcn_s_waitcnt(0);
        unsigned nloc = b.st[0], nx = b.st[1];
        if (nloc == 0u) { xcd_barrier_complete(bar, b.x, nloc, nx); b.st[0] = nloc; b.st[1] = nx; }
        const unsigned old = xb_add(&bar[XB_XSUB(b.x)], 1u);
        const unsigned gen = old / nloc;
        if (old + 1u == (gen + 1u) * nloc) {
            __builtin_amdgcn_fence(__ATOMIC_RELEASE, "agent");
            asm volatile("s_waitcnt vmcnt(0)" ::: "memory");
            const unsigned og = xb_add(&bar[XB_TOP], 1u);
            const unsigned tg = og / nx;
            if (og + 1u == (tg + 1u) * nx) xb_add(&bar[XB_TOPGEN], 1u);
            else XB_SPIN(xb_ld(&bar[XB_TOPGEN]) == tg, bar);
            __builtin_amdgcn_fence(__ATOMIC_ACQUIRE, "agent");
            xb_add(&bar[XB_XGEN(b.x)], 1u);
            asm volatile("s_waitcnt vmcnt(0)" ::: "memory");
        } else {
            XB_SPIN(xb_ld(&bar[XB_XGEN(b.x)]) == gen, bar);
            __builtin_amdgcn_fence(__ATOMIC_ACQUIRE, "agent");
            asm volatile("s_waitcnt vmcnt(0)" ::: "memory");
        }
    }
    __syncthreads();
}
constexpr int MISC_OFF = 135168;

constexpr int N_PHASES = 10;
__global__ void __launch_bounds__(NWAVES * 64, 2) mega_fwd(Args A) {
    extern __shared__ __attribute__((aligned(16))) unsigned char lds[];
    LAS unsigned char* L = (LAS unsigned char*)lds;
    cg::grid_group grid = cg::this_grid();
    const int lo = A.ph_lo, hi = A.ph_hi, G = gridDim.x, c = blockIdx.x;
#ifndef PH_MASK
#define PH_MASK 0x3FF
#endif
#define IN(k) (((PH_MASK >> (k)) & 1) && lo <= (k) && (k) < hi)
    unsigned* barw = (unsigned*)(A.ws + WS_CTL);
    volatile LAS unsigned* MISC = (volatile LAS unsigned*)(L + MISC_OFF);
    if (threadIdx.x < 2) MISC[threadIdx.x] = 0u;
    if (lo == 0 && hi > 1 && blockIdx.x == 0) for (int i = threadIdx.x; i < XCD_BAR_WORDS; i += NWAVES * 64) barw[i] = 0u;
    XcdBarrier xb; xb.bar = barw; xb.x = 0; xb.st = MISC;
#define SEAM(k) do { if (IN(k) && IN((k) + 1)) { if ((k) == 0) { grid.sync(); xb = xcd_barrier_post(barw, MISC); } else xcd_barrier(xb); } } while (0)
    if (IN(0)) phase_prologue(A, L);
    SEAM(0);
    if (IN(1)) phase_hx(A);
    SEAM(1);
    if (IN(2)) { SchedInProj Sd{(const char*)(A.ws + WS_HX), (const char*)(A.ws + WS_HC), (const char*)(A.ws + WS_WIN), G, c}; EpiInProj E{A.ws};
        pg8::gemm_phase<EpiInProj, SchedInProj, true>(L, D, Sd, E); }
    SEAM(2);
    if (IN(3)) { if (!A.dry) phase_kfix(A); phase_conv(A, L); }
    SEAM(3);
    if (IN(4)) phase_attn(A, lds);
    SEAM(4);
    if (IN(5)) { SchedMerge Sd{(const char*)(A.ws + WS_Q), (const char*)(A.ws + WS_HX), (const char*)(A.ws + WS_WA), (const char*)(A.ws + WS_WC), G, c}; EpiMerge E{A.ws};
        pg8::gemm_phase<EpiMerge, SchedMerge, true>(L, D, Sd, E); }
    SEAM(5);
    if (IN(6)) { SchedPlain Sd{(const char*)(A.ws + WS_G), (const char*)(A.ws + WS_WO), M / 256, D / 256, G, c}; EpiOut E{A.x, (const float*)(A.ws + WS_MOD), A.out};
        pg8::gemm_phase<EpiOut, SchedPlain, true>(L, D, Sd, E); }
    SEAM(6);
    if (IN(7)) phase_hx2(A);
    SEAM(7);
    if (IN(8)) { SchedPlain Sd{(const char*)(A.ws + WS_HX), (const char*)(A.ws + WS_WP), M / 256, PW / 256, G, c}; EpiScores E{(float*)(A.ws + WS_SC)};
        pg8::gemm_phase<EpiScores, SchedPlain, true>(L, D, Sd, E); }
    SEAM(8);
    if (IN(9)) phase_peer(A, L);
#undef IN
#undef SEAM
}

#ifndef MK_ONE_LAUNCH
#define MK_ONE_LAUNCH 1
#endif
extern "C" void kernel_launch(void* const* d_in, const int* in_sizes, int n_in, void* d_out, int out_size, void* d_ws, size_t ws_size, hipStream_t stream) {
    static int grid = 0;
    if (grid == 0) {
        if (n_in != 23 || out_size != M * D || ws_size < WS_END) { fprintf(stderr, "kernel_launch: unexpected shapes (n_in %d out %d ws %zu)\n", n_in, out_size, ws_size); grid = -1; return; }
        int dev = 0, cus = 0, per_cu = 0;
        hipGetDevice(&dev); hipDeviceGetAttribute(&cus, hipDeviceAttributeMultiprocessorCount, dev);
        if (hipFuncSetAttribute((const void*)mega_fwd, hipFuncAttributeMaxDynamicSharedMemorySize, LDS_BYTES) != hipSuccess) { fprintf(stderr, "kernel_launch: hipFuncSetAttribute failed\n"); grid = -1; return; }
        if (hipOccupancyMaxActiveBlocksPerMultiprocessor(&per_cu, (const void*)mega_fwd, NWAVES * 64, LDS_BYTES) != hipSuccess || per_cu < 1) { fprintf(stderr, "kernel_launch: occupancy query says %d\n", per_cu); per_cu = 1; }
        (void)hipGetLastError();
        grid = cus * 1;
        if (per_cu < 1) grid = -1;
    }
    if (grid < 0) return;
    Args a{};
    const float** f = (const float**)&a;
    for (int i = 0; i < 23; ++i) f[i] = (const float*)d_in[i];
    a.out = (float*)d_out; a.ws = (unsigned char*)d_ws;
#if MK_ONE_LAUNCH
    a.ph_lo = 0; a.ph_hi = N_PHASES;
    void* args[] = {&a};
    hipError_t e = hipLaunchCooperativeKernel((const void*)mega_fwd, dim3(grid), dim3(NWAVES * 64), args, LDS_BYTES, stream);
    if (e != hipSuccess) fprintf(stderr, "cooperative launch failed: %s (grid %d)\n", hipGetErrorString(e), grid);
#else
#ifndef REPEAT_PH
#define REPEAT_PH -1
#endif
    for (int p = 0; p < N_PHASES; ++p) { a.ph_lo = p; a.ph_hi = p + 1;
        if (p == REPEAT_PH) { a.dry = 1; hipLaunchKernelGGL(mega_fwd, dim3(grid), dim3(NWAVES * 64), LDS_BYTES, stream, a); a.dry = 0; }
        hipLaunchKernelGGL(mega_fwd, dim3(grid), dim3(NWAVES * 64), LDS_BYTES, stream, a); }
#endif
}
```

```cpp
#include <hip/hip_runtime.h>
#include <hip/hip_cooperative_groups.h>
#include <cstdio>
#include <cstdint>
namespace cg = cooperative_groups;

#define LAS __attribute__((address_space(3)))
typedef unsigned short bf16_t;
typedef short bf16x8 __attribute__((ext_vector_type(8)));
typedef short s16x4 __attribute__((ext_vector_type(4)));
typedef float f32x2 __attribute__((ext_vector_type(2)));
typedef float f32x4 __attribute__((ext_vector_type(4)));
typedef float f32x16 __attribute__((ext_vector_type(16)));
typedef unsigned u32x2 __attribute__((ext_vector_type(2)));
typedef unsigned u32x4 __attribute__((ext_vector_type(4)));
typedef __bf16 bf16x2_t __attribute__((ext_vector_type(2)));

constexpr int D = 1024, NB = 8, S = 4096, CTXL = 256, SKV = S + CTXL, HD = 128, HQ = 8, HKV = 2;
constexpr int M = NB * S;
constexpr int MC = NB * CTXL;
constexpr int INW = 5632, NMOD = 6144, NEXP = 16384, PW = 2048;
constexpr float EPS = 1e-6f;

__device__ __forceinline__ unsigned cvt_pk_bf16(float lo, float hi) { f32x2 v = {lo, hi}; bf16x2_t b = __builtin_convertvector(v, bf16x2_t); return __builtin_bit_cast(unsigned, b); }
__device__ __forceinline__ float bf_lo(unsigned u) { return __uint_as_float(u << 16); }
__device__ __forceinline__ float bf_hi(unsigned u) { return __uint_as_float(u & 0xffff0000u); }
__device__ __forceinline__ float fast_sigmoid(float x) { return __builtin_amdgcn_rcpf(1.f + __builtin_amdgcn_exp2f(-1.4426950408889634f * x)); }
__device__ __forceinline__ float wave_sum(float v) {
#pragma unroll
    for (int o = 1; o < 64; o <<= 1) v += __shfl_xor(v, o);
    return v;
}

namespace pg8 {
constexpr int BM = 256, BK = 64, HALF = 128, HTB = HALF * BK * 2  , STAGE_BYTES = 8 * HTB, NXCD = 8, WGM = 8;
__host__ __device__ __forceinline__ int lds_byte(int r, int c) { const int st = (r >> 4) * 2 + (c >> 5), rr = r & 15, cc = c & 31, ob = rr * 64 + cc * 2; return st * 1024 + (ob ^ (((ob >> 9) & 1) << 5)); }
__host__ __device__ __forceinline__ void stage_rc(int b, int& R, int& C) { const int st = b / 1024, sb = b % 1024, swz = sb ^ (((sb >> 9) & 1) << 5); R = (st >> 1) * 16 + swz / 64; C = (st & 1) * 32 + (swz % 64) / 2; }
__host__ __device__ __forceinline__ int perm32(int rho) { const int n = rho >> 4, i = rho & 15; return 8 * (i >> 2) + 4 * n + (i & 3); }

struct Unit { const char* a; const char* b; int pm, pn, kind, keep; };

__device__ __forceinline__ void tile_of(int L, int nM, int nN, int& pm, int& pn) {
    const int nwg = nM * nN; int wgid = L;
    { const int q = nwg / NXCD, r = nwg % NXCD, xcd = wgid % NXCD, off = wgid / NXCD; wgid = (xcd < r ? xcd * (q + 1) : r * (q + 1) + (xcd - r) * q) + off; }
    const int nig = WGM * nN, gid = wgid / nig, fm = gid * WGM, gsz = (nM - fm) < WGM ? (nM - fm) : WGM;
    pm = fm + ((wgid % nig) % gsz); pn = (wgid % nig) / gsz;
}

template <class Epi, class Sched, bool ALIGN_EPI>
__device__ __forceinline__ void gemm_phase(LAS unsigned char* lds, const int K, const Sched& S, const Epi& E) {
    const int tid = threadIdx.x, wid = __builtin_amdgcn_readfirstlane(tid >> 6), lane = tid & 63, wr = wid >> 2, wc = wid & 3, fr = lane & 15, fq = lane >> 4;
    const int nt = K / BK;
    unsigned voffA[2], voffB[2];
#pragma unroll
    for (int i = 0; i < 2; ++i) { int R, C; stage_rc(tid * 16 + i * 8192, R, C); const int Rb = Epi::PERM ? ((R & ~31) + perm32(R & 31)) : R;
        voffA[i] = (unsigned)(R * K + C) * 2u; voffB[i] = (unsigned)(Rb * K + C) * 2u; }
    const size_t kstep = (size_t)(BK * 2);
    const size_t hstep = (size_t)HALF * K * 2;
    const unsigned ldsw = (unsigned)wid * 1024u;
    const int aoff = lds_byte(wr * 64 + fr, fq * 8), boff = lds_byte(wc * 32 + fr, fq * 8);
#define PG8_SA(b, h) (((b) * 2 + (h)) * HTB)
#define PG8_SB(b, h) ((4 + (b) * 2 + (h)) * HTB)
#define PG8_STAGE(bufoff, gbase, voff) do { _Pragma("unroll") for (int _i = 0; _i < 2; ++_i) \
        __builtin_amdgcn_global_load_lds((const unsigned*)((const char*)(gbase) + (voff)[_i]), (LAS unsigned*)(lds + (bufoff) + ldsw + _i * 8192), 16, 0, 0); } while (0)
#define PG8_LDA(dst, b, h) do { _Pragma("unroll") for (int m = 0; m < 4; ++m) _Pragma("unroll") for (int k = 0; k < 2; ++k) dst[m][k] = *(const LAS bf16x8*)(lds + PG8_SA(b, h) + aoff + m * 2048 + k * 1024); } while (0)
#define PG8_LDB(dst, b, h) do { _Pragma("unroll") for (int n = 0; n < 2; ++n) _Pragma("unroll") for (int k = 0; k < 2; ++k) dst[n][k] = *(const LAS bf16x8*)(lds + PG8_SB(b, h) + boff + n * 2048 + k * 1024); } while (0)
#define PG8_MMA(ai, bj, At, Bt) do { __builtin_amdgcn_s_setprio(1); _Pragma("unroll") for (int m = 0; m < 4; ++m) _Pragma("unroll") for (int n = 0; n < 2; ++n) _Pragma("unroll") for (int k = 0; k < 2; ++k) \
        acc[ai][bj][m][n] = __builtin_amdgcn_mfma_f32_16x16x32_bf16(Bt[n][k], At[m][k], acc[ai][bj][m][n], 0, 0, 0); __builtin_amdgcn_s_setprio(0); } while (0)
#define PG8_WAIT_V(n) asm volatile("s_waitcnt vmcnt(" #n ")" ::: "memory")
#define PG8_WAIT_L(n) asm volatile("s_waitcnt lgkmcnt(" #n ")" ::: "memory")
#define PG8_BAR __builtin_amdgcn_s_barrier()
#define PG8_SCHED __builtin_amdgcn_sched_barrier(0)
    Unit cur, nxt; int ui = 0;
    if (!S.next(0, cur)) return;
    f32x4 acc[2][2][4][2];
#pragma unroll
    for (int a = 0; a < 2; ++a)
#pragma unroll
        for (int b = 0; b < 2; ++b)
#pragma unroll
            for (int m = 0; m < 4; ++m)
#pragma unroll
                for (int n = 0; n < 2; ++n) acc[a][b][m][n] = (f32x4){0.f, 0.f, 0.f, 0.f};
    bf16x8 At[4][2], B0[2][2], B1[2][2];
    const char* cA = cur.a; const char* cB = cur.b;
    PG8_STAGE(PG8_SB(0, 0), cB, voffB); PG8_STAGE(PG8_SB(0, 1), cB + hstep, voffB); PG8_STAGE(PG8_SA(0, 0), cA, voffA); PG8_STAGE(PG8_SA(0, 1), cA + hstep, voffA);
    if (wr == 1) PG8_BAR;
    PG8_WAIT_V(2); PG8_BAR;
    PG8_STAGE(PG8_SB(1, 0), cB + kstep, voffB); PG8_STAGE(PG8_SA(1, 0), cA + kstep, voffA); PG8_STAGE(PG8_SB(1, 1), cB + hstep + kstep, voffB);
    PG8_WAIT_V(6); PG8_BAR;
    for (;;) {
        const bool has_next = S.next(ui + 1, nxt);
        const char* nA = has_next ? nxt.a : cA; const char* nB = has_next ? nxt.b : cB;
        for (int t = 0; t < nt; t += 2) {
            const bool last = (t == nt - 2);
            const char* a1 = cA + (size_t)(t + 1) * kstep;
            const char* a2 = last ? nA : cA + (size_t)(t + 2) * kstep; const char* b2 = last ? nB : cB + (size_t)(t + 2) * kstep;
            const char* a3 = a2 + kstep; const char* b3 = b2 + kstep;
            PG8_LDB(B0, 0, 0); PG8_LDB(B1, 0, 1); PG8_SCHED; PG8_LDA(At, 0, 0); PG8_STAGE(PG8_SA(1, 1), a1 + hstep, voffA);
            PG8_WAIT_V(8); PG8_WAIT_L(0); PG8_BAR; PG8_MMA(0, 0, At, B0); PG8_MMA(0, 1, At, B1); PG8_BAR; PG8_SCHED;
            PG8_LDA(At, 0, 1); PG8_STAGE(PG8_SB(0, 0), b2, voffB); PG8_STAGE(PG8_SB(0, 1), b2 + hstep, voffB); PG8_STAGE(PG8_SA(0, 0), a2, voffA);
            PG8_WAIT_V(8); PG8_WAIT_L(0); PG8_BAR; PG8_MMA(1, 0, At, B0); PG8_MMA(1, 1, At, B1); PG8_BAR; PG8_SCHED;
            PG8_LDB(B0, 1, 0); PG8_LDB(B1, 1, 1); PG8_SCHED; PG8_LDA(At, 1, 0); PG8_STAGE(PG8_SA(0, 1), a2 + hstep, voffA);
            PG8_WAIT_V(8); PG8_WAIT_L(0); PG8_BAR; PG8_MMA(0, 0, At, B0); PG8_MMA(0, 1, At, B1); PG8_BAR; PG8_SCHED;
            PG8_LDA(At, 1, 1); PG8_STAGE(PG8_SB(1, 0), b3, voffB); PG8_STAGE(PG8_SB(1, 1), b3 + hstep, voffB); PG8_STAGE(PG8_SA(1, 0), a3, voffA);
            PG8_WAIT_V(8); PG8_WAIT_L(0); PG8_BAR; PG8_MMA(1, 0, At, B0); PG8_MMA(1, 1, At, B1); PG8_BAR; PG8_SCHED;
        }
        if constexpr (ALIGN_EPI) { if (wr == 0) PG8_BAR; }
        E(acc, cur, wr, wc, fr, fq);
        if (!has_next) break;
        if (!cur.keep) {
#pragma unroll
        for (int a = 0; a < 2; ++a)
#pragma unroll
            for (int b = 0; b < 2; ++b)
#pragma unroll
                for (int m = 0; m < 4; ++m)
#pragma unroll
                    for (int n = 0; n < 2; ++n) acc[a][b][m][n] = (f32x4){0.f, 0.f, 0.f, 0.f};
        }
        cur = nxt; cA = nA; cB = nB; ++ui;
        if constexpr (ALIGN_EPI) { if (wr == 1) PG8_BAR; }
    }
    PG8_WAIT_V(0);
    if constexpr (!ALIGN_EPI) { if (wr == 0) PG8_BAR; }
    PG8_BAR;
#undef PG8_SA
#undef PG8_SB
#undef PG8_STAGE
#undef PG8_LDA
#undef PG8_LDB
#undef PG8_MMA
#undef PG8_WAIT_V
#undef PG8_WAIT_L
#undef PG8_BAR
#undef PG8_SCHED
}
}
namespace att {
constexpr int NW = 8, QBLK = 32, KVBLK = 64;
constexpr float SCALE = 0.088388347648318440f;
constexpr float THR = 8.f;
constexpr int LDQ = D, LDK = HKV * HD, LDO = D;
constexpr int SHM_V = KVBLK * HD * 2, SHM_K = KVBLK * HD * 2, SHM_ATTN = 2 * SHM_V + 2 * SHM_K + NW * 64 * 4;
constexpr int OST_OFF = SHM_ATTN, LDS_TOTAL = OST_OFF + NW * 8192;
#define KSWZ(row, colB) ((row) * 256 + ((colB) ^ (((row) & 7) << 4)))
#define SBAR() __builtin_amdgcn_sched_barrier(0)
__device__ __forceinline__ int crow(int r, int hi) { return (r & 3) + 8 * (r >> 2) + 4 * hi; }
__device__ __forceinline__ unsigned cvtpk(float lo, float hi) { unsigned r; asm volatile("v_cvt_pk_bf16_f32 %0, %1, %2" : "=v"(r) : "v"(lo), "v"(hi)); return r; }

__device__ __forceinline__ void partialSM(f32x16& p0, f32x16& p1, float& m_reg, float& mn, float& alpha) {
  constexpr float C = SCALE * 1.4426950408889634f;
  float pmax = p0[0]; for (int r = 1; r < 16; ++r) pmax = fmaxf(pmax, p0[r]); for (int r = 0; r < 16; ++r) pmax = fmaxf(pmax, p1[r]);
  { auto rr = __builtin_amdgcn_permlane32_swap(__float_as_uint(pmax), __float_as_uint(pmax), false, false);
    pmax = fmaxf(__uint_as_float(rr[0]), __uint_as_float(rr[1])); }
  if (__builtin_expect(__all(pmax - m_reg <= THR / SCALE), 1)) { mn = m_reg; alpha = 1.f; }
  else { mn = fmaxf(m_reg, pmax); alpha = __builtin_amdgcn_exp2f((m_reg - mn) * C); m_reg = mn; }
  float mnC = -mn * C;
  for (int r = 0; r < 16; ++r) p0[r] = fmaf(p0[r], C, mnC); for (int r = 0; r < 16; ++r) p1[r] = fmaf(p1[r], C, mnC);
  for (int r = 0; r < 16; ++r) p0[r] = __builtin_amdgcn_exp2f(p0[r]);
}
__device__ __forceinline__ void finishSM(f32x16& p0, f32x16& p1, float alpha, float& l_reg, bf16x8& pa0, bf16x8& pa1, bf16x8& pa2, bf16x8& pa3) {
  for (int r = 0; r < 16; ++r) p1[r] = __builtin_amdgcn_exp2f(p1[r]);
  float ps = 0; for (int r = 0; r < 16; ++r) ps += p0[r]; for (int r = 0; r < 16; ++r) ps += p1[r];
  { auto rr = __builtin_amdgcn_permlane32_swap(__float_as_uint(ps), __float_as_uint(ps), false, false);
    ps = __uint_as_float(rr[0]) + __uint_as_float(rr[1]); }
  l_reg = l_reg * alpha + ps;
#define PK4(P, BASE, OUT) do { unsigned a0 = cvtpk(P[BASE + 0], P[BASE + 1]), a1 = cvtpk(P[BASE + 2], P[BASE + 3]);   \
    unsigned b0 = cvtpk(P[BASE + 4], P[BASE + 5]), b1 = cvtpk(P[BASE + 6], P[BASE + 7]);                              \
    auto r0 = __builtin_amdgcn_permlane32_swap(a0, b0, false, false); auto r1 = __builtin_amdgcn_permlane32_swap(a1, b1, false, false); \
    u32x4 w = {r0[0], r1[0], r0[1], r1[1]}; OUT = *reinterpret_cast<bf16x8*>(&w); } while (0)
  PK4(p0, 0, pa0); PK4(p0, 8, pa1); PK4(p1, 0, pa2); PK4(p1, 8, pa3);
#undef PK4
}
__device__ __forceinline__ void qkt(f32x16& p0, f32x16& p1, const bf16_t* Ks, const bf16x8* qr, int r32, int hi) {
  p0 = f32x16{}; p1 = f32x16{};
  for (int d0 = 0; d0 < 8; ++d0) { int cb = (d0 * 16 + hi * 8) * 2;
    bf16x8 b0 = *reinterpret_cast<const bf16x8*>((const char*)Ks + KSWZ(r32, cb));
    bf16x8 b1 = *reinterpret_cast<const bf16x8*>((const char*)Ks + KSWZ(32 + r32, cb));
    p0 = __builtin_amdgcn_mfma_f32_32x32x16_bf16(b0, qr[d0], p0, 0, 0, 0);
    p1 = __builtin_amdgcn_mfma_f32_32x32x16_bf16(b1, qr[d0], p1, 0, 0, 0); }
}
__device__ __forceinline__ int v_st(int k, int c) { const int kk = (k & ~0xC) | ((k & 4) << 1) | ((k & 8) >> 1); return ((kk >> 3) * 4 + (c >> 5)) * 512 + ((kk & 7) * 32 + (c & 31)) * 2; }
__device__ __forceinline__ int v_rd_base(int lane) { return ((lane & 3) << 3) | (((lane >> 2) & 3) << 6) | (((lane >> 4) & 1) << 5) | (((lane >> 5) & 1) << 8); }
constexpr int v_rd_off(int d0, int ks, int half) { return d0 * 512 + ks * 4096 + half * 2048; }
template <int OFF> __device__ __forceinline__ s16x4 tr_read(int vb) {
  s16x4 r; asm volatile("ds_read_b64_tr_b16 %0, %1 offset:%2" : "=&v"(r) : "v"(vb), "i"(OFF) : "memory"); return r;
}
template <int D0> __device__ __forceinline__ void pv_one(f32x16& od, int vb, bf16x8 pa0, bf16x8 pa1, bf16x8 pa2, bf16x8 pa3) {
  const s16x4 l0 = tr_read<v_rd_off(D0, 0, 0)>(vb), h0 = tr_read<v_rd_off(D0, 0, 1)>(vb), l1 = tr_read<v_rd_off(D0, 1, 0)>(vb), h1 = tr_read<v_rd_off(D0, 1, 1)>(vb);
  const s16x4 l2 = tr_read<v_rd_off(D0, 2, 0)>(vb), h2 = tr_read<v_rd_off(D0, 2, 1)>(vb), l3 = tr_read<v_rd_off(D0, 3, 0)>(vb), h3 = tr_read<v_rd_off(D0, 3, 1)>(vb);
  asm volatile("s_waitcnt lgkmcnt(0)" ::: "memory"); SBAR();
#define PK(L, H) (bf16x8){L[0], L[1], L[2], L[3], H[0], H[1], H[2], H[3]}
  od = __builtin_amdgcn_mfma_f32_32x32x16_bf16(pa0, PK(l0, h0), od, 0, 0, 0);
  od = __builtin_amdgcn_mfma_f32_32x32x16_bf16(pa1, PK(l1, h1), od, 0, 0, 0);
  od = __builtin_amdgcn_mfma_f32_32x32x16_bf16(pa2, PK(l2, h2), od, 0, 0, 0);
  od = __builtin_amdgcn_mfma_f32_32x32x16_bf16(pa3, PK(l3, h3), od, 0, 0, 0);
#undef PK
}
__device__ __forceinline__ void pv_d0(f32x16* o, int vb, bf16x8 pa0, bf16x8 pa1, bf16x8 pa2, bf16x8 pa3) {
  pv_one<0>(o[0], vb, pa0, pa1, pa2, pa3); pv_one<1>(o[1], vb, pa0, pa1, pa2, pa3); pv_one<2>(o[2], vb, pa0, pa1, pa2, pa3); pv_one<3>(o[3], vb, pa0, pa1, pa2, pa3);
}

__device__ __forceinline__ void attn_unit(const bf16_t* Qb, const bf16_t* __restrict__ Kh, const bf16_t* __restrict__ Vh, bf16_t* Ob, int t0, int seq,
                                          const float* __restrict__ qng, const float* __restrict__ cst, const float* __restrict__ snt, char* lds) {
  int tid_ = threadIdx.x; asm volatile("" : "+v"(tid_));
  const int tid = tid_, wid = tid >> 6, lane = tid & 63, r32 = lane & 31, hi = lane >> 5;
  bf16_t* V_lds = (bf16_t*)lds; bf16_t* K_lds = (bf16_t*)(lds + 2 * SHM_V);
  float* ws = (float*)(lds + 2 * SHM_V + 2 * SHM_K) + wid * 64; float* li_l = ws; float* al_l = ws + 32;
  float m_reg = -1e30f, l_reg = 0; f32x16 o[4] = {}; bf16x8 qr[8];
  {
    const bf16_t* Qw = Qb + (long)(wid * QBLK + r32) * LDQ + hi * 8;
    float y[8][8]; float ss = 0.f;
#pragma unroll
    for (int d0 = 0; d0 < 8; ++d0) { const u32x4 w = *reinterpret_cast<const u32x4*>(Qw + d0 * 16);
#pragma unroll
      for (int j = 0; j < 4; ++j) { y[d0][2 * j] = bf_lo(w[j]); y[d0][2 * j + 1] = bf_hi(w[j]); ss += y[d0][2 * j] * y[d0][2 * j] + y[d0][2 * j + 1] * y[d0][2 * j + 1]; } }
    ss += __shfl_xor(ss, 32);
    const float rstd = rsqrtf(ss * (1.f / HD) + EPS);
#pragma unroll
    for (int d0 = 0; d0 < 8; ++d0) { const f32x4 g0 = *reinterpret_cast<const f32x4*>(qng + d0 * 16 + hi * 8), g1 = *reinterpret_cast<const f32x4*>(qng + d0 * 16 + hi * 8 + 4);
#pragma unroll
      for (int j = 0; j < 4; ++j) { y[d0][j] *= rstd * g0[j]; y[d0][4 + j] *= rstd * g1[j]; } }
    const int t = t0 + wid * QBLK + r32;
#pragma unroll
    for (int blk = 0; blk < 2; ++blk) { const int pos = blk == 0 ? (t >> 6) : (t & 63);
#pragma unroll
      for (int dd = 0; dd < 2; ++dd) { const int da = blk * 4 + dd, db = da + 2;
#pragma unroll
        for (int j4 = 0; j4 < 2; ++j4) { const f32x4 c4 = *reinterpret_cast<const f32x4*>(cst + pos * 32 + dd * 16 + hi * 8 + j4 * 4), s4 = *reinterpret_cast<const f32x4*>(snt + pos * 32 + dd * 16 + hi * 8 + j4 * 4);
#pragma unroll
          for (int j = 0; j < 4; ++j) { const float x1 = y[da][j4 * 4 + j], x2 = y[db][j4 * 4 + j]; y[da][j4 * 4 + j] = x1 * c4[j] - x2 * s4[j]; y[db][j4 * 4 + j] = x1 * s4[j] + x2 * c4[j]; } } } }
#pragma unroll
    for (int d0 = 0; d0 < 8; ++d0) { u32x4 w = {cvt_pk_bf16(y[d0][0], y[d0][1]), cvt_pk_bf16(y[d0][2], y[d0][3]), cvt_pk_bf16(y[d0][4], y[d0][5]), cvt_pk_bf16(y[d0][6], y[d0][7])}; qr[d0] = *reinterpret_cast<bf16x8*>(&w); }
  }
  const int sr = tid >> 4, sc = (tid & 15) * 8, vst0 = v_st(sr, sc), vst1 = v_st(32 + sr, sc);
  const int vb0 = (int)(uintptr_t)V_lds + v_rd_base(lane);
  struct { bf16x8 vs0, vs1, ks0, ks1; } sr_[2];
#define LD8(p) (*reinterpret_cast<const bf16x8*>(p))
#define SLOAD(i, k0) do { sr_[i].vs0 = LD8(&Vh[(long)((k0) + sr) * LDK + sc]); sr_[i].vs1 = LD8(&Vh[(long)((k0) + 32 + sr) * LDK + sc]); \
    sr_[i].ks0 = LD8(&Kh[(long)((k0) + sr) * LDK + sc]); sr_[i].ks1 = LD8(&Kh[(long)((k0) + 32 + sr) * LDK + sc]); } while (0)
#define SWRITE(b, i) do { *(bf16x8*)((char*)V_lds + (b) * SHM_V + vst0) = sr_[i].vs0;          \
    *(bf16x8*)((char*)V_lds + (b) * SHM_V + vst1) = sr_[i].vs1; int kc = sc * 2;               \
    *(bf16x8*)((char*)K_lds + (b) * SHM_K + KSWZ(sr, kc)) = sr_[i].ks0;                       \
    *(bf16x8*)((char*)K_lds + (b) * SHM_K + KSWZ(32 + sr, kc)) = sr_[i].ks1; } while (0)
#define SWAIT() asm volatile("s_waitcnt vmcnt(4)" ::: "memory")
#define RESC(a) do { if (__any((a) < 1.f)) { if (hi == 0) al_l[r32] = (a); asm volatile("s_waitcnt lgkmcnt(0)" ::: "memory"); \
    for (int d = 0; d < 4; ++d) for (int r = 0; r < 16; ++r) o[d][r] *= al_l[crow(r, hi)]; } } while (0)
  f32x16 pA0, pA1, pB0, pB1; float mnA, mnB, alA, alB; bf16x8 pa0, pa1, pa2, pa3; const int NT = seq / KVBLK;
  constexpr int SE = 0, SO = 1;
  SLOAD(SE, 0); asm volatile("s_waitcnt vmcnt(0)" ::: "memory"); SWRITE(0, SE); __syncthreads();
  qkt(pA0, pA1, K_lds, qr, r32, hi); partialSM(pA0, pA1, m_reg, mnA, alA);
  SLOAD(SO, KVBLK); if (2 < NT) SLOAD(SE, 2 * KVBLK);
  SWAIT(); SWRITE(1, SO); __syncthreads();
  for (int j = 1; j + 1 < NT; j += 2) {
    SBAR(); qkt(pB0, pB1, (bf16_t*)((char*)K_lds + SHM_K), qr, r32, hi);
    finishSM(pA0, pA1, alA, l_reg, pa0, pa1, pa2, pa3); SBAR();
    SLOAD(SO, (j + 2) * KVBLK); SBAR();
    pv_d0(o, vb0, pa0, pa1, pa2, pa3); partialSM(pB0, pB1, m_reg, mnB, alB);
    __syncthreads(); SWAIT(); SWRITE(0, SE);
    RESC(alB); __syncthreads();
    SBAR(); qkt(pA0, pA1, K_lds, qr, r32, hi);
    finishSM(pB0, pB1, alB, l_reg, pa0, pa1, pa2, pa3); SBAR();
    if (j + 3 < NT) SLOAD(SE, (j + 3) * KVBLK); SBAR();
    pv_d0(o, vb0 + (int)SHM_V, pa0, pa1, pa2, pa3); partialSM(pA0, pA1, m_reg, mnA, alA);
    __syncthreads(); SWAIT(); SWRITE(1, SO);
    RESC(alA); __syncthreads();
  }
  SBAR(); qkt(pB0, pB1, (bf16_t*)((char*)K_lds + SHM_K), qr, r32, hi);
  finishSM(pA0, pA1, alA, l_reg, pa0, pa1, pa2, pa3); SBAR();
  pv_d0(o, vb0, pa0, pa1, pa2, pa3); partialSM(pB0, pB1, m_reg, mnB, alB);
  __syncthreads(); RESC(alB);
  finishSM(pB0, pB1, alB, l_reg, pa0, pa1, pa2, pa3); SBAR();
  pv_d0(o, vb0 + (int)SHM_V, pa0, pa1, pa2, pa3);
  if (hi == 0) li_l[r32] = l_reg; asm volatile("s_waitcnt lgkmcnt(0)" ::: "memory");
  float rli[16];
#pragma unroll
  for (int r = 0; r < 16; ++r) rli[r] = __builtin_amdgcn_rcpf(li_l[crow(r, hi)]);
  { bf16_t* stg = (bf16_t*)(lds + OST_OFF) + wid * 4096;
#pragma unroll
    for (int r = 0; r < 16; ++r) { const int orow = crow(r, hi);
#pragma unroll
      for (int d0 = 0; d0 < 4; ++d0) stg[orow * 128 + d0 * 32 + r32] = (bf16_t)(cvt_pk_bf16(o[d0][r] * rli[r], 0.f) & 0xffffu); }
    asm volatile("s_waitcnt lgkmcnt(0)" ::: "memory");
    bf16_t* Ow = Ob + (long)(wid * QBLK) * LDO;
#pragma unroll
    for (int i = 0; i < 8; ++i) { const int row = i * 4 + (lane >> 4), ch = lane & 15; const u32x4 v = *(const u32x4*)(stg + row * 128 + ch * 8); *(u32x4*)(Ow + (long)row * LDO + ch * 8) = v; }
  }
#undef LD8
#undef SLOAD
#undef SWRITE
#undef SWAIT
#undef RESC
}
#undef KSWZ
#undef SBAR
}
constexpr size_t MiB = 1u << 20;
constexpr size_t WS_CTL = 0, CTL_ZERO_BYTES = 64 * 1024;
constexpr size_t WS_MOD = 1 * MiB;
constexpr size_t WS_ROPE = WS_MOD + 256 * 1024;
constexpr size_t WS_SBIAS = WS_MOD + 512 * 1024;
constexpr size_t WS_HC = 2 * MiB;
constexpr size_t WS_WIN = 6 * MiB;
constexpr size_t WS_WA = 17 * MiB, WS_WC = 19 * MiB, WS_WO = 21 * MiB;
constexpr size_t WS_WP = 23 * MiB;
constexpr size_t WS_UT = 27 * MiB, WS_VT = 59 * MiB;
constexpr size_t WS_TSCALE = 16 * MiB;
constexpr size_t WS_KB = 91 * MiB, WS_VB = 108 * MiB;
constexpr size_t WS_HX = 125 * MiB;
constexpr size_t WS_Q = 189 * MiB;
constexpr size_t WS_G = 253 * MiB;
constexpr size_t WS_RT = 317 * MiB;
constexpr size_t WS_SGC = 381 * MiB;
constexpr size_t WS_SC = 189 * MiB;
constexpr size_t WS_SSQ = 445 * MiB;
constexpr size_t WS_END = 447 * MiB;

constexpr int NWAVES = 8;
constexpr int LDS_BYTES = 147456;

struct Args {
    const float *x, *c, *ctx, *c_ctx, *w_mod, *b_mod, *n1g, *n2g, *w_in, *qng, *kng, *w_ao, *cdw, *cb, *clg, *clb, *w_co, *w_o, *wq, *keys, *ut, *vt, *fg;
    float* out; unsigned char* ws; int ph_lo, ph_hi, dry, pad;
};

__host__ __device__ __forceinline__ int win_row(int n) {
    if (n < 1536) return n;
    const int base = n < 3584 ? 1536 : 3584, m = n - base, half = m >> 10, idx = m & 1023;
    return base + (idx >> 7) * 256 + half * 128 + (idx & 127);
}

__device__ __forceinline__ void task_mod(const Args& A, int task, int lane, const LAS float* sc) {
    const int n0 = task * 8, col = lane & 7, kg = lane >> 3;
    float acc[9];
#pragma unroll
    for (int b = 0; b < 9; ++b) acc[b] = 0.f;
    const float* wp = A.w_mod + (size_t)kg * NMOD + n0 + col;
    for (int i0 = 0; i0 < 128; i0 += 8) {
        float w[8];
#pragma unroll
        for (int u = 0; u < 8; ++u) w[u] = wp[(size_t)(i0 + u) * 8 * NMOD];
#pragma unroll
        for (int u = 0; u < 8; ++u) { const int k = kg + 8 * (i0 + u);
#pragma unroll
            for (int b = 0; b < 9; ++b) acc[b] += sc[b * D + k] * w[u]; }
    }
#pragma unroll
    for (int b = 0; b < 9; ++b) { float v = acc[b]; v += __shfl_xor(v, 8); v += __shfl_xor(v, 16); v += __shfl_xor(v, 32); acc[b] = v; }
    if (lane < 8) { float* mod = (float*)(A.ws + WS_MOD); const float bm = A.b_mod[n0 + col];
#pragma unroll
        for (int b = 0; b < 9; ++b) mod[b * NMOD + n0 + col] = acc[b] + bm; }
}
__device__ __forceinline__ void task_transpose(const float* W, int K, int N, bf16_t* WT, int k0, int n0, int row0, LAS float* scr, int lane) {
#pragma unroll 8
    for (int i = 0; i < 32; ++i) { const int kk = 2 * i + (lane >> 5); scr[kk * 33 + (lane & 31)] = W[(size_t)(k0 + kk) * N + n0 + (lane & 31)]; }
    asm volatile("s_waitcnt lgkmcnt(0)" ::: "memory");
    const int c = lane & 7;
#pragma unroll
    for (int j = 0; j < 4; ++j) { const int n = (lane >> 3) + 8 * j; const LAS float* s = scr + (8 * c) * 33 + n;
        u32x4 o; o.x = cvt_pk_bf16(s[0 * 33], s[1 * 33]); o.y = cvt_pk_bf16(s[2 * 33], s[3 * 33]); o.z = cvt_pk_bf16(s[4 * 33], s[5 * 33]); o.w = cvt_pk_bf16(s[6 * 33], s[7 * 33]);
        *(u32x4*)(WT + (size_t)(row0 + n) * K + k0 + 8 * c) = o; }
    asm volatile("s_waitcnt lgkmcnt(0)" ::: "memory");
}
__device__ __forceinline__ void task_quant_rows4(const float* src, unsigned char* dst, float* scale_out, int lane) {
    f32x4 v[4][4];
#pragma unroll
    for (int r = 0; r < 4; ++r)
#pragma unroll
        for (int i = 0; i < 4; ++i) v[r][i] = *(const f32x4*)(src + (size_t)r * D + (i * 64 + lane) * 4);
#pragma unroll
    for (int r = 0; r < 4; ++r) {
        float am = 0.f;
#pragma unroll
        for (int i = 0; i < 4; ++i) am = fmaxf(fmaxf(am, fmaxf(fabsf(v[r][i][0]), fabsf(v[r][i][1]))), fmaxf(fabsf(v[r][i][2]), fabsf(v[r][i][3])));
#pragma unroll
        for (int o = 1; o < 64; o <<= 1) am = fmaxf(am, __shfl_xor(am, o));
        const float inv = am > 0.f ? 448.f / am : 0.f;
#pragma unroll
        for (int i = 0; i < 4; ++i) { int p = __builtin_amdgcn_cvt_pk_fp8_f32(v[r][i][0] * inv, v[r][i][1] * inv, 0, false); p = __builtin_amdgcn_cvt_pk_fp8_f32(v[r][i][2] * inv, v[r][i][3] * inv, p, true);
            *(int*)(dst + (size_t)r * D + (i * 64 + lane) * 4) = p; }
        if (lane == 0) scale_out[r] = am * (1.f / 448.f);
    }
}
__device__ __forceinline__ bf16x8 ld8_f32_bf16(const float* p) { const f32x4 a = *(const f32x4*)p, b = *(const f32x4*)(p + 4); u32x4 w = {cvt_pk_bf16(a[0], a[1]), cvt_pk_bf16(a[2], a[3]), cvt_pk_bf16(b[0], b[1]), cvt_pk_bf16(b[2], b[3])}; return *reinterpret_cast<bf16x8*>(&w); }
__device__ __forceinline__ void task_wprime(const Args& A, int id, int lane) {
    const int hp = id >> 7, rem = id & 127, n0 = (rem >> 5) * 32, k0 = (rem & 31) * 32, r32 = lane & 31, hi = lane >> 5;
    f32x16 acc = {};
    const float* ka = A.keys + ((size_t)(hp * 128 + n0 + r32)) * 128 + hi * 8;
    const float* wb = A.wq + (size_t)(k0 + r32) * PW + hp * 128 + hi * 8;
#pragma unroll
    for (int s = 0; s < 8; ++s) acc = __builtin_amdgcn_mfma_f32_32x32x16_bf16(ld8_f32_bf16(ka + s * 16), ld8_f32_bf16(wb + s * 16), acc, 0, 0, 0);
    bf16_t* o = (bf16_t*)(A.ws + WS_WP);
#pragma unroll
    for (int r = 0; r < 16; ++r) { const int n = (r & 3) + 8 * (r >> 2) + 4 * hi; o[(size_t)(hp * 128 + n0 + n) * D + k0 + r32] = (bf16_t)(cvt_pk_bf16(acc[r], 0.f) & 0xffffu); }
}
__device__ __forceinline__ void phase_prologue(const Args& A, LAS unsigned char* lds) {
    const int tid = threadIdx.x, lane = tid & 63, wave = __builtin_amdgcn_readfirstlane(tid >> 6);
    LAS float* sc = (LAS float*)lds;
    for (int i = tid; i < 9 * D; i += 512) { const float v = i < 8 * D ? A.c[i] : A.c_ctx[i - 8 * D]; sc[i] = v / (1.f + __expf(-v)); }
    __syncthreads();
    LAS float* scr = (LAS float*)(lds + 36864 + wave * 8448);
    constexpr int T_MOD = NMOD / 8, T_WIN = (D / 64) * (INW / 32), T_SQ = (D / 64) * (D / 32), T_UV = 2 * NEXP / 4, T_WP = 2048, T_ROPE = 1;
    constexpr int NT = T_MOD + T_WIN + 3 * T_SQ + T_UV + T_WP + T_ROPE;
    const int G = gridDim.x;
    for (int task = wave * G + blockIdx.x; task < NT; task += NWAVES * G) {
        int r = task;
        if (r < T_MOD) { task_mod(A, r, lane, sc); continue; } r -= T_MOD;
        if (r < T_WIN) { const int nblk = INW / 32, kb = r / nblk, nb = r % nblk; task_transpose(A.w_in, D, INW, (bf16_t*)(A.ws + WS_WIN), 64 * kb, 32 * nb, win_row(32 * nb), scr, lane); continue; } r -= T_WIN;
        if (r < 3 * T_SQ) { const int wsel = r / T_SQ, q = r % T_SQ, kb = q / 32, nb = q % 32;
            const float* W = wsel == 0 ? A.w_ao : (wsel == 1 ? A.w_co : A.w_o); bf16_t* WT = (bf16_t*)(A.ws + (wsel == 0 ? WS_WA : (wsel == 1 ? WS_WC : WS_WO)));
            task_transpose(W, D, D, WT, 64 * kb, 32 * nb, 32 * nb, scr, lane); continue; } r -= 3 * T_SQ;
        if (r < T_UV) { const int tb = r / (NEXP / 4), row = (r % (NEXP / 4)) * 4; unsigned char* tbase = A.ws + (tb ? WS_VT : WS_UT);
            task_quant_rows4((tb ? A.vt : A.ut) + (size_t)row * D, tbase + (size_t)row * D, (float*)(tbase + WS_TSCALE) + row, lane); continue; } r -= T_UV;
        if (r < T_WP) { task_wprime(A, r, lane); continue; } r -= T_WP;
        { float* cs = (float*)(A.ws + WS_ROPE); float* sn = cs + 2048;
          for (int e = lane; e < 2048; e += 64) { const int p = e >> 5, i = e & 31; const float inv = powf(10000.f, -(float)(2 * i) / 64.f); const float a = (float)p * inv; cs[e] = cosf(a); sn[e] = sinf(a); } }
    }
}
__device__ __forceinline__ void normmod_row(const float* xr, const float* g, const float* modr, int sh_off, int sc_off, bf16_t* orow, int lane) {
    f32x4 v[4]; float ss = 0.f;
#pragma unroll
    for (int i = 0; i < 4; ++i) { v[i] = *(const f32x4*)(xr + (i * 64 + lane) * 4); ss += (v[i][0] * v[i][0] + v[i][1] * v[i][1]) + (v[i][2] * v[i][2] + v[i][3] * v[i][3]); }
    const float r = rsqrtf(wave_sum(ss) * (1.f / D) + EPS);
#pragma unroll
    for (int i = 0; i < 4; ++i) { const int k = (i * 64 + lane) * 4; const f32x4 gg = *(const f32x4*)(g + k), s1 = *(const f32x4*)(modr + sc_off + k), h1 = *(const f32x4*)(modr + sh_off + k);
        float y[4];
#pragma unroll
        for (int j = 0; j < 4; ++j) y[j] = v[i][j] * r * gg[j] * (1.f + s1[j]) + h1[j];
        u32x2 o = {cvt_pk_bf16(y[0], y[1]), cvt_pk_bf16(y[2], y[3])}; *(u32x2*)(orow + k) = o; }
}
__device__ __forceinline__ void phase_hx(const Args& A) {
    const int lane = threadIdx.x & 63, gw = blockIdx.x * NWAVES + (threadIdx.x >> 6), NGW = gridDim.x * NWAVES;
    const float* mod = (const float*)(A.ws + WS_MOD);
    for (int m = gw; m < M + MC; m += NGW) {
        if (m < M) normmod_row(A.x + (size_t)m * D, A.n1g, mod + (m >> 12) * NMOD, 0, D, (bf16_t*)(A.ws + WS_HX) + (size_t)m * D, lane);
        else { const int r = m - M; normmod_row(A.ctx + (size_t)r * D, A.n1g, mod + 8 * NMOD, 0, D, (bf16_t*)(A.ws + WS_HC) + (size_t)r * D, lane); }
    }
    const bf16_t* WP = (const bf16_t*)(A.ws + WS_WP); float* sb = (float*)(A.ws + WS_SBIAS);
    for (int col = gw; col < PW; col += NGW) {
        const u32x4 w0 = *(const u32x4*)(WP + (size_t)col * D + lane * 16), w1 = *(const u32x4*)(WP + (size_t)col * D + lane * 16 + 8);
        float wv[16];
#pragma unroll
        for (int j = 0; j < 4; ++j) { wv[2 * j] = bf_lo(w0[j]); wv[2 * j + 1] = bf_hi(w0[j]); wv[8 + 2 * j] = bf_lo(w1[j]); wv[8 + 2 * j + 1] = bf_hi(w1[j]); }
#pragma unroll 1
        for (int b = 0; b < NB; ++b) { const float* sh = mod + b * NMOD + 3 * D + lane * 16; float s = 0.f;
#pragma unroll
            for (int q = 0; q < 4; ++q) { const f32x4 v = *(const f32x4*)(sh + 4 * q); s += v[0] * wv[4 * q] + v[1] * wv[4 * q + 1] + v[2] * wv[4 * q + 2] + v[3] * wv[4 * q + 3]; }
            s = wave_sum(s); if (lane == 0) sb[b * PW + col] = s; }
    }
}
__device__ __forceinline__ void phase_kfix(const Args& A) {
    const int lane = threadIdx.x & 63, gw = blockIdx.x * NWAVES + (threadIdx.x >> 6), NGW = gridDim.x * NWAVES, li = lane & 15, sub = lane >> 4;
    bf16_t* KB = (bf16_t*)(A.ws + WS_KB); const float* cs = (const float*)(A.ws + WS_ROPE); const float* sn = cs + 2048;
    constexpr int NITEM = NB * SKV * HKV;
    const f32x4 g0 = *(const f32x4*)(A.kng + li * 8), g1 = *(const f32x4*)(A.kng + li * 8 + 4);
    const f32x4 p0 = *(const f32x4*)(A.kng + (li ^ 4) * 8), p1 = *(const f32x4*)(A.kng + (li ^ 4) * 8 + 4);
    for (int it = gw * 4 + sub; it < NITEM; it += NGW * 4) {
        const int row = it >> 1, h = it & 1, t = row % SKV;
        bf16_t* p = KB + (size_t)row * 256 + h * HD + li * 8;
        const u32x4 w = *(const u32x4*)p;
        float x[8], xp[8]; float ss = 0.f;
#pragma unroll
        for (int j = 0; j < 4; ++j) { x[2 * j] = bf_lo(w[j]); x[2 * j + 1] = bf_hi(w[j]); ss += x[2 * j] * x[2 * j] + x[2 * j + 1] * x[2 * j + 1];
            const unsigned pw = (unsigned)__shfl_xor((int)w[j], 4); xp[2 * j] = bf_lo(pw); xp[2 * j + 1] = bf_hi(pw); }
        ss += __shfl_xor(ss, 1); ss += __shfl_xor(ss, 2); ss += __shfl_xor(ss, 4); ss += __shfl_xor(ss, 8);
        const float r = rsqrtf(ss * (1.f / HD) + EPS);
        float y[8];
#pragma unroll
        for (int j = 0; j < 8; ++j) { x[j] *= r * (j < 4 ? g0[j] : g1[j - 4]); xp[j] *= r * (j < 4 ? p0[j] : p1[j - 4]); y[j] = x[j]; }
        if (t < S) {
            const int blk = li >> 3, pos = blk == 0 ? (t >> 6) : (t & 63), second = (li >> 2) & 1, i0 = (li & 3) * 8;
            const f32x4 c0 = *(const f32x4*)(cs + pos * 32 + i0), c1 = *(const f32x4*)(cs + pos * 32 + i0 + 4), s0 = *(const f32x4*)(sn + pos * 32 + i0), s1 = *(const f32x4*)(sn + pos * 32 + i0 + 4);
#pragma unroll
            for (int j = 0; j < 8; ++j) { const float c = j < 4 ? c0[j] : c1[j - 4], s = j < 4 ? s0[j] : s1[j - 4];
                y[j] = second ? (xp[j] * s + x[j] * c) : (x[j] * c - xp[j] * s); }
        }
        u32x4 o = {cvt_pk_bf16(y[0], y[1]), cvt_pk_bf16(y[2], y[3]), cvt_pk_bf16(y[4], y[5]), cvt_pk_bf16(y[6], y[7])};
        *(u32x4*)p = o;
    }
}
template <int R> struct ConvRow {
    static __device__ __forceinline__ void run(const unsigned* gp, int tl0, float (&acc)[32][2], const float (&w)[31][2]) {
        const int tl = tl0 + R - 15;
        unsigned v = 0u; if (tl >= 0 && tl < S) v = gp[(long)(R - 15) * (D / 2)];
        const float a = bf_lo(v), b = bf_hi(v);
#pragma unroll
        for (int t = (R - 30 > 0 ? R - 30 : 0); t <= (R < 31 ? R : 31); ++t) { acc[t][0] += w[R - t][0] * a; acc[t][1] += w[R - t][1] * b; }
        if constexpr (R + 1 < 62) ConvRow<R + 1>::run(gp, tl0, acc, w);
    }
};
__device__ __forceinline__ void phase_conv(const Args& A, LAS unsigned char* lds) {
    const int tid = threadIdx.x, lane = tid & 63, wave = tid >> 6;
    LAS float* tile = (LAS float*)lds;
    const bf16_t* G = (const bf16_t*)(A.ws + WS_G); bf16_t* CV = (bf16_t*)(A.ws + WS_HX);
    float w[31][2];
#pragma unroll
    for (int j = 0; j < 31; ++j) { const f32x2 t = *(const f32x2*)(A.cdw + j * D + 2 * tid); w[j][0] = t[0]; w[j][1] = t[1]; }
    const f32x2 bias = *(const f32x2*)(A.cb + 2 * tid);
    for (int tileid = blockIdx.x; tileid < M / 32; tileid += gridDim.x) {
        const int row0 = tileid * 32, tl0 = row0 & (S - 1);
        float acc[32][2];
#pragma unroll
        for (int t = 0; t < 32; ++t) { acc[t][0] = bias[0]; acc[t][1] = bias[1]; }
        ConvRow<0>::run((const unsigned*)(G + (size_t)row0 * D) + tid, tl0, acc, w);
        __syncthreads();
#pragma unroll
        for (int t = 0; t < 32; ++t) *(LAS f32x2*)(tile + t * D + 2 * tid) = (f32x2){acc[t][0], acc[t][1]};
        __syncthreads();
#pragma unroll
        for (int q = 0; q < 4; ++q) { const int t = wave * 4 + q; const LAS float* tr = tile + t * D;
            f32x4 v[4]; float s = 0.f;
#pragma unroll
            for (int i = 0; i < 4; ++i) { v[i] = *(const LAS f32x4*)(tr + (i * 64 + lane) * 4); s += (v[i][0] + v[i][1]) + (v[i][2] + v[i][3]); }
            const float mu = wave_sum(s) * (1.f / D); float qq = 0.f;
#pragma unroll
            for (int i = 0; i < 4; ++i) { v[i] = v[i] - mu; qq += (v[i][0] * v[i][0] + v[i][1] * v[i][1]) + (v[i][2] * v[i][2] + v[i][3] * v[i][3]); }
            const float rs = rsqrtf(wave_sum(qq) * (1.f / D) + EPS);
#pragma unroll
            for (int i = 0; i < 4; ++i) { const int k = (i * 64 + lane) * 4; const f32x4 gg = *(const f32x4*)(A.clg + k), bb = *(const f32x4*)(A.clb + k); float y[4];
#pragma unroll
                for (int j = 0; j < 4; ++j) { const float z = v[i][j] * rs * gg[j] + bb[j]; y[j] = z * fast_sigmoid(z); }
                u32x2 o = {cvt_pk_bf16(y[0], y[1]), cvt_pk_bf16(y[2], y[3])}; *(u32x2*)(CV + (size_t)(row0 + t) * D + k) = o; }
        }
    }
}
struct EpiInProj {
    static constexpr bool PERM = true;
    unsigned char* ws;
    __device__ __forceinline__ void operator()(f32x4 (&acc)[2][2][4][2], const pg8::Unit& u, int wr, int wc, int fr, int fq) const {
        const int c8 = wc * 32 + 8 * fq;
#pragma unroll
        for (int ai = 0; ai < 2; ++ai)
#pragma unroll
            for (int m = 0; m < 4; ++m) {
                const int row = u.pm * 256 + ai * 128 + wr * 64 + m * 16 + fr;
                if (u.kind == 0) {
                    bf16_t* p = (bf16_t*)(ws + WS_Q) + (size_t)row * D + u.pn * 256 + c8;
#pragma unroll
                    for (int bj = 0; bj < 2; ++bj) { const f32x4 v0 = acc[ai][bj][m][0], v1 = acc[ai][bj][m][1];
                        u32x4 w = {cvt_pk_bf16(v0[0], v0[1]), cvt_pk_bf16(v0[2], v0[3]), cvt_pk_bf16(v1[0], v1[1]), cvt_pk_bf16(v1[2], v1[3])}; *(u32x4*)(p + bj * 128) = w; }
                } else if (u.kind == 1 || u.kind == 2 || u.kind == 5 || u.kind == 6) {
                    const bool ctxu = u.kind >= 5;
                    const int kvrow = ctxu ? (row >> 8) * SKV + S + (row & 255) : (row >> 12) * SKV + (row & (S - 1));
                    bf16_t* p = (bf16_t*)(ws + ((u.kind == 1 || u.kind == 5) ? WS_KB : WS_VB)) + (size_t)kvrow * 256 + c8;
#pragma unroll
                    for (int bj = 0; bj < 2; ++bj) { const f32x4 v0 = acc[ai][bj][m][0], v1 = acc[ai][bj][m][1];
                        u32x4 w = {cvt_pk_bf16(v0[0], v0[1]), cvt_pk_bf16(v0[2], v0[3]), cvt_pk_bf16(v1[0], v1[1]), cvt_pk_bf16(v1[2], v1[3])}; *(u32x4*)(p + bj * 128) = w; }
                } else if (u.kind == 3) {
                    float g[8];
#pragma unroll
                    for (int n = 0; n < 2; ++n)
#pragma unroll
                        for (int j = 0; j < 4; ++j) g[4 * n + j] = acc[ai][0][m][n][j] * fast_sigmoid(acc[ai][1][m][n][j]);
                    u32x4 w = {cvt_pk_bf16(g[0], g[1]), cvt_pk_bf16(g[2], g[3]), cvt_pk_bf16(g[4], g[5]), cvt_pk_bf16(g[6], g[7])};
                    *(u32x4*)((bf16_t*)(ws + WS_G) + (size_t)row * D + (u.pn - 6) * 128 + c8) = w;
                } else {
                    float rt[8], sg[8];
#pragma unroll
                    for (int n = 0; n < 2; ++n)
#pragma unroll
                        for (int j = 0; j < 4; ++j) { const float ea = __builtin_amdgcn_exp2f(-1.4426950408889634f * acc[ai][0][m][n][j]), ec = __builtin_amdgcn_exp2f(-1.4426950408889634f * acc[ai][1][m][n][j]);
                            sg[4 * n + j] = __builtin_amdgcn_rcpf(1.f + ec); rt[4 * n + j] = (1.f + ec) * __builtin_amdgcn_rcpf(1.f + ea); }
                    const size_t off = (size_t)row * D + (u.pn - 14) * 128 + c8;
                    u32x4 w = {cvt_pk_bf16(rt[0], rt[1]), cvt_pk_bf16(rt[2], rt[3]), cvt_pk_bf16(rt[4], rt[5]), cvt_pk_bf16(rt[6], rt[7])}; *(u32x4*)((bf16_t*)(ws + WS_RT) + off) = w;
                    u32x4 w2 = {cvt_pk_bf16(sg[0], sg[1]), cvt_pk_bf16(sg[2], sg[3]), cvt_pk_bf16(sg[4], sg[5]), cvt_pk_bf16(sg[6], sg[7])}; *(u32x4*)((bf16_t*)(ws + WS_SGC) + off) = w2;
                }
            }
    }
};
struct SchedInProj {
    const char* hx; const char* hc; const char* w; int G, c;
    __device__ __forceinline__ bool next(int i, pg8::Unit& u) const {
        constexpr int nM = M / 256, nN = INW / 256, NMAIN = nM * nN, NCTX = (MC / 256) * 2;
        const int L = i * G + c; if (L >= NMAIN + NCTX) return false;
        if (L < NMAIN) { pg8::tile_of(L, nM, nN, u.pm, u.pn); u.a = hx + (size_t)u.pm * 256 * D * 2; u.kind = u.pn < 4 ? 0 : (u.pn == 4 ? 1 : (u.pn == 5 ? 2 : (u.pn < 14 ? 3 : 4))); }
        else { const int j = L - NMAIN; u.pm = j >> 1; u.pn = 4 + (j & 1); u.a = hc + (size_t)u.pm * 256 * D * 2; u.kind = 5 + (j & 1); }
        u.b = w + (size_t)u.pn * 256 * D * 2; u.keep = 0; return true;
    }
};
struct EpiMerge {
    static constexpr bool PERM = true;
    unsigned char* ws;
    __device__ __forceinline__ void operator()(f32x4 (&acc)[2][2][4][2], const pg8::Unit& u, int wr, int wc, int fr, int fq) const {
        const int c8 = u.pn * 256 + wc * 32 + 8 * fq;
        const bf16_t* F = (const bf16_t*)(ws + (u.kind == 0 ? WS_RT : WS_SGC));
#pragma unroll
        for (int ai = 0; ai < 2; ++ai)
#pragma unroll
            for (int m = 0; m < 4; ++m) { const size_t off = (size_t)(u.pm * 256 + ai * 128 + wr * 64 + m * 16 + fr) * D + c8;
#pragma unroll
                for (int bj = 0; bj < 2; ++bj) { const u32x4 f = *(const u32x4*)(F + off + bj * 128);
                    f32x4 v0 = acc[ai][bj][m][0], v1 = acc[ai][bj][m][1];
                    v0[0] *= bf_lo(f[0]); v0[1] *= bf_hi(f[0]); v0[2] *= bf_lo(f[1]); v0[3] *= bf_hi(f[1]); v1[0] *= bf_lo(f[2]); v1[1] *= bf_hi(f[2]); v1[2] *= bf_lo(f[3]); v1[3] *= bf_hi(f[3]);
                    if (u.kind == 0) { acc[ai][bj][m][0] = v0; acc[ai][bj][m][1] = v1; }
                    else { u32x4 w = {cvt_pk_bf16(v0[0], v0[1]), cvt_pk_bf16(v0[2], v0[3]), cvt_pk_bf16(v1[0], v1[1]), cvt_pk_bf16(v1[2], v1[3])}; *(u32x4*)((bf16_t*)(ws + WS_G) + off + bj * 128) = w; } } }
    }
};
struct SchedMerge {
    const char* att; const char* cv; const char* wa; const char* wc; int G, c;
    __device__ __forceinline__ bool next(int i, pg8::Unit& u) const {
        constexpr int nM = M / 256, nN = D / 256;
        const int L = (i >> 1) * G + c, sub = i & 1; if (L >= nM * nN) return false;
        pg8::tile_of(L, nM, nN, u.pm, u.pn);
        u.a = (sub ? cv : att) + (size_t)u.pm * 256 * D * 2; u.b = (sub ? wc : wa) + (size_t)u.pn * 256 * D * 2; u.kind = sub; u.keep = sub ^ 1; return true;
    }
};
struct SchedPlain {
    const char* a; const char* b; int nM, nN, G, c;
    __device__ __forceinline__ bool next(int i, pg8::Unit& u) const {
        const int L = i * G + c; if (L >= nM * nN) return false;
        pg8::tile_of(L, nM, nN, u.pm, u.pn); u.a = a + (size_t)u.pm * 256 * D * 2; u.b = b + (size_t)u.pn * 256 * D * 2; u.kind = 0; u.keep = 0; return true;
    }
};
struct EpiOut {
    static constexpr bool PERM = false;
    const float* x; const float* mod; const float* n2g; float* xs; bf16_t* xg; float* ssq;
    __device__ __forceinline__ void operator()(f32x4 (&acc)[2][2][4][2], const pg8::Unit& u, int wr, int wc, int fr, int fq) const {
        const int col0 = u.pn * 256 + wc * 32 + 4 * fq; const float* mb = mod + ((u.pm * 256) >> 12) * NMOD;
        f32x4 gv[2][2], nv[2][2];
#pragma unroll
        for (int bj = 0; bj < 2; ++bj)
#pragma unroll
            for (int n = 0; n < 2; ++n) { const int c = col0 + bj * 128 + n * 16; gv[bj][n] = *(const f32x4*)(mb + 2 * D + c); nv[bj][n] = *(const f32x4*)(n2g + c) * (*(const f32x4*)(mb + 4 * D + c) + 1.f); }
#pragma unroll
        for (int ai = 0; ai < 2; ++ai)
#pragma unroll
            for (int m = 0; m < 4; ++m) { const int row = u.pm * 256 + ai * 128 + wr * 64 + m * 16 + fr; const size_t off = (size_t)row * D + col0; float ss = 0.f;
#pragma unroll
                for (int bj = 0; bj < 2; ++bj)
#pragma unroll
                    for (int n = 0; n < 2; ++n) { const f32x4 xv = *(const f32x4*)(x + off + bj * 128 + n * 16); const f32x4 v = xv + gv[bj][n] * acc[ai][bj][m][n]; *(f32x4*)(xs + off + bj * 128 + n * 16) = v;
                        ss += (v[0] * v[0] + v[1] * v[1]) + (v[2] * v[2] + v[3] * v[3]); const f32x4 g = v * nv[bj][n];
                        u32x2 w = {cvt_pk_bf16(g[0], g[1]), cvt_pk_bf16(g[2], g[3])}; *(u32x2*)(xg + off + bj * 128 + n * 16) = w; }
                ss += __shfl_xor(ss, 16); ss += __shfl_xor(ss, 32);
                if (fq == 0) ssq[(size_t)row * 16 + u.pn * 4 + wc] = ss; }
    }
};
__device__ __forceinline__ float row_rstd(const float* ssq, int row) {
    const f32x4 a = *(const f32x4*)(ssq + (size_t)row * 16), b = *(const f32x4*)(ssq + (size_t)row * 16 + 4), c = *(const f32x4*)(ssq + (size_t)row * 16 + 8), d = *(const f32x4*)(ssq + (size_t)row * 16 + 12);
    const float s = ((a[0] + a[1]) + (a[2] + a[3])) + ((b[0] + b[1]) + (b[2] + b[3])) + ((c[0] + c[1]) + (c[2] + c[3])) + ((d[0] + d[1]) + (d[2] + d[3]));
    return rsqrtf(s * (1.f / D) + EPS);
}
struct EpiScores {
    static constexpr bool PERM = false;
    float* sc; const float* ssq; const float* sbias;
    __device__ __forceinline__ void operator()(f32x4 (&acc)[2][2][4][2], const pg8::Unit& u, int wr, int wc, int fr, int fq) const {
        const float* sb = sbias + ((u.pm * 256) >> 12) * PW + u.pn * 256 + wc * 32 + 4 * fq;
        f32x4 bv[2][2];
#pragma unroll
        for (int bj = 0; bj < 2; ++bj)
#pragma unroll
            for (int n = 0; n < 2; ++n) bv[bj][n] = *(const f32x4*)(sb + bj * 128 + n * 16);
#pragma unroll
        for (int ai = 0; ai < 2; ++ai)
#pragma unroll
            for (int m = 0; m < 4; ++m) { const int row = u.pm * 256 + ai * 128 + wr * 64 + m * 16 + fr; float* p = sc + (size_t)(row >> 2) * 8192 + (row & 3) * 4; const float rs = row_rstd(ssq, row);
#pragma unroll
                for (int bj = 0; bj < 2; ++bj)
#pragma unroll
                    for (int n = 0; n < 2; ++n) { const int grp = u.pn * 2 + bj, nq = wc * 8 + n * 4 + fq; *(f32x4*)(p + (grp * 32 + nq) * 16) = acc[ai][bj][m][n] * rs + bv[bj][n]; } }
    }
};

__device__ __forceinline__ void phase_attn(const Args& A, unsigned char* lds) {
    const int G = gridDim.x, X = blockIdx.x & 7, j = blockIdx.x >> 3, perx = G >> 3;
    bf16_t* Q = (bf16_t*)(A.ws + WS_Q); const bf16_t* KB = (const bf16_t*)(A.ws + WS_KB); const bf16_t* VB = (const bf16_t*)(A.ws + WS_VB);
    const float* cs = (const float*)(A.ws + WS_ROPE); const float* sn = cs + 2048;
    for (int idx = j; idx < 128; idx += perx) {
        const int grp = 2 * X + (idx >> 6), uu = idx & 63, b = grp >> 1, kv = grp & 1, h = kv * 4 + (uu >> 4), qb = uu & 15;
        bf16_t* qp = Q + ((size_t)b * S + qb * 256) * D + h * HD;
        bf16_t* op = A.dry ? (bf16_t*)(A.ws + ((size_t)445 << 20)) + ((size_t)b * S + qb * 256) * D + h * HD : qp;
        att::attn_unit(qp, KB + (size_t)b * SKV * 256 + kv * HD, VB + (size_t)b * SKV * 256 + kv * HD, op, qb * 256, SKV, A.qng, cs, sn, (char*)lds);
    }
}

__device__ __forceinline__ float gelu_exact(float v) { return 0.5f * v * (1.f + erff(v * 0.70710678118654752f)); }
__device__ __forceinline__ void ins16(float (&t)[16], float v) {
#pragma unroll
    for (int i = 15; i >= 1; --i) t[i] = __builtin_amdgcn_fmed3f(t[i - 1], t[i], v);
    t[0] = fmaxf(t[0], v);
}
__device__ __forceinline__ float key_tag(float v, unsigned keepmask, unsigned tag) { return __uint_as_float((__float_as_uint(v) & keepmask) | tag); }
template <int I, int J> struct CandLoop {
    static __device__ __forceinline__ void run(const float (&a)[16], const float (&b)[16], float (&c)[16]) {
        if constexpr ((I + 1) * (J + 1) <= 16) { ins16(c, key_tag(a[I] + b[J], ~255u, 255u - (unsigned)(I * 16 + J))); CandLoop<I, J + 1>::run(a, b, c); }
        else if constexpr (I + 1 < 16) CandLoop<I + 1, 0>::run(a, b, c);
    }
};
__device__ __forceinline__ void phase_peer(const Args& A, LAS unsigned char* lds) {
    const int lane = threadIdx.x & 63, wave = threadIdx.x >> 6, gw = blockIdx.x * NWAVES + wave, NGW = gridDim.x * NWAVES;
    LAS unsigned char* wl = lds + wave * 9216;
    LAS float* topL = (LAS float*)wl; LAS int* eidA = (LAS int*)(wl + 4096); LAS float* wgtA = (LAS float*)(wl + 6144); LAS float* coefL = (LAS float*)(wl + 8192);
    const float* SC = (const float*)(A.ws + WS_SC); const bf16_t* HX = (const bf16_t*)(A.ws + WS_HX);
    const unsigned char* UT = A.ws + WS_UT; const unsigned char* VT = A.ws + WS_VT; const float* SU = (const float*)(A.ws + WS_UT + WS_TSCALE); const float* SVs = (const float*)(A.ws + WS_VT + WS_TSCALE);
    const float* mod = (const float*)(A.ws + WS_MOD);
    const float NEG = -3.0e38f;
    const int h = lane >> 3, tk = (lane >> 1) & 3, p = lane & 1, grp = 2 * h + p;
    for (int pass = gw; pass < M / 4; pass += NGW) {
        {
            float t[16];
#pragma unroll
            for (int i = 0; i < 16; ++i) t[i] = NEG;
            const float* sp = SC + (size_t)pass * 8192 + (grp * 128 + tk) * 4;
#pragma unroll 4
            for (int i = 0; i < 32; ++i) { const f32x4 v = *(const f32x4*)(sp + i * 16); const unsigned tg = 127u - 4u * (unsigned)i;
                ins16(t, key_tag(v[0], ~127u, tg)); ins16(t, key_tag(v[1], ~127u, tg - 1u)); ins16(t, key_tag(v[2], ~127u, tg - 2u)); ins16(t, key_tag(v[3], ~127u, tg - 3u)); }
            float pb[16];
#pragma unroll
            for (int i = 0; i < 16; ++i) { pb[i] = __shfl_xor(t[i], 1); topL[lane * 16 + i] = t[i]; }
            float c[16];
#pragma unroll
            for (int i = 0; i < 16; ++i) c[i] = NEG;
            CandLoop<0, 0>::run(t, pb, c);
            float e[16]; float es = 0.f;
#pragma unroll
            for (int k = 0; k < 16; ++k) { e[k] = __expf(c[k] - c[0]); es += e[k]; }
            const float inv = __builtin_amdgcn_rcpf(es);
            asm volatile("s_waitcnt lgkmcnt(0)" ::: "memory");
            if (p == 0) {
#pragma unroll
                for (int k = 0; k < 16; ++k) { const unsigned code = 255u - (__float_as_uint(c[k]) & 255u);
                    const unsigned ia = 127u - (__float_as_uint(topL[lane * 16 + (code >> 4)]) & 127u), ib = 127u - (__float_as_uint(topL[(lane + 1) * 16 + (code & 15u)]) & 127u);
                    eidA[tk * 128 + h * 16 + k] = (int)(ia * 128u + ib); wgtA[tk * 128 + h * 16 + k] = e[k] * inv; }
            }
            asm volatile("s_waitcnt lgkmcnt(0)" ::: "memory");
        }
#pragma unroll 1
        for (int tq = 0; tq < 4; ++tq) {
            const int t = pass * 4 + tq; const LAS int* eidL = eidA + tq * 128; const LAS float* wgtL = wgtA + tq * 128;
            f32x2 x2[8];
            { const u32x4 x0 = *(const u32x4*)(HX + (size_t)t * D + lane * 16), x1 = *(const u32x4*)(HX + (size_t)t * D + lane * 16 + 8);
              const float rs = row_rstd((const float*)(A.ws + WS_SSQ), t); const float* sh = mod + (t >> 12) * NMOD + 3 * D + lane * 16;
              const f32x4 s0 = *(const f32x4*)sh, s1 = *(const f32x4*)(sh + 4), s2 = *(const f32x4*)(sh + 8), s3 = *(const f32x4*)(sh + 12);
              x2[0] = (f32x2){bf_lo(x0[0]) * rs + s0[0], bf_hi(x0[0]) * rs + s0[1]}; x2[1] = (f32x2){bf_lo(x0[1]) * rs + s0[2], bf_hi(x0[1]) * rs + s0[3]};
              x2[2] = (f32x2){bf_lo(x0[2]) * rs + s1[0], bf_hi(x0[2]) * rs + s1[1]}; x2[3] = (f32x2){bf_lo(x0[3]) * rs + s1[2], bf_hi(x0[3]) * rs + s1[3]};
              x2[4] = (f32x2){bf_lo(x1[0]) * rs + s2[0], bf_hi(x1[0]) * rs + s2[1]}; x2[5] = (f32x2){bf_lo(x1[1]) * rs + s2[2], bf_hi(x1[1]) * rs + s2[3]};
              x2[6] = (f32x2){bf_lo(x1[2]) * rs + s3[0], bf_hi(x1[2]) * rs + s3[1]}; x2[7] = (f32x2){bf_lo(x1[3]) * rs + s3[2], bf_hi(x1[3]) * rs + s3[3]}; }
            u32x4 bufA[8], bufB[8];
#define LOAD8(buf, TB, hb) do { _Pragma("unroll") for (int e = 0; e < 8; ++e) { const int id = eidL[(hb) * 8 + e]; buf[e] = *(const u32x4*)((TB) + (size_t)id * D + lane * 16); } } while (0)
#define DOT8(buf, off) do { _Pragma("unroll") for (int e = 0; e < 8; ++e) { f32x2 s2 = {0.f, 0.f}; \
                _Pragma("unroll") for (int j = 0; j < 4; ++j) { const int aj = (int)buf[e][j]; s2 += __builtin_amdgcn_cvt_pk_f32_fp8(aj, false) * x2[2 * j]; s2 += __builtin_amdgcn_cvt_pk_f32_fp8(aj, true) * x2[2 * j + 1]; } \
                pp[(off) + e] = s2[0] + s2[1]; } } while (0)
#define REDUCE16(kb) do { const int ke = (kb) * 16 + ((lane >> 2) & 15); const int myid = eidL[ke]; const float su = SU[myid], sv = SVs[myid]; \
            _Pragma("unroll") for (int e = 0; e < 8; ++e) { const bool up = lane & 32; const float keep = up ? pp[e + 8] : pp[e], send = up ? pp[e] : pp[e + 8]; pp[e] = keep + __shfl_xor(send, 32); } \
            _Pragma("unroll") for (int e = 0; e < 4; ++e) { const bool up = lane & 16; const float keep = up ? pp[e + 4] : pp[e], send = up ? pp[e] : pp[e + 4]; pp[e] = keep + __shfl_xor(send, 16); } \
            _Pragma("unroll") for (int e = 0; e < 2; ++e) { const bool up = lane & 8; const float keep = up ? pp[e + 2] : pp[e], send = up ? pp[e] : pp[e + 2]; pp[e] = keep + __shfl_xor(send, 8); } \
            { const bool up = lane & 4; const float keep = up ? pp[1] : pp[0], send = up ? pp[0] : pp[1]; pp[0] = keep + __shfl_xor(send, 4); } \
            float hsum = pp[0]; hsum += __shfl_xor(hsum, 2); hsum += __shfl_xor(hsum, 1); \
            const float cf = wgtL[ke] * gelu_exact(hsum * su) * sv; if ((lane & 3) == 0) coefL[ke] = cf; } while (0)
            LOAD8(bufA, UT, 0);
#pragma unroll 1
            for (int kb = 0; kb < 8; ++kb) {
                float pp[16];
                LOAD8(bufB, UT, 2 * kb + 1);
                DOT8(bufA, 0);
                if (kb < 7) LOAD8(bufA, UT, 2 * kb + 2); else LOAD8(bufA, VT, 0);
                DOT8(bufB, 8);
                REDUCE16(kb);
            }
            asm volatile("s_waitcnt lgkmcnt(0)" ::: "memory");
            f32x2 y2[8];
#pragma unroll
            for (int j = 0; j < 8; ++j) y2[j] = (f32x2){0.f, 0.f};
#define VACC8(buf, hb) do { _Pragma("unroll") for (int e = 0; e < 8; ++e) { const float cf = coefL[(hb) * 8 + e]; const f32x2 cf2 = {cf, cf}; \
                _Pragma("unroll") for (int j = 0; j < 4; ++j) { const int aj = (int)buf[e][j]; y2[2 * j] += cf2 * __builtin_amdgcn_cvt_pk_f32_fp8(aj, false); y2[2 * j + 1] += cf2 * __builtin_amdgcn_cvt_pk_f32_fp8(aj, true); } } } while (0)
#pragma unroll 1
            for (int kb = 0; kb < 8; ++kb) {
                LOAD8(bufB, VT, 2 * kb + 1);
                VACC8(bufA, 2 * kb);
                if (kb < 7) LOAD8(bufA, VT, 2 * kb + 2);
                VACC8(bufB, 2 * kb + 1);
            }
#undef LOAD8
#undef DOT8
#undef REDUCE16
#undef VACC8
            const float* g2 = mod + (t >> 12) * NMOD + 5 * D; float* orow = A.out + (size_t)t * D;
            float z[16]; float ss = 0.f;
#pragma unroll
            for (int q = 0; q < 4; ++q) { const int k = lane * 16 + q * 4; const f32x4 xv = *(const f32x4*)(orow + k), gv = *(const f32x4*)(g2 + k);
                const float yy[4] = {y2[2 * q][0], y2[2 * q][1], y2[2 * q + 1][0], y2[2 * q + 1][1]};
#pragma unroll
                for (int j = 0; j < 4; ++j) { const float zz = xv[j] + gv[j] * yy[j]; z[q * 4 + j] = zz; ss += zz * zz; } }
            const float r = rsqrtf(wave_sum(ss) * (1.f / D) + EPS);
#pragma unroll
            for (int q = 0; q < 4; ++q) { const int k = lane * 16 + q * 4; const f32x4 fv = *(const f32x4*)(A.fg + k);
                f32x4 o;
#pragma unroll
                for (int j = 0; j < 4; ++j) o[j] = z[q * 4 + j] * r * fv[j];
                if (!A.dry || r < 0.f) *(f32x4*)(orow + k) = o; }
        }
    }
}
#define XB_TMO      128
#define XB_XCNT(j)  (256  + 64 * (j))
#define XB_XSUB(j)  (1280 + 64 * (j))
#define XB_XGEN(j)  (2304 + 64 * (j))
#define XB_TOP      3328
#define XB_TOPGEN   3392
#define XCD_BAR_WORDS 3456
#define XB_SPIN_CAP (1u << 22)
__device__ __forceinline__ unsigned xb_ld(unsigned* p)              { return __hip_atomic_load(p, __ATOMIC_RELAXED, __HIP_MEMORY_SCOPE_AGENT); }
__device__ __forceinline__ unsigned xb_add(unsigned* p, unsigned v) { return __hip_atomic_fetch_add(p, v, __ATOMIC_RELAXED, __HIP_MEMORY_SCOPE_AGENT); }
__device__ __forceinline__ unsigned xb_xcc_id() { return (unsigned)__builtin_amdgcn_s_getreg((3 << 11) | 20) & 0xFu; }
#define XB_SPIN(cond, bar) do { unsigned _sp = 0; while (cond) { __builtin_amdgcn_s_sleep(1); \
    if ((++_sp & 255u) == 0u) { if (xb_ld(&(bar)[XB_TMO])) break; if (_sp > XB_SPIN_CAP) { atomicAdd(&(bar)[XB_TMO], 1u); break; } } } } while (0)
struct XcdBarrier { unsigned* bar; unsigned x; volatile LAS unsigned* st; };
__device__ __forceinline__ XcdBarrier xcd_barrier_post(unsigned* bar, volatile LAS unsigned* st) {
    XcdBarrier b; b.bar = bar; b.x = xb_xcc_id(); b.st = st;
    if (threadIdx.x == 0) (void)xb_add(&bar[XB_XCNT(b.x)], 1u);
    return b;
}
__device__ __forceinline__ void xcd_barrier_complete(unsigned* bar, unsigned x, unsigned& nloc, unsigned& nx) {
    const unsigned G = gridDim.x * gridDim.y * gridDim.z;
    unsigned sum, cnt, mine, sp = 0u;
    for (;;) {
        sum = 0u; cnt = 0u; mine = 0u;
#pragma unroll
        for (unsigned j = 0; j < 16; ++j) { const unsigned c = xb_ld(&bar[XB_XCNT(j)]); sum += c; cnt += (c > 0u) ? 1u : 0u; mine = (j == x) ? c : mine; }
        if (sum == G) break;
        __builtin_amdgcn_s_sleep(1);
        if ((++sp & 255u) == 0u) { if (xb_ld(&bar[XB_TMO])) break; if (sp > XB_SPIN_CAP) { atomicAdd(&bar[XB_TMO], 1u); break; } }
    }
    nloc = mine > 0u ? mine : 1u; nx = cnt > 0u ? cnt : 1u;
}
__device__ __forceinline__ void xcd_barrier(const XcdBarrier& b) {
    asm volatile("s_waitcnt vmcnt(0)" ::: "memory");
    __syncthreads();
    if (threadIdx.x == 0) {
        unsigned* bar = b.bar;
        __builtin_amdgcn_s_waitcnt(0);
        unsigned nloc = b.st[0], nx = b.st[1];
        if (nloc == 0u) { xcd_barrier_complete(bar, b.x, nloc, nx); b.st[0] = nloc; b.st[1] = nx; }
        const unsigned old = xb_add(&bar[XB_XSUB(b.x)], 1u);
        const unsigned gen = old / nloc;
        if (old + 1u == (gen + 1u) * nloc) {
            __builtin_amdgcn_fence(__ATOMIC_RELEASE, "agent");
            asm volatile("s_waitcnt vmcnt(0)" ::: "memory");
            const unsigned og = xb_add(&bar[XB_TOP], 1u);
            const unsigned tg = og / nx;
            if (og + 1u == (tg + 1u) * nx) xb_add(&bar[XB_TOPGEN], 1u);
            else XB_SPIN(xb_ld(&bar[XB_TOPGEN]) == tg, bar);
            __builtin_amdgcn_fence(__ATOMIC_ACQUIRE, "agent");
            xb_add(&bar[XB_XGEN(b.x)], 1u);
            asm volatile("s_waitcnt vmcnt(0)" ::: "memory");
        } else {
            XB_SPIN(xb_ld(&bar[XB_XGEN(b.x)]) == gen, bar);
            __builtin_amdgcn_fence(__ATOMIC_ACQUIRE, "agent");
            asm volatile("s_waitcnt vmcnt(0)" ::: "memory");
        }
    }
    __syncthreads();
}
constexpr int MISC_OFF = 135168;

constexpr int N_PHASES = 9;
__global__ void __launch_bounds__(NWAVES * 64, 2) mega_fwd(Args A) {
    extern __shared__ __attribute__((aligned(16))) unsigned char lds[];
    LAS unsigned char* L = (LAS unsigned char*)lds;
    cg::grid_group grid = cg::this_grid();
    const int lo = A.ph_lo, hi = A.ph_hi, G = gridDim.x, c = blockIdx.x;
#ifndef PH_MASK
#define PH_MASK 0x1FF
#endif
#define IN(k) (((PH_MASK >> (k)) & 1) && lo <= (k) && (k) < hi)
    unsigned* barw = (unsigned*)(A.ws + WS_CTL);
    volatile LAS unsigned* MISC = (volatile LAS unsigned*)(L + MISC_OFF);
    if (threadIdx.x < 2) MISC[threadIdx.x] = 0u;
    if (lo == 0 && hi > 1 && blockIdx.x == 0) for (int i = threadIdx.x; i < XCD_BAR_WORDS; i += NWAVES * 64) barw[i] = 0u;
    XcdBarrier xb; xb.bar = barw; xb.x = 0; xb.st = MISC;
#define SEAM(k) do { if (IN(k) && IN((k) + 1)) { if ((k) == 0) { grid.sync(); xb = xcd_barrier_post(barw, MISC); } else xcd_barrier(xb); } } while (0)
    if (IN(0)) phase_prologue(A, L);
    SEAM(0);
    if (IN(1)) phase_hx(A);
    SEAM(1);
    if (IN(2)) { SchedInProj Sd{(const char*)(A.ws + WS_HX), (const char*)(A.ws + WS_HC), (const char*)(A.ws + WS_WIN), G, c}; EpiInProj E{A.ws};
        pg8::gemm_phase<EpiInProj, SchedInProj, true>(L, D, Sd, E); }
    SEAM(2);
    if (IN(3)) { if (!A.dry) phase_kfix(A); phase_conv(A, L); }
    SEAM(3);
    if (IN(4)) phase_attn(A, lds);
    SEAM(4);
    if (IN(5)) { SchedMerge Sd{(const char*)(A.ws + WS_Q), (const char*)(A.ws + WS_HX), (const char*)(A.ws + WS_WA), (const char*)(A.ws + WS_WC), G, c}; EpiMerge E{A.ws};
        pg8::gemm_phase<EpiMerge, SchedMerge, true>(L, D, Sd, E); }
    SEAM(5);
    if (IN(6)) { SchedPlain Sd{(const char*)(A.ws + WS_G), (const char*)(A.ws + WS_WO), M / 256, D / 256, G, c};
        EpiOut E{A.x, (const float*)(A.ws + WS_MOD), A.n2g, A.out, (bf16_t*)(A.ws + WS_HX), (float*)(A.ws + WS_SSQ)};
        pg8::gemm_phase<EpiOut, SchedPlain, true>(L, D, Sd, E); }
    SEAM(6);
    if (IN(7)) { SchedPlain Sd{(const char*)(A.ws + WS_HX), (const char*)(A.ws + WS_WP), M / 256, PW / 256, G, c};
        EpiScores E{(float*)(A.ws + WS_SC), (const float*)(A.ws + WS_SSQ), (const float*)(A.ws + WS_SBIAS)};
        pg8::gemm_phase<EpiScores, SchedPlain, true>(L, D, Sd, E); }
    SEAM(7);
    if (IN(8)) phase_peer(A, L);
#undef IN
#undef SEAM
}

#ifndef MK_ONE_LAUNCH
#define MK_ONE_LAUNCH 1
#endif
extern "C" void kernel_launch(void* const* d_in, const int* in_sizes, int n_in, void* d_out, int out_size, void* d_ws, size_t ws_size, hipStream_t stream) {
    static int grid = 0;
    if (grid == 0) {
        if (n_in != 23 || out_size != M * D || ws_size < WS_END) { fprintf(stderr, "kernel_launch: unexpected shapes (n_in %d out %d ws %zu)\n", n_in, out_size, ws_size); grid = -1; return; }
        int dev = 0, cus = 0, per_cu = 0;
        hipGetDevice(&dev); hipDeviceGetAttribute(&cus, hipDeviceAttributeMultiprocessorCount, dev);
        if (hipFuncSetAttribute((const void*)mega_fwd, hipFuncAttributeMaxDynamicSharedMemorySize, LDS_BYTES) != hipSuccess) { fprintf(stderr, "kernel_launch: hipFuncSetAttribute failed\n"); grid = -1; return; }
        if (hipOccupancyMaxActiveBlocksPerMultiprocessor(&per_cu, (const void*)mega_fwd, NWAVES * 64, LDS_BYTES) != hipSuccess || per_cu < 1) { fprintf(stderr, "kernel_launch: occupancy query says %d\n", per_cu); per_cu = 1; }
        (void)hipGetLastError();
        grid = cus * 1;
        if (per_cu < 1) grid = -1;
    }
    if (grid < 0) return;
    Args a{};
    const float** f = (const float**)&a;
    for (int i = 0; i < 23; ++i) f[i] = (const float*)d_in[i];
    a.out = (float*)d_out; a.ws = (unsigned char*)d_ws;
#if MK_ONE_LAUNCH
    a.ph_lo = 0; a.ph_hi = N_PHASES;
    void* args[] = {&a};
    hipError_t e = hipLaunchCooperativeKernel((const void*)mega_fwd, dim3(grid), dim3(NWAVES * 64), args, LDS_BYTES, stream);
    if (e != hipSuccess) fprintf(stderr, "cooperative launch failed: %s (grid %d)\n", hipGetErrorString(e), grid);
#else
#ifndef REPEAT_PH
#define REPEAT_PH -1
#endif
    for (int p = 0; p < N_PHASES; ++p) { a.ph_lo = p; a.ph_hi = p + 1;
        if (p == REPEAT_PH) { a.dry = 1; hipLaunchKernelGGL(mega_fwd, dim3(grid), dim3(NWAVES * 64), LDS_BYTES, stream, a); a.dry = 0; }
        hipLaunchKernelGGL(mega_fwd, dim3(grid), dim3(NWAVES * 64), LDS_BYTES, stream, a); }
#endif
}
```

```cpp
#include <hip/hip_runtime.h>
#include <hip/hip_cooperative_groups.h>
#include <cstdio>
#include <cstdint>
namespace cg = cooperative_groups;

#define LAS __attribute__((address_space(3)))
typedef unsigned short bf16_t;
typedef short bf16x8 __attribute__((ext_vector_type(8)));
typedef short s16x4 __attribute__((ext_vector_type(4)));
typedef float f32x2 __attribute__((ext_vector_type(2)));
typedef float f32x4 __attribute__((ext_vector_type(4)));
typedef float f32x16 __attribute__((ext_vector_type(16)));
typedef unsigned u32x2 __attribute__((ext_vector_type(2)));
typedef unsigned u32x4 __attribute__((ext_vector_type(4)));
typedef __bf16 bf16x2_t __attribute__((ext_vector_type(2)));

constexpr int D = 1024, NB = 8, S = 4096, CTXL = 256, SKV = S + CTXL, HD = 128, HQ = 8, HKV = 2;
constexpr int M = NB * S;
constexpr int MC = NB * CTXL;
constexpr int INW = 5632, NMOD = 6144, NEXP = 16384, PW = 2048;
constexpr float EPS = 1e-6f;

__device__ __forceinline__ unsigned cvt_pk_bf16(float lo, float hi) { f32x2 v = {lo, hi}; bf16x2_t b = __builtin_convertvector(v, bf16x2_t); return __builtin_bit_cast(unsigned, b); }
__device__ __forceinline__ float bf_lo(unsigned u) { return __uint_as_float(u << 16); }
__device__ __forceinline__ float bf_hi(unsigned u) { return __uint_as_float(u & 0xffff0000u); }
__device__ __forceinline__ float fast_sigmoid(float x) { return __builtin_amdgcn_rcpf(1.f + __builtin_amdgcn_exp2f(-1.4426950408889634f * x)); }
__device__ __forceinline__ float wave_sum(float v) {
#pragma unroll
    for (int o = 1; o < 64; o <<= 1) v += __shfl_xor(v, o);
    return v;
}

namespace pg8 {
constexpr int BM = 256, BK = 64, HALF = 128, HTB = HALF * BK * 2  , STAGE_BYTES = 8 * HTB, NXCD = 8, WGM = 8;
__host__ __device__ __forceinline__ int lds_byte(int r, int c) { const int st = (r >> 4) * 2 + (c >> 5), rr = r & 15, cc = c & 31, ob = rr * 64 + cc * 2; return st * 1024 + (ob ^ (((ob >> 9) & 1) << 5)); }
__host__ __device__ __forceinline__ void stage_rc(int b, int& R, int& C) { const int st = b / 1024, sb = b % 1024, swz = sb ^ (((sb >> 9) & 1) << 5); R = (st >> 1) * 16 + swz / 64; C = (st & 1) * 32 + (swz % 64) / 2; }
__host__ __device__ __forceinline__ int perm32(int rho) { const int n = rho >> 4, i = rho & 15; return 8 * (i >> 2) + 4 * n + (i & 3); }

struct Unit { const char* a; const char* b; int pm, pn, kind, keep; };

__device__ __forceinline__ void tile_of(int L, int nM, int nN, int& pm, int& pn) {
    const int nwg = nM * nN; int wgid = L;
    { const int q = nwg / NXCD, r = nwg % NXCD, xcd = wgid % NXCD, off = wgid / NXCD; wgid = (xcd < r ? xcd * (q + 1) : r * (q + 1) + (xcd - r) * q) + off; }
    const int nig = WGM * nN, gid = wgid / nig, fm = gid * WGM, gsz = (nM - fm) < WGM ? (nM - fm) : WGM;
    pm = fm + ((wgid % nig) % gsz); pn = (wgid % nig) / gsz;
}

template <class Epi, class Sched, bool ALIGN_EPI>
__device__ __forceinline__ void gemm_phase(LAS unsigned char* lds, const int K, const Sched& S, const Epi& E) {
    const int tid = threadIdx.x, wid = __builtin_amdgcn_readfirstlane(tid >> 6), lane = tid & 63, wr = wid >> 2, wc = wid & 3, fr = lane & 15, fq = lane >> 4;
    const int nt = K / BK;
    unsigned voffA[2], voffB[2];
#pragma unroll
    for (int i = 0; i < 2; ++i) { int R, C; stage_rc(tid * 16 + i * 8192, R, C); const int Rb = Epi::PERM ? ((R & ~31) + perm32(R & 31)) : R;
        voffA[i] = (unsigned)(R * K + C) * 2u; voffB[i] = (unsigned)(Rb * K + C) * 2u; }
    const size_t kstep = (size_t)(BK * 2);
    const size_t hstep = (size_t)HALF * K * 2;
    const unsigned ldsw = (unsigned)wid * 1024u;
    const int aoff = lds_byte(wr * 64 + fr, fq * 8), boff = lds_byte(wc * 32 + fr, fq * 8);
#define PG8_SA(b, h) (((b) * 2 + (h)) * HTB)
#define PG8_SB(b, h) ((4 + (b) * 2 + (h)) * HTB)
#define PG8_STAGE(bufoff, gbase, voff) do { _Pragma("unroll") for (int _i = 0; _i < 2; ++_i) \
        __builtin_amdgcn_global_load_lds((const unsigned*)((const char*)(gbase) + (voff)[_i]), (LAS unsigned*)(lds + (bufoff) + ldsw + _i * 8192), 16, 0, 0); } while (0)
#define PG8_LDA(dst, b, h) do { _Pragma("unroll") for (int m = 0; m < 4; ++m) _Pragma("unroll") for (int k = 0; k < 2; ++k) dst[m][k] = *(const LAS bf16x8*)(lds + PG8_SA(b, h) + aoff + m * 2048 + k * 1024); } while (0)
#define PG8_LDB(dst, b, h) do { _Pragma("unroll") for (int n = 0; n < 2; ++n) _Pragma("unroll") for (int k = 0; k < 2; ++k) dst[n][k] = *(const LAS bf16x8*)(lds + PG8_SB(b, h) + boff + n * 2048 + k * 1024); } while (0)
#define PG8_MMA(ai, bj, At, Bt) do { __builtin_amdgcn_s_setprio(1); _Pragma("unroll") for (int m = 0; m < 4; ++m) _Pragma("unroll") for (int n = 0; n < 2; ++n) _Pragma("unroll") for (int k = 0; k < 2; ++k) \
        acc[ai][bj][m][n] = __builtin_amdgcn_mfma_f32_16x16x32_bf16(Bt[n][k], At[m][k], acc[ai][bj][m][n], 0, 0, 0); __builtin_amdgcn_s_setprio(0); } while (0)
#define PG8_WAIT_V(n) asm volatile("s_waitcnt vmcnt(" #n ")" ::: "memory")
#define PG8_WAIT_L(n) asm volatile("s_waitcnt lgkmcnt(" #n ")" ::: "memory")
#define PG8_BAR __builtin_amdgcn_s_barrier()
#define PG8_SCHED __builtin_amdgcn_sched_barrier(0)
    Unit cur, nxt; int ui = 0;
    if (!S.next(0, cur)) return;
    f32x4 acc[2][2][4][2];
#pragma unroll
    for (int a = 0; a < 2; ++a)
#pragma unroll
        for (int b = 0; b < 2; ++b)
#pragma unroll
            for (int m = 0; m < 4; ++m)
#pragma unroll
                for (int n = 0; n < 2; ++n) acc[a][b][m][n] = (f32x4){0.f, 0.f, 0.f, 0.f};
    bf16x8 At[4][2], B0[2][2], B1[2][2];
    const char* cA = cur.a; const char* cB = cur.b;
    PG8_STAGE(PG8_SB(0, 0), cB, voffB); PG8_STAGE(PG8_SB(0, 1), cB + hstep, voffB); PG8_STAGE(PG8_SA(0, 0), cA, voffA); PG8_STAGE(PG8_SA(0, 1), cA + hstep, voffA);
    if (wr == 1) PG8_BAR;
    PG8_WAIT_V(2); PG8_BAR;
    PG8_STAGE(PG8_SB(1, 0), cB + kstep, voffB); PG8_STAGE(PG8_SA(1, 0), cA + kstep, voffA); PG8_STAGE(PG8_SB(1, 1), cB + hstep + kstep, voffB);
    PG8_WAIT_V(6); PG8_BAR;
    for (;;) {
        const bool has_next = S.next(ui + 1, nxt);
        const char* nA = has_next ? nxt.a : cA; const char* nB = has_next ? nxt.b : cB;
        for (int t = 0; t < nt; t += 2) {
            const bool last = (t == nt - 2);
            const char* a1 = cA + (size_t)(t + 1) * kstep;
            const char* a2 = last ? nA : cA + (size_t)(t + 2) * kstep; const char* b2 = last ? nB : cB + (size_t)(t + 2) * kstep;
            const char* a3 = a2 + kstep; const char* b3 = b2 + kstep;
            PG8_LDB(B0, 0, 0); PG8_LDB(B1, 0, 1); PG8_SCHED; PG8_LDA(At, 0, 0); PG8_STAGE(PG8_SA(1, 1), a1 + hstep, voffA);
            PG8_WAIT_V(8); PG8_WAIT_L(0); PG8_BAR; PG8_MMA(0, 0, At, B0); PG8_MMA(0, 1, At, B1); PG8_BAR; PG8_SCHED;
            PG8_LDA(At, 0, 1); PG8_STAGE(PG8_SB(0, 0), b2, voffB); PG8_STAGE(PG8_SB(0, 1), b2 + hstep, voffB); PG8_STAGE(PG8_SA(0, 0), a2, voffA);
            PG8_WAIT_V(8); PG8_WAIT_L(0); PG8_BAR; PG8_MMA(1, 0, At, B0); PG8_MMA(1, 1, At, B1); PG8_BAR; PG8_SCHED;
            PG8_LDB(B0, 1, 0); PG8_LDB(B1, 1, 1); PG8_SCHED; PG8_LDA(At, 1, 0); PG8_STAGE(PG8_SA(0, 1), a2 + hstep, voffA);
            PG8_WAIT_V(8); PG8_WAIT_L(0); PG8_BAR; PG8_MMA(0, 0, At, B0); PG8_MMA(0, 1, At, B1); PG8_BAR; PG8_SCHED;
            PG8_LDA(At, 1, 1); PG8_STAGE(PG8_SB(1, 0), b3, voffB); PG8_STAGE(PG8_SB(1, 1), b3 + hstep, voffB); PG8_STAGE(PG8_SA(1, 0), a3, voffA);
            PG8_WAIT_V(8); PG8_WAIT_L(0); PG8_BAR; PG8_MMA(1, 0, At, B0); PG8_MMA(1, 1, At, B1); PG8_BAR; PG8_SCHED;
        }
        if constexpr (ALIGN_EPI) { if (wr == 0) PG8_BAR; }
        E(acc, cur, wr, wc, fr, fq);
        if (!has_next) break;
        if (!cur.keep) {
#pragma unroll
        for (int a = 0; a < 2; ++a)
#pragma unroll
            for (int b = 0; b < 2; ++b)
#pragma unroll
                for (int m = 0; m < 4; ++m)
#pragma unroll
                    for (int n = 0; n < 2; ++n) acc[a][b][m][n] = (f32x4){0.f, 0.f, 0.f, 0.f};
        }
        cur = nxt; cA = nA; cB = nB; ++ui;
        if constexpr (ALIGN_EPI) { if (wr == 1) PG8_BAR; }
    }
    PG8_WAIT_V(0);
    if constexpr (!ALIGN_EPI) { if (wr == 0) PG8_BAR; }
    PG8_BAR;
#undef PG8_SA
#undef PG8_SB
#undef PG8_STAGE
#undef PG8_LDA
#undef PG8_LDB
#undef PG8_MMA
#undef PG8_WAIT_V
#undef PG8_WAIT_L
#undef PG8_BAR
#undef PG8_SCHED
}
}
namespace att {
typedef int v8i __attribute__((ext_vector_type(8)));
constexpr int NW = 8, QBLK = 32, KVBLK = 64;
constexpr float SCALE = 0.088388347648318440f;
constexpr float SC8 = SCALE / 256.f;
constexpr float THR = 3.f;
constexpr int LDQ = D, LDO = D;
constexpr int SHM_V = 8192, SHM_K = 8192, OFF_K = 2 * SHM_V, OFF_WS = OFF_K + 2 * SHM_K, OST_OFF = OFF_WS + NW * 64 * 4, LDS_TOTAL = OST_OFF + NW * 8192;
#define SBAR() __builtin_amdgcn_sched_barrier(0)
#define MFMA8(a, b, c) __builtin_amdgcn_mfma_scale_f32_32x32x64_f8f6f4((a), (b), (c), 0, 0, 0, 0x7f7f7f7f, 0, 0x7f7f7f7f)
__device__ __forceinline__ int crow(int r, int hi) { return (r & 3) + 8 * (r >> 2) + 4 * hi; }
__device__ __forceinline__ int k_lds(int row, int chunk) { return row * 128 + ((chunk ^ ((row >> 1) & 7)) << 4); }
__device__ __forceinline__ int v_lds(int d, int slot) { return d * 64 + ((slot ^ ((d >> 2) & 3)) << 4); }
__device__ __forceinline__ int pk4_fp8(float a, float b, float c, float d) { int w = __builtin_amdgcn_cvt_pk_fp8_f32(a, b, 0, false); return __builtin_amdgcn_cvt_pk_fp8_f32(c, d, w, true); }

__device__ __forceinline__ void partialSM(f32x16& p0, f32x16& p1, float& m_reg, float& mn, float& alpha) {
  constexpr float C = SC8 * 1.4426950408889634f;
  float pmax = p0[0]; for (int r = 1; r < 16; ++r) pmax = fmaxf(pmax, p0[r]); for (int r = 0; r < 16; ++r) pmax = fmaxf(pmax, p1[r]);
  { auto rr = __builtin_amdgcn_permlane32_swap(__float_as_uint(pmax), __float_as_uint(pmax), false, false);
    pmax = fmaxf(__uint_as_float(rr[0]), __uint_as_float(rr[1])); }
  if (__builtin_expect(__all(pmax - m_reg <= THR / SC8), 1)) { mn = m_reg; alpha = 1.f; }
  else { mn = fmaxf(m_reg, pmax); alpha = __builtin_amdgcn_exp2f((m_reg - mn) * C); m_reg = mn; }
  float mnC = 4.f - mn * C;
  for (int r = 0; r < 16; ++r) p0[r] = fmaf(p0[r], C, mnC); for (int r = 0; r < 16; ++r) p1[r] = fmaf(p1[r], C, mnC);
  for (int r = 0; r < 16; ++r) p0[r] = __builtin_amdgcn_exp2f(p0[r]);
}
__device__ __forceinline__ void finishSM(f32x16& p0, f32x16& p1, float alpha, float& l_reg, v8i& pa) {
  for (int r = 0; r < 16; ++r) p1[r] = __builtin_amdgcn_exp2f(p1[r]);
  float ps = 0; for (int r = 0; r < 16; ++r) ps += p0[r]; for (int r = 0; r < 16; ++r) ps += p1[r];
  { auto rr = __builtin_amdgcn_permlane32_swap(__float_as_uint(ps), __float_as_uint(ps), false, false);
    ps = __uint_as_float(rr[0]) + __uint_as_float(rr[1]); }
  l_reg = l_reg * alpha + ps;
  pa[0] = pk4_fp8(p0[0], p0[1], p0[2], p0[3]); pa[1] = pk4_fp8(p0[4], p0[5], p0[6], p0[7]); pa[2] = pk4_fp8(p0[8], p0[9], p0[10], p0[11]); pa[3] = pk4_fp8(p0[12], p0[13], p0[14], p0[15]);
  pa[4] = pk4_fp8(p1[0], p1[1], p1[2], p1[3]); pa[5] = pk4_fp8(p1[4], p1[5], p1[6], p1[7]); pa[6] = pk4_fp8(p1[8], p1[9], p1[10], p1[11]); pa[7] = pk4_fp8(p1[12], p1[13], p1[14], p1[15]);
}
__device__ __forceinline__ v8i ld32(const char* p0, const char* p1) { const u32x4 a = *reinterpret_cast<const u32x4*>(p0), b = *reinterpret_cast<const u32x4*>(p1);
  v8i r; r[0] = (int)a[0]; r[1] = (int)a[1]; r[2] = (int)a[2]; r[3] = (int)a[3]; r[4] = (int)b[0]; r[5] = (int)b[1]; r[6] = (int)b[2]; r[7] = (int)b[3]; return r; }
__device__ __forceinline__ void qkt(f32x16& p0, f32x16& p1, const char* Ks, const v8i* qf, int r32, int hi) {
  p0 = f32x16{}; p1 = f32x16{};
#pragma unroll
  for (int s = 0; s < 2; ++s) {
    const v8i a0 = ld32(Ks + k_lds(r32, 4 * s + hi), Ks + k_lds(r32, 4 * s + 2 + hi)), a1 = ld32(Ks + k_lds(32 + r32, 4 * s + hi), Ks + k_lds(32 + r32, 4 * s + 2 + hi));
    p0 = MFMA8(a0, qf[s], p0); p1 = MFMA8(a1, qf[s], p1); }
}
__device__ __forceinline__ void pv(f32x16* o, const char* Vs, const v8i pa, int r32, int hi) {
#pragma unroll
  for (int d0 = 0; d0 < 4; ++d0) { const int d = 32 * d0 + r32; const v8i b = ld32(Vs + v_lds(d, 2 * hi), Vs + v_lds(d, 2 * hi + 1)); o[d0] = MFMA8(pa, b, o[d0]); }
}

__device__ __forceinline__ void attn_unit(const bf16_t* Qb, const unsigned char* __restrict__ K8, const unsigned char* __restrict__ VT, bf16_t* Ob, int t0, int seq,
                                          const float* __restrict__ qng, const float* __restrict__ cst, const float* __restrict__ snt, char* lds) {
  int tid_ = threadIdx.x; asm volatile("" : "+v"(tid_));
  const int tid = tid_, wid = tid >> 6, lane = tid & 63, r32 = lane & 31, hi = lane >> 5;
  char* V_lds = lds; char* K_lds = lds + OFF_K;
  float* ws = (float*)(lds + OFF_WS) + wid * 64; float* li_l = ws; float* al_l = ws + 32;
  float m_reg = -1e30f, l_reg = 0; f32x16 o[4] = {}; v8i qf[2];
  {
    const bf16_t* Qw = Qb + (long)(wid * QBLK + r32) * LDQ + 16 * hi;
    float y[2][32]; float ss = 0.f;
#pragma unroll
    for (int s = 0; s < 2; ++s)
#pragma unroll
      for (int part = 0; part < 2; ++part)
#pragma unroll
        for (int c = 0; c < 2; ++c) { const u32x4 w = *reinterpret_cast<const u32x4*>(Qw + 64 * s + 32 * part + 8 * c);
#pragma unroll
          for (int j = 0; j < 4; ++j) { const float a = bf_lo(w[j]), b = bf_hi(w[j]); y[s][16 * part + 8 * c + 2 * j] = a; y[s][16 * part + 8 * c + 2 * j + 1] = b; ss += a * a + b * b; } }
    ss += __shfl_xor(ss, 32);
    const float rstd = rsqrtf(ss * (1.f / HD) + EPS) * 16.f;
    const int t = t0 + wid * QBLK + r32;
#pragma unroll
    for (int s = 0; s < 2; ++s) { const int pos = s == 0 ? (t >> 6) : (t & 63);
#pragma unroll
      for (int c = 0; c < 4; ++c) { const int i0 = 16 * hi + 4 * c;
        const f32x4 g1 = *reinterpret_cast<const f32x4*>(qng + 64 * s + i0), g2 = *reinterpret_cast<const f32x4*>(qng + 64 * s + 32 + i0);
        const f32x4 c4 = *reinterpret_cast<const f32x4*>(cst + pos * 32 + i0), s4 = *reinterpret_cast<const f32x4*>(snt + pos * 32 + i0);
#pragma unroll
        for (int j = 0; j < 4; ++j) { const float x1 = y[s][4 * c + j] * rstd * g1[j], x2 = y[s][16 + 4 * c + j] * rstd * g2[j]; y[s][4 * c + j] = x1 * c4[j] - x2 * s4[j]; y[s][16 + 4 * c + j] = x1 * s4[j] + x2 * c4[j]; } }
#pragma unroll
      for (int w = 0; w < 8; ++w) qf[s][w] = pk4_fp8(y[s][4 * w], y[s][4 * w + 1], y[s][4 * w + 2], y[s][4 * w + 3]); }
  }
  const int krow = tid >> 3, kch = tid & 7, kst = k_lds(krow, kch), vst = v_lds(tid >> 2, tid & 3);
  const unsigned char* kg = K8 + (long)krow * 256 + kch * 16; const unsigned char* vg = VT + tid * 16;
  struct { u32x4 k, v; } sr_[2];
#define SLOAD(i, kt) do { sr_[i].k = *reinterpret_cast<const u32x4*>(kg + (long)(kt) * (KVBLK * 256)); sr_[i].v = *reinterpret_cast<const u32x4*>(vg + (long)(kt) * 8192); } while (0)
#define SWRITE(b, i) do { *(u32x4*)(V_lds + (b) * SHM_V + vst) = sr_[i].v; *(u32x4*)(K_lds + (b) * SHM_K + kst) = sr_[i].k; } while (0)
#define SWAIT() asm volatile("s_waitcnt vmcnt(2)" ::: "memory")
#define RESC(a) do { if (__any((a) < 1.f)) { if (hi == 0) al_l[r32] = (a); asm volatile("s_waitcnt lgkmcnt(0)" ::: "memory"); \
    for (int d = 0; d < 4; ++d) for (int r = 0; r < 16; ++r) o[d][r] *= al_l[crow(r, hi)]; } } while (0)
  f32x16 pA0, pA1, pB0, pB1; float mnA, mnB, alA, alB; v8i pa; const int NT = seq / KVBLK;
  constexpr int SE = 0, SO = 1;
  SLOAD(SE, 0); asm volatile("s_waitcnt vmcnt(0)" ::: "memory"); SWRITE(0, SE); __syncthreads();
  qkt(pA0, pA1, K_lds, qf, r32, hi); partialSM(pA0, pA1, m_reg, mnA, alA);
  SLOAD(SO, 1); if (2 < NT) SLOAD(SE, 2);
  SWAIT(); SWRITE(1, SO); __syncthreads();
  for (int j = 1; j + 1 < NT; j += 2) {
    SBAR(); qkt(pB0, pB1, K_lds + SHM_K, qf, r32, hi);
    finishSM(pA0, pA1, alA, l_reg, pa); SBAR();
    SLOAD(SO, j + 2); SBAR();
    pv(o, V_lds, pa, r32, hi); partialSM(pB0, pB1, m_reg, mnB, alB);
    __syncthreads(); SWAIT(); SWRITE(0, SE);
    RESC(alB); __syncthreads();
    SBAR(); qkt(pA0, pA1, K_lds, qf, r32, hi);
    finishSM(pB0, pB1, alB, l_reg, pa); SBAR();
    if (j + 3 < NT) SLOAD(SE, j + 3); SBAR();
    pv(o, V_lds + SHM_V, pa, r32, hi); partialSM(pA0, pA1, m_reg, mnA, alA);
    __syncthreads(); SWAIT(); SWRITE(1, SO);
    RESC(alA); __syncthreads();
  }
  SBAR(); qkt(pB0, pB1, K_lds + SHM_K, qf, r32, hi);
  finishSM(pA0, pA1, alA, l_reg, pa); SBAR();
  pv(o, V_lds, pa, r32, hi); partialSM(pB0, pB1, m_reg, mnB, alB);
  __syncthreads(); RESC(alB);
  finishSM(pB0, pB1, alB, l_reg, pa); SBAR();
  pv(o, V_lds + SHM_V, pa, r32, hi);
  if (hi == 0) li_l[r32] = l_reg; asm volatile("s_waitcnt lgkmcnt(0)" ::: "memory");
  float rli[16];
#pragma unroll
  for (int r = 0; r < 16; ++r) rli[r] = __builtin_amdgcn_rcpf(16.f * li_l[crow(r, hi)]);
  { bf16_t* stg = (bf16_t*)(lds + OST_OFF) + wid * 4096;
#pragma unroll
    for (int r = 0; r < 16; ++r) { const int orow = crow(r, hi);
#pragma unroll
      for (int d0 = 0; d0 < 4; ++d0) stg[orow * 128 + d0 * 32 + r32] = (bf16_t)(cvt_pk_bf16(o[d0][r] * rli[r], 0.f) & 0xffffu); }
    asm volatile("s_waitcnt lgkmcnt(0)" ::: "memory");
    bf16_t* Ow = Ob + (long)(wid * QBLK) * LDO;
#pragma unroll
    for (int i = 0; i < 8; ++i) { const int row = i * 4 + (lane >> 4), ch = lane & 15; const u32x4 v = *(const u32x4*)(stg + row * 128 + ch * 8); *(u32x4*)(Ow + (long)row * LDO + ch * 8) = v; }
  }
#undef SLOAD
#undef SWRITE
#undef SWAIT
#undef RESC
}
#undef SBAR
#undef MFMA8
}
constexpr size_t MiB = 1u << 20;
constexpr size_t WS_CTL = 0, CTL_ZERO_BYTES = 64 * 1024;
constexpr size_t WS_MOD = 1 * MiB;
constexpr size_t WS_ROPE = WS_MOD + 256 * 1024;
constexpr size_t WS_SBIAS = WS_MOD + 512 * 1024;
constexpr size_t WS_HC = 2 * MiB;
constexpr size_t WS_WIN = 6 * MiB;
constexpr size_t WS_WA = 17 * MiB, WS_WC = 19 * MiB, WS_WO = 21 * MiB;
constexpr size_t WS_WP = 23 * MiB;
constexpr size_t WS_UT = 27 * MiB, WS_VT = 59 * MiB;
constexpr size_t WS_TSCALE = 16 * MiB;
constexpr size_t WS_KB = 91 * MiB, WS_VB = 108 * MiB;
constexpr size_t WS_HX = 125 * MiB;
constexpr size_t WS_Q = 189 * MiB;
constexpr size_t WS_G = 253 * MiB;
constexpr size_t WS_RT = 317 * MiB;
constexpr size_t WS_SGC = 381 * MiB;
constexpr size_t WS_SC = 189 * MiB;
constexpr size_t WS_SSQ = 445 * MiB;
constexpr size_t WS_K8 = 447 * MiB;
constexpr size_t WS_VT8 = 456 * MiB;
constexpr size_t WS_END = 465 * MiB;

constexpr int NWAVES = 8;
constexpr int LDS_BYTES = 147456;

struct Args {
    const float *x, *c, *ctx, *c_ctx, *w_mod, *b_mod, *n1g, *n2g, *w_in, *qng, *kng, *w_ao, *cdw, *cb, *clg, *clb, *w_co, *w_o, *wq, *keys, *ut, *vt, *fg;
    float* out; unsigned char* ws; int ph_lo, ph_hi, dry, pad;
};

__host__ __device__ __forceinline__ int win_row(int n) {
    if (n < 1536) return n;
    const int base = n < 3584 ? 1536 : 3584, m = n - base, half = m >> 10, idx = m & 1023;
    return base + (idx >> 7) * 256 + half * 128 + (idx & 127);
}

__device__ __forceinline__ void task_mod(const Args& A, int task, int lane, const LAS float* sc) {
    const int n0 = task * 8, col = lane & 7, kg = lane >> 3;
    float acc[9];
#pragma unroll
    for (int b = 0; b < 9; ++b) acc[b] = 0.f;
    const float* wp = A.w_mod + (size_t)kg * NMOD + n0 + col;
    for (int i0 = 0; i0 < 128; i0 += 8) {
        float w[8];
#pragma unroll
        for (int u = 0; u < 8; ++u) w[u] = wp[(size_t)(i0 + u) * 8 * NMOD];
#pragma unroll
        for (int u = 0; u < 8; ++u) { const int k = kg + 8 * (i0 + u);
#pragma unroll
            for (int b = 0; b < 9; ++b) acc[b] += sc[b * D + k] * w[u]; }
    }
#pragma unroll
    for (int b = 0; b < 9; ++b) { float v = acc[b]; v += __shfl_xor(v, 8); v += __shfl_xor(v, 16); v += __shfl_xor(v, 32); acc[b] = v; }
    if (lane < 8) { float* mod = (float*)(A.ws + WS_MOD); const float bm = A.b_mod[n0 + col];
#pragma unroll
        for (int b = 0; b < 9; ++b) mod[b * NMOD + n0 + col] = acc[b] + bm; }
}
__device__ __forceinline__ void task_transpose(const float* W, int K, int N, bf16_t* WT, int k0, int n0, int row0, LAS float* scr, int lane) {
#pragma unroll 8
    for (int i = 0; i < 32; ++i) { const int kk = 2 * i + (lane >> 5); scr[kk * 33 + (lane & 31)] = W[(size_t)(k0 + kk) * N + n0 + (lane & 31)]; }
    asm volatile("s_waitcnt lgkmcnt(0)" ::: "memory");
    const int c = lane & 7;
#pragma unroll
    for (int j = 0; j < 4; ++j) { const int n = (lane >> 3) + 8 * j; const LAS float* s = scr + (8 * c) * 33 + n;
        u32x4 o; o.x = cvt_pk_bf16(s[0 * 33], s[1 * 33]); o.y = cvt_pk_bf16(s[2 * 33], s[3 * 33]); o.z = cvt_pk_bf16(s[4 * 33], s[5 * 33]); o.w = cvt_pk_bf16(s[6 * 33], s[7 * 33]);
        *(u32x4*)(WT + (size_t)(row0 + n) * K + k0 + 8 * c) = o; }
    asm volatile("s_waitcnt lgkmcnt(0)" ::: "memory");
}
__device__ __forceinline__ void task_quant_rows4(const float* src, unsigned char* dst, float* scale_out, int lane) {
    f32x4 v[4][4];
#pragma unroll
    for (int r = 0; r < 4; ++r)
#pragma unroll
        for (int i = 0; i < 4; ++i) v[r][i] = *(const f32x4*)(src + (size_t)r * D + (i * 64 + lane) * 4);
#pragma unroll
    for (int r = 0; r < 4; ++r) {
        float am = 0.f;
#pragma unroll
        for (int i = 0; i < 4; ++i) am = fmaxf(fmaxf(am, fmaxf(fabsf(v[r][i][0]), fabsf(v[r][i][1]))), fmaxf(fabsf(v[r][i][2]), fabsf(v[r][i][3])));
#pragma unroll
        for (int o = 1; o < 64; o <<= 1) am = fmaxf(am, __shfl_xor(am, o));
        const float inv = am > 0.f ? 448.f / am : 0.f;
#pragma unroll
        for (int i = 0; i < 4; ++i) { int p = __builtin_amdgcn_cvt_pk_fp8_f32(v[r][i][0] * inv, v[r][i][1] * inv, 0, false); p = __builtin_amdgcn_cvt_pk_fp8_f32(v[r][i][2] * inv, v[r][i][3] * inv, p, true);
            *(int*)(dst + (size_t)r * D + (i * 64 + lane) * 4) = p; }
        if (lane == 0) scale_out[r] = am * (1.f / 448.f);
    }
}
__device__ __forceinline__ bf16x8 ld8_f32_bf16(const float* p) { const f32x4 a = *(const f32x4*)p, b = *(const f32x4*)(p + 4); u32x4 w = {cvt_pk_bf16(a[0], a[1]), cvt_pk_bf16(a[2], a[3]), cvt_pk_bf16(b[0], b[1]), cvt_pk_bf16(b[2], b[3])}; return *reinterpret_cast<bf16x8*>(&w); }
__device__ __forceinline__ void task_wprime(const Args& A, int id, int lane) {
    const int hp = id >> 7, rem = id & 127, n0 = (rem >> 5) * 32, k0 = (rem & 31) * 32, r32 = lane & 31, hi = lane >> 5;
    f32x16 acc = {};
    const float* ka = A.keys + ((size_t)(hp * 128 + n0 + r32)) * 128 + hi * 8;
    const float* wb = A.wq + (size_t)(k0 + r32) * PW + hp * 128 + hi * 8;
#pragma unroll
    for (int s = 0; s < 8; ++s) acc = __builtin_amdgcn_mfma_f32_32x32x16_bf16(ld8_f32_bf16(ka + s * 16), ld8_f32_bf16(wb + s * 16), acc, 0, 0, 0);
    bf16_t* o = (bf16_t*)(A.ws + WS_WP);
#pragma unroll
    for (int r = 0; r < 16; ++r) { const int n = (r & 3) + 8 * (r >> 2) + 4 * hi; o[(size_t)(hp * 128 + n0 + n) * D + k0 + r32] = (bf16_t)(cvt_pk_bf16(acc[r], 0.f) & 0xffffu); }
}
__device__ __forceinline__ void phase_prologue(const Args& A, LAS unsigned char* lds) {
    const int tid = threadIdx.x, lane = tid & 63, wave = __builtin_amdgcn_readfirstlane(tid >> 6);
    LAS float* sc = (LAS float*)lds;
    for (int i = tid; i < 9 * D; i += 512) { const float v = i < 8 * D ? A.c[i] : A.c_ctx[i - 8 * D]; sc[i] = v / (1.f + __expf(-v)); }
    __syncthreads();
    LAS float* scr = (LAS float*)(lds + 36864 + wave * 8448);
    constexpr int T_MOD = NMOD / 8, T_WIN = (D / 64) * (INW / 32), T_SQ = (D / 64) * (D / 32), T_UV = 2 * NEXP / 4, T_WP = 2048, T_ROPE = 1;
    constexpr int NT = T_MOD + T_WIN + 3 * T_SQ + T_UV + T_WP + T_ROPE;
    const int G = gridDim.x;
    for (int task = wave * G + blockIdx.x; task < NT; task += NWAVES * G) {
        int r = task;
        if (r < T_MOD) { task_mod(A, r, lane, sc); continue; } r -= T_MOD;
        if (r < T_WIN) { const int nblk = INW / 32, kb = r / nblk, nb = r % nblk; task_transpose(A.w_in, D, INW, (bf16_t*)(A.ws + WS_WIN), 64 * kb, 32 * nb, win_row(32 * nb), scr, lane); continue; } r -= T_WIN;
        if (r < 3 * T_SQ) { const int wsel = r / T_SQ, q = r % T_SQ, kb = q / 32, nb = q % 32;
            const float* W = wsel == 0 ? A.w_ao : (wsel == 1 ? A.w_co : A.w_o); bf16_t* WT = (bf16_t*)(A.ws + (wsel == 0 ? WS_WA : (wsel == 1 ? WS_WC : WS_WO)));
            task_transpose(W, D, D, WT, 64 * kb, 32 * nb, 32 * nb, scr, lane); continue; } r -= 3 * T_SQ;
        if (r < T_UV) { const int tb = r / (NEXP / 4), row = (r % (NEXP / 4)) * 4; unsigned char* tbase = A.ws + (tb ? WS_VT : WS_UT);
            task_quant_rows4((tb ? A.vt : A.ut) + (size_t)row * D, tbase + (size_t)row * D, (float*)(tbase + WS_TSCALE) + row, lane); continue; } r -= T_UV;
        if (r < T_WP) { task_wprime(A, r, lane); continue; } r -= T_WP;
        { float* cs = (float*)(A.ws + WS_ROPE); float* sn = cs + 2048;
          for (int e = lane; e < 2048; e += 64) { const int p = e >> 5, i = e & 31; const float inv = powf(10000.f, -(float)(2 * i) / 64.f); const float a = (float)p * inv; cs[e] = cosf(a); sn[e] = sinf(a); } }
    }
}
__device__ __forceinline__ void normmod_row(const float* xr, const float* g, const float* modr, int sh_off, int sc_off, bf16_t* orow, int lane) {
    f32x4 v[4]; float ss = 0.f;
#pragma unroll
    for (int i = 0; i < 4; ++i) { v[i] = *(const f32x4*)(xr + (i * 64 + lane) * 4); ss += (v[i][0] * v[i][0] + v[i][1] * v[i][1]) + (v[i][2] * v[i][2] + v[i][3] * v[i][3]); }
    const float r = rsqrtf(wave_sum(ss) * (1.f / D) + EPS);
#pragma unroll
    for (int i = 0; i < 4; ++i) { const int k = (i * 64 + lane) * 4; const f32x4 gg = *(const f32x4*)(g + k), s1 = *(const f32x4*)(modr + sc_off + k), h1 = *(const f32x4*)(modr + sh_off + k);
        float y[4];
#pragma unroll
        for (int j = 0; j < 4; ++j) y[j] = v[i][j] * r * gg[j] * (1.f + s1[j]) + h1[j];
        u32x2 o = {cvt_pk_bf16(y[0], y[1]), cvt_pk_bf16(y[2], y[3])}; *(u32x2*)(orow + k) = o; }
}
__device__ __forceinline__ void phase_hx(const Args& A) {
    const int lane = threadIdx.x & 63, gw = blockIdx.x * NWAVES + (threadIdx.x >> 6), NGW = gridDim.x * NWAVES;
    const float* mod = (const float*)(A.ws + WS_MOD);
    for (int m = gw; m < M + MC; m += NGW) {
        if (m < M) normmod_row(A.x + (size_t)m * D, A.n1g, mod + (m >> 12) * NMOD, 0, D, (bf16_t*)(A.ws + WS_HX) + (size_t)m * D, lane);
        else { const int r = m - M; normmod_row(A.ctx + (size_t)r * D, A.n1g, mod + 8 * NMOD, 0, D, (bf16_t*)(A.ws + WS_HC) + (size_t)r * D, lane); }
    }
    const bf16_t* WP = (const bf16_t*)(A.ws + WS_WP); float* sb = (float*)(A.ws + WS_SBIAS);
    for (int col = gw; col < PW; col += NGW) {
        const u32x4 w0 = *(const u32x4*)(WP + (size_t)col * D + lane * 16), w1 = *(const u32x4*)(WP + (size_t)col * D + lane * 16 + 8);
        float wv[16];
#pragma unroll
        for (int j = 0; j < 4; ++j) { wv[2 * j] = bf_lo(w0[j]); wv[2 * j + 1] = bf_hi(w0[j]); wv[8 + 2 * j] = bf_lo(w1[j]); wv[8 + 2 * j + 1] = bf_hi(w1[j]); }
#pragma unroll 1
        for (int b = 0; b < NB; ++b) { const float* sh = mod + b * NMOD + 3 * D + lane * 16; float s = 0.f;
#pragma unroll
            for (int q = 0; q < 4; ++q) { const f32x4 v = *(const f32x4*)(sh + 4 * q); s += v[0] * wv[4 * q] + v[1] * wv[4 * q + 1] + v[2] * wv[4 * q + 2] + v[3] * wv[4 * q + 3]; }
            s = wave_sum(s); if (lane == 0) sb[b * PW + col] = s; }
    }
}
__device__ __forceinline__ void phase_kfix(const Args& A) {
    const int lane = threadIdx.x & 63, gw = blockIdx.x * NWAVES + (threadIdx.x >> 6), NGW = gridDim.x * NWAVES, li = lane & 15, sub = lane >> 4;
    const bf16_t* KB = (const bf16_t*)(A.ws + WS_KB); const float* cs = (const float*)(A.ws + WS_ROPE); const float* sn = cs + 2048;
    constexpr int NITEM = NB * SKV * HKV;
    const f32x4 g0 = *(const f32x4*)(A.kng + li * 8), g1 = *(const f32x4*)(A.kng + li * 8 + 4);
    const f32x4 p0 = *(const f32x4*)(A.kng + (li ^ 4) * 8), p1 = *(const f32x4*)(A.kng + (li ^ 4) * 8 + 4);
    for (int it = gw * 4 + sub; it < NITEM; it += NGW * 4) {
        const int row = it >> 1, h = it & 1, t = row % SKV;
        const bf16_t* p = KB + (size_t)row * 256 + h * HD + li * 8;
        const u32x4 w = *(const u32x4*)p;
        float x[8], xp[8]; float ss = 0.f;
#pragma unroll
        for (int j = 0; j < 4; ++j) { x[2 * j] = bf_lo(w[j]); x[2 * j + 1] = bf_hi(w[j]); ss += x[2 * j] * x[2 * j] + x[2 * j + 1] * x[2 * j + 1];
            const unsigned pw = (unsigned)__shfl_xor((int)w[j], 4); xp[2 * j] = bf_lo(pw); xp[2 * j + 1] = bf_hi(pw); }
        ss += __shfl_xor(ss, 1); ss += __shfl_xor(ss, 2); ss += __shfl_xor(ss, 4); ss += __shfl_xor(ss, 8);
        const float r = rsqrtf(ss * (1.f / HD) + EPS);
        float y[8];
#pragma unroll
        for (int j = 0; j < 8; ++j) { x[j] *= r * (j < 4 ? g0[j] : g1[j - 4]); xp[j] *= r * (j < 4 ? p0[j] : p1[j - 4]); y[j] = x[j]; }
        if (t < S) {
            const int blk = li >> 3, pos = blk == 0 ? (t >> 6) : (t & 63), second = (li >> 2) & 1, i0 = (li & 3) * 8;
            const f32x4 c0 = *(const f32x4*)(cs + pos * 32 + i0), c1 = *(const f32x4*)(cs + pos * 32 + i0 + 4), s0 = *(const f32x4*)(sn + pos * 32 + i0), s1 = *(const f32x4*)(sn + pos * 32 + i0 + 4);
#pragma unroll
            for (int j = 0; j < 8; ++j) { const float c = j < 4 ? c0[j] : c1[j - 4], s = j < 4 ? s0[j] : s1[j - 4];
                y[j] = second ? (xp[j] * s + x[j] * c) : (x[j] * c - xp[j] * s); }
        }
        u32x2 o = {(unsigned)att::pk4_fp8(y[0] * 16.f, y[1] * 16.f, y[2] * 16.f, y[3] * 16.f), (unsigned)att::pk4_fp8(y[4] * 16.f, y[5] * 16.f, y[6] * 16.f, y[7] * 16.f)};
        *(u32x2*)(A.ws + WS_K8 + (size_t)row * 256 + h * HD + li * 8) = o;
    }
}
__device__ __forceinline__ void phase_vt(const Args& A, LAS unsigned char* lds) {
    const int lane = threadIdx.x & 63, wave = threadIdx.x >> 6, gw = blockIdx.x * NWAVES + wave, NGW = gridDim.x * NWAVES;
    LAS unsigned char* tl = lds + wave * 8192;
    const bf16_t* VB = (const bf16_t*)(A.ws + WS_VB);
    const int kk = lane & 31, pos = 32 * ((kk >> 2) & 1) + (kk & 3) + 4 * (kk >> 3) + 16 * (lane >> 5);
    constexpr int NTILE = SKV / 64;
    for (int it = gw; it < NB * HKV * NTILE; it += NGW) {
        const int j = it % NTILE, bk = it / NTILE, b = bk >> 1, kv = bk & 1;
        const bf16_t* src = VB + ((size_t)b * SKV + j * 64 + lane) * 256 + kv * HD;
#pragma unroll
        for (int c = 0; c < 16; ++c) { const u32x4 w = *(const u32x4*)(src + c * 8);
#pragma unroll
            for (int q = 0; q < 4; ++q) { const int pk = __builtin_amdgcn_cvt_pk_fp8_f32(bf_lo(w[q]) * 16.f, bf_hi(w[q]) * 16.f, 0, false);
                tl[(c * 8 + 2 * q) * 64 + pos] = (unsigned char)(pk & 0xff); tl[(c * 8 + 2 * q + 1) * 64 + pos] = (unsigned char)((pk >> 8) & 0xff); } }
        asm volatile("s_waitcnt lgkmcnt(0)" ::: "memory");
        unsigned char* dst = A.ws + WS_VT8 + (size_t)it * 8192;
#pragma unroll
        for (int i = 0; i < 8; ++i) *(u32x4*)(dst + (i * 64 + lane) * 16) = *(const LAS u32x4*)(tl + (i * 64 + lane) * 16);
        asm volatile("s_waitcnt lgkmcnt(0)" ::: "memory");
    }
}
template <int R> struct ConvRow {
    static __device__ __forceinline__ void run(const unsigned* gp, int tl0, float (&acc)[32][2], const float (&w)[31][2]) {
        const int tl = tl0 + R - 15;
        unsigned v = 0u; if (tl >= 0 && tl < S) v = gp[(long)(R - 15) * (D / 2)];
        const float a = bf_lo(v), b = bf_hi(v);
#pragma unroll
        for (int t = (R - 30 > 0 ? R - 30 : 0); t <= (R < 31 ? R : 31); ++t) { acc[t][0] += w[R - t][0] * a; acc[t][1] += w[R - t][1] * b; }
        if constexpr (R + 1 < 62) ConvRow<R + 1>::run(gp, tl0, acc, w);
    }
};
__device__ __forceinline__ void phase_conv(const Args& A, LAS unsigned char* lds) {
    const int tid = threadIdx.x, lane = tid & 63, wave = tid >> 6;
    LAS float* tile = (LAS float*)lds;
    const bf16_t* G = (const bf16_t*)(A.ws + WS_G); bf16_t* CV = (bf16_t*)(A.ws + WS_HX);
    float w[31][2];
#pragma unroll
    for (int j = 0; j < 31; ++j) { const f32x2 t = *(const f32x2*)(A.cdw + j * D + 2 * tid); w[j][0] = t[0]; w[j][1] = t[1]; }
    const f32x2 bias = *(const f32x2*)(A.cb + 2 * tid);
    for (int tileid = blockIdx.x; tileid < M / 32; tileid += gridDim.x) {
        const int row0 = tileid * 32, tl0 = row0 & (S - 1);
        float acc[32][2];
#pragma unroll
        for (int t = 0; t < 32; ++t) { acc[t][0] = bias[0]; acc[t][1] = bias[1]; }
        ConvRow<0>::run((const unsigned*)(G + (size_t)row0 * D) + tid, tl0, acc, w);
        __syncthreads();
#pragma unroll
        for (int t = 0; t < 32; ++t) *(LAS f32x2*)(tile + t * D + 2 * tid) = (f32x2){acc[t][0], acc[t][1]};
        __syncthreads();
#pragma unroll
        for (int q = 0; q < 4; ++q) { const int t = wave * 4 + q; const LAS float* tr = tile + t * D;
            f32x4 v[4]; float s = 0.f;
#pragma unroll
            for (int i = 0; i < 4; ++i) { v[i] = *(const LAS f32x4*)(tr + (i * 64 + lane) * 4); s += (v[i][0] + v[i][1]) + (v[i][2] + v[i][3]); }
            const float mu = wave_sum(s) * (1.f / D); float qq = 0.f;
#pragma unroll
            for (int i = 0; i < 4; ++i) { v[i] = v[i] - mu; qq += (v[i][0] * v[i][0] + v[i][1] * v[i][1]) + (v[i][2] * v[i][2] + v[i][3] * v[i][3]); }
            const float rs = rsqrtf(wave_sum(qq) * (1.f / D) + EPS);
#pragma unroll
            for (int i = 0; i < 4; ++i) { const int k = (i * 64 + lane) * 4; const f32x4 gg = *(const f32x4*)(A.clg + k), bb = *(const f32x4*)(A.clb + k); float y[4];
#pragma unroll
                for (int j = 0; j < 4; ++j) { const float z = v[i][j] * rs * gg[j] + bb[j]; y[j] = z * fast_sigmoid(z); }
                u32x2 o = {cvt_pk_bf16(y[0], y[1]), cvt_pk_bf16(y[2], y[3])}; *(u32x2*)(CV + (size_t)(row0 + t) * D + k) = o; }
        }
    }
}
struct EpiInProj {
    static constexpr bool PERM = true;
    unsigned char* ws;
    __device__ __forceinline__ void operator()(f32x4 (&acc)[2][2][4][2], const pg8::Unit& u, int wr, int wc, int fr, int fq) const {
        const int c8 = wc * 32 + 8 * fq;
#pragma unroll
        for (int ai = 0; ai < 2; ++ai)
#pragma unroll
            for (int m = 0; m < 4; ++m) {
                const int row = u.pm * 256 + ai * 128 + wr * 64 + m * 16 + fr;
                if (u.kind == 0) {
                    bf16_t* p = (bf16_t*)(ws + WS_Q) + (size_t)row * D + u.pn * 256 + c8;
#pragma unroll
                    for (int bj = 0; bj < 2; ++bj) { const f32x4 v0 = acc[ai][bj][m][0], v1 = acc[ai][bj][m][1];
                        u32x4 w = {cvt_pk_bf16(v0[0], v0[1]), cvt_pk_bf16(v0[2], v0[3]), cvt_pk_bf16(v1[0], v1[1]), cvt_pk_bf16(v1[2], v1[3])}; *(u32x4*)(p + bj * 128) = w; }
                } else if (u.kind == 1 || u.kind == 2 || u.kind == 5 || u.kind == 6) {
                    const bool ctxu = u.kind >= 5;
                    const int kvrow = ctxu ? (row >> 8) * SKV + S + (row & 255) : (row >> 12) * SKV + (row & (S - 1));
                    bf16_t* p = (bf16_t*)(ws + ((u.kind == 1 || u.kind == 5) ? WS_KB : WS_VB)) + (size_t)kvrow * 256 + c8;
#pragma unroll
                    for (int bj = 0; bj < 2; ++bj) { const f32x4 v0 = acc[ai][bj][m][0], v1 = acc[ai][bj][m][1];
                        u32x4 w = {cvt_pk_bf16(v0[0], v0[1]), cvt_pk_bf16(v0[2], v0[3]), cvt_pk_bf16(v1[0], v1[1]), cvt_pk_bf16(v1[2], v1[3])}; *(u32x4*)(p + bj * 128) = w; }
                } else if (u.kind == 3) {
                    float g[8];
#pragma unroll
                    for (int n = 0; n < 2; ++n)
#pragma unroll
                        for (int j = 0; j < 4; ++j) g[4 * n + j] = acc[ai][0][m][n][j] * fast_sigmoid(acc[ai][1][m][n][j]);
                    u32x4 w = {cvt_pk_bf16(g[0], g[1]), cvt_pk_bf16(g[2], g[3]), cvt_pk_bf16(g[4], g[5]), cvt_pk_bf16(g[6], g[7])};
                    *(u32x4*)((bf16_t*)(ws + WS_G) + (size_t)row * D + (u.pn - 6) * 128 + c8) = w;
                } else {
                    float rt[8], sg[8];
#pragma unroll
                    for (int n = 0; n < 2; ++n)
#pragma unroll
                        for (int j = 0; j < 4; ++j) { const float ea = __builtin_amdgcn_exp2f(-1.4426950408889634f * acc[ai][0][m][n][j]), ec = __builtin_amdgcn_exp2f(-1.4426950408889634f * acc[ai][1][m][n][j]);
                            sg[4 * n + j] = __builtin_amdgcn_rcpf(1.f + ec); rt[4 * n + j] = (1.f + ec) * __builtin_amdgcn_rcpf(1.f + ea); }
                    const size_t off = (size_t)row * D + (u.pn - 14) * 128 + c8;
                    u32x4 w = {cvt_pk_bf16(rt[0], rt[1]), cvt_pk_bf16(rt[2], rt[3]), cvt_pk_bf16(rt[4], rt[5]), cvt_pk_bf16(rt[6], rt[7])}; *(u32x4*)((bf16_t*)(ws + WS_RT) + off) = w;
                    u32x4 w2 = {cvt_pk_bf16(sg[0], sg[1]), cvt_pk_bf16(sg[2], sg[3]), cvt_pk_bf16(sg[4], sg[5]), cvt_pk_bf16(sg[6], sg[7])}; *(u32x4*)((bf16_t*)(ws + WS_SGC) + off) = w2;
                }
            }
    }
};
struct SchedInProj {
    const char* hx; const char* hc; const char* w; int G, c;
    __device__ __forceinline__ bool next(int i, pg8::Unit& u) const {
        constexpr int nM = M / 256, nN = INW / 256, NMAIN = nM * nN, NCTX = (MC / 256) * 2;
        const int L = i * G + c; if (L >= NMAIN + NCTX) return false;
        if (L < NMAIN) { pg8::tile_of(L, nM, nN, u.pm, u.pn); u.a = hx + (size_t)u.pm * 256 * D * 2; u.kind = u.pn < 4 ? 0 : (u.pn == 4 ? 1 : (u.pn == 5 ? 2 : (u.pn < 14 ? 3 : 4))); }
        else { const int j = L - NMAIN; u.pm = j >> 1; u.pn = 4 + (j & 1); u.a = hc + (size_t)u.pm * 256 * D * 2; u.kind = 5 + (j & 1); }
        u.b = w + (size_t)u.pn * 256 * D * 2; u.keep = 0; return true;
    }
};
struct EpiMerge {
    static constexpr bool PERM = true;
    unsigned char* ws;
    __device__ __forceinline__ void operator()(f32x4 (&acc)[2][2][4][2], const pg8::Unit& u, int wr, int wc, int fr, int fq) const {
        const int c8 = u.pn * 256 + wc * 32 + 8 * fq;
        const bf16_t* F = (const bf16_t*)(ws + (u.kind == 0 ? WS_RT : WS_SGC));
#pragma unroll
        for (int ai = 0; ai < 2; ++ai)
#pragma unroll
            for (int m = 0; m < 4; ++m) { const size_t off = (size_t)(u.pm * 256 + ai * 128 + wr * 64 + m * 16 + fr) * D + c8;
#pragma unroll
                for (int bj = 0; bj < 2; ++bj) { const u32x4 f = *(const u32x4*)(F + off + bj * 128);
                    f32x4 v0 = acc[ai][bj][m][0], v1 = acc[ai][bj][m][1];
                    v0[0] *= bf_lo(f[0]); v0[1] *= bf_hi(f[0]); v0[2] *= bf_lo(f[1]); v0[3] *= bf_hi(f[1]); v1[0] *= bf_lo(f[2]); v1[1] *= bf_hi(f[2]); v1[2] *= bf_lo(f[3]); v1[3] *= bf_hi(f[3]);
                    if (u.kind == 0) { acc[ai][bj][m][0] = v0; acc[ai][bj][m][1] = v1; }
                    else { u32x4 w = {cvt_pk_bf16(v0[0], v0[1]), cvt_pk_bf16(v0[2], v0[3]), cvt_pk_bf16(v1[0], v1[1]), cvt_pk_bf16(v1[2], v1[3])}; *(u32x4*)((bf16_t*)(ws + WS_G) + off + bj * 128) = w; } } }
    }
};
struct SchedMerge {
    const char* att; const char* cv; const char* wa; const char* wc; int G, c;
    __device__ __forceinline__ bool next(int i, pg8::Unit& u) const {
        constexpr int nM = M / 256, nN = D / 256;
        const int L = (i >> 1) * G + c, sub = i & 1; if (L >= nM * nN) return false;
        pg8::tile_of(L, nM, nN, u.pm, u.pn);
        u.a = (sub ? cv : att) + (size_t)u.pm * 256 * D * 2; u.b = (sub ? wc : wa) + (size_t)u.pn * 256 * D * 2; u.kind = sub; u.keep = sub ^ 1; return true;
    }
};
struct SchedPlain {
    const char* a; const char* b; int nM, nN, G, c;
    __device__ __forceinline__ bool next(int i, pg8::Unit& u) const {
        const int L = i * G + c; if (L >= nM * nN) return false;
        pg8::tile_of(L, nM, nN, u.pm, u.pn); u.a = a + (size_t)u.pm * 256 * D * 2; u.b = b + (size_t)u.pn * 256 * D * 2; u.kind = 0; u.keep = 0; return true;
    }
};
struct EpiOut {
    static constexpr bool PERM = false;
    const float* x; const float* mod; const float* n2g; float* xs; bf16_t* xg; float* ssq;
    __device__ __forceinline__ void operator()(f32x4 (&acc)[2][2][4][2], const pg8::Unit& u, int wr, int wc, int fr, int fq) const {
        const int col0 = u.pn * 256 + wc * 32 + 4 * fq; const float* mb = mod + ((u.pm * 256) >> 12) * NMOD;
        f32x4 gv[2][2], nv[2][2];
#pragma unroll
        for (int bj = 0; bj < 2; ++bj)
#pragma unroll
            for (int n = 0; n < 2; ++n) { const int c = col0 + bj * 128 + n * 16; gv[bj][n] = *(const f32x4*)(mb + 2 * D + c); nv[bj][n] = *(const f32x4*)(n2g + c) * (*(const f32x4*)(mb + 4 * D + c) + 1.f); }
#pragma unroll
        for (int ai = 0; ai < 2; ++ai)
#pragma unroll
            for (int m = 0; m < 4; ++m) { const int row = u.pm * 256 + ai * 128 + wr * 64 + m * 16 + fr; const size_t off = (size_t)row * D + col0; float ss = 0.f;
#pragma unroll
                for (int bj = 0; bj < 2; ++bj)
#pragma unroll
                    for (int n = 0; n < 2; ++n) { const f32x4 xv = *(const f32x4*)(x + off + bj * 128 + n * 16); const f32x4 v = xv + gv[bj][n] * acc[ai][bj][m][n]; *(f32x4*)(xs + off + bj * 128 + n * 16) = v;
                        ss += (v[0] * v[0] + v[1] * v[1]) + (v[2] * v[2] + v[3] * v[3]); const f32x4 g = v * nv[bj][n];
                        u32x2 w = {cvt_pk_bf16(g[0], g[1]), cvt_pk_bf16(g[2], g[3])}; *(u32x2*)(xg + off + bj * 128 + n * 16) = w; }
                ss += __shfl_xor(ss, 16); ss += __shfl_xor(ss, 32);
                if (fq == 0) ssq[(size_t)row * 16 + u.pn * 4 + wc] = ss; }
    }
};
__device__ __forceinline__ float row_rstd(const float* ssq, int row) {
    const f32x4 a = *(const f32x4*)(ssq + (size_t)row * 16), b = *(const f32x4*)(ssq + (size_t)row * 16 + 4), c = *(const f32x4*)(ssq + (size_t)row * 16 + 8), d = *(const f32x4*)(ssq + (size_t)row * 16 + 12);
    const float s = ((a[0] + a[1]) + (a[2] + a[3])) + ((b[0] + b[1]) + (b[2] + b[3])) + ((c[0] + c[1]) + (c[2] + c[3])) + ((d[0] + d[1]) + (d[2] + d[3]));
    return rsqrtf(s * (1.f / D) + EPS);
}
struct EpiScores {
    static constexpr bool PERM = false;
    float* sc; const float* ssq; const float* sbias;
    __device__ __forceinline__ void operator()(f32x4 (&acc)[2][2][4][2], const pg8::Unit& u, int wr, int wc, int fr, int fq) const {
        const float* sb = sbias + ((u.pm * 256) >> 12) * PW + u.pn * 256 + wc * 32 + 4 * fq;
        f32x4 bv[2][2];
#pragma unroll
        for (int bj = 0; bj < 2; ++bj)
#pragma unroll
            for (int n = 0; n < 2; ++n) bv[bj][n] = *(const f32x4*)(sb + bj * 128 + n * 16);
#pragma unroll
        for (int ai = 0; ai < 2; ++ai)
#pragma unroll
            for (int m = 0; m < 4; ++m) { const int row = u.pm * 256 + ai * 128 + wr * 64 + m * 16 + fr; float* p = sc + (size_t)(row >> 2) * 8192 + (row & 3) * 4; const float rs = row_rstd(ssq, row);
#pragma unroll
                for (int bj = 0; bj < 2; ++bj)
#pragma unroll
                    for (int n = 0; n < 2; ++n) { const int grp = u.pn * 2 + bj, nq = wc * 8 + n * 4 + fq; *(f32x4*)(p + (grp * 32 + nq) * 16) = acc[ai][bj][m][n] * rs + bv[bj][n]; } }
    }
};

__device__ __forceinline__ void phase_attn(const Args& A, unsigned char* lds) {
    const int G = gridDim.x, X = blockIdx.x & 7, j = blockIdx.x >> 3, perx = G >> 3;
    bf16_t* Q = (bf16_t*)(A.ws + WS_Q); const unsigned char* K8 = A.ws + WS_K8; const unsigned char* VT8 = A.ws + WS_VT8;
    const float* cs = (const float*)(A.ws + WS_ROPE); const float* sn = cs + 2048;
    for (int idx = j; idx < 128; idx += perx) {
        const int grp = 2 * X + (idx >> 6), uu = idx & 63, b = grp >> 1, kv = grp & 1, h = kv * 4 + (uu >> 4), qb = uu & 15;
        bf16_t* qp = Q + ((size_t)b * S + qb * 256) * D + h * HD;
        bf16_t* op = A.dry ? (bf16_t*)(A.ws + WS_G) + ((size_t)b * S + qb * 256) * D + h * HD : qp;
        att::attn_unit(qp, K8 + (size_t)b * SKV * 256 + kv * HD, VT8 + (size_t)grp * (SKV / 64) * 8192, op, qb * 256, SKV, A.qng, cs, sn, (char*)lds);
    }
}

__device__ __forceinline__ float gelu_exact(float v) { return 0.5f * v * (1.f + erff(v * 0.70710678118654752f)); }
__device__ __forceinline__ void ins16(float (&t)[16], float v) {
#pragma unroll
    for (int i = 15; i >= 1; --i) t[i] = __builtin_amdgcn_fmed3f(t[i - 1], t[i], v);
    t[0] = fmaxf(t[0], v);
}
__device__ __forceinline__ float key_tag(float v, unsigned keepmask, unsigned tag) { return __uint_as_float((__float_as_uint(v) & keepmask) | tag); }
template <int I, int J> struct CandLoop {
    static __device__ __forceinline__ void run(const float (&a)[16], const float (&b)[16], float (&c)[16]) {
        if constexpr ((I + 1) * (J + 1) <= 16) { ins16(c, key_tag(a[I] + b[J], ~255u, 255u - (unsigned)(I * 16 + J))); CandLoop<I, J + 1>::run(a, b, c); }
        else if constexpr (I + 1 < 16) CandLoop<I + 1, 0>::run(a, b, c);
    }
};
__device__ __forceinline__ void phase_peer(const Args& A, LAS unsigned char* lds) {
    const int lane = threadIdx.x & 63, wave = threadIdx.x >> 6, gw = blockIdx.x * NWAVES + wave, NGW = gridDim.x * NWAVES;
    LAS unsigned char* wl = lds + wave * 9216;
    LAS float* topL = (LAS float*)wl; LAS int* eidA = (LAS int*)(wl + 4096); LAS float* wgtA = (LAS float*)(wl + 6144); LAS float* coefL = (LAS float*)(wl + 8192);
    const float* SC = (const float*)(A.ws + WS_SC); const bf16_t* HX = (const bf16_t*)(A.ws + WS_HX);
    const unsigned char* UT = A.ws + WS_UT; const unsigned char* VT = A.ws + WS_VT; const float* SU = (const float*)(A.ws + WS_UT + WS_TSCALE); const float* SVs = (const float*)(A.ws + WS_VT + WS_TSCALE);
    const float* mod = (const float*)(A.ws + WS_MOD);
    const float NEG = -3.0e38f;
    const int h = lane >> 3, tk = (lane >> 1) & 3, p = lane & 1, grp = 2 * h + p;
    for (int pass = gw; pass < M / 4; pass += NGW) {
        {
            float t[16];
#pragma unroll
            for (int i = 0; i < 16; ++i) t[i] = NEG;
            const float* sp = SC + (size_t)pass * 8192 + (grp * 128 + tk) * 4;
#pragma unroll 4
            for (int i = 0; i < 32; ++i) { const f32x4 v = *(const f32x4*)(sp + i * 16); const unsigned tg = 127u - 4u * (unsigned)i;
                ins16(t, key_tag(v[0], ~127u, tg)); ins16(t, key_tag(v[1], ~127u, tg - 1u)); ins16(t, key_tag(v[2], ~127u, tg - 2u)); ins16(t, key_tag(v[3], ~127u, tg - 3u)); }
            float pb[16];
#pragma unroll
            for (int i = 0; i < 16; ++i) { pb[i] = __shfl_xor(t[i], 1); topL[lane * 16 + i] = t[i]; }
            float c[16];
#pragma unroll
            for (int i = 0; i < 16; ++i) c[i] = NEG;
            CandLoop<0, 0>::run(t, pb, c);
            float e[16]; float es = 0.f;
#pragma unroll
            for (int k = 0; k < 16; ++k) { e[k] = __expf(c[k] - c[0]); es += e[k]; }
            const float inv = __builtin_amdgcn_rcpf(es);
            asm volatile("s_waitcnt lgkmcnt(0)" ::: "memory");
            if (p == 0) {
#pragma unroll
                for (int k = 0; k < 16; ++k) { const unsigned code = 255u - (__float_as_uint(c[k]) & 255u);
                    const unsigned ia = 127u - (__float_as_uint(topL[lane * 16 + (code >> 4)]) & 127u), ib = 127u - (__float_as_uint(topL[(lane + 1) * 16 + (code & 15u)]) & 127u);
                    eidA[tk * 128 + h * 16 + k] = (int)(ia * 128u + ib); wgtA[tk * 128 + h * 16 + k] = e[k] * inv; }
            }
            asm volatile("s_waitcnt lgkmcnt(0)" ::: "memory");
        }
#pragma unroll 1
        for (int tq = 0; tq < 4; ++tq) {
            const int t = pass * 4 + tq; const LAS int* eidL = eidA + tq * 128; const LAS float* wgtL = wgtA + tq * 128;
            f32x2 x2[8];
            { const u32x4 x0 = *(const u32x4*)(HX + (size_t)t * D + lane * 16), x1 = *(const u32x4*)(HX + (size_t)t * D + lane * 16 + 8);
              const float rs = row_rstd((const float*)(A.ws + WS_SSQ), t); const float* sh = mod + (t >> 12) * NMOD + 3 * D + lane * 16;
              const f32x4 s0 = *(const f32x4*)sh, s1 = *(const f32x4*)(sh + 4), s2 = *(const f32x4*)(sh + 8), s3 = *(const f32x4*)(sh + 12);
              x2[0] = (f32x2){bf_lo(x0[0]) * rs + s0[0], bf_hi(x0[0]) * rs + s0[1]}; x2[1] = (f32x2){bf_lo(x0[1]) * rs + s0[2], bf_hi(x0[1]) * rs + s0[3]};
              x2[2] = (f32x2){bf_lo(x0[2]) * rs + s1[0], bf_hi(x0[2]) * rs + s1[1]}; x2[3] = (f32x2){bf_lo(x0[3]) * rs + s1[2], bf_hi(x0[3]) * rs + s1[3]};
              x2[4] = (f32x2){bf_lo(x1[0]) * rs + s2[0], bf_hi(x1[0]) * rs + s2[1]}; x2[5] = (f32x2){bf_lo(x1[1]) * rs + s2[2], bf_hi(x1[1]) * rs + s2[3]};
              x2[6] = (f32x2){bf_lo(x1[2]) * rs + s3[0], bf_hi(x1[2]) * rs + s3[1]}; x2[7] = (f32x2){bf_lo(x1[3]) * rs + s3[2], bf_hi(x1[3]) * rs + s3[3]}; }
            u32x4 bufA[8], bufB[8];
#define LOAD8(buf, TB, hb) do { _Pragma("unroll") for (int e = 0; e < 8; ++e) { const int id = eidL[(hb) * 8 + e]; buf[e] = *(const u32x4*)((TB) + (size_t)id * D + lane * 16); } } while (0)
#define DOT8(buf, off) do { _Pragma("unroll") for (int e = 0; e < 8; ++e) { f32x2 s2 = {0.f, 0.f}; \
                _Pragma("unroll") for (int j = 0; j < 4; ++j) { const int aj = (int)buf[e][j]; s2 += __builtin_amdgcn_cvt_pk_f32_fp8(aj, false) * x2[2 * j]; s2 += __builtin_amdgcn_cvt_pk_f32_fp8(aj, true) * x2[2 * j + 1]; } \
                pp[(off) + e] = s2[0] + s2[1]; } } while (0)
#define REDUCE16(kb) do { const int ke = (kb) * 16 + ((lane >> 2) & 15); const int myid = eidL[ke]; const float su = SU[myid], sv = SVs[myid]; \
            _Pragma("unroll") for (int e = 0; e < 8; ++e) { const bool up = lane & 32; const float keep = up ? pp[e + 8] : pp[e], send = up ? pp[e] : pp[e + 8]; pp[e] = keep + __shfl_xor(send, 32); } \
            _Pragma("unroll") for (int e = 0; e < 4; ++e) { const bool up = lane & 16; const float keep = up ? pp[e + 4] : pp[e], send = up ? pp[e] : pp[e + 4]; pp[e] = keep + __shfl_xor(send, 16); } \
            _Pragma("unroll") for (int e = 0; e < 2; ++e) { const bool up = lane & 8; const float keep = up ? pp[e + 2] : pp[e], send = up ? pp[e] : pp[e + 2]; pp[e] = keep + __shfl_xor(send, 8); } \
            { const bool up = lane & 4; const float keep = up ? pp[1] : pp[0], send = up ? pp[0] : pp[1]; pp[0] = keep + __shfl_xor(send, 4); } \
            float hsum = pp[0]; hsum += __shfl_xor(hsum, 2); hsum += __shfl_xor(hsum, 1); \
            const float cf = wgtL[ke] * gelu_exact(hsum * su) * sv; if ((lane & 3) == 0) coefL[ke] = cf; } while (0)
            LOAD8(bufA, UT, 0);
#pragma unroll 1
            for (int kb = 0; kb < 8; ++kb) {
                float pp[16];
                LOAD8(bufB, UT, 2 * kb + 1);
                DOT8(bufA, 0);
                if (kb < 7) LOAD8(bufA, UT, 2 * kb + 2); else LOAD8(bufA, VT, 0);
                DOT8(bufB, 8);
                REDUCE16(kb);
            }
            asm volatile("s_waitcnt lgkmcnt(0)" ::: "memory");
            f32x2 y2[8];
#pragma unroll
            for (int j = 0; j < 8; ++j) y2[j] = (f32x2){0.f, 0.f};
#define VACC8(buf, hb) do { _Pragma("unroll") for (int e = 0; e < 8; ++e) { const float cf = coefL[(hb) * 8 + e]; const f32x2 cf2 = {cf, cf}; \
                _Pragma("unroll") for (int j = 0; j < 4; ++j) { const int aj = (int)buf[e][j]; y2[2 * j] += cf2 * __builtin_amdgcn_cvt_pk_f32_fp8(aj, false); y2[2 * j + 1] += cf2 * __builtin_amdgcn_cvt_pk_f32_fp8(aj, true); } } } while (0)
#pragma unroll 1
            for (int kb = 0; kb < 8; ++kb) {
                LOAD8(bufB, VT, 2 * kb + 1);
                VACC8(bufA, 2 * kb);
                if (kb < 7) LOAD8(bufA, VT, 2 * kb + 2);
                VACC8(bufB, 2 * kb + 1);
            }
#undef LOAD8
#undef DOT8
#undef REDUCE16
#undef VACC8
            const float* g2 = mod + (t >> 12) * NMOD + 5 * D; float* orow = A.out + (size_t)t * D;
            float z[16]; float ss = 0.f;
#pragma unroll
            for (int q = 0; q < 4; ++q) { const int k = lane * 16 + q * 4; const f32x4 xv = *(const f32x4*)(orow + k), gv = *(const f32x4*)(g2 + k);
                const float yy[4] = {y2[2 * q][0], y2[2 * q][1], y2[2 * q + 1][0], y2[2 * q + 1][1]};
#pragma unroll
                for (int j = 0; j < 4; ++j) { const float zz = xv[j] + gv[j] * yy[j]; z[q * 4 + j] = zz; ss += zz * zz; } }
            const float r = rsqrtf(wave_sum(ss) * (1.f / D) + EPS);
#pragma unroll
            for (int q = 0; q < 4; ++q) { const int k = lane * 16 + q * 4; const f32x4 fv = *(const f32x4*)(A.fg + k);
                f32x4 o;
#pragma unroll
                for (int j = 0; j < 4; ++j) o[j] = z[q * 4 + j] * r * fv[j];
                if (!A.dry || r < 0.f) *(f32x4*)(orow + k) = o; }
        }
    }
}
#define XB_TMO      128
#define XB_XCNT(j)  (256  + 64 * (j))
#define XB_XSUB(j)  (1280 + 64 * (j))
#define XB_XGEN(j)  (2304 + 64 * (j))
#define XB_TOP      3328
#define XB_TOPGEN   3392
#define XCD_BAR_WORDS 3456
#define XB_SPIN_CAP (1u << 22)
__device__ __forceinline__ unsigned xb_ld(unsigned* p)              { return __hip_atomic_load(p, __ATOMIC_RELAXED, __HIP_MEMORY_SCOPE_AGENT); }
__device__ __forceinline__ unsigned xb_add(unsigned* p, unsigned v) { return __hip_atomic_fetch_add(p, v, __ATOMIC_RELAXED, __HIP_MEMORY_SCOPE_AGENT); }
__device__ __forceinline__ unsigned xb_xcc_id() { return (unsigned)__builtin_amdgcn_s_getreg((3 << 11) | 20) & 0xFu; }
#define XB_SPIN(cond, bar) do { unsigned _sp = 0; while (cond) { __builtin_amdgcn_s_sleep(1); \
    if ((++_sp & 255u) == 0u) { if (xb_ld(&(bar)[XB_TMO])) break; if (_sp > XB_SPIN_CAP) { atomicAdd(&(bar)[XB_TMO], 1u); break; } } } } while (0)
struct XcdBarrier { unsigned* bar; unsigned x; volatile LAS unsigned* st; };
__device__ __forceinline__ XcdBarrier xcd_barrier_post(unsigned* bar, volatile LAS unsigned* st) {
    XcdBarrier b; b.bar = bar; b.x = xb_xcc_id(); b.st = st;
    if (threadIdx.x == 0) (void)xb_add(&bar[XB_XCNT(b.x)], 1u);
    return b;
}
__device__ __forceinline__ void xcd_barrier_complete(unsigned* bar, unsigned x, unsigned& nloc, unsigned& nx) {
    const unsigned G = gridDim.x * gridDim.y * gridDim.z;
    unsigned sum, cnt, mine, sp = 0u;
    for (;;) {
        sum = 0u; cnt = 0u; mine = 0u;
#pragma unroll
        for (unsigned j = 0; j < 16; ++j) { const unsigned c = xb_ld(&bar[XB_XCNT(j)]); sum += c; cnt += (c > 0u) ? 1u : 0u; mine = (j == x) ? c : mine; }
        if (sum == G) break;
        __builtin_amdgcn_s_sleep(1);
        if ((++sp & 255u) == 0u) { if (xb_ld(&bar[XB_TMO])) break; if (sp > XB_SPIN_CAP) { atomicAdd(&bar[XB_TMO], 1u); break; } }
    }
    nloc = mine > 0u ? mine : 1u; nx = cnt > 0u ? cnt : 1u;
}
__device__ __forceinline__ void xcd_barrier(const XcdBarrier& b) {
    asm volatile("s_waitcnt vmcnt(0)" ::: "memory");
    __syncthreads();
    if (threadIdx.x == 0) {
        unsigned* bar = b.bar;
        __builtin_amdgcn_s_waitcnt(0);
        unsigned nloc = b.st[0], nx = b.st[1];
        if (nloc == 0u) { xcd_barrier_complete(bar, b.x, nloc, nx); b.st[0] = nloc; b.st[1] = nx; }
        const unsigned old = xb_add(&bar[XB_XSUB(b.x)], 1u);
        const unsigned gen = old / nloc;
        if (old + 1u == (gen + 1u) * nloc) {
            __builtin_amdgcn_fence(__ATOMIC_RELEASE, "agent");
            asm volatile("s_waitcnt vmcnt(0)" ::: "memory");
            const unsigned og = xb_add(&bar[XB_TOP], 1u);
            const unsigned tg = og / nx;
            if (og + 1u == (tg + 1u) * nx) xb_add(&bar[XB_TOPGEN], 1u);
            else XB_SPIN(xb_ld(&bar[XB_TOPGEN]) == tg, bar);
            __builtin_amdgcn_fence(__ATOMIC_ACQUIRE, "agent");
            xb_add(&bar[XB_XGEN(b.x)], 1u);
            asm volatile("s_waitcnt vmcnt(0)" ::: "memory");
        } else {
            XB_SPIN(xb_ld(&bar[XB_XGEN(b.x)]) == gen, bar);
            __builtin_amdgcn_fence(__ATOMIC_ACQUIRE, "agent");
            asm volatile("s_waitcnt vmcnt(0)" ::: "memory");
        }
    }
    __syncthreads();
}
constexpr int MISC_OFF = 135168;

constexpr int N_PHASES = 9;
__global__ void __launch_bounds__(NWAVES * 64, 2) mega_fwd(Args A) {
    extern __shared__ __attribute__((aligned(16))) unsigned char lds[];
    LAS unsigned char* L = (LAS unsigned char*)lds;
    cg::grid_group grid = cg::this_grid();
    const int lo = A.ph_lo, hi = A.ph_hi, G = gridDim.x, c = blockIdx.x;
#ifndef PH_MASK
#define PH_MASK 0x1FF
#endif
#define IN(k) (((PH_MASK >> (k)) & 1) && lo <= (k) && (k) < hi)
    unsigned* barw = (unsigned*)(A.ws + WS_CTL);
    volatile LAS unsigned* MISC = (volatile LAS unsigned*)(L + MISC_OFF);
    if (threadIdx.x < 2) MISC[threadIdx.x] = 0u;
    if (lo == 0 && hi > 1 && blockIdx.x == 0) for (int i = threadIdx.x; i < XCD_BAR_WORDS; i += NWAVES * 64) barw[i] = 0u;
    XcdBarrier xb; xb.bar = barw; xb.x = 0; xb.st = MISC;
#define SEAM(k) do { if (IN(k) && IN((k) + 1)) { if ((k) == 0) { grid.sync(); xb = xcd_barrier_post(barw, MISC); } else xcd_barrier(xb); } } while (0)
    if (IN(0)) phase_prologue(A, L);
    SEAM(0);
    if (IN(1)) phase_hx(A);
    SEAM(1);
    if (IN(2)) { SchedInProj Sd{(const char*)(A.ws + WS_HX), (const char*)(A.ws + WS_HC), (const char*)(A.ws + WS_WIN), G, c}; EpiInProj E{A.ws};
        pg8::gemm_phase<EpiInProj, SchedInProj, true>(L, D, Sd, E); }
    SEAM(2);
    if (IN(3)) { phase_kfix(A); phase_vt(A, L); __syncthreads(); phase_conv(A, L); }
    SEAM(3);
    if (IN(4)) phase_attn(A, lds);
    SEAM(4);
    if (IN(5)) { SchedMerge Sd{(const char*)(A.ws + WS_Q), (const char*)(A.ws + WS_HX), (const char*)(A.ws + WS_WA), (const char*)(A.ws + WS_WC), G, c}; EpiMerge E{A.ws};
        pg8::gemm_phase<EpiMerge, SchedMerge, true>(L, D, Sd, E); }
    SEAM(5);
    if (IN(6)) { SchedPlain Sd{(const char*)(A.ws + WS_G), (const char*)(A.ws + WS_WO), M / 256, D / 256, G, c};
        EpiOut E{A.x, (const float*)(A.ws + WS_MOD), A.n2g, A.out, (bf16_t*)(A.ws + WS_HX), (float*)(A.ws + WS_SSQ)};
        pg8::gemm_phase<EpiOut, SchedPlain, true>(L, D, Sd, E); }
    SEAM(6);
    if (IN(7)) { SchedPlain Sd{(const char*)(A.ws + WS_HX), (const char*)(A.ws + WS_WP), M / 256, PW / 256, G, c};
        EpiScores E{(float*)(A.ws + WS_SC), (const float*)(A.ws + WS_SSQ), (const float*)(A.ws + WS_SBIAS)};
        pg8::gemm_phase<EpiScores, SchedPlain, true>(L, D, Sd, E); }
    SEAM(7);
    if (IN(8)) phase_peer(A, L);
#undef IN
#undef SEAM
}

#ifndef MK_ONE_LAUNCH
#define MK_ONE_LAUNCH 1
#endif
extern "C" void kernel_launch(void* const* d_in, const int* in_sizes, int n_in, void* d_out, int out_size, void* d_ws, size_t ws_size, hipStream_t stream) {
    static int grid = 0;
    if (grid == 0) {
        if (n_in != 23 || out_size != M * D || ws_size < WS_END) { fprintf(stderr, "kernel_launch: unexpected shapes (n_in %d out %d ws %zu)\n", n_in, out_size, ws_size); grid = -1; return; }
        int dev = 0, cus = 0, per_cu = 0;
        hipGetDevice(&dev); hipDeviceGetAttribute(&cus, hipDeviceAttributeMultiprocessorCount, dev);
        if (hipFuncSetAttribute((const void*)mega_fwd, hipFuncAttributeMaxDynamicSharedMemorySize, LDS_BYTES) != hipSuccess) { fprintf(stderr, "kernel_launch: hipFuncSetAttribute failed\n"); grid = -1; return; }
        if (hipOccupancyMaxActiveBlocksPerMultiprocessor(&per_cu, (const void*)mega_fwd, NWAVES * 64, LDS_BYTES) != hipSuccess || per_cu < 1) { fprintf(stderr, "kernel_launch: occupancy query says %d\n", per_cu); per_cu = 1; }
        (void)hipGetLastError();
        grid = cus * 1;
        if (per_cu < 1) grid = -1;
    }
    if (grid < 0) return;
    Args a{};
    const float** f = (const float**)&a;
    for (int i = 0; i < 23; ++i) f[i] = (const float*)d_in[i];
    a.out = (float*)d_out; a.ws = (unsigned char*)d_ws;
#if MK_ONE_LAUNCH
    a.ph_lo = 0; a.ph_hi = N_PHASES;
    void* args[] = {&a};
    hipError_t e = hipLaunchCooperativeKernel((const void*)mega_fwd, dim3(grid), dim3(NWAVES * 64), args, LDS_BYTES, stream);
    if (e != hipSuccess) fprintf(stderr, "cooperative launch failed: %s (grid %d)\n", hipGetErrorString(e), grid);
#else
#ifndef REPEAT_PH
#define REPEAT_PH -1
#endif
    for (int p = 0; p < N_PHASES; ++p) { a.ph_lo = p; a.ph_hi = p + 1;
        if (p == REPEAT_PH) { a.dry = 1; hipLaunchKernelGGL(mega_fwd, dim3(grid), dim3(NWAVES * 64), LDS_BYTES, stream, a); a.dry = 0; }
        hipLaunchKernelGGL(mega_fwd, dim3(grid), dim3(NWAVES * 64), LDS_BYTES, stream, a); }
#endif
}
```

```cpp
#include <hip/hip_runtime.h>
#include <hip/hip_cooperative_groups.h>
#include <cstdio>
#include <cstdint>
namespace cg = cooperative_groups;

#define LAS __attribute__((address_space(3)))
typedef unsigned short bf16_t;
typedef short bf16x8 __attribute__((ext_vector_type(8)));
typedef short s16x4 __attribute__((ext_vector_type(4)));
typedef float f32x2 __attribute__((ext_vector_type(2)));
typedef float f32x4 __attribute__((ext_vector_type(4)));
typedef float f32x16 __attribute__((ext_vector_type(16)));
typedef unsigned u32x2 __attribute__((ext_vector_type(2)));
typedef unsigned u32x4 __attribute__((ext_vector_type(4)));
typedef __bf16 bf16x2_t __attribute__((ext_vector_type(2)));

constexpr int D = 1024, NB = 8, S = 4096, CTXL = 256, SKV = S + CTXL, HD = 128, HQ = 8, HKV = 2;
constexpr int M = NB * S;
constexpr int MC = NB * CTXL;
constexpr int INW = 5632, NMOD = 6144, NEXP = 16384, PW = 2048;
constexpr float EPS = 1e-6f;

__device__ __forceinline__ unsigned cvt_pk_bf16(float lo, float hi) { f32x2 v = {lo, hi}; bf16x2_t b = __builtin_convertvector(v, bf16x2_t); return __builtin_bit_cast(unsigned, b); }
__device__ __forceinline__ float bf_lo(unsigned u) { return __uint_as_float(u << 16); }
__device__ __forceinline__ float bf_hi(unsigned u) { return __uint_as_float(u & 0xffff0000u); }
__device__ __forceinline__ float fast_sigmoid(float x) { return __builtin_amdgcn_rcpf(1.f + __builtin_amdgcn_exp2f(-1.4426950408889634f * x)); }
__device__ __forceinline__ float wave_sum(float v) {
#pragma unroll
    for (int o = 1; o < 64; o <<= 1) v += __shfl_xor(v, o);
    return v;
}

namespace pg8 {
constexpr int BM = 256, BK = 64, HALF = 128, HTB = HALF * BK * 2  , STAGE_BYTES = 8 * HTB, NXCD = 8, WGM = 8;
__host__ __device__ __forceinline__ int lds_byte(int r, int c) { const int st = (r >> 4) * 2 + (c >> 5), rr = r & 15, cc = c & 31, ob = rr * 64 + cc * 2; return st * 1024 + (ob ^ (((ob >> 9) & 1) << 5)); }
__host__ __device__ __forceinline__ void stage_rc(int b, int& R, int& C) { const int st = b / 1024, sb = b % 1024, swz = sb ^ (((sb >> 9) & 1) << 5); R = (st >> 1) * 16 + swz / 64; C = (st & 1) * 32 + (swz % 64) / 2; }
__host__ __device__ __forceinline__ int perm32(int rho) { const int n = rho >> 4, i = rho & 15; return 8 * (i >> 2) + 4 * n + (i & 3); }

struct Unit { const char* a; const char* b; int pm, pn, kind, keep; };

__device__ __forceinline__ void tile_of(int L, int nM, int nN, int& pm, int& pn) {
    const int nwg = nM * nN; int wgid = L;
    { const int q = nwg / NXCD, r = nwg % NXCD, xcd = wgid % NXCD, off = wgid / NXCD; wgid = (xcd < r ? xcd * (q + 1) : r * (q + 1) + (xcd - r) * q) + off; }
    const int nig = WGM * nN, gid = wgid / nig, fm = gid * WGM, gsz = (nM - fm) < WGM ? (nM - fm) : WGM;
    pm = fm + ((wgid % nig) % gsz); pn = (wgid % nig) / gsz;
}

template <class Epi, class Sched, bool ALIGN_EPI>
__device__ __forceinline__ void gemm_phase(LAS unsigned char* lds, const int K, const Sched& S, const Epi& E) {
    const int tid = threadIdx.x, wid = __builtin_amdgcn_readfirstlane(tid >> 6), lane = tid & 63, wr = wid >> 2, wc = wid & 3, fr = lane & 15, fq = lane >> 4;
    const int nt = K / BK;
    unsigned voffA[2], voffB[2];
#pragma unroll
    for (int i = 0; i < 2; ++i) { int R, C; stage_rc(tid * 16 + i * 8192, R, C); const int Rb = Epi::PERM ? ((R & ~31) + perm32(R & 31)) : R;
        voffA[i] = (unsigned)(R * K + C) * 2u; voffB[i] = (unsigned)(Rb * K + C) * 2u; }
    const size_t kstep = (size_t)(BK * 2);
    const size_t hstep = (size_t)HALF * K * 2;
    const unsigned ldsw = (unsigned)wid * 1024u;
    const int aoff = lds_byte(wr * 64 + fr, fq * 8), boff = lds_byte(wc * 32 + fr, fq * 8);
#define PG8_SA(b, h) (((b) * 2 + (h)) * HTB)
#define PG8_SB(b, h) ((4 + (b) * 2 + (h)) * HTB)
#define PG8_STAGE(bufoff, gbase, voff) do { _Pragma("unroll") for (int _i = 0; _i < 2; ++_i) \
        __builtin_amdgcn_global_load_lds((const unsigned*)((const char*)(gbase) + (voff)[_i]), (LAS unsigned*)(lds + (bufoff) + ldsw + _i * 8192), 16, 0, 0); } while (0)
#define PG8_LDA(dst, b, h) do { _Pragma("unroll") for (int m = 0; m < 4; ++m) _Pragma("unroll") for (int k = 0; k < 2; ++k) dst[m][k] = *(const LAS bf16x8*)(lds + PG8_SA(b, h) + aoff + m * 2048 + k * 1024); } while (0)
#define PG8_LDB(dst, b, h) do { _Pragma("unroll") for (int n = 0; n < 2; ++n) _Pragma("unroll") for (int k = 0; k < 2; ++k) dst[n][k] = *(const LAS bf16x8*)(lds + PG8_SB(b, h) + boff + n * 2048 + k * 1024); } while (0)
#define PG8_MMA(ai, bj, At, Bt) do { __builtin_amdgcn_s_setprio(1); _Pragma("unroll") for (int m = 0; m < 4; ++m) _Pragma("unroll") for (int n = 0; n < 2; ++n) _Pragma("unroll") for (int k = 0; k < 2; ++k) \
        acc[ai][bj][m][n] = __builtin_amdgcn_mfma_f32_16x16x32_bf16(Bt[n][k], At[m][k], acc[ai][bj][m][n], 0, 0, 0); __builtin_amdgcn_s_setprio(0); } while (0)
#define PG8_WAIT_V(n) asm volatile("s_waitcnt vmcnt(" #n ")" ::: "memory")
#define PG8_WAIT_L(n) asm volatile("s_waitcnt lgkmcnt(" #n ")" ::: "memory")
#define PG8_BAR __builtin_amdgcn_s_barrier()
#define PG8_SCHED __builtin_amdgcn_sched_barrier(0)
    Unit cur, nxt; int ui = 0;
    if (!S.next(0, cur)) return;
    f32x4 acc[2][2][4][2];
#pragma unroll
    for (int a = 0; a < 2; ++a)
#pragma unroll
        for (int b = 0; b < 2; ++b)
#pragma unroll
            for (int m = 0; m < 4; ++m)
#pragma unroll
                for (int n = 0; n < 2; ++n) acc[a][b][m][n] = (f32x4){0.f, 0.f, 0.f, 0.f};
    bf16x8 At[4][2], B0[2][2], B1[2][2];
    const char* cA = cur.a; const char* cB = cur.b;
    PG8_STAGE(PG8_SB(0, 0), cB, voffB); PG8_STAGE(PG8_SB(0, 1), cB + hstep, voffB); PG8_STAGE(PG8_SA(0, 0), cA, voffA); PG8_STAGE(PG8_SA(0, 1), cA + hstep, voffA);
    if (wr == 1) PG8_BAR;
    PG8_WAIT_V(2); PG8_BAR;
    PG8_STAGE(PG8_SB(1, 0), cB + kstep, voffB); PG8_STAGE(PG8_SA(1, 0), cA + kstep, voffA); PG8_STAGE(PG8_SB(1, 1), cB + hstep + kstep, voffB);
    PG8_WAIT_V(6); PG8_BAR;
    for (;;) {
        const bool has_next = S.next(ui + 1, nxt);
        const char* nA = has_next ? nxt.a : cA; const char* nB = has_next ? nxt.b : cB;
        for (int t = 0; t < nt; t += 2) {
            const bool last = (t == nt - 2);
            const char* a1 = cA + (size_t)(t + 1) * kstep;
            const char* a2 = last ? nA : cA + (size_t)(t + 2) * kstep; const char* b2 = last ? nB : cB + (size_t)(t + 2) * kstep;
            const char* a3 = a2 + kstep; const char* b3 = b2 + kstep;
            PG8_LDB(B0, 0, 0); PG8_LDB(B1, 0, 1); PG8_SCHED; PG8_LDA(At, 0, 0); PG8_STAGE(PG8_SA(1, 1), a1 + hstep, voffA);
            PG8_WAIT_V(8); PG8_WAIT_L(0); PG8_BAR; PG8_MMA(0, 0, At, B0); PG8_MMA(0, 1, At, B1); PG8_BAR; PG8_SCHED;
            PG8_LDA(At, 0, 1); PG8_STAGE(PG8_SB(0, 0), b2, voffB); PG8_STAGE(PG8_SB(0, 1), b2 + hstep, voffB); PG8_STAGE(PG8_SA(0, 0), a2, voffA);
            PG8_WAIT_V(8); PG8_WAIT_L(0); PG8_BAR; PG8_MMA(1, 0, At, B0); PG8_MMA(1, 1, At, B1); PG8_BAR; PG8_SCHED;
            PG8_LDB(B0, 1, 0); PG8_LDB(B1, 1, 1); PG8_SCHED; PG8_LDA(At, 1, 0); PG8_STAGE(PG8_SA(0, 1), a2 + hstep, voffA);
            PG8_WAIT_V(8); PG8_WAIT_L(0); PG8_BAR; PG8_MMA(0, 0, At, B0); PG8_MMA(0, 1, At, B1); PG8_BAR; PG8_SCHED;
            PG8_LDA(At, 1, 1); PG8_STAGE(PG8_SB(1, 0), b3, voffB); PG8_STAGE(PG8_SB(1, 1), b3 + hstep, voffB); PG8_STAGE(PG8_SA(1, 0), a3, voffA);
            PG8_WAIT_V(8); PG8_WAIT_L(0); PG8_BAR; PG8_MMA(1, 0, At, B0); PG8_MMA(1, 1, At, B1); PG8_BAR; PG8_SCHED;
        }
        if constexpr (ALIGN_EPI) { if (wr == 0) PG8_BAR; }
        E(acc, cur, wr, wc, fr, fq);
        if (!has_next) break;
        if (!cur.keep) {
#pragma unroll
        for (int a = 0; a < 2; ++a)
#pragma unroll
            for (int b = 0; b < 2; ++b)
#pragma unroll
                for (int m = 0; m < 4; ++m)
#pragma unroll
                    for (int n = 0; n < 2; ++n) acc[a][b][m][n] = (f32x4){0.f, 0.f, 0.f, 0.f};
        }
        cur = nxt; cA = nA; cB = nB; ++ui;
        if constexpr (ALIGN_EPI) { if (wr == 1) PG8_BAR; }
    }
    PG8_WAIT_V(0);
    if constexpr (!ALIGN_EPI) { if (wr == 0) PG8_BAR; }
    PG8_BAR;
#undef PG8_SA
#undef PG8_SB
#undef PG8_STAGE
#undef PG8_LDA
#undef PG8_LDB
#undef PG8_MMA
#undef PG8_WAIT_V
#undef PG8_WAIT_L
#undef PG8_BAR
#undef PG8_SCHED
}
}
namespace att {
typedef int v8i __attribute__((ext_vector_type(8)));
constexpr int NW = 8, QBLK = 32, KVBLK = 64;
constexpr float SCALE = 0.088388347648318440f;
constexpr float SC8 = SCALE / 256.f;
constexpr float THR = 3.f;
constexpr int LDQ = D, LDO = D;
constexpr int SHM_V = 8192, SHM_K = 8192, OFF_K = 2 * SHM_V, OFF_WS = OFF_K + 2 * SHM_K, OST_OFF = OFF_WS + NW * 64 * 4, LDS_TOTAL = OST_OFF + NW * 8192;
#define SBAR() __builtin_amdgcn_sched_barrier(0)
#define MFMA8(a, b, c) __builtin_amdgcn_mfma_scale_f32_32x32x64_f8f6f4((a), (b), (c), 0, 0, 0, 0x7f7f7f7f, 0, 0x7f7f7f7f)
__device__ __forceinline__ int crow(int r, int hi) { return (r & 3) + 8 * (r >> 2) + 4 * hi; }
__device__ __forceinline__ int k_lds(int row, int chunk) { return row * 128 + ((chunk ^ ((row >> 1) & 7)) << 4); }
__device__ __forceinline__ int v_lds(int d, int slot) { return d * 64 + ((slot ^ ((d >> 2) & 3)) << 4); }
__device__ __forceinline__ int pk4_fp8(float a, float b, float c, float d) { int w = __builtin_amdgcn_cvt_pk_fp8_f32(a, b, 0, false); return __builtin_amdgcn_cvt_pk_fp8_f32(c, d, w, true); }

__device__ __forceinline__ void partialSM(f32x16& p0, f32x16& p1, float& m_reg, float& mn, float& alpha) {
  constexpr float C = SC8 * 1.4426950408889634f;
  float pmax = p0[0]; for (int r = 1; r < 16; ++r) pmax = fmaxf(pmax, p0[r]); for (int r = 0; r < 16; ++r) pmax = fmaxf(pmax, p1[r]);
  { auto rr = __builtin_amdgcn_permlane32_swap(__float_as_uint(pmax), __float_as_uint(pmax), false, false);
    pmax = fmaxf(__uint_as_float(rr[0]), __uint_as_float(rr[1])); }
  if (__builtin_expect(__all(pmax - m_reg <= THR / SC8), 1)) { mn = m_reg; alpha = 1.f; }
  else { mn = fmaxf(m_reg, pmax); alpha = __builtin_amdgcn_exp2f((m_reg - mn) * C); m_reg = mn; }
  float mnC = 4.f - mn * C;
  for (int r = 0; r < 16; ++r) p0[r] = fmaf(p0[r], C, mnC); for (int r = 0; r < 16; ++r) p1[r] = fmaf(p1[r], C, mnC);
  for (int r = 0; r < 16; ++r) p0[r] = __builtin_amdgcn_exp2f(p0[r]);
}
__device__ __forceinline__ void finishSM(f32x16& p0, f32x16& p1, float alpha, float& l_reg, v8i& pa) {
  for (int r = 0; r < 16; ++r) p1[r] = __builtin_amdgcn_exp2f(p1[r]);
  float ps = 0; for (int r = 0; r < 16; ++r) ps += p0[r]; for (int r = 0; r < 16; ++r) ps += p1[r];
  { auto rr = __builtin_amdgcn_permlane32_swap(__float_as_uint(ps), __float_as_uint(ps), false, false);
    ps = __uint_as_float(rr[0]) + __uint_as_float(rr[1]); }
  l_reg = l_reg * alpha + ps;
  pa[0] = pk4_fp8(p0[0], p0[1], p0[2], p0[3]); pa[1] = pk4_fp8(p0[4], p0[5], p0[6], p0[7]); pa[2] = pk4_fp8(p0[8], p0[9], p0[10], p0[11]); pa[3] = pk4_fp8(p0[12], p0[13], p0[14], p0[15]);
  pa[4] = pk4_fp8(p1[0], p1[1], p1[2], p1[3]); pa[5] = pk4_fp8(p1[4], p1[5], p1[6], p1[7]); pa[6] = pk4_fp8(p1[8], p1[9], p1[10], p1[11]); pa[7] = pk4_fp8(p1[12], p1[13], p1[14], p1[15]);
}
__device__ __forceinline__ v8i ld32(const char* p0, const char* p1) { const u32x4 a = *reinterpret_cast<const u32x4*>(p0), b = *reinterpret_cast<const u32x4*>(p1);
  v8i r; r[0] = (int)a[0]; r[1] = (int)a[1]; r[2] = (int)a[2]; r[3] = (int)a[3]; r[4] = (int)b[0]; r[5] = (int)b[1]; r[6] = (int)b[2]; r[7] = (int)b[3]; return r; }
__device__ __forceinline__ void qkt(f32x16& p0, f32x16& p1, const char* Ks, const v8i* qf, int r32, int hi) {
  p0 = f32x16{}; p1 = f32x16{};
#pragma unroll
  for (int s = 0; s < 2; ++s) {
    const v8i a0 = ld32(Ks + k_lds(r32, 4 * s + hi), Ks + k_lds(r32, 4 * s + 2 + hi)), a1 = ld32(Ks + k_lds(32 + r32, 4 * s + hi), Ks + k_lds(32 + r32, 4 * s + 2 + hi));
    p0 = MFMA8(a0, qf[s], p0); p1 = MFMA8(a1, qf[s], p1); }
}
__device__ __forceinline__ void pv(f32x16* o, const char* Vs, const v8i pa, int r32, int hi) {
#pragma unroll
  for (int d0 = 0; d0 < 4; ++d0) { const int d = 32 * d0 + r32; const v8i b = ld32(Vs + v_lds(d, 2 * hi), Vs + v_lds(d, 2 * hi + 1)); o[d0] = MFMA8(pa, b, o[d0]); }
}

__device__ __forceinline__ void attn_unit(const bf16_t* Qb, const unsigned char* __restrict__ K8, const unsigned char* __restrict__ VT, bf16_t* Ob, int t0, int seq,
                                          const float* __restrict__ qng, const float* __restrict__ cst, const float* __restrict__ snt, char* lds) {
  int tid_ = threadIdx.x; asm volatile("" : "+v"(tid_));
  const int tid = tid_, wid = tid >> 6, lane = tid & 63, r32 = lane & 31, hi = lane >> 5;
  char* V_lds = lds; char* K_lds = lds + OFF_K;
  float* ws = (float*)(lds + OFF_WS) + wid * 64; float* li_l = ws; float* al_l = ws + 32;
  float m_reg = -1e30f, l_reg = 0; f32x16 o[4] = {}; v8i qf[2];
  {
    const bf16_t* Qw = Qb + (long)(wid * QBLK + r32) * LDQ + 16 * hi;
    float y[2][32]; float ss = 0.f;
#pragma unroll
    for (int s = 0; s < 2; ++s)
#pragma unroll
      for (int part = 0; part < 2; ++part)
#pragma unroll
        for (int c = 0; c < 2; ++c) { const u32x4 w = *reinterpret_cast<const u32x4*>(Qw + 64 * s + 32 * part + 8 * c);
#pragma unroll
          for (int j = 0; j < 4; ++j) { const float a = bf_lo(w[j]), b = bf_hi(w[j]); y[s][16 * part + 8 * c + 2 * j] = a; y[s][16 * part + 8 * c + 2 * j + 1] = b; ss += a * a + b * b; } }
    ss += __shfl_xor(ss, 32);
    const float rstd = rsqrtf(ss * (1.f / HD) + EPS) * 16.f;
    const int t = t0 + wid * QBLK + r32;
#pragma unroll
    for (int s = 0; s < 2; ++s) { const int pos = s == 0 ? (t >> 6) : (t & 63);
#pragma unroll
      for (int c = 0; c < 4; ++c) { const int i0 = 16 * hi + 4 * c;
        const f32x4 g1 = *reinterpret_cast<const f32x4*>(qng + 64 * s + i0), g2 = *reinterpret_cast<const f32x4*>(qng + 64 * s + 32 + i0);
        const f32x4 c4 = *reinterpret_cast<const f32x4*>(cst + pos * 32 + i0), s4 = *reinterpret_cast<const f32x4*>(snt + pos * 32 + i0);
#pragma unroll
        for (int j = 0; j < 4; ++j) { const float x1 = y[s][4 * c + j] * rstd * g1[j], x2 = y[s][16 + 4 * c + j] * rstd * g2[j]; y[s][4 * c + j] = x1 * c4[j] - x2 * s4[j]; y[s][16 + 4 * c + j] = x1 * s4[j] + x2 * c4[j]; } }
#pragma unroll
      for (int w = 0; w < 8; ++w) qf[s][w] = pk4_fp8(y[s][4 * w], y[s][4 * w + 1], y[s][4 * w + 2], y[s][4 * w + 3]); }
  }
  const int krow = tid >> 3, kch = tid & 7, kst = k_lds(krow, kch), vst = v_lds(tid >> 2, tid & 3);
  const unsigned char* kg = K8 + (long)krow * 256 + kch * 16; const unsigned char* vg = VT + tid * 16;
  struct { u32x4 k, v; } sr_[2];
#define SLOAD(i, kt) do { sr_[i].k = *reinterpret_cast<const u32x4*>(kg + (long)(kt) * (KVBLK * 256)); sr_[i].v = *reinterpret_cast<const u32x4*>(vg + (long)(kt) * 8192); } while (0)
#define SWRITE(b, i) do { *(u32x4*)(V_lds + (b) * SHM_V + vst) = sr_[i].v; *(u32x4*)(K_lds + (b) * SHM_K + kst) = sr_[i].k; } while (0)
#define SWAIT() asm volatile("s_waitcnt vmcnt(2)" ::: "memory")
#define RESC(a) do { if (__any((a) < 1.f)) { if (hi == 0) al_l[r32] = (a); asm volatile("s_waitcnt lgkmcnt(0)" ::: "memory"); \
    for (int d = 0; d < 4; ++d) for (int r = 0; r < 16; ++r) o[d][r] *= al_l[crow(r, hi)]; } } while (0)
  f32x16 pA0, pA1, pB0, pB1; float mnA, mnB, alA, alB; v8i pa; const int NT = seq / KVBLK;
  constexpr int SE = 0, SO = 1;
  SLOAD(SE, 0); asm volatile("s_waitcnt vmcnt(0)" ::: "memory"); SWRITE(0, SE); __syncthreads();
  qkt(pA0, pA1, K_lds, qf, r32, hi); partialSM(pA0, pA1, m_reg, mnA, alA);
  SLOAD(SO, 1); if (2 < NT) SLOAD(SE, 2);
  SWAIT(); SWRITE(1, SO); __syncthreads();
  for (int j = 1; j + 1 < NT; j += 2) {
    SBAR(); qkt(pB0, pB1, K_lds + SHM_K, qf, r32, hi);
    finishSM(pA0, pA1, alA, l_reg, pa); SBAR();
    SLOAD(SO, j + 2); SBAR();
    pv(o, V_lds, pa, r32, hi); partialSM(pB0, pB1, m_reg, mnB, alB);
    __syncthreads(); SWAIT(); SWRITE(0, SE);
    RESC(alB); __syncthreads();
    SBAR(); qkt(pA0, pA1, K_lds, qf, r32, hi);
    finishSM(pB0, pB1, alB, l_reg, pa); SBAR();
    if (j + 3 < NT) SLOAD(SE, j + 3); SBAR();
    pv(o, V_lds + SHM_V, pa, r32, hi); partialSM(pA0, pA1, m_reg, mnA, alA);
    __syncthreads(); SWAIT(); SWRITE(1, SO);
    RESC(alA); __syncthreads();
  }
  SBAR(); qkt(pB0, pB1, K_lds + SHM_K, qf, r32, hi);
  finishSM(pA0, pA1, alA, l_reg, pa); SBAR();
  pv(o, V_lds, pa, r32, hi); partialSM(pB0, pB1, m_reg, mnB, alB);
  __syncthreads(); RESC(alB);
  finishSM(pB0, pB1, alB, l_reg, pa); SBAR();
  pv(o, V_lds + SHM_V, pa, r32, hi);
  if (hi == 0) li_l[r32] = l_reg; asm volatile("s_waitcnt lgkmcnt(0)" ::: "memory");
  float rli[16];
#pragma unroll
  for (int r = 0; r < 16; ++r) rli[r] = __builtin_amdgcn_rcpf(16.f * li_l[crow(r, hi)]);
  { bf16_t* stg = (bf16_t*)(lds + OST_OFF) + wid * 4096;
#pragma unroll
    for (int r = 0; r < 16; ++r) { const int orow = crow(r, hi);
#pragma unroll
      for (int d0 = 0; d0 < 4; ++d0) stg[orow * 128 + d0 * 32 + r32] = (bf16_t)(cvt_pk_bf16(o[d0][r] * rli[r], 0.f) & 0xffffu); }
    asm volatile("s_waitcnt lgkmcnt(0)" ::: "memory");
    bf16_t* Ow = Ob + (long)(wid * QBLK) * LDO;
#pragma unroll
    for (int i = 0; i < 8; ++i) { const int row = i * 4 + (lane >> 4), ch = lane & 15; const u32x4 v = *(const u32x4*)(stg + row * 128 + ch * 8); *(u32x4*)(Ow + (long)row * LDO + ch * 8) = v; }
  }
#undef SLOAD
#undef SWRITE
#undef SWAIT
#undef RESC
}
#undef SBAR
#undef MFMA8
}
constexpr size_t MiB = 1u << 20;
constexpr size_t WS_CTL = 0, CTL_ZERO_BYTES = 64 * 1024;
constexpr size_t WS_MOD = 1 * MiB;
constexpr size_t WS_ROPE = WS_MOD + 256 * 1024;
constexpr size_t WS_SBIAS = WS_MOD + 512 * 1024;
constexpr size_t WS_HC = 2 * MiB;
constexpr size_t WS_WIN = 6 * MiB;
constexpr size_t WS_WA = 17 * MiB, WS_WC = 19 * MiB, WS_WO = 21 * MiB;
constexpr size_t WS_WP = 23 * MiB;
constexpr size_t WS_UT = 27 * MiB, WS_VT = 59 * MiB;
constexpr size_t WS_TSCALE = 16 * MiB;
constexpr size_t WS_KB = 91 * MiB, WS_VB = 108 * MiB;
constexpr size_t WS_HX = 125 * MiB;
constexpr size_t WS_Q = 189 * MiB;
constexpr size_t WS_G = 253 * MiB;
constexpr size_t WS_RT = 317 * MiB;
constexpr size_t WS_SGC = 381 * MiB;
constexpr size_t WS_SC = 189 * MiB;
constexpr size_t WS_SSQ = 445 * MiB;
constexpr size_t WS_K8 = 447 * MiB;
constexpr size_t WS_VT8 = 456 * MiB;
constexpr size_t WS_END = 465 * MiB;

constexpr int NWAVES = 8;
constexpr int LDS_BYTES = 147456;

struct Args {
    const float *x, *c, *ctx, *c_ctx, *w_mod, *b_mod, *n1g, *n2g, *w_in, *qng, *kng, *w_ao, *cdw, *cb, *clg, *clb, *w_co, *w_o, *wq, *keys, *ut, *vt, *fg;
    float* out; unsigned char* ws; int ph_lo, ph_hi, dry, pad;
};

__host__ __device__ __forceinline__ int win_row(int n) {
    if (n < 1536) return n;
    const int base = n < 3584 ? 1536 : 3584, m = n - base, half = m >> 10, idx = m & 1023;
    return base + (idx >> 7) * 256 + half * 128 + (idx & 127);
}

__device__ __forceinline__ void task_mod(const Args& A, int task, int lane, const LAS float* sc) {
    const int n0 = task * 8, col = lane & 7, kg = lane >> 3;
    float acc[9];
#pragma unroll
    for (int b = 0; b < 9; ++b) acc[b] = 0.f;
    const float* wp = A.w_mod + (size_t)kg * NMOD + n0 + col;
    for (int i0 = 0; i0 < 128; i0 += 8) {
        float w[8];
#pragma unroll
        for (int u = 0; u < 8; ++u) w[u] = wp[(size_t)(i0 + u) * 8 * NMOD];
#pragma unroll
        for (int u = 0; u < 8; ++u) { const int k = kg + 8 * (i0 + u);
#pragma unroll
            for (int b = 0; b < 9; ++b) acc[b] += sc[b * D + k] * w[u]; }
    }
#pragma unroll
    for (int b = 0; b < 9; ++b) { float v = acc[b]; v += __shfl_xor(v, 8); v += __shfl_xor(v, 16); v += __shfl_xor(v, 32); acc[b] = v; }
    if (lane < 8) { float* mod = (float*)(A.ws + WS_MOD); const float bm = A.b_mod[n0 + col];
#pragma unroll
        for (int b = 0; b < 9; ++b) mod[b * NMOD + n0 + col] = acc[b] + bm; }
}
__device__ __forceinline__ void task_transpose(const float* W, int K, int N, bf16_t* WT, int k0, int n0, int row0, LAS float* scr, int lane) {
#pragma unroll 8
    for (int i = 0; i < 32; ++i) { const int kk = 2 * i + (lane >> 5); scr[kk * 33 + (lane & 31)] = W[(size_t)(k0 + kk) * N + n0 + (lane & 31)]; }
    asm volatile("s_waitcnt lgkmcnt(0)" ::: "memory");
    const int c = lane & 7;
#pragma unroll
    for (int j = 0; j < 4; ++j) { const int n = (lane >> 3) + 8 * j; const LAS float* s = scr + (8 * c) * 33 + n;
        u32x4 o; o.x = cvt_pk_bf16(s[0 * 33], s[1 * 33]); o.y = cvt_pk_bf16(s[2 * 33], s[3 * 33]); o.z = cvt_pk_bf16(s[4 * 33], s[5 * 33]); o.w = cvt_pk_bf16(s[6 * 33], s[7 * 33]);
        *(u32x4*)(WT + (size_t)(row0 + n) * K + k0 + 8 * c) = o; }
    asm volatile("s_waitcnt lgkmcnt(0)" ::: "memory");
}
typedef float f32x16v __attribute__((ext_vector_type(16)));
typedef unsigned u32x6 __attribute__((ext_vector_type(6)));
constexpr int ROWB = 768;
__device__ __forceinline__ void task_quant_rows4(const float* src, unsigned char* dst, float* scale_out, int lane) {
    const int g = lane & 31, hh = lane >> 5;
    f32x4 v[2][8];
#pragma unroll
    for (int r = 0; r < 2; ++r)
#pragma unroll
        for (int i = 0; i < 8; ++i) v[r][i] = *(const f32x4*)(src + (size_t)(2 * r + hh) * D + g * 32 + i * 4);
#pragma unroll
    for (int r = 0; r < 2; ++r) {
        float am = 0.f;
#pragma unroll
        for (int i = 0; i < 8; ++i) am = fmaxf(fmaxf(am, fmaxf(fabsf(v[r][i][0]), fabsf(v[r][i][1]))), fmaxf(fabsf(v[r][i][2]), fabsf(v[r][i][3])));
#pragma unroll
        for (int o = 1; o < 32; o <<= 1) am = fmaxf(am, __shfl_xor(am, o));
        const float inv = am > 0.f ? 7.5f / am : 0.f;
        f32x16v a, b;
#pragma unroll
        for (int i = 0; i < 4; ++i)
#pragma unroll
            for (int j = 0; j < 4; ++j) { const int e0 = 4 * i + j;
                a[e0] = v[r][(2 * e0) >> 2][(2 * e0) & 3] * inv; b[e0] = v[r][(2 * e0 + 1) >> 2][(2 * e0 + 1) & 3] * inv; }
        const u32x6 p = __builtin_amdgcn_cvt_scalef32_2xpk16_fp6_f32(a, b, 1.0f);
        unsigned char* rowp = dst + (size_t)(2 * r + hh) * ROWB;
        *(u32x4*)(rowp + g * 16) = (u32x4){p[0], p[1], p[2], p[3]}; *(u32x2*)(rowp + 512 + g * 8) = (u32x2){p[4], p[5]};
        if (g == 0) scale_out[2 * r + hh] = am * (1.f / 7.5f);
    }
}
__device__ __forceinline__ bf16x8 ld8_f32_bf16(const float* p) { const f32x4 a = *(const f32x4*)p, b = *(const f32x4*)(p + 4); u32x4 w = {cvt_pk_bf16(a[0], a[1]), cvt_pk_bf16(a[2], a[3]), cvt_pk_bf16(b[0], b[1]), cvt_pk_bf16(b[2], b[3])}; return *reinterpret_cast<bf16x8*>(&w); }
__device__ __forceinline__ void task_wprime(const Args& A, int id, int lane) {
    const int hp = id >> 7, rem = id & 127, n0 = (rem >> 5) * 32, k0 = (rem & 31) * 32, r32 = lane & 31, hi = lane >> 5;
    f32x16 acc = {};
    const float* ka = A.keys + ((size_t)(hp * 128 + n0 + r32)) * 128 + hi * 8;
    const float* wb = A.wq + (size_t)(k0 + r32) * PW + hp * 128 + hi * 8;
#pragma unroll
    for (int s = 0; s < 8; ++s) acc = __builtin_amdgcn_mfma_f32_32x32x16_bf16(ld8_f32_bf16(ka + s * 16), ld8_f32_bf16(wb + s * 16), acc, 0, 0, 0);
    bf16_t* o = (bf16_t*)(A.ws + WS_WP);
#pragma unroll
    for (int r = 0; r < 16; ++r) { const int n = (r & 3) + 8 * (r >> 2) + 4 * hi; o[(size_t)(hp * 128 + n0 + n) * D + k0 + r32] = (bf16_t)(cvt_pk_bf16(acc[r], 0.f) & 0xffffu); }
}
__device__ __forceinline__ void phase_prologue(const Args& A, LAS unsigned char* lds) {
    const int tid = threadIdx.x, lane = tid & 63, wave = __builtin_amdgcn_readfirstlane(tid >> 6);
    LAS float* sc = (LAS float*)lds;
    for (int i = tid; i < 9 * D; i += 512) { const float v = i < 8 * D ? A.c[i] : A.c_ctx[i - 8 * D]; sc[i] = v / (1.f + __expf(-v)); }
    __syncthreads();
    LAS float* scr = (LAS float*)(lds + 36864 + wave * 8448);
    constexpr int T_MOD = NMOD / 8, T_WIN = (D / 64) * (INW / 32), T_SQ = (D / 64) * (D / 32), T_UV = 2 * NEXP / 4, T_WP = 2048, T_ROPE = 1;
    constexpr int NT = T_MOD + T_WIN + 3 * T_SQ + T_UV + T_WP + T_ROPE;
    const int G = gridDim.x;
    for (int task = wave * G + blockIdx.x; task < NT; task += NWAVES * G) {
        int r = task;
        if (r < T_MOD) { task_mod(A, r, lane, sc); continue; } r -= T_MOD;
        if (r < T_WIN) { const int nblk = INW / 32, kb = r / nblk, nb = r % nblk; task_transpose(A.w_in, D, INW, (bf16_t*)(A.ws + WS_WIN), 64 * kb, 32 * nb, win_row(32 * nb), scr, lane); continue; } r -= T_WIN;
        if (r < 3 * T_SQ) { const int wsel = r / T_SQ, q = r % T_SQ, kb = q / 32, nb = q % 32;
            const float* W = wsel == 0 ? A.w_ao : (wsel == 1 ? A.w_co : A.w_o); bf16_t* WT = (bf16_t*)(A.ws + (wsel == 0 ? WS_WA : (wsel == 1 ? WS_WC : WS_WO)));
            task_transpose(W, D, D, WT, 64 * kb, 32 * nb, 32 * nb, scr, lane); continue; } r -= 3 * T_SQ;
        if (r < T_UV) { const int tb = r / (NEXP / 4), row = (r % (NEXP / 4)) * 4; unsigned char* tbase = A.ws + (tb ? WS_VT : WS_UT);
            task_quant_rows4((tb ? A.vt : A.ut) + (size_t)row * D, tbase + (size_t)row * ROWB, (float*)(tbase + WS_TSCALE) + row, lane); continue; } r -= T_UV;
        if (r < T_WP) { task_wprime(A, r, lane); continue; } r -= T_WP;
        { float* cs = (float*)(A.ws + WS_ROPE); float* sn = cs + 2048;
          for (int e = lane; e < 2048; e += 64) { const int p = e >> 5, i = e & 31; const float inv = powf(10000.f, -(float)(2 * i) / 64.f); const float a = (float)p * inv; cs[e] = cosf(a); sn[e] = sinf(a); } }
    }
}
__device__ __forceinline__ void normmod_row(const float* xr, const float* g, const float* modr, int sh_off, int sc_off, bf16_t* orow, int lane) {
    f32x4 v[4]; float ss = 0.f;
#pragma unroll
    for (int i = 0; i < 4; ++i) { v[i] = *(const f32x4*)(xr + (i * 64 + lane) * 4); ss += (v[i][0] * v[i][0] + v[i][1] * v[i][1]) + (v[i][2] * v[i][2] + v[i][3] * v[i][3]); }
    const float r = rsqrtf(wave_sum(ss) * (1.f / D) + EPS);
#pragma unroll
    for (int i = 0; i < 4; ++i) { const int k = (i * 64 + lane) * 4; const f32x4 gg = *(const f32x4*)(g + k), s1 = *(const f32x4*)(modr + sc_off + k), h1 = *(const f32x4*)(modr + sh_off + k);
        float y[4];
#pragma unroll
        for (int j = 0; j < 4; ++j) y[j] = v[i][j] * r * gg[j] * (1.f + s1[j]) + h1[j];
        u32x2 o = {cvt_pk_bf16(y[0], y[1]), cvt_pk_bf16(y[2], y[3])}; *(u32x2*)(orow + k) = o; }
}
__device__ __forceinline__ void phase_hx(const Args& A) {
    const int lane = threadIdx.x & 63, gw = blockIdx.x * NWAVES + (threadIdx.x >> 6), NGW = gridDim.x * NWAVES;
    const float* mod = (const float*)(A.ws + WS_MOD);
    for (int m = gw; m < M + MC; m += NGW) {
        if (m < M) normmod_row(A.x + (size_t)m * D, A.n1g, mod + (m >> 12) * NMOD, 0, D, (bf16_t*)(A.ws + WS_HX) + (size_t)m * D, lane);
        else { const int r = m - M; normmod_row(A.ctx + (size_t)r * D, A.n1g, mod + 8 * NMOD, 0, D, (bf16_t*)(A.ws + WS_HC) + (size_t)r * D, lane); }
    }
    const bf16_t* WP = (const bf16_t*)(A.ws + WS_WP); float* sb = (float*)(A.ws + WS_SBIAS);
    for (int col = gw; col < PW; col += NGW) {
        const u32x4 w0 = *(const u32x4*)(WP + (size_t)col * D + lane * 16), w1 = *(const u32x4*)(WP + (size_t)col * D + lane * 16 + 8);
        float wv[16];
#pragma unroll
        for (int j = 0; j < 4; ++j) { wv[2 * j] = bf_lo(w0[j]); wv[2 * j + 1] = bf_hi(w0[j]); wv[8 + 2 * j] = bf_lo(w1[j]); wv[8 + 2 * j + 1] = bf_hi(w1[j]); }
#pragma unroll 1
        for (int b = 0; b < NB; ++b) { const float* sh = mod + b * NMOD + 3 * D + lane * 16; float s = 0.f;
#pragma unroll
            for (int q = 0; q < 4; ++q) { const f32x4 v = *(const f32x4*)(sh + 4 * q); s += v[0] * wv[4 * q] + v[1] * wv[4 * q + 1] + v[2] * wv[4 * q + 2] + v[3] * wv[4 * q + 3]; }
            s = wave_sum(s); if (lane == 0) sb[b * PW + col] = s; }
    }
}
__device__ __forceinline__ void phase_kfix(const Args& A) {
    const int lane = threadIdx.x & 63, gw = blockIdx.x * NWAVES + (threadIdx.x >> 6), NGW = gridDim.x * NWAVES, li = lane & 15, sub = lane >> 4;
    const bf16_t* KB = (const bf16_t*)(A.ws + WS_KB); const float* cs = (const float*)(A.ws + WS_ROPE); const float* sn = cs + 2048;
    constexpr int NITEM = NB * SKV * HKV;
    const f32x4 g0 = *(const f32x4*)(A.kng + li * 8), g1 = *(const f32x4*)(A.kng + li * 8 + 4);
    const f32x4 p0 = *(const f32x4*)(A.kng + (li ^ 4) * 8), p1 = *(const f32x4*)(A.kng + (li ^ 4) * 8 + 4);
    for (int it = gw * 4 + sub; it < NITEM; it += NGW * 4) {
        const int row = it >> 1, h = it & 1, t = row % SKV;
        const bf16_t* p = KB + (size_t)row * 256 + h * HD + li * 8;
        const u32x4 w = *(const u32x4*)p;
        float x[8], xp[8]; float ss = 0.f;
#pragma unroll
        for (int j = 0; j < 4; ++j) { x[2 * j] = bf_lo(w[j]); x[2 * j + 1] = bf_hi(w[j]); ss += x[2 * j] * x[2 * j] + x[2 * j + 1] * x[2 * j + 1];
            const unsigned pw = (unsigned)__shfl_xor((int)w[j], 4); xp[2 * j] = bf_lo(pw); xp[2 * j + 1] = bf_hi(pw); }
        ss += __shfl_xor(ss, 1); ss += __shfl_xor(ss, 2); ss += __shfl_xor(ss, 4); ss += __shfl_xor(ss, 8);
        const float r = rsqrtf(ss * (1.f / HD) + EPS);
        float y[8];
#pragma unroll
        for (int j = 0; j < 8; ++j) { x[j] *= r * (j < 4 ? g0[j] : g1[j - 4]); xp[j] *= r * (j < 4 ? p0[j] : p1[j - 4]); y[j] = x[j]; }
        if (t < S) {
            const int blk = li >> 3, pos = blk == 0 ? (t >> 6) : (t & 63), second = (li >> 2) & 1, i0 = (li & 3) * 8;
            const f32x4 c0 = *(const f32x4*)(cs + pos * 32 + i0), c1 = *(const f32x4*)(cs + pos * 32 + i0 + 4), s0 = *(const f32x4*)(sn + pos * 32 + i0), s1 = *(const f32x4*)(sn + pos * 32 + i0 + 4);
#pragma unroll
            for (int j = 0; j < 8; ++j) { const float c = j < 4 ? c0[j] : c1[j - 4], s = j < 4 ? s0[j] : s1[j - 4];
                y[j] = second ? (xp[j] * s + x[j] * c) : (x[j] * c - xp[j] * s); }
        }
        u32x2 o = {(unsigned)att::pk4_fp8(y[0] * 16.f, y[1] * 16.f, y[2] * 16.f, y[3] * 16.f), (unsigned)att::pk4_fp8(y[4] * 16.f, y[5] * 16.f, y[6] * 16.f, y[7] * 16.f)};
        *(u32x2*)(A.ws + WS_K8 + (size_t)row * 256 + h * HD + li * 8) = o;
    }
}
__device__ __forceinline__ void phase_vt(const Args& A, LAS unsigned char* lds) {
    const int lane = threadIdx.x & 63, wave = threadIdx.x >> 6, gw = blockIdx.x * NWAVES + wave, NGW = gridDim.x * NWAVES;
    LAS unsigned char* tl = lds + wave * 8192;
    const bf16_t* VB = (const bf16_t*)(A.ws + WS_VB);
    const int kk = lane & 31, pos = 32 * ((kk >> 2) & 1) + (kk & 3) + 4 * (kk >> 3) + 16 * (lane >> 5);
    constexpr int NTILE = SKV / 64;
    for (int it = gw; it < NB * HKV * NTILE; it += NGW) {
        const int j = it % NTILE, bk = it / NTILE, b = bk >> 1, kv = bk & 1;
        const bf16_t* src = VB + ((size_t)b * SKV + j * 64 + lane) * 256 + kv * HD;
#pragma unroll
        for (int c = 0; c < 16; ++c) { const u32x4 w = *(const u32x4*)(src + c * 8);
#pragma unroll
            for (int q = 0; q < 4; ++q) { const int pk = __builtin_amdgcn_cvt_pk_fp8_f32(bf_lo(w[q]) * 16.f, bf_hi(w[q]) * 16.f, 0, false);
                tl[(c * 8 + 2 * q) * 64 + pos] = (unsigned char)(pk & 0xff); tl[(c * 8 + 2 * q + 1) * 64 + pos] = (unsigned char)((pk >> 8) & 0xff); } }
        asm volatile("s_waitcnt lgkmcnt(0)" ::: "memory");
        unsigned char* dst = A.ws + WS_VT8 + (size_t)it * 8192;
#pragma unroll
        for (int i = 0; i < 8; ++i) *(u32x4*)(dst + (i * 64 + lane) * 16) = *(const LAS u32x4*)(tl + (i * 64 + lane) * 16);
        asm volatile("s_waitcnt lgkmcnt(0)" ::: "memory");
    }
}
template <int R> struct ConvRow {
    static __device__ __forceinline__ void run(const unsigned* gp, int tl0, float (&acc)[32][2], const float (&w)[31][2]) {
        const int tl = tl0 + R - 15;
        unsigned v = 0u; if (tl >= 0 && tl < S) v = gp[(long)(R - 15) * (D / 2)];
        const float a = bf_lo(v), b = bf_hi(v);
#pragma unroll
        for (int t = (R - 30 > 0 ? R - 30 : 0); t <= (R < 31 ? R : 31); ++t) { acc[t][0] += w[R - t][0] * a; acc[t][1] += w[R - t][1] * b; }
        if constexpr (R + 1 < 62) ConvRow<R + 1>::run(gp, tl0, acc, w);
    }
};
__device__ __forceinline__ void phase_conv(const Args& A, LAS unsigned char* lds) {
    const int tid = threadIdx.x, lane = tid & 63, wave = tid >> 6;
    LAS float* tile = (LAS float*)lds;
    const bf16_t* G = (const bf16_t*)(A.ws + WS_G); bf16_t* CV = (bf16_t*)(A.ws + WS_HX);
    float w[31][2];
#pragma unroll
    for (int j = 0; j < 31; ++j) { const f32x2 t = *(const f32x2*)(A.cdw + j * D + 2 * tid); w[j][0] = t[0]; w[j][1] = t[1]; }
    const f32x2 bias = *(const f32x2*)(A.cb + 2 * tid);
    for (int tileid = blockIdx.x; tileid < M / 32; tileid += gridDim.x) {
        const int row0 = tileid * 32, tl0 = row0 & (S - 1);
        float acc[32][2];
#pragma unroll
        for (int t = 0; t < 32; ++t) { acc[t][0] = bias[0]; acc[t][1] = bias[1]; }
        ConvRow<0>::run((const unsigned*)(G + (size_t)row0 * D) + tid, tl0, acc, w);
        __syncthreads();
#pragma unroll
        for (int t = 0; t < 32; ++t) *(LAS f32x2*)(tile + t * D + 2 * tid) = (f32x2){acc[t][0], acc[t][1]};
        __syncthreads();
#pragma unroll
        for (int q = 0; q < 4; ++q) { const int t = wave * 4 + q; const LAS float* tr = tile + t * D;
            f32x4 v[4]; float s = 0.f;
#pragma unroll
            for (int i = 0; i < 4; ++i) { v[i] = *(const LAS f32x4*)(tr + (i * 64 + lane) * 4); s += (v[i][0] + v[i][1]) + (v[i][2] + v[i][3]); }
            const float mu = wave_sum(s) * (1.f / D); float qq = 0.f;
#pragma unroll
            for (int i = 0; i < 4; ++i) { v[i] = v[i] - mu; qq += (v[i][0] * v[i][0] + v[i][1] * v[i][1]) + (v[i][2] * v[i][2] + v[i][3] * v[i][3]); }
            const float rs = rsqrtf(wave_sum(qq) * (1.f / D) + EPS);
#pragma unroll
            for (int i = 0; i < 4; ++i) { const int k = (i * 64 + lane) * 4; const f32x4 gg = *(const f32x4*)(A.clg + k), bb = *(const f32x4*)(A.clb + k); float y[4];
#pragma unroll
                for (int j = 0; j < 4; ++j) { const float z = v[i][j] * rs * gg[j] + bb[j]; y[j] = z * fast_sigmoid(z); }
                u32x2 o = {cvt_pk_bf16(y[0], y[1]), cvt_pk_bf16(y[2], y[3])}; *(u32x2*)(CV + (size_t)(row0 + t) * D + k) = o; }
        }
    }
}
struct EpiInProj {
    static constexpr bool PERM = true;
    unsigned char* ws;
    __device__ __forceinline__ void operator()(f32x4 (&acc)[2][2][4][2], const pg8::Unit& u, int wr, int wc, int fr, int fq) const {
        const int c8 = wc * 32 + 8 * fq;
#pragma unroll
        for (int ai = 0; ai < 2; ++ai)
#pragma unroll
            for (int m = 0; m < 4; ++m) {
                const int row = u.pm * 256 + ai * 128 + wr * 64 + m * 16 + fr;
                if (u.kind == 0) {
                    bf16_t* p = (bf16_t*)(ws + WS_Q) + (size_t)row * D + u.pn * 256 + c8;
#pragma unroll
                    for (int bj = 0; bj < 2; ++bj) { const f32x4 v0 = acc[ai][bj][m][0], v1 = acc[ai][bj][m][1];
                        u32x4 w = {cvt_pk_bf16(v0[0], v0[1]), cvt_pk_bf16(v0[2], v0[3]), cvt_pk_bf16(v1[0], v1[1]), cvt_pk_bf16(v1[2], v1[3])}; *(u32x4*)(p + bj * 128) = w; }
                } else if (u.kind == 1 || u.kind == 2 || u.kind == 5 || u.kind == 6) {
                    const bool ctxu = u.kind >= 5;
                    const int kvrow = ctxu ? (row >> 8) * SKV + S + (row & 255) : (row >> 12) * SKV + (row & (S - 1));
                    bf16_t* p = (bf16_t*)(ws + ((u.kind == 1 || u.kind == 5) ? WS_KB : WS_VB)) + (size_t)kvrow * 256 + c8;
#pragma unroll
                    for (int bj = 0; bj < 2; ++bj) { const f32x4 v0 = acc[ai][bj][m][0], v1 = acc[ai][bj][m][1];
                        u32x4 w = {cvt_pk_bf16(v0[0], v0[1]), cvt_pk_bf16(v0[2], v0[3]), cvt_pk_bf16(v1[0], v1[1]), cvt_pk_bf16(v1[2], v1[3])}; *(u32x4*)(p + bj * 128) = w; }
                } else if (u.kind == 3) {
                    float g[8];
#pragma unroll
                    for (int n = 0; n < 2; ++n)
#pragma unroll
                        for (int j = 0; j < 4; ++j) g[4 * n + j] = acc[ai][0][m][n][j] * fast_sigmoid(acc[ai][1][m][n][j]);
                    u32x4 w = {cvt_pk_bf16(g[0], g[1]), cvt_pk_bf16(g[2], g[3]), cvt_pk_bf16(g[4], g[5]), cvt_pk_bf16(g[6], g[7])};
                    *(u32x4*)((bf16_t*)(ws + WS_G) + (size_t)row * D + (u.pn - 6) * 128 + c8) = w;
                } else {
                    float rt[8], sg[8];
#pragma unroll
                    for (int n = 0; n < 2; ++n)
#pragma unroll
                        for (int j = 0; j < 4; ++j) { const float ea = __builtin_amdgcn_exp2f(-1.4426950408889634f * acc[ai][0][m][n][j]), ec = __builtin_amdgcn_exp2f(-1.4426950408889634f * acc[ai][1][m][n][j]);
                            sg[4 * n + j] = __builtin_amdgcn_rcpf(1.f + ec); rt[4 * n + j] = (1.f + ec) * __builtin_amdgcn_rcpf(1.f + ea); }
                    const size_t off = (size_t)row * D + (u.pn - 14) * 128 + c8;
                    u32x4 w = {cvt_pk_bf16(rt[0], rt[1]), cvt_pk_bf16(rt[2], rt[3]), cvt_pk_bf16(rt[4], rt[5]), cvt_pk_bf16(rt[6], rt[7])}; *(u32x4*)((bf16_t*)(ws + WS_RT) + off) = w;
                    u32x4 w2 = {cvt_pk_bf16(sg[0], sg[1]), cvt_pk_bf16(sg[2], sg[3]), cvt_pk_bf16(sg[4], sg[5]), cvt_pk_bf16(sg[6], sg[7])}; *(u32x4*)((bf16_t*)(ws + WS_SGC) + off) = w2;
                }
            }
    }
};
struct SchedInProj {
    const char* hx; const char* hc; const char* w; int G, c;
    __device__ __forceinline__ bool next(int i, pg8::Unit& u) const {
        constexpr int nM = M / 256, nN = INW / 256, NMAIN = nM * nN, NCTX = (MC / 256) * 2;
        const int L = i * G + c; if (L >= NMAIN + NCTX) return false;
        if (L < NMAIN) { pg8::tile_of(L, nM, nN, u.pm, u.pn); u.a = hx + (size_t)u.pm * 256 * D * 2; u.kind = u.pn < 4 ? 0 : (u.pn == 4 ? 1 : (u.pn == 5 ? 2 : (u.pn < 14 ? 3 : 4))); }
        else { const int j = L - NMAIN; u.pm = j >> 1; u.pn = 4 + (j & 1); u.a = hc + (size_t)u.pm * 256 * D * 2; u.kind = 5 + (j & 1); }
        u.b = w + (size_t)u.pn * 256 * D * 2; u.keep = 0; return true;
    }
};
struct EpiMerge {
    static constexpr bool PERM = true;
    unsigned char* ws;
    __device__ __forceinline__ void operator()(f32x4 (&acc)[2][2][4][2], const pg8::Unit& u, int wr, int wc, int fr, int fq) const {
        const int c8 = u.pn * 256 + wc * 32 + 8 * fq;
        const bf16_t* F = (const bf16_t*)(ws + (u.kind == 0 ? WS_RT : WS_SGC));
#pragma unroll
        for (int ai = 0; ai < 2; ++ai)
#pragma unroll
            for (int m = 0; m < 4; ++m) { const size_t off = (size_t)(u.pm * 256 + ai * 128 + wr * 64 + m * 16 + fr) * D + c8;
#pragma unroll
                for (int bj = 0; bj < 2; ++bj) { const u32x4 f = *(const u32x4*)(F + off + bj * 128);
                    f32x4 v0 = acc[ai][bj][m][0], v1 = acc[ai][bj][m][1];
                    v0[0] *= bf_lo(f[0]); v0[1] *= bf_hi(f[0]); v0[2] *= bf_lo(f[1]); v0[3] *= bf_hi(f[1]); v1[0] *= bf_lo(f[2]); v1[1] *= bf_hi(f[2]); v1[2] *= bf_lo(f[3]); v1[3] *= bf_hi(f[3]);
                    if (u.kind == 0) { acc[ai][bj][m][0] = v0; acc[ai][bj][m][1] = v1; }
                    else { u32x4 w = {cvt_pk_bf16(v0[0], v0[1]), cvt_pk_bf16(v0[2], v0[3]), cvt_pk_bf16(v1[0], v1[1]), cvt_pk_bf16(v1[2], v1[3])}; *(u32x4*)((bf16_t*)(ws + WS_G) + off + bj * 128) = w; } } }
    }
};
struct SchedMerge {
    const char* att; const char* cv; const char* wa; const char* wc; int G, c;
    __device__ __forceinline__ bool next(int i, pg8::Unit& u) const {
        constexpr int nM = M / 256, nN = D / 256;
        const int L = (i >> 1) * G + c, sub = i & 1; if (L >= nM * nN) return false;
        pg8::tile_of(L, nM, nN, u.pm, u.pn);
        u.a = (sub ? cv : att) + (size_t)u.pm * 256 * D * 2; u.b = (sub ? wc : wa) + (size_t)u.pn * 256 * D * 2; u.kind = sub; u.keep = sub ^ 1; return true;
    }
};
struct SchedPlain {
    const char* a; const char* b; int nM, nN, G, c;
    __device__ __forceinline__ bool next(int i, pg8::Unit& u) const {
        const int L = i * G + c; if (L >= nM * nN) return false;
        pg8::tile_of(L, nM, nN, u.pm, u.pn); u.a = a + (size_t)u.pm * 256 * D * 2; u.b = b + (size_t)u.pn * 256 * D * 2; u.kind = 0; u.keep = 0; return true;
    }
};
struct EpiOut {
    static constexpr bool PERM = false;
    const float* x; const float* mod; const float* n2g; float* xs; bf16_t* xg; float* ssq;
    __device__ __forceinline__ void operator()(f32x4 (&acc)[2][2][4][2], const pg8::Unit& u, int wr, int wc, int fr, int fq) const {
        const int col0 = u.pn * 256 + wc * 32 + 4 * fq; const float* mb = mod + ((u.pm * 256) >> 12) * NMOD;
        f32x4 gv[2][2], nv[2][2];
#pragma unroll
        for (int bj = 0; bj < 2; ++bj)
#pragma unroll
            for (int n = 0; n < 2; ++n) { const int c = col0 + bj * 128 + n * 16; gv[bj][n] = *(const f32x4*)(mb + 2 * D + c); nv[bj][n] = *(const f32x4*)(n2g + c) * (*(const f32x4*)(mb + 4 * D + c) + 1.f); }
#pragma unroll
        for (int ai = 0; ai < 2; ++ai)
#pragma unroll
            for (int m = 0; m < 4; ++m) { const int row = u.pm * 256 + ai * 128 + wr * 64 + m * 16 + fr; const size_t off = (size_t)row * D + col0; float ss = 0.f;
#pragma unroll
                for (int bj = 0; bj < 2; ++bj)
#pragma unroll
                    for (int n = 0; n < 2; ++n) { const f32x4 xv = *(const f32x4*)(x + off + bj * 128 + n * 16); const f32x4 v = xv + gv[bj][n] * acc[ai][bj][m][n]; *(f32x4*)(xs + off + bj * 128 + n * 16) = v;
                        ss += (v[0] * v[0] + v[1] * v[1]) + (v[2] * v[2] + v[3] * v[3]); const f32x4 g = v * nv[bj][n];
                        u32x2 w = {cvt_pk_bf16(g[0], g[1]), cvt_pk_bf16(g[2], g[3])}; *(u32x2*)(xg + off + bj * 128 + n * 16) = w; }
                ss += __shfl_xor(ss, 16); ss += __shfl_xor(ss, 32);
                if (fq == 0) ssq[(size_t)row * 16 + u.pn * 4 + wc] = ss; }
    }
};
__device__ __forceinline__ float row_rstd(const float* ssq, int row) {
    const f32x4 a = *(const f32x4*)(ssq + (size_t)row * 16), b = *(const f32x4*)(ssq + (size_t)row * 16 + 4), c = *(const f32x4*)(ssq + (size_t)row * 16 + 8), d = *(const f32x4*)(ssq + (size_t)row * 16 + 12);
    const float s = ((a[0] + a[1]) + (a[2] + a[3])) + ((b[0] + b[1]) + (b[2] + b[3])) + ((c[0] + c[1]) + (c[2] + c[3])) + ((d[0] + d[1]) + (d[2] + d[3]));
    return rsqrtf(s * (1.f / D) + EPS);
}
struct EpiScores {
    static constexpr bool PERM = false;
    float* sc; const float* ssq; const float* sbias;
    __device__ __forceinline__ void operator()(f32x4 (&acc)[2][2][4][2], const pg8::Unit& u, int wr, int wc, int fr, int fq) const {
        const float* sb = sbias + ((u.pm * 256) >> 12) * PW + u.pn * 256 + wc * 32 + 4 * fq;
        f32x4 bv[2][2];
#pragma unroll
        for (int bj = 0; bj < 2; ++bj)
#pragma unroll
            for (int n = 0; n < 2; ++n) bv[bj][n] = *(const f32x4*)(sb + bj * 128 + n * 16);
#pragma unroll
        for (int ai = 0; ai < 2; ++ai)
#pragma unroll
            for (int m = 0; m < 4; ++m) { const int row = u.pm * 256 + ai * 128 + wr * 64 + m * 16 + fr; float* p = sc + (size_t)(row >> 2) * 8192 + (row & 3) * 4; const float rs = row_rstd(ssq, row);
#pragma unroll
                for (int bj = 0; bj < 2; ++bj)
#pragma unroll
                    for (int n = 0; n < 2; ++n) { const int grp = u.pn * 2 + bj, nq = wc * 8 + n * 4 + fq; *(f32x4*)(p + (grp * 32 + nq) * 16) = acc[ai][bj][m][n] * rs + bv[bj][n]; } }
    }
};

__device__ __forceinline__ void phase_attn(const Args& A, unsigned char* lds) {
    const int G = gridDim.x, X = blockIdx.x & 7, j = blockIdx.x >> 3, perx = G >> 3;
    bf16_t* Q = (bf16_t*)(A.ws + WS_Q); const unsigned char* K8 = A.ws + WS_K8; const unsigned char* VT8 = A.ws + WS_VT8;
    const float* cs = (const float*)(A.ws + WS_ROPE); const float* sn = cs + 2048;
    for (int idx = j; idx < 128; idx += perx) {
        const int grp = 2 * X + (idx >> 6), uu = idx & 63, b = grp >> 1, kv = grp & 1, h = kv * 4 + (uu >> 4), qb = uu & 15;
        bf16_t* qp = Q + ((size_t)b * S + qb * 256) * D + h * HD;
        bf16_t* op = A.dry ? (bf16_t*)(A.ws + WS_G) + ((size_t)b * S + qb * 256) * D + h * HD : qp;
        att::attn_unit(qp, K8 + (size_t)b * SKV * 256 + kv * HD, VT8 + (size_t)grp * (SKV / 64) * 8192, op, qb * 256, SKV, A.qng, cs, sn, (char*)lds);
    }
}

__device__ __forceinline__ float gelu_exact(float v) {
    const float av = fabsf(v), t = __builtin_amdgcn_rcpf(av * 0.2316418882f + 1.0f);
    float q = t * 0.5307027145f + (-0.7265760135f); q = q * t + 0.7107068705f; q = q * t + (-0.142248368f); q = q * t + 0.127414796f; q = q * t;
    const float e = __builtin_amdgcn_exp2f((v * v) * (-0.72134752044f));
    const float m = v * (q * e);
    return v < 0.f ? m : v - m;
}
__device__ __forceinline__ void ins16(float (&t)[16], float v) {
#pragma unroll
    for (int i = 15; i >= 1; --i) t[i] = __builtin_amdgcn_fmed3f(t[i - 1], t[i], v);
    t[0] = fmaxf(t[0], v);
}
typedef float f32x32v __attribute__((ext_vector_type(32)));
__device__ __forceinline__ float key_tag(float v, unsigned keepmask, unsigned tag) { return __uint_as_float((__float_as_uint(v) & keepmask) | tag); }
template <int I, int J> struct CandLoop {
    static __device__ __forceinline__ void run(const float (&a)[16], const float (&b)[16], float (&c)[16]) {
        if constexpr ((I + 1) * (J + 1) <= 16) { ins16(c, key_tag(a[I] + b[J], ~255u, 255u - (unsigned)(I * 16 + J))); CandLoop<I, J + 1>::run(a, b, c); }
        else if constexpr (I + 1 < 16) CandLoop<I + 1, 0>::run(a, b, c);
    }
};
__device__ __forceinline__ void phase_peer(const Args& A, LAS unsigned char* lds) {
    const int lane = threadIdx.x & 63, wave = threadIdx.x >> 6, gw = blockIdx.x * NWAVES + wave, NGW = gridDim.x * NWAVES;
    LAS unsigned char* wl = lds + wave * 10240;
    LAS float* topL = (LAS float*)wl; LAS int* eidA = (LAS int*)(wl + 4096); LAS float* wgtA = (LAS float*)(wl + 6144); LAS float* coefL = (LAS float*)(wl + 8192);
    LAS float* suL = (LAS float*)(wl + 8704); LAS float* svL = (LAS float*)(wl + 9216);
    const float* SC = (const float*)(A.ws + WS_SC); const bf16_t* HX = (const bf16_t*)(A.ws + WS_HX);
    const unsigned char* UT = A.ws + WS_UT; const unsigned char* VT = A.ws + WS_VT; const float* SU = (const float*)(A.ws + WS_UT + WS_TSCALE); const float* SVs = (const float*)(A.ws + WS_VT + WS_TSCALE);
    const float* mod = (const float*)(A.ws + WS_MOD);
#ifdef PROBE_L2SUBSET
    const int idmask = A.dry ? 2047 : 0x7fffffff;
#else
    const int idmask = 0x7fffffff;
#endif
    const float NEG = -3.0e38f;
    const int h = lane >> 3, tk = (lane >> 1) & 3, p = lane & 1, grp = 2 * h + p;
    for (int pass = gw; pass < M / 4; pass += NGW) {
        {
            float t[16];
#pragma unroll
            for (int i = 0; i < 16; ++i) t[i] = NEG;
            const float* sp = SC + (size_t)pass * 8192 + (grp * 128 + tk) * 4;
#pragma unroll 4
            for (int i = 0; i < 32; ++i) { const f32x4 v = *(const f32x4*)(sp + i * 16); const unsigned tg = 127u - 4u * (unsigned)i;
                ins16(t, key_tag(v[0], ~127u, tg)); ins16(t, key_tag(v[1], ~127u, tg - 1u)); ins16(t, key_tag(v[2], ~127u, tg - 2u)); ins16(t, key_tag(v[3], ~127u, tg - 3u)); }
            float pb[16];
#pragma unroll
            for (int i = 0; i < 16; ++i) { pb[i] = __shfl_xor(t[i], 1); topL[lane * 16 + i] = t[i]; }
            float c[16];
#pragma unroll
            for (int i = 0; i < 16; ++i) c[i] = NEG;
            CandLoop<0, 0>::run(t, pb, c);
            float e[16]; float es = 0.f;
#pragma unroll
            for (int k = 0; k < 16; ++k) { e[k] = __expf(c[k] - c[0]); es += e[k]; }
            const float inv = __builtin_amdgcn_rcpf(es);
            asm volatile("s_waitcnt lgkmcnt(0)" ::: "memory");
            if (p == 0) {
#pragma unroll
                for (int k = 0; k < 16; ++k) { const unsigned code = 255u - (__float_as_uint(c[k]) & 255u);
                    const unsigned ia = 127u - (__float_as_uint(topL[lane * 16 + (code >> 4)]) & 127u), ib = 127u - (__float_as_uint(topL[(lane + 1) * 16 + (code & 15u)]) & 127u);
                    eidA[tk * 128 + h * 16 + k] = (int)(ia * 128u + ib); wgtA[tk * 128 + h * 16 + k] = e[k] * inv; }
            }
            asm volatile("s_waitcnt lgkmcnt(0)" ::: "memory");
        }
#pragma unroll 1
        for (int tq = 0; tq < 4; ++tq) {
            const int t = pass * 4 + tq; const LAS int* eidL = eidA + tq * 128; const LAS float* wgtL = wgtA + tq * 128;
            const int g = lane & 31, hh = lane >> 5;
            f32x2 x2[16];
            { const float rs = row_rstd((const float*)(A.ws + WS_SSQ), t); const float* sh = mod + (t >> 12) * NMOD + 3 * D + g * 32; const bf16_t* xp = HX + (size_t)t * D + g * 32;
#pragma unroll
              for (int c = 0; c < 4; ++c) { const u32x4 w = *(const u32x4*)(xp + 8 * c); const f32x4 s0 = *(const f32x4*)(sh + 8 * c), s1 = *(const f32x4*)(sh + 8 * c + 4);
                x2[4 * c] = (f32x2){bf_lo(w[0]) * rs + s0[0], bf_hi(w[0]) * rs + s0[1]}; x2[4 * c + 1] = (f32x2){bf_lo(w[1]) * rs + s0[2], bf_hi(w[1]) * rs + s0[3]};
                x2[4 * c + 2] = (f32x2){bf_lo(w[2]) * rs + s1[0], bf_hi(w[2]) * rs + s1[1]}; x2[4 * c + 3] = (f32x2){bf_lo(w[3]) * rs + s1[2], bf_hi(w[3]) * rs + s1[3]}; } }
            { const int i0 = eidL[lane], i1 = eidL[64 + lane]; suL[lane] = SU[i0]; suL[64 + lane] = SU[i1]; svL[lane] = SVs[i0]; svL[64 + lane] = SVs[i1]; }
            u32x6 bufA[4], bufB[4];
#define LOAD8(buf, TB, hb) do { _Pragma("unroll") for (int r = 0; r < 4; ++r) { const int id = eidL[(hb) * 8 + 2 * r + hh] & idmask; const unsigned char* rp = (TB) + (size_t)id * ROWB; \
                const u32x4 lo = *(const u32x4*)(rp + g * 16); const u32x2 hi2 = *(const u32x2*)(rp + 512 + g * 8); buf[r] = (u32x6){lo[0], lo[1], lo[2], lo[3], hi2[0], hi2[1]}; } } while (0)
#define DOT8(buf, off) do { _Pragma("unroll") for (int r = 0; r < 4; ++r) { const f32x32v dq = __builtin_amdgcn_cvt_scalef32_pk32_f32_fp6(buf[r], 1.0f); f32x2 s2 = {0.f, 0.f}; \
                _Pragma("unroll") for (int j = 0; j < 16; ++j) s2 += (f32x2){dq[2 * j], dq[2 * j + 1]} * x2[j]; \
                pp[(off) + r] = s2[0] + s2[1]; } } while (0)
#define REDUCE16(kb) do { \
            _Pragma("unroll") for (int e = 0; e < 4; ++e) { const bool up = lane & 16; const float keep = up ? pp[e + 4] : pp[e], send = up ? pp[e] : pp[e + 4]; pp[e] = keep + __shfl_xor(send, 16); } \
            _Pragma("unroll") for (int e = 0; e < 2; ++e) { const bool up = lane & 8; const float keep = up ? pp[e + 2] : pp[e], send = up ? pp[e] : pp[e + 2]; pp[e] = keep + __shfl_xor(send, 8); } \
            { const bool up = lane & 4; const float keep = up ? pp[1] : pp[0], send = up ? pp[0] : pp[1]; pp[0] = keep + __shfl_xor(send, 4); } \
            float hsum = pp[0]; hsum += __shfl_xor(hsum, 2); hsum += __shfl_xor(hsum, 1); \
            const int ke = (kb) * 16 + 2 * ((lane >> 2) & 7) + hh; const float su = suL[ke], sv = svL[ke]; \
            const float cf = wgtL[ke] * gelu_exact(hsum * su) * sv; if ((lane & 3) == 0) coefL[ke] = cf; } while (0)
            LOAD8(bufA, UT, 0);
#pragma unroll 1
            for (int kb = 0; kb < 8; ++kb) {
                float pp[8];
                LOAD8(bufB, UT, 2 * kb + 1);
                DOT8(bufA, 0);
                if (kb < 7) LOAD8(bufA, UT, 2 * kb + 2); else LOAD8(bufA, VT, 0);
                DOT8(bufB, 4);
                REDUCE16(kb);
            }
            asm volatile("s_waitcnt lgkmcnt(0)" ::: "memory");
            f32x2 y2[16];
#pragma unroll
            for (int j = 0; j < 16; ++j) y2[j] = (f32x2){0.f, 0.f};
#define VACC8(buf, hb) do { _Pragma("unroll") for (int r = 0; r < 4; ++r) { const float cf = coefL[(hb) * 8 + 2 * r + hh]; const f32x2 cf2 = {cf, cf}; \
                const f32x32v dq = __builtin_amdgcn_cvt_scalef32_pk32_f32_fp6(buf[r], 1.0f); \
                _Pragma("unroll") for (int j = 0; j < 16; ++j) y2[j] += cf2 * (f32x2){dq[2 * j], dq[2 * j + 1]}; } } while (0)
#pragma unroll 1
            for (int kb = 0; kb < 8; ++kb) {
                LOAD8(bufB, VT, 2 * kb + 1);
                VACC8(bufA, 2 * kb);
                if (kb < 7) LOAD8(bufA, VT, 2 * kb + 2);
                VACC8(bufB, 2 * kb + 1);
            }
#undef LOAD8
#undef DOT8
#undef REDUCE16
#undef VACC8
            float yy[16];
#pragma unroll
            for (int j = 0; j < 16; ++j) { const float a = y2[j][0] + __shfl_xor(y2[j][0], 32), b = y2[j][1] + __shfl_xor(y2[j][1], 32); if ((j >> 3) == hh) { yy[2 * (j & 7)] = a; yy[2 * (j & 7) + 1] = b; } }
            const float* g2 = mod + (t >> 12) * NMOD + 5 * D; float* orow = A.out + (size_t)t * D;
            float z[16]; float ss = 0.f;
#pragma unroll
            for (int q = 0; q < 4; ++q) { const int k = g * 32 + hh * 16 + q * 4; const f32x4 xv = *(const f32x4*)(orow + k), gv = *(const f32x4*)(g2 + k);
#pragma unroll
                for (int j = 0; j < 4; ++j) { const float zz = xv[j] + gv[j] * yy[q * 4 + j]; z[q * 4 + j] = zz; ss += zz * zz; } }
            const float r = rsqrtf(wave_sum(ss) * (1.f / D) + EPS);
#pragma unroll
            for (int q = 0; q < 4; ++q) { const int k = g * 32 + hh * 16 + q * 4; const f32x4 fv = *(const f32x4*)(A.fg + k);
                f32x4 o;
#pragma unroll
                for (int j = 0; j < 4; ++j) o[j] = z[q * 4 + j] * r * fv[j];
                if (!A.dry || r < 0.f) *(f32x4*)(orow + k) = o; }
        }
    }
}
#define XB_TMO      128
#define XB_XCNT(j)  (256  + 64 * (j))
#define XB_XSUB(j)  (1280 + 64 * (j))
#define XB_XGEN(j)  (2304 + 64 * (j))
#define XB_TOP      3328
#define XB_TOPGEN   3392
#define XCD_BAR_WORDS 3456
#define XB_SPIN_CAP (1u << 22)
__device__ __forceinline__ unsigned xb_ld(unsigned* p)              { return __hip_atomic_load(p, __ATOMIC_RELAXED, __HIP_MEMORY_SCOPE_AGENT); }
__device__ __forceinline__ unsigned xb_add(unsigned* p, unsigned v) { return __hip_atomic_fetch_add(p, v, __ATOMIC_RELAXED, __HIP_MEMORY_SCOPE_AGENT); }
__device__ __forceinline__ unsigned xb_xcc_id() { return (unsigned)__builtin_amdgcn_s_getreg((3 << 11) | 20) & 0xFu; }
#define XB_SPIN(cond, bar) do { unsigned _sp = 0; while (cond) { __builtin_amdgcn_s_sleep(1); \
    if ((++_sp & 255u) == 0u) { if (xb_ld(&(bar)[XB_TMO])) break; if (_sp > XB_SPIN_CAP) { atomicAdd(&(bar)[XB_TMO], 1u); break; } } } } while (0)
struct XcdBarrier { unsigned* bar; unsigned x; volatile LAS unsigned* st; };
__device__ __forceinline__ XcdBarrier xcd_barrier_post(unsigned* bar, volatile LAS unsigned* st) {
    XcdBarrier b; b.bar = bar; b.x = xb_xcc_id(); b.st = st;
    if (threadIdx.x == 0) (void)xb_add(&bar[XB_XCNT(b.x)], 1u);
    return b;
}
__device__ __forceinline__ void xcd_barrier_complete(unsigned* bar, unsigned x, unsigned& nloc, unsigned& nx) {
    const unsigned G = gridDim.x * gridDim.y * gridDim.z;
    unsigned sum, cnt, mine, sp = 0u;
    for (;;) {
        sum = 0u; cnt = 0u; mine = 0u;
#pragma unroll
        for (unsigned j = 0; j < 16; ++j) { const unsigned c = xb_ld(&bar[XB_XCNT(j)]); sum += c; cnt += (c > 0u) ? 1u : 0u; mine = (j == x) ? c : mine; }
        if (sum == G) break;
        __builtin_amdgcn_s_sleep(1);
        if ((++sp & 255u) == 0u) { if (xb_ld(&bar[XB_TMO])) break; if (sp > XB_SPIN_CAP) { atomicAdd(&bar[XB_TMO], 1u); break; } }
    }
    nloc = mine > 0u ? mine : 1u; nx = cnt > 0u ? cnt : 1u;
}
__device__ __forceinline__ void xcd_barrier(const XcdBarrier& b) {
    asm volatile("s_waitcnt vmcnt(0)" ::: "memory");
    __syncthreads();
    if (threadIdx.x == 0) {
        unsigned* bar = b.bar;
        __builtin_amdgcn_s_waitcnt(0);
        unsigned nloc = b.st[0], nx = b.st[1];
        if (nloc == 0u) { xcd_barrier_complete(bar, b.x, nloc, nx); b.st[0] = nloc; b.st[1] = nx; }
        const unsigned old = xb_add(&bar[XB_XSUB(b.x)], 1u);
        const unsigned gen = old / nloc;
        if (old + 1u == (gen + 1u) * nloc) {
            __builtin_amdgcn_fence(__ATOMIC_RELEASE, "agent");
            asm volatile("s_waitcnt vmcnt(0)" ::: "memory");
            const unsigned og = xb_add(&bar[XB_TOP], 1u);
            const unsigned tg = og / nx;
            if (og + 1u == (tg + 1u) * nx) xb_add(&bar[XB_TOPGEN], 1u);
            else XB_SPIN(xb_ld(&bar[XB_TOPGEN]) == tg, bar);
            __builtin_amdgcn_fence(__ATOMIC_ACQUIRE, "agent");
            xb_add(&bar[XB_XGEN(b.x)], 1u);
            asm volatile("s_waitcnt vmcnt(0)" ::: "memory");
        } else {
            XB_SPIN(xb_ld(&bar[XB_XGEN(b.x)]) == gen, bar);
            __builtin_amdgcn_fence(__ATOMIC_ACQUIRE, "agent");
            asm volatile("s_waitcnt vmcnt(0)" ::: "memory");
        }
    }
    __syncthreads();
}
constexpr int MISC_OFF = 135168;

constexpr int N_PHASES = 9;
__global__ void __launch_bounds__(NWAVES * 64, 2) mega_fwd(Args A) {
    extern __shared__ __attribute__((aligned(16))) unsigned char lds[];
    LAS unsigned char* L = (LAS unsigned char*)lds;
    cg::grid_group grid = cg::this_grid();
    const int lo = A.ph_lo, hi = A.ph_hi, G = gridDim.x, c = blockIdx.x;
#ifndef PH_MASK
#define PH_MASK 0x1FF
#endif
#define IN(k) (((PH_MASK >> (k)) & 1) && lo <= (k) && (k) < hi)
    unsigned* barw = (unsigned*)(A.ws + WS_CTL);
    volatile LAS unsigned* MISC = (volatile LAS unsigned*)(L + MISC_OFF);
    if (threadIdx.x < 2) MISC[threadIdx.x] = 0u;
    if (lo == 0 && hi > 1 && blockIdx.x == 0) for (int i = threadIdx.x; i < XCD_BAR_WORDS; i += NWAVES * 64) barw[i] = 0u;
    XcdBarrier xb; xb.bar = barw; xb.x = 0; xb.st = MISC;
#define SEAM(k) do { if (IN(k) && IN((k) + 1)) { if ((k) == 0) { grid.sync(); xb = xcd_barrier_post(barw, MISC); } else xcd_barrier(xb); } } while (0)
    if (IN(0)) phase_prologue(A, L);
    SEAM(0);
    if (IN(1)) phase_hx(A);
    SEAM(1);
    if (IN(2)) { SchedInProj Sd{(const char*)(A.ws + WS_HX), (const char*)(A.ws + WS_HC), (const char*)(A.ws + WS_WIN), G, c}; EpiInProj E{A.ws};
        pg8::gemm_phase<EpiInProj, SchedInProj, true>(L, D, Sd, E); }
    SEAM(2);
    if (IN(3)) { phase_kfix(A); phase_vt(A, L); __syncthreads(); phase_conv(A, L); }
    SEAM(3);
    if (IN(4)) phase_attn(A, lds);
    SEAM(4);
    if (IN(5)) { SchedMerge Sd{(const char*)(A.ws + WS_Q), (const char*)(A.ws + WS_HX), (const char*)(A.ws + WS_WA), (const char*)(A.ws + WS_WC), G, c}; EpiMerge E{A.ws};
        pg8::gemm_phase<EpiMerge, SchedMerge, true>(L, D, Sd, E); }
    SEAM(5);
    if (IN(6)) { SchedPlain Sd{(const char*)(A.ws + WS_G), (const char*)(A.ws + WS_WO), M / 256, D / 256, G, c};
        EpiOut E{A.x, (const float*)(A.ws + WS_MOD), A.n2g, A.out, (bf16_t*)(A.ws + WS_HX), (float*)(A.ws + WS_SSQ)};
        pg8::gemm_phase<EpiOut, SchedPlain, true>(L, D, Sd, E); }
    SEAM(6);
    if (IN(7)) { SchedPlain Sd{(const char*)(A.ws + WS_HX), (const char*)(A.ws + WS_WP), M / 256, PW / 256, G, c};
        EpiScores E{(float*)(A.ws + WS_SC), (const float*)(A.ws + WS_SSQ), (const float*)(A.ws + WS_SBIAS)};
        pg8::gemm_phase<EpiScores, SchedPlain, true>(L, D, Sd, E); }
    SEAM(7);
    if (IN(8)) phase_peer(A, L);
#undef IN
#undef SEAM
}

#ifndef MK_ONE_LAUNCH
#define MK_ONE_LAUNCH 1
#endif
extern "C" void kernel_launch(void* const* d_in, const int* in_sizes, int n_in, void* d_out, int out_size, void* d_ws, size_t ws_size, hipStream_t stream) {
    static int grid = 0;
    if (grid == 0) {
        if (n_in != 23 || out_size != M * D || ws_size < WS_END) { fprintf(stderr, "kernel_launch: unexpected shapes (n_in %d out %d ws %zu)\n", n_in, out_size, ws_size); grid = -1; return; }
        int dev = 0, cus = 0, per_cu = 0;
        hipGetDevice(&dev); hipDeviceGetAttribute(&cus, hipDeviceAttributeMultiprocessorCount, dev);
        if (hipFuncSetAttribute((const void*)mega_fwd, hipFuncAttributeMaxDynamicSharedMemorySize, LDS_BYTES) != hipSuccess) { fprintf(stderr, "kernel_launch: hipFuncSetAttribute failed\n"); grid = -1; return; }
        if (hipOccupancyMaxActiveBlocksPerMultiprocessor(&per_cu, (const void*)mega_fwd, NWAVES * 64, LDS_BYTES) != hipSuccess || per_cu < 1) { fprintf(stderr, "kernel_launch: occupancy query says %d\n", per_cu); per_cu = 1; }
        (void)hipGetLastError();
        grid = cus * 1;
        if (per_cu < 1) grid = -1;
    }
    if (grid < 0) return;
    Args a{};
    const float** f = (const float**)&a;
    for (int i = 0; i < 23; ++i) f[i] = (const float*)d_in[i];
    a.out = (float*)d_out; a.ws = (unsigned char*)d_ws;
#if MK_ONE_LAUNCH
    a.ph_lo = 0; a.ph_hi = N_PHASES;
    void* args[] = {&a};
    hipError_t e = hipLaunchCooperativeKernel((const void*)mega_fwd, dim3(grid), dim3(NWAVES * 64), args, LDS_BYTES, stream);
    if (e != hipSuccess) fprintf(stderr, "cooperative launch failed: %s (grid %d)\n", hipGetErrorString(e), grid);
#else
#ifndef REPEAT_PH
#define REPEAT_PH -1
#endif
    for (int p = 0; p < N_PHASES; ++p) { a.ph_lo = p; a.ph_hi = p + 1;
        if (p == REPEAT_PH) { a.dry = 1; hipLaunchKernelGGL(mega_fwd, dim3(grid), dim3(NWAVES * 64), LDS_BYTES, stream, a); a.dry = 0; }
        hipLaunchKernelGGL(mega_fwd, dim3(grid), dim3(NWAVES * 64), LDS_BYTES, stream, a); }
#endif
}
```

```cpp
#include <hip/hip_runtime.h>
#include <hip/hip_cooperative_groups.h>
#include <cstdio>
#include <cstdint>
namespace cg = cooperative_groups;

#define LAS __attribute__((address_space(3)))
typedef unsigned short bf16_t;
typedef short bf16x8 __attribute__((ext_vector_type(8)));
typedef short s16x4 __attribute__((ext_vector_type(4)));
typedef float f32x2 __attribute__((ext_vector_type(2)));
typedef float f32x4 __attribute__((ext_vector_type(4)));
typedef float f32x16 __attribute__((ext_vector_type(16)));
typedef unsigned u32x2 __attribute__((ext_vector_type(2)));
typedef unsigned u32x4 __attribute__((ext_vector_type(4)));
typedef __bf16 bf16x2_t __attribute__((ext_vector_type(2)));

constexpr int D = 1024, NB = 8, S = 4096, CTXL = 256, SKV = S + CTXL, HD = 128, HQ = 8, HKV = 2;
constexpr int M = NB * S;
constexpr int MC = NB * CTXL;
constexpr int INW = 5632, NMOD = 6144, NEXP = 16384, PW = 2048;
constexpr float EPS = 1e-6f;

__device__ __forceinline__ unsigned cvt_pk_bf16(float lo, float hi) { f32x2 v = {lo, hi}; bf16x2_t b = __builtin_convertvector(v, bf16x2_t); return __builtin_bit_cast(unsigned, b); }
__device__ __forceinline__ float bf_lo(unsigned u) { return __uint_as_float(u << 16); }
__device__ __forceinline__ float bf_hi(unsigned u) { return __uint_as_float(u & 0xffff0000u); }
__device__ __forceinline__ float fast_sigmoid(float x) { return __builtin_amdgcn_rcpf(1.f + __builtin_amdgcn_exp2f(-1.4426950408889634f * x)); }
__device__ __forceinline__ float wave_sum(float v) {
#pragma unroll
    for (int o = 1; o < 64; o <<= 1) v += __shfl_xor(v, o);
    return v;
}

namespace pg8 {
constexpr int BM = 256, BK = 64, HALF = 128, HTB = HALF * BK * 2  , STAGE_BYTES = 8 * HTB, NXCD = 8, WGM = 8;
__host__ __device__ __forceinline__ int lds_byte(int r, int c) { const int st = (r >> 4) * 2 + (c >> 5), rr = r & 15, cc = c & 31, ob = rr * 64 + cc * 2; return st * 1024 + (ob ^ (((ob >> 9) & 1) << 5)); }
__host__ __device__ __forceinline__ void stage_rc(int b, int& R, int& C) { const int st = b / 1024, sb = b % 1024, swz = sb ^ (((sb >> 9) & 1) << 5); R = (st >> 1) * 16 + swz / 64; C = (st & 1) * 32 + (swz % 64) / 2; }
__host__ __device__ __forceinline__ int perm32(int rho) { const int n = rho >> 4, i = rho & 15; return 8 * (i >> 2) + 4 * n + (i & 3); }

struct Unit { const char* a; const char* b; int pm, pn, kind, keep; };

__device__ __forceinline__ void tile_of(int L, int nM, int nN, int& pm, int& pn) {
    const int nwg = nM * nN; int wgid = L;
    { const int q = nwg / NXCD, r = nwg % NXCD, xcd = wgid % NXCD, off = wgid / NXCD; wgid = (xcd < r ? xcd * (q + 1) : r * (q + 1) + (xcd - r) * q) + off; }
    const int nig = WGM * nN, gid = wgid / nig, fm = gid * WGM, gsz = (nM - fm) < WGM ? (nM - fm) : WGM;
    pm = fm + ((wgid % nig) % gsz); pn = (wgid % nig) / gsz;
}

template <class Epi, class Sched, bool ALIGN_EPI>
__device__ __forceinline__ void gemm_phase(LAS unsigned char* lds, const int K, const Sched& S, const Epi& E) {
    const int tid = threadIdx.x, wid = __builtin_amdgcn_readfirstlane(tid >> 6), lane = tid & 63, wr = wid >> 2, wc = wid & 3, fr = lane & 15, fq = lane >> 4;
    const int nt = K / BK;
    unsigned voffA[2], voffB[2];
#pragma unroll
    for (int i = 0; i < 2; ++i) { int R, C; stage_rc(tid * 16 + i * 8192, R, C); const int Rb = Epi::PERM ? ((R & ~31) + perm32(R & 31)) : R;
        voffA[i] = (unsigned)(R * K + C) * 2u; voffB[i] = (unsigned)(Rb * K + C) * 2u; }
    const size_t kstep = (size_t)(BK * 2);
    const size_t hstep = (size_t)HALF * K * 2;
    const unsigned ldsw = (unsigned)wid * 1024u;
    const int aoff = lds_byte(wr * 64 + fr, fq * 8), boff = lds_byte(wc * 32 + fr, fq * 8);
#define PG8_SA(b, h) (((b) * 2 + (h)) * HTB)
#define PG8_SB(b, h) ((4 + (b) * 2 + (h)) * HTB)
#define PG8_STAGE(bufoff, gbase, voff) do { _Pragma("unroll") for (int _i = 0; _i < 2; ++_i) \
        __builtin_amdgcn_global_load_lds((const unsigned*)((const char*)(gbase) + (voff)[_i]), (LAS unsigned*)(lds + (bufoff) + ldsw + _i * 8192), 16, 0, 0); } while (0)
#define PG8_LDA(dst, b, h) do { _Pragma("unroll") for (int m = 0; m < 4; ++m) _Pragma("unroll") for (int k = 0; k < 2; ++k) dst[m][k] = *(const LAS bf16x8*)(lds + PG8_SA(b, h) + aoff + m * 2048 + k * 1024); } while (0)
#define PG8_LDB(dst, b, h) do { _Pragma("unroll") for (int n = 0; n < 2; ++n) _Pragma("unroll") for (int k = 0; k < 2; ++k) dst[n][k] = *(const LAS bf16x8*)(lds + PG8_SB(b, h) + boff + n * 2048 + k * 1024); } while (0)
#define PG8_MMA(ai, bj, At, Bt) do { __builtin_amdgcn_s_setprio(1); _Pragma("unroll") for (int m = 0; m < 4; ++m) _Pragma("unroll") for (int n = 0; n < 2; ++n) _Pragma("unroll") for (int k = 0; k < 2; ++k) \
        acc[ai][bj][m][n] = __builtin_amdgcn_mfma_f32_16x16x32_bf16(Bt[n][k], At[m][k], acc[ai][bj][m][n], 0, 0, 0); __builtin_amdgcn_s_setprio(0); } while (0)
#define PG8_WAIT_V(n) asm volatile("s_waitcnt vmcnt(" #n ")" ::: "memory")
#define PG8_WAIT_L(n) asm volatile("s_waitcnt lgkmcnt(" #n ")" ::: "memory")
#define PG8_BAR __builtin_amdgcn_s_barrier()
#define PG8_SCHED __builtin_amdgcn_sched_barrier(0)
    Unit cur, nxt; int ui = 0;
    if (!S.next(0, cur)) return;
    f32x4 acc[2][2][4][2];
#pragma unroll
    for (int a = 0; a < 2; ++a)
#pragma unroll
        for (int b = 0; b < 2; ++b)
#pragma unroll
            for (int m = 0; m < 4; ++m)
#pragma unroll
                for (int n = 0; n < 2; ++n) acc[a][b][m][n] = (f32x4){0.f, 0.f, 0.f, 0.f};
    bf16x8 At[4][2], B0[2][2], B1[2][2];
    const char* cA = cur.a; const char* cB = cur.b;
    PG8_STAGE(PG8_SB(0, 0), cB, voffB); PG8_STAGE(PG8_SB(0, 1), cB + hstep, voffB); PG8_STAGE(PG8_SA(0, 0), cA, voffA); PG8_STAGE(PG8_SA(0, 1), cA + hstep, voffA);
    if (wr == 1) PG8_BAR;
    PG8_WAIT_V(2); PG8_BAR;
    PG8_STAGE(PG8_SB(1, 0), cB + kstep, voffB); PG8_STAGE(PG8_SA(1, 0), cA + kstep, voffA); PG8_STAGE(PG8_SB(1, 1), cB + hstep + kstep, voffB);
    PG8_WAIT_V(6); PG8_BAR;
    for (;;) {
        const bool has_next = S.next(ui + 1, nxt);
        const char* nA = has_next ? nxt.a : cA; const char* nB = has_next ? nxt.b : cB;
        for (int t = 0; t < nt; t += 2) {
            const bool last = (t == nt - 2);
            const char* a1 = cA + (size_t)(t + 1) * kstep;
            const char* a2 = last ? nA : cA + (size_t)(t + 2) * kstep; const char* b2 = last ? nB : cB + (size_t)(t + 2) * kstep;
            const char* a3 = a2 + kstep; const char* b3 = b2 + kstep;
            PG8_LDB(B0, 0, 0); PG8_LDB(B1, 0, 1); PG8_SCHED; PG8_LDA(At, 0, 0); PG8_STAGE(PG8_SA(1, 1), a1 + hstep, voffA);
            PG8_WAIT_V(8); PG8_WAIT_L(0); PG8_BAR; PG8_MMA(0, 0, At, B0); PG8_MMA(0, 1, At, B1); PG8_BAR; PG8_SCHED;
            PG8_LDA(At, 0, 1); PG8_STAGE(PG8_SB(0, 0), b2, voffB); PG8_STAGE(PG8_SB(0, 1), b2 + hstep, voffB); PG8_STAGE(PG8_SA(0, 0), a2, voffA);
            PG8_WAIT_V(8); PG8_WAIT_L(0); PG8_BAR; PG8_MMA(1, 0, At, B0); PG8_MMA(1, 1, At, B1); PG8_BAR; PG8_SCHED;
            PG8_LDB(B0, 1, 0); PG8_LDB(B1, 1, 1); PG8_SCHED; PG8_LDA(At, 1, 0); PG8_STAGE(PG8_SA(0, 1), a2 + hstep, voffA);
            PG8_WAIT_V(8); PG8_WAIT_L(0); PG8_BAR; PG8_MMA(0, 0, At, B0); PG8_MMA(0, 1, At, B1); PG8_BAR; PG8_SCHED;
            PG8_LDA(At, 1, 1); PG8_STAGE(PG8_SB(1, 0), b3, voffB); PG8_STAGE(PG8_SB(1, 1), b3 + hstep, voffB); PG8_STAGE(PG8_SA(1, 0), a3, voffA);
            PG8_WAIT_V(8); PG8_WAIT_L(0); PG8_BAR; PG8_MMA(1, 0, At, B0); PG8_MMA(1, 1, At, B1); PG8_BAR; PG8_SCHED;
        }
        if constexpr (ALIGN_EPI) { if (wr == 0) PG8_BAR; }
        E(acc, cur, wr, wc, fr, fq);
        if (!has_next) break;
        if (!cur.keep) {
#pragma unroll
        for (int a = 0; a < 2; ++a)
#pragma unroll
            for (int b = 0; b < 2; ++b)
#pragma unroll
                for (int m = 0; m < 4; ++m)
#pragma unroll
                    for (int n = 0; n < 2; ++n) acc[a][b][m][n] = (f32x4){0.f, 0.f, 0.f, 0.f};
        }
        cur = nxt; cA = nA; cB = nB; ++ui;
        if constexpr (ALIGN_EPI) { if (wr == 1) PG8_BAR; }
    }
    PG8_WAIT_V(0);
    if constexpr (!ALIGN_EPI) { if (wr == 0) PG8_BAR; }
    PG8_BAR;
#undef PG8_SA
#undef PG8_SB
#undef PG8_STAGE
#undef PG8_LDA
#undef PG8_LDB
#undef PG8_MMA
#undef PG8_WAIT_V
#undef PG8_WAIT_L
#undef PG8_BAR
#undef PG8_SCHED
}
}
namespace att {
typedef int v8i __attribute__((ext_vector_type(8)));
constexpr int NW = 8, QBLK = 32, KVBLK = 64;
constexpr float SCALE = 0.088388347648318440f;
constexpr float SC8 = SCALE / 256.f;
constexpr float THR = 3.f;
constexpr int LDQ = D, LDO = D;
constexpr int SHM_V = 8192, SHM_K = 8192, NRING = 3, OFF_K = NRING * SHM_V, OFF_WS = OFF_K + NRING * SHM_K, OST_OFF = OFF_WS + NW * 64 * 4, LDS_TOTAL = OST_OFF + NW * 8192;
#define SBAR() __builtin_amdgcn_sched_barrier(0)
#define MFMA8(a, b, c) __builtin_amdgcn_mfma_scale_f32_32x32x64_f8f6f4((a), (b), (c), 0, 0, 0, 0x7f7f7f7f, 0, 0x7f7f7f7f)
__device__ __forceinline__ int crow(int r, int hi) { return (r & 3) + 8 * (r >> 2) + 4 * hi; }
__device__ __forceinline__ int k_lds(int row, int chunk) { return row * 128 + ((chunk ^ ((row >> 1) & 7)) << 4); }
__device__ __forceinline__ int v_lds(int d, int slot) { return d * 64 + ((slot ^ ((d >> 2) & 3)) << 4); }
__device__ __forceinline__ int pk4_fp8(float a, float b, float c, float d) { int w = __builtin_amdgcn_cvt_pk_fp8_f32(a, b, 0, false); return __builtin_amdgcn_cvt_pk_fp8_f32(c, d, w, true); }

__device__ __forceinline__ void partialSM(f32x16& p0, f32x16& p1, float& m_reg, float& mn, float& alpha) {
  constexpr float C = SC8 * 1.4426950408889634f;
  float mx[8];
#pragma unroll
  for (int i = 0; i < 8; ++i) mx[i] = fmaxf(fmaxf(p0[i], p0[8 + i]), fmaxf(p1[i], p1[8 + i]));
  float pmax = fmaxf(fmaxf(fmaxf(mx[0], mx[1]), fmaxf(mx[2], mx[3])), fmaxf(fmaxf(mx[4], mx[5]), fmaxf(mx[6], mx[7])));
  { auto rr = __builtin_amdgcn_permlane32_swap(__float_as_uint(pmax), __float_as_uint(pmax), false, false);
    pmax = fmaxf(__uint_as_float(rr[0]), __uint_as_float(rr[1])); }
  if (__builtin_expect(__all(pmax - m_reg <= THR / SC8), 1)) { mn = m_reg; alpha = 1.f; }
  else { mn = fmaxf(m_reg, pmax); alpha = __builtin_amdgcn_exp2f((m_reg - mn) * C); m_reg = mn; }
  float mnC = 4.f - mn * C;
  for (int r = 0; r < 16; ++r) p0[r] = fmaf(p0[r], C, mnC); for (int r = 0; r < 16; ++r) p1[r] = fmaf(p1[r], C, mnC);
  for (int r = 0; r < 16; ++r) p0[r] = __builtin_amdgcn_exp2f(p0[r]);
}
__device__ __forceinline__ void finishSM(f32x16& p0, f32x16& p1, float alpha, float& l_reg, v8i& pa) {
  for (int r = 0; r < 16; ++r) p1[r] = __builtin_amdgcn_exp2f(p1[r]);
  float sm[8];
#pragma unroll
  for (int i = 0; i < 8; ++i) sm[i] = (p0[i] + p0[8 + i]) + (p1[i] + p1[8 + i]);
  float ps = ((sm[0] + sm[1]) + (sm[2] + sm[3])) + ((sm[4] + sm[5]) + (sm[6] + sm[7]));
  { auto rr = __builtin_amdgcn_permlane32_swap(__float_as_uint(ps), __float_as_uint(ps), false, false);
    ps = __uint_as_float(rr[0]) + __uint_as_float(rr[1]); }
  l_reg = l_reg * alpha + ps;
  pa[0] = pk4_fp8(p0[0], p0[1], p0[2], p0[3]); pa[1] = pk4_fp8(p0[4], p0[5], p0[6], p0[7]); pa[2] = pk4_fp8(p0[8], p0[9], p0[10], p0[11]); pa[3] = pk4_fp8(p0[12], p0[13], p0[14], p0[15]);
  pa[4] = pk4_fp8(p1[0], p1[1], p1[2], p1[3]); pa[5] = pk4_fp8(p1[4], p1[5], p1[6], p1[7]); pa[6] = pk4_fp8(p1[8], p1[9], p1[10], p1[11]); pa[7] = pk4_fp8(p1[12], p1[13], p1[14], p1[15]);
}
__device__ __forceinline__ v8i ld32(const char* p0, const char* p1) { const u32x4 a = *reinterpret_cast<const u32x4*>(p0), b = *reinterpret_cast<const u32x4*>(p1);
  v8i r; r[0] = (int)a[0]; r[1] = (int)a[1]; r[2] = (int)a[2]; r[3] = (int)a[3]; r[4] = (int)b[0]; r[5] = (int)b[1]; r[6] = (int)b[2]; r[7] = (int)b[3]; return r; }
__device__ __forceinline__ void qkt(f32x16& p0, f32x16& p1, const char* Ks, const v8i* qf, int r32, int hi) {
  p0 = f32x16{}; p1 = f32x16{};
#pragma unroll
  for (int s = 0; s < 2; ++s) {
    const v8i a0 = ld32(Ks + k_lds(r32, 4 * s + hi), Ks + k_lds(r32, 4 * s + 2 + hi)), a1 = ld32(Ks + k_lds(32 + r32, 4 * s + hi), Ks + k_lds(32 + r32, 4 * s + 2 + hi));
    p0 = MFMA8(a0, qf[s], p0); p1 = MFMA8(a1, qf[s], p1); }
}
__device__ __forceinline__ void pv(f32x16* o, const char* Vs, const v8i pa, int r32, int hi) {
#pragma unroll
  for (int d0 = 0; d0 < 4; ++d0) { const int d = 32 * d0 + r32; const v8i b = ld32(Vs + v_lds(d, 2 * hi), Vs + v_lds(d, 2 * hi + 1)); o[d0] = MFMA8(pa, b, o[d0]); }
}

__device__ __forceinline__ void attn_unit(const bf16_t* Qb, const unsigned char* __restrict__ K8, const unsigned char* __restrict__ VT, bf16_t* Ob, int t0, int seq,
                                          const float* __restrict__ qng, const float* __restrict__ cst, const float* __restrict__ snt, char* lds) {
  int tid_ = threadIdx.x; asm volatile("" : "+v"(tid_));
  const int tid = tid_, wid = tid >> 6, lane = tid & 63, r32 = lane & 31, hi = lane >> 5;
  char* V_lds = lds; char* K_lds = lds + OFF_K;
  float* ws = (float*)(lds + OFF_WS) + wid * 64; float* li_l = ws; float* al_l = ws + 32;
  float m_reg = -1e30f, l_reg = 0; f32x16 o[4] = {}; v8i qf[2];
  {
    const bf16_t* Qw = Qb + (long)(wid * QBLK + r32) * LDQ + 16 * hi;
    float y[2][32]; float ss = 0.f;
#pragma unroll
    for (int s = 0; s < 2; ++s)
#pragma unroll
      for (int part = 0; part < 2; ++part)
#pragma unroll
        for (int c = 0; c < 2; ++c) { const u32x4 w = *reinterpret_cast<const u32x4*>(Qw + 64 * s + 32 * part + 8 * c);
#pragma unroll
          for (int j = 0; j < 4; ++j) { const float a = bf_lo(w[j]), b = bf_hi(w[j]); y[s][16 * part + 8 * c + 2 * j] = a; y[s][16 * part + 8 * c + 2 * j + 1] = b; ss += a * a + b * b; } }
    ss += __shfl_xor(ss, 32);
    const float rstd = rsqrtf(ss * (1.f / HD) + EPS) * 16.f;
    const int t = t0 + wid * QBLK + r32;
#pragma unroll
    for (int s = 0; s < 2; ++s) { const int pos = s == 0 ? (t >> 6) : (t & 63);
#pragma unroll
      for (int c = 0; c < 4; ++c) { const int i0 = 16 * hi + 4 * c;
        const f32x4 g1 = *reinterpret_cast<const f32x4*>(qng + 64 * s + i0), g2 = *reinterpret_cast<const f32x4*>(qng + 64 * s + 32 + i0);
        const f32x4 c4 = *reinterpret_cast<const f32x4*>(cst + pos * 32 + i0), s4 = *reinterpret_cast<const f32x4*>(snt + pos * 32 + i0);
#pragma unroll
        for (int j = 0; j < 4; ++j) { const float x1 = y[s][4 * c + j] * rstd * g1[j], x2 = y[s][16 + 4 * c + j] * rstd * g2[j]; y[s][4 * c + j] = x1 * c4[j] - x2 * s4[j]; y[s][16 + 4 * c + j] = x1 * s4[j] + x2 * c4[j]; } }
#pragma unroll
      for (int w = 0; w < 8; ++w) qf[s][w] = pk4_fp8(y[s][4 * w], y[s][4 * w + 1], y[s][4 * w + 2], y[s][4 * w + 3]); }
  }
  const int krow = tid >> 3, kch = tid & 7, kst = k_lds(krow, kch), vst = v_lds(tid >> 2, tid & 3);
  const unsigned char* kg = K8 + (long)krow * 256 + kch * 16; const unsigned char* vg = VT + tid * 16;
  struct { u32x4 k, v; } sr_[2];
#define SLOAD(i, kt) do { sr_[i].k = *reinterpret_cast<const u32x4*>(kg + (long)(kt) * (KVBLK * 256)); sr_[i].v = *reinterpret_cast<const u32x4*>(vg + (long)(kt) * 8192); } while (0)
#define SWRITE(boff, i) do { *(u32x4*)(V_lds + (boff) + vst) = sr_[i].v; *(u32x4*)(K_lds + (boff) + kst) = sr_[i].k; } while (0)
#define SWAIT() asm volatile("s_waitcnt vmcnt(2)" ::: "memory")
#define RESC(a) do { if (__any((a) < 1.f)) { if (hi == 0) al_l[r32] = (a); asm volatile("s_waitcnt lgkmcnt(0)" ::: "memory"); \
    for (int d = 0; d < 4; ++d) for (int r = 0; r < 16; ++r) o[d][r] *= al_l[crow(r, hi)]; } } while (0)
  f32x16 pA0, pA1, pB0, pB1; float mnA, mnB, alA, alB; v8i pa; const int NT = seq / KVBLK;
  constexpr int SE = 0, SO = 1;
  int bprev = 0, bcur = SHM_K, bnext = 2 * SHM_K;
#define ROT() do { const int t_ = bprev; bprev = bcur; bcur = bnext; bnext = t_; } while (0)
  SLOAD(SE, 0); asm volatile("s_waitcnt vmcnt(0)" ::: "memory"); SWRITE(0, SE); __syncthreads();
  qkt(pA0, pA1, K_lds, qf, r32, hi); partialSM(pA0, pA1, m_reg, mnA, alA);
  SLOAD(SO, 1); if (2 < NT) SLOAD(SE, 2);
  SWAIT(); SWRITE(SHM_K, SO); __syncthreads();
  for (int j = 1; j + 1 < NT; j += 2) {
    SBAR(); qkt(pB0, pB1, K_lds + bcur, qf, r32, hi);
    finishSM(pA0, pA1, alA, l_reg, pa); SBAR();
    SLOAD(SO, j + 2); SBAR();
    pv(o, V_lds + bprev, pa, r32, hi); partialSM(pB0, pB1, m_reg, mnB, alB);
    SWAIT(); SWRITE(bnext, SE);
    RESC(alB); __syncthreads(); ROT();
    SBAR(); qkt(pA0, pA1, K_lds + bcur, qf, r32, hi);
    finishSM(pB0, pB1, alB, l_reg, pa); SBAR();
    if (j + 3 < NT) SLOAD(SE, j + 3); SBAR();
    pv(o, V_lds + bprev, pa, r32, hi); partialSM(pA0, pA1, m_reg, mnA, alA);
    SWAIT(); SWRITE(bnext, SO);
    RESC(alA); __syncthreads(); ROT();
  }
  SBAR(); qkt(pB0, pB1, K_lds + bcur, qf, r32, hi);
  finishSM(pA0, pA1, alA, l_reg, pa); SBAR();
  pv(o, V_lds + bprev, pa, r32, hi); partialSM(pB0, pB1, m_reg, mnB, alB);
  RESC(alB);
  finishSM(pB0, pB1, alB, l_reg, pa); SBAR();
  pv(o, V_lds + bcur, pa, r32, hi);
  __syncthreads();
#undef ROT
  if (hi == 0) li_l[r32] = l_reg; asm volatile("s_waitcnt lgkmcnt(0)" ::: "memory");
  float rli[16];
#pragma unroll
  for (int r = 0; r < 16; ++r) rli[r] = __builtin_amdgcn_rcpf(16.f * li_l[crow(r, hi)]);
  { bf16_t* stg = (bf16_t*)(lds + OST_OFF) + wid * 4096;
#pragma unroll
    for (int r = 0; r < 16; ++r) { const int orow = crow(r, hi);
#pragma unroll
      for (int d0 = 0; d0 < 4; ++d0) stg[orow * 128 + d0 * 32 + r32] = (bf16_t)(cvt_pk_bf16(o[d0][r] * rli[r], 0.f) & 0xffffu); }
    asm volatile("s_waitcnt lgkmcnt(0)" ::: "memory");
    bf16_t* Ow = Ob + (long)(wid * QBLK) * LDO;
#pragma unroll
    for (int i = 0; i < 8; ++i) { const int row = i * 4 + (lane >> 4), ch = lane & 15; const u32x4 v = *(const u32x4*)(stg + row * 128 + ch * 8); *(u32x4*)(Ow + (long)row * LDO + ch * 8) = v; }
  }
#undef SLOAD
#undef SWRITE
#undef SWAIT
#undef RESC
}
#undef SBAR
#undef MFMA8
}
constexpr size_t MiB = 1u << 20;
constexpr size_t WS_CTL = 0, CTL_ZERO_BYTES = 64 * 1024;
constexpr size_t WS_MOD = 1 * MiB;
constexpr size_t WS_ROPE = WS_MOD + 256 * 1024;
constexpr size_t WS_SBIAS = WS_MOD + 512 * 1024;
constexpr size_t WS_HC = 2 * MiB;
constexpr size_t WS_WIN = 6 * MiB;
constexpr size_t WS_WA = 17 * MiB, WS_WC = 19 * MiB, WS_WO = 21 * MiB;
constexpr size_t WS_WP = 23 * MiB;
constexpr size_t WS_UT = 27 * MiB, WS_VT = 59 * MiB;
constexpr size_t WS_TSCALE = 16 * MiB;
constexpr size_t WS_KB = 91 * MiB, WS_VB = 108 * MiB;
constexpr size_t WS_HX = 125 * MiB;
constexpr size_t WS_Q = 189 * MiB;
constexpr size_t WS_G = 253 * MiB;
constexpr size_t WS_RT = 317 * MiB;
constexpr size_t WS_SGC = 381 * MiB;
constexpr size_t WS_SC = 189 * MiB;
constexpr size_t WS_SSQ = 445 * MiB;
constexpr size_t WS_K8 = 447 * MiB;
constexpr size_t WS_VT8 = 456 * MiB;
constexpr size_t WS_END = 465 * MiB;

constexpr int NWAVES = 8;
constexpr int LDS_BYTES = 147456;

struct Args {
    const float *x, *c, *ctx, *c_ctx, *w_mod, *b_mod, *n1g, *n2g, *w_in, *qng, *kng, *w_ao, *cdw, *cb, *clg, *clb, *w_co, *w_o, *wq, *keys, *ut, *vt, *fg;
    float* out; unsigned char* ws; int ph_lo, ph_hi, dry, pad;
};

__host__ __device__ __forceinline__ int win_row(int n) {
    if (n < 1536) return n;
    const int base = n < 3584 ? 1536 : 3584, m = n - base, half = m >> 10, idx = m & 1023;
    return base + (idx >> 7) * 256 + half * 128 + (idx & 127);
}

__device__ __forceinline__ void task_mod(const Args& A, int task, int lane, const LAS float* sc) {
    const int n0 = task * 8, col = lane & 7, kg = lane >> 3;
    float acc[9];
#pragma unroll
    for (int b = 0; b < 9; ++b) acc[b] = 0.f;
    const float* wp = A.w_mod + (size_t)kg * NMOD + n0 + col;
    for (int i0 = 0; i0 < 128; i0 += 8) {
        float w[8];
#pragma unroll
        for (int u = 0; u < 8; ++u) w[u] = wp[(size_t)(i0 + u) * 8 * NMOD];
#pragma unroll
        for (int u = 0; u < 8; ++u) { const int k = kg + 8 * (i0 + u);
#pragma unroll
            for (int b = 0; b < 9; ++b) acc[b] += sc[b * D + k] * w[u]; }
    }
#pragma unroll
    for (int b = 0; b < 9; ++b) { float v = acc[b]; v += __shfl_xor(v, 8); v += __shfl_xor(v, 16); v += __shfl_xor(v, 32); acc[b] = v; }
    if (lane < 8) { float* mod = (float*)(A.ws + WS_MOD); const float bm = A.b_mod[n0 + col];
#pragma unroll
        for (int b = 0; b < 9; ++b) mod[b * NMOD + n0 + col] = acc[b] + bm; }
}
__device__ __forceinline__ void task_transpose(const float* W, int K, int N, bf16_t* WT, int k0, int n0, int row0, LAS float* scr, int lane) {
#pragma unroll 8
    for (int i = 0; i < 32; ++i) { const int kk = 2 * i + (lane >> 5); scr[kk * 33 + (lane & 31)] = W[(size_t)(k0 + kk) * N + n0 + (lane & 31)]; }
    asm volatile("s_waitcnt lgkmcnt(0)" ::: "memory");
    const int c = lane & 7;
#pragma unroll
    for (int j = 0; j < 4; ++j) { const int n = (lane >> 3) + 8 * j; const LAS float* s = scr + (8 * c) * 33 + n;
        u32x4 o; o.x = cvt_pk_bf16(s[0 * 33], s[1 * 33]); o.y = cvt_pk_bf16(s[2 * 33], s[3 * 33]); o.z = cvt_pk_bf16(s[4 * 33], s[5 * 33]); o.w = cvt_pk_bf16(s[6 * 33], s[7 * 33]);
        *(u32x4*)(WT + (size_t)(row0 + n) * K + k0 + 8 * c) = o; }
    asm volatile("s_waitcnt lgkmcnt(0)" ::: "memory");
}
typedef float f32x16v __attribute__((ext_vector_type(16)));
typedef unsigned u32x6 __attribute__((ext_vector_type(6)));
constexpr int ROWB = 768;
__device__ __forceinline__ void task_quant_rows4(const float* src, unsigned char* dst, float* scale_out, int lane) {
    const int g = lane & 31, hh = lane >> 5;
    f32x4 v[2][8];
#pragma unroll
    for (int r = 0; r < 2; ++r)
#pragma unroll
        for (int i = 0; i < 8; ++i) v[r][i] = *(const f32x4*)(src + (size_t)(2 * r + hh) * D + g * 32 + i * 4);
#pragma unroll
    for (int r = 0; r < 2; ++r) {
        float am = 0.f;
#pragma unroll
        for (int i = 0; i < 8; ++i) am = fmaxf(fmaxf(am, fmaxf(fabsf(v[r][i][0]), fabsf(v[r][i][1]))), fmaxf(fabsf(v[r][i][2]), fabsf(v[r][i][3])));
#pragma unroll
        for (int o = 1; o < 32; o <<= 1) am = fmaxf(am, __shfl_xor(am, o));
        const float inv = am > 0.f ? 7.5f / am : 0.f;
        f32x16v a, b;
#pragma unroll
        for (int i = 0; i < 4; ++i)
#pragma unroll
            for (int j = 0; j < 4; ++j) { const int e0 = 4 * i + j;
                a[e0] = v[r][(2 * e0) >> 2][(2 * e0) & 3] * inv; b[e0] = v[r][(2 * e0 + 1) >> 2][(2 * e0 + 1) & 3] * inv; }
        const u32x6 p = __builtin_amdgcn_cvt_scalef32_2xpk16_fp6_f32(a, b, 1.0f);
        unsigned char* rowp = dst + (size_t)(2 * r + hh) * ROWB;
        *(u32x4*)(rowp + g * 16) = (u32x4){p[0], p[1], p[2], p[3]}; *(u32x2*)(rowp + 512 + g * 8) = (u32x2){p[4], p[5]};
        if (g == 0) scale_out[2 * r + hh] = am * (1.f / 7.5f);
    }
}
__device__ __forceinline__ bf16x8 ld8_f32_bf16(const float* p) { const f32x4 a = *(const f32x4*)p, b = *(const f32x4*)(p + 4); u32x4 w = {cvt_pk_bf16(a[0], a[1]), cvt_pk_bf16(a[2], a[3]), cvt_pk_bf16(b[0], b[1]), cvt_pk_bf16(b[2], b[3])}; return *reinterpret_cast<bf16x8*>(&w); }
__device__ __forceinline__ void task_wprime(const Args& A, int id, int lane) {
    const int hp = id >> 7, rem = id & 127, n0 = (rem >> 5) * 32, k0 = (rem & 31) * 32, r32 = lane & 31, hi = lane >> 5;
    f32x16 acc = {};
    const float* ka = A.keys + ((size_t)(hp * 128 + n0 + r32)) * 128 + hi * 8;
    const float* wb = A.wq + (size_t)(k0 + r32) * PW + hp * 128 + hi * 8;
#pragma unroll
    for (int s = 0; s < 8; ++s) acc = __builtin_amdgcn_mfma_f32_32x32x16_bf16(ld8_f32_bf16(ka + s * 16), ld8_f32_bf16(wb + s * 16), acc, 0, 0, 0);
    bf16_t* o = (bf16_t*)(A.ws + WS_WP);
#pragma unroll
    for (int r = 0; r < 16; ++r) { const int n = (r & 3) + 8 * (r >> 2) + 4 * hi; o[(size_t)(hp * 128 + n0 + n) * D + k0 + r32] = (bf16_t)(cvt_pk_bf16(acc[r], 0.f) & 0xffffu); }
}
__device__ __forceinline__ void phase_prologue(const Args& A, LAS unsigned char* lds) {
    const int tid = threadIdx.x, lane = tid & 63, wave = __builtin_amdgcn_readfirstlane(tid >> 6);
    LAS float* sc = (LAS float*)lds;
    for (int i = tid; i < 9 * D; i += 512) { const float v = i < 8 * D ? A.c[i] : A.c_ctx[i - 8 * D]; sc[i] = v / (1.f + __expf(-v)); }
    __syncthreads();
    LAS float* scr = (LAS float*)(lds + 36864 + wave * 8448);
    constexpr int T_MOD = NMOD / 8, T_WIN = (D / 64) * (INW / 32), T_SQ = (D / 64) * (D / 32), T_UV = 2 * NEXP / 4, T_WP = 2048, T_ROPE = 1;
    constexpr int NT = T_MOD + T_WIN + 3 * T_SQ + T_UV + T_WP + T_ROPE;
    const int G = gridDim.x;
    for (int task = wave * G + blockIdx.x; task < NT; task += NWAVES * G) {
        int r = task;
        if (r < T_MOD) { task_mod(A, r, lane, sc); continue; } r -= T_MOD;
        if (r < T_WIN) { const int nblk = INW / 32, kb = r / nblk, nb = r % nblk; task_transpose(A.w_in, D, INW, (bf16_t*)(A.ws + WS_WIN), 64 * kb, 32 * nb, win_row(32 * nb), scr, lane); continue; } r -= T_WIN;
        if (r < 3 * T_SQ) { const int wsel = r / T_SQ, q = r % T_SQ, kb = q / 32, nb = q % 32;
            const float* W = wsel == 0 ? A.w_ao : (wsel == 1 ? A.w_co : A.w_o); bf16_t* WT = (bf16_t*)(A.ws + (wsel == 0 ? WS_WA : (wsel == 1 ? WS_WC : WS_WO)));
            task_transpose(W, D, D, WT, 64 * kb, 32 * nb, 32 * nb, scr, lane); continue; } r -= 3 * T_SQ;
        if (r < T_UV) { const int tb = r / (NEXP / 4), row = (r % (NEXP / 4)) * 4; unsigned char* tbase = A.ws + (tb ? WS_VT : WS_UT);
            task_quant_rows4((tb ? A.vt : A.ut) + (size_t)row * D, tbase + (size_t)row * ROWB, (float*)(tbase + WS_TSCALE) + row, lane); continue; } r -= T_UV;
        if (r < T_WP) { task_wprime(A, r, lane); continue; } r -= T_WP;
        { float* cs = (float*)(A.ws + WS_ROPE); float* sn = cs + 2048;
          for (int e = lane; e < 2048; e += 64) { const int p = e >> 5, i = e & 31; const float inv = powf(10000.f, -(float)(2 * i) / 64.f); const float a = (float)p * inv; cs[e] = cosf(a); sn[e] = sinf(a); } }
    }
}
__device__ __forceinline__ void normmod_row(const float* xr, const float* g, const float* modr, int sh_off, int sc_off, bf16_t* orow, int lane) {
    f32x4 v[4]; float ss = 0.f;
#pragma unroll
    for (int i = 0; i < 4; ++i) { v[i] = *(const f32x4*)(xr + (i * 64 + lane) * 4); ss += (v[i][0] * v[i][0] + v[i][1] * v[i][1]) + (v[i][2] * v[i][2] + v[i][3] * v[i][3]); }
    const float r = rsqrtf(wave_sum(ss) * (1.f / D) + EPS);
#pragma unroll
    for (int i = 0; i < 4; ++i) { const int k = (i * 64 + lane) * 4; const f32x4 gg = *(const f32x4*)(g + k), s1 = *(const f32x4*)(modr + sc_off + k), h1 = *(const f32x4*)(modr + sh_off + k);
        float y[4];
#pragma unroll
        for (int j = 0; j < 4; ++j) y[j] = v[i][j] * r * gg[j] * (1.f + s1[j]) + h1[j];
        u32x2 o = {cvt_pk_bf16(y[0], y[1]), cvt_pk_bf16(y[2], y[3])}; *(u32x2*)(orow + k) = o; }
}
__device__ __forceinline__ void phase_hx(const Args& A) {
    const int lane = threadIdx.x & 63, gw = blockIdx.x * NWAVES + (threadIdx.x >> 6), NGW = gridDim.x * NWAVES;
    const float* mod = (const float*)(A.ws + WS_MOD);
    for (int m = gw; m < M + MC; m += NGW) {
        if (m < M) normmod_row(A.x + (size_t)m * D, A.n1g, mod + (m >> 12) * NMOD, 0, D, (bf16_t*)(A.ws + WS_HX) + (size_t)m * D, lane);
        else { const int r = m - M; normmod_row(A.ctx + (size_t)r * D, A.n1g, mod + 8 * NMOD, 0, D, (bf16_t*)(A.ws + WS_HC) + (size_t)r * D, lane); }
    }
    const bf16_t* WP = (const bf16_t*)(A.ws + WS_WP); float* sb = (float*)(A.ws + WS_SBIAS);
    for (int col = gw; col < PW; col += NGW) {
        const u32x4 w0 = *(const u32x4*)(WP + (size_t)col * D + lane * 16), w1 = *(const u32x4*)(WP + (size_t)col * D + lane * 16 + 8);
        float wv[16];
#pragma unroll
        for (int j = 0; j < 4; ++j) { wv[2 * j] = bf_lo(w0[j]); wv[2 * j + 1] = bf_hi(w0[j]); wv[8 + 2 * j] = bf_lo(w1[j]); wv[8 + 2 * j + 1] = bf_hi(w1[j]); }
#pragma unroll 1
        for (int b = 0; b < NB; ++b) { const float* sh = mod + b * NMOD + 3 * D + lane * 16; float s = 0.f;
#pragma unroll
            for (int q = 0; q < 4; ++q) { const f32x4 v = *(const f32x4*)(sh + 4 * q); s += v[0] * wv[4 * q] + v[1] * wv[4 * q + 1] + v[2] * wv[4 * q + 2] + v[3] * wv[4 * q + 3]; }
            s = wave_sum(s); if (lane == 0) sb[b * PW + col] = s; }
    }
}
__device__ __forceinline__ void phase_kfix(const Args& A) {
    const int lane = threadIdx.x & 63, gw = blockIdx.x * NWAVES + (threadIdx.x >> 6), NGW = gridDim.x * NWAVES, li = lane & 15, sub = lane >> 4;
    const bf16_t* KB = (const bf16_t*)(A.ws + WS_KB); const float* cs = (const float*)(A.ws + WS_ROPE); const float* sn = cs + 2048;
    constexpr int NITEM = NB * SKV * HKV;
    const f32x4 g0 = *(const f32x4*)(A.kng + li * 8), g1 = *(const f32x4*)(A.kng + li * 8 + 4);
    const f32x4 p0 = *(const f32x4*)(A.kng + (li ^ 4) * 8), p1 = *(const f32x4*)(A.kng + (li ^ 4) * 8 + 4);
    for (int it = gw * 4 + sub; it < NITEM; it += NGW * 4) {
        const int row = it >> 1, h = it & 1, t = row % SKV;
        const bf16_t* p = KB + (size_t)row * 256 + h * HD + li * 8;
        const u32x4 w = *(const u32x4*)p;
        float x[8], xp[8]; float ss = 0.f;
#pragma unroll
        for (int j = 0; j < 4; ++j) { x[2 * j] = bf_lo(w[j]); x[2 * j + 1] = bf_hi(w[j]); ss += x[2 * j] * x[2 * j] + x[2 * j + 1] * x[2 * j + 1];
            const unsigned pw = (unsigned)__shfl_xor((int)w[j], 4); xp[2 * j] = bf_lo(pw); xp[2 * j + 1] = bf_hi(pw); }
        ss += __shfl_xor(ss, 1); ss += __shfl_xor(ss, 2); ss += __shfl_xor(ss, 4); ss += __shfl_xor(ss, 8);
        const float r = rsqrtf(ss * (1.f / HD) + EPS);
        float y[8];
#pragma unroll
        for (int j = 0; j < 8; ++j) { x[j] *= r * (j < 4 ? g0[j] : g1[j - 4]); xp[j] *= r * (j < 4 ? p0[j] : p1[j - 4]); y[j] = x[j]; }
        if (t < S) {
            const int blk = li >> 3, pos = blk == 0 ? (t >> 6) : (t & 63), second = (li >> 2) & 1, i0 = (li & 3) * 8;
            const f32x4 c0 = *(const f32x4*)(cs + pos * 32 + i0), c1 = *(const f32x4*)(cs + pos * 32 + i0 + 4), s0 = *(const f32x4*)(sn + pos * 32 + i0), s1 = *(const f32x4*)(sn + pos * 32 + i0 + 4);
#pragma unroll
            for (int j = 0; j < 8; ++j) { const float c = j < 4 ? c0[j] : c1[j - 4], s = j < 4 ? s0[j] : s1[j - 4];
                y[j] = second ? (xp[j] * s + x[j] * c) : (x[j] * c - xp[j] * s); }
        }
        u32x2 o = {(unsigned)att::pk4_fp8(y[0] * 16.f, y[1] * 16.f, y[2] * 16.f, y[3] * 16.f), (unsigned)att::pk4_fp8(y[4] * 16.f, y[5] * 16.f, y[6] * 16.f, y[7] * 16.f)};
        *(u32x2*)(A.ws + WS_K8 + (size_t)row * 256 + h * HD + li * 8) = o;
    }
}
__device__ __forceinline__ void phase_vt(const Args& A, LAS unsigned char* lds) {
    const int lane = threadIdx.x & 63, wave = threadIdx.x >> 6, gw = blockIdx.x * NWAVES + wave, NGW = gridDim.x * NWAVES;
    LAS unsigned char* tl = lds + wave * 4096;
    const bf16_t* VB = (const bf16_t*)(A.ws + WS_VB);
    const int kk = lane & 31, pos = 32 * ((kk >> 2) & 1) + (kk & 3) + 4 * (kk >> 3) + 16 * (lane >> 5);
    constexpr int NTILE = SKV / 64;
    for (int it2 = gw; it2 < NB * HKV * NTILE * 2; it2 += NGW) {
        const int dh = it2 & 1, it = it2 >> 1, j = it % NTILE, bk = it / NTILE, b = bk >> 1, kv = bk & 1;
        const bf16_t* src = VB + ((size_t)b * SKV + j * 64 + lane) * 256 + kv * HD + dh * 64;
        u32x4 w[8];
#pragma unroll
        for (int c = 0; c < 8; ++c) w[c] = *(const u32x4*)(src + c * 8);
#pragma unroll
        for (int c = 0; c < 8; ++c)
#pragma unroll
            for (int q = 0; q < 4; ++q) { const int pk = __builtin_amdgcn_cvt_pk_fp8_f32(bf_lo(w[c][q]) * 16.f, bf_hi(w[c][q]) * 16.f, 0, false);
                tl[(c * 8 + 2 * q) * 64 + pos] = (unsigned char)(pk & 0xff); tl[(c * 8 + 2 * q + 1) * 64 + pos] = (unsigned char)((pk >> 8) & 0xff); }
        asm volatile("s_waitcnt lgkmcnt(0)" ::: "memory");
        unsigned char* dst = A.ws + WS_VT8 + (size_t)it * 8192 + dh * 4096;
#pragma unroll
        for (int i = 0; i < 4; ++i) *(u32x4*)(dst + (i * 64 + lane) * 16) = *(const LAS u32x4*)(tl + (i * 64 + lane) * 16);
        asm volatile("s_waitcnt lgkmcnt(0)" ::: "memory");
    }
}
template <int R> struct ConvRow {
    static __device__ __forceinline__ void run(const unsigned* gp, int tl0, float (&acc)[32][2], const float (&w)[31][2]) {
        const int tl = tl0 + R - 15;
        unsigned v = 0u; if (tl >= 0 && tl < S) v = gp[(long)(R - 15) * (D / 2)];
        const float a = bf_lo(v), b = bf_hi(v);
#pragma unroll
        for (int t = (R - 30 > 0 ? R - 30 : 0); t <= (R < 31 ? R : 31); ++t) { acc[t][0] += w[R - t][0] * a; acc[t][1] += w[R - t][1] * b; }
        if constexpr (R + 1 < 62) ConvRow<R + 1>::run(gp, tl0, acc, w);
    }
};
__device__ __forceinline__ void phase_conv(const Args& A, LAS unsigned char* lds) {
    const int tid = threadIdx.x, lane = tid & 63, wave = tid >> 6;
    LAS float* tile = (LAS float*)lds;
    const bf16_t* G = (const bf16_t*)(A.ws + WS_G); bf16_t* CV = (bf16_t*)(A.ws + WS_HX);
    float w[31][2];
#pragma unroll
    for (int j = 0; j < 31; ++j) { const f32x2 t = *(const f32x2*)(A.cdw + j * D + 2 * tid); w[j][0] = t[0]; w[j][1] = t[1]; }
    const f32x2 bias = *(const f32x2*)(A.cb + 2 * tid);
    for (int tileid = blockIdx.x; tileid < M / 32; tileid += gridDim.x) {
        const int row0 = tileid * 32, tl0 = row0 & (S - 1);
        float acc[32][2];
#pragma unroll
        for (int t = 0; t < 32; ++t) { acc[t][0] = bias[0]; acc[t][1] = bias[1]; }
        ConvRow<0>::run((const unsigned*)(G + (size_t)row0 * D) + tid, tl0, acc, w);
        __syncthreads();
#pragma unroll
        for (int t = 0; t < 32; ++t) *(LAS f32x2*)(tile + t * D + 2 * tid) = (f32x2){acc[t][0], acc[t][1]};
        __syncthreads();
#pragma unroll
        for (int q = 0; q < 4; ++q) { const int t = wave * 4 + q; const LAS float* tr = tile + t * D;
            f32x4 v[4]; float s = 0.f;
#pragma unroll
            for (int i = 0; i < 4; ++i) { v[i] = *(const LAS f32x4*)(tr + (i * 64 + lane) * 4); s += (v[i][0] + v[i][1]) + (v[i][2] + v[i][3]); }
            const float mu = wave_sum(s) * (1.f / D); float qq = 0.f;
#pragma unroll
            for (int i = 0; i < 4; ++i) { v[i] = v[i] - mu; qq += (v[i][0] * v[i][0] + v[i][1] * v[i][1]) + (v[i][2] * v[i][2] + v[i][3] * v[i][3]); }
            const float rs = rsqrtf(wave_sum(qq) * (1.f / D) + EPS);
#pragma unroll
            for (int i = 0; i < 4; ++i) { const int k = (i * 64 + lane) * 4; const f32x4 gg = *(const f32x4*)(A.clg + k), bb = *(const f32x4*)(A.clb + k); float y[4];
#pragma unroll
                for (int j = 0; j < 4; ++j) { const float z = v[i][j] * rs * gg[j] + bb[j]; y[j] = z * fast_sigmoid(z); }
                u32x2 o = {cvt_pk_bf16(y[0], y[1]), cvt_pk_bf16(y[2], y[3])}; *(u32x2*)(CV + (size_t)(row0 + t) * D + k) = o; }
        }
    }
}
struct EpiInProj {
    static constexpr bool PERM = true;
    unsigned char* ws;
    __device__ __forceinline__ void operator()(f32x4 (&acc)[2][2][4][2], const pg8::Unit& u, int wr, int wc, int fr, int fq) const {
        const int c8 = wc * 32 + 8 * fq;
#pragma unroll
        for (int ai = 0; ai < 2; ++ai)
#pragma unroll
            for (int m = 0; m < 4; ++m) {
                const int row = u.pm * 256 + ai * 128 + wr * 64 + m * 16 + fr;
                if (u.kind == 0) {
                    bf16_t* p = (bf16_t*)(ws + WS_Q) + (size_t)row * D + u.pn * 256 + c8;
#pragma unroll
                    for (int bj = 0; bj < 2; ++bj) { const f32x4 v0 = acc[ai][bj][m][0], v1 = acc[ai][bj][m][1];
                        u32x4 w = {cvt_pk_bf16(v0[0], v0[1]), cvt_pk_bf16(v0[2], v0[3]), cvt_pk_bf16(v1[0], v1[1]), cvt_pk_bf16(v1[2], v1[3])}; *(u32x4*)(p + bj * 128) = w; }
                } else if (u.kind == 1 || u.kind == 2 || u.kind == 5 || u.kind == 6) {
                    const bool ctxu = u.kind >= 5;
                    const int kvrow = ctxu ? (row >> 8) * SKV + S + (row & 255) : (row >> 12) * SKV + (row & (S - 1));
                    bf16_t* p = (bf16_t*)(ws + ((u.kind == 1 || u.kind == 5) ? WS_KB : WS_VB)) + (size_t)kvrow * 256 + c8;
#pragma unroll
                    for (int bj = 0; bj < 2; ++bj) { const f32x4 v0 = acc[ai][bj][m][0], v1 = acc[ai][bj][m][1];
                        u32x4 w = {cvt_pk_bf16(v0[0], v0[1]), cvt_pk_bf16(v0[2], v0[3]), cvt_pk_bf16(v1[0], v1[1]), cvt_pk_bf16(v1[2], v1[3])}; *(u32x4*)(p + bj * 128) = w; }
                } else if (u.kind == 3) {
                    float g[8];
#pragma unroll
                    for (int n = 0; n < 2; ++n)
#pragma unroll
                        for (int j = 0; j < 4; ++j) g[4 * n + j] = acc[ai][0][m][n][j] * fast_sigmoid(acc[ai][1][m][n][j]);
                    u32x4 w = {cvt_pk_bf16(g[0], g[1]), cvt_pk_bf16(g[2], g[3]), cvt_pk_bf16(g[4], g[5]), cvt_pk_bf16(g[6], g[7])};
                    *(u32x4*)((bf16_t*)(ws + WS_G) + (size_t)row * D + (u.pn - 6) * 128 + c8) = w;
                } else {
                    float rt[8], sg[8];
#pragma unroll
                    for (int n = 0; n < 2; ++n)
#pragma unroll
                        for (int j = 0; j < 4; ++j) { const float ea = __builtin_amdgcn_exp2f(-1.4426950408889634f * acc[ai][0][m][n][j]), ec = __builtin_amdgcn_exp2f(-1.4426950408889634f * acc[ai][1][m][n][j]);
                            sg[4 * n + j] = __builtin_amdgcn_rcpf(1.f + ec); rt[4 * n + j] = (1.f + ec) * __builtin_amdgcn_rcpf(1.f + ea); }
                    const size_t off = (size_t)row * D + (u.pn - 14) * 128 + c8;
                    u32x4 w = {cvt_pk_bf16(rt[0], rt[1]), cvt_pk_bf16(rt[2], rt[3]), cvt_pk_bf16(rt[4], rt[5]), cvt_pk_bf16(rt[6], rt[7])}; *(u32x4*)((bf16_t*)(ws + WS_RT) + off) = w;
                    u32x4 w2 = {cvt_pk_bf16(sg[0], sg[1]), cvt_pk_bf16(sg[2], sg[3]), cvt_pk_bf16(sg[4], sg[5]), cvt_pk_bf16(sg[6], sg[7])}; *(u32x4*)((bf16_t*)(ws + WS_SGC) + off) = w2;
                }
            }
    }
};
struct SchedInProj {
    const char* hx; const char* hc; const char* w; int G, c;
    __device__ __forceinline__ bool next(int i, pg8::Unit& u) const {
        constexpr int nM = M / 256, nN = INW / 256, NMAIN = nM * nN, NCTX = (MC / 256) * 2;
        const int L = i * G + c; if (L >= NMAIN + NCTX) return false;
        if (L < NMAIN) { pg8::tile_of(L, nM, nN, u.pm, u.pn); u.a = hx + (size_t)u.pm * 256 * D * 2; u.kind = u.pn < 4 ? 0 : (u.pn == 4 ? 1 : (u.pn == 5 ? 2 : (u.pn < 14 ? 3 : 4))); }
        else { const int j = L - NMAIN; u.pm = j >> 1; u.pn = 4 + (j & 1); u.a = hc + (size_t)u.pm * 256 * D * 2; u.kind = 5 + (j & 1); }
        u.b = w + (size_t)u.pn * 256 * D * 2; u.keep = 0; return true;
    }
};
struct EpiMerge {
    static constexpr bool PERM = true;
    unsigned char* ws;
    __device__ __forceinline__ void operator()(f32x4 (&acc)[2][2][4][2], const pg8::Unit& u, int wr, int wc, int fr, int fq) const {
        const int c8 = u.pn * 256 + wc * 32 + 8 * fq;
        const bf16_t* __restrict__ F = (const bf16_t*)(ws + (u.kind == 0 ? WS_RT : WS_SGC));
#pragma unroll
        for (int ai = 0; ai < 2; ++ai)
#pragma unroll
            for (int m = 0; m < 4; ++m) { const size_t off = (size_t)(u.pm * 256 + ai * 128 + wr * 64 + m * 16 + fr) * D + c8;
#pragma unroll
                for (int bj = 0; bj < 2; ++bj) { const u32x4 f = *(const u32x4*)(F + off + bj * 128);
                    f32x4 v0 = acc[ai][bj][m][0], v1 = acc[ai][bj][m][1];
                    v0[0] *= bf_lo(f[0]); v0[1] *= bf_hi(f[0]); v0[2] *= bf_lo(f[1]); v0[3] *= bf_hi(f[1]); v1[0] *= bf_lo(f[2]); v1[1] *= bf_hi(f[2]); v1[2] *= bf_lo(f[3]); v1[3] *= bf_hi(f[3]);
                    if (u.kind == 0) { acc[ai][bj][m][0] = v0; acc[ai][bj][m][1] = v1; }
                    else { u32x4 w = {cvt_pk_bf16(v0[0], v0[1]), cvt_pk_bf16(v0[2], v0[3]), cvt_pk_bf16(v1[0], v1[1]), cvt_pk_bf16(v1[2], v1[3])}; *(u32x4*)((bf16_t*)(ws + WS_G) + off + bj * 128) = w; } } }
    }
};
struct SchedMerge {
    const char* att; const char* cv; const char* wa; const char* wc; int G, c;
    __device__ __forceinline__ bool next(int i, pg8::Unit& u) const {
        constexpr int nM = M / 256, nN = D / 256;
        const int L = (i >> 1) * G + c, sub = i & 1; if (L >= nM * nN) return false;
        pg8::tile_of(L, nM, nN, u.pm, u.pn);
        u.a = (sub ? cv : att) + (size_t)u.pm * 256 * D * 2; u.b = (sub ? wc : wa) + (size_t)u.pn * 256 * D * 2; u.kind = sub; u.keep = sub ^ 1; return true;
    }
};
struct SchedPlain {
    const char* a; const char* b; int nM, nN, G, c;
    __device__ __forceinline__ bool next(int i, pg8::Unit& u) const {
        const int L = i * G + c; if (L >= nM * nN) return false;
        pg8::tile_of(L, nM, nN, u.pm, u.pn); u.a = a + (size_t)u.pm * 256 * D * 2; u.b = b + (size_t)u.pn * 256 * D * 2; u.kind = 0; u.keep = 0; return true;
    }
};
struct EpiOut {
    static constexpr bool PERM = false;
    const float* __restrict__ x; const float* __restrict__ mod; const float* __restrict__ n2g; float* __restrict__ xs; bf16_t* __restrict__ xg; float* __restrict__ ssq;
    __device__ __forceinline__ void operator()(f32x4 (&acc)[2][2][4][2], const pg8::Unit& u, int wr, int wc, int fr, int fq) const {
        const int col0 = u.pn * 256 + wc * 32 + 4 * fq; const float* mb = mod + ((u.pm * 256) >> 12) * NMOD;
        f32x4 gv[2][2], nv[2][2];
#pragma unroll
        for (int bj = 0; bj < 2; ++bj)
#pragma unroll
            for (int n = 0; n < 2; ++n) { const int c = col0 + bj * 128 + n * 16; gv[bj][n] = *(const f32x4*)(mb + 2 * D + c); nv[bj][n] = *(const f32x4*)(n2g + c) * (*(const f32x4*)(mb + 4 * D + c) + 1.f); }
        f32x4 xa[2][2], xb[2][2];
#define XLOAD(dst, k) do { _Pragma("unroll") for (int bj = 0; bj < 2; ++bj) _Pragma("unroll") for (int n = 0; n < 2; ++n) \
            dst[bj][n] = *(const f32x4*)(x + (size_t)(u.pm * 256 + ((k) >> 2) * 128 + wr * 64 + ((k) & 3) * 16 + fr) * D + col0 + bj * 128 + n * 16); } while (0)
#define XDONE(src, k) do { const int ai = (k) >> 2, m = (k) & 3; const int row = u.pm * 256 + ai * 128 + wr * 64 + m * 16 + fr; const size_t off = (size_t)row * D + col0; float ss = 0.f; \
            _Pragma("unroll") for (int bj = 0; bj < 2; ++bj) _Pragma("unroll") for (int n = 0; n < 2; ++n) { const f32x4 v = src[bj][n] + gv[bj][n] * acc[ai][bj][m][n]; *(f32x4*)(xs + off + bj * 128 + n * 16) = v; \
                ss += (v[0] * v[0] + v[1] * v[1]) + (v[2] * v[2] + v[3] * v[3]); const f32x4 g = v * nv[bj][n]; \
                u32x2 w = {cvt_pk_bf16(g[0], g[1]), cvt_pk_bf16(g[2], g[3])}; *(u32x2*)(xg + off + bj * 128 + n * 16) = w; } \
            ss += __shfl_xor(ss, 16); ss += __shfl_xor(ss, 32); if (fq == 0) ssq[(size_t)row * 16 + u.pn * 4 + wc] = ss; } while (0)
        XLOAD(xa, 0); XLOAD(xb, 1); XDONE(xa, 0); XLOAD(xa, 2); XDONE(xb, 1); XLOAD(xb, 3); XDONE(xa, 2); XLOAD(xa, 4); XDONE(xb, 3); XLOAD(xb, 5); XDONE(xa, 4); XLOAD(xa, 6); XDONE(xb, 5); XLOAD(xb, 7); XDONE(xa, 6); XDONE(xb, 7);
#undef XLOAD
#undef XDONE
    }
};
__device__ __forceinline__ float row_rstd(const float* ssq, int row) {
    const f32x4 a = *(const f32x4*)(ssq + (size_t)row * 16), b = *(const f32x4*)(ssq + (size_t)row * 16 + 4), c = *(const f32x4*)(ssq + (size_t)row * 16 + 8), d = *(const f32x4*)(ssq + (size_t)row * 16 + 12);
    const float s = ((a[0] + a[1]) + (a[2] + a[3])) + ((b[0] + b[1]) + (b[2] + b[3])) + ((c[0] + c[1]) + (c[2] + c[3])) + ((d[0] + d[1]) + (d[2] + d[3]));
    return rsqrtf(s * (1.f / D) + EPS);
}
struct EpiScores {
    static constexpr bool PERM = false;
    float* sc; const float* ssq; const float* sbias;
    __device__ __forceinline__ void operator()(f32x4 (&acc)[2][2][4][2], const pg8::Unit& u, int wr, int wc, int fr, int fq) const {
        const float* sb = sbias + ((u.pm * 256) >> 12) * PW + u.pn * 256 + wc * 32 + 4 * fq;
        f32x4 bv[2][2];
#pragma unroll
        for (int bj = 0; bj < 2; ++bj)
#pragma unroll
            for (int n = 0; n < 2; ++n) bv[bj][n] = *(const f32x4*)(sb + bj * 128 + n * 16);
#pragma unroll
        for (int ai = 0; ai < 2; ++ai)
#pragma unroll
            for (int m = 0; m < 4; ++m) { const int row = u.pm * 256 + ai * 128 + wr * 64 + m * 16 + fr; float* p = sc + (size_t)(row >> 2) * 8192 + (row & 3) * 4; const float rs = row_rstd(ssq, row);
#pragma unroll
                for (int bj = 0; bj < 2; ++bj)
#pragma unroll
                    for (int n = 0; n < 2; ++n) { const int grp = u.pn * 2 + bj, nq = wc * 8 + n * 4 + fq; *(f32x4*)(p + (grp * 32 + nq) * 16) = acc[ai][bj][m][n] * rs + bv[bj][n]; } }
    }
};

#ifndef PROBE_HALFKEYS
#define PROBE_HALFKEYS 0
#endif
__device__ __forceinline__ void phase_attn(const Args& A, unsigned char* lds) {
    const int G = gridDim.x, X = blockIdx.x & 7, j = blockIdx.x >> 3, perx = G >> 3;
    bf16_t* Q = (bf16_t*)(A.ws + WS_Q); const unsigned char* K8 = A.ws + WS_K8; const unsigned char* VT8 = A.ws + WS_VT8;
    const float* cs = (const float*)(A.ws + WS_ROPE); const float* sn = cs + 2048;
    for (int idx = j; idx < 128; idx += perx) {
        const int grp = 2 * X + (idx >> 6), uu = idx & 63, b = grp >> 1, kv = grp & 1, h = kv * 4 + (uu >> 4), qb = uu & 15;
        bf16_t* qp = Q + ((size_t)b * S + qb * 256) * D + h * HD;
        bf16_t* op = A.dry ? (bf16_t*)(A.ws + WS_G) + ((size_t)b * S + qb * 256) * D + h * HD : qp;
        att::attn_unit(qp, K8 + (size_t)b * SKV * 256 + kv * HD, VT8 + (size_t)grp * (SKV / 64) * 8192, op, qb * 256, (A.dry && PROBE_HALFKEYS) ? SKV / 2 : SKV, A.qng, cs, sn, (char*)lds);
    }
}

__device__ __forceinline__ float gelu_exact(float v) {
    const float av = fabsf(v), t = __builtin_amdgcn_rcpf(av * 0.2316418882f + 1.0f);
    float q = t * 0.5307027145f + (-0.7265760135f); q = q * t + 0.7107068705f; q = q * t + (-0.142248368f); q = q * t + 0.127414796f; q = q * t;
    const float e = __builtin_amdgcn_exp2f((v * v) * (-0.72134752044f));
    const float m = v * (q * e);
    return v < 0.f ? m : v - m;
}
__device__ __forceinline__ void ins16(float (&t)[16], float v) {
#pragma unroll
    for (int i = 15; i >= 1; --i) t[i] = __builtin_amdgcn_fmed3f(t[i - 1], t[i], v);
    t[0] = fmaxf(t[0], v);
}
typedef float f32x32v __attribute__((ext_vector_type(32)));
__device__ __forceinline__ float key_tag(float v, unsigned keepmask, unsigned tag) { return __uint_as_float((__float_as_uint(v) & keepmask) | tag); }
template <int I, int J> struct CandLoop {
    static __device__ __forceinline__ void run(const float (&a)[16], const float (&b)[16], float (&c)[16]) {
        if constexpr ((I + 1) * (J + 1) <= 16) { ins16(c, key_tag(a[I] + b[J], ~255u, 255u - (unsigned)(I * 16 + J))); CandLoop<I, J + 1>::run(a, b, c); }
        else if constexpr (I + 1 < 16) CandLoop<I + 1, 0>::run(a, b, c);
    }
};
__device__ __forceinline__ void phase_peer(const Args& A, LAS unsigned char* lds) {
    const int lane = threadIdx.x & 63, wave = threadIdx.x >> 6, gw = blockIdx.x * NWAVES + wave, NGW = gridDim.x * NWAVES;
    LAS unsigned char* wl = lds + wave * 10240;
    LAS float* topL = (LAS float*)wl; LAS int* eidA = (LAS int*)(wl + 4096); LAS float* wgtA = (LAS float*)(wl + 6144); LAS float* coefL = (LAS float*)(wl + 8192);
    LAS float* suL = (LAS float*)(wl + 8704); LAS float* svL = (LAS float*)(wl + 9216);
    const float* SC = (const float*)(A.ws + WS_SC); const bf16_t* HX = (const bf16_t*)(A.ws + WS_HX);
    const unsigned char* UT = A.ws + WS_UT; const unsigned char* VT = A.ws + WS_VT; const float* SU = (const float*)(A.ws + WS_UT + WS_TSCALE); const float* SVs = (const float*)(A.ws + WS_VT + WS_TSCALE);
    const float* mod = (const float*)(A.ws + WS_MOD);
#ifdef PROBE_L2SUBSET
    const int idmask = A.dry ? 2047 : 0x7fffffff;
#else
    const int idmask = 0x7fffffff;
#endif
    const float NEG = -3.0e38f;
    const int h = lane >> 3, tk = (lane >> 1) & 3, p = lane & 1, grp = 2 * h + p;
    for (int pass = gw; pass < M / 4; pass += NGW) {
        {
            float t[16];
#pragma unroll
            for (int i = 0; i < 16; ++i) t[i] = NEG;
            const float* sp = SC + (size_t)pass * 8192 + (grp * 128 + tk) * 4;
#pragma unroll 4
            for (int i = 0; i < 32; ++i) { const f32x4 v = *(const f32x4*)(sp + i * 16); const unsigned tg = 127u - 4u * (unsigned)i;
                ins16(t, key_tag(v[0], ~127u, tg)); ins16(t, key_tag(v[1], ~127u, tg - 1u)); ins16(t, key_tag(v[2], ~127u, tg - 2u)); ins16(t, key_tag(v[3], ~127u, tg - 3u)); }
            float pb[16];
#pragma unroll
            for (int i = 0; i < 16; ++i) { pb[i] = __shfl_xor(t[i], 1); topL[lane * 16 + i] = t[i]; }
            float c[16];
#pragma unroll
            for (int i = 0; i < 16; ++i) c[i] = NEG;
            CandLoop<0, 0>::run(t, pb, c);
            float e[16]; float es = 0.f;
#pragma unroll
            for (int k = 0; k < 16; ++k) { e[k] = __expf(c[k] - c[0]); es += e[k]; }
            const float inv = __builtin_amdgcn_rcpf(es);
            asm volatile("s_waitcnt lgkmcnt(0)" ::: "memory");
            if (p == 0) {
#pragma unroll
                for (int k = 0; k < 16; ++k) { const unsigned code = 255u - (__float_as_uint(c[k]) & 255u);
                    const unsigned ia = 127u - (__float_as_uint(topL[lane * 16 + (code >> 4)]) & 127u), ib = 127u - (__float_as_uint(topL[(lane + 1) * 16 + (code & 15u)]) & 127u);
                    eidA[tk * 128 + h * 16 + k] = (int)(ia * 128u + ib); wgtA[tk * 128 + h * 16 + k] = e[k] * inv; }
            }
            asm volatile("s_waitcnt lgkmcnt(0)" ::: "memory");
        }
#pragma unroll 1
        for (int tq = 0; tq < 4; ++tq) {
            const int t = pass * 4 + tq; const LAS int* eidL = eidA + tq * 128; const LAS float* wgtL = wgtA + tq * 128;
            const int g = lane & 31, hh = lane >> 5;
            f32x2 x2[16];
            { const float rs = row_rstd((const float*)(A.ws + WS_SSQ), t); const float* sh = mod + (t >> 12) * NMOD + 3 * D + g * 32; const bf16_t* xp = HX + (size_t)t * D + g * 32;
#pragma unroll
              for (int c = 0; c < 4; ++c) { const u32x4 w = *(const u32x4*)(xp + 8 * c); const f32x4 s0 = *(const f32x4*)(sh + 8 * c), s1 = *(const f32x4*)(sh + 8 * c + 4);
                x2[4 * c] = (f32x2){bf_lo(w[0]) * rs + s0[0], bf_hi(w[0]) * rs + s0[1]}; x2[4 * c + 1] = (f32x2){bf_lo(w[1]) * rs + s0[2], bf_hi(w[1]) * rs + s0[3]};
                x2[4 * c + 2] = (f32x2){bf_lo(w[2]) * rs + s1[0], bf_hi(w[2]) * rs + s1[1]}; x2[4 * c + 3] = (f32x2){bf_lo(w[3]) * rs + s1[2], bf_hi(w[3]) * rs + s1[3]}; } }
            { const int i0 = eidL[lane], i1 = eidL[64 + lane]; suL[lane] = SU[i0]; suL[64 + lane] = SU[i1]; svL[lane] = SVs[i0]; svL[64 + lane] = SVs[i1]; }
            u32x6 bufA[4], bufB[4];
#define LOAD8(buf, TB, hb) do { _Pragma("unroll") for (int r = 0; r < 4; ++r) { const int id = eidL[(hb) * 8 + 2 * r + hh] & idmask; const unsigned char* rp = (TB) + (size_t)id * ROWB; \
                const u32x4 lo = *(const u32x4*)(rp + g * 16); const u32x2 hi2 = *(const u32x2*)(rp + 512 + g * 8); buf[r] = (u32x6){lo[0], lo[1], lo[2], lo[3], hi2[0], hi2[1]}; } } while (0)
#define DOT8(buf, off) do { _Pragma("unroll") for (int r = 0; r < 4; ++r) { const f32x32v dq = __builtin_amdgcn_cvt_scalef32_pk32_f32_fp6(buf[r], 1.0f); f32x2 s2 = {0.f, 0.f}; \
                _Pragma("unroll") for (int j = 0; j < 16; ++j) s2 += (f32x2){dq[2 * j], dq[2 * j + 1]} * x2[j]; \
                pp[(off) + r] = s2[0] + s2[1]; } } while (0)
#define REDUCE16(kb) do { \
            _Pragma("unroll") for (int e = 0; e < 4; ++e) { const bool up = lane & 16; const float keep = up ? pp[e + 4] : pp[e], send = up ? pp[e] : pp[e + 4]; pp[e] = keep + __shfl_xor(send, 16); } \
            _Pragma("unroll") for (int e = 0; e < 2; ++e) { const bool up = lane & 8; const float keep = up ? pp[e + 2] : pp[e], send = up ? pp[e] : pp[e + 2]; pp[e] = keep + __shfl_xor(send, 8); } \
            { const bool up = lane & 4; const float keep = up ? pp[1] : pp[0], send = up ? pp[0] : pp[1]; pp[0] = keep + __shfl_xor(send, 4); } \
            float hsum = pp[0]; hsum += __shfl_xor(hsum, 2); hsum += __shfl_xor(hsum, 1); \
            const int ke = (kb) * 16 + 2 * ((lane >> 2) & 7) + hh; const float su = suL[ke], sv = svL[ke]; \
            const float cf = wgtL[ke] * gelu_exact(hsum * su) * sv; if ((lane & 3) == 0) coefL[ke] = cf; } while (0)
            LOAD8(bufA, UT, 0);
#pragma unroll 1
            for (int kb = 0; kb < 8; ++kb) {
                float pp[8];
                LOAD8(bufB, UT, 2 * kb + 1);
                DOT8(bufA, 0);
                if (kb < 7) LOAD8(bufA, UT, 2 * kb + 2); else LOAD8(bufA, VT, 0);
                DOT8(bufB, 4);
                REDUCE16(kb);
            }
            asm volatile("s_waitcnt lgkmcnt(0)" ::: "memory");
            f32x2 y2[16];
#pragma unroll
            for (int j = 0; j < 16; ++j) y2[j] = (f32x2){0.f, 0.f};
#define VACC8(buf, hb) do { _Pragma("unroll") for (int r = 0; r < 4; ++r) { const float cf = coefL[(hb) * 8 + 2 * r + hh]; const f32x2 cf2 = {cf, cf}; \
                const f32x32v dq = __builtin_amdgcn_cvt_scalef32_pk32_f32_fp6(buf[r], 1.0f); \
                _Pragma("unroll") for (int j = 0; j < 16; ++j) y2[j] += cf2 * (f32x2){dq[2 * j], dq[2 * j + 1]}; } } while (0)
#pragma unroll 1
            for (int kb = 0; kb < 8; ++kb) {
                LOAD8(bufB, VT, 2 * kb + 1);
                VACC8(bufA, 2 * kb);
                if (kb < 7) LOAD8(bufA, VT, 2 * kb + 2);
                VACC8(bufB, 2 * kb + 1);
            }
#undef LOAD8
#undef DOT8
#undef REDUCE16
#undef VACC8
            float yy[16];
#pragma unroll
            for (int j = 0; j < 16; ++j) { const float a = y2[j][0] + __shfl_xor(y2[j][0], 32), b = y2[j][1] + __shfl_xor(y2[j][1], 32); if ((j >> 3) == hh) { yy[2 * (j & 7)] = a; yy[2 * (j & 7) + 1] = b; } }
            const float* g2 = mod + (t >> 12) * NMOD + 5 * D; float* orow = A.out + (size_t)t * D;
            float z[16]; float ss = 0.f;
#pragma unroll
            for (int q = 0; q < 4; ++q) { const int k = g * 32 + hh * 16 + q * 4; const f32x4 xv = *(const f32x4*)(orow + k), gv = *(const f32x4*)(g2 + k);
#pragma unroll
                for (int j = 0; j < 4; ++j) { const float zz = xv[j] + gv[j] * yy[q * 4 + j]; z[q * 4 + j] = zz; ss += zz * zz; } }
            const float r = rsqrtf(wave_sum(ss) * (1.f / D) + EPS);
#pragma unroll
            for (int q = 0; q < 4; ++q) { const int k = g * 32 + hh * 16 + q * 4; const f32x4 fv = *(const f32x4*)(A.fg + k);
                f32x4 o;
#pragma unroll
                for (int j = 0; j < 4; ++j) o[j] = z[q * 4 + j] * r * fv[j];
                if (!A.dry || r < 0.f) *(f32x4*)(orow + k) = o; }
        }
    }
}
#define XB_TMO      128
#define XB_XCNT(j)  (256  + 64 * (j))
#define XB_XSUB(j)  (1280 + 64 * (j))
#define XB_XGEN(j)  (2304 + 64 * (j))
#define XB_TOP      3328
#define XB_TOPGEN   3392
#define XCD_BAR_WORDS 3456
#define XB_SPIN_CAP (1u << 22)
__device__ __forceinline__ unsigned xb_ld(unsigned* p)              { return __hip_atomic_load(p, __ATOMIC_RELAXED, __HIP_MEMORY_SCOPE_AGENT); }
__device__ __forceinline__ unsigned xb_add(unsigned* p, unsigned v) { return __hip_atomic_fetch_add(p, v, __ATOMIC_RELAXED, __HIP_MEMORY_SCOPE_AGENT); }
__device__ __forceinline__ unsigned xb_xcc_id() { return (unsigned)__builtin_amdgcn_s_getreg((3 << 11) | 20) & 0xFu; }
#define XB_SPIN(cond, bar) do { unsigned _sp = 0; while (cond) { __builtin_amdgcn_s_sleep(1); \
    if ((++_sp & 255u) == 0u) { if (xb_ld(&(bar)[XB_TMO])) break; if (_sp > XB_SPIN_CAP) { atomicAdd(&(bar)[XB_TMO], 1u); break; } } } } while (0)
struct XcdBarrier { unsigned* bar; unsigned x; volatile LAS unsigned* st; };
__device__ __forceinline__ XcdBarrier xcd_barrier_post(unsigned* bar, volatile LAS unsigned* st) {
    XcdBarrier b; b.bar = bar; b.x = xb_xcc_id(); b.st = st;
    if (threadIdx.x == 0) (void)xb_add(&bar[XB_XCNT(b.x)], 1u);
    return b;
}
__device__ __forceinline__ void xcd_barrier_complete(unsigned* bar, unsigned x, unsigned& nloc, unsigned& nx) {
    const unsigned G = gridDim.x * gridDim.y * gridDim.z;
    unsigned sum, cnt, mine, sp = 0u;
    for (;;) {
        sum = 0u; cnt = 0u; mine = 0u;
#pragma unroll
        for (unsigned j = 0; j < 16; ++j) { const unsigned c = xb_ld(&bar[XB_XCNT(j)]); sum += c; cnt += (c > 0u) ? 1u : 0u; mine = (j == x) ? c : mine; }
        if (sum == G) break;
        __builtin_amdgcn_s_sleep(1);
        if ((++sp & 255u) == 0u) { if (xb_ld(&bar[XB_TMO])) break; if (sp > XB_SPIN_CAP) { atomicAdd(&bar[XB_TMO], 1u); break; } }
    }
    nloc = mine > 0u ? mine : 1u; nx = cnt > 0u ? cnt : 1u;
}
__device__ __forceinline__ void xcd_barrier(const XcdBarrier& b) {
    asm volatile("s_waitcnt vmcnt(0)" ::: "memory");
    __syncthreads();
    if (threadIdx.x == 0) {
        unsigned* bar = b.bar;
        __builtin_amdgcn_s_waitcnt(0);
        unsigned nloc = b.st[0], nx = b.st[1];
        if (nloc == 0u) { xcd_barrier_complete(bar, b.x, nloc, nx); b.st[0] = nloc; b.st[1] = nx; }
        const unsigned old = xb_add(&bar[XB_XSUB(b.x)], 1u);
        const unsigned gen = old / nloc;
        if (old + 1u == (gen + 1u) * nloc) {
            __builtin_amdgcn_fence(__ATOMIC_RELEASE, "agent");
            asm volatile("s_waitcnt vmcnt(0)" ::: "memory");
            const unsigned og = xb_add(&bar[XB_TOP], 1u);
            const unsigned tg = og / nx;
            if (og + 1u == (tg + 1u) * nx) xb_add(&bar[XB_TOPGEN], 1u);
            else XB_SPIN(xb_ld(&bar[XB_TOPGEN]) == tg, bar);
            __builtin_amdgcn_fence(__ATOMIC_ACQUIRE, "agent");
            xb_add(&bar[XB_XGEN(b.x)], 1u);
            asm volatile("s_waitcnt vmcnt(0)" ::: "memory");
        } else {
            XB_SPIN(xb_ld(&bar[XB_XGEN(b.x)]) == gen, bar);
            __builtin_amdgcn_fence(__ATOMIC_ACQUIRE, "agent");
            asm volatile("s_waitcnt vmcnt(0)" ::: "memory");
        }
    }
    __syncthreads();
}
constexpr int MISC_OFF = 135168;

constexpr int N_PHASES = 9;
__global__ void __launch_bounds__(NWAVES * 64, 2) mega_fwd(Args A) {
    extern __shared__ __attribute__((aligned(16))) unsigned char lds[];
    LAS unsigned char* L = (LAS unsigned char*)lds;
    cg::grid_group grid = cg::this_grid();
    const int lo = A.ph_lo, hi = A.ph_hi, G = gridDim.x, c = blockIdx.x;
#ifndef PH_MASK
#define PH_MASK 0x1FF
#endif
#define IN(k) (((PH_MASK >> (k)) & 1) && lo <= (k) && (k) < hi)
    unsigned* barw = (unsigned*)(A.ws + WS_CTL);
    volatile LAS unsigned* MISC = (volatile LAS unsigned*)(L + MISC_OFF);
    if (threadIdx.x < 2) MISC[threadIdx.x] = 0u;
    if (lo == 0 && hi > 1 && blockIdx.x == 0) for (int i = threadIdx.x; i < XCD_BAR_WORDS; i += NWAVES * 64) barw[i] = 0u;
    XcdBarrier xb; xb.bar = barw; xb.x = 0; xb.st = MISC;
#define SEAM(k) do { if (IN(k) && IN((k) + 1)) { if ((k) == 0) { grid.sync(); xb = xcd_barrier_post(barw, MISC); } else xcd_barrier(xb); } } while (0)
    if (IN(0)) phase_prologue(A, L);
    SEAM(0);
    if (IN(1)) phase_hx(A);
    SEAM(1);
    if (IN(2)) { SchedInProj Sd{(const char*)(A.ws + WS_HX), (const char*)(A.ws + WS_HC), (const char*)(A.ws + WS_WIN), G, c}; EpiInProj E{A.ws};
        pg8::gemm_phase<EpiInProj, SchedInProj, true>(L, D, Sd, E); }
    SEAM(2);
    if (IN(3)) { phase_kfix(A); phase_vt(A, L); __syncthreads(); phase_conv(A, L); }
    SEAM(3);
    if (IN(4)) phase_attn(A, lds);
    SEAM(4);
    if (IN(5)) { SchedMerge Sd{(const char*)(A.ws + WS_Q), (const char*)(A.ws + WS_HX), (const char*)(A.ws + WS_WA), (const char*)(A.ws + WS_WC), G, c}; EpiMerge E{A.ws};
        pg8::gemm_phase<EpiMerge, SchedMerge, true>(L, D, Sd, E); }
    SEAM(5);
    if (IN(6)) { SchedPlain Sd{(const char*)(A.ws + WS_G), (const char*)(A.ws + WS_WO), M / 256, D / 256, G, c};
        EpiOut E{A.x, (const float*)(A.ws + WS_MOD), A.n2g, A.out, (bf16_t*)(A.ws + WS_HX), (float*)(A.ws + WS_SSQ)};
        pg8::gemm_phase<EpiOut, SchedPlain, true>(L, D, Sd, E); }
    SEAM(6);
    if (IN(7)) { SchedPlain Sd{(const char*)(A.ws + WS_HX), (const char*)(A.ws + WS_WP), M / 256, PW / 256, G, c};
        EpiScores E{(float*)(A.ws + WS_SC), (const float*)(A.ws + WS_SSQ), (const float*)(A.ws + WS_SBIAS)};
        pg8::gemm_phase<EpiScores, SchedPlain, true>(L, D, Sd, E); }
    SEAM(7);
    if (IN(8)) phase_peer(A, L);
#undef IN
#undef SEAM
}

#ifndef MK_ONE_LAUNCH
#define MK_ONE_LAUNCH 1
#endif
extern "C" void kernel_launch(void* const* d_in, const int* in_sizes, int n_in, void* d_out, int out_size, void* d_ws, size_t ws_size, hipStream_t stream) {
    static int grid = 0;
    if (grid == 0) {
        if (n_in != 23 || out_size != M * D || ws_size < WS_END) { fprintf(stderr, "kernel_launch: unexpected shapes (n_in %d out %d ws %zu)\n", n_in, out_size, ws_size); grid = -1; return; }
        int dev = 0, cus = 0, per_cu = 0;
        hipGetDevice(&dev); hipDeviceGetAttribute(&cus, hipDeviceAttributeMultiprocessorCount, dev);
        if (hipFuncSetAttribute((const void*)mega_fwd, hipFuncAttributeMaxDynamicSharedMemorySize, LDS_BYTES) != hipSuccess) { fprintf(stderr, "kernel_launch: hipFuncSetAttribute failed\n"); grid = -1; return; }
        if (hipOccupancyMaxActiveBlocksPerMultiprocessor(&per_cu, (const void*)mega_fwd, NWAVES * 64, LDS_BYTES) != hipSuccess || per_cu < 1) { fprintf(stderr, "kernel_launch: occupancy query says %d\n", per_cu); per_cu = 1; }
        (void)hipGetLastError();
        grid = cus * 1;
        if (per_cu < 1) grid = -1;
    }
    if (grid < 0) return;
    Args a{};
    const float** f = (const float**)&a;
    for (int i = 0; i < 23; ++i) f[i] = (const float*)d_in[i];
    a.out = (float*)d_out; a.ws = (unsigned char*)d_ws;
#if MK_ONE_LAUNCH
    a.ph_lo = 0; a.ph_hi = N_PHASES;
    void* args[] = {&a};
    hipError_t e = hipLaunchCooperativeKernel((const void*)mega_fwd, dim3(grid), dim3(NWAVES * 64), args, LDS_BYTES, stream);
    if (e != hipSuccess) fprintf(stderr, "cooperative launch failed: %s (grid %d)\n", hipGetErrorString(e), grid);
#else
#ifndef REPEAT_PH
#define REPEAT_PH -1
#endif
    for (int p = 0; p < N_PHASES; ++p) { a.ph_lo = p; a.ph_hi = p + 1;
        if (p == REPEAT_PH) { a.dry = 1; hipLaunchKernelGGL(mega_fwd, dim3(grid), dim3(NWAVES * 64), LDS_BYTES, stream, a); a.dry = 0; }
        hipLaunchKernelGGL(mega_fwd, dim3(grid), dim3(NWAVES * 64), LDS_BYTES, stream, a); }
#endif
}
```

```cpp
#include <hip/hip_runtime.h>
#include <hip/hip_cooperative_groups.h>
#include <cstdio>
#include <cstdint>
namespace cg = cooperative_groups;

#define LAS __attribute__((address_space(3)))
typedef unsigned short bf16_t;
typedef short bf16x8 __attribute__((ext_vector_type(8)));
typedef short s16x4 __attribute__((ext_vector_type(4)));
typedef float f32x2 __attribute__((ext_vector_type(2)));
typedef float f32x4 __attribute__((ext_vector_type(4)));
typedef float f32x16 __attribute__((ext_vector_type(16)));
typedef unsigned u32x2 __attribute__((ext_vector_type(2)));
typedef unsigned u32x4 __attribute__((ext_vector_type(4)));
typedef __bf16 bf16x2_t __attribute__((ext_vector_type(2)));

constexpr int D = 1024, NB = 8, S = 4096, CTXL = 256, SKV = S + CTXL, HD = 128, HQ = 8, HKV = 2;
constexpr int M = NB * S;
constexpr int MC = NB * CTXL;
constexpr int INW = 5632, NMOD = 6144, NEXP = 16384, PW = 2048;
constexpr float EPS = 1e-6f;

__device__ __forceinline__ unsigned cvt_pk_bf16(float lo, float hi) { f32x2 v = {lo, hi}; bf16x2_t b = __builtin_convertvector(v, bf16x2_t); return __builtin_bit_cast(unsigned, b); }
__device__ __forceinline__ float bf_lo(unsigned u) { return __uint_as_float(u << 16); }
__device__ __forceinline__ float bf_hi(unsigned u) { return __uint_as_float(u & 0xffff0000u); }
__device__ __forceinline__ float fast_sigmoid(float x) { return __builtin_amdgcn_rcpf(1.f + __builtin_amdgcn_exp2f(-1.4426950408889634f * x)); }
__device__ __forceinline__ float wave_sum(float v) {
#pragma unroll
    for (int o = 1; o < 64; o <<= 1) v += __shfl_xor(v, o);
    return v;
}

namespace pg8 {
constexpr int BM = 256, BK = 64, HALF = 128, HTB = HALF * BK * 2  , STAGE_BYTES = 8 * HTB, NXCD = 8, WGM = 8;
__host__ __device__ __forceinline__ int lds_byte(int r, int c) { const int st = (r >> 4) * 2 + (c >> 5), rr = r & 15, cc = c & 31, ob = rr * 64 + cc * 2; return st * 1024 + (ob ^ (((ob >> 9) & 1) << 5)); }
__host__ __device__ __forceinline__ void stage_rc(int b, int& R, int& C) { const int st = b / 1024, sb = b % 1024, swz = sb ^ (((sb >> 9) & 1) << 5); R = (st >> 1) * 16 + swz / 64; C = (st & 1) * 32 + (swz % 64) / 2; }
__host__ __device__ __forceinline__ int perm32(int rho) { const int n = rho >> 4, i = rho & 15; return 8 * (i >> 2) + 4 * n + (i & 3); }

struct Unit { const char* a; const char* b; int pm, pn, kind, keep; };

__device__ __forceinline__ void tile_of(int L, int nM, int nN, int& pm, int& pn) {
    const int nwg = nM * nN; int wgid = L;
    { const int q = nwg / NXCD, r = nwg % NXCD, xcd = wgid % NXCD, off = wgid / NXCD; wgid = (xcd < r ? xcd * (q + 1) : r * (q + 1) + (xcd - r) * q) + off; }
    const int nig = WGM * nN, gid = wgid / nig, fm = gid * WGM, gsz = (nM - fm) < WGM ? (nM - fm) : WGM;
    pm = fm + ((wgid % nig) % gsz); pn = (wgid % nig) / gsz;
}

template <class Epi, class Sched, bool ALIGN_EPI>
__device__ __forceinline__ void gemm_phase(LAS unsigned char* lds, const int K, const Sched& S, const Epi& E) {
    const int tid = threadIdx.x, wid = __builtin_amdgcn_readfirstlane(tid >> 6), lane = tid & 63, wr = wid >> 2, wc = wid & 3, fr = lane & 15, fq = lane >> 4;
    const int nt = K / BK;
    unsigned voffA[2], voffB[2];
#pragma unroll
    for (int i = 0; i < 2; ++i) { int R, C; stage_rc(tid * 16 + i * 8192, R, C); const int Rb = Epi::PERM ? ((R & ~31) + perm32(R & 31)) : R;
        voffA[i] = (unsigned)(R * K + C) * 2u; voffB[i] = (unsigned)(Rb * K + C) * 2u; }
    const size_t kstep = (size_t)(BK * 2);
    const size_t hstep = (size_t)HALF * K * 2;
    const unsigned ldsw = (unsigned)wid * 1024u;
    const int aoff = lds_byte(wr * 64 + fr, fq * 8), boff = lds_byte(wc * 32 + fr, fq * 8);
#define PG8_SA(b, h) (((b) * 2 + (h)) * HTB)
#define PG8_SB(b, h) ((4 + (b) * 2 + (h)) * HTB)
#define PG8_STAGE(bufoff, gbase, voff) do { _Pragma("unroll") for (int _i = 0; _i < 2; ++_i) \
        __builtin_amdgcn_global_load_lds((const unsigned*)((const char*)(gbase) + (voff)[_i]), (LAS unsigned*)(lds + (bufoff) + ldsw + _i * 8192), 16, 0, 0); } while (0)
#define PG8_LDA(dst, b, h) do { _Pragma("unroll") for (int m = 0; m < 4; ++m) _Pragma("unroll") for (int k = 0; k < 2; ++k) dst[m][k] = *(const LAS bf16x8*)(lds + PG8_SA(b, h) + aoff + m * 2048 + k * 1024); } while (0)
#define PG8_LDB(dst, b, h) do { _Pragma("unroll") for (int n = 0; n < 2; ++n) _Pragma("unroll") for (int k = 0; k < 2; ++k) dst[n][k] = *(const LAS bf16x8*)(lds + PG8_SB(b, h) + boff + n * 2048 + k * 1024); } while (0)
#define PG8_MMA(ai, bj, At, Bt) do { __builtin_amdgcn_s_setprio(1); _Pragma("unroll") for (int m = 0; m < 4; ++m) _Pragma("unroll") for (int n = 0; n < 2; ++n) _Pragma("unroll") for (int k = 0; k < 2; ++k) \
        acc[ai][bj][m][n] = __builtin_amdgcn_mfma_f32_16x16x32_bf16(Bt[n][k], At[m][k], acc[ai][bj][m][n], 0, 0, 0); __builtin_amdgcn_s_setprio(0); } while (0)
#define PG8_WAIT_V(n) asm volatile("s_waitcnt vmcnt(" #n ")" ::: "memory")
#define PG8_WAIT_L(n) asm volatile("s_waitcnt lgkmcnt(" #n ")" ::: "memory")
#define PG8_BAR __builtin_amdgcn_s_barrier()
#define PG8_SCHED __builtin_amdgcn_sched_barrier(0)
    Unit cur, nxt; int ui = 0;
    if (!S.next(0, cur)) return;
    f32x4 acc[2][2][4][2];
#pragma unroll
    for (int a = 0; a < 2; ++a)
#pragma unroll
        for (int b = 0; b < 2; ++b)
#pragma unroll
            for (int m = 0; m < 4; ++m)
#pragma unroll
                for (int n = 0; n < 2; ++n) acc[a][b][m][n] = (f32x4){0.f, 0.f, 0.f, 0.f};
    bf16x8 At[4][2], B0[2][2], B1[2][2];
    const char* cA = cur.a; const char* cB = cur.b;
    PG8_STAGE(PG8_SB(0, 0), cB, voffB); PG8_STAGE(PG8_SB(0, 1), cB + hstep, voffB); PG8_STAGE(PG8_SA(0, 0), cA, voffA); PG8_STAGE(PG8_SA(0, 1), cA + hstep, voffA);
    if (wr == 1) PG8_BAR;
    PG8_WAIT_V(2); PG8_BAR;
    PG8_STAGE(PG8_SB(1, 0), cB + kstep, voffB); PG8_STAGE(PG8_SA(1, 0), cA + kstep, voffA); PG8_STAGE(PG8_SB(1, 1), cB + hstep + kstep, voffB);
    PG8_WAIT_V(6); PG8_BAR;
    for (;;) {
        const bool has_next = S.next(ui + 1, nxt);
        const char* nA = has_next ? nxt.a : cA; const char* nB = has_next ? nxt.b : cB;
        for (int t = 0; t < nt; t += 2) {
            const bool last = (t == nt - 2);
            const char* a1 = cA + (size_t)(t + 1) * kstep;
            const char* a2 = last ? nA : cA + (size_t)(t + 2) * kstep; const char* b2 = last ? nB : cB + (size_t)(t + 2) * kstep;
            const char* a3 = a2 + kstep; const char* b3 = b2 + kstep;
            PG8_LDB(B0, 0, 0); PG8_LDB(B1, 0, 1); PG8_SCHED; PG8_LDA(At, 0, 0); PG8_STAGE(PG8_SA(1, 1), a1 + hstep, voffA);
            PG8_WAIT_V(8); PG8_WAIT_L(0); PG8_BAR; PG8_MMA(0, 0, At, B0); PG8_MMA(0, 1, At, B1); PG8_BAR; PG8_SCHED;
            PG8_LDA(At, 0, 1); PG8_STAGE(PG8_SB(0, 0), b2, voffB); PG8_STAGE(PG8_SB(0, 1), b2 + hstep, voffB); PG8_STAGE(PG8_SA(0, 0), a2, voffA);
            PG8_WAIT_V(8); PG8_WAIT_L(0); PG8_BAR; PG8_MMA(1, 0, At, B0); PG8_MMA(1, 1, At, B1); PG8_BAR; PG8_SCHED;
            PG8_LDB(B0, 1, 0); PG8_LDB(B1, 1, 1); PG8_SCHED; PG8_LDA(At, 1, 0); PG8_STAGE(PG8_SA(0, 1), a2 + hstep, voffA);
            PG8_WAIT_V(8); PG8_WAIT_L(0); PG8_BAR; PG8_MMA(0, 0, At, B0); PG8_MMA(0, 1, At, B1); PG8_BAR; PG8_SCHED;
            PG8_LDA(At, 1, 1); PG8_STAGE(PG8_SB(1, 0), b3, voffB); PG8_STAGE(PG8_SB(1, 1), b3 + hstep, voffB); PG8_STAGE(PG8_SA(1, 0), a3, voffA);
            PG8_WAIT_V(8); PG8_WAIT_L(0); PG8_BAR; PG8_MMA(1, 0, At, B0); PG8_MMA(1, 1, At, B1); PG8_BAR; PG8_SCHED;
        }
        if constexpr (ALIGN_EPI) { if (wr == 0) PG8_BAR; }
        E(acc, cur, wr, wc, fr, fq);
        if (!has_next) break;
        if (!cur.keep) {
#pragma unroll
        for (int a = 0; a < 2; ++a)
#pragma unroll
            for (int b = 0; b < 2; ++b)
#pragma unroll
                for (int m = 0; m < 4; ++m)
#pragma unroll
                    for (int n = 0; n < 2; ++n) acc[a][b][m][n] = (f32x4){0.f, 0.f, 0.f, 0.f};
        }
        cur = nxt; cA = nA; cB = nB; ++ui;
        if constexpr (ALIGN_EPI) { if (wr == 1) PG8_BAR; }
    }
    PG8_WAIT_V(0);
    if constexpr (!ALIGN_EPI) { if (wr == 0) PG8_BAR; }
    PG8_BAR;
#undef PG8_SA
#undef PG8_SB
#undef PG8_STAGE
#undef PG8_LDA
#undef PG8_LDB
#undef PG8_MMA
#undef PG8_WAIT_V
#undef PG8_WAIT_L
#undef PG8_BAR
#undef PG8_SCHED
}
}
namespace att {
typedef int v8i __attribute__((ext_vector_type(8)));
constexpr int NW = 8, QBLK = 32, KVBLK = 64;
constexpr float SCALE = 0.088388347648318440f;
constexpr float SC8 = SCALE / 256.f;
constexpr float THR = 3.f;
constexpr int LDQ = D, LDO = D;
constexpr int SHM_V = 8192, SHM_K = 8192, NRING = 3, OFF_K = NRING * SHM_V, OFF_WS = OFF_K + NRING * SHM_K, OST_OFF = OFF_WS + NW * 64 * 4, LDS_TOTAL = OST_OFF + NW * 8192;
#define SBAR() __builtin_amdgcn_sched_barrier(0)
#define MFMA8(a, b, c) __builtin_amdgcn_mfma_scale_f32_32x32x64_f8f6f4((a), (b), (c), 0, 0, 0, 0x7f7f7f7f, 0, 0x7f7f7f7f)
__device__ __forceinline__ int crow(int r, int hi) { return (r & 3) + 8 * (r >> 2) + 4 * hi; }
__device__ __forceinline__ int k_lds(int row, int chunk) { return row * 128 + ((chunk ^ ((row >> 1) & 7)) << 4); }
__device__ __forceinline__ int v_lds(int d, int slot) { return d * 64 + ((slot ^ ((d >> 2) & 3)) << 4); }
__device__ __forceinline__ int pk4_fp8(float a, float b, float c, float d) { int w = __builtin_amdgcn_cvt_pk_fp8_f32(a, b, 0, false); return __builtin_amdgcn_cvt_pk_fp8_f32(c, d, w, true); }

__device__ __forceinline__ void partialSM(f32x16& p0, f32x16& p1, float& m_reg, float& mn, float& alpha) {
  constexpr float C = SC8 * 1.4426950408889634f;
  float mx[8];
#pragma unroll
  for (int i = 0; i < 8; ++i) mx[i] = fmaxf(fmaxf(p0[i], p0[8 + i]), fmaxf(p1[i], p1[8 + i]));
  float pmax = fmaxf(fmaxf(fmaxf(mx[0], mx[1]), fmaxf(mx[2], mx[3])), fmaxf(fmaxf(mx[4], mx[5]), fmaxf(mx[6], mx[7])));
  { auto rr = __builtin_amdgcn_permlane32_swap(__float_as_uint(pmax), __float_as_uint(pmax), false, false);
    pmax = fmaxf(__uint_as_float(rr[0]), __uint_as_float(rr[1])); }
  if (__builtin_expect(__all(pmax - m_reg <= THR / SC8), 1)) { mn = m_reg; alpha = 1.f; }
  else { mn = fmaxf(m_reg, pmax); alpha = __builtin_amdgcn_exp2f((m_reg - mn) * C); m_reg = mn; }
  float mnC = 4.f - mn * C;
  for (int r = 0; r < 16; ++r) p0[r] = fmaf(p0[r], C, mnC); for (int r = 0; r < 16; ++r) p1[r] = fmaf(p1[r], C, mnC);
  for (int r = 0; r < 16; ++r) p0[r] = __builtin_amdgcn_exp2f(p0[r]);
}
__device__ __forceinline__ void finishSM(f32x16& p0, f32x16& p1, float alpha, float& l_reg, v8i& pa) {
  for (int r = 0; r < 16; ++r) p1[r] = __builtin_amdgcn_exp2f(p1[r]);
  float sm[8];
#pragma unroll
  for (int i = 0; i < 8; ++i) sm[i] = (p0[i] + p0[8 + i]) + (p1[i] + p1[8 + i]);
  float ps = ((sm[0] + sm[1]) + (sm[2] + sm[3])) + ((sm[4] + sm[5]) + (sm[6] + sm[7]));
  { auto rr = __builtin_amdgcn_permlane32_swap(__float_as_uint(ps), __float_as_uint(ps), false, false);
    ps = __uint_as_float(rr[0]) + __uint_as_float(rr[1]); }
  l_reg = l_reg * alpha + ps;
  pa[0] = pk4_fp8(p0[0], p0[1], p0[2], p0[3]); pa[1] = pk4_fp8(p0[4], p0[5], p0[6], p0[7]); pa[2] = pk4_fp8(p0[8], p0[9], p0[10], p0[11]); pa[3] = pk4_fp8(p0[12], p0[13], p0[14], p0[15]);
  pa[4] = pk4_fp8(p1[0], p1[1], p1[2], p1[3]); pa[5] = pk4_fp8(p1[4], p1[5], p1[6], p1[7]); pa[6] = pk4_fp8(p1[8], p1[9], p1[10], p1[11]); pa[7] = pk4_fp8(p1[12], p1[13], p1[14], p1[15]);
}
__device__ __forceinline__ v8i ld32(const char* p0, const char* p1) { const u32x4 a = *reinterpret_cast<const u32x4*>(p0), b = *reinterpret_cast<const u32x4*>(p1);
  v8i r; r[0] = (int)a[0]; r[1] = (int)a[1]; r[2] = (int)a[2]; r[3] = (int)a[3]; r[4] = (int)b[0]; r[5] = (int)b[1]; r[6] = (int)b[2]; r[7] = (int)b[3]; return r; }
__device__ __forceinline__ void qkt(f32x16& p0, f32x16& p1, const char* Ks, const v8i* qf, int r32, int hi) {
  p0 = f32x16{}; p1 = f32x16{};
#pragma unroll
  for (int s = 0; s < 2; ++s) {
    const v8i a0 = ld32(Ks + k_lds(r32, 4 * s + hi), Ks + k_lds(r32, 4 * s + 2 + hi)), a1 = ld32(Ks + k_lds(32 + r32, 4 * s + hi), Ks + k_lds(32 + r32, 4 * s + 2 + hi));
    p0 = MFMA8(a0, qf[s], p0); p1 = MFMA8(a1, qf[s], p1); }
}
__device__ __forceinline__ void pv(f32x16* o, const char* Vs, const v8i pa, int r32, int hi) {
#pragma unroll
  for (int d0 = 0; d0 < 4; ++d0) { const int d = 32 * d0 + r32; const v8i b = ld32(Vs + v_lds(d, 2 * hi), Vs + v_lds(d, 2 * hi + 1)); o[d0] = MFMA8(pa, b, o[d0]); }
}

__device__ __forceinline__ void attn_unit(const bf16_t* Qb, const unsigned char* __restrict__ K8, const unsigned char* __restrict__ VT, bf16_t* Ob, int t0, int seq,
                                          const float* __restrict__ qng, const float* __restrict__ cst, const float* __restrict__ snt, char* lds) {
  int tid_ = threadIdx.x; asm volatile("" : "+v"(tid_));
  const int tid = tid_, wid = tid >> 6, lane = tid & 63, r32 = lane & 31, hi = lane >> 5;
  char* V_lds = lds; char* K_lds = lds + OFF_K;
  float* ws = (float*)(lds + OFF_WS) + wid * 64; float* li_l = ws; float* al_l = ws + 32;
  float m_reg = -1e30f, l_reg = 0; f32x16 o[4] = {}; v8i qf[2];
  const int krow = tid >> 3, kch = tid & 7, kst = k_lds(krow, kch), vst = v_lds(tid >> 2, tid & 3);
  const unsigned char* kg = K8 + (long)krow * 256 + kch * 16; const unsigned char* vg = VT + tid * 16;
  struct { u32x4 k, v; } sr_[2];
#define SLOAD(i, kt) do { sr_[i].k = *reinterpret_cast<const u32x4*>(kg + (long)(kt) * (KVBLK * 256)); sr_[i].v = *reinterpret_cast<const u32x4*>(vg + (long)(kt) * 8192); } while (0)
  SLOAD(0, 0); SLOAD(1, 1);
  {
    const bf16_t* Qw = Qb + (long)(wid * QBLK + r32) * LDQ + 16 * hi;
    float y[2][32]; float ss = 0.f;
#pragma unroll
    for (int s = 0; s < 2; ++s)
#pragma unroll
      for (int part = 0; part < 2; ++part)
#pragma unroll
        for (int c = 0; c < 2; ++c) { const u32x4 w = *reinterpret_cast<const u32x4*>(Qw + 64 * s + 32 * part + 8 * c);
#pragma unroll
          for (int j = 0; j < 4; ++j) { const float a = bf_lo(w[j]), b = bf_hi(w[j]); y[s][16 * part + 8 * c + 2 * j] = a; y[s][16 * part + 8 * c + 2 * j + 1] = b; ss += a * a + b * b; } }
    ss += __shfl_xor(ss, 32);
    const float rstd = rsqrtf(ss * (1.f / HD) + EPS) * 16.f;
    const int t = t0 + wid * QBLK + r32;
#pragma unroll
    for (int s = 0; s < 2; ++s) { const int pos = s == 0 ? (t >> 6) : (t & 63);
#pragma unroll
      for (int c = 0; c < 4; ++c) { const int i0 = 16 * hi + 4 * c;
        const f32x4 g1 = *reinterpret_cast<const f32x4*>(qng + 64 * s + i0), g2 = *reinterpret_cast<const f32x4*>(qng + 64 * s + 32 + i0);
        const f32x4 c4 = *reinterpret_cast<const f32x4*>(cst + pos * 32 + i0), s4 = *reinterpret_cast<const f32x4*>(snt + pos * 32 + i0);
#pragma unroll
        for (int j = 0; j < 4; ++j) { const float x1 = y[s][4 * c + j] * rstd * g1[j], x2 = y[s][16 + 4 * c + j] * rstd * g2[j]; y[s][4 * c + j] = x1 * c4[j] - x2 * s4[j]; y[s][16 + 4 * c + j] = x1 * s4[j] + x2 * c4[j]; } }
#pragma unroll
      for (int w = 0; w < 8; ++w) qf[s][w] = pk4_fp8(y[s][4 * w], y[s][4 * w + 1], y[s][4 * w + 2], y[s][4 * w + 3]); }
  }
#define SWRITE(boff, i) do { *(u32x4*)(V_lds + (boff) + vst) = sr_[i].v; *(u32x4*)(K_lds + (boff) + kst) = sr_[i].k; } while (0)
#define SWAIT() asm volatile("s_waitcnt vmcnt(2)" ::: "memory")
#define RESC(a) do { if (__any((a) < 1.f)) { if (hi == 0) al_l[r32] = (a); asm volatile("s_waitcnt lgkmcnt(0)" ::: "memory"); \
    for (int d = 0; d < 4; ++d) for (int r = 0; r < 16; ++r) o[d][r] *= al_l[crow(r, hi)]; } } while (0)
  f32x16 pA0, pA1, pB0, pB1; float mnA, mnB, alA, alB; v8i pa; const int NT = seq / KVBLK;
  constexpr int SE = 0, SO = 1;
  int bprev = 0, bcur = SHM_K, bnext = 2 * SHM_K;
#define ROT() do { const int t_ = bprev; bprev = bcur; bcur = bnext; bnext = t_; } while (0)
  asm volatile("s_waitcnt vmcnt(0)" ::: "memory"); SWRITE(0, SE); SWRITE(SHM_K, SO); if (2 < NT) SLOAD(SE, 2); __syncthreads();
  qkt(pA0, pA1, K_lds, qf, r32, hi); partialSM(pA0, pA1, m_reg, mnA, alA);
  for (int j = 1; j + 1 < NT; j += 2) {
    SBAR(); qkt(pB0, pB1, K_lds + bcur, qf, r32, hi);
    finishSM(pA0, pA1, alA, l_reg, pa); SBAR();
    SLOAD(SO, j + 2); SBAR();
    pv(o, V_lds + bprev, pa, r32, hi); partialSM(pB0, pB1, m_reg, mnB, alB);
    SWAIT(); SWRITE(bnext, SE);
    RESC(alB); __syncthreads(); ROT();
    SBAR(); qkt(pA0, pA1, K_lds + bcur, qf, r32, hi);
    finishSM(pB0, pB1, alB, l_reg, pa); SBAR();
    if (j + 3 < NT) SLOAD(SE, j + 3); SBAR();
    pv(o, V_lds + bprev, pa, r32, hi); partialSM(pA0, pA1, m_reg, mnA, alA);
    SWAIT(); SWRITE(bnext, SO);
    RESC(alA); __syncthreads(); ROT();
  }
  SBAR(); qkt(pB0, pB1, K_lds + bcur, qf, r32, hi);
  finishSM(pA0, pA1, alA, l_reg, pa); SBAR();
  pv(o, V_lds + bprev, pa, r32, hi); partialSM(pB0, pB1, m_reg, mnB, alB);
  RESC(alB);
  finishSM(pB0, pB1, alB, l_reg, pa); SBAR();
  pv(o, V_lds + bcur, pa, r32, hi);
  __syncthreads();
#undef ROT
  if (hi == 0) li_l[r32] = l_reg; asm volatile("s_waitcnt lgkmcnt(0)" ::: "memory");
  float rli[16];
#pragma unroll
  for (int r = 0; r < 16; ++r) rli[r] = __builtin_amdgcn_rcpf(16.f * li_l[crow(r, hi)]);
  { bf16_t* stg = (bf16_t*)(lds + OST_OFF) + wid * 4096;
#pragma unroll
    for (int r = 0; r < 16; ++r) { const int orow = crow(r, hi);
#pragma unroll
      for (int d0 = 0; d0 < 4; ++d0) stg[orow * 128 + d0 * 32 + r32] = (bf16_t)(cvt_pk_bf16(o[d0][r] * rli[r], 0.f) & 0xffffu); }
    asm volatile("s_waitcnt lgkmcnt(0)" ::: "memory");
    bf16_t* Ow = Ob + (long)(wid * QBLK) * LDO;
#pragma unroll
    for (int i = 0; i < 8; ++i) { const int row = i * 4 + (lane >> 4), ch = lane & 15; const u32x4 v = *(const u32x4*)(stg + row * 128 + ch * 8); *(u32x4*)(Ow + (long)row * LDO + ch * 8) = v; }
  }
#undef SLOAD
#undef SWRITE
#undef SWAIT
#undef RESC
}
#undef SBAR
#undef MFMA8
}
constexpr size_t MiB = 1u << 20;
constexpr size_t WS_CTL = 0, CTL_ZERO_BYTES = 64 * 1024;
constexpr size_t WS_MOD = 1 * MiB;
constexpr size_t WS_ROPE = WS_MOD + 256 * 1024;
constexpr size_t WS_SBIAS = WS_MOD + 512 * 1024;
constexpr size_t WS_HC = 2 * MiB;
constexpr size_t WS_WIN = 6 * MiB;
constexpr size_t WS_WA = 17 * MiB, WS_WC = 19 * MiB, WS_WO = 21 * MiB;
constexpr size_t WS_WP = 23 * MiB;
constexpr size_t WS_UT = 27 * MiB, WS_VT = 59 * MiB;
constexpr size_t WS_TSCALE = 16 * MiB;
constexpr size_t WS_KB = 91 * MiB, WS_VB = 108 * MiB;
constexpr size_t WS_HX = 125 * MiB;
constexpr size_t WS_Q = 189 * MiB;
constexpr size_t WS_G = 253 * MiB;
constexpr size_t WS_RT = 317 * MiB;
constexpr size_t WS_SGC = 381 * MiB;
constexpr size_t WS_SC = 189 * MiB;
constexpr size_t WS_SSQ = 445 * MiB;
constexpr size_t WS_K8 = 447 * MiB;
constexpr size_t WS_VT8 = 456 * MiB;
constexpr size_t WS_END = 465 * MiB;

constexpr int NWAVES = 8;
constexpr int LDS_BYTES = 147456;

struct Args {
    const float *x, *c, *ctx, *c_ctx, *w_mod, *b_mod, *n1g, *n2g, *w_in, *qng, *kng, *w_ao, *cdw, *cb, *clg, *clb, *w_co, *w_o, *wq, *keys, *ut, *vt, *fg;
    float* out; unsigned char* ws; int ph_lo, ph_hi, dry, pad;
};

__host__ __device__ __forceinline__ int win_row(int n) {
    if (n < 1536) return n;
    const int base = n < 3584 ? 1536 : 3584, m = n - base, half = m >> 10, idx = m & 1023;
    return base + (idx >> 7) * 256 + half * 128 + (idx & 127);
}

__device__ __forceinline__ void task_mod(const Args& A, int task, int lane, const LAS float* sc) {
    const int n0 = task * 8, col = lane & 7, kg = lane >> 3;
    float acc[9];
#pragma unroll
    for (int b = 0; b < 9; ++b) acc[b] = 0.f;
    const float* wp = A.w_mod + (size_t)kg * NMOD + n0 + col;
    for (int i0 = 0; i0 < 128; i0 += 8) {
        float w[8];
#pragma unroll
        for (int u = 0; u < 8; ++u) w[u] = wp[(size_t)(i0 + u) * 8 * NMOD];
#pragma unroll
        for (int u = 0; u < 8; ++u) { const int k = kg + 8 * (i0 + u);
#pragma unroll
            for (int b = 0; b < 9; ++b) acc[b] += sc[b * D + k] * w[u]; }
    }
#pragma unroll
    for (int b = 0; b < 9; ++b) { float v = acc[b]; v += __shfl_xor(v, 8); v += __shfl_xor(v, 16); v += __shfl_xor(v, 32); acc[b] = v; }
    if (lane < 8) { float* mod = (float*)(A.ws + WS_MOD); const float bm = A.b_mod[n0 + col];
#pragma unroll
        for (int b = 0; b < 9; ++b) mod[b * NMOD + n0 + col] = acc[b] + bm; }
}
__device__ __forceinline__ void task_transpose(const float* W, int K, int N, bf16_t* WT, int k0, int n0, int row0, LAS float* scr, int lane) {
#pragma unroll 8
    for (int i = 0; i < 32; ++i) { const int kk = 2 * i + (lane >> 5); scr[kk * 33 + (lane & 31)] = W[(size_t)(k0 + kk) * N + n0 + (lane & 31)]; }
    asm volatile("s_waitcnt lgkmcnt(0)" ::: "memory");
    const int c = lane & 7;
#pragma unroll
    for (int j = 0; j < 4; ++j) { const int n = (lane >> 3) + 8 * j; const LAS float* s = scr + (8 * c) * 33 + n;
        u32x4 o; o.x = cvt_pk_bf16(s[0 * 33], s[1 * 33]); o.y = cvt_pk_bf16(s[2 * 33], s[3 * 33]); o.z = cvt_pk_bf16(s[4 * 33], s[5 * 33]); o.w = cvt_pk_bf16(s[6 * 33], s[7 * 33]);
        *(u32x4*)(WT + (size_t)(row0 + n) * K + k0 + 8 * c) = o; }
    asm volatile("s_waitcnt lgkmcnt(0)" ::: "memory");
}
typedef float f32x16v __attribute__((ext_vector_type(16)));
typedef unsigned u32x6 __attribute__((ext_vector_type(6)));
constexpr int ROWB = 768;
__device__ __forceinline__ void task_quant_rows4(const float* src, unsigned char* dst, float* scale_out, int lane) {
    const int g = lane & 31, hh = lane >> 5;
    f32x4 v[2][8];
#pragma unroll
    for (int r = 0; r < 2; ++r)
#pragma unroll
        for (int i = 0; i < 8; ++i) v[r][i] = *(const f32x4*)(src + (size_t)(2 * r + hh) * D + g * 32 + i * 4);
#pragma unroll
    for (int r = 0; r < 2; ++r) {
        float am = 0.f;
#pragma unroll
        for (int i = 0; i < 8; ++i) am = fmaxf(fmaxf(am, fmaxf(fabsf(v[r][i][0]), fabsf(v[r][i][1]))), fmaxf(fabsf(v[r][i][2]), fabsf(v[r][i][3])));
#pragma unroll
        for (int o = 1; o < 32; o <<= 1) am = fmaxf(am, __shfl_xor(am, o));
        const float inv = am > 0.f ? 7.5f / am : 0.f;
        f32x16v a, b;
#pragma unroll
        for (int i = 0; i < 4; ++i)
#pragma unroll
            for (int j = 0; j < 4; ++j) { const int e0 = 4 * i + j;
                a[e0] = v[r][(2 * e0) >> 2][(2 * e0) & 3] * inv; b[e0] = v[r][(2 * e0 + 1) >> 2][(2 * e0 + 1) & 3] * inv; }
        const u32x6 p = __builtin_amdgcn_cvt_scalef32_2xpk16_fp6_f32(a, b, 1.0f);
        unsigned char* rowp = dst + (size_t)(2 * r + hh) * ROWB;
        *(u32x4*)(rowp + g * 16) = (u32x4){p[0], p[1], p[2], p[3]}; *(u32x2*)(rowp + 512 + g * 8) = (u32x2){p[4], p[5]};
        if (g == 0) scale_out[2 * r + hh] = am * (1.f / 7.5f);
    }
}
__device__ __forceinline__ bf16x8 ld8_f32_bf16(const float* p) { const f32x4 a = *(const f32x4*)p, b = *(const f32x4*)(p + 4); u32x4 w = {cvt_pk_bf16(a[0], a[1]), cvt_pk_bf16(a[2], a[3]), cvt_pk_bf16(b[0], b[1]), cvt_pk_bf16(b[2], b[3])}; return *reinterpret_cast<bf16x8*>(&w); }
__device__ __forceinline__ void task_wprime(const Args& A, int id, int lane) {
    const int hp = id >> 7, rem = id & 127, n0 = (rem >> 5) * 32, k0 = (rem & 31) * 32, r32 = lane & 31, hi = lane >> 5;
    f32x16 acc = {};
    const float* ka = A.keys + ((size_t)(hp * 128 + n0 + r32)) * 128 + hi * 8;
    const float* wb = A.wq + (size_t)(k0 + r32) * PW + hp * 128 + hi * 8;
#pragma unroll
    for (int s = 0; s < 8; ++s) acc = __builtin_amdgcn_mfma_f32_32x32x16_bf16(ld8_f32_bf16(ka + s * 16), ld8_f32_bf16(wb + s * 16), acc, 0, 0, 0);
    bf16_t* o = (bf16_t*)(A.ws + WS_WP);
#pragma unroll
    for (int r = 0; r < 16; ++r) { const int n = (r & 3) + 8 * (r >> 2) + 4 * hi; o[(size_t)(hp * 128 + n0 + n) * D + k0 + r32] = (bf16_t)(cvt_pk_bf16(acc[r], 0.f) & 0xffffu); }
}
__device__ __forceinline__ void phase_prologue(const Args& A, LAS unsigned char* lds) {
    const int tid = threadIdx.x, lane = tid & 63, wave = __builtin_amdgcn_readfirstlane(tid >> 6);
    LAS float* sc = (LAS float*)lds;
    for (int i = tid; i < 9 * D; i += 512) { const float v = i < 8 * D ? A.c[i] : A.c_ctx[i - 8 * D]; sc[i] = v / (1.f + __expf(-v)); }
    __syncthreads();
    LAS float* scr = (LAS float*)(lds + 36864 + wave * 8448);
    constexpr int T_MOD = NMOD / 8, T_WIN = (D / 64) * (INW / 32), T_SQ = (D / 64) * (D / 32), T_UV = 2 * NEXP / 4, T_WP = 2048, T_ROPE = 1;
    constexpr int NT = T_MOD + T_WIN + 3 * T_SQ + T_UV + T_WP + T_ROPE;
    const int G = gridDim.x;
    for (int task = wave * G + blockIdx.x; task < NT; task += NWAVES * G) {
        int r = task;
        if (r < T_MOD) { task_mod(A, r, lane, sc); continue; } r -= T_MOD;
        if (r < T_WIN) { const int nblk = INW / 32, kb = r / nblk, nb = r % nblk; task_transpose(A.w_in, D, INW, (bf16_t*)(A.ws + WS_WIN), 64 * kb, 32 * nb, win_row(32 * nb), scr, lane); continue; } r -= T_WIN;
        if (r < 3 * T_SQ) { const int wsel = r / T_SQ, q = r % T_SQ, kb = q / 32, nb = q % 32;
            const float* W = wsel == 0 ? A.w_ao : (wsel == 1 ? A.w_co : A.w_o); bf16_t* WT = (bf16_t*)(A.ws + (wsel == 0 ? WS_WA : (wsel == 1 ? WS_WC : WS_WO)));
            task_transpose(W, D, D, WT, 64 * kb, 32 * nb, 32 * nb, scr, lane); continue; } r -= 3 * T_SQ;
        if (r < T_UV) { const int tb = r / (NEXP / 4), row = (r % (NEXP / 4)) * 4; unsigned char* tbase = A.ws + (tb ? WS_VT : WS_UT);
            task_quant_rows4((tb ? A.vt : A.ut) + (size_t)row * D, tbase + (size_t)row * ROWB, (float*)(tbase + WS_TSCALE) + row, lane); continue; } r -= T_UV;
        if (r < T_WP) { task_wprime(A, r, lane); continue; } r -= T_WP;
        { float* cs = (float*)(A.ws + WS_ROPE); float* sn = cs + 2048;
          for (int e = lane; e < 2048; e += 64) { const int p = e >> 5, i = e & 31; const float inv = powf(10000.f, -(float)(2 * i) / 64.f); const float a = (float)p * inv; cs[e] = cosf(a); sn[e] = sinf(a); } }
    }
}
__device__ __forceinline__ void normmod_row(const float* xr, const float* g, const float* modr, int sh_off, int sc_off, bf16_t* orow, int lane) {
    f32x4 v[4]; float ss = 0.f;
#pragma unroll
    for (int i = 0; i < 4; ++i) { v[i] = *(const f32x4*)(xr + (i * 64 + lane) * 4); ss += (v[i][0] * v[i][0] + v[i][1] * v[i][1]) + (v[i][2] * v[i][2] + v[i][3] * v[i][3]); }
    const float r = rsqrtf(wave_sum(ss) * (1.f / D) + EPS);
#pragma unroll
    for (int i = 0; i < 4; ++i) { const int k = (i * 64 + lane) * 4; const f32x4 gg = *(const f32x4*)(g + k), s1 = *(const f32x4*)(modr + sc_off + k), h1 = *(const f32x4*)(modr + sh_off + k);
        float y[4];
#pragma unroll
        for (int j = 0; j < 4; ++j) y[j] = v[i][j] * r * gg[j] * (1.f + s1[j]) + h1[j];
        u32x2 o = {cvt_pk_bf16(y[0], y[1]), cvt_pk_bf16(y[2], y[3])}; *(u32x2*)(orow + k) = o; }
}
__device__ __forceinline__ void phase_hx(const Args& A) {
    const int lane = threadIdx.x & 63, gw = blockIdx.x * NWAVES + (threadIdx.x >> 6), NGW = gridDim.x * NWAVES;
    const float* mod = (const float*)(A.ws + WS_MOD);
    for (int m = gw; m < M + MC; m += NGW) {
        if (m < M) normmod_row(A.x + (size_t)m * D, A.n1g, mod + (m >> 12) * NMOD, 0, D, (bf16_t*)(A.ws + WS_HX) + (size_t)m * D, lane);
        else { const int r = m - M; normmod_row(A.ctx + (size_t)r * D, A.n1g, mod + 8 * NMOD, 0, D, (bf16_t*)(A.ws + WS_HC) + (size_t)r * D, lane); }
    }
    const bf16_t* WP = (const bf16_t*)(A.ws + WS_WP); float* sb = (float*)(A.ws + WS_SBIAS);
    for (int col = gw; col < PW; col += NGW) {
        const u32x4 w0 = *(const u32x4*)(WP + (size_t)col * D + lane * 16), w1 = *(const u32x4*)(WP + (size_t)col * D + lane * 16 + 8);
        float wv[16];
#pragma unroll
        for (int j = 0; j < 4; ++j) { wv[2 * j] = bf_lo(w0[j]); wv[2 * j + 1] = bf_hi(w0[j]); wv[8 + 2 * j] = bf_lo(w1[j]); wv[8 + 2 * j + 1] = bf_hi(w1[j]); }
#pragma unroll 1
        for (int b = 0; b < NB; ++b) { const float* sh = mod + b * NMOD + 3 * D + lane * 16; float s = 0.f;
#pragma unroll
            for (int q = 0; q < 4; ++q) { const f32x4 v = *(const f32x4*)(sh + 4 * q); s += v[0] * wv[4 * q] + v[1] * wv[4 * q + 1] + v[2] * wv[4 * q + 2] + v[3] * wv[4 * q + 3]; }
            s = wave_sum(s); if (lane == 0) sb[b * PW + col] = s; }
    }
}
__device__ __forceinline__ void phase_kfix(const Args& A) {
    const int lane = threadIdx.x & 63, gw = blockIdx.x * NWAVES + (threadIdx.x >> 6), NGW = gridDim.x * NWAVES, li = lane & 15, sub = lane >> 4;
    const bf16_t* KB = (const bf16_t*)(A.ws + WS_KB); const float* cs = (const float*)(A.ws + WS_ROPE); const float* sn = cs + 2048;
    constexpr int NITEM = NB * SKV * HKV;
    const f32x4 g0 = *(const f32x4*)(A.kng + li * 8), g1 = *(const f32x4*)(A.kng + li * 8 + 4);
    const f32x4 p0 = *(const f32x4*)(A.kng + (li ^ 4) * 8), p1 = *(const f32x4*)(A.kng + (li ^ 4) * 8 + 4);
    for (int it = gw * 4 + sub; it < NITEM; it += NGW * 4) {
        const int row = it >> 1, h = it & 1, t = row % SKV;
        const bf16_t* p = KB + (size_t)row * 256 + h * HD + li * 8;
        const u32x4 w = *(const u32x4*)p;
        float x[8], xp[8]; float ss = 0.f;
#pragma unroll
        for (int j = 0; j < 4; ++j) { x[2 * j] = bf_lo(w[j]); x[2 * j + 1] = bf_hi(w[j]); ss += x[2 * j] * x[2 * j] + x[2 * j + 1] * x[2 * j + 1];
            const unsigned pw = (unsigned)__shfl_xor((int)w[j], 4); xp[2 * j] = bf_lo(pw); xp[2 * j + 1] = bf_hi(pw); }
        ss += __shfl_xor(ss, 1); ss += __shfl_xor(ss, 2); ss += __shfl_xor(ss, 4); ss += __shfl_xor(ss, 8);
        const float r = rsqrtf(ss * (1.f / HD) + EPS);
        float y[8];
#pragma unroll
        for (int j = 0; j < 8; ++j) { x[j] *= r * (j < 4 ? g0[j] : g1[j - 4]); xp[j] *= r * (j < 4 ? p0[j] : p1[j - 4]); y[j] = x[j]; }
        if (t < S) {
            const int blk = li >> 3, pos = blk == 0 ? (t >> 6) : (t & 63), second = (li >> 2) & 1, i0 = (li & 3) * 8;
            const f32x4 c0 = *(const f32x4*)(cs + pos * 32 + i0), c1 = *(const f32x4*)(cs + pos * 32 + i0 + 4), s0 = *(const f32x4*)(sn + pos * 32 + i0), s1 = *(const f32x4*)(sn + pos * 32 + i0 + 4);
#pragma unroll
            for (int j = 0; j < 8; ++j) { const float c = j < 4 ? c0[j] : c1[j - 4], s = j < 4 ? s0[j] : s1[j - 4];
                y[j] = second ? (xp[j] * s + x[j] * c) : (x[j] * c - xp[j] * s); }
        }
        u32x2 o = {(unsigned)att::pk4_fp8(y[0] * 16.f, y[1] * 16.f, y[2] * 16.f, y[3] * 16.f), (unsigned)att::pk4_fp8(y[4] * 16.f, y[5] * 16.f, y[6] * 16.f, y[7] * 16.f)};
        *(u32x2*)(A.ws + WS_K8 + (size_t)row * 256 + h * HD + li * 8) = o;
    }
}
__device__ __forceinline__ void phase_vt(const Args& A, LAS unsigned char* lds) {
    const int lane = threadIdx.x & 63, wave = threadIdx.x >> 6, gw = blockIdx.x * NWAVES + wave, NGW = gridDim.x * NWAVES;
    LAS unsigned char* tl = lds + wave * 4096;
    const bf16_t* VB = (const bf16_t*)(A.ws + WS_VB);
    const int kk = lane & 31, pos = 32 * ((kk >> 2) & 1) + (kk & 3) + 4 * (kk >> 3) + 16 * (lane >> 5);
    constexpr int NTILE = SKV / 64;
    for (int it2 = gw; it2 < NB * HKV * NTILE * 2; it2 += NGW) {
        const int dh = it2 & 1, it = it2 >> 1, j = it % NTILE, bk = it / NTILE, b = bk >> 1, kv = bk & 1;
        const bf16_t* src = VB + ((size_t)b * SKV + j * 64 + lane) * 256 + kv * HD + dh * 64;
        u32x4 w[8];
#pragma unroll
        for (int c = 0; c < 8; ++c) w[c] = *(const u32x4*)(src + c * 8);
#pragma unroll
        for (int c = 0; c < 8; ++c)
#pragma unroll
            for (int q = 0; q < 4; ++q) { const int pk = __builtin_amdgcn_cvt_pk_fp8_f32(bf_lo(w[c][q]) * 16.f, bf_hi(w[c][q]) * 16.f, 0, false);
                tl[(c * 8 + 2 * q) * 64 + pos] = (unsigned char)(pk & 0xff); tl[(c * 8 + 2 * q + 1) * 64 + pos] = (unsigned char)((pk >> 8) & 0xff); }
        asm volatile("s_waitcnt lgkmcnt(0)" ::: "memory");
        unsigned char* dst = A.ws + WS_VT8 + (size_t)it * 8192 + dh * 4096;
#pragma unroll
        for (int i = 0; i < 4; ++i) *(u32x4*)(dst + (i * 64 + lane) * 16) = *(const LAS u32x4*)(tl + (i * 64 + lane) * 16);
        asm volatile("s_waitcnt lgkmcnt(0)" ::: "memory");
    }
}
template <int R> struct ConvRow {
    static __device__ __forceinline__ void run(const unsigned* gp, int tl0, float (&acc)[32][2], const float (&w)[31][2]) {
        const int tl = tl0 + R - 15;
        unsigned v = 0u; if (tl >= 0 && tl < S) v = gp[(long)(R - 15) * (D / 2)];
        const float a = bf_lo(v), b = bf_hi(v);
#pragma unroll
        for (int t = (R - 30 > 0 ? R - 30 : 0); t <= (R < 31 ? R : 31); ++t) { acc[t][0] += w[R - t][0] * a; acc[t][1] += w[R - t][1] * b; }
        if constexpr (R + 1 < 62) ConvRow<R + 1>::run(gp, tl0, acc, w);
    }
};
__device__ __forceinline__ void phase_conv(const Args& A, LAS unsigned char* lds) {
    const int tid = threadIdx.x, lane = tid & 63, wave = tid >> 6;
    LAS float* tile = (LAS float*)lds;
    const bf16_t* G = (const bf16_t*)(A.ws + WS_G); bf16_t* CV = (bf16_t*)(A.ws + WS_HX);
    float w[31][2];
#pragma unroll
    for (int j = 0; j < 31; ++j) { const f32x2 t = *(const f32x2*)(A.cdw + j * D + 2 * tid); w[j][0] = t[0]; w[j][1] = t[1]; }
    const f32x2 bias = *(const f32x2*)(A.cb + 2 * tid);
    for (int tileid = blockIdx.x; tileid < M / 32; tileid += gridDim.x) {
        const int row0 = tileid * 32, tl0 = row0 & (S - 1);
        float acc[32][2];
#pragma unroll
        for (int t = 0; t < 32; ++t) { acc[t][0] = bias[0]; acc[t][1] = bias[1]; }
        ConvRow<0>::run((const unsigned*)(G + (size_t)row0 * D) + tid, tl0, acc, w);
        __syncthreads();
#pragma unroll
        for (int t = 0; t < 32; ++t) *(LAS f32x2*)(tile + t * D + 2 * tid) = (f32x2){acc[t][0], acc[t][1]};
        __syncthreads();
#pragma unroll
        for (int q = 0; q < 4; ++q) { const int t = wave * 4 + q; const LAS float* tr = tile + t * D;
            f32x4 v[4]; float s = 0.f;
#pragma unroll
            for (int i = 0; i < 4; ++i) { v[i] = *(const LAS f32x4*)(tr + (i * 64 + lane) * 4); s += (v[i][0] + v[i][1]) + (v[i][2] + v[i][3]); }
            const float mu = wave_sum(s) * (1.f / D); float qq = 0.f;
#pragma unroll
            for (int i = 0; i < 4; ++i) { v[i] = v[i] - mu; qq += (v[i][0] * v[i][0] + v[i][1] * v[i][1]) + (v[i][2] * v[i][2] + v[i][3] * v[i][3]); }
            const float rs = rsqrtf(wave_sum(qq) * (1.f / D) + EPS);
#pragma unroll
            for (int i = 0; i < 4; ++i) { const int k = (i * 64 + lane) * 4; const f32x4 gg = *(const f32x4*)(A.clg + k), bb = *(const f32x4*)(A.clb + k); float y[4];
#pragma unroll
                for (int j = 0; j < 4; ++j) { const float z = v[i][j] * rs * gg[j] + bb[j]; y[j] = z * fast_sigmoid(z); }
                u32x2 o = {cvt_pk_bf16(y[0], y[1]), cvt_pk_bf16(y[2], y[3])}; *(u32x2*)(CV + (size_t)(row0 + t) * D + k) = o; }
        }
    }
}
struct EpiInProj {
    static constexpr bool PERM = true;
    unsigned char* ws;
    __device__ __forceinline__ void operator()(f32x4 (&acc)[2][2][4][2], const pg8::Unit& u, int wr, int wc, int fr, int fq) const {
        const int c8 = wc * 32 + 8 * fq;
#pragma unroll
        for (int ai = 0; ai < 2; ++ai)
#pragma unroll
            for (int m = 0; m < 4; ++m) {
                const int row = u.pm * 256 + ai * 128 + wr * 64 + m * 16 + fr;
                if (u.kind == 0) {
                    bf16_t* p = (bf16_t*)(ws + WS_Q) + (size_t)row * D + u.pn * 256 + c8;
#pragma unroll
                    for (int bj = 0; bj < 2; ++bj) { const f32x4 v0 = acc[ai][bj][m][0], v1 = acc[ai][bj][m][1];
                        u32x4 w = {cvt_pk_bf16(v0[0], v0[1]), cvt_pk_bf16(v0[2], v0[3]), cvt_pk_bf16(v1[0], v1[1]), cvt_pk_bf16(v1[2], v1[3])}; *(u32x4*)(p + bj * 128) = w; }
                } else if (u.kind == 1 || u.kind == 2 || u.kind == 5 || u.kind == 6) {
                    const bool ctxu = u.kind >= 5;
                    const int kvrow = ctxu ? (row >> 8) * SKV + S + (row & 255) : (row >> 12) * SKV + (row & (S - 1));
                    bf16_t* p = (bf16_t*)(ws + ((u.kind == 1 || u.kind == 5) ? WS_KB : WS_VB)) + (size_t)kvrow * 256 + c8;
#pragma unroll
                    for (int bj = 0; bj < 2; ++bj) { const f32x4 v0 = acc[ai][bj][m][0], v1 = acc[ai][bj][m][1];
                        u32x4 w = {cvt_pk_bf16(v0[0], v0[1]), cvt_pk_bf16(v0[2], v0[3]), cvt_pk_bf16(v1[0], v1[1]), cvt_pk_bf16(v1[2], v1[3])}; *(u32x4*)(p + bj * 128) = w; }
                } else if (u.kind == 3) {
                    float g[8];
#pragma unroll
                    for (int n = 0; n < 2; ++n)
#pragma unroll
                        for (int j = 0; j < 4; ++j) g[4 * n + j] = acc[ai][0][m][n][j] * fast_sigmoid(acc[ai][1][m][n][j]);
                    u32x4 w = {cvt_pk_bf16(g[0], g[1]), cvt_pk_bf16(g[2], g[3]), cvt_pk_bf16(g[4], g[5]), cvt_pk_bf16(g[6], g[7])};
                    *(u32x4*)((bf16_t*)(ws + WS_G) + (size_t)row * D + (u.pn - 6) * 128 + c8) = w;
                } else {
                    float rt[8], sg[8];
#pragma unroll
                    for (int n = 0; n < 2; ++n)
#pragma unroll
                        for (int j = 0; j < 4; ++j) { const float ea = __builtin_amdgcn_exp2f(-1.4426950408889634f * acc[ai][0][m][n][j]), ec = __builtin_amdgcn_exp2f(-1.4426950408889634f * acc[ai][1][m][n][j]);
                            sg[4 * n + j] = __builtin_amdgcn_rcpf(1.f + ec); rt[4 * n + j] = (1.f + ec) * __builtin_amdgcn_rcpf(1.f + ea); }
                    const size_t off = (size_t)row * D + (u.pn - 14) * 128 + c8;
                    u32x4 w = {cvt_pk_bf16(rt[0], rt[1]), cvt_pk_bf16(rt[2], rt[3]), cvt_pk_bf16(rt[4], rt[5]), cvt_pk_bf16(rt[6], rt[7])}; *(u32x4*)((bf16_t*)(ws + WS_RT) + off) = w;
                    u32x4 w2 = {cvt_pk_bf16(sg[0], sg[1]), cvt_pk_bf16(sg[2], sg[3]), cvt_pk_bf16(sg[4], sg[5]), cvt_pk_bf16(sg[6], sg[7])}; *(u32x4*)((bf16_t*)(ws + WS_SGC) + off) = w2;
                }
            }
    }
};
struct SchedInProj {
    const char* hx; const char* hc; const char* w; int G, c;
    __device__ __forceinline__ bool next(int i, pg8::Unit& u) const {
        constexpr int nM = M / 256, nN = INW / 256, NMAIN = nM * nN, NCTX = (MC / 256) * 2;
        const int L = i * G + c; if (L >= NMAIN + NCTX) return false;
        if (L < NMAIN) { pg8::tile_of(L, nM, nN, u.pm, u.pn); u.a = hx + (size_t)u.pm * 256 * D * 2; u.kind = u.pn < 4 ? 0 : (u.pn == 4 ? 1 : (u.pn == 5 ? 2 : (u.pn < 14 ? 3 : 4))); }
        else { const int j = L - NMAIN; u.pm = j >> 1; u.pn = 4 + (j & 1); u.a = hc + (size_t)u.pm * 256 * D * 2; u.kind = 5 + (j & 1); }
        u.b = w + (size_t)u.pn * 256 * D * 2; u.keep = 0; return true;
    }
};
struct EpiMerge {
    static constexpr bool PERM = true;
    unsigned char* ws;
    __device__ __forceinline__ void operator()(f32x4 (&acc)[2][2][4][2], const pg8::Unit& u, int wr, int wc, int fr, int fq) const {
        const int c8 = u.pn * 256 + wc * 32 + 8 * fq;
        const bf16_t* __restrict__ F = (const bf16_t*)(ws + (u.kind == 0 ? WS_RT : WS_SGC));
#pragma unroll
        for (int ai = 0; ai < 2; ++ai)
#pragma unroll
            for (int m = 0; m < 4; ++m) { const size_t off = (size_t)(u.pm * 256 + ai * 128 + wr * 64 + m * 16 + fr) * D + c8;
#pragma unroll
                for (int bj = 0; bj < 2; ++bj) { const u32x4 f = *(const u32x4*)(F + off + bj * 128);
                    f32x4 v0 = acc[ai][bj][m][0], v1 = acc[ai][bj][m][1];
                    v0[0] *= bf_lo(f[0]); v0[1] *= bf_hi(f[0]); v0[2] *= bf_lo(f[1]); v0[3] *= bf_hi(f[1]); v1[0] *= bf_lo(f[2]); v1[1] *= bf_hi(f[2]); v1[2] *= bf_lo(f[3]); v1[3] *= bf_hi(f[3]);
                    if (u.kind == 0) { acc[ai][bj][m][0] = v0; acc[ai][bj][m][1] = v1; }
                    else { u32x4 w = {cvt_pk_bf16(v0[0], v0[1]), cvt_pk_bf16(v0[2], v0[3]), cvt_pk_bf16(v1[0], v1[1]), cvt_pk_bf16(v1[2], v1[3])}; *(u32x4*)((bf16_t*)(ws + WS_G) + off + bj * 128) = w; } } }
    }
};
struct SchedMerge {
    const char* att; const char* cv; const char* wa; const char* wc; int G, c;
    __device__ __forceinline__ bool next(int i, pg8::Unit& u) const {
        constexpr int nM = M / 256, nN = D / 256;
        const int L = (i >> 1) * G + c, sub = i & 1; if (L >= nM * nN) return false;
        pg8::tile_of(L, nM, nN, u.pm, u.pn);
        u.a = (sub ? cv : att) + (size_t)u.pm * 256 * D * 2; u.b = (sub ? wc : wa) + (size_t)u.pn * 256 * D * 2; u.kind = sub; u.keep = sub ^ 1; return true;
    }
};
struct SchedPlain {
    const char* a; const char* b; int nM, nN, G, c;
    __device__ __forceinline__ bool next(int i, pg8::Unit& u) const {
        const int L = i * G + c; if (L >= nM * nN) return false;
        pg8::tile_of(L, nM, nN, u.pm, u.pn); u.a = a + (size_t)u.pm * 256 * D * 2; u.b = b + (size_t)u.pn * 256 * D * 2; u.kind = 0; u.keep = 0; return true;
    }
};
struct EpiOut {
    static constexpr bool PERM = false;
    const float* __restrict__ x; const float* __restrict__ mod; const float* __restrict__ n2g; float* __restrict__ xs; bf16_t* __restrict__ xg; float* __restrict__ ssq;
    __device__ __forceinline__ void operator()(f32x4 (&acc)[2][2][4][2], const pg8::Unit& u, int wr, int wc, int fr, int fq) const {
        const int col0 = u.pn * 256 + wc * 32 + 4 * fq; const float* mb = mod + ((u.pm * 256) >> 12) * NMOD;
        f32x4 gv[2][2], nv[2][2];
#pragma unroll
        for (int bj = 0; bj < 2; ++bj)
#pragma unroll
            for (int n = 0; n < 2; ++n) { const int c = col0 + bj * 128 + n * 16; gv[bj][n] = *(const f32x4*)(mb + 2 * D + c); nv[bj][n] = *(const f32x4*)(n2g + c) * (*(const f32x4*)(mb + 4 * D + c) + 1.f); }
        f32x4 xa[2][2], xb[2][2];
#define XLOAD(dst, k) do { _Pragma("unroll") for (int bj = 0; bj < 2; ++bj) _Pragma("unroll") for (int n = 0; n < 2; ++n) \
            dst[bj][n] = *(const f32x4*)(x + (size_t)(u.pm * 256 + ((k) >> 2) * 128 + wr * 64 + ((k) & 3) * 16 + fr) * D + col0 + bj * 128 + n * 16); } while (0)
#define XDONE(src, k) do { const int ai = (k) >> 2, m = (k) & 3; const int row = u.pm * 256 + ai * 128 + wr * 64 + m * 16 + fr; const size_t off = (size_t)row * D + col0; float ss = 0.f; \
            _Pragma("unroll") for (int bj = 0; bj < 2; ++bj) _Pragma("unroll") for (int n = 0; n < 2; ++n) { const f32x4 v = src[bj][n] + gv[bj][n] * acc[ai][bj][m][n]; *(f32x4*)(xs + off + bj * 128 + n * 16) = v; \
                ss += (v[0] * v[0] + v[1] * v[1]) + (v[2] * v[2] + v[3] * v[3]); const f32x4 g = v * nv[bj][n]; \
                u32x2 w = {cvt_pk_bf16(g[0], g[1]), cvt_pk_bf16(g[2], g[3])}; *(u32x2*)(xg + off + bj * 128 + n * 16) = w; } \
            ss += __shfl_xor(ss, 16); ss += __shfl_xor(ss, 32); if (fq == 0) ssq[(size_t)row * 16 + u.pn * 4 + wc] = ss; } while (0)
        XLOAD(xa, 0); XLOAD(xb, 1); XDONE(xa, 0); XLOAD(xa, 2); XDONE(xb, 1); XLOAD(xb, 3); XDONE(xa, 2); XLOAD(xa, 4); XDONE(xb, 3); XLOAD(xb, 5); XDONE(xa, 4); XLOAD(xa, 6); XDONE(xb, 5); XLOAD(xb, 7); XDONE(xa, 6); XDONE(xb, 7);
#undef XLOAD
#undef XDONE
    }
};
__device__ __forceinline__ float row_rstd(const float* ssq, int row) {
    const f32x4 a = *(const f32x4*)(ssq + (size_t)row * 16), b = *(const f32x4*)(ssq + (size_t)row * 16 + 4), c = *(const f32x4*)(ssq + (size_t)row * 16 + 8), d = *(const f32x4*)(ssq + (size_t)row * 16 + 12);
    const float s = ((a[0] + a[1]) + (a[2] + a[3])) + ((b[0] + b[1]) + (b[2] + b[3])) + ((c[0] + c[1]) + (c[2] + c[3])) + ((d[0] + d[1]) + (d[2] + d[3]));
    return rsqrtf(s * (1.f / D) + EPS);
}
struct EpiScores {
    static constexpr bool PERM = false;
    float* sc; const float* ssq; const float* sbias;
    __device__ __forceinline__ void operator()(f32x4 (&acc)[2][2][4][2], const pg8::Unit& u, int wr, int wc, int fr, int fq) const {
        const float* sb = sbias + ((u.pm * 256) >> 12) * PW + u.pn * 256 + wc * 32 + 4 * fq;
        f32x4 bv[2][2];
#pragma unroll
        for (int bj = 0; bj < 2; ++bj)
#pragma unroll
            for (int n = 0; n < 2; ++n) bv[bj][n] = *(const f32x4*)(sb + bj * 128 + n * 16);
#pragma unroll
        for (int ai = 0; ai < 2; ++ai)
#pragma unroll
            for (int m = 0; m < 4; ++m) { const int row = u.pm * 256 + ai * 128 + wr * 64 + m * 16 + fr; float* p = sc + (size_t)(row >> 2) * 8192 + (row & 3) * 4; const float rs = row_rstd(ssq, row);
#pragma unroll
                for (int bj = 0; bj < 2; ++bj)
#pragma unroll
                    for (int n = 0; n < 2; ++n) { const int grp = u.pn * 2 + bj, nq = wc * 8 + n * 4 + fq; *(f32x4*)(p + (grp * 32 + nq) * 16) = acc[ai][bj][m][n] * rs + bv[bj][n]; } }
    }
};

#ifndef PROBE_HALFKEYS
#define PROBE_HALFKEYS 0
#endif
__device__ __forceinline__ void phase_attn(const Args& A, unsigned char* lds) {
    const int G = gridDim.x, X = blockIdx.x & 7, j = blockIdx.x >> 3, perx = G >> 3;
    bf16_t* Q = (bf16_t*)(A.ws + WS_Q); const unsigned char* K8 = A.ws + WS_K8; const unsigned char* VT8 = A.ws + WS_VT8;
    const float* cs = (const float*)(A.ws + WS_ROPE); const float* sn = cs + 2048;
    for (int idx = j; idx < 128; idx += perx) {
        const int grp = 2 * X + (idx >> 6), uu = idx & 63, b = grp >> 1, kv = grp & 1, h = kv * 4 + (uu >> 4), qb = uu & 15;
        bf16_t* qp = Q + ((size_t)b * S + qb * 256) * D + h * HD;
        bf16_t* op = A.dry ? (bf16_t*)(A.ws + WS_G) + ((size_t)b * S + qb * 256) * D + h * HD : qp;
        att::attn_unit(qp, K8 + (size_t)b * SKV * 256 + kv * HD, VT8 + (size_t)grp * (SKV / 64) * 8192, op, qb * 256, (A.dry && PROBE_HALFKEYS) ? SKV / 2 : SKV, A.qng, cs, sn, (char*)lds);
    }
}

__device__ __forceinline__ float gelu_exact(float v) {
    const float av = fabsf(v), t = __builtin_amdgcn_rcpf(av * 0.2316418882f + 1.0f);
    float q = t * 0.5307027145f + (-0.7265760135f); q = q * t + 0.7107068705f; q = q * t + (-0.142248368f); q = q * t + 0.127414796f; q = q * t;
    const float e = __builtin_amdgcn_exp2f((v * v) * (-0.72134752044f));
    const float m = v * (q * e);
    return v < 0.f ? m : v - m;
}
__device__ __forceinline__ void ins16(float (&t)[16], float v) {
#pragma unroll
    for (int i = 15; i >= 1; --i) t[i] = __builtin_amdgcn_fmed3f(t[i - 1], t[i], v);
    t[0] = fmaxf(t[0], v);
}
typedef float f32x32v __attribute__((ext_vector_type(32)));
typedef _Float16 f16x32v __attribute__((ext_vector_type(32)));
typedef _Float16 f16x2v __attribute__((ext_vector_type(2)));
__device__ __forceinline__ float key_tag(float v, unsigned keepmask, unsigned tag) { return __uint_as_float((__float_as_uint(v) & keepmask) | tag); }
template <int I, int J> struct CandLoop {
    static __device__ __forceinline__ void run(const float (&a)[16], const float (&b)[16], float (&c)[16]) {
        if constexpr ((I + 1) * (J + 1) <= 16) { ins16(c, key_tag(a[I] + b[J], ~255u, 255u - (unsigned)(I * 16 + J))); CandLoop<I, J + 1>::run(a, b, c); }
        else if constexpr (I + 1 < 16) CandLoop<I + 1, 0>::run(a, b, c);
    }
};
__device__ __forceinline__ void phase_peer(const Args& A, LAS unsigned char* lds) {
    const int lane = threadIdx.x & 63, wave = threadIdx.x >> 6, gw = blockIdx.x * NWAVES + wave, NGW = gridDim.x * NWAVES;
    LAS unsigned char* wl = lds + wave * 10240;
    LAS float* topL = (LAS float*)wl; LAS int* eidA = (LAS int*)(wl + 4096); LAS float* wgtA = (LAS float*)(wl + 6144); LAS float* coefL = (LAS float*)(wl + 8192);
    LAS float* suL = (LAS float*)(wl + 8704); LAS float* svL = (LAS float*)(wl + 9216);
    const float* SC = (const float*)(A.ws + WS_SC); const bf16_t* HX = (const bf16_t*)(A.ws + WS_HX);
    const unsigned char* UT = A.ws + WS_UT; const unsigned char* VT = A.ws + WS_VT; const float* SU = (const float*)(A.ws + WS_UT + WS_TSCALE); const float* SVs = (const float*)(A.ws + WS_VT + WS_TSCALE);
    const float* mod = (const float*)(A.ws + WS_MOD);
#ifdef PROBE_L2SUBSET
    const int idmask = A.dry ? 2047 : 0x7fffffff;
#else
    const int idmask = 0x7fffffff;
#endif
#ifndef PROBE_SKIP
#define PROBE_SKIP 0
#endif
    const float NEG = -3.0e38f;
    const int h = lane >> 3, tk = (lane >> 1) & 3, p = lane & 1, grp = 2 * h + p;
    for (int pass = gw; pass < M / 4; pass += NGW) {
        {
            float t[16];
#pragma unroll
            for (int i = 0; i < 16; ++i) t[i] = NEG;
            const float* sp = SC + (size_t)pass * 8192 + (grp * 128 + tk) * 4;
#pragma unroll 4
            for (int i = 0; i < 32; ++i) { const f32x4 v = *(const f32x4*)(sp + i * 16); const unsigned tg = 127u - 4u * (unsigned)i;
                ins16(t, key_tag(v[0], ~127u, tg)); ins16(t, key_tag(v[1], ~127u, tg - 1u)); ins16(t, key_tag(v[2], ~127u, tg - 2u)); ins16(t, key_tag(v[3], ~127u, tg - 3u)); }
            float pb[16];
#pragma unroll
            for (int i = 0; i < 16; ++i) { pb[i] = __shfl_xor(t[i], 1); topL[i * 64 + lane] = t[i]; }
            float c[16];
#pragma unroll
            for (int i = 0; i < 16; ++i) c[i] = NEG;
            CandLoop<0, 0>::run(t, pb, c);
            float e[16]; float es = 0.f;
#pragma unroll
            for (int k = 0; k < 16; ++k) { e[k] = __expf(c[k] - c[0]); es += e[k]; }
            const float inv = __builtin_amdgcn_rcpf(es);
            asm volatile("s_waitcnt lgkmcnt(0)" ::: "memory");
            if (p == 0) {
#pragma unroll
                for (int k = 0; k < 16; ++k) { const unsigned code = 255u - (__float_as_uint(c[k]) & 255u);
                    const unsigned ia = 127u - (__float_as_uint(topL[(code >> 4) * 64 + lane]) & 127u), ib = 127u - (__float_as_uint(topL[(code & 15u) * 64 + lane + 1]) & 127u);
                    eidA[tk * 128 + h * 16 + k] = (int)(ia * 128u + ib); wgtA[tk * 128 + h * 16 + k] = e[k] * inv; }
            }
            asm volatile("s_waitcnt lgkmcnt(0)" ::: "memory");
        }
#pragma unroll 1
        for (int tq = 0; tq < 4; ++tq) {
            const int t = pass * 4 + tq; const LAS int* eidL = eidA + tq * 128; const LAS float* wgtL = wgtA + tq * 128;
            const int g = lane & 31, hh = lane >> 5;
            f16x2v xh[16];
            { const float rs = row_rstd((const float*)(A.ws + WS_SSQ), t); const float* sh = mod + (t >> 12) * NMOD + 3 * D + g * 32; const bf16_t* xp = HX + (size_t)t * D + g * 32;
#pragma unroll
              for (int c = 0; c < 4; ++c) { const u32x4 w = *(const u32x4*)(xp + 8 * c); const f32x4 s0 = *(const f32x4*)(sh + 8 * c), s1 = *(const f32x4*)(sh + 8 * c + 4);
                xh[4 * c] = (f16x2v){(_Float16)(bf_lo(w[0]) * rs + s0[0]), (_Float16)(bf_hi(w[0]) * rs + s0[1])}; xh[4 * c + 1] = (f16x2v){(_Float16)(bf_lo(w[1]) * rs + s0[2]), (_Float16)(bf_hi(w[1]) * rs + s0[3])};
                xh[4 * c + 2] = (f16x2v){(_Float16)(bf_lo(w[2]) * rs + s1[0]), (_Float16)(bf_hi(w[2]) * rs + s1[1])}; xh[4 * c + 3] = (f16x2v){(_Float16)(bf_lo(w[3]) * rs + s1[2]), (_Float16)(bf_hi(w[3]) * rs + s1[3])}; } }
            { const int i0 = eidL[lane], i1 = eidL[64 + lane]; suL[lane] = SU[i0]; suL[64 + lane] = SU[i1]; svL[lane] = SVs[i0]; svL[64 + lane] = SVs[i1]; }
            u32x6 rb0[4], rb1[4], rb2[4], rb3[4];
#define LOAD8(buf, TB, hb) do { _Pragma("unroll") for (int r = 0; r < 4; ++r) { const int id = eidL[(hb) * 8 + 2 * r + hh] & idmask; const unsigned char* rp = (TB) + (size_t)id * ROWB; \
                const u32x4 lo = *(const u32x4*)(rp + g * 16); const u32x2 hi2 = *(const u32x2*)(rp + 512 + g * 8); buf[r] = (u32x6){lo[0], lo[1], lo[2], lo[3], hi2[0], hi2[1]}; } } while (0)
#define DOT8(buf, off) do { _Pragma("unroll") for (int r = 0; r < 4; ++r) { const f16x32v dq = __builtin_amdgcn_cvt_scalef32_pk32_f16_fp6(buf[r], 1.0f); \
                float sa = 0.f, sb = 0.f, sc = 0.f, sd = 0.f;     \
                _Pragma("unroll") for (int j = 0; j < 16; j += 4) { sa = __builtin_amdgcn_fdot2((f16x2v){dq[2 * j], dq[2 * j + 1]}, xh[j], sa, false); sb = __builtin_amdgcn_fdot2((f16x2v){dq[2 * j + 2], dq[2 * j + 3]}, xh[j + 1], sb, false); \
                    sc = __builtin_amdgcn_fdot2((f16x2v){dq[2 * j + 4], dq[2 * j + 5]}, xh[j + 2], sc, false); sd = __builtin_amdgcn_fdot2((f16x2v){dq[2 * j + 6], dq[2 * j + 7]}, xh[j + 3], sd, false); } \
                pp[(off) + r] = (sa + sb) + (sc + sd); } } while (0)
#define REDUCE16(kb) do { \
            _Pragma("unroll") for (int e = 0; e < 4; ++e) { const bool up = lane & 16; const float keep = up ? pp[e + 4] : pp[e], send = up ? pp[e] : pp[e + 4]; pp[e] = keep + __shfl_xor(send, 16); } \
            _Pragma("unroll") for (int e = 0; e < 2; ++e) { const bool up = lane & 8; const float keep = up ? pp[e + 2] : pp[e], send = up ? pp[e] : pp[e + 2]; pp[e] = keep + __shfl_xor(send, 8); } \
            { const bool up = lane & 4; const float keep = up ? pp[1] : pp[0], send = up ? pp[0] : pp[1]; pp[0] = keep + __shfl_xor(send, 4); } \
            float hsum = pp[0]; hsum += __shfl_xor(hsum, 2); hsum += __shfl_xor(hsum, 1); \
            const int ke = (kb) * 16 + 2 * ((lane >> 2) & 7) + hh; const float su = suL[ke], sv = svL[ke]; \
            const float cf = wgtL[ke] * gelu_exact(hsum * su) * sv; if ((lane & 3) == 0) coefL[ke] = cf; } while (0)
            float pp[8];
            LOAD8(rb0, UT, 0); LOAD8(rb1, UT, 1); LOAD8(rb2, UT, 2);
            if (!(A.dry && PROBE_SKIP == 3)) { LOAD8(rb3, UT, 3); DOT8(rb0, 0); }
            if (!(A.dry && PROBE_SKIP == 3)) { LOAD8(rb0, UT, 4); DOT8(rb1, 4); REDUCE16(0); }
            if (!(A.dry && PROBE_SKIP == 3)) { LOAD8(rb1, UT, 5); DOT8(rb2, 0); }
            if (!(A.dry && PROBE_SKIP == 3)) { LOAD8(rb2, UT, 6); DOT8(rb3, 4); REDUCE16(1); }
            if (!(A.dry && PROBE_SKIP == 3)) { LOAD8(rb3, UT, 7); DOT8(rb0, 0); }
            if (!(A.dry && PROBE_SKIP == 3)) { LOAD8(rb0, UT, 8); DOT8(rb1, 4); REDUCE16(2); }
            if (!(A.dry && PROBE_SKIP == 3)) { LOAD8(rb1, UT, 9); DOT8(rb2, 0); }
            if (!(A.dry && PROBE_SKIP == 3)) { LOAD8(rb2, UT, 10); DOT8(rb3, 4); REDUCE16(3); }
            if (!(A.dry && PROBE_SKIP == 3)) { LOAD8(rb3, UT, 11); DOT8(rb0, 0); }
            if (!(A.dry && PROBE_SKIP == 3)) { LOAD8(rb0, UT, 12); DOT8(rb1, 4); REDUCE16(4); }
            if (!(A.dry && PROBE_SKIP == 3)) { LOAD8(rb1, UT, 13); DOT8(rb2, 0); }
            if (!(A.dry && PROBE_SKIP == 3)) { LOAD8(rb2, UT, 14); DOT8(rb3, 4); REDUCE16(5); }
            if (!(A.dry && PROBE_SKIP == 3)) { LOAD8(rb3, UT, 15); DOT8(rb0, 0); }
            if (!(A.dry && PROBE_SKIP == 3)) { LOAD8(rb0, VT, 0); DOT8(rb1, 4); REDUCE16(6); }
            if (!(A.dry && PROBE_SKIP == 3)) { LOAD8(rb1, VT, 1); DOT8(rb2, 0); }
            if (!(A.dry && PROBE_SKIP == 3)) { LOAD8(rb2, VT, 2); DOT8(rb3, 4); REDUCE16(7); }
            asm volatile("s_waitcnt lgkmcnt(0)" ::: "memory");
            f32x2 y2[16];
#pragma unroll
            for (int j = 0; j < 16; ++j) y2[j] = (f32x2){0.f, 0.f};
#define VACC8(buf, hb) do { _Pragma("unroll") for (int r = 0; r < 4; ++r) { const float cf = coefL[(hb) * 8 + 2 * r + hh]; const f32x2 cf2 = {cf, cf}; \
                const f32x32v dq = __builtin_amdgcn_cvt_scalef32_pk32_f32_fp6(buf[r], 1.0f); \
                _Pragma("unroll") for (int j = 0; j < 16; ++j) y2[j] += cf2 * (f32x2){dq[2 * j], dq[2 * j + 1]}; } } while (0)
            if (!(A.dry && PROBE_SKIP == 4)) { LOAD8(rb3, VT, 3); VACC8(rb0, 0); }
            if (!(A.dry && PROBE_SKIP == 4)) { LOAD8(rb0, VT, 4); VACC8(rb1, 1); }
            if (!(A.dry && PROBE_SKIP == 4)) { LOAD8(rb1, VT, 5); VACC8(rb2, 2); }
            if (!(A.dry && PROBE_SKIP == 4)) { LOAD8(rb2, VT, 6); VACC8(rb3, 3); }
            if (!(A.dry && PROBE_SKIP == 4)) { LOAD8(rb3, VT, 7); VACC8(rb0, 4); }
            if (!(A.dry && PROBE_SKIP == 4)) { LOAD8(rb0, VT, 8); VACC8(rb1, 5); }
            if (!(A.dry && PROBE_SKIP == 4)) { LOAD8(rb1, VT, 9); VACC8(rb2, 6); }
            if (!(A.dry && PROBE_SKIP == 4)) { LOAD8(rb2, VT, 10); VACC8(rb3, 7); }
            if (!(A.dry && PROBE_SKIP == 4)) { LOAD8(rb3, VT, 11); VACC8(rb0, 8); }
            if (!(A.dry && PROBE_SKIP == 4)) { LOAD8(rb0, VT, 12); VACC8(rb1, 9); }
            if (!(A.dry && PROBE_SKIP == 4)) { LOAD8(rb1, VT, 13); VACC8(rb2, 10); }
            if (!(A.dry && PROBE_SKIP == 4)) { LOAD8(rb2, VT, 14); VACC8(rb3, 11); }
            if (!(A.dry && PROBE_SKIP == 4)) { LOAD8(rb3, VT, 15); VACC8(rb0, 12); }
            if (!(A.dry && PROBE_SKIP == 4)) { VACC8(rb1, 13); }
            if (!(A.dry && PROBE_SKIP == 4)) { VACC8(rb2, 14); }
            if (!(A.dry && PROBE_SKIP == 4)) { VACC8(rb3, 15); }
#undef LOAD8
#undef DOT8
#undef REDUCE16
#undef VACC8
            float yy[16];
#pragma unroll
            for (int j = 0; j < 16; ++j) { const float a = y2[j][0] + __shfl_xor(y2[j][0], 32), b = y2[j][1] + __shfl_xor(y2[j][1], 32); if ((j >> 3) == hh) { yy[2 * (j & 7)] = a; yy[2 * (j & 7) + 1] = b; } }
            const float* g2 = mod + (t >> 12) * NMOD + 5 * D; float* orow = A.out + (size_t)t * D;
            float z[16]; float ss = 0.f;
#pragma unroll
            for (int q = 0; q < 4; ++q) { const int k = g * 32 + hh * 16 + q * 4; const f32x4 xv = *(const f32x4*)(orow + k), gv = *(const f32x4*)(g2 + k);
#pragma unroll
                for (int j = 0; j < 4; ++j) { const float zz = xv[j] + gv[j] * yy[q * 4 + j]; z[q * 4 + j] = zz; ss += zz * zz; } }
            const float r = rsqrtf(wave_sum(ss) * (1.f / D) + EPS);
#pragma unroll
            for (int q = 0; q < 4; ++q) { const int k = g * 32 + hh * 16 + q * 4; const f32x4 fv = *(const f32x4*)(A.fg + k);
                f32x4 o;
#pragma unroll
                for (int j = 0; j < 4; ++j) o[j] = z[q * 4 + j] * r * fv[j];
                if (!A.dry || r < 0.f) *(f32x4*)(orow + k) = o; }
        }
    }
}
#define XB_TMO      128
#define XB_XCNT(j)  (256  + 64 * (j))
#define XB_XSUB(j)  (1280 + 64 * (j))
#define XB_XGEN(j)  (2304 + 64 * (j))
#define XB_TOP      3328
#define XB_TOPGEN   3392
#define XCD_BAR_WORDS 3456
#define XB_SPIN_CAP (1u << 22)
__device__ __forceinline__ unsigned xb_ld(unsigned* p)              { return __hip_atomic_load(p, __ATOMIC_RELAXED, __HIP_MEMORY_SCOPE_AGENT); }
__device__ __forceinline__ unsigned xb_add(unsigned* p, unsigned v) { return __hip_atomic_fetch_add(p, v, __ATOMIC_RELAXED, __HIP_MEMORY_SCOPE_AGENT); }
__device__ __forceinline__ unsigned xb_xcc_id() { return (unsigned)__builtin_amdgcn_s_getreg((3 << 11) | 20) & 0xFu; }
#define XB_SPIN(cond, bar) do { unsigned _sp = 0; while (cond) { __builtin_amdgcn_s_sleep(1); \
    if ((++_sp & 255u) == 0u) { if (xb_ld(&(bar)[XB_TMO])) break; if (_sp > XB_SPIN_CAP) { atomicAdd(&(bar)[XB_TMO], 1u); break; } } } } while (0)
struct XcdBarrier { unsigned* bar; unsigned x; volatile LAS unsigned* st; };
__device__ __forceinline__ XcdBarrier xcd_barrier_post(unsigned* bar, volatile LAS unsigned* st) {
    XcdBarrier b; b.bar = bar; b.x = xb_xcc_id(); b.st = st;
    if (threadIdx.x == 0) (void)xb_add(&bar[XB_XCNT(b.x)], 1u);
    return b;
}
__device__ __forceinline__ void xcd_barrier_complete(unsigned* bar, unsigned x, unsigned& nloc, unsigned& nx) {
    const unsigned G = gridDim.x * gridDim.y * gridDim.z;
    unsigned sum, cnt, mine, sp = 0u;
    for (;;) {
        sum = 0u; cnt = 0u; mine = 0u;
#pragma unroll
        for (unsigned j = 0; j < 16; ++j) { const unsigned c = xb_ld(&bar[XB_XCNT(j)]); sum += c; cnt += (c > 0u) ? 1u : 0u; mine = (j == x) ? c : mine; }
        if (sum == G) break;
        __builtin_amdgcn_s_sleep(1);
        if ((++sp & 255u) == 0u) { if (xb_ld(&bar[XB_TMO])) break; if (sp > XB_SPIN_CAP) { atomicAdd(&bar[XB_TMO], 1u); break; } }
    }
    nloc = mine > 0u ? mine : 1u; nx = cnt > 0u ? cnt : 1u;
}
__device__ __forceinline__ void xcd_barrier(const XcdBarrier& b) {
    asm volatile("s_waitcnt vmcnt(0)" ::: "memory");
    __syncthreads();
    if (threadIdx.x == 0) {
        unsigned* bar = b.bar;
        __builtin_amdgcn_s_waitcnt(0);
        unsigned nloc = b.st[0], nx = b.st[1];
        if (nloc == 0u) { xcd_barrier_complete(bar, b.x, nloc, nx); b.st[0] = nloc; b.st[1] = nx; }
        const unsigned old = xb_add(&bar[XB_XSUB(b.x)], 1u);
        const unsigned gen = old / nloc;
        if (old + 1u == (gen + 1u) * nloc) {
            __builtin_amdgcn_fence(__ATOMIC_RELEASE, "agent");
            asm volatile("s_waitcnt vmcnt(0)" ::: "memory");
            const unsigned og = xb_add(&bar[XB_TOP], 1u);
            const unsigned tg = og / nx;
            if (og + 1u == (tg + 1u) * nx) xb_add(&bar[XB_TOPGEN], 1u);
            else XB_SPIN(xb_ld(&bar[XB_TOPGEN]) == tg, bar);
            __builtin_amdgcn_fence(__ATOMIC_ACQUIRE, "agent");
            xb_add(&bar[XB_XGEN(b.x)], 1u);
            asm volatile("s_waitcnt vmcnt(0)" ::: "memory");
        } else {
            XB_SPIN(xb_ld(&bar[XB_XGEN(b.x)]) == gen, bar);
            __builtin_amdgcn_fence(__ATOMIC_ACQUIRE, "agent");
            asm volatile("s_waitcnt vmcnt(0)" ::: "memory");
        }
    }
    __syncthreads();
}
constexpr int MISC_OFF = 135168;

constexpr int N_PHASES = 9;
__global__ void __launch_bounds__(NWAVES * 64, 2) mega_fwd(Args A) {
    extern __shared__ __attribute__((aligned(16))) unsigned char lds[];
    LAS unsigned char* L = (LAS unsigned char*)lds;
    cg::grid_group grid = cg::this_grid();
    const int lo = A.ph_lo, hi = A.ph_hi, G = gridDim.x, c = blockIdx.x;
#ifndef PH_MASK
#define PH_MASK 0x1FF
#endif
#define IN(k) (((PH_MASK >> (k)) & 1) && lo <= (k) && (k) < hi)
    unsigned* barw = (unsigned*)(A.ws + WS_CTL);
    volatile LAS unsigned* MISC = (volatile LAS unsigned*)(L + MISC_OFF);
    if (threadIdx.x < 2) MISC[threadIdx.x] = 0u;
    if (lo == 0 && hi > 1 && blockIdx.x == 0) for (int i = threadIdx.x; i < XCD_BAR_WORDS; i += NWAVES * 64) barw[i] = 0u;
    XcdBarrier xb; xb.bar = barw; xb.x = 0; xb.st = MISC;
#define SEAM(k) do { if (IN(k) && IN((k) + 1)) { if ((k) == 0) { grid.sync(); xb = xcd_barrier_post(barw, MISC); } else xcd_barrier(xb); } } while (0)
    if (IN(0)) phase_prologue(A, L);
    SEAM(0);
    if (IN(1)) phase_hx(A);
    SEAM(1);
    if (IN(2)) { SchedInProj Sd{(const char*)(A.ws + WS_HX), (const char*)(A.ws + WS_HC), (const char*)(A.ws + WS_WIN), G, c}; EpiInProj E{A.ws};
        pg8::gemm_phase<EpiInProj, SchedInProj, true>(L, D, Sd, E); }
    SEAM(2);
    if (IN(3)) { phase_kfix(A); phase_vt(A, L); __syncthreads(); phase_conv(A, L); }
    SEAM(3);
    if (IN(4)) phase_attn(A, lds);
    SEAM(4);
    if (IN(5)) { SchedMerge Sd{(const char*)(A.ws + WS_Q), (const char*)(A.ws + WS_HX), (const char*)(A.ws + WS_WA), (const char*)(A.ws + WS_WC), G, c}; EpiMerge E{A.ws};
        pg8::gemm_phase<EpiMerge, SchedMerge, true>(L, D, Sd, E); }
    SEAM(5);
    if (IN(6)) { SchedPlain Sd{(const char*)(A.ws + WS_G), (const char*)(A.ws + WS_WO), M / 256, D / 256, G, c};
        EpiOut E{A.x, (const float*)(A.ws + WS_MOD), A.n2g, A.out, (bf16_t*)(A.ws + WS_HX), (float*)(A.ws + WS_SSQ)};
        pg8::gemm_phase<EpiOut, SchedPlain, true>(L, D, Sd, E); }
    SEAM(6);
    if (IN(7)) { SchedPlain Sd{(const char*)(A.ws + WS_HX), (const char*)(A.ws + WS_WP), M / 256, PW / 256, G, c};
        EpiScores E{(float*)(A.ws + WS_SC), (const float*)(A.ws + WS_SSQ), (const float*)(A.ws + WS_SBIAS)};
        pg8::gemm_phase<EpiScores, SchedPlain, true>(L, D, Sd, E); }
    SEAM(7);
    if (IN(8)) phase_peer(A, L);
#undef IN
#undef SEAM
}

#ifndef MK_ONE_LAUNCH
#define MK_ONE_LAUNCH 1
#endif
extern "C" void kernel_launch(void* const* d_in, const int* in_sizes, int n_in, void* d_out, int out_size, void* d_ws, size_t ws_size, hipStream_t stream) {
    static int grid = 0;
    if (grid == 0) {
        if (n_in != 23 || out_size != M * D || ws_size < WS_END) { fprintf(stderr, "kernel_launch: unexpected shapes (n_in %d out %d ws %zu)\n", n_in, out_size, ws_size); grid = -1; return; }
        int dev = 0, cus = 0, per_cu = 0;
        hipGetDevice(&dev); hipDeviceGetAttribute(&cus, hipDeviceAttributeMultiprocessorCount, dev);
        if (hipFuncSetAttribute((const void*)mega_fwd, hipFuncAttributeMaxDynamicSharedMemorySize, LDS_BYTES) != hipSuccess) { fprintf(stderr, "kernel_launch: hipFuncSetAttribute failed\n"); grid = -1; return; }
        if (hipOccupancyMaxActiveBlocksPerMultiprocessor(&per_cu, (const void*)mega_fwd, NWAVES * 64, LDS_BYTES) != hipSuccess || per_cu < 1) { fprintf(stderr, "kernel_launch: occupancy query says %d\n", per_cu); per_cu = 1; }
        (void)hipGetLastError();
        grid = cus * 1;
        if (per_cu < 1) grid = -1;
    }
    if (grid < 0) return;
    Args a{};
    const float** f = (const float**)&a;
    for (int i = 0; i < 23; ++i) f[i] = (const float*)d_in[i];
    a.out = (float*)d_out; a.ws = (unsigned char*)d_ws;
#if MK_ONE_LAUNCH
    a.ph_lo = 0; a.ph_hi = N_PHASES;
    void* args[] = {&a};
    hipError_t e = hipLaunchCooperativeKernel((const void*)mega_fwd, dim3(grid), dim3(NWAVES * 64), args, LDS_BYTES, stream);
    if (e != hipSuccess) fprintf(stderr, "cooperative launch failed: %s (grid %d)\n", hipGetErrorString(e), grid);
#else
#ifndef REPEAT_PH
#define REPEAT_PH -1
#endif
    for (int p = 0; p < N_PHASES; ++p) { a.ph_lo = p; a.ph_hi = p + 1;
        if (p == REPEAT_PH) { a.dry = 1; hipLaunchKernelGGL(mega_fwd, dim3(grid), dim3(NWAVES * 64), LDS_BYTES, stream, a); a.dry = 0; }
        hipLaunchKernelGGL(mega_fwd, dim3(grid), dim3(NWAVES * 64), LDS_BYTES, stream, a); }
#endif
}
```

```cpp
#include <hip/hip_runtime.h>
#include <hip/hip_cooperative_groups.h>
#include <cstdio>
#include <cstdint>
namespace cg = cooperative_groups;

#define LAS __attribute__((address_space(3)))
typedef unsigned short bf16_t;
typedef short bf16x8 __attribute__((ext_vector_type(8)));
typedef short s16x4 __attribute__((ext_vector_type(4)));
typedef float f32x2 __attribute__((ext_vector_type(2)));
typedef float f32x4 __attribute__((ext_vector_type(4)));
typedef float f32x16 __attribute__((ext_vector_type(16)));
typedef unsigned u32x2 __attribute__((ext_vector_type(2)));
typedef unsigned u32x4 __attribute__((ext_vector_type(4)));
typedef __bf16 bf16x2_t __attribute__((ext_vector_type(2)));

constexpr int D = 1024, NB = 8, S = 4096, CTXL = 256, SKV = S + CTXL, HD = 128, HQ = 8, HKV = 2;
constexpr int M = NB * S;
constexpr int MC = NB * CTXL;
constexpr int INW = 5632, NMOD = 6144, NEXP = 16384, PW = 2048;
constexpr float EPS = 1e-6f;

__device__ __forceinline__ unsigned cvt_pk_bf16(float lo, float hi) { f32x2 v = {lo, hi}; bf16x2_t b = __builtin_convertvector(v, bf16x2_t); return __builtin_bit_cast(unsigned, b); }
__device__ __forceinline__ float bf_lo(unsigned u) { return __uint_as_float(u << 16); }
__device__ __forceinline__ float bf_hi(unsigned u) { return __uint_as_float(u & 0xffff0000u); }
__device__ __forceinline__ float fast_sigmoid(float x) { return __builtin_amdgcn_rcpf(1.f + __builtin_amdgcn_exp2f(-1.4426950408889634f * x)); }
__device__ __forceinline__ float wave_sum(float v) {
#pragma unroll
    for (int o = 1; o < 64; o <<= 1) v += __shfl_xor(v, o);
    return v;
}

namespace pg8 {
constexpr int BM = 256, BK = 64, HALF = 128, HTB = HALF * BK * 2  , STAGE_BYTES = 8 * HTB, NXCD = 8, WGM = 8;
__host__ __device__ __forceinline__ int lds_byte(int r, int c) { const int st = (r >> 4) * 2 + (c >> 5), rr = r & 15, cc = c & 31, ob = rr * 64 + cc * 2; return st * 1024 + (ob ^ (((ob >> 9) & 1) << 5)); }
__host__ __device__ __forceinline__ void stage_rc(int b, int& R, int& C) { const int st = b / 1024, sb = b % 1024, swz = sb ^ (((sb >> 9) & 1) << 5); R = (st >> 1) * 16 + swz / 64; C = (st & 1) * 32 + (swz % 64) / 2; }
__host__ __device__ __forceinline__ int perm32(int rho) { const int n = rho >> 4, i = rho & 15; return 8 * (i >> 2) + 4 * n + (i & 3); }

struct Unit { const char* a; const char* b; int pm, pn, kind, keep; };

__device__ __forceinline__ void tile_of(int L, int nM, int nN, int& pm, int& pn) {
    const int nwg = nM * nN; int wgid = L;
    { const int q = nwg / NXCD, r = nwg % NXCD, xcd = wgid % NXCD, off = wgid / NXCD; wgid = (xcd < r ? xcd * (q + 1) : r * (q + 1) + (xcd - r) * q) + off; }
    const int nig = WGM * nN, gid = wgid / nig, fm = gid * WGM, gsz = (nM - fm) < WGM ? (nM - fm) : WGM;
    pm = fm + ((wgid % nig) % gsz); pn = (wgid % nig) / gsz;
}

template <class Epi, class Sched, bool ALIGN_EPI>
__device__ __forceinline__ void gemm_phase(LAS unsigned char* lds, const int K, const Sched& S, const Epi& E) {
    const int tid = threadIdx.x, wid = __builtin_amdgcn_readfirstlane(tid >> 6), lane = tid & 63, wr = wid >> 2, wc = wid & 3, fr = lane & 15, fq = lane >> 4;
    const int nt = K / BK;
    unsigned voffA[2], voffB[2];
#pragma unroll
    for (int i = 0; i < 2; ++i) { int R, C; stage_rc(tid * 16 + i * 8192, R, C); const int Rb = Epi::PERM ? ((R & ~31) + perm32(R & 31)) : R;
        voffA[i] = (unsigned)(R * K + C) * 2u; voffB[i] = (unsigned)(Rb * K + C) * 2u; }
    const size_t kstep = (size_t)(BK * 2);
    const size_t hstep = (size_t)HALF * K * 2;
    const unsigned ldsw = (unsigned)wid * 1024u;
    const int aoff = lds_byte(wr * 64 + fr, fq * 8), boff = lds_byte(wc * 32 + fr, fq * 8);
#define PG8_SA(b, h) (((b) * 2 + (h)) * HTB)
#define PG8_SB(b, h) ((4 + (b) * 2 + (h)) * HTB)
#define PG8_STAGE(bufoff, gbase, voff) do { _Pragma("unroll") for (int _i = 0; _i < 2; ++_i) \
        __builtin_amdgcn_global_load_lds((const unsigned*)((const char*)(gbase) + (voff)[_i]), (LAS unsigned*)(lds + (bufoff) + ldsw + _i * 8192), 16, 0, 0); } while (0)
#define PG8_LDA(dst, b, h) do { _Pragma("unroll") for (int m = 0; m < 4; ++m) _Pragma("unroll") for (int k = 0; k < 2; ++k) dst[m][k] = *(const LAS bf16x8*)(lds + PG8_SA(b, h) + aoff + m * 2048 + k * 1024); } while (0)
#define PG8_LDB(dst, b, h) do { _Pragma("unroll") for (int n = 0; n < 2; ++n) _Pragma("unroll") for (int k = 0; k < 2; ++k) dst[n][k] = *(const LAS bf16x8*)(lds + PG8_SB(b, h) + boff + n * 2048 + k * 1024); } while (0)
#define PG8_MMA(ai, bj, At, Bt) do { __builtin_amdgcn_s_setprio(1); _Pragma("unroll") for (int m = 0; m < 4; ++m) _Pragma("unroll") for (int n = 0; n < 2; ++n) _Pragma("unroll") for (int k = 0; k < 2; ++k) \
        acc[ai][bj][m][n] = __builtin_amdgcn_mfma_f32_16x16x32_bf16(Bt[n][k], At[m][k], acc[ai][bj][m][n], 0, 0, 0); __builtin_amdgcn_s_setprio(0); } while (0)
#define PG8_WAIT_V(n) asm volatile("s_waitcnt vmcnt(" #n ")" ::: "memory")
#define PG8_WAIT_L(n) asm volatile("s_waitcnt lgkmcnt(" #n ")" ::: "memory")
#define PG8_BAR __builtin_amdgcn_s_barrier()
#define PG8_SCHED __builtin_amdgcn_sched_barrier(0)
    Unit cur, nxt; int ui = 0;
    if (!S.next(0, cur)) return;
    f32x4 acc[2][2][4][2];
#pragma unroll
    for (int a = 0; a < 2; ++a)
#pragma unroll
        for (int b = 0; b < 2; ++b)
#pragma unroll
            for (int m = 0; m < 4; ++m)
#pragma unroll
                for (int n = 0; n < 2; ++n) acc[a][b][m][n] = (f32x4){0.f, 0.f, 0.f, 0.f};
    bf16x8 At[4][2], B0[2][2], B1[2][2];
    const char* cA = cur.a; const char* cB = cur.b;
    PG8_STAGE(PG8_SB(0, 0), cB, voffB); PG8_STAGE(PG8_SB(0, 1), cB + hstep, voffB); PG8_STAGE(PG8_SA(0, 0), cA, voffA); PG8_STAGE(PG8_SA(0, 1), cA + hstep, voffA);
    if (wr == 1) PG8_BAR;
    PG8_WAIT_V(2); PG8_BAR;
    PG8_STAGE(PG8_SB(1, 0), cB + kstep, voffB); PG8_STAGE(PG8_SA(1, 0), cA + kstep, voffA); PG8_STAGE(PG8_SB(1, 1), cB + hstep + kstep, voffB);
    PG8_WAIT_V(6); PG8_BAR;
    for (;;) {
        const bool has_next = S.next(ui + 1, nxt);
        const char* nA = has_next ? nxt.a : cA; const char* nB = has_next ? nxt.b : cB;
        for (int t = 0; t < nt; t += 2) {
            const bool last = (t == nt - 2);
            const char* a1 = cA + (size_t)(t + 1) * kstep;
            const char* a2 = last ? nA : cA + (size_t)(t + 2) * kstep; const char* b2 = last ? nB : cB + (size_t)(t + 2) * kstep;
            const char* a3 = a2 + kstep; const char* b3 = b2 + kstep;
            PG8_LDB(B0, 0, 0); PG8_LDB(B1, 0, 1); PG8_SCHED; PG8_LDA(At, 0, 0); PG8_STAGE(PG8_SA(1, 1), a1 + hstep, voffA);
            PG8_WAIT_V(8); PG8_WAIT_L(0); PG8_BAR; PG8_MMA(0, 0, At, B0); PG8_MMA(0, 1, At, B1); PG8_BAR; PG8_SCHED;
            PG8_LDA(At, 0, 1); PG8_STAGE(PG8_SB(0, 0), b2, voffB); PG8_STAGE(PG8_SB(0, 1), b2 + hstep, voffB); PG8_STAGE(PG8_SA(0, 0), a2, voffA);
            PG8_WAIT_V(8); PG8_WAIT_L(0); PG8_BAR; PG8_MMA(1, 0, At, B0); PG8_MMA(1, 1, At, B1); PG8_BAR; PG8_SCHED;
            PG8_LDB(B0, 1, 0); PG8_LDB(B1, 1, 1); PG8_SCHED; PG8_LDA(At, 1, 0); PG8_STAGE(PG8_SA(0, 1), a2 + hstep, voffA);
            PG8_WAIT_V(8); PG8_WAIT_L(0); PG8_BAR; PG8_MMA(0, 0, At, B0); PG8_MMA(0, 1, At, B1); PG8_BAR; PG8_SCHED;
            PG8_LDA(At, 1, 1); PG8_STAGE(PG8_SB(1, 0), b3, voffB); PG8_STAGE(PG8_SB(1, 1), b3 + hstep, voffB); PG8_STAGE(PG8_SA(1, 0), a3, voffA);
            PG8_WAIT_V(8); PG8_WAIT_L(0); PG8_BAR; PG8_MMA(1, 0, At, B0); PG8_MMA(1, 1, At, B1); PG8_BAR; PG8_SCHED;
        }
        if constexpr (ALIGN_EPI) { if (wr == 0) PG8_BAR; }
        E(acc, cur, wr, wc, fr, fq);
        if (!has_next) break;
        if (!cur.keep) {
#pragma unroll
        for (int a = 0; a < 2; ++a)
#pragma unroll
            for (int b = 0; b < 2; ++b)
#pragma unroll
                for (int m = 0; m < 4; ++m)
#pragma unroll
                    for (int n = 0; n < 2; ++n) acc[a][b][m][n] = (f32x4){0.f, 0.f, 0.f, 0.f};
        }
        cur = nxt; cA = nA; cB = nB; ++ui;
        if constexpr (ALIGN_EPI) { if (wr == 1) PG8_BAR; }
    }
    PG8_WAIT_V(0);
    if constexpr (!ALIGN_EPI) { if (wr == 0) PG8_BAR; }
    PG8_BAR;
#undef PG8_SA
#undef PG8_SB
#undef PG8_STAGE
#undef PG8_LDA
#undef PG8_LDB
#undef PG8_MMA
#undef PG8_WAIT_V
#undef PG8_WAIT_L
#undef PG8_BAR
#undef PG8_SCHED
}
}
namespace att {
typedef int v8i __attribute__((ext_vector_type(8)));
constexpr int NW = 8, QBLK = 32, KVBLK = 64;
constexpr float SCALE = 0.088388347648318440f;
constexpr float SC8 = SCALE / 256.f;
constexpr float THR = 3.f;
constexpr int LDQ = D, LDO = D;
constexpr int SHM_V = 8192, SHM_K = 8192, NRING = 3, OFF_K = NRING * SHM_V, OFF_WS = OFF_K + NRING * SHM_K, OST_OFF = OFF_WS + NW * 64 * 4, LDS_TOTAL = OST_OFF + NW * 8192;
#define SBAR() __builtin_amdgcn_sched_barrier(0)
#define MFMA8(a, b, c) __builtin_amdgcn_mfma_scale_f32_32x32x64_f8f6f4((a), (b), (c), 0, 0, 0, 0x7f7f7f7f, 0, 0x7f7f7f7f)
__device__ __forceinline__ int crow(int r, int hi) { return (r & 3) + 8 * (r >> 2) + 4 * hi; }
__device__ __forceinline__ int k_lds(int row, int chunk) { return row * 128 + ((chunk ^ ((row >> 1) & 7)) << 4); }
__device__ __forceinline__ int v_lds(int d, int slot) { return d * 64 + ((slot ^ ((d >> 2) & 3)) << 4); }
__device__ __forceinline__ int pk4_fp8(float a, float b, float c, float d) { int w = __builtin_amdgcn_cvt_pk_fp8_f32(a, b, 0, false); return __builtin_amdgcn_cvt_pk_fp8_f32(c, d, w, true); }

__device__ __forceinline__ void partialSM(f32x16& p0, f32x16& p1, float& m_reg, float& mn, float& alpha) {
  constexpr float C = SC8 * 1.4426950408889634f;
  float mx[8];
#pragma unroll
  for (int i = 0; i < 8; ++i) mx[i] = fmaxf(fmaxf(p0[i], p0[8 + i]), fmaxf(p1[i], p1[8 + i]));
  float pmax = fmaxf(fmaxf(fmaxf(mx[0], mx[1]), fmaxf(mx[2], mx[3])), fmaxf(fmaxf(mx[4], mx[5]), fmaxf(mx[6], mx[7])));
  { auto rr = __builtin_amdgcn_permlane32_swap(__float_as_uint(pmax), __float_as_uint(pmax), false, false);
    pmax = fmaxf(__uint_as_float(rr[0]), __uint_as_float(rr[1])); }
  if (__builtin_expect(__all(pmax - m_reg <= THR / SC8), 1)) { mn = m_reg; alpha = 1.f; }
  else { mn = fmaxf(m_reg, pmax); alpha = __builtin_amdgcn_exp2f((m_reg - mn) * C); m_reg = mn; }
  float mnC = 4.f - mn * C;
  for (int r = 0; r < 16; ++r) p0[r] = fmaf(p0[r], C, mnC); for (int r = 0; r < 16; ++r) p1[r] = fmaf(p1[r], C, mnC);
  for (int r = 0; r < 16; ++r) p0[r] = __builtin_amdgcn_exp2f(p0[r]);
}
__device__ __forceinline__ void finishSM(f32x16& p0, f32x16& p1, float alpha, float& l_reg, v8i& pa) {
  for (int r = 0; r < 16; ++r) p1[r] = __builtin_amdgcn_exp2f(p1[r]);
  float sm[8];
#pragma unroll
  for (int i = 0; i < 8; ++i) sm[i] = (p0[i] + p0[8 + i]) + (p1[i] + p1[8 + i]);
  float ps = ((sm[0] + sm[1]) + (sm[2] + sm[3])) + ((sm[4] + sm[5]) + (sm[6] + sm[7]));
  { auto rr = __builtin_amdgcn_permlane32_swap(__float_as_uint(ps), __float_as_uint(ps), false, false);
    ps = __uint_as_float(rr[0]) + __uint_as_float(rr[1]); }
  l_reg = l_reg * alpha + ps;
  pa[0] = pk4_fp8(p0[0], p0[1], p0[2], p0[3]); pa[1] = pk4_fp8(p0[4], p0[5], p0[6], p0[7]); pa[2] = pk4_fp8(p0[8], p0[9], p0[10], p0[11]); pa[3] = pk4_fp8(p0[12], p0[13], p0[14], p0[15]);
  pa[4] = pk4_fp8(p1[0], p1[1], p1[2], p1[3]); pa[5] = pk4_fp8(p1[4], p1[5], p1[6], p1[7]); pa[6] = pk4_fp8(p1[8], p1[9], p1[10], p1[11]); pa[7] = pk4_fp8(p1[12], p1[13], p1[14], p1[15]);
}
__device__ __forceinline__ v8i ld32(const char* p0, const char* p1) { const u32x4 a = *reinterpret_cast<const u32x4*>(p0), b = *reinterpret_cast<const u32x4*>(p1);
  v8i r; r[0] = (int)a[0]; r[1] = (int)a[1]; r[2] = (int)a[2]; r[3] = (int)a[3]; r[4] = (int)b[0]; r[5] = (int)b[1]; r[6] = (int)b[2]; r[7] = (int)b[3]; return r; }
__device__ __forceinline__ void qkt(f32x16& p0, f32x16& p1, const char* Ks, const v8i* qf, int r32, int hi) {
  p0 = f32x16{}; p1 = f32x16{};
#pragma unroll
  for (int s = 0; s < 2; ++s) {
    const v8i a0 = ld32(Ks + k_lds(r32, 4 * s + hi), Ks + k_lds(r32, 4 * s + 2 + hi)), a1 = ld32(Ks + k_lds(32 + r32, 4 * s + hi), Ks + k_lds(32 + r32, 4 * s + 2 + hi));
    p0 = MFMA8(a0, qf[s], p0); p1 = MFMA8(a1, qf[s], p1); }
}
__device__ __forceinline__ void pv(f32x16* o, const char* Vs, const v8i pa, int r32, int hi) {
#pragma unroll
  for (int d0 = 0; d0 < 4; ++d0) { const int d = 32 * d0 + r32; const v8i b = ld32(Vs + v_lds(d, 2 * hi), Vs + v_lds(d, 2 * hi + 1)); o[d0] = MFMA8(pa, b, o[d0]); }
}

__device__ __forceinline__ void attn_unit(const bf16_t* Qb, const unsigned char* __restrict__ K8, const unsigned char* __restrict__ VT, bf16_t* Ob, int t0, int seq,
                                          const float* __restrict__ qng, const float* __restrict__ cst, const float* __restrict__ snt, char* lds) {
  int tid_ = threadIdx.x; asm volatile("" : "+v"(tid_));
  const int tid = tid_, wid = tid >> 6, lane = tid & 63, r32 = lane & 31, hi = lane >> 5;
  char* V_lds = lds; char* K_lds = lds + OFF_K;
  float* ws = (float*)(lds + OFF_WS) + wid * 64; float* li_l = ws; float* al_l = ws + 32;
  float m_reg = -1e30f, l_reg = 0; f32x16 o[4] = {}; v8i qf[2];
  {
    const bf16_t* Qw = Qb + (long)(wid * QBLK + r32) * LDQ + 16 * hi;
    float y[2][32]; float ss = 0.f;
#pragma unroll
    for (int s = 0; s < 2; ++s)
#pragma unroll
      for (int part = 0; part < 2; ++part)
#pragma unroll
        for (int c = 0; c < 2; ++c) { const u32x4 w = *reinterpret_cast<const u32x4*>(Qw + 64 * s + 32 * part + 8 * c);
#pragma unroll
          for (int j = 0; j < 4; ++j) { const float a = bf_lo(w[j]), b = bf_hi(w[j]); y[s][16 * part + 8 * c + 2 * j] = a; y[s][16 * part + 8 * c + 2 * j + 1] = b; ss += a * a + b * b; } }
    ss += __shfl_xor(ss, 32);
    const float rstd = rsqrtf(ss * (1.f / HD) + EPS) * 16.f;
    const int t = t0 + wid * QBLK + r32;
#pragma unroll
    for (int s = 0; s < 2; ++s) { const int pos = s == 0 ? (t >> 6) : (t & 63);
#pragma unroll
      for (int c = 0; c < 4; ++c) { const int i0 = 16 * hi + 4 * c;
        const f32x4 g1 = *reinterpret_cast<const f32x4*>(qng + 64 * s + i0), g2 = *reinterpret_cast<const f32x4*>(qng + 64 * s + 32 + i0);
        const f32x4 c4 = *reinterpret_cast<const f32x4*>(cst + pos * 32 + i0), s4 = *reinterpret_cast<const f32x4*>(snt + pos * 32 + i0);
#pragma unroll
        for (int j = 0; j < 4; ++j) { const float x1 = y[s][4 * c + j] * rstd * g1[j], x2 = y[s][16 + 4 * c + j] * rstd * g2[j]; y[s][4 * c + j] = x1 * c4[j] - x2 * s4[j]; y[s][16 + 4 * c + j] = x1 * s4[j] + x2 * c4[j]; } }
#pragma unroll
      for (int w = 0; w < 8; ++w) qf[s][w] = pk4_fp8(y[s][4 * w], y[s][4 * w + 1], y[s][4 * w + 2], y[s][4 * w + 3]); }
  }
  const int krow = tid >> 3, kch = tid & 7, kst = k_lds(krow, kch), vst = v_lds(tid >> 2, tid & 3);
  const unsigned char* kg = K8 + (long)krow * 256 + kch * 16; const unsigned char* vg = VT + tid * 16;
  struct { u32x4 k, v; } sr_[2];
#define SLOAD(i, kt) do { sr_[i].k = *reinterpret_cast<const u32x4*>(kg + (long)(kt) * (KVBLK * 256)); sr_[i].v = *reinterpret_cast<const u32x4*>(vg + (long)(kt) * 8192); } while (0)
#define SWRITE(boff, i) do { *(u32x4*)(V_lds + (boff) + vst) = sr_[i].v; *(u32x4*)(K_lds + (boff) + kst) = sr_[i].k; } while (0)
#define SWAIT() asm volatile("s_waitcnt vmcnt(2)" ::: "memory")
#define RESC(a) do { if (__any((a) < 1.f)) { if (hi == 0) al_l[r32] = (a); asm volatile("s_waitcnt lgkmcnt(0)" ::: "memory"); \
    for (int d = 0; d < 4; ++d) for (int r = 0; r < 16; ++r) o[d][r] *= al_l[crow(r, hi)]; } } while (0)
  f32x16 pA0, pA1, pB0, pB1; float mnA, mnB, alA, alB; v8i pa; const int NT = seq / KVBLK;
  constexpr int SE = 0, SO = 1;
  int bprev = 0, bcur = SHM_K, bnext = 2 * SHM_K;
#define ROT() do { const int t_ = bprev; bprev = bcur; bcur = bnext; bnext = t_; } while (0)
  SLOAD(SE, 0); asm volatile("s_waitcnt vmcnt(0)" ::: "memory"); SWRITE(0, SE); __syncthreads();
  qkt(pA0, pA1, K_lds, qf, r32, hi); partialSM(pA0, pA1, m_reg, mnA, alA);
  SLOAD(SO, 1); if (2 < NT) SLOAD(SE, 2);
  SWAIT(); SWRITE(SHM_K, SO); __syncthreads();
  for (int j = 1; j + 1 < NT; j += 2) {
    SBAR(); qkt(pB0, pB1, K_lds + bcur, qf, r32, hi);
    finishSM(pA0, pA1, alA, l_reg, pa); SBAR();
    SLOAD(SO, j + 2); SBAR();
    pv(o, V_lds + bprev, pa, r32, hi); partialSM(pB0, pB1, m_reg, mnB, alB);
    SWAIT(); SWRITE(bnext, SE);
    RESC(alB); __syncthreads(); ROT();
    SBAR(); qkt(pA0, pA1, K_lds + bcur, qf, r32, hi);
    finishSM(pB0, pB1, alB, l_reg, pa); SBAR();
    if (j + 3 < NT) SLOAD(SE, j + 3); SBAR();
    pv(o, V_lds + bprev, pa, r32, hi); partialSM(pA0, pA1, m_reg, mnA, alA);
    SWAIT(); SWRITE(bnext, SO);
    RESC(alA); __syncthreads(); ROT();
  }
  SBAR(); qkt(pB0, pB1, K_lds + bcur, qf, r32, hi);
  finishSM(pA0, pA1, alA, l_reg, pa); SBAR();
  pv(o, V_lds + bprev, pa, r32, hi); partialSM(pB0, pB1, m_reg, mnB, alB);
  RESC(alB);
  finishSM(pB0, pB1, alB, l_reg, pa); SBAR();
  pv(o, V_lds + bcur, pa, r32, hi);
  __syncthreads();
#undef ROT
  if (hi == 0) li_l[r32] = l_reg; asm volatile("s_waitcnt lgkmcnt(0)" ::: "memory");
  float rli[16];
#pragma unroll
  for (int r = 0; r < 16; ++r) rli[r] = __builtin_amdgcn_rcpf(16.f * li_l[crow(r, hi)]);
  { bf16_t* stg = (bf16_t*)(lds + OST_OFF) + wid * 4096;
#pragma unroll
    for (int r = 0; r < 16; ++r) { const int orow = crow(r, hi);
#pragma unroll
      for (int d0 = 0; d0 < 4; ++d0) stg[orow * 128 + d0 * 32 + r32] = (bf16_t)(cvt_pk_bf16(o[d0][r] * rli[r], 0.f) & 0xffffu); }
    asm volatile("s_waitcnt lgkmcnt(0)" ::: "memory");
    bf16_t* Ow = Ob + (long)(wid * QBLK) * LDO;
#pragma unroll
    for (int i = 0; i < 8; ++i) { const int row = i * 4 + (lane >> 4), ch = lane & 15; const u32x4 v = *(const u32x4*)(stg + row * 128 + ch * 8); *(u32x4*)(Ow + (long)row * LDO + ch * 8) = v; }
  }
#undef SLOAD
#undef SWRITE
#undef SWAIT
#undef RESC
}
#undef SBAR
#undef MFMA8
}
constexpr size_t MiB = 1u << 20;
constexpr size_t WS_CTL = 0, CTL_ZERO_BYTES = 64 * 1024;
constexpr size_t WS_MOD = 1 * MiB;
constexpr size_t WS_ROPE = WS_MOD + 256 * 1024;
constexpr size_t WS_SBIAS = WS_MOD + 512 * 1024;
constexpr size_t WS_HC = 2 * MiB;
constexpr size_t WS_WIN = 6 * MiB;
constexpr size_t WS_WA = 17 * MiB, WS_WC = 19 * MiB, WS_WO = 21 * MiB;
constexpr size_t WS_WP = 23 * MiB;
constexpr size_t WS_UT = 27 * MiB, WS_VT = 59 * MiB;
constexpr size_t WS_TSCALE = 16 * MiB;
constexpr size_t WS_KB = 91 * MiB, WS_VB = 108 * MiB;
constexpr size_t WS_HX = 125 * MiB;
constexpr size_t WS_Q = 189 * MiB;
constexpr size_t WS_G = 253 * MiB;
constexpr size_t WS_RT = 317 * MiB;
constexpr size_t WS_SGC = 381 * MiB;
constexpr size_t WS_SC = 189 * MiB;
constexpr size_t WS_SSQ = 445 * MiB;
constexpr size_t WS_K8 = 447 * MiB;
constexpr size_t WS_VT8 = 456 * MiB;
constexpr size_t WS_PE = 465 * MiB, WS_PC = 481 * MiB;
constexpr size_t WS_END = 497 * MiB;

constexpr int NWAVES = 8;
constexpr int LDS_BYTES = 147456;

struct Args {
    const float *x, *c, *ctx, *c_ctx, *w_mod, *b_mod, *n1g, *n2g, *w_in, *qng, *kng, *w_ao, *cdw, *cb, *clg, *clb, *w_co, *w_o, *wq, *keys, *ut, *vt, *fg;
    float* out; unsigned char* ws; int ph_lo, ph_hi, dry, pad;
};

__host__ __device__ __forceinline__ int win_row(int n) {
    if (n < 1536) return n;
    const int base = n < 3584 ? 1536 : 3584, m = n - base, half = m >> 10, idx = m & 1023;
    return base + (idx >> 7) * 256 + half * 128 + (idx & 127);
}

__device__ __forceinline__ void task_mod(const Args& A, int task, int lane, const LAS float* sc) {
    const int n0 = task * 8, col = lane & 7, kg = lane >> 3;
    float acc[9];
#pragma unroll
    for (int b = 0; b < 9; ++b) acc[b] = 0.f;
    const float* wp = A.w_mod + (size_t)kg * NMOD + n0 + col;
    for (int i0 = 0; i0 < 128; i0 += 8) {
        float w[8];
#pragma unroll
        for (int u = 0; u < 8; ++u) w[u] = wp[(size_t)(i0 + u) * 8 * NMOD];
#pragma unroll
        for (int u = 0; u < 8; ++u) { const int k = kg + 8 * (i0 + u);
#pragma unroll
            for (int b = 0; b < 9; ++b) acc[b] += sc[b * D + k] * w[u]; }
    }
#pragma unroll
    for (int b = 0; b < 9; ++b) { float v = acc[b]; v += __shfl_xor(v, 8); v += __shfl_xor(v, 16); v += __shfl_xor(v, 32); acc[b] = v; }
    if (lane < 8) { float* mod = (float*)(A.ws + WS_MOD); const float bm = A.b_mod[n0 + col];
#pragma unroll
        for (int b = 0; b < 9; ++b) mod[b * NMOD + n0 + col] = acc[b] + bm; }
}
__device__ __forceinline__ void task_transpose(const float* W, int K, int N, bf16_t* WT, int k0, int n0, int row0, LAS float* scr, int lane) {
#pragma unroll 8
    for (int i = 0; i < 32; ++i) { const int kk = 2 * i + (lane >> 5); scr[kk * 33 + (lane & 31)] = W[(size_t)(k0 + kk) * N + n0 + (lane & 31)]; }
    asm volatile("s_waitcnt lgkmcnt(0)" ::: "memory");
    const int c = lane & 7;
#pragma unroll
    for (int j = 0; j < 4; ++j) { const int n = (lane >> 3) + 8 * j; const LAS float* s = scr + (8 * c) * 33 + n;
        u32x4 o; o.x = cvt_pk_bf16(s[0 * 33], s[1 * 33]); o.y = cvt_pk_bf16(s[2 * 33], s[3 * 33]); o.z = cvt_pk_bf16(s[4 * 33], s[5 * 33]); o.w = cvt_pk_bf16(s[6 * 33], s[7 * 33]);
        *(u32x4*)(WT + (size_t)(row0 + n) * K + k0 + 8 * c) = o; }
    asm volatile("s_waitcnt lgkmcnt(0)" ::: "memory");
}
typedef float f32x16v __attribute__((ext_vector_type(16)));
typedef unsigned u32x6 __attribute__((ext_vector_type(6)));
constexpr int ROWB = 768;
__device__ __forceinline__ void task_quant_rows4(const float* src, unsigned char* dst, float* scale_out, int lane) {
    const int g = lane & 31, hh = lane >> 5;
    f32x4 v[2][8];
#pragma unroll
    for (int r = 0; r < 2; ++r)
#pragma unroll
        for (int i = 0; i < 8; ++i) v[r][i] = *(const f32x4*)(src + (size_t)(2 * r + hh) * D + g * 32 + i * 4);
#pragma unroll
    for (int r = 0; r < 2; ++r) {
        float am = 0.f;
#pragma unroll
        for (int i = 0; i < 8; ++i) am = fmaxf(fmaxf(am, fmaxf(fabsf(v[r][i][0]), fabsf(v[r][i][1]))), fmaxf(fabsf(v[r][i][2]), fabsf(v[r][i][3])));
#pragma unroll
        for (int o = 1; o < 32; o <<= 1) am = fmaxf(am, __shfl_xor(am, o));
        const float inv = am > 0.f ? 7.5f / am : 0.f;
        f32x16v a, b;
#pragma unroll
        for (int i = 0; i < 4; ++i)
#pragma unroll
            for (int j = 0; j < 4; ++j) { const int e0 = 4 * i + j;
                a[e0] = v[r][(2 * e0) >> 2][(2 * e0) & 3] * inv; b[e0] = v[r][(2 * e0 + 1) >> 2][(2 * e0 + 1) & 3] * inv; }
        const u32x6 p = __builtin_amdgcn_cvt_scalef32_2xpk16_fp6_f32(a, b, 1.0f);
        unsigned char* rowp = dst + (size_t)(2 * r + hh) * ROWB;
        *(u32x4*)(rowp + g * 16) = (u32x4){p[0], p[1], p[2], p[3]}; *(u32x2*)(rowp + 512 + g * 8) = (u32x2){p[4], p[5]};
        if (g == 0) scale_out[2 * r + hh] = am * (1.f / 7.5f);
    }
}
__device__ __forceinline__ bf16x8 ld8_f32_bf16(const float* p) { const f32x4 a = *(const f32x4*)p, b = *(const f32x4*)(p + 4); u32x4 w = {cvt_pk_bf16(a[0], a[1]), cvt_pk_bf16(a[2], a[3]), cvt_pk_bf16(b[0], b[1]), cvt_pk_bf16(b[2], b[3])}; return *reinterpret_cast<bf16x8*>(&w); }
__device__ __forceinline__ void task_wprime(const Args& A, int id, int lane) {
    const int hp = id >> 7, rem = id & 127, n0 = (rem >> 5) * 32, k0 = (rem & 31) * 32, r32 = lane & 31, hi = lane >> 5;
    f32x16 acc = {};
    const float* ka = A.keys + ((size_t)(hp * 128 + n0 + r32)) * 128 + hi * 8;
    const float* wb = A.wq + (size_t)(k0 + r32) * PW + hp * 128 + hi * 8;
#pragma unroll
    for (int s = 0; s < 8; ++s) acc = __builtin_amdgcn_mfma_f32_32x32x16_bf16(ld8_f32_bf16(ka + s * 16), ld8_f32_bf16(wb + s * 16), acc, 0, 0, 0);
    bf16_t* o = (bf16_t*)(A.ws + WS_WP);
#pragma unroll
    for (int r = 0; r < 16; ++r) { const int n = (r & 3) + 8 * (r >> 2) + 4 * hi; o[(size_t)(hp * 128 + n0 + n) * D + k0 + r32] = (bf16_t)(cvt_pk_bf16(acc[r], 0.f) & 0xffffu); }
}
__device__ __forceinline__ void phase_prologue(const Args& A, LAS unsigned char* lds) {
    const int tid = threadIdx.x, lane = tid & 63, wave = __builtin_amdgcn_readfirstlane(tid >> 6);
    LAS float* sc = (LAS float*)lds;
    for (int i = tid; i < 9 * D; i += 512) { const float v = i < 8 * D ? A.c[i] : A.c_ctx[i - 8 * D]; sc[i] = v / (1.f + __expf(-v)); }
    __syncthreads();
    LAS float* scr = (LAS float*)(lds + 36864 + wave * 8448);
    constexpr int T_MOD = NMOD / 8, T_WIN = (D / 64) * (INW / 32), T_SQ = (D / 64) * (D / 32), T_UV = 2 * NEXP / 4, T_WP = 2048, T_ROPE = 1;
    constexpr int NT = T_MOD + T_WIN + 3 * T_SQ + T_UV + T_WP + T_ROPE;
    const int G = gridDim.x;
    for (int task = wave * G + blockIdx.x; task < NT; task += NWAVES * G) {
        int r = task;
        if (r < T_MOD) { task_mod(A, r, lane, sc); continue; } r -= T_MOD;
        if (r < T_WIN) { const int nblk = INW / 32, kb = r / nblk, nb = r % nblk; task_transpose(A.w_in, D, INW, (bf16_t*)(A.ws + WS_WIN), 64 * kb, 32 * nb, win_row(32 * nb), scr, lane); continue; } r -= T_WIN;
        if (r < 3 * T_SQ) { const int wsel = r / T_SQ, q = r % T_SQ, kb = q / 32, nb = q % 32;
            const float* W = wsel == 0 ? A.w_ao : (wsel == 1 ? A.w_co : A.w_o); bf16_t* WT = (bf16_t*)(A.ws + (wsel == 0 ? WS_WA : (wsel == 1 ? WS_WC : WS_WO)));
            task_transpose(W, D, D, WT, 64 * kb, 32 * nb, 32 * nb, scr, lane); continue; } r -= 3 * T_SQ;
        if (r < T_UV) { const int tb = r / (NEXP / 4), row = (r % (NEXP / 4)) * 4; unsigned char* tbase = A.ws + (tb ? WS_VT : WS_UT);
            task_quant_rows4((tb ? A.vt : A.ut) + (size_t)row * D, tbase + (size_t)row * ROWB, (float*)(tbase + WS_TSCALE) + row, lane); continue; } r -= T_UV;
        if (r < T_WP) { task_wprime(A, r, lane); continue; } r -= T_WP;
        { float* cs = (float*)(A.ws + WS_ROPE); float* sn = cs + 2048;
          for (int e = lane; e < 2048; e += 64) { const int p = e >> 5, i = e & 31; const float inv = powf(10000.f, -(float)(2 * i) / 64.f); const float a = (float)p * inv; cs[e] = cosf(a); sn[e] = sinf(a); } }
    }
}
__device__ __forceinline__ void normmod_row(const float* xr, const float* g, const float* modr, int sh_off, int sc_off, bf16_t* orow, int lane) {
    f32x4 v[4]; float ss = 0.f;
#pragma unroll
    for (int i = 0; i < 4; ++i) { v[i] = *(const f32x4*)(xr + (i * 64 + lane) * 4); ss += (v[i][0] * v[i][0] + v[i][1] * v[i][1]) + (v[i][2] * v[i][2] + v[i][3] * v[i][3]); }
    const float r = rsqrtf(wave_sum(ss) * (1.f / D) + EPS);
#pragma unroll
    for (int i = 0; i < 4; ++i) { const int k = (i * 64 + lane) * 4; const f32x4 gg = *(const f32x4*)(g + k), s1 = *(const f32x4*)(modr + sc_off + k), h1 = *(const f32x4*)(modr + sh_off + k);
        float y[4];
#pragma unroll
        for (int j = 0; j < 4; ++j) y[j] = v[i][j] * r * gg[j] * (1.f + s1[j]) + h1[j];
        u32x2 o = {cvt_pk_bf16(y[0], y[1]), cvt_pk_bf16(y[2], y[3])}; *(u32x2*)(orow + k) = o; }
}
__device__ __forceinline__ void phase_hx(const Args& A) {
    const int lane = threadIdx.x & 63, gw = blockIdx.x * NWAVES + (threadIdx.x >> 6), NGW = gridDim.x * NWAVES;
    const float* mod = (const float*)(A.ws + WS_MOD);
    for (int m = gw; m < M + MC; m += NGW) {
        if (m < M) normmod_row(A.x + (size_t)m * D, A.n1g, mod + (m >> 12) * NMOD, 0, D, (bf16_t*)(A.ws + WS_HX) + (size_t)m * D, lane);
        else { const int r = m - M; normmod_row(A.ctx + (size_t)r * D, A.n1g, mod + 8 * NMOD, 0, D, (bf16_t*)(A.ws + WS_HC) + (size_t)r * D, lane); }
    }
    const bf16_t* WP = (const bf16_t*)(A.ws + WS_WP); float* sb = (float*)(A.ws + WS_SBIAS);
    for (int col = gw; col < PW; col += NGW) {
        const u32x4 w0 = *(const u32x4*)(WP + (size_t)col * D + lane * 16), w1 = *(const u32x4*)(WP + (size_t)col * D + lane * 16 + 8);
        float wv[16];
#pragma unroll
        for (int j = 0; j < 4; ++j) { wv[2 * j] = bf_lo(w0[j]); wv[2 * j + 1] = bf_hi(w0[j]); wv[8 + 2 * j] = bf_lo(w1[j]); wv[8 + 2 * j + 1] = bf_hi(w1[j]); }
#pragma unroll 1
        for (int b = 0; b < NB; ++b) { const float* sh = mod + b * NMOD + 3 * D + lane * 16; float s = 0.f;
#pragma unroll
            for (int q = 0; q < 4; ++q) { const f32x4 v = *(const f32x4*)(sh + 4 * q); s += v[0] * wv[4 * q] + v[1] * wv[4 * q + 1] + v[2] * wv[4 * q + 2] + v[3] * wv[4 * q + 3]; }
            s = wave_sum(s); if (lane == 0) sb[b * PW + col] = s; }
    }
}
__device__ __forceinline__ void phase_kfix(const Args& A) {
    const int lane = threadIdx.x & 63, gw = blockIdx.x * NWAVES + (threadIdx.x >> 6), NGW = gridDim.x * NWAVES, li = lane & 15, sub = lane >> 4;
    const bf16_t* KB = (const bf16_t*)(A.ws + WS_KB); const float* cs = (const float*)(A.ws + WS_ROPE); const float* sn = cs + 2048;
    constexpr int NITEM = NB * SKV * HKV;
    const f32x4 g0 = *(const f32x4*)(A.kng + li * 8), g1 = *(const f32x4*)(A.kng + li * 8 + 4);
    const f32x4 p0 = *(const f32x4*)(A.kng + (li ^ 4) * 8), p1 = *(const f32x4*)(A.kng + (li ^ 4) * 8 + 4);
    for (int it = gw * 4 + sub; it < NITEM; it += NGW * 4) {
        const int row = it >> 1, h = it & 1, t = row % SKV;
        const bf16_t* p = KB + (size_t)row * 256 + h * HD + li * 8;
        const u32x4 w = *(const u32x4*)p;
        float x[8], xp[8]; float ss = 0.f;
#pragma unroll
        for (int j = 0; j < 4; ++j) { x[2 * j] = bf_lo(w[j]); x[2 * j + 1] = bf_hi(w[j]); ss += x[2 * j] * x[2 * j] + x[2 * j + 1] * x[2 * j + 1];
            const unsigned pw = (unsigned)__shfl_xor((int)w[j], 4); xp[2 * j] = bf_lo(pw); xp[2 * j + 1] = bf_hi(pw); }
        ss += __shfl_xor(ss, 1); ss += __shfl_xor(ss, 2); ss += __shfl_xor(ss, 4); ss += __shfl_xor(ss, 8);
        const float r = rsqrtf(ss * (1.f / HD) + EPS);
        float y[8];
#pragma unroll
        for (int j = 0; j < 8; ++j) { x[j] *= r * (j < 4 ? g0[j] : g1[j - 4]); xp[j] *= r * (j < 4 ? p0[j] : p1[j - 4]); y[j] = x[j]; }
        if (t < S) {
            const int blk = li >> 3, pos = blk == 0 ? (t >> 6) : (t & 63), second = (li >> 2) & 1, i0 = (li & 3) * 8;
            const f32x4 c0 = *(const f32x4*)(cs + pos * 32 + i0), c1 = *(const f32x4*)(cs + pos * 32 + i0 + 4), s0 = *(const f32x4*)(sn + pos * 32 + i0), s1 = *(const f32x4*)(sn + pos * 32 + i0 + 4);
#pragma unroll
            for (int j = 0; j < 8; ++j) { const float c = j < 4 ? c0[j] : c1[j - 4], s = j < 4 ? s0[j] : s1[j - 4];
                y[j] = second ? (xp[j] * s + x[j] * c) : (x[j] * c - xp[j] * s); }
        }
        u32x2 o = {(unsigned)att::pk4_fp8(y[0] * 16.f, y[1] * 16.f, y[2] * 16.f, y[3] * 16.f), (unsigned)att::pk4_fp8(y[4] * 16.f, y[5] * 16.f, y[6] * 16.f, y[7] * 16.f)};
        *(u32x2*)(A.ws + WS_K8 + (size_t)row * 256 + h * HD + li * 8) = o;
    }
}
__device__ __forceinline__ void phase_vt(const Args& A, LAS unsigned char* lds) {
    const int lane = threadIdx.x & 63, wave = threadIdx.x >> 6, gw = blockIdx.x * NWAVES + wave, NGW = gridDim.x * NWAVES;
    LAS unsigned char* tl = lds + wave * 4096;
    const bf16_t* VB = (const bf16_t*)(A.ws + WS_VB);
    const int kk = lane & 31, pos = 32 * ((kk >> 2) & 1) + (kk & 3) + 4 * (kk >> 3) + 16 * (lane >> 5);
    constexpr int NTILE = SKV / 64;
    for (int it2 = gw; it2 < NB * HKV * NTILE * 2; it2 += NGW) {
        const int dh = it2 & 1, it = it2 >> 1, j = it % NTILE, bk = it / NTILE, b = bk >> 1, kv = bk & 1;
        const bf16_t* src = VB + ((size_t)b * SKV + j * 64 + lane) * 256 + kv * HD + dh * 64;
        u32x4 w[8];
#pragma unroll
        for (int c = 0; c < 8; ++c) w[c] = *(const u32x4*)(src + c * 8);
#pragma unroll
        for (int c = 0; c < 8; ++c)
#pragma unroll
            for (int q = 0; q < 4; ++q) { const int pk = __builtin_amdgcn_cvt_pk_fp8_f32(bf_lo(w[c][q]) * 16.f, bf_hi(w[c][q]) * 16.f, 0, false);
                tl[(c * 8 + 2 * q) * 64 + pos] = (unsigned char)(pk & 0xff); tl[(c * 8 + 2 * q + 1) * 64 + pos] = (unsigned char)((pk >> 8) & 0xff); }
        asm volatile("s_waitcnt lgkmcnt(0)" ::: "memory");
        unsigned char* dst = A.ws + WS_VT8 + (size_t)it * 8192 + dh * 4096;
#pragma unroll
        for (int i = 0; i < 4; ++i) *(u32x4*)(dst + (i * 64 + lane) * 16) = *(const LAS u32x4*)(tl + (i * 64 + lane) * 16);
        asm volatile("s_waitcnt lgkmcnt(0)" ::: "memory");
    }
}
template <int R> struct ConvRow {
    static __device__ __forceinline__ void run(const unsigned* gp, int tl0, float (&acc)[32][2], const float (&w)[31][2]) {
        const int tl = tl0 + R - 15;
        unsigned v = 0u; if (tl >= 0 && tl < S) v = gp[(long)(R - 15) * (D / 2)];
        const float a = bf_lo(v), b = bf_hi(v);
#pragma unroll
        for (int t = (R - 30 > 0 ? R - 30 : 0); t <= (R < 31 ? R : 31); ++t) { acc[t][0] += w[R - t][0] * a; acc[t][1] += w[R - t][1] * b; }
        if constexpr (R + 1 < 62) ConvRow<R + 1>::run(gp, tl0, acc, w);
    }
};
__device__ __forceinline__ void phase_conv(const Args& A, LAS unsigned char* lds) {
    const int tid = threadIdx.x, lane = tid & 63, wave = tid >> 6;
    LAS float* tile = (LAS float*)lds;
    const bf16_t* G = (const bf16_t*)(A.ws + WS_G); bf16_t* CV = (bf16_t*)(A.ws + WS_HX);
    float w[31][2];
#pragma unroll
    for (int j = 0; j < 31; ++j) { const f32x2 t = *(const f32x2*)(A.cdw + j * D + 2 * tid); w[j][0] = t[0]; w[j][1] = t[1]; }
    const f32x2 bias = *(const f32x2*)(A.cb + 2 * tid);
    for (int tileid = blockIdx.x; tileid < M / 32; tileid += gridDim.x) {
        const int row0 = tileid * 32, tl0 = row0 & (S - 1);
        float acc[32][2];
#pragma unroll
        for (int t = 0; t < 32; ++t) { acc[t][0] = bias[0]; acc[t][1] = bias[1]; }
        ConvRow<0>::run((const unsigned*)(G + (size_t)row0 * D) + tid, tl0, acc, w);
        __syncthreads();
#pragma unroll
        for (int t = 0; t < 32; ++t) *(LAS f32x2*)(tile + t * D + 2 * tid) = (f32x2){acc[t][0], acc[t][1]};
        __syncthreads();
#pragma unroll
        for (int q = 0; q < 4; ++q) { const int t = wave * 4 + q; const LAS float* tr = tile + t * D;
            f32x4 v[4]; float s = 0.f;
#pragma unroll
            for (int i = 0; i < 4; ++i) { v[i] = *(const LAS f32x4*)(tr + (i * 64 + lane) * 4); s += (v[i][0] + v[i][1]) + (v[i][2] + v[i][3]); }
            const float mu = wave_sum(s) * (1.f / D); float qq = 0.f;
#pragma unroll
            for (int i = 0; i < 4; ++i) { v[i] = v[i] - mu; qq += (v[i][0] * v[i][0] + v[i][1] * v[i][1]) + (v[i][2] * v[i][2] + v[i][3] * v[i][3]); }
            const float rs = rsqrtf(wave_sum(qq) * (1.f / D) + EPS);
#pragma unroll
            for (int i = 0; i < 4; ++i) { const int k = (i * 64 + lane) * 4; const f32x4 gg = *(const f32x4*)(A.clg + k), bb = *(const f32x4*)(A.clb + k); float y[4];
#pragma unroll
                for (int j = 0; j < 4; ++j) { const float z = v[i][j] * rs * gg[j] + bb[j]; y[j] = z * fast_sigmoid(z); }
                u32x2 o = {cvt_pk_bf16(y[0], y[1]), cvt_pk_bf16(y[2], y[3])}; *(u32x2*)(CV + (size_t)(row0 + t) * D + k) = o; }
        }
    }
}
struct EpiInProj {
    static constexpr bool PERM = true;
    unsigned char* ws;
    __device__ __forceinline__ void operator()(f32x4 (&acc)[2][2][4][2], const pg8::Unit& u, int wr, int wc, int fr, int fq) const {
        const int c8 = wc * 32 + 8 * fq;
#pragma unroll
        for (int ai = 0; ai < 2; ++ai)
#pragma unroll
            for (int m = 0; m < 4; ++m) {
                const int row = u.pm * 256 + ai * 128 + wr * 64 + m * 16 + fr;
                if (u.kind == 0) {
                    bf16_t* p = (bf16_t*)(ws + WS_Q) + (size_t)row * D + u.pn * 256 + c8;
#pragma unroll
                    for (int bj = 0; bj < 2; ++bj) { const f32x4 v0 = acc[ai][bj][m][0], v1 = acc[ai][bj][m][1];
                        u32x4 w = {cvt_pk_bf16(v0[0], v0[1]), cvt_pk_bf16(v0[2], v0[3]), cvt_pk_bf16(v1[0], v1[1]), cvt_pk_bf16(v1[2], v1[3])}; *(u32x4*)(p + bj * 128) = w; }
                } else if (u.kind == 1 || u.kind == 2 || u.kind == 5 || u.kind == 6) {
                    const bool ctxu = u.kind >= 5;
                    const int kvrow = ctxu ? (row >> 8) * SKV + S + (row & 255) : (row >> 12) * SKV + (row & (S - 1));
                    bf16_t* p = (bf16_t*)(ws + ((u.kind == 1 || u.kind == 5) ? WS_KB : WS_VB)) + (size_t)kvrow * 256 + c8;
#pragma unroll
                    for (int bj = 0; bj < 2; ++bj) { const f32x4 v0 = acc[ai][bj][m][0], v1 = acc[ai][bj][m][1];
                        u32x4 w = {cvt_pk_bf16(v0[0], v0[1]), cvt_pk_bf16(v0[2], v0[3]), cvt_pk_bf16(v1[0], v1[1]), cvt_pk_bf16(v1[2], v1[3])}; *(u32x4*)(p + bj * 128) = w; }
                } else if (u.kind == 3) {
                    float g[8];
#pragma unroll
                    for (int n = 0; n < 2; ++n)
#pragma unroll
                        for (int j = 0; j < 4; ++j) g[4 * n + j] = acc[ai][0][m][n][j] * fast_sigmoid(acc[ai][1][m][n][j]);
                    u32x4 w = {cvt_pk_bf16(g[0], g[1]), cvt_pk_bf16(g[2], g[3]), cvt_pk_bf16(g[4], g[5]), cvt_pk_bf16(g[6], g[7])};
                    *(u32x4*)((bf16_t*)(ws + WS_G) + (size_t)row * D + (u.pn - 6) * 128 + c8) = w;
                } else {
                    float rt[8], sg[8];
#pragma unroll
                    for (int n = 0; n < 2; ++n)
#pragma unroll
                        for (int j = 0; j < 4; ++j) { const float ea = __builtin_amdgcn_exp2f(-1.4426950408889634f * acc[ai][0][m][n][j]), ec = __builtin_amdgcn_exp2f(-1.4426950408889634f * acc[ai][1][m][n][j]);
                            sg[4 * n + j] = __builtin_amdgcn_rcpf(1.f + ec); rt[4 * n + j] = (1.f + ec) * __builtin_amdgcn_rcpf(1.f + ea); }
                    const size_t off = (size_t)row * D + (u.pn - 14) * 128 + c8;
                    u32x4 w = {cvt_pk_bf16(rt[0], rt[1]), cvt_pk_bf16(rt[2], rt[3]), cvt_pk_bf16(rt[4], rt[5]), cvt_pk_bf16(rt[6], rt[7])}; *(u32x4*)((bf16_t*)(ws + WS_RT) + off) = w;
                    u32x4 w2 = {cvt_pk_bf16(sg[0], sg[1]), cvt_pk_bf16(sg[2], sg[3]), cvt_pk_bf16(sg[4], sg[5]), cvt_pk_bf16(sg[6], sg[7])}; *(u32x4*)((bf16_t*)(ws + WS_SGC) + off) = w2;
                }
            }
    }
};
struct SchedInProj {
    const char* hx; const char* hc; const char* w; int G, c;
    __device__ __forceinline__ bool next(int i, pg8::Unit& u) const {
        constexpr int nM = M / 256, nN = INW / 256, NMAIN = nM * nN, NCTX = (MC / 256) * 2;
        const int L = i * G + c; if (L >= NMAIN + NCTX) return false;
        if (L < NMAIN) { pg8::tile_of(L, nM, nN, u.pm, u.pn); u.a = hx + (size_t)u.pm * 256 * D * 2; u.kind = u.pn < 4 ? 0 : (u.pn == 4 ? 1 : (u.pn == 5 ? 2 : (u.pn < 14 ? 3 : 4))); }
        else { const int j = L - NMAIN; u.pm = j >> 1; u.pn = 4 + (j & 1); u.a = hc + (size_t)u.pm * 256 * D * 2; u.kind = 5 + (j & 1); }
        u.b = w + (size_t)u.pn * 256 * D * 2; u.keep = 0; return true;
    }
};
struct EpiMerge {
    static constexpr bool PERM = true;
    unsigned char* ws;
    __device__ __forceinline__ void operator()(f32x4 (&acc)[2][2][4][2], const pg8::Unit& u, int wr, int wc, int fr, int fq) const {
        const int c8 = u.pn * 256 + wc * 32 + 8 * fq;
        const bf16_t* __restrict__ F = (const bf16_t*)(ws + (u.kind == 0 ? WS_RT : WS_SGC));
#pragma unroll
        for (int ai = 0; ai < 2; ++ai)
#pragma unroll
            for (int m = 0; m < 4; ++m) { const size_t off = (size_t)(u.pm * 256 + ai * 128 + wr * 64 + m * 16 + fr) * D + c8;
#pragma unroll
                for (int bj = 0; bj < 2; ++bj) { const u32x4 f = *(const u32x4*)(F + off + bj * 128);
                    f32x4 v0 = acc[ai][bj][m][0], v1 = acc[ai][bj][m][1];
                    v0[0] *= bf_lo(f[0]); v0[1] *= bf_hi(f[0]); v0[2] *= bf_lo(f[1]); v0[3] *= bf_hi(f[1]); v1[0] *= bf_lo(f[2]); v1[1] *= bf_hi(f[2]); v1[2] *= bf_lo(f[3]); v1[3] *= bf_hi(f[3]);
                    if (u.kind == 0) { acc[ai][bj][m][0] = v0; acc[ai][bj][m][1] = v1; }
                    else { u32x4 w = {cvt_pk_bf16(v0[0], v0[1]), cvt_pk_bf16(v0[2], v0[3]), cvt_pk_bf16(v1[0], v1[1]), cvt_pk_bf16(v1[2], v1[3])}; *(u32x4*)((bf16_t*)(ws + WS_G) + off + bj * 128) = w; } } }
    }
};
struct SchedMerge {
    const char* att; const char* cv; const char* wa; const char* wc; int G, c;
    __device__ __forceinline__ bool next(int i, pg8::Unit& u) const {
        constexpr int nM = M / 256, nN = D / 256;
        const int L = (i >> 1) * G + c, sub = i & 1; if (L >= nM * nN) return false;
        pg8::tile_of(L, nM, nN, u.pm, u.pn);
        u.a = (sub ? cv : att) + (size_t)u.pm * 256 * D * 2; u.b = (sub ? wc : wa) + (size_t)u.pn * 256 * D * 2; u.kind = sub; u.keep = sub ^ 1; return true;
    }
};
struct SchedPlain {
    const char* a; const char* b; int nM, nN, G, c;
    __device__ __forceinline__ bool next(int i, pg8::Unit& u) const {
        const int L = i * G + c; if (L >= nM * nN) return false;
        pg8::tile_of(L, nM, nN, u.pm, u.pn); u.a = a + (size_t)u.pm * 256 * D * 2; u.b = b + (size_t)u.pn * 256 * D * 2; u.kind = 0; u.keep = 0; return true;
    }
};
struct EpiOut {
    static constexpr bool PERM = false;
    const float* __restrict__ x; const float* __restrict__ mod; const float* __restrict__ n2g; float* __restrict__ xs; bf16_t* __restrict__ xg; float* __restrict__ ssq;
    __device__ __forceinline__ void operator()(f32x4 (&acc)[2][2][4][2], const pg8::Unit& u, int wr, int wc, int fr, int fq) const {
        const int col0 = u.pn * 256 + wc * 32 + 4 * fq; const float* mb = mod + ((u.pm * 256) >> 12) * NMOD;
        f32x4 gv[2][2], nv[2][2];
#pragma unroll
        for (int bj = 0; bj < 2; ++bj)
#pragma unroll
            for (int n = 0; n < 2; ++n) { const int c = col0 + bj * 128 + n * 16; gv[bj][n] = *(const f32x4*)(mb + 2 * D + c); nv[bj][n] = *(const f32x4*)(n2g + c) * (*(const f32x4*)(mb + 4 * D + c) + 1.f); }
        f32x4 xa[2][2], xb[2][2];
#define XLOAD(dst, k) do { _Pragma("unroll") for (int bj = 0; bj < 2; ++bj) _Pragma("unroll") for (int n = 0; n < 2; ++n) \
            dst[bj][n] = *(const f32x4*)(x + (size_t)(u.pm * 256 + ((k) >> 2) * 128 + wr * 64 + ((k) & 3) * 16 + fr) * D + col0 + bj * 128 + n * 16); } while (0)
#define XDONE(src, k) do { const int ai = (k) >> 2, m = (k) & 3; const int row = u.pm * 256 + ai * 128 + wr * 64 + m * 16 + fr; const size_t off = (size_t)row * D + col0; float ss = 0.f; \
            _Pragma("unroll") for (int bj = 0; bj < 2; ++bj) _Pragma("unroll") for (int n = 0; n < 2; ++n) { const f32x4 v = src[bj][n] + gv[bj][n] * acc[ai][bj][m][n]; *(f32x4*)(xs + off + bj * 128 + n * 16) = v; \
                ss += (v[0] * v[0] + v[1] * v[1]) + (v[2] * v[2] + v[3] * v[3]); const f32x4 g = v * nv[bj][n]; \
                u32x2 w = {cvt_pk_bf16(g[0], g[1]), cvt_pk_bf16(g[2], g[3])}; *(u32x2*)(xg + off + bj * 128 + n * 16) = w; } \
            ss += __shfl_xor(ss, 16); ss += __shfl_xor(ss, 32); if (fq == 0) ssq[(size_t)row * 16 + u.pn * 4 + wc] = ss; } while (0)
        XLOAD(xa, 0); XLOAD(xb, 1); XDONE(xa, 0); XLOAD(xa, 2); XDONE(xb, 1); XLOAD(xb, 3); XDONE(xa, 2); XLOAD(xa, 4); XDONE(xb, 3); XLOAD(xb, 5); XDONE(xa, 4); XLOAD(xa, 6); XDONE(xb, 5); XLOAD(xb, 7); XDONE(xa, 6); XDONE(xb, 7);
#undef XLOAD
#undef XDONE
    }
};
__device__ __forceinline__ float row_rstd(const float* ssq, int row) {
    const f32x4 a = *(const f32x4*)(ssq + (size_t)row * 16), b = *(const f32x4*)(ssq + (size_t)row * 16 + 4), c = *(const f32x4*)(ssq + (size_t)row * 16 + 8), d = *(const f32x4*)(ssq + (size_t)row * 16 + 12);
    const float s = ((a[0] + a[1]) + (a[2] + a[3])) + ((b[0] + b[1]) + (b[2] + b[3])) + ((c[0] + c[1]) + (c[2] + c[3])) + ((d[0] + d[1]) + (d[2] + d[3]));
    return rsqrtf(s * (1.f / D) + EPS);
}
struct EpiScores {
    static constexpr bool PERM = false;
    float* sc; const float* ssq; const float* sbias;
    __device__ __forceinline__ void operator()(f32x4 (&acc)[2][2][4][2], const pg8::Unit& u, int wr, int wc, int fr, int fq) const {
        const float* sb = sbias + ((u.pm * 256) >> 12) * PW + u.pn * 256 + wc * 32 + 4 * fq;
        f32x4 bv[2][2];
#pragma unroll
        for (int bj = 0; bj < 2; ++bj)
#pragma unroll
            for (int n = 0; n < 2; ++n) bv[bj][n] = *(const f32x4*)(sb + bj * 128 + n * 16);
#pragma unroll
        for (int ai = 0; ai < 2; ++ai)
#pragma unroll
            for (int m = 0; m < 4; ++m) { const int row = u.pm * 256 + ai * 128 + wr * 64 + m * 16 + fr; float* p = sc + (size_t)(row >> 2) * 8192 + (row & 3) * 4; const float rs = row_rstd(ssq, row);
#pragma unroll
                for (int bj = 0; bj < 2; ++bj)
#pragma unroll
                    for (int n = 0; n < 2; ++n) { const int grp = u.pn * 2 + bj, nq = wc * 8 + n * 4 + fq; *(f32x4*)(p + (grp * 32 + nq) * 16) = acc[ai][bj][m][n] * rs + bv[bj][n]; } }
    }
};

#ifndef PROBE_HALFKEYS
#define PROBE_HALFKEYS 0
#endif
__device__ __forceinline__ void phase_attn(const Args& A, unsigned char* lds) {
    const int G = gridDim.x, X = blockIdx.x & 7, j = blockIdx.x >> 3, perx = G >> 3;
    bf16_t* Q = (bf16_t*)(A.ws + WS_Q); const unsigned char* K8 = A.ws + WS_K8; const unsigned char* VT8 = A.ws + WS_VT8;
    const float* cs = (const float*)(A.ws + WS_ROPE); const float* sn = cs + 2048;
    for (int idx = j; idx < 128; idx += perx) {
        const int grp = 2 * X + (idx >> 6), uu = idx & 63, b = grp >> 1, kv = grp & 1, h = kv * 4 + (uu >> 4), qb = uu & 15;
        bf16_t* qp = Q + ((size_t)b * S + qb * 256) * D + h * HD;
        bf16_t* op = A.dry ? (bf16_t*)(A.ws + WS_G) + ((size_t)b * S + qb * 256) * D + h * HD : qp;
        att::attn_unit(qp, K8 + (size_t)b * SKV * 256 + kv * HD, VT8 + (size_t)grp * (SKV / 64) * 8192, op, qb * 256, (A.dry && PROBE_HALFKEYS) ? SKV / 2 : SKV, A.qng, cs, sn, (char*)lds);
    }
}

__device__ __forceinline__ float gelu_exact(float v) {
    const float av = fabsf(v), t = __builtin_amdgcn_rcpf(av * 0.2316418882f + 1.0f);
    float q = t * 0.5307027145f + (-0.7265760135f); q = q * t + 0.7107068705f; q = q * t + (-0.142248368f); q = q * t + 0.127414796f; q = q * t;
    const float e = __builtin_amdgcn_exp2f((v * v) * (-0.72134752044f));
    const float m = v * (q * e);
    return v < 0.f ? m : v - m;
}
__device__ __forceinline__ void ins16(float (&t)[16], float v) {
#pragma unroll
    for (int i = 15; i >= 1; --i) t[i] = __builtin_amdgcn_fmed3f(t[i - 1], t[i], v);
    t[0] = fmaxf(t[0], v);
}
typedef float f32x32v __attribute__((ext_vector_type(32)));
typedef _Float16 f16x32v __attribute__((ext_vector_type(32)));
typedef _Float16 f16x2v __attribute__((ext_vector_type(2)));

__device__ __forceinline__ float key_tag(float v, unsigned keepmask, unsigned tag) { return __uint_as_float((__float_as_uint(v) & keepmask) | tag); }
template <int I, int J> struct CandLoop {
    static __device__ __forceinline__ void run(const float (&a)[16], const float (&b)[16], float (&c)[16]) {
        if constexpr ((I + 1) * (J + 1) <= 16) { ins16(c, key_tag(a[I] + b[J], ~255u, 255u - (unsigned)(I * 16 + J))); CandLoop<I, J + 1>::run(a, b, c); }
        else if constexpr (I + 1 < 16) CandLoop<I + 1, 0>::run(a, b, c);
    }
};
__device__ __forceinline__ void phase_peer_u(const Args& A, LAS unsigned char* lds) {
    const int lane = threadIdx.x & 63, wave = threadIdx.x >> 6, gw = blockIdx.x * NWAVES + wave, NGW = gridDim.x * NWAVES;
    LAS unsigned char* wl = lds + wave * 10240;
    LAS float* topL = (LAS float*)wl; LAS int* eidA = (LAS int*)(wl + 4096); LAS float* wgtA = (LAS float*)(wl + 6144); LAS float* coefL = (LAS float*)(wl + 8192);
    LAS float* suL = (LAS float*)(wl + 8704); LAS float* svL = (LAS float*)(wl + 9216);
    const float* SC = (const float*)(A.ws + WS_SC); const bf16_t* HX = (const bf16_t*)(A.ws + WS_HX);
    const unsigned char* UT = A.ws + WS_UT; const float* SU = (const float*)(A.ws + WS_UT + WS_TSCALE); const float* SVs = (const float*)(A.ws + WS_VT + WS_TSCALE);
    const float* mod = (const float*)(A.ws + WS_MOD);
    int* PE = (int*)(A.ws + WS_PE); float* PC = (float*)(A.ws + WS_PC);
    const float NEG = -3.0e38f;
    const int h = lane >> 3, tk = (lane >> 1) & 3, p = lane & 1, grp = 2 * h + p;
    for (int pass = gw; pass < M / 4; pass += NGW) {
        {
            float t[16];
#pragma unroll
            for (int i = 0; i < 16; ++i) t[i] = NEG;
            const float* sp = SC + (size_t)pass * 8192 + (grp * 128 + tk) * 4;
            f32x4 sv[32];
#pragma unroll
            for (int i = 0; i < 32; ++i) sv[i] = *(const f32x4*)(sp + i * 16);
#pragma unroll
            for (int i = 0; i < 32; ++i) { const unsigned tg = 127u - 4u * (unsigned)i;
                ins16(t, key_tag(sv[i][0], ~127u, tg)); ins16(t, key_tag(sv[i][1], ~127u, tg - 1u)); ins16(t, key_tag(sv[i][2], ~127u, tg - 2u)); ins16(t, key_tag(sv[i][3], ~127u, tg - 3u)); }
            float pb[16];
#pragma unroll
            for (int i = 0; i < 16; ++i) { pb[i] = __shfl_xor(t[i], 1); topL[i * 64 + lane] = t[i]; }
            float c[16];
#pragma unroll
            for (int i = 0; i < 16; ++i) c[i] = NEG;
            CandLoop<0, 0>::run(t, pb, c);
            float e[16]; float es = 0.f;
#pragma unroll
            for (int k = 0; k < 16; ++k) { e[k] = __expf(c[k] - c[0]); es += e[k]; }
            const float inv = __builtin_amdgcn_rcpf(es);
            asm volatile("s_waitcnt lgkmcnt(0)" ::: "memory");
            if (p == 0) {
#pragma unroll
                for (int k = 0; k < 16; ++k) { const unsigned code = 255u - (__float_as_uint(c[k]) & 255u);
                    const unsigned ia = 127u - (__float_as_uint(topL[(code >> 4) * 64 + lane]) & 127u), ib = 127u - (__float_as_uint(topL[(code & 15u) * 64 + lane + 1]) & 127u);
                    eidA[tk * 128 + h * 16 + k] = (int)(ia * 128u + ib); wgtA[tk * 128 + h * 16 + k] = e[k] * inv; }
            }
            asm volatile("s_waitcnt lgkmcnt(0)" ::: "memory");
        }
#pragma unroll 1
        for (int tq = 0; tq < 4; ++tq) {
            const int t = pass * 4 + tq; const LAS int* eidL = eidA + tq * 128; const LAS float* wgtL = wgtA + tq * 128;
            const int g = lane & 31, hh = lane >> 5;
            f16x2v xh[16];
            { const float rs = row_rstd((const float*)(A.ws + WS_SSQ), t); const float* sh = mod + (t >> 12) * NMOD + 3 * D + g * 32; const bf16_t* xp = HX + (size_t)t * D + g * 32;
#pragma unroll
              for (int c = 0; c < 4; ++c) { const u32x4 w = *(const u32x4*)(xp + 8 * c); const f32x4 s0 = *(const f32x4*)(sh + 8 * c), s1 = *(const f32x4*)(sh + 8 * c + 4);
                xh[4 * c] = (f16x2v){(_Float16)(bf_lo(w[0]) * rs + s0[0]), (_Float16)(bf_hi(w[0]) * rs + s0[1])}; xh[4 * c + 1] = (f16x2v){(_Float16)(bf_lo(w[1]) * rs + s0[2]), (_Float16)(bf_hi(w[1]) * rs + s0[3])};
                xh[4 * c + 2] = (f16x2v){(_Float16)(bf_lo(w[2]) * rs + s1[0]), (_Float16)(bf_hi(w[2]) * rs + s1[1])}; xh[4 * c + 3] = (f16x2v){(_Float16)(bf_lo(w[3]) * rs + s1[2]), (_Float16)(bf_hi(w[3]) * rs + s1[3])}; } }
            { const int i0 = eidL[lane], i1 = eidL[64 + lane]; suL[lane] = SU[i0]; suL[64 + lane] = SU[i1]; svL[lane] = SVs[i0]; svL[64 + lane] = SVs[i1]; }
            u32x6 rb0[4], rb1[4], rb2[4], rb3[4];
#define LOAD8(buf, TB, hb) do { _Pragma("unroll") for (int r = 0; r < 4; ++r) { const int id = eidL[(hb) * 8 + 2 * r + hh]; const unsigned char* rp = (TB) + (size_t)id * ROWB; \
                const u32x4 lo = *(const u32x4*)(rp + g * 16); const u32x2 hi2 = *(const u32x2*)(rp + 512 + g * 8); buf[r] = (u32x6){lo[0], lo[1], lo[2], lo[3], hi2[0], hi2[1]}; } } while (0)
#define DOT8(buf, off) do { _Pragma("unroll") for (int r = 0; r < 4; ++r) { const f16x32v dq = __builtin_amdgcn_cvt_scalef32_pk32_f16_fp6(buf[r], 1.0f); \
                float sa = 0.f, sb = 0.f, sc = 0.f, sd = 0.f;     \
                _Pragma("unroll") for (int j = 0; j < 16; j += 4) { sa = __builtin_amdgcn_fdot2((f16x2v){dq[2 * j], dq[2 * j + 1]}, xh[j], sa, false); sb = __builtin_amdgcn_fdot2((f16x2v){dq[2 * j + 2], dq[2 * j + 3]}, xh[j + 1], sb, false); \
                    sc = __builtin_amdgcn_fdot2((f16x2v){dq[2 * j + 4], dq[2 * j + 5]}, xh[j + 2], sc, false); sd = __builtin_amdgcn_fdot2((f16x2v){dq[2 * j + 6], dq[2 * j + 7]}, xh[j + 3], sd, false); } \
                pp[(off) + r] = (sa + sb) + (sc + sd); } } while (0)
#define REDUCE16(kb) do { \
            _Pragma("unroll") for (int e = 0; e < 4; ++e) { const bool up = lane & 16; const float keep = up ? pp[e + 4] : pp[e], send = up ? pp[e] : pp[e + 4]; pp[e] = keep + __shfl_xor(send, 16); } \
            _Pragma("unroll") for (int e = 0; e < 2; ++e) { const bool up = lane & 8; const float keep = up ? pp[e + 2] : pp[e], send = up ? pp[e] : pp[e + 2]; pp[e] = keep + __shfl_xor(send, 8); } \
            { const bool up = lane & 4; const float keep = up ? pp[1] : pp[0], send = up ? pp[0] : pp[1]; pp[0] = keep + __shfl_xor(send, 4); } \
            float hsum = pp[0]; hsum += __shfl_xor(hsum, 2); hsum += __shfl_xor(hsum, 1); \
            const int ke = (kb) * 16 + 2 * ((lane >> 2) & 7) + hh; const float su = suL[ke], sv = svL[ke]; \
            const float cf = wgtL[ke] * gelu_exact(hsum * su) * sv; if ((lane & 3) == 0) coefL[ke] = cf; } while (0)
            float pp[8];
            LOAD8(rb0, UT, 0); LOAD8(rb1, UT, 1); LOAD8(rb2, UT, 2);
            LOAD8(rb3, UT, 3); DOT8(rb0, 0);
            LOAD8(rb0, UT, 4); DOT8(rb1, 4); REDUCE16(0);
            LOAD8(rb1, UT, 5); DOT8(rb2, 0);
            LOAD8(rb2, UT, 6); DOT8(rb3, 4); REDUCE16(1);
            LOAD8(rb3, UT, 7); DOT8(rb0, 0);
            LOAD8(rb0, UT, 8); DOT8(rb1, 4); REDUCE16(2);
            LOAD8(rb1, UT, 9); DOT8(rb2, 0);
            LOAD8(rb2, UT, 10); DOT8(rb3, 4); REDUCE16(3);
            LOAD8(rb3, UT, 11); DOT8(rb0, 0);
            LOAD8(rb0, UT, 12); DOT8(rb1, 4); REDUCE16(4);
            LOAD8(rb1, UT, 13); DOT8(rb2, 0);
            LOAD8(rb2, UT, 14); DOT8(rb3, 4); REDUCE16(5);
            LOAD8(rb3, UT, 15); DOT8(rb0, 0);
            DOT8(rb1, 4); REDUCE16(6);
            DOT8(rb2, 0);
            DOT8(rb3, 4); REDUCE16(7);
#undef LOAD8
#undef DOT8
#undef REDUCE16
            asm volatile("s_waitcnt lgkmcnt(0)" ::: "memory");
            PE[(size_t)t * 128 + lane] = eidL[lane]; PE[(size_t)t * 128 + 64 + lane] = eidL[64 + lane];
            PC[(size_t)t * 128 + lane] = coefL[lane]; PC[(size_t)t * 128 + 64 + lane] = coefL[64 + lane];
        }
    }
}
__device__ __forceinline__ void phase_peer_v(const Args& A, LAS unsigned char* lds) {
    const int lane = threadIdx.x & 63, wave = threadIdx.x >> 6, gw = blockIdx.x * NWAVES + wave, NGW = gridDim.x * NWAVES;
    LAS int* eidL = (LAS int*)(lds + wave * 1024); LAS float* coefL = (LAS float*)(lds + wave * 1024 + 512);
    const unsigned char* VT = A.ws + WS_VT; const float* mod = (const float*)(A.ws + WS_MOD);
    const int* PE = (const int*)(A.ws + WS_PE); const float* PC = (const float*)(A.ws + WS_PC);
    const int g = lane & 31, hh = lane >> 5;
    for (int t = gw; t < M; t += NGW) {
        eidL[lane] = PE[(size_t)t * 128 + lane]; eidL[64 + lane] = PE[(size_t)t * 128 + 64 + lane];
        coefL[lane] = PC[(size_t)t * 128 + lane]; coefL[64 + lane] = PC[(size_t)t * 128 + 64 + lane];
        asm volatile("s_waitcnt vmcnt(0) lgkmcnt(0)" ::: "memory");
        u32x6 rb0[4], rb1[4], rb2[4], rb3[4];
#define LOAD8(buf, hb) do { _Pragma("unroll") for (int r = 0; r < 4; ++r) { const int id = eidL[(hb) * 8 + 2 * r + hh]; const unsigned char* rp = VT + (size_t)id * ROWB; \
            const u32x4 lo = *(const u32x4*)(rp + g * 16); const u32x2 hi2 = *(const u32x2*)(rp + 512 + g * 8); buf[r] = (u32x6){lo[0], lo[1], lo[2], lo[3], hi2[0], hi2[1]}; } } while (0)
#define VACC8(buf, hb) do { _Pragma("unroll") for (int r = 0; r < 4; ++r) { const _Float16 ch = (_Float16)coefL[(hb) * 8 + 2 * r + hh]; const f16x2v cf2 = {ch, ch}; \
            const f16x32v dq = __builtin_amdgcn_cvt_scalef32_pk32_f16_fp6(buf[r], 1.0f); \
            _Pragma("unroll") for (int j = 0; j < 16; ++j) yh[j] = cf2 * (f16x2v){dq[2 * j], dq[2 * j + 1]} + yh[j]; } } while (0)
        f16x2v yh[16];
#pragma unroll
        for (int j = 0; j < 16; ++j) yh[j] = (f16x2v){(_Float16)0.f, (_Float16)0.f};
        LOAD8(rb0, 0); LOAD8(rb1, 1); LOAD8(rb2, 2);
        LOAD8(rb3, 3); VACC8(rb0, 0);
        LOAD8(rb0, 4); VACC8(rb1, 1);
        LOAD8(rb1, 5); VACC8(rb2, 2);
        LOAD8(rb2, 6); VACC8(rb3, 3);
        LOAD8(rb3, 7); VACC8(rb0, 4);
        LOAD8(rb0, 8); VACC8(rb1, 5);
        LOAD8(rb1, 9); VACC8(rb2, 6);
        LOAD8(rb2, 10); VACC8(rb3, 7);
        LOAD8(rb3, 11); VACC8(rb0, 8);
        LOAD8(rb0, 12); VACC8(rb1, 9);
        LOAD8(rb1, 13); VACC8(rb2, 10);
        LOAD8(rb2, 14); VACC8(rb3, 11);
        LOAD8(rb3, 15); VACC8(rb0, 12);
        VACC8(rb1, 13);
        VACC8(rb2, 14);
        VACC8(rb3, 15);
#undef LOAD8
#undef VACC8
        float yy[16];
#pragma unroll
        for (int j = 0; j < 16; ++j) { const float y0 = (float)yh[j][0], y1 = (float)yh[j][1]; const float a = y0 + __shfl_xor(y0, 32), b = y1 + __shfl_xor(y1, 32); if ((j >> 3) == hh) { yy[2 * (j & 7)] = a; yy[2 * (j & 7) + 1] = b; } }
        const float* g2 = mod + (t >> 12) * NMOD + 5 * D; float* orow = A.out + (size_t)t * D;
        float z[16]; float ss = 0.f;
#pragma unroll
        for (int q = 0; q < 4; ++q) { const int k = g * 32 + hh * 16 + q * 4; const f32x4 xv = *(const f32x4*)(orow + k), gv = *(const f32x4*)(g2 + k);
#pragma unroll
            for (int j = 0; j < 4; ++j) { const float zz = xv[j] + gv[j] * yy[q * 4 + j]; z[q * 4 + j] = zz; ss += zz * zz; } }
        const float r = rsqrtf(wave_sum(ss) * (1.f / D) + EPS);
#pragma unroll
        for (int q = 0; q < 4; ++q) { const int k = g * 32 + hh * 16 + q * 4; const f32x4 fv = *(const f32x4*)(A.fg + k);
            f32x4 o;
#pragma unroll
            for (int j = 0; j < 4; ++j) o[j] = z[q * 4 + j] * r * fv[j];
            if (!A.dry || r < 0.f) *(f32x4*)(orow + k) = o; }
    }
}
#define XB_TMO      128
#define XB_XCNT(j)  (256  + 64 * (j))
#define XB_XSUB(j)  (1280 + 64 * (j))
#define XB_XGEN(j)  (2304 + 64 * (j))
#define XB_TOP      3328
#define XB_TOPGEN   3392
#define XCD_BAR_WORDS 3456
#define XB_SPIN_CAP (1u << 22)
__device__ __forceinline__ unsigned xb_ld(unsigned* p)              { return __hip_atomic_load(p, __ATOMIC_RELAXED, __HIP_MEMORY_SCOPE_AGENT); }
__device__ __forceinline__ unsigned xb_add(unsigned* p, unsigned v) { return __hip_atomic_fetch_add(p, v, __ATOMIC_RELAXED, __HIP_MEMORY_SCOPE_AGENT); }
__device__ __forceinline__ unsigned xb_xcc_id() { return (unsigned)__builtin_amdgcn_s_getreg((3 << 11) | 20) & 0xFu; }
#define XB_SPIN(cond, bar) do { unsigned _sp = 0; while (cond) { __builtin_amdgcn_s_sleep(1); \
    if ((++_sp & 255u) == 0u) { if (xb_ld(&(bar)[XB_TMO])) break; if (_sp > XB_SPIN_CAP) { atomicAdd(&(bar)[XB_TMO], 1u); break; } } } } while (0)
struct XcdBarrier { unsigned* bar; unsigned x; volatile LAS unsigned* st; };
__device__ __forceinline__ XcdBarrier xcd_barrier_post(unsigned* bar, volatile LAS unsigned* st) {
    XcdBarrier b; b.bar = bar; b.x = xb_xcc_id(); b.st = st;
    if (threadIdx.x == 0) (void)xb_add(&bar[XB_XCNT(b.x)], 1u);
    return b;
}
__device__ __forceinline__ void xcd_barrier_complete(unsigned* bar, unsigned x, unsigned& nloc, unsigned& nx) {
    const unsigned G = gridDim.x * gridDim.y * gridDim.z;
    unsigned sum, cnt, mine, sp = 0u;
    for (;;) {
        sum = 0u; cnt = 0u; mine = 0u;
#pragma unroll
        for (unsigned j = 0; j < 16; ++j) { const unsigned c = xb_ld(&bar[XB_XCNT(j)]); sum += c; cnt += (c > 0u) ? 1u : 0u; mine = (j == x) ? c : mine; }
        if (sum == G) break;
        __builtin_amdgcn_s_sleep(1);
        if ((++sp & 255u) == 0u) { if (xb_ld(&bar[XB_TMO])) break; if (sp > XB_SPIN_CAP) { atomicAdd(&bar[XB_TMO], 1u); break; } }
    }
    nloc = mine > 0u ? mine : 1u; nx = cnt > 0u ? cnt : 1u;
}
__device__ __forceinline__ void xcd_barrier(const XcdBarrier& b) {
    asm volatile("s_waitcnt vmcnt(0)" ::: "memory");
    __syncthreads();
    if (threadIdx.x == 0) {
        unsigned* bar = b.bar;
        __builtin_amdgcn_s_waitcnt(0);
        unsigned nloc = b.st[0], nx = b.st[1];
        if (nloc == 0u) { xcd_barrier_complete(bar, b.x, nloc, nx); b.st[0] = nloc; b.st[1] = nx; }
        const unsigned old = xb_add(&bar[XB_XSUB(b.x)], 1u);
        const unsigned gen = old / nloc;
        if (old + 1u == (gen + 1u) * nloc) {
            __builtin_amdgcn_fence(__ATOMIC_RELEASE, "agent");
            asm volatile("s_waitcnt vmcnt(0)" ::: "memory");
            const unsigned og = xb_add(&bar[XB_TOP], 1u);
            const unsigned tg = og / nx;
            if (og + 1u == (tg + 1u) * nx) xb_add(&bar[XB_TOPGEN], 1u);
            else XB_SPIN(xb_ld(&bar[XB_TOPGEN]) == tg, bar);
            __builtin_amdgcn_fence(__ATOMIC_ACQUIRE, "agent");
            xb_add(&bar[XB_XGEN(b.x)], 1u);
            asm volatile("s_waitcnt vmcnt(0)" ::: "memory");
        } else {
            XB_SPIN(xb_ld(&bar[XB_XGEN(b.x)]) == gen, bar);
            __builtin_amdgcn_fence(__ATOMIC_ACQUIRE, "agent");
            asm volatile("s_waitcnt vmcnt(0)" ::: "memory");
        }
    }
    __syncthreads();
}
constexpr int MISC_OFF = 135168;

constexpr int N_PHASES = 10;
__global__ void __launch_bounds__(NWAVES * 64, 2) mega_fwd(Args A) {
    extern __shared__ __attribute__((aligned(16))) unsigned char lds[];
    LAS unsigned char* L = (LAS unsigned char*)lds;
    cg::grid_group grid = cg::this_grid();
    const int lo = A.ph_lo, hi = A.ph_hi, G = gridDim.x, c = blockIdx.x;
#ifndef PH_MASK
#define PH_MASK 0x3FF
#endif
#define IN(k) (((PH_MASK >> (k)) & 1) && lo <= (k) && (k) < hi)
    unsigned* barw = (unsigned*)(A.ws + WS_CTL);
    volatile LAS unsigned* MISC = (volatile LAS unsigned*)(L + MISC_OFF);
    if (threadIdx.x < 2) MISC[threadIdx.x] = 0u;
    if (lo == 0 && hi > 1 && blockIdx.x == 0) for (int i = threadIdx.x; i < XCD_BAR_WORDS; i += NWAVES * 64) barw[i] = 0u;
    XcdBarrier xb; xb.bar = barw; xb.x = 0; xb.st = MISC;
#define SEAM(k) do { if (IN(k) && IN((k) + 1)) { if ((k) == 0) { grid.sync(); xb = xcd_barrier_post(barw, MISC); } else xcd_barrier(xb); } } while (0)
    if (IN(0)) phase_prologue(A, L);
    SEAM(0);
    if (IN(1)) phase_hx(A);
    SEAM(1);
    if (IN(2)) { SchedInProj Sd{(const char*)(A.ws + WS_HX), (const char*)(A.ws + WS_HC), (const char*)(A.ws + WS_WIN), G, c}; EpiInProj E{A.ws};
        pg8::gemm_phase<EpiInProj, SchedInProj, true>(L, D, Sd, E); }
    SEAM(2);
    if (IN(3)) { phase_kfix(A); phase_vt(A, L); __syncthreads(); phase_conv(A, L); }
    SEAM(3);
    if (IN(4)) phase_attn(A, lds);
    SEAM(4);
    if (IN(5)) { SchedMerge Sd{(const char*)(A.ws + WS_Q), (const char*)(A.ws + WS_HX), (const char*)(A.ws + WS_WA), (const char*)(A.ws + WS_WC), G, c}; EpiMerge E{A.ws};
        pg8::gemm_phase<EpiMerge, SchedMerge, true>(L, D, Sd, E); }
    SEAM(5);
    if (IN(6)) { SchedPlain Sd{(const char*)(A.ws + WS_G), (const char*)(A.ws + WS_WO), M / 256, D / 256, G, c};
        EpiOut E{A.x, (const float*)(A.ws + WS_MOD), A.n2g, A.out, (bf16_t*)(A.ws + WS_HX), (float*)(A.ws + WS_SSQ)};
        pg8::gemm_phase<EpiOut, SchedPlain, true>(L, D, Sd, E); }
    SEAM(6);
    if (IN(7)) { SchedPlain Sd{(const char*)(A.ws + WS_HX), (const char*)(A.ws + WS_WP), M / 256, PW / 256, G, c};
        EpiScores E{(float*)(A.ws + WS_SC), (const float*)(A.ws + WS_SSQ), (const float*)(A.ws + WS_SBIAS)};
        pg8::gemm_phase<EpiScores, SchedPlain, true>(L, D, Sd, E); }
    SEAM(7);
    if (IN(8)) phase_peer_u(A, L);
    SEAM(8);
    if (IN(9)) phase_peer_v(A, L);
#undef IN
#undef SEAM
}

#ifndef MK_ONE_LAUNCH
#define MK_ONE_LAUNCH 1
#endif
extern "C" void kernel_launch(void* const* d_in, const int* in_sizes, int n_in, void* d_out, int out_size, void* d_ws, size_t ws_size, hipStream_t stream) {
    static int grid = 0;
    if (grid == 0) {
        if (n_in != 23 || out_size != M * D || ws_size < WS_END) { fprintf(stderr, "kernel_launch: unexpected shapes (n_in %d out %d ws %zu)\n", n_in, out_size, ws_size); grid = -1; return; }
        int dev = 0, cus = 0, per_cu = 0;
        hipGetDevice(&dev); hipDeviceGetAttribute(&cus, hipDeviceAttributeMultiprocessorCount, dev);
        if (hipFuncSetAttribute((const void*)mega_fwd, hipFuncAttributeMaxDynamicSharedMemorySize, LDS_BYTES) != hipSuccess) { fprintf(stderr, "kernel_launch: hipFuncSetAttribute failed\n"); grid = -1; return; }
        if (hipOccupancyMaxActiveBlocksPerMultiprocessor(&per_cu, (const void*)mega_fwd, NWAVES * 64, LDS_BYTES) != hipSuccess || per_cu < 1) { fprintf(stderr, "kernel_launch: occupancy query says %d\n", per_cu); per_cu = 1; }
        (void)hipGetLastError();
        grid = cus * 1;
        if (per_cu < 1) grid = -1;
    }
    if (grid < 0) return;
    Args a{};
    const float** f = (const float**)&a;
    for (int i = 0; i < 23; ++i) f[i] = (const float*)d_in[i];
    a.out = (float*)d_out; a.ws = (unsigned char*)d_ws;
#if MK_ONE_LAUNCH
    a.ph_lo = 0; a.ph_hi = N_PHASES;
    void* args[] = {&a};
    hipError_t e = hipLaunchCooperativeKernel((const void*)mega_fwd, dim3(grid), dim3(NWAVES * 64), args, LDS_BYTES, stream);
    if (e != hipSuccess) fprintf(stderr, "cooperative launch failed: %s (grid %d)\n", hipGetErrorString(e), grid);
#else
#ifndef REPEAT_PH
#define REPEAT_PH -1
#endif
    for (int p = 0; p < N_PHASES; ++p) { a.ph_lo = p; a.ph_hi = p + 1;
        if (p == REPEAT_PH) { a.dry = 1; hipLaunchKernelGGL(mega_fwd, dim3(grid), dim3(NWAVES * 64), LDS_BYTES, stream, a); a.dry = 0; }
        hipLaunchKernelGGL(mega_fwd, dim3(grid), dim3(NWAVES * 64), LDS_BYTES, stream, a); }
#endif
}
```

```cpp
#include <hip/hip_runtime.h>
#include <hip/hip_cooperative_groups.h>
#include <cstdio>
#include <cstdint>
namespace cg = cooperative_groups;

#define LAS __attribute__((address_space(3)))
typedef unsigned short bf16_t;
typedef short bf16x8 __attribute__((ext_vector_type(8)));
typedef short s16x4 __attribute__((ext_vector_type(4)));
typedef float f32x2 __attribute__((ext_vector_type(2)));
typedef float f32x4 __attribute__((ext_vector_type(4)));
typedef float f32x16 __attribute__((ext_vector_type(16)));
typedef unsigned u32x2 __attribute__((ext_vector_type(2)));
typedef unsigned u32x4 __attribute__((ext_vector_type(4)));
typedef __bf16 bf16x2_t __attribute__((ext_vector_type(2)));

constexpr int D = 1024, NB = 8, S = 4096, CTXL = 256, SKV = S + CTXL, HD = 128, HQ = 8, HKV = 2;
constexpr int M = NB * S;
constexpr int MC = NB * CTXL;
constexpr int INW = 5632, NMOD = 6144, NEXP = 16384, PW = 2048;
constexpr float EPS = 1e-6f;

__device__ __forceinline__ unsigned cvt_pk_bf16(float lo, float hi) { f32x2 v = {lo, hi}; bf16x2_t b = __builtin_convertvector(v, bf16x2_t); return __builtin_bit_cast(unsigned, b); }
__device__ __forceinline__ float bf_lo(unsigned u) { return __uint_as_float(u << 16); }
__device__ __forceinline__ float bf_hi(unsigned u) { return __uint_as_float(u & 0xffff0000u); }
__device__ __forceinline__ float fast_sigmoid(float x) { return __builtin_amdgcn_rcpf(1.f + __builtin_amdgcn_exp2f(-1.4426950408889634f * x)); }
__device__ __forceinline__ float wave_sum(float v) {
#pragma unroll
    for (int o = 1; o < 64; o <<= 1) v += __shfl_xor(v, o);
    return v;
}

namespace pg8 {
constexpr int BM = 256, BK = 64, HALF = 128, HTB = HALF * BK * 2  , STAGE_BYTES = 8 * HTB, NXCD = 8, WGM = 8;
__host__ __device__ __forceinline__ int lds_byte(int r, int c) { const int st = (r >> 4) * 2 + (c >> 5), rr = r & 15, cc = c & 31, ob = rr * 64 + cc * 2; return st * 1024 + (ob ^ (((ob >> 9) & 1) << 5)); }
__host__ __device__ __forceinline__ void stage_rc(int b, int& R, int& C) { const int st = b / 1024, sb = b % 1024, swz = sb ^ (((sb >> 9) & 1) << 5); R = (st >> 1) * 16 + swz / 64; C = (st & 1) * 32 + (swz % 64) / 2; }
__host__ __device__ __forceinline__ int perm32(int rho) { const int n = rho >> 4, i = rho & 15; return 8 * (i >> 2) + 4 * n + (i & 3); }

struct Unit { const char* a; const char* b; int pm, pn, kind, keep; };

__device__ __forceinline__ void tile_of(int L, int nM, int nN, int& pm, int& pn) {
    const int nwg = nM * nN; int wgid = L;
    { const int q = nwg / NXCD, r = nwg % NXCD, xcd = wgid % NXCD, off = wgid / NXCD; wgid = (xcd < r ? xcd * (q + 1) : r * (q + 1) + (xcd - r) * q) + off; }
    const int nig = WGM * nN, gid = wgid / nig, fm = gid * WGM, gsz = (nM - fm) < WGM ? (nM - fm) : WGM;
    pm = fm + ((wgid % nig) % gsz); pn = (wgid % nig) / gsz;
}

template <class Epi, class Sched, bool ALIGN_EPI>
__device__ __forceinline__ void gemm_phase(LAS unsigned char* lds, const int K, const Sched& S, const Epi& E) {
    const int tid = threadIdx.x, wid = __builtin_amdgcn_readfirstlane(tid >> 6), lane = tid & 63, wr = wid >> 2, wc = wid & 3, fr = lane & 15, fq = lane >> 4;
    const int nt = K / BK;
    unsigned voffA[2], voffB[2];
#pragma unroll
    for (int i = 0; i < 2; ++i) { int R, C; stage_rc(tid * 16 + i * 8192, R, C); const int Rb = Epi::PERM ? ((R & ~31) + perm32(R & 31)) : R;
        voffA[i] = (unsigned)(R * K + C) * 2u; voffB[i] = (unsigned)(Rb * K + C) * 2u; }
    const size_t kstep = (size_t)(BK * 2);
    const size_t hstep = (size_t)HALF * K * 2;
    const unsigned ldsw = (unsigned)wid * 1024u;
    const int aoff = lds_byte(wr * 64 + fr, fq * 8), boff = lds_byte(wc * 32 + fr, fq * 8);
#define PG8_SA(b, h) (((b) * 2 + (h)) * HTB)
#define PG8_SB(b, h) ((4 + (b) * 2 + (h)) * HTB)
#define PG8_STAGE(bufoff, gbase, voff) do { _Pragma("unroll") for (int _i = 0; _i < 2; ++_i) \
        __builtin_amdgcn_global_load_lds((const unsigned*)((const char*)(gbase) + (voff)[_i]), (LAS unsigned*)(lds + (bufoff) + ldsw + _i * 8192), 16, 0, 0); } while (0)
#define PG8_LDA(dst, b, h) do { _Pragma("unroll") for (int m = 0; m < 4; ++m) _Pragma("unroll") for (int k = 0; k < 2; ++k) dst[m][k] = *(const LAS bf16x8*)(lds + PG8_SA(b, h) + aoff + m * 2048 + k * 1024); } while (0)
#define PG8_LDB(dst, b, h) do { _Pragma("unroll") for (int n = 0; n < 2; ++n) _Pragma("unroll") for (int k = 0; k < 2; ++k) dst[n][k] = *(const LAS bf16x8*)(lds + PG8_SB(b, h) + boff + n * 2048 + k * 1024); } while (0)
#define PG8_MMA(ai, bj, At, Bt) do { __builtin_amdgcn_s_setprio(1); _Pragma("unroll") for (int m = 0; m < 4; ++m) _Pragma("unroll") for (int n = 0; n < 2; ++n) _Pragma("unroll") for (int k = 0; k < 2; ++k) \
        acc[ai][bj][m][n] = __builtin_amdgcn_mfma_f32_16x16x32_bf16(Bt[n][k], At[m][k], acc[ai][bj][m][n], 0, 0, 0); __builtin_amdgcn_s_setprio(0); } while (0)
#define PG8_WAIT_V(n) asm volatile("s_waitcnt vmcnt(" #n ")" ::: "memory")
#define PG8_WAIT_L(n) asm volatile("s_waitcnt lgkmcnt(" #n ")" ::: "memory")
#define PG8_BAR __builtin_amdgcn_s_barrier()
#define PG8_SCHED __builtin_amdgcn_sched_barrier(0)
    Unit cur, nxt; int ui = 0;
    if (!S.next(0, cur)) return;
    f32x4 acc[2][2][4][2];
#pragma unroll
    for (int a = 0; a < 2; ++a)
#pragma unroll
        for (int b = 0; b < 2; ++b)
#pragma unroll
            for (int m = 0; m < 4; ++m)
#pragma unroll
                for (int n = 0; n < 2; ++n) acc[a][b][m][n] = (f32x4){0.f, 0.f, 0.f, 0.f};
    bf16x8 At[4][2], B0[2][2], B1[2][2];
    const char* cA = cur.a; const char* cB = cur.b;
    PG8_STAGE(PG8_SB(0, 0), cB, voffB); PG8_STAGE(PG8_SB(0, 1), cB + hstep, voffB); PG8_STAGE(PG8_SA(0, 0), cA, voffA); PG8_STAGE(PG8_SA(0, 1), cA + hstep, voffA);
    if (wr == 1) PG8_BAR;
    PG8_WAIT_V(2); PG8_BAR;
    PG8_STAGE(PG8_SB(1, 0), cB + kstep, voffB); PG8_STAGE(PG8_SA(1, 0), cA + kstep, voffA); PG8_STAGE(PG8_SB(1, 1), cB + hstep + kstep, voffB);
    PG8_WAIT_V(6); PG8_BAR;
    for (;;) {
        const bool has_next = S.next(ui + 1, nxt);
        const char* nA = has_next ? nxt.a : cA; const char* nB = has_next ? nxt.b : cB;
        for (int t = 0; t < nt; t += 2) {
            const bool last = (t == nt - 2);
            const char* a1 = cA + (size_t)(t + 1) * kstep;
            const char* a2 = last ? nA : cA + (size_t)(t + 2) * kstep; const char* b2 = last ? nB : cB + (size_t)(t + 2) * kstep;
            const char* a3 = a2 + kstep; const char* b3 = b2 + kstep;
            PG8_LDB(B0, 0, 0); PG8_LDB(B1, 0, 1); PG8_SCHED; PG8_LDA(At, 0, 0); PG8_STAGE(PG8_SA(1, 1), a1 + hstep, voffA);
            PG8_WAIT_V(8); PG8_WAIT_L(0); PG8_BAR; PG8_MMA(0, 0, At, B0); PG8_MMA(0, 1, At, B1); PG8_BAR; PG8_SCHED;
            PG8_LDA(At, 0, 1); PG8_STAGE(PG8_SB(0, 0), b2, voffB); PG8_STAGE(PG8_SB(0, 1), b2 + hstep, voffB); PG8_STAGE(PG8_SA(0, 0), a2, voffA);
            PG8_WAIT_V(8); PG8_WAIT_L(0); PG8_BAR; PG8_MMA(1, 0, At, B0); PG8_MMA(1, 1, At, B1); PG8_BAR; PG8_SCHED;
            PG8_LDB(B0, 1, 0); PG8_LDB(B1, 1, 1); PG8_SCHED; PG8_LDA(At, 1, 0); PG8_STAGE(PG8_SA(0, 1), a2 + hstep, voffA);
            PG8_WAIT_V(8); PG8_WAIT_L(0); PG8_BAR; PG8_MMA(0, 0, At, B0); PG8_MMA(0, 1, At, B1); PG8_BAR; PG8_SCHED;
            PG8_LDA(At, 1, 1); PG8_STAGE(PG8_SB(1, 0), b3, voffB); PG8_STAGE(PG8_SB(1, 1), b3 + hstep, voffB); PG8_STAGE(PG8_SA(1, 0), a3, voffA);
            PG8_WAIT_V(8); PG8_WAIT_L(0); PG8_BAR; PG8_MMA(1, 0, At, B0); PG8_MMA(1, 1, At, B1); PG8_BAR; PG8_SCHED;
        }
        if constexpr (ALIGN_EPI) { if (wr == 0) PG8_BAR; }
        E(acc, cur, wr, wc, fr, fq);
        if (!has_next) break;
        if (!cur.keep) {
#pragma unroll
        for (int a = 0; a < 2; ++a)
#pragma unroll
            for (int b = 0; b < 2; ++b)
#pragma unroll
                for (int m = 0; m < 4; ++m)
#pragma unroll
                    for (int n = 0; n < 2; ++n) acc[a][b][m][n] = (f32x4){0.f, 0.f, 0.f, 0.f};
        }
        cur = nxt; cA = nA; cB = nB; ++ui;
        if constexpr (ALIGN_EPI) { if (wr == 1) PG8_BAR; }
    }
    PG8_WAIT_V(0);
    if constexpr (!ALIGN_EPI) { if (wr == 0) PG8_BAR; }
    PG8_BAR;
#undef PG8_SA
#undef PG8_SB
#undef PG8_STAGE
#undef PG8_LDA
#undef PG8_LDB
#undef PG8_MMA
#undef PG8_WAIT_V
#undef PG8_WAIT_L
#undef PG8_BAR
#undef PG8_SCHED
}
}
namespace att {
typedef int v8i __attribute__((ext_vector_type(8)));
constexpr int NW = 8, QBLK = 32, KVBLK = 64;
constexpr float SCALE = 0.088388347648318440f;
constexpr float SC8 = SCALE / 256.f;
constexpr float THR = 3.f;
constexpr int LDQ = D, LDO = D;
constexpr int SHM_V = 8192, SHM_K = 8192, NRING = 3, OFF_K = NRING * SHM_V, OFF_WS = OFF_K + NRING * SHM_K, OST_OFF = OFF_WS + NW * 64 * 4, LDS_TOTAL = OST_OFF + NW * 8192;
#define SBAR() __builtin_amdgcn_sched_barrier(0)
#define MFMA8(a, b, c) __builtin_amdgcn_mfma_scale_f32_32x32x64_f8f6f4((a), (b), (c), 0, 0, 0, 0x7f7f7f7f, 0, 0x7f7f7f7f)
__device__ __forceinline__ int crow(int r, int hi) { return (r & 3) + 8 * (r >> 2) + 4 * hi; }
__device__ __forceinline__ int k_lds(int row, int chunk) { return row * 128 + ((chunk ^ ((row >> 1) & 7)) << 4); }
__device__ __forceinline__ int v_lds(int d, int slot) { return d * 64 + ((slot ^ ((d >> 2) & 3)) << 4); }
__device__ __forceinline__ float max3f(float a, float b, float c) { float r; asm("v_max3_f32 %0, %1, %2, %3" : "=v"(r) : "v"(a), "v"(b), "v"(c)); return r; }
__device__ __forceinline__ int pk4_fp8(float a, float b, float c, float d) { int w = __builtin_amdgcn_cvt_pk_fp8_f32(a, b, 0, false); return __builtin_amdgcn_cvt_pk_fp8_f32(c, d, w, true); }

__device__ __forceinline__ void partialSM(f32x16& p0, f32x16& p1, float& m_reg, float& mn, float& alpha) {
  constexpr float C = SC8 * 1.4426950408889634f;
  asm volatile("s_nop 15\n\ts_nop 7" : "+v"(p0), "+v"(p1));
  float mx[8];
#pragma unroll
  for (int i = 0; i < 8; ++i) mx[i] = max3f(p0[i], p0[8 + i], p1[i]);
  float m4[4];
#pragma unroll
  for (int i = 0; i < 4; ++i) m4[i] = max3f(mx[i], mx[4 + i], p1[8 + i]);
  float m2a = max3f(m4[0], m4[1], p1[12]), m2b = max3f(m4[2], m4[3], p1[13]);
  float pmax = max3f(m2a, m2b, p1[14]); pmax = max3f(pmax, p1[15], p1[15]);
  { auto rr = __builtin_amdgcn_permlane32_swap(__float_as_uint(pmax), __float_as_uint(pmax), false, false);
    pmax = fmaxf(__uint_as_float(rr[0]), __uint_as_float(rr[1])); }
  if (__builtin_expect(__all(pmax - m_reg <= THR / SC8), 1)) { mn = m_reg; alpha = 1.f; }
  else { mn = fmaxf(m_reg, pmax); alpha = __builtin_amdgcn_exp2f((m_reg - mn) * C); m_reg = mn; }
  float mnC = 4.f - mn * C;
  for (int r = 0; r < 16; ++r) p0[r] = fmaf(p0[r], C, mnC); for (int r = 0; r < 16; ++r) p1[r] = fmaf(p1[r], C, mnC);
  for (int r = 0; r < 16; ++r) p0[r] = __builtin_amdgcn_exp2f(p0[r]);
}
__device__ __forceinline__ void finishSM(f32x16& p0, f32x16& p1, float alpha, float& l_reg, v8i& pa) {
  for (int r = 0; r < 16; ++r) p1[r] = __builtin_amdgcn_exp2f(p1[r]);
  float sm[8];
#pragma unroll
  for (int i = 0; i < 8; ++i) sm[i] = (p0[i] + p0[8 + i]) + (p1[i] + p1[8 + i]);
  float ps = ((sm[0] + sm[1]) + (sm[2] + sm[3])) + ((sm[4] + sm[5]) + (sm[6] + sm[7]));
  { auto rr = __builtin_amdgcn_permlane32_swap(__float_as_uint(ps), __float_as_uint(ps), false, false);
    ps = __uint_as_float(rr[0]) + __uint_as_float(rr[1]); }
  l_reg = l_reg * alpha + ps;
  pa[0] = pk4_fp8(p0[0], p0[1], p0[2], p0[3]); pa[1] = pk4_fp8(p0[4], p0[5], p0[6], p0[7]); pa[2] = pk4_fp8(p0[8], p0[9], p0[10], p0[11]); pa[3] = pk4_fp8(p0[12], p0[13], p0[14], p0[15]);
  pa[4] = pk4_fp8(p1[0], p1[1], p1[2], p1[3]); pa[5] = pk4_fp8(p1[4], p1[5], p1[6], p1[7]); pa[6] = pk4_fp8(p1[8], p1[9], p1[10], p1[11]); pa[7] = pk4_fp8(p1[12], p1[13], p1[14], p1[15]);
}
__device__ __forceinline__ v8i ld32(const char* p0, const char* p1) { const u32x4 a = *reinterpret_cast<const u32x4*>(p0), b = *reinterpret_cast<const u32x4*>(p1);
  v8i r; r[0] = (int)a[0]; r[1] = (int)a[1]; r[2] = (int)a[2]; r[3] = (int)a[3]; r[4] = (int)b[0]; r[5] = (int)b[1]; r[6] = (int)b[2]; r[7] = (int)b[3]; return r; }
__device__ __forceinline__ void qkt(f32x16& p0, f32x16& p1, const char* Ks, const v8i* qf, int r32, int hi) {
  p0 = f32x16{}; p1 = f32x16{};
#pragma unroll
  for (int s = 0; s < 2; ++s) {
    const v8i a0 = ld32(Ks + k_lds(r32, 4 * s + hi), Ks + k_lds(r32, 4 * s + 2 + hi)), a1 = ld32(Ks + k_lds(32 + r32, 4 * s + hi), Ks + k_lds(32 + r32, 4 * s + 2 + hi));
    p0 = MFMA8(a0, qf[s], p0); p1 = MFMA8(a1, qf[s], p1); }
}
__device__ __forceinline__ void pv(f32x16* o, const char* Vs, const v8i pa, int r32, int hi) {
#pragma unroll
  for (int d0 = 0; d0 < 4; ++d0) { const int d = 32 * d0 + r32; const v8i b = ld32(Vs + v_lds(d, 2 * hi), Vs + v_lds(d, 2 * hi + 1)); o[d0] = MFMA8(pa, b, o[d0]); }
}

__device__ __forceinline__ void attn_unit(const bf16_t* Qb, const unsigned char* __restrict__ K8, const unsigned char* __restrict__ VT, bf16_t* Ob, int t0, int seq,
                                          const float* __restrict__ qng, const float* __restrict__ cst, const float* __restrict__ snt, char* lds) {
  int tid_ = threadIdx.x; asm volatile("" : "+v"(tid_));
  const int tid = tid_, wid = tid >> 6, lane = tid & 63, r32 = lane & 31, hi = lane >> 5;
  char* V_lds = lds; char* K_lds = lds + OFF_K;
  float* ws = (float*)(lds + OFF_WS) + wid * 64; float* li_l = ws; float* al_l = ws + 32;
  float m_reg = -1e30f, l_reg = 0; f32x16 o[4] = {}; v8i qf[2];
  {
    const bf16_t* Qw = Qb + (long)(wid * QBLK + r32) * LDQ + 16 * hi;
    float y[2][32]; float ss = 0.f;
#pragma unroll
    for (int s = 0; s < 2; ++s)
#pragma unroll
      for (int part = 0; part < 2; ++part)
#pragma unroll
        for (int c = 0; c < 2; ++c) { const u32x4 w = *reinterpret_cast<const u32x4*>(Qw + 64 * s + 32 * part + 8 * c);
#pragma unroll
          for (int j = 0; j < 4; ++j) { const float a = bf_lo(w[j]), b = bf_hi(w[j]); y[s][16 * part + 8 * c + 2 * j] = a; y[s][16 * part + 8 * c + 2 * j + 1] = b; ss += a * a + b * b; } }
    ss += __shfl_xor(ss, 32);
    const float rstd = rsqrtf(ss * (1.f / HD) + EPS) * 16.f;
    const int t = t0 + wid * QBLK + r32;
#pragma unroll
    for (int s = 0; s < 2; ++s) { const int pos = s == 0 ? (t >> 6) : (t & 63);
#pragma unroll
      for (int c = 0; c < 4; ++c) { const int i0 = 16 * hi + 4 * c;
        const f32x4 g1 = *reinterpret_cast<const f32x4*>(qng + 64 * s + i0), g2 = *reinterpret_cast<const f32x4*>(qng + 64 * s + 32 + i0);
        const f32x4 c4 = *reinterpret_cast<const f32x4*>(cst + pos * 32 + i0), s4 = *reinterpret_cast<const f32x4*>(snt + pos * 32 + i0);
#pragma unroll
        for (int j = 0; j < 4; ++j) { const float x1 = y[s][4 * c + j] * rstd * g1[j], x2 = y[s][16 + 4 * c + j] * rstd * g2[j]; y[s][4 * c + j] = x1 * c4[j] - x2 * s4[j]; y[s][16 + 4 * c + j] = x1 * s4[j] + x2 * c4[j]; } }
#pragma unroll
      for (int w = 0; w < 8; ++w) qf[s][w] = pk4_fp8(y[s][4 * w], y[s][4 * w + 1], y[s][4 * w + 2], y[s][4 * w + 3]); }
  }
  const int krow = tid >> 3, kch = tid & 7, kst = k_lds(krow, kch), vst = v_lds(tid >> 2, tid & 3);
  const unsigned char* kg = K8 + (long)krow * 256 + kch * 16; const unsigned char* vg = VT + tid * 16;
  struct { u32x4 k, v; } sr_[2];
#define SLOAD(i, kt) do { sr_[i].k = *reinterpret_cast<const u32x4*>(kg + (long)(kt) * (KVBLK * 256)); sr_[i].v = *reinterpret_cast<const u32x4*>(vg + (long)(kt) * 8192); } while (0)
#define SWRITE(boff, i) do { *(u32x4*)(V_lds + (boff) + vst) = sr_[i].v; *(u32x4*)(K_lds + (boff) + kst) = sr_[i].k; } while (0)
#define SWAIT() asm volatile("s_waitcnt vmcnt(2)" ::: "memory")
#define RESC(a) do { if (__any((a) < 1.f)) { if (hi == 0) al_l[r32] = (a); asm volatile("s_waitcnt lgkmcnt(0)" ::: "memory"); \
    for (int d = 0; d < 4; ++d) for (int r = 0; r < 16; ++r) o[d][r] *= al_l[crow(r, hi)]; } } while (0)
  f32x16 pA0, pA1, pB0, pB1; float mnA, mnB, alA, alB; v8i pa; const int NT = seq / KVBLK;
  constexpr int SE = 0, SO = 1;
  int bprev = 0, bcur = SHM_K, bnext = 2 * SHM_K;
#define ROT() do { const int t_ = bprev; bprev = bcur; bcur = bnext; bnext = t_; } while (0)
  SLOAD(SE, 0); asm volatile("s_waitcnt vmcnt(0)" ::: "memory"); SWRITE(0, SE); __syncthreads();
  qkt(pA0, pA1, K_lds, qf, r32, hi); partialSM(pA0, pA1, m_reg, mnA, alA);
  SLOAD(SO, 1); if (2 < NT) SLOAD(SE, 2);
  SWAIT(); SWRITE(SHM_K, SO); __syncthreads();
  for (int j = 1; j + 1 < NT; j += 2) {
    SBAR(); qkt(pB0, pB1, K_lds + bcur, qf, r32, hi);
    finishSM(pA0, pA1, alA, l_reg, pa); SBAR();
    SLOAD(SO, j + 2); SBAR();
    pv(o, V_lds + bprev, pa, r32, hi); partialSM(pB0, pB1, m_reg, mnB, alB);
    SWAIT(); SWRITE(bnext, SE);
    RESC(alB); __syncthreads(); ROT();
    SBAR(); qkt(pA0, pA1, K_lds + bcur, qf, r32, hi);
    finishSM(pB0, pB1, alB, l_reg, pa); SBAR();
    if (j + 3 < NT) SLOAD(SE, j + 3); SBAR();
    pv(o, V_lds + bprev, pa, r32, hi); partialSM(pA0, pA1, m_reg, mnA, alA);
    SWAIT(); SWRITE(bnext, SO);
    RESC(alA); __syncthreads(); ROT();
  }
  SBAR(); qkt(pB0, pB1, K_lds + bcur, qf, r32, hi);
  finishSM(pA0, pA1, alA, l_reg, pa); SBAR();
  pv(o, V_lds + bprev, pa, r32, hi); partialSM(pB0, pB1, m_reg, mnB, alB);
  RESC(alB);
  finishSM(pB0, pB1, alB, l_reg, pa); SBAR();
  pv(o, V_lds + bcur, pa, r32, hi);
  __syncthreads();
#undef ROT
  if (hi == 0) li_l[r32] = l_reg; asm volatile("s_waitcnt lgkmcnt(0)" ::: "memory");
  float rli[16];
#pragma unroll
  for (int r = 0; r < 16; ++r) rli[r] = __builtin_amdgcn_rcpf(16.f * li_l[crow(r, hi)]);
  { bf16_t* stg = (bf16_t*)(lds + OST_OFF) + wid * 4096;
#pragma unroll
    for (int r = 0; r < 16; ++r) { const int orow = crow(r, hi);
#pragma unroll
      for (int d0 = 0; d0 < 4; ++d0) stg[orow * 128 + d0 * 32 + r32] = (bf16_t)(cvt_pk_bf16(o[d0][r] * rli[r], 0.f) & 0xffffu); }
    asm volatile("s_waitcnt lgkmcnt(0)" ::: "memory");
    bf16_t* Ow = Ob + (long)(wid * QBLK) * LDO;
#pragma unroll
    for (int i = 0; i < 8; ++i) { const int row = i * 4 + (lane >> 4), ch = lane & 15; const u32x4 v = *(const u32x4*)(stg + row * 128 + ch * 8); *(u32x4*)(Ow + (long)row * LDO + ch * 8) = v; }
  }
#undef SLOAD
#undef SWRITE
#undef SWAIT
#undef RESC
}
#undef SBAR
#undef MFMA8
}
constexpr size_t MiB = 1u << 20;
constexpr size_t WS_CTL = 0, CTL_ZERO_BYTES = 64 * 1024;
constexpr size_t WS_MOD = 1 * MiB;
constexpr size_t WS_ROPE = WS_MOD + 256 * 1024;
constexpr size_t WS_SBIAS = WS_MOD + 512 * 1024;
constexpr size_t WS_HC = 2 * MiB;
constexpr size_t WS_WIN = 6 * MiB;
constexpr size_t WS_WA = 17 * MiB, WS_WC = 19 * MiB, WS_WO = 21 * MiB;
constexpr size_t WS_WP = 23 * MiB;
constexpr size_t WS_UT = 27 * MiB, WS_VT = 59 * MiB;
constexpr size_t WS_TSCALE = 16 * MiB;
constexpr size_t WS_KB = 91 * MiB, WS_VB = 108 * MiB;
constexpr size_t WS_HX = 125 * MiB;
constexpr size_t WS_Q = 189 * MiB;
constexpr size_t WS_G = 253 * MiB;
constexpr size_t WS_RT = 317 * MiB;
constexpr size_t WS_SGC = 381 * MiB;
constexpr size_t WS_SC = 189 * MiB;
constexpr size_t WS_SSQ = 445 * MiB;
constexpr size_t WS_K8 = 447 * MiB;
constexpr size_t WS_VT8 = 456 * MiB;
constexpr size_t WS_PE = 465 * MiB, WS_PC = 481 * MiB;
constexpr size_t WS_END = 497 * MiB;

constexpr int NWAVES = 8;
constexpr int LDS_BYTES = 147456;

struct Args {
    const float *x, *c, *ctx, *c_ctx, *w_mod, *b_mod, *n1g, *n2g, *w_in, *qng, *kng, *w_ao, *cdw, *cb, *clg, *clb, *w_co, *w_o, *wq, *keys, *ut, *vt, *fg;
    float* out; unsigned char* ws; int ph_lo, ph_hi, dry, pad;
};

__host__ __device__ __forceinline__ int win_row(int n) {
    if (n < 1536) return n;
    const int base = n < 3584 ? 1536 : 3584, m = n - base, half = m >> 10, idx = m & 1023;
    return base + (idx >> 7) * 256 + half * 128 + (idx & 127);
}

__device__ __forceinline__ void task_mod(const Args& A, int task, int lane, const LAS float* sc) {
    const int n0 = task * 8, col = lane & 7, kg = lane >> 3;
    float acc[9];
#pragma unroll
    for (int b = 0; b < 9; ++b) acc[b] = 0.f;
    const float* wp = A.w_mod + (size_t)kg * NMOD + n0 + col;
    for (int i0 = 0; i0 < 128; i0 += 8) {
        float w[8];
#pragma unroll
        for (int u = 0; u < 8; ++u) w[u] = wp[(size_t)(i0 + u) * 8 * NMOD];
#pragma unroll
        for (int u = 0; u < 8; ++u) { const int k = kg + 8 * (i0 + u);
#pragma unroll
            for (int b = 0; b < 9; ++b) acc[b] += sc[b * D + k] * w[u]; }
    }
#pragma unroll
    for (int b = 0; b < 9; ++b) { float v = acc[b]; v += __shfl_xor(v, 8); v += __shfl_xor(v, 16); v += __shfl_xor(v, 32); acc[b] = v; }
    if (lane < 8) { float* mod = (float*)(A.ws + WS_MOD); const float bm = A.b_mod[n0 + col];
#pragma unroll
        for (int b = 0; b < 9; ++b) mod[b * NMOD + n0 + col] = acc[b] + bm; }
}
__device__ __forceinline__ void task_transpose(const float* W, int K, int N, bf16_t* WT, int k0, int n0, int row0, LAS float* scr, int lane) {
#pragma unroll 8
    for (int i = 0; i < 32; ++i) { const int kk = 2 * i + (lane >> 5); scr[kk * 33 + (lane & 31)] = W[(size_t)(k0 + kk) * N + n0 + (lane & 31)]; }
    asm volatile("s_waitcnt lgkmcnt(0)" ::: "memory");
    const int c = lane & 7;
#pragma unroll
    for (int j = 0; j < 4; ++j) { const int n = (lane >> 3) + 8 * j; const LAS float* s = scr + (8 * c) * 33 + n;
        u32x4 o; o.x = cvt_pk_bf16(s[0 * 33], s[1 * 33]); o.y = cvt_pk_bf16(s[2 * 33], s[3 * 33]); o.z = cvt_pk_bf16(s[4 * 33], s[5 * 33]); o.w = cvt_pk_bf16(s[6 * 33], s[7 * 33]);
        *(u32x4*)(WT + (size_t)(row0 + n) * K + k0 + 8 * c) = o; }
    asm volatile("s_waitcnt lgkmcnt(0)" ::: "memory");
}
typedef float f32x16v __attribute__((ext_vector_type(16)));
typedef unsigned u32x6 __attribute__((ext_vector_type(6)));
constexpr int ROWB = 768;
__device__ __forceinline__ void task_quant_rows4(const float* src, unsigned char* dst, float* scale_out, int lane) {
    const int g = lane & 31, hh = lane >> 5;
    f32x4 v[2][8];
#pragma unroll
    for (int r = 0; r < 2; ++r)
#pragma unroll
        for (int i = 0; i < 8; ++i) v[r][i] = *(const f32x4*)(src + (size_t)(2 * r + hh) * D + g * 32 + i * 4);
#pragma unroll
    for (int r = 0; r < 2; ++r) {
        float am = 0.f;
#pragma unroll
        for (int i = 0; i < 8; ++i) am = fmaxf(fmaxf(am, fmaxf(fabsf(v[r][i][0]), fabsf(v[r][i][1]))), fmaxf(fabsf(v[r][i][2]), fabsf(v[r][i][3])));
#pragma unroll
        for (int o = 1; o < 32; o <<= 1) am = fmaxf(am, __shfl_xor(am, o));
        const float inv = am > 0.f ? 7.5f / am : 0.f;
        f32x16v a, b;
#pragma unroll
        for (int i = 0; i < 4; ++i)
#pragma unroll
            for (int j = 0; j < 4; ++j) { const int e0 = 4 * i + j;
                a[e0] = v[r][(2 * e0) >> 2][(2 * e0) & 3] * inv; b[e0] = v[r][(2 * e0 + 1) >> 2][(2 * e0 + 1) & 3] * inv; }
        const u32x6 p = __builtin_amdgcn_cvt_scalef32_2xpk16_fp6_f32(a, b, 1.0f);
        unsigned char* rowp = dst + (size_t)(2 * r + hh) * ROWB;
        *(u32x4*)(rowp + g * 16) = (u32x4){p[0], p[1], p[2], p[3]}; *(u32x2*)(rowp + 512 + g * 8) = (u32x2){p[4], p[5]};
        if (g == 0) scale_out[2 * r + hh] = am * (1.f / 7.5f);
    }
}
__device__ __forceinline__ bf16x8 ld8_f32_bf16(const float* p) { const f32x4 a = *(const f32x4*)p, b = *(const f32x4*)(p + 4); u32x4 w = {cvt_pk_bf16(a[0], a[1]), cvt_pk_bf16(a[2], a[3]), cvt_pk_bf16(b[0], b[1]), cvt_pk_bf16(b[2], b[3])}; return *reinterpret_cast<bf16x8*>(&w); }
__device__ __forceinline__ void task_wprime(const Args& A, int id, int lane) {
    const int hp = id >> 7, rem = id & 127, n0 = (rem >> 5) * 32, k0 = (rem & 31) * 32, r32 = lane & 31, hi = lane >> 5;
    f32x16 acc = {};
    const float* ka = A.keys + ((size_t)(hp * 128 + n0 + r32)) * 128 + hi * 8;
    const float* wb = A.wq + (size_t)(k0 + r32) * PW + hp * 128 + hi * 8;
#pragma unroll
    for (int s = 0; s < 8; ++s) acc = __builtin_amdgcn_mfma_f32_32x32x16_bf16(ld8_f32_bf16(ka + s * 16), ld8_f32_bf16(wb + s * 16), acc, 0, 0, 0);
    bf16_t* o = (bf16_t*)(A.ws + WS_WP);
#pragma unroll
    for (int r = 0; r < 16; ++r) { const int n = (r & 3) + 8 * (r >> 2) + 4 * hi; o[(size_t)(hp * 128 + n0 + n) * D + k0 + r32] = (bf16_t)(cvt_pk_bf16(acc[r], 0.f) & 0xffffu); }
}
__device__ __forceinline__ void phase_prologue(const Args& A, LAS unsigned char* lds) {
    const int tid = threadIdx.x, lane = tid & 63, wave = __builtin_amdgcn_readfirstlane(tid >> 6);
    LAS float* sc = (LAS float*)lds;
    for (int i = tid; i < 9 * D; i += 512) { const float v = i < 8 * D ? A.c[i] : A.c_ctx[i - 8 * D]; sc[i] = v / (1.f + __expf(-v)); }
    __syncthreads();
    LAS float* scr = (LAS float*)(lds + 36864 + wave * 8448);
    constexpr int T_MOD = NMOD / 8, T_WIN = (D / 64) * (INW / 32), T_SQ = (D / 64) * (D / 32), T_UV = 2 * NEXP / 4, T_WP = 2048, T_ROPE = 1;
    constexpr int NT = T_MOD + T_WIN + 3 * T_SQ + T_UV + T_WP + T_ROPE;
    const int G = gridDim.x;
    for (int task = wave * G + blockIdx.x; task < NT; task += NWAVES * G) {
        int r = task;
        if (r < T_MOD) { task_mod(A, r, lane, sc); continue; } r -= T_MOD;
        if (r < T_WIN) { const int nblk = INW / 32, kb = r / nblk, nb = r % nblk; task_transpose(A.w_in, D, INW, (bf16_t*)(A.ws + WS_WIN), 64 * kb, 32 * nb, win_row(32 * nb), scr, lane); continue; } r -= T_WIN;
        if (r < 3 * T_SQ) { const int wsel = r / T_SQ, q = r % T_SQ, kb = q / 32, nb = q % 32;
            const float* W = wsel == 0 ? A.w_ao : (wsel == 1 ? A.w_co : A.w_o); bf16_t* WT = (bf16_t*)(A.ws + (wsel == 0 ? WS_WA : (wsel == 1 ? WS_WC : WS_WO)));
            task_transpose(W, D, D, WT, 64 * kb, 32 * nb, 32 * nb, scr, lane); continue; } r -= 3 * T_SQ;
        if (r < T_UV) { const int tb = r / (NEXP / 4), row = (r % (NEXP / 4)) * 4; unsigned char* tbase = A.ws + (tb ? WS_VT : WS_UT);
            task_quant_rows4((tb ? A.vt : A.ut) + (size_t)row * D, tbase + (size_t)row * ROWB, (float*)(tbase + WS_TSCALE) + row, lane); continue; } r -= T_UV;
        if (r < T_WP) { task_wprime(A, r, lane); continue; } r -= T_WP;
        { float* cs = (float*)(A.ws + WS_ROPE); float* sn = cs + 2048;
          for (int e = lane; e < 2048; e += 64) { const int p = e >> 5, i = e & 31; const float inv = powf(10000.f, -(float)(2 * i) / 64.f); const float a = (float)p * inv; cs[e] = cosf(a); sn[e] = sinf(a); } }
    }
}
__device__ __forceinline__ void normmod_row(const float* xr, const float* g, const float* modr, int sh_off, int sc_off, bf16_t* orow, int lane) {
    f32x4 v[4]; float ss = 0.f;
#pragma unroll
    for (int i = 0; i < 4; ++i) { v[i] = *(const f32x4*)(xr + (i * 64 + lane) * 4); ss += (v[i][0] * v[i][0] + v[i][1] * v[i][1]) + (v[i][2] * v[i][2] + v[i][3] * v[i][3]); }
    const float r = rsqrtf(wave_sum(ss) * (1.f / D) + EPS);
#pragma unroll
    for (int i = 0; i < 4; ++i) { const int k = (i * 64 + lane) * 4; const f32x4 gg = *(const f32x4*)(g + k), s1 = *(const f32x4*)(modr + sc_off + k), h1 = *(const f32x4*)(modr + sh_off + k);
        float y[4];
#pragma unroll
        for (int j = 0; j < 4; ++j) y[j] = v[i][j] * r * gg[j] * (1.f + s1[j]) + h1[j];
        u32x2 o = {cvt_pk_bf16(y[0], y[1]), cvt_pk_bf16(y[2], y[3])}; *(u32x2*)(orow + k) = o; }
}
__device__ __forceinline__ void phase_hx(const Args& A) {
    const int lane = threadIdx.x & 63, gw = blockIdx.x * NWAVES + (threadIdx.x >> 6), NGW = gridDim.x * NWAVES;
    const float* mod = (const float*)(A.ws + WS_MOD);
    for (int m = gw; m < M + MC; m += NGW) {
        if (m < M) normmod_row(A.x + (size_t)m * D, A.n1g, mod + (m >> 12) * NMOD, 0, D, (bf16_t*)(A.ws + WS_HX) + (size_t)m * D, lane);
        else { const int r = m - M; normmod_row(A.ctx + (size_t)r * D, A.n1g, mod + 8 * NMOD, 0, D, (bf16_t*)(A.ws + WS_HC) + (size_t)r * D, lane); }
    }
    const bf16_t* WP = (const bf16_t*)(A.ws + WS_WP); float* sb = (float*)(A.ws + WS_SBIAS);
    for (int col = gw; col < PW; col += NGW) {
        const u32x4 w0 = *(const u32x4*)(WP + (size_t)col * D + lane * 16), w1 = *(const u32x4*)(WP + (size_t)col * D + lane * 16 + 8);
        float wv[16];
#pragma unroll
        for (int j = 0; j < 4; ++j) { wv[2 * j] = bf_lo(w0[j]); wv[2 * j + 1] = bf_hi(w0[j]); wv[8 + 2 * j] = bf_lo(w1[j]); wv[8 + 2 * j + 1] = bf_hi(w1[j]); }
#pragma unroll 1
        for (int b = 0; b < NB; ++b) { const float* sh = mod + b * NMOD + 3 * D + lane * 16; float s = 0.f;
#pragma unroll
            for (int q = 0; q < 4; ++q) { const f32x4 v = *(const f32x4*)(sh + 4 * q); s += v[0] * wv[4 * q] + v[1] * wv[4 * q + 1] + v[2] * wv[4 * q + 2] + v[3] * wv[4 * q + 3]; }
            s = wave_sum(s); if (lane == 0) sb[b * PW + col] = s; }
    }
}
__device__ __forceinline__ void phase_kfix(const Args& A) {
    const int lane = threadIdx.x & 63, gw = blockIdx.x * NWAVES + (threadIdx.x >> 6), NGW = gridDim.x * NWAVES, li = lane & 15, sub = lane >> 4;
    const bf16_t* KB = (const bf16_t*)(A.ws + WS_KB); const float* cs = (const float*)(A.ws + WS_ROPE); const float* sn = cs + 2048;
    constexpr int NITEM = NB * SKV * HKV;
    const f32x4 g0 = *(const f32x4*)(A.kng + li * 8), g1 = *(const f32x4*)(A.kng + li * 8 + 4);
    const f32x4 p0 = *(const f32x4*)(A.kng + (li ^ 4) * 8), p1 = *(const f32x4*)(A.kng + (li ^ 4) * 8 + 4);
    for (int it = gw * 4 + sub; it < NITEM; it += NGW * 4) {
        const int row = it >> 1, h = it & 1, t = row % SKV;
        const bf16_t* p = KB + (size_t)row * 256 + h * HD + li * 8;
        const u32x4 w = *(const u32x4*)p;
        float x[8], xp[8]; float ss = 0.f;
#pragma unroll
        for (int j = 0; j < 4; ++j) { x[2 * j] = bf_lo(w[j]); x[2 * j + 1] = bf_hi(w[j]); ss += x[2 * j] * x[2 * j] + x[2 * j + 1] * x[2 * j + 1];
            const unsigned pw = (unsigned)__shfl_xor((int)w[j], 4); xp[2 * j] = bf_lo(pw); xp[2 * j + 1] = bf_hi(pw); }
        ss += __shfl_xor(ss, 1); ss += __shfl_xor(ss, 2); ss += __shfl_xor(ss, 4); ss += __shfl_xor(ss, 8);
        const float r = rsqrtf(ss * (1.f / HD) + EPS);
        float y[8];
#pragma unroll
        for (int j = 0; j < 8; ++j) { x[j] *= r * (j < 4 ? g0[j] : g1[j - 4]); xp[j] *= r * (j < 4 ? p0[j] : p1[j - 4]); y[j] = x[j]; }
        if (t < S) {
            const int blk = li >> 3, pos = blk == 0 ? (t >> 6) : (t & 63), second = (li >> 2) & 1, i0 = (li & 3) * 8;
            const f32x4 c0 = *(const f32x4*)(cs + pos * 32 + i0), c1 = *(const f32x4*)(cs + pos * 32 + i0 + 4), s0 = *(const f32x4*)(sn + pos * 32 + i0), s1 = *(const f32x4*)(sn + pos * 32 + i0 + 4);
#pragma unroll
            for (int j = 0; j < 8; ++j) { const float c = j < 4 ? c0[j] : c1[j - 4], s = j < 4 ? s0[j] : s1[j - 4];
                y[j] = second ? (xp[j] * s + x[j] * c) : (x[j] * c - xp[j] * s); }
        }
        u32x2 o = {(unsigned)att::pk4_fp8(y[0] * 16.f, y[1] * 16.f, y[2] * 16.f, y[3] * 16.f), (unsigned)att::pk4_fp8(y[4] * 16.f, y[5] * 16.f, y[6] * 16.f, y[7] * 16.f)};
        *(u32x2*)(A.ws + WS_K8 + (size_t)row * 256 + h * HD + li * 8) = o;
    }
}
__device__ __forceinline__ void phase_vt(const Args& A, LAS unsigned char* lds) {
    const int lane = threadIdx.x & 63, wave = threadIdx.x >> 6, gw = blockIdx.x * NWAVES + wave, NGW = gridDim.x * NWAVES;
    LAS unsigned char* tl = lds + wave * 4096;
    const bf16_t* VB = (const bf16_t*)(A.ws + WS_VB);
    const int kk = lane & 31, pos = 32 * ((kk >> 2) & 1) + (kk & 3) + 4 * (kk >> 3) + 16 * (lane >> 5);
    constexpr int NTILE = SKV / 64;
    for (int it2 = gw; it2 < NB * HKV * NTILE * 2; it2 += NGW) {
        const int dh = it2 & 1, it = it2 >> 1, j = it % NTILE, bk = it / NTILE, b = bk >> 1, kv = bk & 1;
        const bf16_t* src = VB + ((size_t)b * SKV + j * 64 + lane) * 256 + kv * HD + dh * 64;
        u32x4 w[8];
#pragma unroll
        for (int c = 0; c < 8; ++c) w[c] = *(const u32x4*)(src + c * 8);
#pragma unroll
        for (int c = 0; c < 8; ++c)
#pragma unroll
            for (int q = 0; q < 4; ++q) { const int pk = __builtin_amdgcn_cvt_pk_fp8_f32(bf_lo(w[c][q]) * 16.f, bf_hi(w[c][q]) * 16.f, 0, false);
                tl[(c * 8 + 2 * q) * 64 + pos] = (unsigned char)(pk & 0xff); tl[(c * 8 + 2 * q + 1) * 64 + pos] = (unsigned char)((pk >> 8) & 0xff); }
        asm volatile("s_waitcnt lgkmcnt(0)" ::: "memory");
        unsigned char* dst = A.ws + WS_VT8 + (size_t)it * 8192 + dh * 4096;
#pragma unroll
        for (int i = 0; i < 4; ++i) *(u32x4*)(dst + (i * 64 + lane) * 16) = *(const LAS u32x4*)(tl + (i * 64 + lane) * 16);
        asm volatile("s_waitcnt lgkmcnt(0)" ::: "memory");
    }
}
template <int R> struct ConvRow {
    static __device__ __forceinline__ void run(const unsigned* gp, int tl0, float (&acc)[32][2], const float (&w)[31][2]) {
        const int tl = tl0 + R - 15;
        unsigned v = 0u; if (tl >= 0 && tl < S) v = gp[(long)(R - 15) * (D / 2)];
        const float a = bf_lo(v), b = bf_hi(v);
#pragma unroll
        for (int t = (R - 30 > 0 ? R - 30 : 0); t <= (R < 31 ? R : 31); ++t) { acc[t][0] += w[R - t][0] * a; acc[t][1] += w[R - t][1] * b; }
        if constexpr (R + 1 < 62) ConvRow<R + 1>::run(gp, tl0, acc, w);
    }
};
__device__ __forceinline__ void phase_conv(const Args& A, LAS unsigned char* lds) {
    const int tid = threadIdx.x, lane = tid & 63, wave = tid >> 6;
    LAS float* tile = (LAS float*)lds;
    const bf16_t* G = (const bf16_t*)(A.ws + WS_G); bf16_t* CV = (bf16_t*)(A.ws + WS_HX);
    float w[31][2];
#pragma unroll
    for (int j = 0; j < 31; ++j) { const f32x2 t = *(const f32x2*)(A.cdw + j * D + 2 * tid); w[j][0] = t[0]; w[j][1] = t[1]; }
    const f32x2 bias = *(const f32x2*)(A.cb + 2 * tid);
    for (int tileid = blockIdx.x; tileid < M / 32; tileid += gridDim.x) {
        const int row0 = tileid * 32, tl0 = row0 & (S - 1);
        float acc[32][2];
#pragma unroll
        for (int t = 0; t < 32; ++t) { acc[t][0] = bias[0]; acc[t][1] = bias[1]; }
        ConvRow<0>::run((const unsigned*)(G + (size_t)row0 * D) + tid, tl0, acc, w);
        __syncthreads();
#pragma unroll
        for (int t = 0; t < 32; ++t) *(LAS f32x2*)(tile + t * D + 2 * tid) = (f32x2){acc[t][0], acc[t][1]};
        __syncthreads();
#pragma unroll
        for (int q = 0; q < 4; ++q) { const int t = wave * 4 + q; const LAS float* tr = tile + t * D;
            f32x4 v[4]; float s = 0.f;
#pragma unroll
            for (int i = 0; i < 4; ++i) { v[i] = *(const LAS f32x4*)(tr + (i * 64 + lane) * 4); s += (v[i][0] + v[i][1]) + (v[i][2] + v[i][3]); }
            const float mu = wave_sum(s) * (1.f / D); float qq = 0.f;
#pragma unroll
            for (int i = 0; i < 4; ++i) { v[i] = v[i] - mu; qq += (v[i][0] * v[i][0] + v[i][1] * v[i][1]) + (v[i][2] * v[i][2] + v[i][3] * v[i][3]); }
            const float rs = rsqrtf(wave_sum(qq) * (1.f / D) + EPS);
#pragma unroll
            for (int i = 0; i < 4; ++i) { const int k = (i * 64 + lane) * 4; const f32x4 gg = *(const f32x4*)(A.clg + k), bb = *(const f32x4*)(A.clb + k); float y[4];
#pragma unroll
                for (int j = 0; j < 4; ++j) { const float z = v[i][j] * rs * gg[j] + bb[j]; y[j] = z * fast_sigmoid(z); }
                u32x2 o = {cvt_pk_bf16(y[0], y[1]), cvt_pk_bf16(y[2], y[3])}; *(u32x2*)(CV + (size_t)(row0 + t) * D + k) = o; }
        }
    }
}
struct EpiInProj {
    static constexpr bool PERM = true;
    unsigned char* ws;
    __device__ __forceinline__ void operator()(f32x4 (&acc)[2][2][4][2], const pg8::Unit& u, int wr, int wc, int fr, int fq) const {
        const int c8 = wc * 32 + 8 * fq;
#pragma unroll
        for (int ai = 0; ai < 2; ++ai)
#pragma unroll
            for (int m = 0; m < 4; ++m) {
                const int row = u.pm * 256 + ai * 128 + wr * 64 + m * 16 + fr;
                if (u.kind == 0) {
                    bf16_t* p = (bf16_t*)(ws + WS_Q) + (size_t)row * D + u.pn * 256 + c8;
#pragma unroll
                    for (int bj = 0; bj < 2; ++bj) { const f32x4 v0 = acc[ai][bj][m][0], v1 = acc[ai][bj][m][1];
                        u32x4 w = {cvt_pk_bf16(v0[0], v0[1]), cvt_pk_bf16(v0[2], v0[3]), cvt_pk_bf16(v1[0], v1[1]), cvt_pk_bf16(v1[2], v1[3])}; *(u32x4*)(p + bj * 128) = w; }
                } else if (u.kind == 1 || u.kind == 2 || u.kind == 5 || u.kind == 6) {
                    const bool ctxu = u.kind >= 5;
                    const int kvrow = ctxu ? (row >> 8) * SKV + S + (row & 255) : (row >> 12) * SKV + (row & (S - 1));
                    bf16_t* p = (bf16_t*)(ws + ((u.kind == 1 || u.kind == 5) ? WS_KB : WS_VB)) + (size_t)kvrow * 256 + c8;
#pragma unroll
                    for (int bj = 0; bj < 2; ++bj) { const f32x4 v0 = acc[ai][bj][m][0], v1 = acc[ai][bj][m][1];
                        u32x4 w = {cvt_pk_bf16(v0[0], v0[1]), cvt_pk_bf16(v0[2], v0[3]), cvt_pk_bf16(v1[0], v1[1]), cvt_pk_bf16(v1[2], v1[3])}; *(u32x4*)(p + bj * 128) = w; }
                } else if (u.kind == 3) {
                    float g[8];
#pragma unroll
                    for (int n = 0; n < 2; ++n)
#pragma unroll
                        for (int j = 0; j < 4; ++j) g[4 * n + j] = acc[ai][0][m][n][j] * fast_sigmoid(acc[ai][1][m][n][j]);
                    u32x4 w = {cvt_pk_bf16(g[0], g[1]), cvt_pk_bf16(g[2], g[3]), cvt_pk_bf16(g[4], g[5]), cvt_pk_bf16(g[6], g[7])};
                    *(u32x4*)((bf16_t*)(ws + WS_G) + (size_t)row * D + (u.pn - 6) * 128 + c8) = w;
                } else {
                    float rt[8], sg[8];
#pragma unroll
                    for (int n = 0; n < 2; ++n)
#pragma unroll
                        for (int j = 0; j < 4; ++j) { const float ea = __builtin_amdgcn_exp2f(-1.4426950408889634f * acc[ai][0][m][n][j]), ec = __builtin_amdgcn_exp2f(-1.4426950408889634f * acc[ai][1][m][n][j]);
                            sg[4 * n + j] = __builtin_amdgcn_rcpf(1.f + ec); rt[4 * n + j] = (1.f + ec) * __builtin_amdgcn_rcpf(1.f + ea); }
                    const size_t off = (size_t)row * D + (u.pn - 14) * 128 + c8;
                    u32x4 w = {cvt_pk_bf16(rt[0], rt[1]), cvt_pk_bf16(rt[2], rt[3]), cvt_pk_bf16(rt[4], rt[5]), cvt_pk_bf16(rt[6], rt[7])}; *(u32x4*)((bf16_t*)(ws + WS_RT) + off) = w;
                    u32x4 w2 = {cvt_pk_bf16(sg[0], sg[1]), cvt_pk_bf16(sg[2], sg[3]), cvt_pk_bf16(sg[4], sg[5]), cvt_pk_bf16(sg[6], sg[7])}; *(u32x4*)((bf16_t*)(ws + WS_SGC) + off) = w2;
                }
            }
    }
};
struct SchedInProj {
    const char* hx; const char* hc; const char* w; int G, c;
    __device__ __forceinline__ bool next(int i, pg8::Unit& u) const {
        constexpr int nM = M / 256, nN = INW / 256, NMAIN = nM * nN, NCTX = (MC / 256) * 2;
        const int L = i * G + c; if (L >= NMAIN + NCTX) return false;
        if (L < NMAIN) { pg8::tile_of(L, nM, nN, u.pm, u.pn); u.a = hx + (size_t)u.pm * 256 * D * 2; u.kind = u.pn < 4 ? 0 : (u.pn == 4 ? 1 : (u.pn == 5 ? 2 : (u.pn < 14 ? 3 : 4))); }
        else { const int j = L - NMAIN; u.pm = j >> 1; u.pn = 4 + (j & 1); u.a = hc + (size_t)u.pm * 256 * D * 2; u.kind = 5 + (j & 1); }
        u.b = w + (size_t)u.pn * 256 * D * 2; u.keep = 0; return true;
    }
};
struct EpiMerge {
    static constexpr bool PERM = true;
    unsigned char* ws;
    __device__ __forceinline__ void operator()(f32x4 (&acc)[2][2][4][2], const pg8::Unit& u, int wr, int wc, int fr, int fq) const {
        const int c8 = u.pn * 256 + wc * 32 + 8 * fq;
        const bf16_t* __restrict__ F = (const bf16_t*)(ws + (u.kind == 0 ? WS_RT : WS_SGC));
#pragma unroll
        for (int ai = 0; ai < 2; ++ai)
#pragma unroll
            for (int m = 0; m < 4; ++m) { const size_t off = (size_t)(u.pm * 256 + ai * 128 + wr * 64 + m * 16 + fr) * D + c8;
#pragma unroll
                for (int bj = 0; bj < 2; ++bj) { const u32x4 f = *(const u32x4*)(F + off + bj * 128);
                    f32x4 v0 = acc[ai][bj][m][0], v1 = acc[ai][bj][m][1];
                    v0[0] *= bf_lo(f[0]); v0[1] *= bf_hi(f[0]); v0[2] *= bf_lo(f[1]); v0[3] *= bf_hi(f[1]); v1[0] *= bf_lo(f[2]); v1[1] *= bf_hi(f[2]); v1[2] *= bf_lo(f[3]); v1[3] *= bf_hi(f[3]);
                    if (u.kind == 0) { acc[ai][bj][m][0] = v0; acc[ai][bj][m][1] = v1; }
                    else { u32x4 w = {cvt_pk_bf16(v0[0], v0[1]), cvt_pk_bf16(v0[2], v0[3]), cvt_pk_bf16(v1[0], v1[1]), cvt_pk_bf16(v1[2], v1[3])}; *(u32x4*)((bf16_t*)(ws + WS_G) + off + bj * 128) = w; } } }
    }
};
struct SchedMerge {
    const char* att; const char* cv; const char* wa; const char* wc; int G, c;
    __device__ __forceinline__ bool next(int i, pg8::Unit& u) const {
        constexpr int nM = M / 256, nN = D / 256;
        const int L = (i >> 1) * G + c, sub = i & 1; if (L >= nM * nN) return false;
        pg8::tile_of(L, nM, nN, u.pm, u.pn);
        u.a = (sub ? cv : att) + (size_t)u.pm * 256 * D * 2; u.b = (sub ? wc : wa) + (size_t)u.pn * 256 * D * 2; u.kind = sub; u.keep = sub ^ 1; return true;
    }
};
struct SchedPlain {
    const char* a; const char* b; int nM, nN, G, c;
    __device__ __forceinline__ bool next(int i, pg8::Unit& u) const {
        const int L = i * G + c; if (L >= nM * nN) return false;
        pg8::tile_of(L, nM, nN, u.pm, u.pn); u.a = a + (size_t)u.pm * 256 * D * 2; u.b = b + (size_t)u.pn * 256 * D * 2; u.kind = 0; u.keep = 0; return true;
    }
};
struct EpiOut {
    static constexpr bool PERM = false;
    const float* __restrict__ x; const float* __restrict__ mod; const float* __restrict__ n2g; float* __restrict__ xs; bf16_t* __restrict__ xg; float* __restrict__ ssq;
    __device__ __forceinline__ void operator()(f32x4 (&acc)[2][2][4][2], const pg8::Unit& u, int wr, int wc, int fr, int fq) const {
        const int col0 = u.pn * 256 + wc * 32 + 4 * fq; const float* mb = mod + ((u.pm * 256) >> 12) * NMOD;
        f32x4 gv[2][2], nv[2][2];
#pragma unroll
        for (int bj = 0; bj < 2; ++bj)
#pragma unroll
            for (int n = 0; n < 2; ++n) { const int c = col0 + bj * 128 + n * 16; gv[bj][n] = *(const f32x4*)(mb + 2 * D + c); nv[bj][n] = *(const f32x4*)(n2g + c) * (*(const f32x4*)(mb + 4 * D + c) + 1.f); }
        f32x4 xa[2][2], xb[2][2];
#define XLOAD(dst, k) do { _Pragma("unroll") for (int bj = 0; bj < 2; ++bj) _Pragma("unroll") for (int n = 0; n < 2; ++n) \
            dst[bj][n] = *(const f32x4*)(x + (size_t)(u.pm * 256 + ((k) >> 2) * 128 + wr * 64 + ((k) & 3) * 16 + fr) * D + col0 + bj * 128 + n * 16); } while (0)
#define XDONE(src, k) do { const int ai = (k) >> 2, m = (k) & 3; const int row = u.pm * 256 + ai * 128 + wr * 64 + m * 16 + fr; const size_t off = (size_t)row * D + col0; float ss = 0.f; \
            _Pragma("unroll") for (int bj = 0; bj < 2; ++bj) _Pragma("unroll") for (int n = 0; n < 2; ++n) { const f32x4 v = src[bj][n] + gv[bj][n] * acc[ai][bj][m][n]; *(f32x4*)(xs + off + bj * 128 + n * 16) = v; \
                ss += (v[0] * v[0] + v[1] * v[1]) + (v[2] * v[2] + v[3] * v[3]); const f32x4 g = v * nv[bj][n]; \
                u32x2 w = {cvt_pk_bf16(g[0], g[1]), cvt_pk_bf16(g[2], g[3])}; *(u32x2*)(xg + off + bj * 128 + n * 16) = w; } \
            ss += __shfl_xor(ss, 16); ss += __shfl_xor(ss, 32); if (fq == 0) ssq[(size_t)row * 16 + u.pn * 4 + wc] = ss; } while (0)
        XLOAD(xa, 0); XLOAD(xb, 1); XDONE(xa, 0); XLOAD(xa, 2); XDONE(xb, 1); XLOAD(xb, 3); XDONE(xa, 2); XLOAD(xa, 4); XDONE(xb, 3); XLOAD(xb, 5); XDONE(xa, 4); XLOAD(xa, 6); XDONE(xb, 5); XLOAD(xb, 7); XDONE(xa, 6); XDONE(xb, 7);
#undef XLOAD
#undef XDONE
    }
};
__device__ __forceinline__ float row_rstd(const float* ssq, int row) {
    const f32x4 a = *(const f32x4*)(ssq + (size_t)row * 16), b = *(const f32x4*)(ssq + (size_t)row * 16 + 4), c = *(const f32x4*)(ssq + (size_t)row * 16 + 8), d = *(const f32x4*)(ssq + (size_t)row * 16 + 12);
    const float s = ((a[0] + a[1]) + (a[2] + a[3])) + ((b[0] + b[1]) + (b[2] + b[3])) + ((c[0] + c[1]) + (c[2] + c[3])) + ((d[0] + d[1]) + (d[2] + d[3]));
    return rsqrtf(s * (1.f / D) + EPS);
}
struct EpiScores {
    static constexpr bool PERM = false;
    float* sc; const float* ssq; const float* sbias;
    __device__ __forceinline__ void operator()(f32x4 (&acc)[2][2][4][2], const pg8::Unit& u, int wr, int wc, int fr, int fq) const {
        const float* sb = sbias + ((u.pm * 256) >> 12) * PW + u.pn * 256 + wc * 32 + 4 * fq;
        f32x4 bv[2][2];
#pragma unroll
        for (int bj = 0; bj < 2; ++bj)
#pragma unroll
            for (int n = 0; n < 2; ++n) bv[bj][n] = *(const f32x4*)(sb + bj * 128 + n * 16);
#pragma unroll
        for (int ai = 0; ai < 2; ++ai)
#pragma unroll
            for (int m = 0; m < 4; ++m) { const int row = u.pm * 256 + ai * 128 + wr * 64 + m * 16 + fr; float* p = sc + (size_t)(row >> 2) * 8192 + (row & 3) * 4; const float rs = row_rstd(ssq, row);
#pragma unroll
                for (int bj = 0; bj < 2; ++bj)
#pragma unroll
                    for (int n = 0; n < 2; ++n) { const int grp = u.pn * 2 + bj, nq = wc * 8 + n * 4 + fq; *(f32x4*)(p + (grp * 32 + nq) * 16) = acc[ai][bj][m][n] * rs + bv[bj][n]; } }
    }
};

#ifndef PROBE_HALFKEYS
#define PROBE_HALFKEYS 0
#endif
__device__ __forceinline__ void phase_attn(const Args& A, unsigned char* lds) {
    const int G = gridDim.x, X = blockIdx.x & 7, j = blockIdx.x >> 3, perx = G >> 3;
    bf16_t* Q = (bf16_t*)(A.ws + WS_Q); const unsigned char* K8 = A.ws + WS_K8; const unsigned char* VT8 = A.ws + WS_VT8;
    const float* cs = (const float*)(A.ws + WS_ROPE); const float* sn = cs + 2048;
    for (int idx = j; idx < 128; idx += perx) {
        const int grp = 2 * X + (idx >> 6), uu = idx & 63, b = grp >> 1, kv = grp & 1, h = kv * 4 + (uu >> 4), qb = uu & 15;
        bf16_t* qp = Q + ((size_t)b * S + qb * 256) * D + h * HD;
        bf16_t* op = A.dry ? (bf16_t*)(A.ws + WS_G) + ((size_t)b * S + qb * 256) * D + h * HD : qp;
        att::attn_unit(qp, K8 + (size_t)b * SKV * 256 + kv * HD, VT8 + (size_t)grp * (SKV / 64) * 8192, op, qb * 256, (A.dry && PROBE_HALFKEYS) ? SKV / 2 : SKV, A.qng, cs, sn, (char*)lds);
    }
}

__device__ __forceinline__ float gelu_exact(float v) {
    const float av = fabsf(v), t = __builtin_amdgcn_rcpf(av * 0.2316418882f + 1.0f);
    float q = t * 0.5307027145f + (-0.7265760135f); q = q * t + 0.7107068705f; q = q * t + (-0.142248368f); q = q * t + 0.127414796f; q = q * t;
    const float e = __builtin_amdgcn_exp2f((v * v) * (-0.72134752044f));
    const float m = v * (q * e);
    return v < 0.f ? m : v - m;
}
__device__ __forceinline__ void ins16(float (&t)[16], float v) {
#pragma unroll
    for (int i = 15; i >= 1; --i) t[i] = __builtin_amdgcn_fmed3f(t[i - 1], t[i], v);
    t[0] = fmaxf(t[0], v);
}
typedef float f32x32v __attribute__((ext_vector_type(32)));
typedef _Float16 f16x32v __attribute__((ext_vector_type(32)));
typedef _Float16 f16x2v __attribute__((ext_vector_type(2)));

__device__ __forceinline__ float key_tag(float v, unsigned keepmask, unsigned tag) { return __uint_as_float((__float_as_uint(v) & keepmask) | tag); }
template <int I, int J> struct CandLoop {
    static __device__ __forceinline__ void run(const float (&a)[16], const float (&b)[16], float (&c)[16]) {
        if constexpr ((I + 1) * (J + 1) <= 16) { ins16(c, key_tag(a[I] + b[J], ~255u, 255u - (unsigned)(I * 16 + J))); CandLoop<I, J + 1>::run(a, b, c); }
        else if constexpr (I + 1 < 16) CandLoop<I + 1, 0>::run(a, b, c);
    }
};
__device__ __forceinline__ void phase_peer_u(const Args& A, LAS unsigned char* lds) {
    const int lane = threadIdx.x & 63, wave = threadIdx.x >> 6, gw = blockIdx.x * NWAVES + wave, NGW = gridDim.x * NWAVES;
    LAS unsigned char* wl = lds + wave * 10240;
    LAS float* topL = (LAS float*)wl; LAS int* eidA = (LAS int*)(wl + 4096); LAS float* wgtA = (LAS float*)(wl + 6144); LAS float* coefL = (LAS float*)(wl + 8192);
    LAS float* suL = (LAS float*)(wl + 8704); LAS float* svL = (LAS float*)(wl + 9216);
    const float* SC = (const float*)(A.ws + WS_SC); const bf16_t* HX = (const bf16_t*)(A.ws + WS_HX);
    const unsigned char* UT = A.ws + WS_UT; const float* SU = (const float*)(A.ws + WS_UT + WS_TSCALE); const float* SVs = (const float*)(A.ws + WS_VT + WS_TSCALE);
    const float* mod = (const float*)(A.ws + WS_MOD);
    int* PE = (int*)(A.ws + WS_PE); float* PC = (float*)(A.ws + WS_PC);
    const float NEG = -3.0e38f;
    const int h = lane >> 3, tk = (lane >> 1) & 3, p = lane & 1, grp = 2 * h + p;
    for (int pass = gw; pass < M / 4; pass += NGW) {
        {
            float t[16];
#pragma unroll
            for (int i = 0; i < 16; ++i) t[i] = NEG;
            const float* sp = SC + (size_t)pass * 8192 + (grp * 128 + tk) * 4;
            f32x4 sv[32];
#pragma unroll
            for (int i = 0; i < 32; ++i) sv[i] = *(const f32x4*)(sp + i * 16);
#pragma unroll
            for (int i = 0; i < 32; ++i) { const unsigned tg = 127u - 4u * (unsigned)i;
                ins16(t, key_tag(sv[i][0], ~127u, tg)); ins16(t, key_tag(sv[i][1], ~127u, tg - 1u)); ins16(t, key_tag(sv[i][2], ~127u, tg - 2u)); ins16(t, key_tag(sv[i][3], ~127u, tg - 3u)); }
            float pb[16];
#pragma unroll
            for (int i = 0; i < 16; ++i) { pb[i] = __shfl_xor(t[i], 1); topL[i * 64 + lane] = t[i]; }
            float c[16];
#pragma unroll
            for (int i = 0; i < 16; ++i) c[i] = NEG;
            CandLoop<0, 0>::run(t, pb, c);
            float e[16]; float es = 0.f;
#pragma unroll
            for (int k = 0; k < 16; ++k) { e[k] = __expf(c[k] - c[0]); es += e[k]; }
            const float inv = __builtin_amdgcn_rcpf(es);
            asm volatile("s_waitcnt lgkmcnt(0)" ::: "memory");
            if (p == 0) {
#pragma unroll
                for (int k = 0; k < 16; ++k) { const unsigned code = 255u - (__float_as_uint(c[k]) & 255u);
                    const unsigned ia = 127u - (__float_as_uint(topL[(code >> 4) * 64 + lane]) & 127u), ib = 127u - (__float_as_uint(topL[(code & 15u) * 64 + lane + 1]) & 127u);
                    eidA[tk * 128 + h * 16 + k] = (int)(ia * 128u + ib); wgtA[tk * 128 + h * 16 + k] = e[k] * inv; }
            }
            asm volatile("s_waitcnt lgkmcnt(0)" ::: "memory");
        }
#pragma unroll 1
        for (int tq = 0; tq < 4; ++tq) {
            const int t = pass * 4 + tq; const LAS int* eidL = eidA + tq * 128; const LAS float* wgtL = wgtA + tq * 128;
            const int g = lane & 31, hh = lane >> 5;
            f16x2v xh[16];
            { const float rs = row_rstd((const float*)(A.ws + WS_SSQ), t); const float* sh = mod + (t >> 12) * NMOD + 3 * D + g * 32; const bf16_t* xp = HX + (size_t)t * D + g * 32;
#pragma unroll
              for (int c = 0; c < 4; ++c) { const u32x4 w = *(const u32x4*)(xp + 8 * c); const f32x4 s0 = *(const f32x4*)(sh + 8 * c), s1 = *(const f32x4*)(sh + 8 * c + 4);
                xh[4 * c] = (f16x2v){(_Float16)(bf_lo(w[0]) * rs + s0[0]), (_Float16)(bf_hi(w[0]) * rs + s0[1])}; xh[4 * c + 1] = (f16x2v){(_Float16)(bf_lo(w[1]) * rs + s0[2]), (_Float16)(bf_hi(w[1]) * rs + s0[3])};
                xh[4 * c + 2] = (f16x2v){(_Float16)(bf_lo(w[2]) * rs + s1[0]), (_Float16)(bf_hi(w[2]) * rs + s1[1])}; xh[4 * c + 3] = (f16x2v){(_Float16)(bf_lo(w[3]) * rs + s1[2]), (_Float16)(bf_hi(w[3]) * rs + s1[3])}; } }
            { const int i0 = eidL[lane], i1 = eidL[64 + lane]; suL[lane] = SU[i0]; suL[64 + lane] = SU[i1]; svL[lane] = SVs[i0]; svL[64 + lane] = SVs[i1]; }
            u32x6 rb0[4], rb1[4], rb2[4], rb3[4];
#define LOAD8(buf, TB, hb) do { _Pragma("unroll") for (int r = 0; r < 4; ++r) { const int id = eidL[(hb) * 8 + 2 * r + hh]; const unsigned char* rp = (TB) + (size_t)id * ROWB; \
                const u32x4 lo = *(const u32x4*)(rp + g * 16); const u32x2 hi2 = *(const u32x2*)(rp + 512 + g * 8); buf[r] = (u32x6){lo[0], lo[1], lo[2], lo[3], hi2[0], hi2[1]}; } } while (0)
#define DOT8(buf, off) do { _Pragma("unroll") for (int r = 0; r < 4; ++r) { const f16x32v dq = __builtin_amdgcn_cvt_scalef32_pk32_f16_fp6(buf[r], 1.0f); \
                float sa = 0.f, sb = 0.f, sc = 0.f, sd = 0.f;     \
                _Pragma("unroll") for (int j = 0; j < 16; j += 4) { sa = __builtin_amdgcn_fdot2((f16x2v){dq[2 * j], dq[2 * j + 1]}, xh[j], sa, false); sb = __builtin_amdgcn_fdot2((f16x2v){dq[2 * j + 2], dq[2 * j + 3]}, xh[j + 1], sb, false); \
                    sc = __builtin_amdgcn_fdot2((f16x2v){dq[2 * j + 4], dq[2 * j + 5]}, xh[j + 2], sc, false); sd = __builtin_amdgcn_fdot2((f16x2v){dq[2 * j + 6], dq[2 * j + 7]}, xh[j + 3], sd, false); } \
                pp[(off) + r] = (sa + sb) + (sc + sd); } } while (0)
#define REDUCE16(kb) do { \
            _Pragma("unroll") for (int e = 0; e < 4; ++e) { const bool up = lane & 16; const float keep = up ? pp[e + 4] : pp[e], send = up ? pp[e] : pp[e + 4]; pp[e] = keep + __shfl_xor(send, 16); } \
            _Pragma("unroll") for (int e = 0; e < 2; ++e) { const bool up = lane & 8; const float keep = up ? pp[e + 2] : pp[e], send = up ? pp[e] : pp[e + 2]; pp[e] = keep + __shfl_xor(send, 8); } \
            { const bool up = lane & 4; const float keep = up ? pp[1] : pp[0], send = up ? pp[0] : pp[1]; pp[0] = keep + __shfl_xor(send, 4); } \
            float hsum = pp[0]; hsum += __shfl_xor(hsum, 2); hsum += __shfl_xor(hsum, 1); \
            const int ke = (kb) * 16 + 2 * ((lane >> 2) & 7) + hh; const float su = suL[ke], sv = svL[ke]; \
            const float cf = wgtL[ke] * gelu_exact(hsum * su) * sv; if ((lane & 3) == 0) coefL[ke] = cf; } while (0)
            float pp[8];
            LOAD8(rb0, UT, 0); LOAD8(rb1, UT, 1); LOAD8(rb2, UT, 2);
            LOAD8(rb3, UT, 3); DOT8(rb0, 0);
            LOAD8(rb0, UT, 4); DOT8(rb1, 4); REDUCE16(0);
            LOAD8(rb1, UT, 5); DOT8(rb2, 0);
            LOAD8(rb2, UT, 6); DOT8(rb3, 4); REDUCE16(1);
            LOAD8(rb3, UT, 7); DOT8(rb0, 0);
            LOAD8(rb0, UT, 8); DOT8(rb1, 4); REDUCE16(2);
            LOAD8(rb1, UT, 9); DOT8(rb2, 0);
            LOAD8(rb2, UT, 10); DOT8(rb3, 4); REDUCE16(3);
            LOAD8(rb3, UT, 11); DOT8(rb0, 0);
            LOAD8(rb0, UT, 12); DOT8(rb1, 4); REDUCE16(4);
            LOAD8(rb1, UT, 13); DOT8(rb2, 0);
            LOAD8(rb2, UT, 14); DOT8(rb3, 4); REDUCE16(5);
            LOAD8(rb3, UT, 15); DOT8(rb0, 0);
            DOT8(rb1, 4); REDUCE16(6);
            DOT8(rb2, 0);
            DOT8(rb3, 4); REDUCE16(7);
#undef LOAD8
#undef DOT8
#undef REDUCE16
            asm volatile("s_waitcnt lgkmcnt(0)" ::: "memory");
            PE[(size_t)t * 128 + lane] = eidL[lane]; PE[(size_t)t * 128 + 64 + lane] = eidL[64 + lane];
            PC[(size_t)t * 128 + lane] = coefL[lane]; PC[(size_t)t * 128 + 64 + lane] = coefL[64 + lane];
        }
    }
}
__device__ __forceinline__ void phase_peer_v(const Args& A, LAS unsigned char* lds) {
    const int lane = threadIdx.x & 63, wave = threadIdx.x >> 6, gw = blockIdx.x * NWAVES + wave, NGW = gridDim.x * NWAVES;
    LAS int* eidL = (LAS int*)(lds + wave * 1024); LAS float* coefL = (LAS float*)(lds + wave * 1024 + 512);
    const unsigned char* VT = A.ws + WS_VT; const float* mod = (const float*)(A.ws + WS_MOD);
    const int* PE = (const int*)(A.ws + WS_PE); const float* PC = (const float*)(A.ws + WS_PC);
    const int g = lane & 31, hh = lane >> 5;
    int pe0 = 0, pe1 = 0; float pc0 = 0.f, pc1 = 0.f;
    if (gw < M) { pe0 = PE[(size_t)gw * 128 + lane]; pe1 = PE[(size_t)gw * 128 + 64 + lane]; pc0 = PC[(size_t)gw * 128 + lane]; pc1 = PC[(size_t)gw * 128 + 64 + lane]; }
    for (int t = gw; t < M; t += NGW) {
        eidL[lane] = pe0; eidL[64 + lane] = pe1; coefL[lane] = pc0; coefL[64 + lane] = pc1;
        asm volatile("s_waitcnt lgkmcnt(0)" ::: "memory");
        { const int tn = t + NGW < M ? t + NGW : t; pe0 = PE[(size_t)tn * 128 + lane]; pe1 = PE[(size_t)tn * 128 + 64 + lane]; pc0 = PC[(size_t)tn * 128 + lane]; pc1 = PC[(size_t)tn * 128 + 64 + lane]; }
        f32x4 xsv[4];
        { const float* orow_ = A.out + (size_t)t * D;
#pragma unroll
          for (int q = 0; q < 4; ++q) xsv[q] = *(const f32x4*)(orow_ + g * 32 + hh * 16 + q * 4); }
        u32x6 rb0[4], rb1[4], rb2[4], rb3[4];
#define LOAD8(buf, hb) do { _Pragma("unroll") for (int r = 0; r < 4; ++r) { const int id = eidL[(hb) * 8 + 2 * r + hh]; const unsigned char* rp = VT + (size_t)id * ROWB; \
            const u32x4 lo = *(const u32x4*)(rp + g * 16); const u32x2 hi2 = *(const u32x2*)(rp + 512 + g * 8); buf[r] = (u32x6){lo[0], lo[1], lo[2], lo[3], hi2[0], hi2[1]}; } } while (0)
#define VACC8(buf, hb) do { _Pragma("unroll") for (int r = 0; r < 4; ++r) { const _Float16 ch = (_Float16)coefL[(hb) * 8 + 2 * r + hh]; const f16x2v cf2 = {ch, ch}; \
            const f16x32v dq = __builtin_amdgcn_cvt_scalef32_pk32_f16_fp6(buf[r], 1.0f); \
            _Pragma("unroll") for (int j = 0; j < 16; ++j) yh[j] = cf2 * (f16x2v){dq[2 * j], dq[2 * j + 1]} + yh[j]; } } while (0)
        f16x2v yh[16];
#pragma unroll
        for (int j = 0; j < 16; ++j) yh[j] = (f16x2v){(_Float16)0.f, (_Float16)0.f};
        LOAD8(rb0, 0); LOAD8(rb1, 1); LOAD8(rb2, 2);
        LOAD8(rb3, 3); VACC8(rb0, 0);
        LOAD8(rb0, 4); VACC8(rb1, 1);
        LOAD8(rb1, 5); VACC8(rb2, 2);
        LOAD8(rb2, 6); VACC8(rb3, 3);
        LOAD8(rb3, 7); VACC8(rb0, 4);
        LOAD8(rb0, 8); VACC8(rb1, 5);
        LOAD8(rb1, 9); VACC8(rb2, 6);
        LOAD8(rb2, 10); VACC8(rb3, 7);
        LOAD8(rb3, 11); VACC8(rb0, 8);
        LOAD8(rb0, 12); VACC8(rb1, 9);
        LOAD8(rb1, 13); VACC8(rb2, 10);
        LOAD8(rb2, 14); VACC8(rb3, 11);
        LOAD8(rb3, 15); VACC8(rb0, 12);
        VACC8(rb1, 13);
        VACC8(rb2, 14);
        VACC8(rb3, 15);
#undef LOAD8
#undef VACC8
        float yy[16];
#pragma unroll
        for (int j = 0; j < 16; ++j) { const float y0 = (float)yh[j][0], y1 = (float)yh[j][1]; const float a = y0 + __shfl_xor(y0, 32), b = y1 + __shfl_xor(y1, 32); if ((j >> 3) == hh) { yy[2 * (j & 7)] = a; yy[2 * (j & 7) + 1] = b; } }
        const float* g2 = mod + (t >> 12) * NMOD + 5 * D; float* orow = A.out + (size_t)t * D;
        float z[16]; float ss = 0.f;
#pragma unroll
        for (int q = 0; q < 4; ++q) { const int k = g * 32 + hh * 16 + q * 4; const f32x4 xv = xsv[q], gv = *(const f32x4*)(g2 + k);
#pragma unroll
            for (int j = 0; j < 4; ++j) { const float zz = xv[j] + gv[j] * yy[q * 4 + j]; z[q * 4 + j] = zz; ss += zz * zz; } }
        const float r = rsqrtf(wave_sum(ss) * (1.f / D) + EPS);
#pragma unroll
        for (int q = 0; q < 4; ++q) { const int k = g * 32 + hh * 16 + q * 4; const f32x4 fv = *(const f32x4*)(A.fg + k);
            f32x4 o;
#pragma unroll
            for (int j = 0; j < 4; ++j) o[j] = z[q * 4 + j] * r * fv[j];
            if (!A.dry || r < 0.f) *(f32x4*)(orow + k) = o; }
    }
}
#define XB_TMO      128
#define XB_XCNT(j)  (256  + 64 * (j))
#define XB_XSUB(j)  (1280 + 64 * (j))
#define XB_XGEN(j)  (2304 + 64 * (j))
#define XB_TOP      3328
#define XB_TOPGEN   3392
#define XCD_BAR_WORDS 3456
#define XB_SPIN_CAP (1u << 22)
__device__ __forceinline__ unsigned xb_ld(unsigned* p)              { return __hip_atomic_load(p, __ATOMIC_RELAXED, __HIP_MEMORY_SCOPE_AGENT); }
__device__ __forceinline__ unsigned xb_add(unsigned* p, unsigned v) { return __hip_atomic_fetch_add(p, v, __ATOMIC_RELAXED, __HIP_MEMORY_SCOPE_AGENT); }
__device__ __forceinline__ unsigned xb_xcc_id() { return (unsigned)__builtin_amdgcn_s_getreg((3 << 11) | 20) & 0xFu; }
#define XB_SPIN(cond, bar) do { unsigned _sp = 0; while (cond) { __builtin_amdgcn_s_sleep(1); \
    if ((++_sp & 255u) == 0u) { if (xb_ld(&(bar)[XB_TMO])) break; if (_sp > XB_SPIN_CAP) { atomicAdd(&(bar)[XB_TMO], 1u); break; } } } } while (0)
struct XcdBarrier { unsigned* bar; unsigned x; volatile LAS unsigned* st; };
__device__ __forceinline__ XcdBarrier xcd_barrier_post(unsigned* bar, volatile LAS unsigned* st) {
    XcdBarrier b; b.bar = bar; b.x = xb_xcc_id(); b.st = st;
    if (threadIdx.x == 0) (void)xb_add(&bar[XB_XCNT(b.x)], 1u);
    return b;
}
__device__ __forceinline__ void xcd_barrier_complete(unsigned* bar, unsigned x, unsigned& nloc, unsigned& nx) {
    const unsigned G = gridDim.x * gridDim.y * gridDim.z;
    unsigned sum, cnt, mine, sp = 0u;
    for (;;) {
        sum = 0u; cnt = 0u; mine = 0u;
#pragma unroll
        for (unsigned j = 0; j < 16; ++j) { const unsigned c = xb_ld(&bar[XB_XCNT(j)]); sum += c; cnt += (c > 0u) ? 1u : 0u; mine = (j == x) ? c : mine; }
        if (sum == G) break;
        __builtin_amdgcn_s_sleep(1);
        if ((++sp & 255u) == 0u) { if (xb_ld(&bar[XB_TMO])) break; if (sp > XB_SPIN_CAP) { atomicAdd(&bar[XB_TMO], 1u); break; } }
    }
    nloc = mine > 0u ? mine : 1u; nx = cnt > 0u ? cnt : 1u;
}
__device__ __forceinline__ void xcd_barrier(const XcdBarrier& b) {
    asm volatile("s_waitcnt vmcnt(0)" ::: "memory");
    __syncthreads();
    if (threadIdx.x == 0) {
        unsigned* bar = b.bar;
        __builtin_amdgcn_s_waitcnt(0);
        unsigned nloc = b.st[0], nx = b.st[1];
        if (nloc == 0u) { xcd_barrier_complete(bar, b.x, nloc, nx); b.st[0] = nloc; b.st[1] = nx; }
        const unsigned old = xb_add(&bar[XB_XSUB(b.x)], 1u);
        const unsigned gen = old / nloc;
        if (old + 1u == (gen + 1u) * nloc) {
            __builtin_amdgcn_fence(__ATOMIC_RELEASE, "agent");
            asm volatile("s_waitcnt vmcnt(0)" ::: "memory");
            const unsigned og = xb_add(&bar[XB_TOP], 1u);
            const unsigned tg = og / nx;
            if (og + 1u == (tg + 1u) * nx) xb_add(&bar[XB_TOPGEN], 1u);
            else XB_SPIN(xb_ld(&bar[XB_TOPGEN]) == tg, bar);
            __builtin_amdgcn_fence(__ATOMIC_ACQUIRE, "agent");
            xb_add(&bar[XB_XGEN(b.x)], 1u);
            asm volatile("s_waitcnt vmcnt(0)" ::: "memory");
        } else {
            XB_SPIN(xb_ld(&bar[XB_XGEN(b.x)]) == gen, bar);
            __builtin_amdgcn_fence(__ATOMIC_ACQUIRE, "agent");
            asm volatile("s_waitcnt vmcnt(0)" ::: "memory");
        }
    }
    __syncthreads();
}
constexpr int MISC_OFF = 135168;

constexpr int N_PHASES = 10;
__global__ void __launch_bounds__(NWAVES * 64, 2) mega_fwd(Args A) {
    extern __shared__ __attribute__((aligned(16))) unsigned char lds[];
    LAS unsigned char* L = (LAS unsigned char*)lds;
    cg::grid_group grid = cg::this_grid();
    const int lo = A.ph_lo, hi = A.ph_hi, G = gridDim.x, c = blockIdx.x;
#ifndef PH_MASK
#define PH_MASK 0x3FF
#endif
#define IN(k) (((PH_MASK >> (k)) & 1) && lo <= (k) && (k) < hi)
    unsigned* barw = (unsigned*)(A.ws + WS_CTL);
    volatile LAS unsigned* MISC = (volatile LAS unsigned*)(L + MISC_OFF);
    if (threadIdx.x < 2) MISC[threadIdx.x] = 0u;
    if (lo == 0 && hi > 1 && blockIdx.x == 0) for (int i = threadIdx.x; i < XCD_BAR_WORDS; i += NWAVES * 64) barw[i] = 0u;
    XcdBarrier xb; xb.bar = barw; xb.x = 0; xb.st = MISC;
#define SEAM(k) do { if (IN(k) && IN((k) + 1)) { if ((k) == 0) { grid.sync(); xb = xcd_barrier_post(barw, MISC); } else xcd_barrier(xb); } } while (0)
    if (IN(0)) phase_prologue(A, L);
    SEAM(0);
    if (IN(1)) phase_hx(A);
    SEAM(1);
    if (IN(2)) { SchedInProj Sd{(const char*)(A.ws + WS_HX), (const char*)(A.ws + WS_HC), (const char*)(A.ws + WS_WIN), G, c}; EpiInProj E{A.ws};
        pg8::gemm_phase<EpiInProj, SchedInProj, true>(L, D, Sd, E); }
    SEAM(2);
    if (IN(3)) { phase_kfix(A); phase_vt(A, L); __syncthreads(); phase_conv(A, L); }
    SEAM(3);
    if (IN(4)) phase_attn(A, lds);
    SEAM(4);
    if (IN(5)) { SchedMerge Sd{(const char*)(A.ws + WS_Q), (const char*)(A.ws + WS_HX), (const char*)(A.ws + WS_WA), (const char*)(A.ws + WS_WC), G, c}; EpiMerge E{A.ws};
        pg8::gemm_phase<EpiMerge, SchedMerge, true>(L, D, Sd, E); }
    SEAM(5);
    if (IN(6)) { SchedPlain Sd{(const char*)(A.ws + WS_G), (const char*)(A.ws + WS_WO), M / 256, D / 256, G, c};
        EpiOut E{A.x, (const float*)(A.ws + WS_MOD), A.n2g, A.out, (bf16_t*)(A.ws + WS_HX), (float*)(A.ws + WS_SSQ)};
        pg8::gemm_phase<EpiOut, SchedPlain, true>(L, D, Sd, E); }
    SEAM(6);
    if (IN(7)) { SchedPlain Sd{(const char*)(A.ws + WS_HX), (const char*)(A.ws + WS_WP), M / 256, PW / 256, G, c};
        EpiScores E{(float*)(A.ws + WS_SC), (const float*)(A.ws + WS_SSQ), (const float*)(A.ws + WS_SBIAS)};
        pg8::gemm_phase<EpiScores, SchedPlain, true>(L, D, Sd, E); }
    SEAM(7);
    if (IN(8)) phase_peer_u(A, L);
    SEAM(8);
    if (IN(9)) phase_peer_v(A, L);
#undef IN
#undef SEAM
}

#ifndef MK_ONE_LAUNCH
#define MK_ONE_LAUNCH 1
#endif
extern "C" void kernel_launch(void* const* d_in, const int* in_sizes, int n_in, void* d_out, int out_size, void* d_ws, size_t ws_size, hipStream_t stream) {
    static int grid = 0;
    if (grid == 0) {
        if (n_in != 23 || out_size != M * D || ws_size < WS_END) { fprintf(stderr, "kernel_launch: unexpected shapes (n_in %d out %d ws %zu)\n", n_in, out_size, ws_size); grid = -1; return; }
        int dev = 0, cus = 0, per_cu = 0;
        hipGetDevice(&dev); hipDeviceGetAttribute(&cus, hipDeviceAttributeMultiprocessorCount, dev);
        if (hipFuncSetAttribute((const void*)mega_fwd, hipFuncAttributeMaxDynamicSharedMemorySize, LDS_BYTES) != hipSuccess) { fprintf(stderr, "kernel_launch: hipFuncSetAttribute failed\n"); grid = -1; return; }
        if (hipOccupancyMaxActiveBlocksPerMultiprocessor(&per_cu, (const void*)mega_fwd, NWAVES * 64, LDS_BYTES) != hipSuccess || per_cu < 1) { fprintf(stderr, "kernel_launch: occupancy query says %d\n", per_cu); per_cu = 1; }
        (void)hipGetLastError();
        grid = cus * 1;
        if (per_cu < 1) grid = -1;
    }
    if (grid < 0) return;
    Args a{};
    const float** f = (const float**)&a;
    for (int i = 0; i < 23; ++i) f[i] = (const float*)d_in[i];
    a.out = (float*)d_out; a.ws = (unsigned char*)d_ws;
#if MK_ONE_LAUNCH
    a.ph_lo = 0; a.ph_hi = N_PHASES;
    void* args[] = {&a};
    hipError_t e = hipLaunchCooperativeKernel((const void*)mega_fwd, dim3(grid), dim3(NWAVES * 64), args, LDS_BYTES, stream);
    if (e != hipSuccess) fprintf(stderr, "cooperative launch failed: %s (grid %d)\n", hipGetErrorString(e), grid);
#else
#ifndef REPEAT_PH
#define REPEAT_PH -1
#endif
    for (int p = 0; p < N_PHASES; ++p) { a.ph_lo = p; a.ph_hi = p + 1;
        if (p == REPEAT_PH) { a.dry = 1; hipLaunchKernelGGL(mega_fwd, dim3(grid), dim3(NWAVES * 64), LDS_BYTES, stream, a); a.dry = 0; }
        hipLaunchKernelGGL(mega_fwd, dim3(grid), dim3(NWAVES * 64), LDS_BYTES, stream, a); }
#endif
}
```

```cpp
#include <hip/hip_runtime.h>
#include <hip/hip_cooperative_groups.h>
#include <cstdio>
#include <cstdint>
namespace cg = cooperative_groups;

#define LAS __attribute__((address_space(3)))
typedef unsigned short bf16_t;
typedef short bf16x8 __attribute__((ext_vector_type(8)));
typedef short s16x4 __attribute__((ext_vector_type(4)));
typedef float f32x2 __attribute__((ext_vector_type(2)));
typedef float f32x4 __attribute__((ext_vector_type(4)));
typedef float f32x16 __attribute__((ext_vector_type(16)));
typedef unsigned u32x2 __attribute__((ext_vector_type(2)));
typedef unsigned u32x4 __attribute__((ext_vector_type(4)));
typedef __bf16 bf16x2_t __attribute__((ext_vector_type(2)));

constexpr int D = 1024, NB = 8, S = 4096, CTXL = 256, SKV = S + CTXL, HD = 128, HQ = 8, HKV = 2;
constexpr int M = NB * S;
constexpr int MC = NB * CTXL;
constexpr int INW = 5632, NMOD = 6144, NEXP = 16384, PW = 2048;
constexpr float EPS = 1e-6f;

__device__ __forceinline__ unsigned cvt_pk_bf16(float lo, float hi) { f32x2 v = {lo, hi}; bf16x2_t b = __builtin_convertvector(v, bf16x2_t); return __builtin_bit_cast(unsigned, b); }
__device__ __forceinline__ float bf_lo(unsigned u) { return __uint_as_float(u << 16); }
__device__ __forceinline__ float bf_hi(unsigned u) { return __uint_as_float(u & 0xffff0000u); }
__device__ __forceinline__ float fast_sigmoid(float x) { return __builtin_amdgcn_rcpf(1.f + __builtin_amdgcn_exp2f(-1.4426950408889634f * x)); }
__device__ __forceinline__ float wave_sum(float v) {
#pragma unroll
    for (int o = 1; o < 64; o <<= 1) v += __shfl_xor(v, o);
    return v;
}

namespace pg8 {
constexpr int BM = 256, BK = 64, HALF = 128, HTB = HALF * BK * 2  , STAGE_BYTES = 8 * HTB, NXCD = 8, WGM = 8;
__host__ __device__ __forceinline__ int lds_byte(int r, int c) { const int st = (r >> 4) * 2 + (c >> 5), rr = r & 15, cc = c & 31, ob = rr * 64 + cc * 2; return st * 1024 + (ob ^ (((ob >> 9) & 1) << 5)); }
__host__ __device__ __forceinline__ void stage_rc(int b, int& R, int& C) { const int st = b / 1024, sb = b % 1024, swz = sb ^ (((sb >> 9) & 1) << 5); R = (st >> 1) * 16 + swz / 64; C = (st & 1) * 32 + (swz % 64) / 2; }
__host__ __device__ __forceinline__ int perm32(int rho) { const int n = rho >> 4, i = rho & 15; return 8 * (i >> 2) + 4 * n + (i & 3); }

struct Unit { const char* a; const char* b; int pm, pn, kind, keep; };

__device__ __forceinline__ void tile_of(int L, int nM, int nN, int& pm, int& pn) {
    const int nwg = nM * nN; int wgid = L;
    { const int q = nwg / NXCD, r = nwg % NXCD, xcd = wgid % NXCD, off = wgid / NXCD; wgid = (xcd < r ? xcd * (q + 1) : r * (q + 1) + (xcd - r) * q) + off; }
    const int nig = WGM * nN, gid = wgid / nig, fm = gid * WGM, gsz = (nM - fm) < WGM ? (nM - fm) : WGM;
    pm = fm + ((wgid % nig) % gsz); pn = (wgid % nig) / gsz;
}

template <class Epi, class Sched, bool ALIGN_EPI>
__device__ __forceinline__ void gemm_phase(LAS unsigned char* lds, const int K, const Sched& S, const Epi& E) {
    const int tid = threadIdx.x, wid = __builtin_amdgcn_readfirstlane(tid >> 6), lane = tid & 63, wr = wid >> 2, wc = wid & 3, fr = lane & 15, fq = lane >> 4;
    const int nt = K / BK;
    unsigned voffA[2], voffB[2];
#pragma unroll
    for (int i = 0; i < 2; ++i) { int R, C; stage_rc(tid * 16 + i * 8192, R, C); const int Rb = Epi::PERM ? ((R & ~31) + perm32(R & 31)) : R;
        voffA[i] = (unsigned)(R * K + C) * 2u; voffB[i] = (unsigned)(Rb * K + C) * 2u; }
    const size_t kstep = (size_t)(BK * 2);
    const size_t hstep = (size_t)HALF * K * 2;
    const unsigned ldsw = (unsigned)wid * 1024u;
    const int aoff = lds_byte(wr * 64 + fr, fq * 8), boff = lds_byte(wc * 32 + fr, fq * 8);
#define PG8_SA(b, h) (((b) * 2 + (h)) * HTB)
#define PG8_SB(b, h) ((4 + (b) * 2 + (h)) * HTB)
#define PG8_STAGE(bufoff, gbase, voff) do { _Pragma("unroll") for (int _i = 0; _i < 2; ++_i) \
        __builtin_amdgcn_global_load_lds((const unsigned*)((const char*)(gbase) + (voff)[_i]), (LAS unsigned*)(lds + (bufoff) + ldsw + _i * 8192), 16, 0, 0); } while (0)
#define PG8_LDA(dst, b, h) do { _Pragma("unroll") for (int m = 0; m < 4; ++m) _Pragma("unroll") for (int k = 0; k < 2; ++k) dst[m][k] = *(const LAS bf16x8*)(lds + PG8_SA(b, h) + aoff + m * 2048 + k * 1024); } while (0)
#define PG8_LDB(dst, b, h) do { _Pragma("unroll") for (int n = 0; n < 2; ++n) _Pragma("unroll") for (int k = 0; k < 2; ++k) dst[n][k] = *(const LAS bf16x8*)(lds + PG8_SB(b, h) + boff + n * 2048 + k * 1024); } while (0)
#define PG8_MMA(ai, bj, At, Bt) do { __builtin_amdgcn_s_setprio(1); _Pragma("unroll") for (int m = 0; m < 4; ++m) _Pragma("unroll") for (int n = 0; n < 2; ++n) _Pragma("unroll") for (int k = 0; k < 2; ++k) \
        acc[ai][bj][m][n] = __builtin_amdgcn_mfma_f32_16x16x32_bf16(Bt[n][k], At[m][k], acc[ai][bj][m][n], 0, 0, 0); __builtin_amdgcn_s_setprio(0); } while (0)
#define PG8_WAIT_V(n) asm volatile("s_waitcnt vmcnt(" #n ")" ::: "memory")
#define PG8_WAIT_L(n) asm volatile("s_waitcnt lgkmcnt(" #n ")" ::: "memory")
#define PG8_BAR __builtin_amdgcn_s_barrier()
#define PG8_SCHED __builtin_amdgcn_sched_barrier(0)
    Unit cur, nxt; int ui = 0;
    if (!S.next(0, cur)) return;
    f32x4 acc[2][2][4][2];
#pragma unroll
    for (int a = 0; a < 2; ++a)
#pragma unroll
        for (int b = 0; b < 2; ++b)
#pragma unroll
            for (int m = 0; m < 4; ++m)
#pragma unroll
                for (int n = 0; n < 2; ++n) acc[a][b][m][n] = (f32x4){0.f, 0.f, 0.f, 0.f};
    bf16x8 At[4][2], B0[2][2], B1[2][2];
    const char* cA = cur.a; const char* cB = cur.b;
    PG8_STAGE(PG8_SB(0, 0), cB, voffB); PG8_STAGE(PG8_SB(0, 1), cB + hstep, voffB); PG8_STAGE(PG8_SA(0, 0), cA, voffA); PG8_STAGE(PG8_SA(0, 1), cA + hstep, voffA);
    if (wr == 1) PG8_BAR;
    PG8_WAIT_V(2); PG8_BAR;
    PG8_STAGE(PG8_SB(1, 0), cB + kstep, voffB); PG8_STAGE(PG8_SA(1, 0), cA + kstep, voffA); PG8_STAGE(PG8_SB(1, 1), cB + hstep + kstep, voffB);
    PG8_WAIT_V(6); PG8_BAR;
    for (;;) {
        const bool has_next = S.next(ui + 1, nxt);
        const char* nA = has_next ? nxt.a : cA; const char* nB = has_next ? nxt.b : cB;
        for (int t = 0; t < nt; t += 2) {
            const bool last = (t == nt - 2);
            const char* a1 = cA + (size_t)(t + 1) * kstep;
            const char* a2 = last ? nA : cA + (size_t)(t + 2) * kstep; const char* b2 = last ? nB : cB + (size_t)(t + 2) * kstep;
            const char* a3 = a2 + kstep; const char* b3 = b2 + kstep;
            PG8_LDB(B0, 0, 0); PG8_LDB(B1, 0, 1); PG8_SCHED; PG8_LDA(At, 0, 0); PG8_STAGE(PG8_SA(1, 1), a1 + hstep, voffA);
            PG8_WAIT_V(8); PG8_WAIT_L(0); PG8_BAR; PG8_MMA(0, 0, At, B0); PG8_MMA(0, 1, At, B1); PG8_BAR; PG8_SCHED;
            PG8_LDA(At, 0, 1); PG8_STAGE(PG8_SB(0, 0), b2, voffB); PG8_STAGE(PG8_SB(0, 1), b2 + hstep, voffB); PG8_STAGE(PG8_SA(0, 0), a2, voffA);
            PG8_WAIT_V(8); PG8_WAIT_L(0); PG8_BAR; PG8_MMA(1, 0, At, B0); PG8_MMA(1, 1, At, B1); PG8_BAR; PG8_SCHED;
            PG8_LDB(B0, 1, 0); PG8_LDB(B1, 1, 1); PG8_SCHED; PG8_LDA(At, 1, 0); PG8_STAGE(PG8_SA(0, 1), a2 + hstep, voffA);
            PG8_WAIT_V(8); PG8_WAIT_L(0); PG8_BAR; PG8_MMA(0, 0, At, B0); PG8_MMA(0, 1, At, B1); PG8_BAR; PG8_SCHED;
            PG8_LDA(At, 1, 1); PG8_STAGE(PG8_SB(1, 0), b3, voffB); PG8_STAGE(PG8_SB(1, 1), b3 + hstep, voffB); PG8_STAGE(PG8_SA(1, 0), a3, voffA);
            PG8_WAIT_V(8); PG8_WAIT_L(0); PG8_BAR; PG8_MMA(1, 0, At, B0); PG8_MMA(1, 1, At, B1); PG8_BAR; PG8_SCHED;
        }
        if constexpr (ALIGN_EPI) { if (wr == 0) PG8_BAR; }
        E(acc, cur, wr, wc, fr, fq);
        if (!has_next) break;
        if (!cur.keep) {
#pragma unroll
        for (int a = 0; a < 2; ++a)
#pragma unroll
            for (int b = 0; b < 2; ++b)
#pragma unroll
                for (int m = 0; m < 4; ++m)
#pragma unroll
                    for (int n = 0; n < 2; ++n) acc[a][b][m][n] = (f32x4){0.f, 0.f, 0.f, 0.f};
        }
        cur = nxt; cA = nA; cB = nB; ++ui;
        if constexpr (ALIGN_EPI) { if (wr == 1) PG8_BAR; }
    }
    PG8_WAIT_V(0);
    if constexpr (!ALIGN_EPI) { if (wr == 0) PG8_BAR; }
    PG8_BAR;
#undef PG8_SA
#undef PG8_SB
#undef PG8_STAGE
#undef PG8_LDA
#undef PG8_LDB
#undef PG8_MMA
#undef PG8_WAIT_V
#undef PG8_WAIT_L
#undef PG8_BAR
#undef PG8_SCHED
}
}
namespace att {
typedef int v8i __attribute__((ext_vector_type(8)));
constexpr int NW = 8, QBLK = 32, KVBLK = 64;
constexpr float SCALE = 0.088388347648318440f;
constexpr float SC8 = SCALE / 256.f;
constexpr float THR = 3.f;
constexpr int LDQ = D, LDO = D;
constexpr int SHM_V = 8192, SHM_K = 8192, NRING = 3, OFF_K = NRING * SHM_V, OFF_WS = OFF_K + NRING * SHM_K, OST_OFF = OFF_WS + NW * 64 * 4, LDS_TOTAL = OST_OFF + NW * 8192;
#define SBAR() __builtin_amdgcn_sched_barrier(0)
#define MFMA8(a, b, c) __builtin_amdgcn_mfma_scale_f32_32x32x64_f8f6f4((a), (b), (c), 0, 0, 0, 0x7f7f7f7f, 0, 0x7f7f7f7f)
__device__ __forceinline__ int crow(int r, int hi) { return (r & 3) + 8 * (r >> 2) + 4 * hi; }
__device__ __forceinline__ int k_lds(int row, int chunk) { return row * 128 + ((chunk ^ ((row >> 1) & 7)) << 4); }
__device__ __forceinline__ int v_lds(int d, int slot) { return d * 64 + ((slot ^ ((d >> 2) & 3)) << 4); }
__device__ __forceinline__ float max3f(float a, float b, float c) { float r; asm("v_max3_f32 %0, %1, %2, %3" : "=v"(r) : "v"(a), "v"(b), "v"(c)); return r; }
__device__ __forceinline__ int pk4_fp8(float a, float b, float c, float d) { int w = __builtin_amdgcn_cvt_pk_fp8_f32(a, b, 0, false); return __builtin_amdgcn_cvt_pk_fp8_f32(c, d, w, true); }

__device__ __forceinline__ void partialSM(f32x16& p0, f32x16& p1, float& m_reg, float& mn, float& alpha) {
  constexpr float C = SC8 * 1.4426950408889634f;
  asm volatile("s_nop 15\n\ts_nop 7" : "+v"(p0), "+v"(p1));
  float mx[8];
#pragma unroll
  for (int i = 0; i < 8; ++i) mx[i] = max3f(p0[i], p0[8 + i], p1[i]);
  float m4[4];
#pragma unroll
  for (int i = 0; i < 4; ++i) m4[i] = max3f(mx[i], mx[4 + i], p1[8 + i]);
  float m2a = max3f(m4[0], m4[1], p1[12]), m2b = max3f(m4[2], m4[3], p1[13]);
  float pmax = max3f(m2a, m2b, p1[14]); pmax = max3f(pmax, p1[15], p1[15]);
  { auto rr = __builtin_amdgcn_permlane32_swap(__float_as_uint(pmax), __float_as_uint(pmax), false, false);
    pmax = fmaxf(__uint_as_float(rr[0]), __uint_as_float(rr[1])); }
  if (__builtin_expect(__all(pmax - m_reg <= THR / SC8), 1)) { mn = m_reg; alpha = 1.f; }
  else { mn = fmaxf(m_reg, pmax); alpha = __builtin_amdgcn_exp2f((m_reg - mn) * C); m_reg = mn; }
  float mnC = 4.f - mn * C;
  for (int r = 0; r < 16; ++r) p0[r] = fmaf(p0[r], C, mnC); for (int r = 0; r < 16; ++r) p1[r] = fmaf(p1[r], C, mnC);
  for (int r = 0; r < 16; ++r) p0[r] = __builtin_amdgcn_exp2f(p0[r]);
}
__device__ __forceinline__ void finishSM(f32x16& p0, f32x16& p1, float alpha, float& l_reg, v8i& pa) {
  for (int r = 0; r < 16; ++r) p1[r] = __builtin_amdgcn_exp2f(p1[r]);
  float sm[8];
#pragma unroll
  for (int i = 0; i < 8; ++i) sm[i] = (p0[i] + p0[8 + i]) + (p1[i] + p1[8 + i]);
  float ps = ((sm[0] + sm[1]) + (sm[2] + sm[3])) + ((sm[4] + sm[5]) + (sm[6] + sm[7]));
  { auto rr = __builtin_amdgcn_permlane32_swap(__float_as_uint(ps), __float_as_uint(ps), false, false);
    ps = __uint_as_float(rr[0]) + __uint_as_float(rr[1]); }
  l_reg = l_reg * alpha + ps;
  pa[0] = pk4_fp8(p0[0], p0[1], p0[2], p0[3]); pa[1] = pk4_fp8(p0[4], p0[5], p0[6], p0[7]); pa[2] = pk4_fp8(p0[8], p0[9], p0[10], p0[11]); pa[3] = pk4_fp8(p0[12], p0[13], p0[14], p0[15]);
  pa[4] = pk4_fp8(p1[0], p1[1], p1[2], p1[3]); pa[5] = pk4_fp8(p1[4], p1[5], p1[6], p1[7]); pa[6] = pk4_fp8(p1[8], p1[9], p1[10], p1[11]); pa[7] = pk4_fp8(p1[12], p1[13], p1[14], p1[15]);
}
__device__ __forceinline__ v8i ld32(const char* p0, const char* p1) { const u32x4 a = *reinterpret_cast<const u32x4*>(p0), b = *reinterpret_cast<const u32x4*>(p1);
  v8i r; r[0] = (int)a[0]; r[1] = (int)a[1]; r[2] = (int)a[2]; r[3] = (int)a[3]; r[4] = (int)b[0]; r[5] = (int)b[1]; r[6] = (int)b[2]; r[7] = (int)b[3]; return r; }
__device__ __forceinline__ void qkt(f32x16& p0, f32x16& p1, const char* Ks, const v8i* qf, int r32, int hi) {
  p0 = f32x16{}; p1 = f32x16{};
#pragma unroll
  for (int s = 0; s < 2; ++s) {
    const v8i a0 = ld32(Ks + k_lds(r32, 4 * s + hi), Ks + k_lds(r32, 4 * s + 2 + hi)), a1 = ld32(Ks + k_lds(32 + r32, 4 * s + hi), Ks + k_lds(32 + r32, 4 * s + 2 + hi));
    p0 = MFMA8(a0, qf[s], p0); p1 = MFMA8(a1, qf[s], p1); }
}
__device__ __forceinline__ void pv(f32x16* o, const char* Vs, const v8i pa, int r32, int hi) {
#pragma unroll
  for (int d0 = 0; d0 < 4; ++d0) { const int d = 32 * d0 + r32; const v8i b = ld32(Vs + v_lds(d, 2 * hi), Vs + v_lds(d, 2 * hi + 1)); o[d0] = MFMA8(pa, b, o[d0]); }
}

__device__ __forceinline__ void attn_unit(const bf16_t* Qb, const unsigned char* __restrict__ K8, const unsigned char* __restrict__ VT, bf16_t* Ob, int t0, int seq,
                                          const float* __restrict__ qng, const float* __restrict__ cst, const float* __restrict__ snt, char* lds) {
  int tid_ = threadIdx.x; asm volatile("" : "+v"(tid_));
  const int tid = tid_, wid = tid >> 6, lane = tid & 63, r32 = lane & 31, hi = lane >> 5;
  char* V_lds = lds; char* K_lds = lds + OFF_K;
  float* ws = (float*)(lds + OFF_WS) + wid * 64; float* li_l = ws; float* al_l = ws + 32;
  float m_reg = -1e30f, l_reg = 0; f32x16 o[4] = {}; v8i qf[2];
  {
    const bf16_t* Qw = Qb + (long)(wid * QBLK + r32) * LDQ + 16 * hi;
    float y[2][32]; float ss = 0.f;
#pragma unroll
    for (int s = 0; s < 2; ++s)
#pragma unroll
      for (int part = 0; part < 2; ++part)
#pragma unroll
        for (int c = 0; c < 2; ++c) { const u32x4 w = *reinterpret_cast<const u32x4*>(Qw + 64 * s + 32 * part + 8 * c);
#pragma unroll
          for (int j = 0; j < 4; ++j) { const float a = bf_lo(w[j]), b = bf_hi(w[j]); y[s][16 * part + 8 * c + 2 * j] = a; y[s][16 * part + 8 * c + 2 * j + 1] = b; ss += a * a + b * b; } }
    ss += __shfl_xor(ss, 32);
    const float rstd = rsqrtf(ss * (1.f / HD) + EPS) * 16.f;
    const int t = t0 + wid * QBLK + r32;
#pragma unroll
    for (int s = 0; s < 2; ++s) { const int pos = s == 0 ? (t >> 6) : (t & 63);
#pragma unroll
      for (int c = 0; c < 4; ++c) { const int i0 = 16 * hi + 4 * c;
        const f32x4 g1 = *reinterpret_cast<const f32x4*>(qng + 64 * s + i0), g2 = *reinterpret_cast<const f32x4*>(qng + 64 * s + 32 + i0);
        const f32x4 c4 = *reinterpret_cast<const f32x4*>(cst + pos * 32 + i0), s4 = *reinterpret_cast<const f32x4*>(snt + pos * 32 + i0);
#pragma unroll
        for (int j = 0; j < 4; ++j) { const float x1 = y[s][4 * c + j] * rstd * g1[j], x2 = y[s][16 + 4 * c + j] * rstd * g2[j]; y[s][4 * c + j] = x1 * c4[j] - x2 * s4[j]; y[s][16 + 4 * c + j] = x1 * s4[j] + x2 * c4[j]; } }
#pragma unroll
      for (int w = 0; w < 8; ++w) qf[s][w] = pk4_fp8(y[s][4 * w], y[s][4 * w + 1], y[s][4 * w + 2], y[s][4 * w + 3]); }
  }
  const int krow = tid >> 3, kch = tid & 7, kst = k_lds(krow, kch), vst = v_lds(tid >> 2, tid & 3);
  const unsigned char* kg = K8 + (long)krow * 256 + kch * 16; const unsigned char* vg = VT + tid * 16;
  struct { u32x4 k, v; } sr_[2];
#define SLOAD(i, kt) do { sr_[i].k = *reinterpret_cast<const u32x4*>(kg + (long)(kt) * (KVBLK * 256)); sr_[i].v = *reinterpret_cast<const u32x4*>(vg + (long)(kt) * 8192); } while (0)
#define SWRITE(boff, i) do { *(u32x4*)(V_lds + (boff) + vst) = sr_[i].v; *(u32x4*)(K_lds + (boff) + kst) = sr_[i].k; } while (0)
#define SWAIT() asm volatile("s_waitcnt vmcnt(2)" ::: "memory")
#define RESC(a) do { if (__any((a) < 1.f)) { if (hi == 0) al_l[r32] = (a); asm volatile("s_waitcnt lgkmcnt(0)" ::: "memory"); \
    for (int d = 0; d < 4; ++d) for (int r = 0; r < 16; ++r) o[d][r] *= al_l[crow(r, hi)]; } } while (0)
  f32x16 pA0, pA1, pB0, pB1; float mnA, mnB, alA, alB; v8i pa; const int NT = seq / KVBLK;
  constexpr int SE = 0, SO = 1;
  int bprev = 0, bcur = SHM_K, bnext = 2 * SHM_K;
#define ROT() do { const int t_ = bprev; bprev = bcur; bcur = bnext; bnext = t_; } while (0)
  SLOAD(SE, 0); asm volatile("s_waitcnt vmcnt(0)" ::: "memory"); SWRITE(0, SE); __syncthreads();
  qkt(pA0, pA1, K_lds, qf, r32, hi); partialSM(pA0, pA1, m_reg, mnA, alA);
  SLOAD(SO, 1); if (2 < NT) SLOAD(SE, 2);
  SWAIT(); SWRITE(SHM_K, SO); __syncthreads();
  for (int j = 1; j + 1 < NT; j += 2) {
    SBAR(); qkt(pB0, pB1, K_lds + bcur, qf, r32, hi);
    finishSM(pA0, pA1, alA, l_reg, pa); SBAR();
    SLOAD(SO, j + 2); SBAR();
    pv(o, V_lds + bprev, pa, r32, hi); partialSM(pB0, pB1, m_reg, mnB, alB);
    SWAIT(); SWRITE(bnext, SE);
    RESC(alB); __syncthreads(); ROT();
    SBAR(); qkt(pA0, pA1, K_lds + bcur, qf, r32, hi);
    finishSM(pB0, pB1, alB, l_reg, pa); SBAR();
    if (j + 3 < NT) SLOAD(SE, j + 3); SBAR();
    pv(o, V_lds + bprev, pa, r32, hi); partialSM(pA0, pA1, m_reg, mnA, alA);
    SWAIT(); SWRITE(bnext, SO);
    RESC(alA); __syncthreads(); ROT();
  }
  SBAR(); qkt(pB0, pB1, K_lds + bcur, qf, r32, hi);
  finishSM(pA0, pA1, alA, l_reg, pa); SBAR();
  pv(o, V_lds + bprev, pa, r32, hi); partialSM(pB0, pB1, m_reg, mnB, alB);
  RESC(alB);
  finishSM(pB0, pB1, alB, l_reg, pa); SBAR();
  pv(o, V_lds + bcur, pa, r32, hi);
  __syncthreads();
#undef ROT
  if (hi == 0) li_l[r32] = l_reg; asm volatile("s_waitcnt lgkmcnt(0)" ::: "memory");
  float rli[16];
#pragma unroll
  for (int r = 0; r < 16; ++r) rli[r] = __builtin_amdgcn_rcpf(16.f * li_l[crow(r, hi)]);
  { bf16_t* stg = (bf16_t*)(lds + OST_OFF) + wid * 4096;
#pragma unroll
    for (int r = 0; r < 16; ++r) { const int orow = crow(r, hi);
#pragma unroll
      for (int d0 = 0; d0 < 4; ++d0) stg[orow * 128 + d0 * 32 + r32] = (bf16_t)(cvt_pk_bf16(o[d0][r] * rli[r], 0.f) & 0xffffu); }
    asm volatile("s_waitcnt lgkmcnt(0)" ::: "memory");
    bf16_t* Ow = Ob + (long)(wid * QBLK) * LDO;
#pragma unroll
    for (int i = 0; i < 8; ++i) { const int row = i * 4 + (lane >> 4), ch = lane & 15; const u32x4 v = *(const u32x4*)(stg + row * 128 + ch * 8); *(u32x4*)(Ow + (long)row * LDO + ch * 8) = v; }
  }
#undef SLOAD
#undef SWRITE
#undef SWAIT
#undef RESC
}
#undef SBAR
#undef MFMA8
}
constexpr size_t MiB = 1u << 20;
constexpr size_t WS_CTL = 0, CTL_ZERO_BYTES = 64 * 1024;
constexpr size_t WS_MOD = 1 * MiB;
constexpr size_t WS_ROPE = WS_MOD + 256 * 1024;
constexpr size_t WS_SBIAS = WS_MOD + 512 * 1024;
constexpr size_t WS_HC = 2 * MiB;
constexpr size_t WS_WIN = 6 * MiB;
constexpr size_t WS_WA = 17 * MiB, WS_WC = 19 * MiB, WS_WO = 21 * MiB;
constexpr size_t WS_WP = 23 * MiB;
constexpr size_t WS_UT = 27 * MiB, WS_VT = 59 * MiB;
constexpr size_t WS_TSCALE = 16 * MiB;
constexpr size_t WS_KB = 91 * MiB, WS_VB = 108 * MiB;
constexpr size_t WS_HX = 125 * MiB;
constexpr size_t WS_Q = 189 * MiB;
constexpr size_t WS_G = 253 * MiB;
constexpr size_t WS_RT = 317 * MiB;
constexpr size_t WS_SGC = 381 * MiB;
constexpr size_t WS_SC = 189 * MiB;
constexpr size_t WS_SSQ = 445 * MiB;
constexpr size_t WS_K8 = 447 * MiB;
constexpr size_t WS_VT8 = 456 * MiB;
constexpr size_t WS_PE = 465 * MiB, WS_PC = 481 * MiB;
constexpr size_t WS_END = 497 * MiB;

constexpr int NWAVES = 8;
constexpr int LDS_BYTES = 147456;

struct Args {
    const float *x, *c, *ctx, *c_ctx, *w_mod, *b_mod, *n1g, *n2g, *w_in, *qng, *kng, *w_ao, *cdw, *cb, *clg, *clb, *w_co, *w_o, *wq, *keys, *ut, *vt, *fg;
    float* out; unsigned char* ws; int ph_lo, ph_hi, dry, pad;
};

__host__ __device__ __forceinline__ int win_row(int n) {
    if (n < 1536) return n;
    const int base = n < 3584 ? 1536 : 3584, m = n - base, half = m >> 10, idx = m & 1023;
    return base + (idx >> 7) * 256 + half * 128 + (idx & 127);
}

__device__ __forceinline__ void task_mod(const Args& A, int task, int lane, const LAS float* sc) {
    const int n0 = task * 8, col = lane & 7, kg = lane >> 3;
    float acc[9];
#pragma unroll
    for (int b = 0; b < 9; ++b) acc[b] = 0.f;
    const float* wp = A.w_mod + (size_t)kg * NMOD + n0 + col;
    for (int i0 = 0; i0 < 128; i0 += 8) {
        float w[8];
#pragma unroll
        for (int u = 0; u < 8; ++u) w[u] = wp[(size_t)(i0 + u) * 8 * NMOD];
#pragma unroll
        for (int u = 0; u < 8; ++u) { const int k = kg + 8 * (i0 + u);
#pragma unroll
            for (int b = 0; b < 9; ++b) acc[b] += sc[b * D + k] * w[u]; }
    }
#pragma unroll
    for (int b = 0; b < 9; ++b) { float v = acc[b]; v += __shfl_xor(v, 8); v += __shfl_xor(v, 16); v += __shfl_xor(v, 32); acc[b] = v; }
    if (lane < 8) { float* mod = (float*)(A.ws + WS_MOD); const float bm = A.b_mod[n0 + col];
#pragma unroll
        for (int b = 0; b < 9; ++b) mod[b * NMOD + n0 + col] = acc[b] + bm; }
}
__device__ __forceinline__ void task_transpose(const float* W, int K, int N, bf16_t* WT, int k0, int n0, int row0, LAS float* scr, int lane) {
#pragma unroll 8
    for (int i = 0; i < 32; ++i) { const int kk = 2 * i + (lane >> 5); scr[kk * 33 + (lane & 31)] = W[(size_t)(k0 + kk) * N + n0 + (lane & 31)]; }
    asm volatile("s_waitcnt lgkmcnt(0)" ::: "memory");
    const int c = lane & 7;
#pragma unroll
    for (int j = 0; j < 4; ++j) { const int n = (lane >> 3) + 8 * j; const LAS float* s = scr + (8 * c) * 33 + n;
        u32x4 o; o.x = cvt_pk_bf16(s[0 * 33], s[1 * 33]); o.y = cvt_pk_bf16(s[2 * 33], s[3 * 33]); o.z = cvt_pk_bf16(s[4 * 33], s[5 * 33]); o.w = cvt_pk_bf16(s[6 * 33], s[7 * 33]);
        *(u32x4*)(WT + (size_t)(row0 + n) * K + k0 + 8 * c) = o; }
    asm volatile("s_waitcnt lgkmcnt(0)" ::: "memory");
}
typedef float f32x16v __attribute__((ext_vector_type(16)));
typedef unsigned u32x6 __attribute__((ext_vector_type(6)));
constexpr int ROWB = 768;
__device__ __forceinline__ void task_quant_rows4(const float* src, unsigned char* dst, float* scale_out, int lane) {
    const int g = lane & 31, hh = lane >> 5;
    f32x4 v[2][8];
#pragma unroll
    for (int r = 0; r < 2; ++r)
#pragma unroll
        for (int i = 0; i < 8; ++i) v[r][i] = *(const f32x4*)(src + (size_t)(2 * r + hh) * D + g * 32 + i * 4);
#pragma unroll
    for (int r = 0; r < 2; ++r) {
        float am = 0.f;
#pragma unroll
        for (int i = 0; i < 8; ++i) am = fmaxf(fmaxf(am, fmaxf(fabsf(v[r][i][0]), fabsf(v[r][i][1]))), fmaxf(fabsf(v[r][i][2]), fabsf(v[r][i][3])));
#pragma unroll
        for (int o = 1; o < 32; o <<= 1) am = fmaxf(am, __shfl_xor(am, o));
        const float inv = am > 0.f ? 7.5f / am : 0.f;
        f32x16v a, b;
#pragma unroll
        for (int i = 0; i < 4; ++i)
#pragma unroll
            for (int j = 0; j < 4; ++j) { const int e0 = 4 * i + j;
                a[e0] = v[r][(2 * e0) >> 2][(2 * e0) & 3] * inv; b[e0] = v[r][(2 * e0 + 1) >> 2][(2 * e0 + 1) & 3] * inv; }
        const u32x6 p = __builtin_amdgcn_cvt_scalef32_2xpk16_fp6_f32(a, b, 1.0f);
        unsigned char* rowp = dst + (size_t)(2 * r + hh) * ROWB;
        *(u32x4*)(rowp + g * 16) = (u32x4){p[0], p[1], p[2], p[3]}; *(u32x2*)(rowp + 512 + g * 8) = (u32x2){p[4], p[5]};
        if (g == 0) scale_out[2 * r + hh] = am * (1.f / 7.5f);
    }
}
__device__ __forceinline__ bf16x8 ld8_f32_bf16(const float* p) { const f32x4 a = *(const f32x4*)p, b = *(const f32x4*)(p + 4); u32x4 w = {cvt_pk_bf16(a[0], a[1]), cvt_pk_bf16(a[2], a[3]), cvt_pk_bf16(b[0], b[1]), cvt_pk_bf16(b[2], b[3])}; return *reinterpret_cast<bf16x8*>(&w); }
__device__ __forceinline__ void task_wprime(const Args& A, int id, int lane) {
    const int hp = id >> 7, rem = id & 127, n0 = (rem >> 5) * 32, k0 = (rem & 31) * 32, r32 = lane & 31, hi = lane >> 5;
    f32x16 acc = {};
    const float* ka = A.keys + ((size_t)(hp * 128 + n0 + r32)) * 128 + hi * 8;
    const float* wb = A.wq + (size_t)(k0 + r32) * PW + hp * 128 + hi * 8;
#pragma unroll
    for (int s = 0; s < 8; ++s) acc = __builtin_amdgcn_mfma_f32_32x32x16_bf16(ld8_f32_bf16(ka + s * 16), ld8_f32_bf16(wb + s * 16), acc, 0, 0, 0);
    bf16_t* o = (bf16_t*)(A.ws + WS_WP);
#pragma unroll
    for (int r = 0; r < 16; ++r) { const int n = (r & 3) + 8 * (r >> 2) + 4 * hi; o[(size_t)(hp * 128 + n0 + n) * D + k0 + r32] = (bf16_t)(cvt_pk_bf16(acc[r], 0.f) & 0xffffu); }
}
__device__ __forceinline__ void phase_prologue(const Args& A, LAS unsigned char* lds) {
    const int tid = threadIdx.x, lane = tid & 63, wave = __builtin_amdgcn_readfirstlane(tid >> 6);
    LAS float* sc = (LAS float*)lds;
    for (int i = tid; i < 9 * D; i += 512) { const float v = i < 8 * D ? A.c[i] : A.c_ctx[i - 8 * D]; sc[i] = v / (1.f + __expf(-v)); }
    __syncthreads();
    LAS float* scr = (LAS float*)(lds + 36864 + wave * 8448);
    constexpr int T_MOD = NMOD / 8, T_WIN = (D / 64) * (INW / 32), T_SQ = (D / 64) * (D / 32), T_UV = 2 * NEXP / 4, T_WP = 2048, T_ROPE = 1;
    constexpr int NT = T_MOD + T_WIN + 3 * T_SQ + T_UV + T_WP + T_ROPE;
    const int G = gridDim.x;
    for (int task = wave * G + blockIdx.x; task < NT; task += NWAVES * G) {
        int r = task;
        if (r < T_MOD) { task_mod(A, r, lane, sc); continue; } r -= T_MOD;
        if (r < T_WIN) { const int nblk = INW / 32, kb = r / nblk, nb = r % nblk; task_transpose(A.w_in, D, INW, (bf16_t*)(A.ws + WS_WIN), 64 * kb, 32 * nb, win_row(32 * nb), scr, lane); continue; } r -= T_WIN;
        if (r < 3 * T_SQ) { const int wsel = r / T_SQ, q = r % T_SQ, kb = q / 32, nb = q % 32;
            const float* W = wsel == 0 ? A.w_ao : (wsel == 1 ? A.w_co : A.w_o); bf16_t* WT = (bf16_t*)(A.ws + (wsel == 0 ? WS_WA : (wsel == 1 ? WS_WC : WS_WO)));
            task_transpose(W, D, D, WT, 64 * kb, 32 * nb, 32 * nb, scr, lane); continue; } r -= 3 * T_SQ;
        if (r < T_UV) { const int tb = r / (NEXP / 4), row = (r % (NEXP / 4)) * 4; unsigned char* tbase = A.ws + (tb ? WS_VT : WS_UT);
            task_quant_rows4((tb ? A.vt : A.ut) + (size_t)row * D, tbase + (size_t)row * ROWB, (float*)(tbase + WS_TSCALE) + row, lane); continue; } r -= T_UV;
        if (r < T_WP) { task_wprime(A, r, lane); continue; } r -= T_WP;
        { float* cs = (float*)(A.ws + WS_ROPE); float* sn = cs + 2048;
          for (int e = lane; e < 2048; e += 64) { const int p = e >> 5, i = e & 31; const float inv = powf(10000.f, -(float)(2 * i) / 64.f); const float a = (float)p * inv; cs[e] = cosf(a); sn[e] = sinf(a); } }
    }
}
__device__ __forceinline__ void normmod_row(const float* xr, const float* g, const float* modr, int sh_off, int sc_off, bf16_t* orow, int lane) {
    f32x4 v[4]; float ss = 0.f;
#pragma unroll
    for (int i = 0; i < 4; ++i) { v[i] = *(const f32x4*)(xr + (i * 64 + lane) * 4); ss += (v[i][0] * v[i][0] + v[i][1] * v[i][1]) + (v[i][2] * v[i][2] + v[i][3] * v[i][3]); }
    const float r = rsqrtf(wave_sum(ss) * (1.f / D) + EPS);
#pragma unroll
    for (int i = 0; i < 4; ++i) { const int k = (i * 64 + lane) * 4; const f32x4 gg = *(const f32x4*)(g + k), s1 = *(const f32x4*)(modr + sc_off + k), h1 = *(const f32x4*)(modr + sh_off + k);
        float y[4];
#pragma unroll
        for (int j = 0; j < 4; ++j) y[j] = v[i][j] * r * gg[j] * (1.f + s1[j]) + h1[j];
        u32x2 o = {cvt_pk_bf16(y[0], y[1]), cvt_pk_bf16(y[2], y[3])}; *(u32x2*)(orow + k) = o; }
}
__device__ __forceinline__ void phase_hx(const Args& A) {
    const int lane = threadIdx.x & 63, gw = blockIdx.x * NWAVES + (threadIdx.x >> 6), NGW = gridDim.x * NWAVES;
    const float* mod = (const float*)(A.ws + WS_MOD);
    for (int m = gw; m < M + MC; m += NGW) {
        if (m < M) normmod_row(A.x + (size_t)m * D, A.n1g, mod + (m >> 12) * NMOD, 0, D, (bf16_t*)(A.ws + WS_HX) + (size_t)m * D, lane);
        else { const int r = m - M; normmod_row(A.ctx + (size_t)r * D, A.n1g, mod + 8 * NMOD, 0, D, (bf16_t*)(A.ws + WS_HC) + (size_t)r * D, lane); }
    }
    const bf16_t* WP = (const bf16_t*)(A.ws + WS_WP); float* sb = (float*)(A.ws + WS_SBIAS);
    for (int col = gw; col < PW; col += NGW) {
        const u32x4 w0 = *(const u32x4*)(WP + (size_t)col * D + lane * 16), w1 = *(const u32x4*)(WP + (size_t)col * D + lane * 16 + 8);
        float wv[16];
#pragma unroll
        for (int j = 0; j < 4; ++j) { wv[2 * j] = bf_lo(w0[j]); wv[2 * j + 1] = bf_hi(w0[j]); wv[8 + 2 * j] = bf_lo(w1[j]); wv[8 + 2 * j + 1] = bf_hi(w1[j]); }
#pragma unroll 1
        for (int b = 0; b < NB; ++b) { const float* sh = mod + b * NMOD + 3 * D + lane * 16; float s = 0.f;
#pragma unroll
            for (int q = 0; q < 4; ++q) { const f32x4 v = *(const f32x4*)(sh + 4 * q); s += v[0] * wv[4 * q] + v[1] * wv[4 * q + 1] + v[2] * wv[4 * q + 2] + v[3] * wv[4 * q + 3]; }
            s = wave_sum(s); if (lane == 0) sb[b * PW + col] = s; }
    }
}
__device__ __forceinline__ void phase_kfix(const Args& A) {
    const int lane = threadIdx.x & 63, gw = blockIdx.x * NWAVES + (threadIdx.x >> 6), NGW = gridDim.x * NWAVES, li = lane & 15, sub = lane >> 4;
    const bf16_t* KB = (const bf16_t*)(A.ws + WS_KB); const float* cs = (const float*)(A.ws + WS_ROPE); const float* sn = cs + 2048;
    constexpr int NITEM = NB * SKV * HKV;
    const f32x4 g0 = *(const f32x4*)(A.kng + li * 8), g1 = *(const f32x4*)(A.kng + li * 8 + 4);
    const f32x4 p0 = *(const f32x4*)(A.kng + (li ^ 4) * 8), p1 = *(const f32x4*)(A.kng + (li ^ 4) * 8 + 4);
    for (int it = gw * 4 + sub; it < NITEM; it += NGW * 4) {
        const int row = it >> 1, h = it & 1, t = row % SKV;
        const bf16_t* p = KB + (size_t)row * 256 + h * HD + li * 8;
        const u32x4 w = *(const u32x4*)p;
        float x[8], xp[8]; float ss = 0.f;
#pragma unroll
        for (int j = 0; j < 4; ++j) { x[2 * j] = bf_lo(w[j]); x[2 * j + 1] = bf_hi(w[j]); ss += x[2 * j] * x[2 * j] + x[2 * j + 1] * x[2 * j + 1];
            const unsigned pw = (unsigned)__shfl_xor((int)w[j], 4); xp[2 * j] = bf_lo(pw); xp[2 * j + 1] = bf_hi(pw); }
        ss += __shfl_xor(ss, 1); ss += __shfl_xor(ss, 2); ss += __shfl_xor(ss, 4); ss += __shfl_xor(ss, 8);
        const float r = rsqrtf(ss * (1.f / HD) + EPS);
        float y[8];
#pragma unroll
        for (int j = 0; j < 8; ++j) { x[j] *= r * (j < 4 ? g0[j] : g1[j - 4]); xp[j] *= r * (j < 4 ? p0[j] : p1[j - 4]); y[j] = x[j]; }
        if (t < S) {
            const int blk = li >> 3, pos = blk == 0 ? (t >> 6) : (t & 63), second = (li >> 2) & 1, i0 = (li & 3) * 8;
            const f32x4 c0 = *(const f32x4*)(cs + pos * 32 + i0), c1 = *(const f32x4*)(cs + pos * 32 + i0 + 4), s0 = *(const f32x4*)(sn + pos * 32 + i0), s1 = *(const f32x4*)(sn + pos * 32 + i0 + 4);
#pragma unroll
            for (int j = 0; j < 8; ++j) { const float c = j < 4 ? c0[j] : c1[j - 4], s = j < 4 ? s0[j] : s1[j - 4];
                y[j] = second ? (xp[j] * s + x[j] * c) : (x[j] * c - xp[j] * s); }
        }
        u32x2 o = {(unsigned)att::pk4_fp8(y[0] * 16.f, y[1] * 16.f, y[2] * 16.f, y[3] * 16.f), (unsigned)att::pk4_fp8(y[4] * 16.f, y[5] * 16.f, y[6] * 16.f, y[7] * 16.f)};
        *(u32x2*)(A.ws + WS_K8 + (size_t)row * 256 + h * HD + li * 8) = o;
    }
}
__device__ __forceinline__ void phase_vt(const Args& A, LAS unsigned char* lds) {
    const int lane = threadIdx.x & 63, wave = threadIdx.x >> 6, gw = blockIdx.x * NWAVES + wave, NGW = gridDim.x * NWAVES;
    LAS unsigned char* tl = lds + wave * 4096;
    const bf16_t* VB = (const bf16_t*)(A.ws + WS_VB);
    const int kk = lane & 31, pos = 32 * ((kk >> 2) & 1) + (kk & 3) + 4 * (kk >> 3) + 16 * (lane >> 5);
    constexpr int NTILE = SKV / 64;
    for (int it2 = gw; it2 < NB * HKV * NTILE * 2; it2 += NGW) {
        const int dh = it2 & 1, it = it2 >> 1, j = it % NTILE, bk = it / NTILE, b = bk >> 1, kv = bk & 1;
        const bf16_t* src = VB + ((size_t)b * SKV + j * 64 + lane) * 256 + kv * HD + dh * 64;
        u32x4 w[8];
#pragma unroll
        for (int c = 0; c < 8; ++c) w[c] = *(const u32x4*)(src + c * 8);
#pragma unroll
        for (int c = 0; c < 8; ++c)
#pragma unroll
            for (int q = 0; q < 4; ++q) { const int pk = __builtin_amdgcn_cvt_pk_fp8_f32(bf_lo(w[c][q]) * 16.f, bf_hi(w[c][q]) * 16.f, 0, false);
                tl[(c * 8 + 2 * q) * 64 + pos] = (unsigned char)(pk & 0xff); tl[(c * 8 + 2 * q + 1) * 64 + pos] = (unsigned char)((pk >> 8) & 0xff); }
        asm volatile("s_waitcnt lgkmcnt(0)" ::: "memory");
        unsigned char* dst = A.ws + WS_VT8 + (size_t)it * 8192 + dh * 4096;
#pragma unroll
        for (int i = 0; i < 4; ++i) *(u32x4*)(dst + (i * 64 + lane) * 16) = *(const LAS u32x4*)(tl + (i * 64 + lane) * 16);
        asm volatile("s_waitcnt lgkmcnt(0)" ::: "memory");
    }
}
template <int R> struct ConvRow {
    static __device__ __forceinline__ void run(const unsigned* gp, int tl0, float (&acc)[32][2], const float (&w)[31][2]) {
        const int tl = tl0 + R - 15;
        unsigned v = 0u; if (tl >= 0 && tl < S) v = gp[(long)(R - 15) * (D / 2)];
        const float a = bf_lo(v), b = bf_hi(v);
#pragma unroll
        for (int t = (R - 30 > 0 ? R - 30 : 0); t <= (R < 31 ? R : 31); ++t) { acc[t][0] += w[R - t][0] * a; acc[t][1] += w[R - t][1] * b; }
        if constexpr (R + 1 < 62) ConvRow<R + 1>::run(gp, tl0, acc, w);
    }
};
__device__ __forceinline__ void phase_conv(const Args& A, LAS unsigned char* lds) {
    const int tid = threadIdx.x, lane = tid & 63, wave = tid >> 6;
    LAS float* tile = (LAS float*)lds;
    const bf16_t* G = (const bf16_t*)(A.ws + WS_G); bf16_t* CV = (bf16_t*)(A.ws + WS_HX);
    float w[31][2];
#pragma unroll
    for (int j = 0; j < 31; ++j) { const f32x2 t = *(const f32x2*)(A.cdw + j * D + 2 * tid); w[j][0] = t[0]; w[j][1] = t[1]; }
    const f32x2 bias = *(const f32x2*)(A.cb + 2 * tid);
    for (int tileid = blockIdx.x; tileid < M / 32; tileid += gridDim.x) {
        const int row0 = tileid * 32, tl0 = row0 & (S - 1);
        float acc[32][2];
#pragma unroll
        for (int t = 0; t < 32; ++t) { acc[t][0] = bias[0]; acc[t][1] = bias[1]; }
        ConvRow<0>::run((const unsigned*)(G + (size_t)row0 * D) + tid, tl0, acc, w);
        __syncthreads();
#pragma unroll
        for (int t = 0; t < 32; ++t) *(LAS f32x2*)(tile + t * D + 2 * tid) = (f32x2){acc[t][0], acc[t][1]};
        __syncthreads();
#pragma unroll
        for (int q = 0; q < 4; ++q) { const int t = wave * 4 + q; const LAS float* tr = tile + t * D;
            f32x4 v[4]; float s = 0.f;
#pragma unroll
            for (int i = 0; i < 4; ++i) { v[i] = *(const LAS f32x4*)(tr + (i * 64 + lane) * 4); s += (v[i][0] + v[i][1]) + (v[i][2] + v[i][3]); }
            const float mu = wave_sum(s) * (1.f / D); float qq = 0.f;
#pragma unroll
            for (int i = 0; i < 4; ++i) { v[i] = v[i] - mu; qq += (v[i][0] * v[i][0] + v[i][1] * v[i][1]) + (v[i][2] * v[i][2] + v[i][3] * v[i][3]); }
            const float rs = rsqrtf(wave_sum(qq) * (1.f / D) + EPS);
#pragma unroll
            for (int i = 0; i < 4; ++i) { const int k = (i * 64 + lane) * 4; const f32x4 gg = *(const f32x4*)(A.clg + k), bb = *(const f32x4*)(A.clb + k); float y[4];
#pragma unroll
                for (int j = 0; j < 4; ++j) { const float z = v[i][j] * rs * gg[j] + bb[j]; y[j] = z * fast_sigmoid(z); }
                u32x2 o = {cvt_pk_bf16(y[0], y[1]), cvt_pk_bf16(y[2], y[3])}; *(u32x2*)(CV + (size_t)(row0 + t) * D + k) = o; }
        }
    }
}
typedef float f32x32v __attribute__((ext_vector_type(32)));
typedef _Float16 f16x32v __attribute__((ext_vector_type(32)));
typedef _Float16 f16x2v __attribute__((ext_vector_type(2)));
__device__ __forceinline__ unsigned pk_f16(float a, float b) { const f16x2v h = {(_Float16)a, (_Float16)b}; return __builtin_bit_cast(unsigned, h); }
struct EpiInProj {
    static constexpr bool PERM = true;
    unsigned char* ws;
    __device__ __forceinline__ void operator()(f32x4 (&acc)[2][2][4][2], const pg8::Unit& u, int wr, int wc, int fr, int fq) const {
        const int c8 = wc * 32 + 8 * fq;
#pragma unroll
        for (int ai = 0; ai < 2; ++ai)
#pragma unroll
            for (int m = 0; m < 4; ++m) {
                const int row = u.pm * 256 + ai * 128 + wr * 64 + m * 16 + fr;
                if (u.kind == 0) {
                    bf16_t* p = (bf16_t*)(ws + WS_Q) + (size_t)row * D + u.pn * 256 + c8;
#pragma unroll
                    for (int bj = 0; bj < 2; ++bj) { const f32x4 v0 = acc[ai][bj][m][0], v1 = acc[ai][bj][m][1];
                        u32x4 w = {cvt_pk_bf16(v0[0], v0[1]), cvt_pk_bf16(v0[2], v0[3]), cvt_pk_bf16(v1[0], v1[1]), cvt_pk_bf16(v1[2], v1[3])}; *(u32x4*)(p + bj * 128) = w; }
                } else if (u.kind == 1 || u.kind == 2 || u.kind == 5 || u.kind == 6) {
                    const bool ctxu = u.kind >= 5;
                    const int kvrow = ctxu ? (row >> 8) * SKV + S + (row & 255) : (row >> 12) * SKV + (row & (S - 1));
                    bf16_t* p = (bf16_t*)(ws + ((u.kind == 1 || u.kind == 5) ? WS_KB : WS_VB)) + (size_t)kvrow * 256 + c8;
#pragma unroll
                    for (int bj = 0; bj < 2; ++bj) { const f32x4 v0 = acc[ai][bj][m][0], v1 = acc[ai][bj][m][1];
                        u32x4 w = {cvt_pk_bf16(v0[0], v0[1]), cvt_pk_bf16(v0[2], v0[3]), cvt_pk_bf16(v1[0], v1[1]), cvt_pk_bf16(v1[2], v1[3])}; *(u32x4*)(p + bj * 128) = w; }
                } else if (u.kind == 3) {
                    float g[8];
#pragma unroll
                    for (int n = 0; n < 2; ++n)
#pragma unroll
                        for (int j = 0; j < 4; ++j) g[4 * n + j] = acc[ai][0][m][n][j] * fast_sigmoid(acc[ai][1][m][n][j]);
                    u32x4 w = {cvt_pk_bf16(g[0], g[1]), cvt_pk_bf16(g[2], g[3]), cvt_pk_bf16(g[4], g[5]), cvt_pk_bf16(g[6], g[7])};
                    *(u32x4*)((bf16_t*)(ws + WS_G) + (size_t)row * D + (u.pn - 6) * 128 + c8) = w;
                } else {
                    float rt[8], sg[8];
#pragma unroll
                    for (int n = 0; n < 2; ++n)
#pragma unroll
                        for (int j = 0; j < 4; ++j) { const float ea = __builtin_amdgcn_exp2f(-1.4426950408889634f * acc[ai][0][m][n][j]), ec = __builtin_amdgcn_exp2f(-1.4426950408889634f * acc[ai][1][m][n][j]);
                            sg[4 * n + j] = __builtin_amdgcn_rcpf(1.f + ec); rt[4 * n + j] = (1.f + ec) * __builtin_amdgcn_rcpf(1.f + ea); }
                    const size_t off = (size_t)row * D + (u.pn - 14) * 128 + c8;
                    u32x4 w = {cvt_pk_bf16(rt[0], rt[1]), cvt_pk_bf16(rt[2], rt[3]), cvt_pk_bf16(rt[4], rt[5]), cvt_pk_bf16(rt[6], rt[7])}; *(u32x4*)((bf16_t*)(ws + WS_RT) + off) = w;
                    u32x4 w2 = {cvt_pk_bf16(sg[0], sg[1]), cvt_pk_bf16(sg[2], sg[3]), cvt_pk_bf16(sg[4], sg[5]), cvt_pk_bf16(sg[6], sg[7])}; *(u32x4*)((bf16_t*)(ws + WS_SGC) + off) = w2;
                }
            }
    }
};
struct SchedInProj {
    const char* hx; const char* hc; const char* w; int G, c;
    __device__ __forceinline__ bool next(int i, pg8::Unit& u) const {
        constexpr int nM = M / 256, nN = INW / 256, NMAIN = nM * nN, NCTX = (MC / 256) * 2;
        const int L = i * G + c; if (L >= NMAIN + NCTX) return false;
        if (L < NMAIN) { pg8::tile_of(L, nM, nN, u.pm, u.pn); u.a = hx + (size_t)u.pm * 256 * D * 2; u.kind = u.pn < 4 ? 0 : (u.pn == 4 ? 1 : (u.pn == 5 ? 2 : (u.pn < 14 ? 3 : 4))); }
        else { const int j = L - NMAIN; u.pm = j >> 1; u.pn = 4 + (j & 1); u.a = hc + (size_t)u.pm * 256 * D * 2; u.kind = 5 + (j & 1); }
        u.b = w + (size_t)u.pn * 256 * D * 2; u.keep = 0; return true;
    }
};
struct EpiMerge {
    static constexpr bool PERM = true;
    unsigned char* ws;
    __device__ __forceinline__ void operator()(f32x4 (&acc)[2][2][4][2], const pg8::Unit& u, int wr, int wc, int fr, int fq) const {
        const int c8 = u.pn * 256 + wc * 32 + 8 * fq;
        const bf16_t* __restrict__ F = (const bf16_t*)(ws + (u.kind == 0 ? WS_RT : WS_SGC));
#pragma unroll
        for (int ai = 0; ai < 2; ++ai)
#pragma unroll
            for (int m = 0; m < 4; ++m) { const size_t off = (size_t)(u.pm * 256 + ai * 128 + wr * 64 + m * 16 + fr) * D + c8;
#pragma unroll
                for (int bj = 0; bj < 2; ++bj) { const u32x4 f = *(const u32x4*)(F + off + bj * 128);
                    f32x4 v0 = acc[ai][bj][m][0], v1 = acc[ai][bj][m][1];
                    v0[0] *= bf_lo(f[0]); v0[1] *= bf_hi(f[0]); v0[2] *= bf_lo(f[1]); v0[3] *= bf_hi(f[1]); v1[0] *= bf_lo(f[2]); v1[1] *= bf_hi(f[2]); v1[2] *= bf_lo(f[3]); v1[3] *= bf_hi(f[3]);
                    if (u.kind == 0) { acc[ai][bj][m][0] = v0; acc[ai][bj][m][1] = v1; }
                    else { u32x4 w = {cvt_pk_bf16(v0[0], v0[1]), cvt_pk_bf16(v0[2], v0[3]), cvt_pk_bf16(v1[0], v1[1]), cvt_pk_bf16(v1[2], v1[3])}; *(u32x4*)((bf16_t*)(ws + WS_G) + off + bj * 128) = w; } } }
    }
};
struct SchedMerge {
    const char* att; const char* cv; const char* wa; const char* wc; int G, c;
    __device__ __forceinline__ bool next(int i, pg8::Unit& u) const {
        constexpr int nM = M / 256, nN = D / 256;
        const int L = (i >> 1) * G + c, sub = i & 1; if (L >= nM * nN) return false;
        pg8::tile_of(L, nM, nN, u.pm, u.pn);
        u.a = (sub ? cv : att) + (size_t)u.pm * 256 * D * 2; u.b = (sub ? wc : wa) + (size_t)u.pn * 256 * D * 2; u.kind = sub; u.keep = sub ^ 1; return true;
    }
};
struct SchedPlain {
    const char* a; const char* b; int nM, nN, G, c;
    __device__ __forceinline__ bool next(int i, pg8::Unit& u) const {
        const int L = i * G + c; if (L >= nM * nN) return false;
        pg8::tile_of(L, nM, nN, u.pm, u.pn); u.a = a + (size_t)u.pm * 256 * D * 2; u.b = b + (size_t)u.pn * 256 * D * 2; u.kind = 0; u.keep = 0; return true;
    }
};
struct EpiOut {
    static constexpr bool PERM = false;
    const float* __restrict__ x; const float* __restrict__ mod; const float* __restrict__ n2g; float* __restrict__ xs; bf16_t* __restrict__ xg; float* __restrict__ ssq;
    __device__ __forceinline__ void operator()(f32x4 (&acc)[2][2][4][2], const pg8::Unit& u, int wr, int wc, int fr, int fq) const {
        const int col0 = u.pn * 256 + wc * 32 + 4 * fq; const float* mb = mod + ((u.pm * 256) >> 12) * NMOD;
        f32x4 gv[2][2], nv[2][2];
#pragma unroll
        for (int bj = 0; bj < 2; ++bj)
#pragma unroll
            for (int n = 0; n < 2; ++n) { const int c = col0 + bj * 128 + n * 16; gv[bj][n] = *(const f32x4*)(mb + 2 * D + c); nv[bj][n] = *(const f32x4*)(n2g + c) * (*(const f32x4*)(mb + 4 * D + c) + 1.f); }
        f32x4 xa[2][2], xb[2][2];
#define XLOAD(dst, k) do { _Pragma("unroll") for (int bj = 0; bj < 2; ++bj) _Pragma("unroll") for (int n = 0; n < 2; ++n) \
            dst[bj][n] = *(const f32x4*)(x + (size_t)(u.pm * 256 + ((k) >> 2) * 128 + wr * 64 + ((k) & 3) * 16 + fr) * D + col0 + bj * 128 + n * 16); } while (0)
#define XDONE(src, k) do { const int ai = (k) >> 2, m = (k) & 3; const int row = u.pm * 256 + ai * 128 + wr * 64 + m * 16 + fr; const size_t off = (size_t)row * D + col0; float ss = 0.f; \
            _Pragma("unroll") for (int bj = 0; bj < 2; ++bj) _Pragma("unroll") for (int n = 0; n < 2; ++n) { const f32x4 v = src[bj][n] + gv[bj][n] * acc[ai][bj][m][n]; *(f32x4*)(xs + off + bj * 128 + n * 16) = v; \
                ss += (v[0] * v[0] + v[1] * v[1]) + (v[2] * v[2] + v[3] * v[3]); const f32x4 g = v * nv[bj][n]; \
                u32x2 w = {cvt_pk_bf16(g[0], g[1]), cvt_pk_bf16(g[2], g[3])}; *(u32x2*)(xg + off + bj * 128 + n * 16) = w; } \
            ss += __shfl_xor(ss, 16); ss += __shfl_xor(ss, 32); if (fq == 0) ssq[(size_t)row * 16 + u.pn * 4 + wc] = ss; } while (0)
        XLOAD(xa, 0); XLOAD(xb, 1); XDONE(xa, 0); XLOAD(xa, 2); XDONE(xb, 1); XLOAD(xb, 3); XDONE(xa, 2); XLOAD(xa, 4); XDONE(xb, 3); XLOAD(xb, 5); XDONE(xa, 4); XLOAD(xa, 6); XDONE(xb, 5); XLOAD(xb, 7); XDONE(xa, 6); XDONE(xb, 7);
#undef XLOAD
#undef XDONE
    }
};
__device__ __forceinline__ float row_rstd(const float* ssq, int row) {
    const f32x4 a = *(const f32x4*)(ssq + (size_t)row * 16), b = *(const f32x4*)(ssq + (size_t)row * 16 + 4), c = *(const f32x4*)(ssq + (size_t)row * 16 + 8), d = *(const f32x4*)(ssq + (size_t)row * 16 + 12);
    const float s = ((a[0] + a[1]) + (a[2] + a[3])) + ((b[0] + b[1]) + (b[2] + b[3])) + ((c[0] + c[1]) + (c[2] + c[3])) + ((d[0] + d[1]) + (d[2] + d[3]));
    return rsqrtf(s * (1.f / D) + EPS);
}
struct EpiScores {
    static constexpr bool PERM = true;
    unsigned short* sc; const float* ssq; const float* sbias;
    __device__ __forceinline__ void operator()(f32x4 (&acc)[2][2][4][2], const pg8::Unit& u, int wr, int wc, int fr, int fq) const {
        const float* sb = sbias + ((u.pm * 256) >> 12) * PW + u.pn * 256 + wc * 32 + 8 * fq;
        f32x4 bv[2][2];
#pragma unroll
        for (int bj = 0; bj < 2; ++bj)
#pragma unroll
            for (int n = 0; n < 2; ++n) bv[bj][n] = *(const f32x4*)(sb + bj * 128 + n * 4);
#pragma unroll
        for (int ai = 0; ai < 2; ++ai)
#pragma unroll
            for (int m = 0; m < 4; ++m) { const int row = u.pm * 256 + ai * 128 + wr * 64 + m * 16 + fr; unsigned short* p = sc + (size_t)(row >> 2) * 8192 + (row & 3) * 8; const float rs = row_rstd(ssq, row);
#pragma unroll
                for (int bj = 0; bj < 2; ++bj) { const int grp = u.pn * 2 + bj, nq = wc * 4 + fq; const f32x4 v0 = acc[ai][bj][m][0] * rs + bv[bj][0], v1 = acc[ai][bj][m][1] * rs + bv[bj][1];
                    u32x4 w = {pk_f16(v0[0], v0[1]), pk_f16(v0[2], v0[3]), pk_f16(v1[0], v1[1]), pk_f16(v1[2], v1[3])}; *(u32x4*)(p + (grp * 16 + nq) * 32) = w; } }
    }
};

#ifndef PROBE_HALFKEYS
#define PROBE_HALFKEYS 0
#endif
__device__ __forceinline__ void phase_attn(const Args& A, unsigned char* lds) {
    const int G = gridDim.x, X = blockIdx.x & 7, j = blockIdx.x >> 3, perx = G >> 3;
    bf16_t* Q = (bf16_t*)(A.ws + WS_Q); const unsigned char* K8 = A.ws + WS_K8; const unsigned char* VT8 = A.ws + WS_VT8;
    const float* cs = (const float*)(A.ws + WS_ROPE); const float* sn = cs + 2048;
    for (int idx = j; idx < 128; idx += perx) {
        const int grp = 2 * X + (idx >> 6), uu = idx & 63, b = grp >> 1, kv = grp & 1, h = kv * 4 + (uu >> 4), qb = uu & 15;
        bf16_t* qp = Q + ((size_t)b * S + qb * 256) * D + h * HD;
        bf16_t* op = A.dry ? (bf16_t*)(A.ws + WS_G) + ((size_t)b * S + qb * 256) * D + h * HD : qp;
        att::attn_unit(qp, K8 + (size_t)b * SKV * 256 + kv * HD, VT8 + (size_t)grp * (SKV / 64) * 8192, op, qb * 256, (A.dry && PROBE_HALFKEYS) ? SKV / 2 : SKV, A.qng, cs, sn, (char*)lds);
    }
}

__device__ __forceinline__ float gelu_exact(float v) {
    const float av = fabsf(v), t = __builtin_amdgcn_rcpf(av * 0.2316418882f + 1.0f);
    float q = t * 0.5307027145f + (-0.7265760135f); q = q * t + 0.7107068705f; q = q * t + (-0.142248368f); q = q * t + 0.127414796f; q = q * t;
    const float e = __builtin_amdgcn_exp2f((v * v) * (-0.72134752044f));
    const float m = v * (q * e);
    return v < 0.f ? m : v - m;
}
__device__ __forceinline__ void ins16(float (&t)[16], float v) {
#pragma unroll
    for (int i = 15; i >= 1; --i) t[i] = __builtin_amdgcn_fmed3f(t[i - 1], t[i], v);
    t[0] = fmaxf(t[0], v);
}

__device__ __forceinline__ float key_tag(float v, unsigned keepmask, unsigned tag) { return __uint_as_float((__float_as_uint(v) & keepmask) | tag); }
template <int I, int J> struct CandLoop {
    static __device__ __forceinline__ void run(const float (&a)[16], const float (&b)[16], float (&c)[16]) {
        if constexpr ((I + 1) * (J + 1) <= 16) { ins16(c, key_tag(a[I] + b[J], ~255u, 255u - (unsigned)(I * 16 + J))); CandLoop<I, J + 1>::run(a, b, c); }
        else if constexpr (I + 1 < 16) CandLoop<I + 1, 0>::run(a, b, c);
    }
};
__device__ __forceinline__ void phase_peer_u(const Args& A, LAS unsigned char* lds) {
    const int lane = threadIdx.x & 63, wave = threadIdx.x >> 6, gw = blockIdx.x * NWAVES + wave, NGW = gridDim.x * NWAVES;
    LAS unsigned char* wl = lds + wave * 10240;
    LAS float* topL = (LAS float*)wl; LAS int* eidA = (LAS int*)(wl + 4096); LAS float* wgtA = (LAS float*)(wl + 6144); LAS float* coefL = (LAS float*)(wl + 8192);
    LAS float* suL = (LAS float*)(wl + 8704); LAS float* svL = (LAS float*)(wl + 9216);
    const unsigned short* SC = (const unsigned short*)(A.ws + WS_SC); const bf16_t* HX = (const bf16_t*)(A.ws + WS_HX);
    const unsigned char* UT = A.ws + WS_UT; const float* SU = (const float*)(A.ws + WS_UT + WS_TSCALE); const float* SVs = (const float*)(A.ws + WS_VT + WS_TSCALE);
    const float* mod = (const float*)(A.ws + WS_MOD);
    int* PE = (int*)(A.ws + WS_PE); float* PC = (float*)(A.ws + WS_PC);
    const float NEG = -3.0e38f;
    const int h = lane >> 3, tk = (lane >> 1) & 3, p = lane & 1, grp = 2 * h + p;
    for (int pass = gw; pass < M / 4; pass += NGW) {
        {
            float t[16];
#pragma unroll
            for (int i = 0; i < 16; ++i) t[i] = NEG;
            const unsigned short* sp = SC + (size_t)pass * 8192 + (grp * 64 + tk) * 8;
            u32x4 sv[16];
#pragma unroll
            for (int i = 0; i < 16; ++i) sv[i] = *(const u32x4*)(sp + i * 32);
#pragma unroll
            for (int i = 0; i < 16; ++i)
#pragma unroll
                for (int q = 0; q < 4; ++q) { const unsigned w = sv[i][q]; const f16x2v hv = __builtin_bit_cast(f16x2v, w); const unsigned tg = 127u - (unsigned)(8 * i + 2 * q);
                    ins16(t, __uint_as_float(__float_as_uint((float)hv[0]) | tg)); ins16(t, __uint_as_float(__float_as_uint((float)hv[1]) | (tg - 1u))); }
            float pb[16];
#pragma unroll
            for (int i = 0; i < 16; ++i) { pb[i] = __shfl_xor(t[i], 1); topL[i * 64 + lane] = t[i]; }
            float c[16];
#pragma unroll
            for (int i = 0; i < 16; ++i) c[i] = NEG;
            CandLoop<0, 0>::run(t, pb, c);
            float e[16]; float es = 0.f;
#pragma unroll
            for (int k = 0; k < 16; ++k) { e[k] = __expf(c[k] - c[0]); es += e[k]; }
            const float inv = __builtin_amdgcn_rcpf(es);
            asm volatile("s_waitcnt lgkmcnt(0)" ::: "memory");
            if (p == 0) {
#pragma unroll
                for (int k = 0; k < 16; ++k) { const unsigned code = 255u - (__float_as_uint(c[k]) & 255u);
                    const unsigned ia = 127u - (__float_as_uint(topL[(code >> 4) * 64 + lane]) & 127u), ib = 127u - (__float_as_uint(topL[(code & 15u) * 64 + lane + 1]) & 127u);
                    eidA[tk * 128 + h * 16 + k] = (int)(ia * 128u + ib); wgtA[tk * 128 + h * 16 + k] = e[k] * inv; }
            }
            asm volatile("s_waitcnt lgkmcnt(0)" ::: "memory");
        }
#pragma unroll 1
        for (int tq = 0; tq < 4; ++tq) {
            const int t = pass * 4 + tq; const LAS int* eidL = eidA + tq * 128; const LAS float* wgtL = wgtA + tq * 128;
            const int g = lane & 31, hh = lane >> 5;
            f16x2v xh[16];
            { const float rs = row_rstd((const float*)(A.ws + WS_SSQ), t); const float* sh = mod + (t >> 12) * NMOD + 3 * D + g * 32; const bf16_t* xp = HX + (size_t)t * D + g * 32;
#pragma unroll
              for (int c = 0; c < 4; ++c) { const u32x4 w = *(const u32x4*)(xp + 8 * c); const f32x4 s0 = *(const f32x4*)(sh + 8 * c), s1 = *(const f32x4*)(sh + 8 * c + 4);
                xh[4 * c] = (f16x2v){(_Float16)(bf_lo(w[0]) * rs + s0[0]), (_Float16)(bf_hi(w[0]) * rs + s0[1])}; xh[4 * c + 1] = (f16x2v){(_Float16)(bf_lo(w[1]) * rs + s0[2]), (_Float16)(bf_hi(w[1]) * rs + s0[3])};
                xh[4 * c + 2] = (f16x2v){(_Float16)(bf_lo(w[2]) * rs + s1[0]), (_Float16)(bf_hi(w[2]) * rs + s1[1])}; xh[4 * c + 3] = (f16x2v){(_Float16)(bf_lo(w[3]) * rs + s1[2]), (_Float16)(bf_hi(w[3]) * rs + s1[3])}; } }
            { const int i0 = eidL[lane], i1 = eidL[64 + lane]; suL[lane] = SU[i0]; suL[64 + lane] = SU[i1]; svL[lane] = SVs[i0]; svL[64 + lane] = SVs[i1]; }
            u32x6 rb0[4], rb1[4], rb2[4], rb3[4];
#define LOAD8(buf, TB, hb) do { _Pragma("unroll") for (int r = 0; r < 4; ++r) { const int id = eidL[(hb) * 8 + 2 * r + hh]; const unsigned char* rp = (TB) + (size_t)id * ROWB; \
                const u32x4 lo = *(const u32x4*)(rp + g * 16); const u32x2 hi2 = *(const u32x2*)(rp + 512 + g * 8); buf[r] = (u32x6){lo[0], lo[1], lo[2], lo[3], hi2[0], hi2[1]}; } } while (0)
#define DOT8(buf, off) do { _Pragma("unroll") for (int r = 0; r < 4; ++r) { const f16x32v dq = __builtin_amdgcn_cvt_scalef32_pk32_f16_fp6(buf[r], 1.0f); \
                float sa = 0.f, sb = 0.f, sc = 0.f, sd = 0.f;     \
                _Pragma("unroll") for (int j = 0; j < 16; j += 4) { sa = __builtin_amdgcn_fdot2((f16x2v){dq[2 * j], dq[2 * j + 1]}, xh[j], sa, false); sb = __builtin_amdgcn_fdot2((f16x2v){dq[2 * j + 2], dq[2 * j + 3]}, xh[j + 1], sb, false); \
                    sc = __builtin_amdgcn_fdot2((f16x2v){dq[2 * j + 4], dq[2 * j + 5]}, xh[j + 2], sc, false); sd = __builtin_amdgcn_fdot2((f16x2v){dq[2 * j + 6], dq[2 * j + 7]}, xh[j + 3], sd, false); } \
                pp[(off) + r] = (sa + sb) + (sc + sd); } } while (0)
#define REDUCE16(kb) do { \
            _Pragma("unroll") for (int e = 0; e < 4; ++e) { const bool up = lane & 16; const float keep = up ? pp[e + 4] : pp[e], send = up ? pp[e] : pp[e + 4]; pp[e] = keep + __shfl_xor(send, 16); } \
            _Pragma("unroll") for (int e = 0; e < 2; ++e) { const bool up = lane & 8; const float keep = up ? pp[e + 2] : pp[e], send = up ? pp[e] : pp[e + 2]; pp[e] = keep + __shfl_xor(send, 8); } \
            { const bool up = lane & 4; const float keep = up ? pp[1] : pp[0], send = up ? pp[0] : pp[1]; pp[0] = keep + __shfl_xor(send, 4); } \
            float hsum = pp[0]; hsum += __shfl_xor(hsum, 2); hsum += __shfl_xor(hsum, 1); \
            const int ke = (kb) * 16 + 2 * ((lane >> 2) & 7) + hh; const float su = suL[ke], sv = svL[ke]; \
            const float cf = wgtL[ke] * gelu_exact(hsum * su) * sv; if ((lane & 3) == 0) coefL[ke] = cf; } while (0)
            float pp[8];
            LOAD8(rb0, UT, 0); LOAD8(rb1, UT, 1); LOAD8(rb2, UT, 2);
            LOAD8(rb3, UT, 3); DOT8(rb0, 0);
            LOAD8(rb0, UT, 4); DOT8(rb1, 4); REDUCE16(0);
            LOAD8(rb1, UT, 5); DOT8(rb2, 0);
            LOAD8(rb2, UT, 6); DOT8(rb3, 4); REDUCE16(1);
            LOAD8(rb3, UT, 7); DOT8(rb0, 0);
            LOAD8(rb0, UT, 8); DOT8(rb1, 4); REDUCE16(2);
            LOAD8(rb1, UT, 9); DOT8(rb2, 0);
            LOAD8(rb2, UT, 10); DOT8(rb3, 4); REDUCE16(3);
            LOAD8(rb3, UT, 11); DOT8(rb0, 0);
            LOAD8(rb0, UT, 12); DOT8(rb1, 4); REDUCE16(4);
            LOAD8(rb1, UT, 13); DOT8(rb2, 0);
            LOAD8(rb2, UT, 14); DOT8(rb3, 4); REDUCE16(5);
            LOAD8(rb3, UT, 15); DOT8(rb0, 0);
            DOT8(rb1, 4); REDUCE16(6);
            DOT8(rb2, 0);
            DOT8(rb3, 4); REDUCE16(7);
#undef LOAD8
#undef DOT8
#undef REDUCE16
            asm volatile("s_waitcnt lgkmcnt(0)" ::: "memory");
            PE[(size_t)t * 128 + lane] = eidL[lane]; PE[(size_t)t * 128 + 64 + lane] = eidL[64 + lane];
            PC[(size_t)t * 128 + lane] = coefL[lane]; PC[(size_t)t * 128 + 64 + lane] = coefL[64 + lane];
        }
    }
}
__device__ __forceinline__ void phase_peer_v(const Args& A, LAS unsigned char* lds) {
    const int lane = threadIdx.x & 63, wave = threadIdx.x >> 6, gw = blockIdx.x * NWAVES + wave, NGW = gridDim.x * NWAVES;
    LAS int* eidL = (LAS int*)(lds + wave * 1024); LAS float* coefL = (LAS float*)(lds + wave * 1024 + 512);
    const unsigned char* VT = A.ws + WS_VT; const float* mod = (const float*)(A.ws + WS_MOD);
    const int* PE = (const int*)(A.ws + WS_PE); const float* PC = (const float*)(A.ws + WS_PC);
    const int g = lane & 31, hh = lane >> 5;
    int pe0 = 0, pe1 = 0; float pc0 = 0.f, pc1 = 0.f;
    if (gw < M) { pe0 = PE[(size_t)gw * 128 + lane]; pe1 = PE[(size_t)gw * 128 + 64 + lane]; pc0 = PC[(size_t)gw * 128 + lane]; pc1 = PC[(size_t)gw * 128 + 64 + lane]; }
    for (int t = gw; t < M; t += NGW) {
        eidL[lane] = pe0; eidL[64 + lane] = pe1; coefL[lane] = pc0; coefL[64 + lane] = pc1;
        asm volatile("s_waitcnt lgkmcnt(0)" ::: "memory");
        { const int tn = t + NGW < M ? t + NGW : t; pe0 = PE[(size_t)tn * 128 + lane]; pe1 = PE[(size_t)tn * 128 + 64 + lane]; pc0 = PC[(size_t)tn * 128 + lane]; pc1 = PC[(size_t)tn * 128 + 64 + lane]; }
        f32x4 xsv[4];
        { const float* orow_ = A.out + (size_t)t * D;
#pragma unroll
          for (int q = 0; q < 4; ++q) xsv[q] = *(const f32x4*)(orow_ + g * 32 + hh * 16 + q * 4); }
        u32x6 rb0[4], rb1[4], rb2[4], rb3[4];
#define LOAD8(buf, hb) do { _Pragma("unroll") for (int r = 0; r < 4; ++r) { const int id = eidL[(hb) * 8 + 2 * r + hh]; const unsigned char* rp = VT + (size_t)id * ROWB; \
            const u32x4 lo = *(const u32x4*)(rp + g * 16); const u32x2 hi2 = *(const u32x2*)(rp + 512 + g * 8); buf[r] = (u32x6){lo[0], lo[1], lo[2], lo[3], hi2[0], hi2[1]}; } } while (0)
#define VACC8(buf, hb) do { _Pragma("unroll") for (int r = 0; r < 4; ++r) { const _Float16 ch = (_Float16)coefL[(hb) * 8 + 2 * r + hh]; const f16x2v cf2 = {ch, ch}; \
            const f16x32v dq = __builtin_amdgcn_cvt_scalef32_pk32_f16_fp6(buf[r], 1.0f); \
            _Pragma("unroll") for (int j = 0; j < 16; ++j) yh[j] = cf2 * (f16x2v){dq[2 * j], dq[2 * j + 1]} + yh[j]; } } while (0)
        f16x2v yh[16];
#pragma unroll
        for (int j = 0; j < 16; ++j) yh[j] = (f16x2v){(_Float16)0.f, (_Float16)0.f};
        LOAD8(rb0, 0); LOAD8(rb1, 1); LOAD8(rb2, 2);
        LOAD8(rb3, 3); VACC8(rb0, 0);
        LOAD8(rb0, 4); VACC8(rb1, 1);
        LOAD8(rb1, 5); VACC8(rb2, 2);
        LOAD8(rb2, 6); VACC8(rb3, 3);
        LOAD8(rb3, 7); VACC8(rb0, 4);
        LOAD8(rb0, 8); VACC8(rb1, 5);
        LOAD8(rb1, 9); VACC8(rb2, 6);
        LOAD8(rb2, 10); VACC8(rb3, 7);
        LOAD8(rb3, 11); VACC8(rb0, 8);
        LOAD8(rb0, 12); VACC8(rb1, 9);
        LOAD8(rb1, 13); VACC8(rb2, 10);
        LOAD8(rb2, 14); VACC8(rb3, 11);
        LOAD8(rb3, 15); VACC8(rb0, 12);
        VACC8(rb1, 13);
        VACC8(rb2, 14);
        VACC8(rb3, 15);
#undef LOAD8
#undef VACC8
        float yy[16];
#pragma unroll
        for (int j = 0; j < 16; ++j) { const float y0 = (float)yh[j][0], y1 = (float)yh[j][1]; const float a = y0 + __shfl_xor(y0, 32), b = y1 + __shfl_xor(y1, 32); if ((j >> 3) == hh) { yy[2 * (j & 7)] = a; yy[2 * (j & 7) + 1] = b; } }
        const float* g2 = mod + (t >> 12) * NMOD + 5 * D; float* orow = A.out + (size_t)t * D;
        float z[16]; float ss = 0.f;
#pragma unroll
        for (int q = 0; q < 4; ++q) { const int k = g * 32 + hh * 16 + q * 4; const f32x4 xv = xsv[q], gv = *(const f32x4*)(g2 + k);
#pragma unroll
            for (int j = 0; j < 4; ++j) { const float zz = xv[j] + gv[j] * yy[q * 4 + j]; z[q * 4 + j] = zz; ss += zz * zz; } }
        const float r = rsqrtf(wave_sum(ss) * (1.f / D) + EPS);
#pragma unroll
        for (int q = 0; q < 4; ++q) { const int k = g * 32 + hh * 16 + q * 4; const f32x4 fv = *(const f32x4*)(A.fg + k);
            f32x4 o;
#pragma unroll
            for (int j = 0; j < 4; ++j) o[j] = z[q * 4 + j] * r * fv[j];
            if (!A.dry || r < 0.f) *(f32x4*)(orow + k) = o; }
    }
}
#define XB_TMO      128
#define XB_XCNT(j)  (256  + 64 * (j))
#define XB_XSUB(j)  (1280 + 64 * (j))
#define XB_XGEN(j)  (2304 + 64 * (j))
#define XB_TOP      3328
#define XB_TOPGEN   3392
#define XCD_BAR_WORDS 3456
#define XB_SPIN_CAP (1u << 22)
__device__ __forceinline__ unsigned xb_ld(unsigned* p)              { return __hip_atomic_load(p, __ATOMIC_RELAXED, __HIP_MEMORY_SCOPE_AGENT); }
__device__ __forceinline__ unsigned xb_add(unsigned* p, unsigned v) { return __hip_atomic_fetch_add(p, v, __ATOMIC_RELAXED, __HIP_MEMORY_SCOPE_AGENT); }
__device__ __forceinline__ unsigned xb_xcc_id() { return (unsigned)__builtin_amdgcn_s_getreg((3 << 11) | 20) & 0xFu; }
#define XB_SPIN(cond, bar) do { unsigned _sp = 0; while (cond) { __builtin_amdgcn_s_sleep(1); \
    if ((++_sp & 255u) == 0u) { if (xb_ld(&(bar)[XB_TMO])) break; if (_sp > XB_SPIN_CAP) { atomicAdd(&(bar)[XB_TMO], 1u); break; } } } } while (0)
struct XcdBarrier { unsigned* bar; unsigned x; volatile LAS unsigned* st; };
__device__ __forceinline__ XcdBarrier xcd_barrier_post(unsigned* bar, volatile LAS unsigned* st) {
    XcdBarrier b; b.bar = bar; b.x = xb_xcc_id(); b.st = st;
    if (threadIdx.x == 0) (void)xb_add(&bar[XB_XCNT(b.x)], 1u);
    return b;
}
__device__ __forceinline__ void xcd_barrier_complete(unsigned* bar, unsigned x, unsigned& nloc, unsigned& nx) {
    const unsigned G = gridDim.x * gridDim.y * gridDim.z;
    unsigned sum, cnt, mine, sp = 0u;
    for (;;) {
        sum = 0u; cnt = 0u; mine = 0u;
#pragma unroll
        for (unsigned j = 0; j < 16; ++j) { const unsigned c = xb_ld(&bar[XB_XCNT(j)]); sum += c; cnt += (c > 0u) ? 1u : 0u; mine = (j == x) ? c : mine; }
        if (sum == G) break;
        __builtin_amdgcn_s_sleep(1);
        if ((++sp & 255u) == 0u) { if (xb_ld(&bar[XB_TMO])) break; if (sp > XB_SPIN_CAP) { atomicAdd(&bar[XB_TMO], 1u); break; } }
    }
    nloc = mine > 0u ? mine : 1u; nx = cnt > 0u ? cnt : 1u;
}
__device__ __forceinline__ void xcd_barrier(const XcdBarrier& b) {
    asm volatile("s_waitcnt vmcnt(0)" ::: "memory");
    __syncthreads();
    if (threadIdx.x == 0) {
        unsigned* bar = b.bar;
        __builtin_amdgcn_s_waitcnt(0);
        unsigned nloc = b.st[0], nx = b.st[1];
        if (nloc == 0u) { xcd_barrier_complete(bar, b.x, nloc, nx); b.st[0] = nloc; b.st[1] = nx; }
        const unsigned old = xb_add(&bar[XB_XSUB(b.x)], 1u);
        const unsigned gen = old / nloc;
        if (old + 1u == (gen + 1u) * nloc) {
            __builtin_amdgcn_fence(__ATOMIC_RELEASE, "agent");
            asm volatile("s_waitcnt vmcnt(0)" ::: "memory");
            const unsigned og = xb_add(&bar[XB_TOP], 1u);
            const unsigned tg = og / nx;
            if (og + 1u == (tg + 1u) * nx) xb_add(&bar[XB_TOPGEN], 1u);
            else XB_SPIN(xb_ld(&bar[XB_TOPGEN]) == tg, bar);
            __builtin_amdgcn_fence(__ATOMIC_ACQUIRE, "agent");
            xb_add(&bar[XB_XGEN(b.x)], 1u);
            asm volatile("s_waitcnt vmcnt(0)" ::: "memory");
        } else {
            XB_SPIN(xb_ld(&bar[XB_XGEN(b.x)]) == gen, bar);
            __builtin_amdgcn_fence(__ATOMIC_ACQUIRE, "agent");
            asm volatile("s_waitcnt vmcnt(0)" ::: "memory");
        }
    }
    __syncthreads();
}
constexpr int MISC_OFF = 135168;

constexpr int N_PHASES = 10;
__global__ void __launch_bounds__(NWAVES * 64, 2) mega_fwd(Args A) {
    extern __shared__ __attribute__((aligned(16))) unsigned char lds[];
    LAS unsigned char* L = (LAS unsigned char*)lds;
    cg::grid_group grid = cg::this_grid();
    const int lo = A.ph_lo, hi = A.ph_hi, G = gridDim.x, c = blockIdx.x;
#ifndef PH_MASK
#define PH_MASK 0x3FF
#endif
#define IN(k) (((PH_MASK >> (k)) & 1) && lo <= (k) && (k) < hi)
    unsigned* barw = (unsigned*)(A.ws + WS_CTL);
    volatile LAS unsigned* MISC = (volatile LAS unsigned*)(L + MISC_OFF);
    if (threadIdx.x < 2) MISC[threadIdx.x] = 0u;
    if (lo == 0 && hi > 1 && blockIdx.x == 0) for (int i = threadIdx.x; i < XCD_BAR_WORDS; i += NWAVES * 64) barw[i] = 0u;
    XcdBarrier xb; xb.bar = barw; xb.x = 0; xb.st = MISC;
#define SEAM(k) do { if (IN(k) && IN((k) + 1)) { if ((k) == 0) { grid.sync(); xb = xcd_barrier_post(barw, MISC); } else xcd_barrier(xb); } } while (0)
    if (IN(0)) phase_prologue(A, L);
    SEAM(0);
    if (IN(1)) phase_hx(A);
    SEAM(1);
    if (IN(2)) { SchedInProj Sd{(const char*)(A.ws + WS_HX), (const char*)(A.ws + WS_HC), (const char*)(A.ws + WS_WIN), G, c}; EpiInProj E{A.ws};
        pg8::gemm_phase<EpiInProj, SchedInProj, true>(L, D, Sd, E); }
    SEAM(2);
    if (IN(3)) { phase_kfix(A); phase_vt(A, L); __syncthreads(); phase_conv(A, L); }
    SEAM(3);
    if (IN(4)) phase_attn(A, lds);
    SEAM(4);
    if (IN(5)) { SchedMerge Sd{(const char*)(A.ws + WS_Q), (const char*)(A.ws + WS_HX), (const char*)(A.ws + WS_WA), (const char*)(A.ws + WS_WC), G, c}; EpiMerge E{A.ws};
        pg8::gemm_phase<EpiMerge, SchedMerge, true>(L, D, Sd, E); }
    SEAM(5);
    if (IN(6)) { SchedPlain Sd{(const char*)(A.ws + WS_G), (const char*)(A.ws + WS_WO), M / 256, D / 256, G, c};
        EpiOut E{A.x, (const float*)(A.ws + WS_MOD), A.n2g, A.out, (bf16_t*)(A.ws + WS_HX), (float*)(A.ws + WS_SSQ)};
        pg8::gemm_phase<EpiOut, SchedPlain, true>(L, D, Sd, E); }
    SEAM(6);
    if (IN(7)) { SchedPlain Sd{(const char*)(A.ws + WS_HX), (const char*)(A.ws + WS_WP), M / 256, PW / 256, G, c};
        EpiScores E{(unsigned short*)(A.ws + WS_SC), (const float*)(A.ws + WS_SSQ), (const float*)(A.ws + WS_SBIAS)};
        pg8::gemm_phase<EpiScores, SchedPlain, true>(L, D, Sd, E); }
    SEAM(7);
    if (IN(8)) phase_peer_u(A, L);
    SEAM(8);
    if (IN(9)) phase_peer_v(A, L);
#undef IN
#undef SEAM
}

#ifndef MK_ONE_LAUNCH
#define MK_ONE_LAUNCH 1
#endif
extern "C" void kernel_launch(void* const* d_in, const int* in_sizes, int n_in, void* d_out, int out_size, void* d_ws, size_t ws_size, hipStream_t stream) {
    static int grid = 0;
    if (grid == 0) {
        if (n_in != 23 || out_size != M * D || ws_size < WS_END) { fprintf(stderr, "kernel_launch: unexpected shapes (n_in %d out %d ws %zu)\n", n_in, out_size, ws_size); grid = -1; return; }
        int dev = 0, cus = 0, per_cu = 0;
        hipGetDevice(&dev); hipDeviceGetAttribute(&cus, hipDeviceAttributeMultiprocessorCount, dev);
        if (hipFuncSetAttribute((const void*)mega_fwd, hipFuncAttributeMaxDynamicSharedMemorySize, LDS_BYTES) != hipSuccess) { fprintf(stderr, "kernel_launch: hipFuncSetAttribute failed\n"); grid = -1; return; }
        if (hipOccupancyMaxActiveBlocksPerMultiprocessor(&per_cu, (const void*)mega_fwd, NWAVES * 64, LDS_BYTES) != hipSuccess || per_cu < 1) { fprintf(stderr, "kernel_launch: occupancy query says %d\n", per_cu); per_cu = 1; }
        (void)hipGetLastError();
        grid = cus * 1;
        if (per_cu < 1) grid = -1;
    }
    if (grid < 0) return;
    Args a{};
    const float** f = (const float**)&a;
    for (int i = 0; i < 23; ++i) f[i] = (const float*)d_in[i];
    a.out = (float*)d_out; a.ws = (unsigned char*)d_ws;
#if MK_ONE_LAUNCH
    a.ph_lo = 0; a.ph_hi = N_PHASES;
    void* args[] = {&a};
    hipError_t e = hipLaunchCooperativeKernel((const void*)mega_fwd, dim3(grid), dim3(NWAVES * 64), args, LDS_BYTES, stream);
    if (e != hipSuccess) fprintf(stderr, "cooperative launch failed: %s (grid %d)\n", hipGetErrorString(e), grid);
#else
#ifndef REPEAT_PH
#define REPEAT_PH -1
#endif
    for (int p = 0; p < N_PHASES; ++p) { a.ph_lo = p; a.ph_hi = p + 1;
        if (p == REPEAT_PH) { a.dry = 1; hipLaunchKernelGGL(mega_fwd, dim3(grid), dim3(NWAVES * 64), LDS_BYTES, stream, a); a.dry = 0; }
        hipLaunchKernelGGL(mega_fwd, dim3(grid), dim3(NWAVES * 64), LDS_BYTES, stream, a); }
#endif
}
```

```cpp
#include <hip/hip_runtime.h>
#include <hip/hip_cooperative_groups.h>
#include <cstdio>
#include <cstdint>
namespace cg = cooperative_groups;

#define LAS __attribute__((address_space(3)))
typedef unsigned short bf16_t;
typedef short bf16x8 __attribute__((ext_vector_type(8)));
typedef short s16x4 __attribute__((ext_vector_type(4)));
typedef float f32x2 __attribute__((ext_vector_type(2)));
typedef float f32x4 __attribute__((ext_vector_type(4)));
typedef float f32x16 __attribute__((ext_vector_type(16)));
typedef unsigned u32x2 __attribute__((ext_vector_type(2)));
typedef unsigned u32x4 __attribute__((ext_vector_type(4)));
typedef __bf16 bf16x2_t __attribute__((ext_vector_type(2)));

constexpr int D = 1024, NB = 8, S = 4096, CTXL = 256, SKV = S + CTXL, HD = 128, HQ = 8, HKV = 2;
constexpr int M = NB * S;
constexpr int MC = NB * CTXL;
constexpr int INW = 5632, NMOD = 6144, NEXP = 16384, PW = 2048;
constexpr float EPS = 1e-6f;

__device__ __forceinline__ unsigned cvt_pk_bf16(float lo, float hi) { f32x2 v = {lo, hi}; bf16x2_t b = __builtin_convertvector(v, bf16x2_t); return __builtin_bit_cast(unsigned, b); }
__device__ __forceinline__ float bf_lo(unsigned u) { return __uint_as_float(u << 16); }
__device__ __forceinline__ float bf_hi(unsigned u) { return __uint_as_float(u & 0xffff0000u); }
__device__ __forceinline__ float fast_sigmoid(float x) { return __builtin_amdgcn_rcpf(1.f + __builtin_amdgcn_exp2f(-1.4426950408889634f * x)); }
__device__ __forceinline__ float wave_sum(float v) {
#pragma unroll
    for (int o = 1; o < 64; o <<= 1) v += __shfl_xor(v, o);
    return v;
}

namespace pg8 {
constexpr int BM = 256, BK = 64, HALF = 128, HTB = HALF * BK * 2  , STAGE_BYTES = 8 * HTB, NXCD = 8, WGM = 8;
__host__ __device__ __forceinline__ int lds_byte(int r, int c) { const int st = (r >> 4) * 2 + (c >> 5), rr = r & 15, cc = c & 31, ob = rr * 64 + cc * 2; return st * 1024 + (ob ^ (((ob >> 9) & 1) << 5)); }
__host__ __device__ __forceinline__ void stage_rc(int b, int& R, int& C) { const int st = b / 1024, sb = b % 1024, swz = sb ^ (((sb >> 9) & 1) << 5); R = (st >> 1) * 16 + swz / 64; C = (st & 1) * 32 + (swz % 64) / 2; }
__host__ __device__ __forceinline__ int perm32(int rho) { const int n = rho >> 4, i = rho & 15; return 8 * (i >> 2) + 4 * n + (i & 3); }

struct Unit { const char* a; const char* b; int pm, pn, kind, keep; };

__device__ __forceinline__ void tile_of(int L, int nM, int nN, int& pm, int& pn) {
    const int nwg = nM * nN; int wgid = L;
    { const int q = nwg / NXCD, r = nwg % NXCD, xcd = wgid % NXCD, off = wgid / NXCD; wgid = (xcd < r ? xcd * (q + 1) : r * (q + 1) + (xcd - r) * q) + off; }
    const int nig = WGM * nN, gid = wgid / nig, fm = gid * WGM, gsz = (nM - fm) < WGM ? (nM - fm) : WGM;
    pm = fm + ((wgid % nig) % gsz); pn = (wgid % nig) / gsz;
}

template <class Epi, class Sched, bool ALIGN_EPI>
__device__ __forceinline__ void gemm_phase(LAS unsigned char* lds, const int K, const Sched& S, const Epi& E) {
    const int tid = threadIdx.x, wid = __builtin_amdgcn_readfirstlane(tid >> 6), lane = tid & 63, wr = wid >> 2, wc = wid & 3, fr = lane & 15, fq = lane >> 4;
    const int nt = K / BK;
    unsigned voffA[2], voffB[2];
#pragma unroll
    for (int i = 0; i < 2; ++i) { int R, C; stage_rc(tid * 16 + i * 8192, R, C); const int Rb = Epi::PERM ? ((R & ~31) + perm32(R & 31)) : R;
        voffA[i] = (unsigned)(R * K + C) * 2u; voffB[i] = (unsigned)(Rb * K + C) * 2u; }
    const size_t kstep = (size_t)(BK * 2);
    const size_t hstep = (size_t)HALF * K * 2;
    const unsigned ldsw = (unsigned)wid * 1024u;
    const int aoff = lds_byte(wr * 64 + fr, fq * 8), boff = lds_byte(wc * 32 + fr, fq * 8);
#define PG8_SA(b, h) (((b) * 2 + (h)) * HTB)
#define PG8_SB(b, h) ((4 + (b) * 2 + (h)) * HTB)
#define PG8_STAGE(bufoff, gbase, voff) do { _Pragma("unroll") for (int _i = 0; _i < 2; ++_i) \
        __builtin_amdgcn_global_load_lds((const unsigned*)((const char*)(gbase) + (voff)[_i]), (LAS unsigned*)(lds + (bufoff) + ldsw + _i * 8192), 16, 0, 0); } while (0)
#define PG8_LDA(dst, b, h) do { _Pragma("unroll") for (int m = 0; m < 4; ++m) _Pragma("unroll") for (int k = 0; k < 2; ++k) dst[m][k] = *(const LAS bf16x8*)(lds + PG8_SA(b, h) + aoff + m * 2048 + k * 1024); } while (0)
#define PG8_LDB(dst, b, h) do { _Pragma("unroll") for (int n = 0; n < 2; ++n) _Pragma("unroll") for (int k = 0; k < 2; ++k) dst[n][k] = *(const LAS bf16x8*)(lds + PG8_SB(b, h) + boff + n * 2048 + k * 1024); } while (0)
#define PG8_MMA(ai, bj, At, Bt) do { __builtin_amdgcn_s_setprio(1); _Pragma("unroll") for (int m = 0; m < 4; ++m) _Pragma("unroll") for (int n = 0; n < 2; ++n) _Pragma("unroll") for (int k = 0; k < 2; ++k) \
        acc[ai][bj][m][n] = __builtin_amdgcn_mfma_f32_16x16x32_bf16(Bt[n][k], At[m][k], acc[ai][bj][m][n], 0, 0, 0); __builtin_amdgcn_s_setprio(0); } while (0)
#define PG8_WAIT_V(n) asm volatile("s_waitcnt vmcnt(" #n ")" ::: "memory")
#define PG8_WAIT_L(n) asm volatile("s_waitcnt lgkmcnt(" #n ")" ::: "memory")
#define PG8_BAR __builtin_amdgcn_s_barrier()
#define PG8_SCHED __builtin_amdgcn_sched_barrier(0)
    Unit cur, nxt; int ui = 0;
    if (!S.next(0, cur)) return;
    f32x4 acc[2][2][4][2];
#pragma unroll
    for (int a = 0; a < 2; ++a)
#pragma unroll
        for (int b = 0; b < 2; ++b)
#pragma unroll
            for (int m = 0; m < 4; ++m)
#pragma unroll
                for (int n = 0; n < 2; ++n) acc[a][b][m][n] = (f32x4){0.f, 0.f, 0.f, 0.f};
    bf16x8 At[4][2], B0[2][2], B1[2][2];
    const char* cA = cur.a; const char* cB = cur.b;
    PG8_STAGE(PG8_SB(0, 0), cB, voffB); PG8_STAGE(PG8_SB(0, 1), cB + hstep, voffB); PG8_STAGE(PG8_SA(0, 0), cA, voffA); PG8_STAGE(PG8_SA(0, 1), cA + hstep, voffA);
    if (wr == 1) PG8_BAR;
    PG8_WAIT_V(2); PG8_BAR;
    PG8_STAGE(PG8_SB(1, 0), cB + kstep, voffB); PG8_STAGE(PG8_SA(1, 0), cA + kstep, voffA); PG8_STAGE(PG8_SB(1, 1), cB + hstep + kstep, voffB);
    PG8_WAIT_V(6); PG8_BAR;
    for (;;) {
        const bool has_next = S.next(ui + 1, nxt);
        const char* nA = has_next ? nxt.a : cA; const char* nB = has_next ? nxt.b : cB;
        for (int t = 0; t < nt; t += 2) {
            const bool last = (t == nt - 2);
            const char* a1 = cA + (size_t)(t + 1) * kstep;
            const char* a2 = last ? nA : cA + (size_t)(t + 2) * kstep; const char* b2 = last ? nB : cB + (size_t)(t + 2) * kstep;
            const char* a3 = a2 + kstep; const char* b3 = b2 + kstep;
            PG8_LDB(B0, 0, 0); PG8_LDB(B1, 0, 1); PG8_SCHED; PG8_LDA(At, 0, 0); PG8_STAGE(PG8_SA(1, 1), a1 + hstep, voffA);
            PG8_WAIT_V(8); PG8_WAIT_L(0); PG8_BAR; PG8_MMA(0, 0, At, B0); PG8_MMA(0, 1, At, B1); PG8_BAR; PG8_SCHED;
            PG8_LDA(At, 0, 1); PG8_STAGE(PG8_SB(0, 0), b2, voffB); PG8_STAGE(PG8_SB(0, 1), b2 + hstep, voffB); PG8_STAGE(PG8_SA(0, 0), a2, voffA);
            PG8_WAIT_V(8); PG8_WAIT_L(0); PG8_BAR; PG8_MMA(1, 0, At, B0); PG8_MMA(1, 1, At, B1); PG8_BAR; PG8_SCHED;
            PG8_LDB(B0, 1, 0); PG8_LDB(B1, 1, 1); PG8_SCHED; PG8_LDA(At, 1, 0); PG8_STAGE(PG8_SA(0, 1), a2 + hstep, voffA);
            PG8_WAIT_V(8); PG8_WAIT_L(0); PG8_BAR; PG8_MMA(0, 0, At, B0); PG8_MMA(0, 1, At, B1); PG8_BAR; PG8_SCHED;
            PG8_LDA(At, 1, 1); PG8_STAGE(PG8_SB(1, 0), b3, voffB); PG8_STAGE(PG8_SB(1, 1), b3 + hstep, voffB); PG8_STAGE(PG8_SA(1, 0), a3, voffA);
            PG8_WAIT_V(8); PG8_WAIT_L(0); PG8_BAR; PG8_MMA(1, 0, At, B0); PG8_MMA(1, 1, At, B1); PG8_BAR; PG8_SCHED;
        }
        if constexpr (ALIGN_EPI) { if (wr == 0) PG8_BAR; }
        E(acc, cur, wr, wc, fr, fq);
        if (!has_next) break;
        if (!cur.keep) {
#pragma unroll
        for (int a = 0; a < 2; ++a)
#pragma unroll
            for (int b = 0; b < 2; ++b)
#pragma unroll
                for (int m = 0; m < 4; ++m)
#pragma unroll
                    for (int n = 0; n < 2; ++n) acc[a][b][m][n] = (f32x4){0.f, 0.f, 0.f, 0.f};
        }
        cur = nxt; cA = nA; cB = nB; ++ui;
        if constexpr (ALIGN_EPI) { if (wr == 1) PG8_BAR; }
    }
    PG8_WAIT_V(0);
    if constexpr (!ALIGN_EPI) { if (wr == 0) PG8_BAR; }
    PG8_BAR;
#undef PG8_SA
#undef PG8_SB
#undef PG8_STAGE
#undef PG8_LDA
#undef PG8_LDB
#undef PG8_MMA
#undef PG8_WAIT_V
#undef PG8_WAIT_L
#undef PG8_BAR
#undef PG8_SCHED
}
}
namespace att {
typedef int v8i __attribute__((ext_vector_type(8)));
constexpr int NW = 8, QBLK = 32, KVBLK = 64;
constexpr float SCALE = 0.088388347648318440f;
constexpr float SC8 = SCALE / 256.f;
constexpr float THR = 3.f;
constexpr int LDQ = D, LDO = D;
constexpr int SHM_V = 8192, SHM_K = 8192, NRING = 3, OFF_K = NRING * SHM_V, OFF_WS = OFF_K + NRING * SHM_K, OST_OFF = OFF_WS + NW * 64 * 4, LDS_TOTAL = OST_OFF + NW * 8192;
#define SBAR() __builtin_amdgcn_sched_barrier(0)
#define MFMA8(a, b, c) __builtin_amdgcn_mfma_scale_f32_32x32x64_f8f6f4((a), (b), (c), 0, 0, 0, 0x7f7f7f7f, 0, 0x7f7f7f7f)
__device__ __forceinline__ int crow(int r, int hi) { return (r & 3) + 8 * (r >> 2) + 4 * hi; }
__device__ __forceinline__ int k_lds(int row, int chunk) { return row * 128 + ((chunk ^ ((row >> 1) & 7)) << 4); }
__device__ __forceinline__ int v_lds(int d, int slot) { return d * 64 + ((slot ^ ((d >> 2) & 3)) << 4); }
__device__ __forceinline__ float max3f(float a, float b, float c) { float r; asm("v_max3_f32 %0, %1, %2, %3" : "=v"(r) : "v"(a), "v"(b), "v"(c)); return r; }
__device__ __forceinline__ int pk4_fp8(float a, float b, float c, float d) { int w = __builtin_amdgcn_cvt_pk_fp8_f32(a, b, 0, false); return __builtin_amdgcn_cvt_pk_fp8_f32(c, d, w, true); }

__device__ __forceinline__ void partialSM(f32x16& p0, f32x16& p1, float& m_reg, float& mn, float& alpha) {
  constexpr float C = SC8 * 1.4426950408889634f;
  asm volatile("s_nop 15\n\ts_nop 7" : "+v"(p0), "+v"(p1));
  float mx[8];
#pragma unroll
  for (int i = 0; i < 8; ++i) mx[i] = max3f(p0[i], p0[8 + i], p1[i]);
  float m4[4];
#pragma unroll
  for (int i = 0; i < 4; ++i) m4[i] = max3f(mx[i], mx[4 + i], p1[8 + i]);
  float m2a = max3f(m4[0], m4[1], p1[12]), m2b = max3f(m4[2], m4[3], p1[13]);
  float pmax = max3f(m2a, m2b, p1[14]); pmax = max3f(pmax, p1[15], p1[15]);
  { auto rr = __builtin_amdgcn_permlane32_swap(__float_as_uint(pmax), __float_as_uint(pmax), false, false);
    pmax = fmaxf(__uint_as_float(rr[0]), __uint_as_float(rr[1])); }
  if (__builtin_expect(__all(pmax - m_reg <= THR / SC8), 1)) { mn = m_reg; alpha = 1.f; }
  else { mn = fmaxf(m_reg, pmax); alpha = __builtin_amdgcn_exp2f((m_reg - mn) * C); m_reg = mn; }
  float mnC = 4.f - mn * C;
  for (int r = 0; r < 16; ++r) p0[r] = fmaf(p0[r], C, mnC); for (int r = 0; r < 16; ++r) p1[r] = fmaf(p1[r], C, mnC);
  for (int r = 0; r < 16; ++r) p0[r] = __builtin_amdgcn_exp2f(p0[r]);
}
__device__ __forceinline__ void finishSM(f32x16& p0, f32x16& p1, float alpha, float& l_reg, v8i& pa) {
  for (int r = 0; r < 16; ++r) p1[r] = __builtin_amdgcn_exp2f(p1[r]);
  float sm[8];
#pragma unroll
  for (int i = 0; i < 8; ++i) sm[i] = (p0[i] + p0[8 + i]) + (p1[i] + p1[8 + i]);
  float ps = ((sm[0] + sm[1]) + (sm[2] + sm[3])) + ((sm[4] + sm[5]) + (sm[6] + sm[7]));
  { auto rr = __builtin_amdgcn_permlane32_swap(__float_as_uint(ps), __float_as_uint(ps), false, false);
    ps = __uint_as_float(rr[0]) + __uint_as_float(rr[1]); }
  l_reg = l_reg * alpha + ps;
  pa[0] = pk4_fp8(p0[0], p0[1], p0[2], p0[3]); pa[1] = pk4_fp8(p0[4], p0[5], p0[6], p0[7]); pa[2] = pk4_fp8(p0[8], p0[9], p0[10], p0[11]); pa[3] = pk4_fp8(p0[12], p0[13], p0[14], p0[15]);
  pa[4] = pk4_fp8(p1[0], p1[1], p1[2], p1[3]); pa[5] = pk4_fp8(p1[4], p1[5], p1[6], p1[7]); pa[6] = pk4_fp8(p1[8], p1[9], p1[10], p1[11]); pa[7] = pk4_fp8(p1[12], p1[13], p1[14], p1[15]);
}
__device__ __forceinline__ v8i ld32(const char* p0, const char* p1) { const u32x4 a = *reinterpret_cast<const u32x4*>(p0), b = *reinterpret_cast<const u32x4*>(p1);
  v8i r; r[0] = (int)a[0]; r[1] = (int)a[1]; r[2] = (int)a[2]; r[3] = (int)a[3]; r[4] = (int)b[0]; r[5] = (int)b[1]; r[6] = (int)b[2]; r[7] = (int)b[3]; return r; }
__device__ __forceinline__ void qkt(f32x16& p0, f32x16& p1, const char* Ks, const v8i* qf, int r32, int hi) {
  p0 = f32x16{}; p1 = f32x16{};
#pragma unroll
  for (int s = 0; s < 2; ++s) {
    const v8i a0 = ld32(Ks + k_lds(r32, 4 * s + hi), Ks + k_lds(r32, 4 * s + 2 + hi)), a1 = ld32(Ks + k_lds(32 + r32, 4 * s + hi), Ks + k_lds(32 + r32, 4 * s + 2 + hi));
    p0 = MFMA8(a0, qf[s], p0); p1 = MFMA8(a1, qf[s], p1); }
}
__device__ __forceinline__ void pv(f32x16* o, const char* Vs, const v8i pa, int r32, int hi) {
#pragma unroll
  for (int d0 = 0; d0 < 4; ++d0) { const int d = 32 * d0 + r32; const v8i b = ld32(Vs + v_lds(d, 2 * hi), Vs + v_lds(d, 2 * hi + 1)); o[d0] = MFMA8(pa, b, o[d0]); }
}

__device__ __forceinline__ void attn_unit(const bf16_t* Qb, const unsigned char* __restrict__ K8, const unsigned char* __restrict__ VT, bf16_t* Ob, int t0, int seq,
                                          const float* __restrict__ qng, const float* __restrict__ cst, const float* __restrict__ snt, char* lds) {
  int tid_ = threadIdx.x; asm volatile("" : "+v"(tid_));
  const int tid = tid_, wid = tid >> 6, lane = tid & 63, r32 = lane & 31, hi = lane >> 5;
  char* V_lds = lds; char* K_lds = lds + OFF_K;
  float* ws = (float*)(lds + OFF_WS) + wid * 64; float* li_l = ws; float* al_l = ws + 32;
  float m_reg = -1e30f, l_reg = 0; f32x16 o[4] = {}; v8i qf[2];
  {
    const bf16_t* Qw = Qb + (long)(wid * QBLK + r32) * LDQ + 16 * hi;
    float y[2][32]; float ss = 0.f;
#pragma unroll
    for (int s = 0; s < 2; ++s)
#pragma unroll
      for (int part = 0; part < 2; ++part)
#pragma unroll
        for (int c = 0; c < 2; ++c) { const u32x4 w = *reinterpret_cast<const u32x4*>(Qw + 64 * s + 32 * part + 8 * c);
#pragma unroll
          for (int j = 0; j < 4; ++j) { const float a = bf_lo(w[j]), b = bf_hi(w[j]); y[s][16 * part + 8 * c + 2 * j] = a; y[s][16 * part + 8 * c + 2 * j + 1] = b; ss += a * a + b * b; } }
    ss += __shfl_xor(ss, 32);
    const float rstd = rsqrtf(ss * (1.f / HD) + EPS) * 16.f;
    const int t = t0 + wid * QBLK + r32;
#pragma unroll
    for (int s = 0; s < 2; ++s) { const int pos = s == 0 ? (t >> 6) : (t & 63);
#pragma unroll
      for (int c = 0; c < 4; ++c) { const int i0 = 16 * hi + 4 * c;
        const f32x4 g1 = *reinterpret_cast<const f32x4*>(qng + 64 * s + i0), g2 = *reinterpret_cast<const f32x4*>(qng + 64 * s + 32 + i0);
        const f32x4 c4 = *reinterpret_cast<const f32x4*>(cst + pos * 32 + i0), s4 = *reinterpret_cast<const f32x4*>(snt + pos * 32 + i0);
#pragma unroll
        for (int j = 0; j < 4; ++j) { const float x1 = y[s][4 * c + j] * rstd * g1[j], x2 = y[s][16 + 4 * c + j] * rstd * g2[j]; y[s][4 * c + j] = x1 * c4[j] - x2 * s4[j]; y[s][16 + 4 * c + j] = x1 * s4[j] + x2 * c4[j]; } }
#pragma unroll
      for (int w = 0; w < 8; ++w) qf[s][w] = pk4_fp8(y[s][4 * w], y[s][4 * w + 1], y[s][4 * w + 2], y[s][4 * w + 3]); }
  }
  const int krow = tid >> 3, kch = tid & 7, kst = k_lds(krow, kch), vst = v_lds(tid >> 2, tid & 3);
  const unsigned char* kg = K8 + (long)krow * 256 + kch * 16; const unsigned char* vg = VT + tid * 16;
  struct { u32x4 k, v; } sr_[2];
#define SLOAD(i, kt) do { sr_[i].k = *reinterpret_cast<const u32x4*>(kg + (long)(kt) * (KVBLK * 256)); sr_[i].v = *reinterpret_cast<const u32x4*>(vg + (long)(kt) * 8192); } while (0)
#define SWRITE(boff, i) do { *(u32x4*)(V_lds + (boff) + vst) = sr_[i].v; *(u32x4*)(K_lds + (boff) + kst) = sr_[i].k; } while (0)
#define SWAIT() asm volatile("s_waitcnt vmcnt(2)" ::: "memory")
#define RESC(a) do { if (__any((a) < 1.f)) { if (hi == 0) al_l[r32] = (a); asm volatile("s_waitcnt lgkmcnt(0)" ::: "memory"); \
    for (int d = 0; d < 4; ++d) for (int r = 0; r < 16; ++r) o[d][r] *= al_l[crow(r, hi)]; } } while (0)
  f32x16 pA0, pA1, pB0, pB1; float mnA, mnB, alA, alB; v8i pa; const int NT = seq / KVBLK;
  constexpr int SE = 0, SO = 1;
  int bprev = 0, bcur = SHM_K, bnext = 2 * SHM_K;
#define ROT() do { const int t_ = bprev; bprev = bcur; bcur = bnext; bnext = t_; } while (0)
  SLOAD(SE, 0); asm volatile("s_waitcnt vmcnt(0)" ::: "memory"); SWRITE(0, SE); __syncthreads();
  qkt(pA0, pA1, K_lds, qf, r32, hi); partialSM(pA0, pA1, m_reg, mnA, alA);
  SLOAD(SO, 1); if (2 < NT) SLOAD(SE, 2);
  SWAIT(); SWRITE(SHM_K, SO); __syncthreads();
  for (int j = 1; j + 1 < NT; j += 2) {
    SBAR(); qkt(pB0, pB1, K_lds + bcur, qf, r32, hi);
    finishSM(pA0, pA1, alA, l_reg, pa); SBAR();
    SLOAD(SO, j + 2); SBAR();
    pv(o, V_lds + bprev, pa, r32, hi); partialSM(pB0, pB1, m_reg, mnB, alB);
    SWAIT(); SWRITE(bnext, SE);
    RESC(alB); __syncthreads(); ROT();
    SBAR(); qkt(pA0, pA1, K_lds + bcur, qf, r32, hi);
    finishSM(pB0, pB1, alB, l_reg, pa); SBAR();
    if (j + 3 < NT) SLOAD(SE, j + 3); SBAR();
    pv(o, V_lds + bprev, pa, r32, hi); partialSM(pA0, pA1, m_reg, mnA, alA);
    SWAIT(); SWRITE(bnext, SO);
    RESC(alA); __syncthreads(); ROT();
  }
  SBAR(); qkt(pB0, pB1, K_lds + bcur, qf, r32, hi);
  finishSM(pA0, pA1, alA, l_reg, pa); SBAR();
  pv(o, V_lds + bprev, pa, r32, hi); partialSM(pB0, pB1, m_reg, mnB, alB);
  RESC(alB);
  finishSM(pB0, pB1, alB, l_reg, pa); SBAR();
  pv(o, V_lds + bcur, pa, r32, hi);
  __syncthreads();
#undef ROT
  if (hi == 0) li_l[r32] = l_reg; asm volatile("s_waitcnt lgkmcnt(0)" ::: "memory");
  float rli[16];
#pragma unroll
  for (int r = 0; r < 16; ++r) rli[r] = __builtin_amdgcn_rcpf(16.f * li_l[crow(r, hi)]);
  { bf16_t* stg = (bf16_t*)(lds + OST_OFF) + wid * 4096;
#pragma unroll
    for (int r = 0; r < 16; ++r) { const int orow = crow(r, hi);
#pragma unroll
      for (int d0 = 0; d0 < 4; ++d0) stg[orow * 128 + d0 * 32 + r32] = (bf16_t)(cvt_pk_bf16(o[d0][r] * rli[r], 0.f) & 0xffffu); }
    asm volatile("s_waitcnt lgkmcnt(0)" ::: "memory");
    bf16_t* Ow = Ob + (long)(wid * QBLK) * LDO;
#pragma unroll
    for (int i = 0; i < 8; ++i) { const int row = i * 4 + (lane >> 4), ch = lane & 15; const u32x4 v = *(const u32x4*)(stg + row * 128 + ch * 8); *(u32x4*)(Ow + (long)row * LDO + ch * 8) = v; }
  }
#undef SLOAD
#undef SWRITE
#undef SWAIT
#undef RESC
}
#undef SBAR
#undef MFMA8
}
constexpr size_t MiB = 1u << 20;
constexpr size_t WS_CTL = 0, CTL_ZERO_BYTES = 64 * 1024;
constexpr size_t WS_MOD = 1 * MiB;
constexpr size_t WS_ROPE = WS_MOD + 256 * 1024;
constexpr size_t WS_SBIAS = WS_MOD + 512 * 1024;
constexpr size_t WS_HC = 2 * MiB;
constexpr size_t WS_WIN = 6 * MiB;
constexpr size_t WS_WA = 17 * MiB, WS_WC = 19 * MiB, WS_WO = 21 * MiB;
constexpr size_t WS_WP = 23 * MiB;
constexpr size_t WS_UT = 27 * MiB, WS_VT = 59 * MiB;
constexpr size_t WS_TSCALE = 16 * MiB;
constexpr size_t WS_KB = 91 * MiB, WS_VB = 108 * MiB;
constexpr size_t WS_HX = 125 * MiB;
constexpr size_t WS_Q = 189 * MiB;
constexpr size_t WS_G = 253 * MiB;
constexpr size_t WS_RT = 317 * MiB;
constexpr size_t WS_XSB = WS_RT;
constexpr size_t WS_SGC = 381 * MiB;
constexpr size_t WS_SC = 189 * MiB;
constexpr size_t WS_SSQ = 445 * MiB;
constexpr size_t WS_K8 = 447 * MiB;
constexpr size_t WS_VT8 = 456 * MiB;
constexpr size_t WS_PE = 465 * MiB, WS_PC = 481 * MiB;
constexpr size_t WS_END = 497 * MiB;

constexpr int NWAVES = 8;
constexpr int LDS_BYTES = 147456;

struct Args {
    const float *x, *c, *ctx, *c_ctx, *w_mod, *b_mod, *n1g, *n2g, *w_in, *qng, *kng, *w_ao, *cdw, *cb, *clg, *clb, *w_co, *w_o, *wq, *keys, *ut, *vt, *fg;
    float* out; unsigned char* ws; int ph_lo, ph_hi, dry, pad;
};

__host__ __device__ __forceinline__ int win_row(int n) {
    if (n < 1536) return n;
    const int base = n < 3584 ? 1536 : 3584, m = n - base, half = m >> 10, idx = m & 1023;
    return base + (idx >> 7) * 256 + half * 128 + (idx & 127);
}

__device__ __forceinline__ void task_mod(const Args& A, int task, int lane, const LAS float* sc) {
    const int n0 = task * 8, col = lane & 7, kg = lane >> 3;
    float acc[9];
#pragma unroll
    for (int b = 0; b < 9; ++b) acc[b] = 0.f;
    const float* wp = A.w_mod + (size_t)kg * NMOD + n0 + col;
    for (int i0 = 0; i0 < 128; i0 += 8) {
        float w[8];
#pragma unroll
        for (int u = 0; u < 8; ++u) w[u] = wp[(size_t)(i0 + u) * 8 * NMOD];
#pragma unroll
        for (int u = 0; u < 8; ++u) { const int k = kg + 8 * (i0 + u);
#pragma unroll
            for (int b = 0; b < 9; ++b) acc[b] += sc[b * D + k] * w[u]; }
    }
#pragma unroll
    for (int b = 0; b < 9; ++b) { float v = acc[b]; v += __shfl_xor(v, 8); v += __shfl_xor(v, 16); v += __shfl_xor(v, 32); acc[b] = v; }
    if (lane < 8) { float* mod = (float*)(A.ws + WS_MOD); const float bm = A.b_mod[n0 + col];
#pragma unroll
        for (int b = 0; b < 9; ++b) mod[b * NMOD + n0 + col] = acc[b] + bm; }
}
__device__ __forceinline__ void task_transpose(const float* W, int K, int N, bf16_t* WT, int k0, int n0, int row0, LAS float* scr, int lane) {
#pragma unroll 8
    for (int i = 0; i < 32; ++i) { const int kk = 2 * i + (lane >> 5); scr[kk * 33 + (lane & 31)] = W[(size_t)(k0 + kk) * N + n0 + (lane & 31)]; }
    asm volatile("s_waitcnt lgkmcnt(0)" ::: "memory");
    const int c = lane & 7;
#pragma unroll
    for (int j = 0; j < 4; ++j) { const int n = (lane >> 3) + 8 * j; const LAS float* s = scr + (8 * c) * 33 + n;
        u32x4 o; o.x = cvt_pk_bf16(s[0 * 33], s[1 * 33]); o.y = cvt_pk_bf16(s[2 * 33], s[3 * 33]); o.z = cvt_pk_bf16(s[4 * 33], s[5 * 33]); o.w = cvt_pk_bf16(s[6 * 33], s[7 * 33]);
        *(u32x4*)(WT + (size_t)(row0 + n) * K + k0 + 8 * c) = o; }
    asm volatile("s_waitcnt lgkmcnt(0)" ::: "memory");
}
typedef float f32x16v __attribute__((ext_vector_type(16)));
typedef unsigned u32x6 __attribute__((ext_vector_type(6)));
constexpr int ROWB = 768;
__device__ __forceinline__ void task_quant_rows4(const float* src, unsigned char* dst, float* scale_out, int lane) {
    const int g = lane & 31, hh = lane >> 5;
    f32x4 v[2][8];
#pragma unroll
    for (int r = 0; r < 2; ++r)
#pragma unroll
        for (int i = 0; i < 8; ++i) v[r][i] = *(const f32x4*)(src + (size_t)(2 * r + hh) * D + g * 32 + i * 4);
#pragma unroll
    for (int r = 0; r < 2; ++r) {
        float am = 0.f;
#pragma unroll
        for (int i = 0; i < 8; ++i) am = fmaxf(fmaxf(am, fmaxf(fabsf(v[r][i][0]), fabsf(v[r][i][1]))), fmaxf(fabsf(v[r][i][2]), fabsf(v[r][i][3])));
#pragma unroll
        for (int o = 1; o < 32; o <<= 1) am = fmaxf(am, __shfl_xor(am, o));
        const float inv = am > 0.f ? 7.5f / am : 0.f;
        f32x16v a, b;
#pragma unroll
        for (int i = 0; i < 4; ++i)
#pragma unroll
            for (int j = 0; j < 4; ++j) { const int e0 = 4 * i + j;
                a[e0] = v[r][(2 * e0) >> 2][(2 * e0) & 3] * inv; b[e0] = v[r][(2 * e0 + 1) >> 2][(2 * e0 + 1) & 3] * inv; }
        const u32x6 p = __builtin_amdgcn_cvt_scalef32_2xpk16_fp6_f32(a, b, 1.0f);
        unsigned char* rowp = dst + (size_t)(2 * r + hh) * ROWB;
        *(u32x4*)(rowp + g * 16) = (u32x4){p[0], p[1], p[2], p[3]}; *(u32x2*)(rowp + 512 + g * 8) = (u32x2){p[4], p[5]};
        if (g == 0) scale_out[2 * r + hh] = am * (1.f / 7.5f);
    }
}
__device__ __forceinline__ bf16x8 ld8_f32_bf16(const float* p) { const f32x4 a = *(const f32x4*)p, b = *(const f32x4*)(p + 4); u32x4 w = {cvt_pk_bf16(a[0], a[1]), cvt_pk_bf16(a[2], a[3]), cvt_pk_bf16(b[0], b[1]), cvt_pk_bf16(b[2], b[3])}; return *reinterpret_cast<bf16x8*>(&w); }
__device__ __forceinline__ void task_wprime(const Args& A, int id, int lane) {
    const int hp = id >> 7, rem = id & 127, n0 = (rem >> 5) * 32, k0 = (rem & 31) * 32, r32 = lane & 31, hi = lane >> 5;
    f32x16 acc = {};
    const float* ka = A.keys + ((size_t)(hp * 128 + n0 + r32)) * 128 + hi * 8;
    const float* wb = A.wq + (size_t)(k0 + r32) * PW + hp * 128 + hi * 8;
#pragma unroll
    for (int s = 0; s < 8; ++s) acc = __builtin_amdgcn_mfma_f32_32x32x16_bf16(ld8_f32_bf16(ka + s * 16), ld8_f32_bf16(wb + s * 16), acc, 0, 0, 0);
    bf16_t* o = (bf16_t*)(A.ws + WS_WP);
#pragma unroll
    for (int r = 0; r < 16; ++r) { const int n = (r & 3) + 8 * (r >> 2) + 4 * hi; o[(size_t)(hp * 128 + n0 + n) * D + k0 + r32] = (bf16_t)(cvt_pk_bf16(acc[r], 0.f) & 0xffffu); }
}
__device__ __forceinline__ void phase_prologue(const Args& A, LAS unsigned char* lds) {
    const int tid = threadIdx.x, lane = tid & 63, wave = __builtin_amdgcn_readfirstlane(tid >> 6);
    LAS float* sc = (LAS float*)lds;
    for (int i = tid; i < 9 * D; i += 512) { const float v = i < 8 * D ? A.c[i] : A.c_ctx[i - 8 * D]; sc[i] = v / (1.f + __expf(-v)); }
    __syncthreads();
    LAS float* scr = (LAS float*)(lds + 36864 + wave * 8448);
    constexpr int T_MOD = NMOD / 8, T_WIN = (D / 64) * (INW / 32), T_SQ = (D / 64) * (D / 32), T_UV = 2 * NEXP / 4, T_WP = 2048, T_ROPE = 1;
    constexpr int NT = T_MOD + T_WIN + 3 * T_SQ + T_UV + T_WP + T_ROPE;
    const int G = gridDim.x;
    for (int task = wave * G + blockIdx.x; task < NT; task += NWAVES * G) {
        int r = task;
        if (r < T_MOD) { task_mod(A, r, lane, sc); continue; } r -= T_MOD;
        if (r < T_WIN) { const int nblk = INW / 32, kb = r / nblk, nb = r % nblk; task_transpose(A.w_in, D, INW, (bf16_t*)(A.ws + WS_WIN), 64 * kb, 32 * nb, win_row(32 * nb), scr, lane); continue; } r -= T_WIN;
        if (r < 3 * T_SQ) { const int wsel = r / T_SQ, q = r % T_SQ, kb = q / 32, nb = q % 32;
            const float* W = wsel == 0 ? A.w_ao : (wsel == 1 ? A.w_co : A.w_o); bf16_t* WT = (bf16_t*)(A.ws + (wsel == 0 ? WS_WA : (wsel == 1 ? WS_WC : WS_WO)));
            task_transpose(W, D, D, WT, 64 * kb, 32 * nb, 32 * nb, scr, lane); continue; } r -= 3 * T_SQ;
        if (r < T_UV) { const int tb = r / (NEXP / 4), row = (r % (NEXP / 4)) * 4; unsigned char* tbase = A.ws + (tb ? WS_VT : WS_UT);
            task_quant_rows4((tb ? A.vt : A.ut) + (size_t)row * D, tbase + (size_t)row * ROWB, (float*)(tbase + WS_TSCALE) + row, lane); continue; } r -= T_UV;
        if (r < T_WP) { task_wprime(A, r, lane); continue; } r -= T_WP;
        { float* cs = (float*)(A.ws + WS_ROPE); float* sn = cs + 2048;
          for (int e = lane; e < 2048; e += 64) { const int p = e >> 5, i = e & 31; const float inv = powf(10000.f, -(float)(2 * i) / 64.f); const float a = (float)p * inv; cs[e] = cosf(a); sn[e] = sinf(a); } }
    }
}
__device__ __forceinline__ void normmod_row(const float* xr, const float* g, const float* modr, int sh_off, int sc_off, bf16_t* orow, int lane) {
    f32x4 v[4]; float ss = 0.f;
#pragma unroll
    for (int i = 0; i < 4; ++i) { v[i] = *(const f32x4*)(xr + (i * 64 + lane) * 4); ss += (v[i][0] * v[i][0] + v[i][1] * v[i][1]) + (v[i][2] * v[i][2] + v[i][3] * v[i][3]); }
    const float r = rsqrtf(wave_sum(ss) * (1.f / D) + EPS);
#pragma unroll
    for (int i = 0; i < 4; ++i) { const int k = (i * 64 + lane) * 4; const f32x4 gg = *(const f32x4*)(g + k), s1 = *(const f32x4*)(modr + sc_off + k), h1 = *(const f32x4*)(modr + sh_off + k);
        float y[4];
#pragma unroll
        for (int j = 0; j < 4; ++j) y[j] = v[i][j] * r * gg[j] * (1.f + s1[j]) + h1[j];
        u32x2 o = {cvt_pk_bf16(y[0], y[1]), cvt_pk_bf16(y[2], y[3])}; *(u32x2*)(orow + k) = o; }
}
__device__ __forceinline__ void phase_hx(const Args& A) {
    const int lane = threadIdx.x & 63, gw = blockIdx.x * NWAVES + (threadIdx.x >> 6), NGW = gridDim.x * NWAVES;
    const float* mod = (const float*)(A.ws + WS_MOD);
    for (int m = gw; m < M + MC; m += NGW) {
        if (m < M) normmod_row(A.x + (size_t)m * D, A.n1g, mod + (m >> 12) * NMOD, 0, D, (bf16_t*)(A.ws + WS_HX) + (size_t)m * D, lane);
        else { const int r = m - M; normmod_row(A.ctx + (size_t)r * D, A.n1g, mod + 8 * NMOD, 0, D, (bf16_t*)(A.ws + WS_HC) + (size_t)r * D, lane); }
    }
    const bf16_t* WP = (const bf16_t*)(A.ws + WS_WP); float* sb = (float*)(A.ws + WS_SBIAS);
    for (int col = gw; col < PW; col += NGW) {
        const u32x4 w0 = *(const u32x4*)(WP + (size_t)col * D + lane * 16), w1 = *(const u32x4*)(WP + (size_t)col * D + lane * 16 + 8);
        float wv[16];
#pragma unroll
        for (int j = 0; j < 4; ++j) { wv[2 * j] = bf_lo(w0[j]); wv[2 * j + 1] = bf_hi(w0[j]); wv[8 + 2 * j] = bf_lo(w1[j]); wv[8 + 2 * j + 1] = bf_hi(w1[j]); }
#pragma unroll 1
        for (int b = 0; b < NB; ++b) { const float* sh = mod + b * NMOD + 3 * D + lane * 16; float s = 0.f;
#pragma unroll
            for (int q = 0; q < 4; ++q) { const f32x4 v = *(const f32x4*)(sh + 4 * q); s += v[0] * wv[4 * q] + v[1] * wv[4 * q + 1] + v[2] * wv[4 * q + 2] + v[3] * wv[4 * q + 3]; }
            s = wave_sum(s); if (lane == 0) sb[b * PW + col] = s; }
    }
}
__device__ __forceinline__ void phase_kfix(const Args& A) {
    const int lane = threadIdx.x & 63, gw = blockIdx.x * NWAVES + (threadIdx.x >> 6), NGW = gridDim.x * NWAVES, li = lane & 15, sub = lane >> 4;
    const bf16_t* KB = (const bf16_t*)(A.ws + WS_KB); const float* cs = (const float*)(A.ws + WS_ROPE); const float* sn = cs + 2048;
    constexpr int NITEM = NB * SKV * HKV;
    const f32x4 g0 = *(const f32x4*)(A.kng + li * 8), g1 = *(const f32x4*)(A.kng + li * 8 + 4);
    const f32x4 p0 = *(const f32x4*)(A.kng + (li ^ 4) * 8), p1 = *(const f32x4*)(A.kng + (li ^ 4) * 8 + 4);
    for (int it = gw * 4 + sub; it < NITEM; it += NGW * 4) {
        const int row = it >> 1, h = it & 1, t = row % SKV;
        const bf16_t* p = KB + (size_t)row * 256 + h * HD + li * 8;
        const u32x4 w = *(const u32x4*)p;
        float x[8], xp[8]; float ss = 0.f;
#pragma unroll
        for (int j = 0; j < 4; ++j) { x[2 * j] = bf_lo(w[j]); x[2 * j + 1] = bf_hi(w[j]); ss += x[2 * j] * x[2 * j] + x[2 * j + 1] * x[2 * j + 1];
            const unsigned pw = (unsigned)__shfl_xor((int)w[j], 4); xp[2 * j] = bf_lo(pw); xp[2 * j + 1] = bf_hi(pw); }
        ss += __shfl_xor(ss, 1); ss += __shfl_xor(ss, 2); ss += __shfl_xor(ss, 4); ss += __shfl_xor(ss, 8);
        const float r = rsqrtf(ss * (1.f / HD) + EPS);
        float y[8];
#pragma unroll
        for (int j = 0; j < 8; ++j) { x[j] *= r * (j < 4 ? g0[j] : g1[j - 4]); xp[j] *= r * (j < 4 ? p0[j] : p1[j - 4]); y[j] = x[j]; }
        if (t < S) {
            const int blk = li >> 3, pos = blk == 0 ? (t >> 6) : (t & 63), second = (li >> 2) & 1, i0 = (li & 3) * 8;
            const f32x4 c0 = *(const f32x4*)(cs + pos * 32 + i0), c1 = *(const f32x4*)(cs + pos * 32 + i0 + 4), s0 = *(const f32x4*)(sn + pos * 32 + i0), s1 = *(const f32x4*)(sn + pos * 32 + i0 + 4);
#pragma unroll
            for (int j = 0; j < 8; ++j) { const float c = j < 4 ? c0[j] : c1[j - 4], s = j < 4 ? s0[j] : s1[j - 4];
                y[j] = second ? (xp[j] * s + x[j] * c) : (x[j] * c - xp[j] * s); }
        }
        u32x2 o = {(unsigned)att::pk4_fp8(y[0] * 16.f, y[1] * 16.f, y[2] * 16.f, y[3] * 16.f), (unsigned)att::pk4_fp8(y[4] * 16.f, y[5] * 16.f, y[6] * 16.f, y[7] * 16.f)};
        *(u32x2*)(A.ws + WS_K8 + (size_t)row * 256 + h * HD + li * 8) = o;
    }
}
__device__ __forceinline__ void phase_vt(const Args& A, LAS unsigned char* lds) {
    const int lane = threadIdx.x & 63, wave = threadIdx.x >> 6, gw = blockIdx.x * NWAVES + wave, NGW = gridDim.x * NWAVES;
    LAS unsigned char* tl = lds + wave * 4096;
    const bf16_t* VB = (const bf16_t*)(A.ws + WS_VB);
    const int kk = lane & 31, pos = 32 * ((kk >> 2) & 1) + (kk & 3) + 4 * (kk >> 3) + 16 * (lane >> 5);
    constexpr int NTILE = SKV / 64;
    for (int it2 = gw; it2 < NB * HKV * NTILE * 2; it2 += NGW) {
        const int dh = it2 & 1, it = it2 >> 1, j = it % NTILE, bk = it / NTILE, b = bk >> 1, kv = bk & 1;
        const bf16_t* src = VB + ((size_t)b * SKV + j * 64 + lane) * 256 + kv * HD + dh * 64;
        u32x4 w[8];
#pragma unroll
        for (int c = 0; c < 8; ++c) w[c] = *(const u32x4*)(src + c * 8);
#pragma unroll
        for (int c = 0; c < 8; ++c)
#pragma unroll
            for (int q = 0; q < 4; ++q) { const int pk = __builtin_amdgcn_cvt_pk_fp8_f32(bf_lo(w[c][q]) * 16.f, bf_hi(w[c][q]) * 16.f, 0, false);
                tl[(c * 8 + 2 * q) * 64 + pos] = (unsigned char)(pk & 0xff); tl[(c * 8 + 2 * q + 1) * 64 + pos] = (unsigned char)((pk >> 8) & 0xff); }
        asm volatile("s_waitcnt lgkmcnt(0)" ::: "memory");
        unsigned char* dst = A.ws + WS_VT8 + (size_t)it * 8192 + dh * 4096;
#pragma unroll
        for (int i = 0; i < 4; ++i) *(u32x4*)(dst + (i * 64 + lane) * 16) = *(const LAS u32x4*)(tl + (i * 64 + lane) * 16);
        asm volatile("s_waitcnt lgkmcnt(0)" ::: "memory");
    }
}
template <int R> struct ConvRow {
    static __device__ __forceinline__ void run(const unsigned* gp, int tl0, float (&acc)[32][2], const float (&w)[31][2]) {
        const int tl = tl0 + R - 15;
        unsigned v = 0u; if (tl >= 0 && tl < S) v = gp[(long)(R - 15) * (D / 2)];
        const float a = bf_lo(v), b = bf_hi(v);
#pragma unroll
        for (int t = (R - 30 > 0 ? R - 30 : 0); t <= (R < 31 ? R : 31); ++t) { acc[t][0] += w[R - t][0] * a; acc[t][1] += w[R - t][1] * b; }
        if constexpr (R + 1 < 62) ConvRow<R + 1>::run(gp, tl0, acc, w);
    }
};
__device__ __forceinline__ void phase_conv(const Args& A, LAS unsigned char* lds) {
    const int tid = threadIdx.x, lane = tid & 63, wave = tid >> 6;
    LAS float* tile = (LAS float*)lds;
    const bf16_t* G = (const bf16_t*)(A.ws + WS_G); bf16_t* CV = (bf16_t*)(A.ws + WS_HX);
    float w[31][2];
#pragma unroll
    for (int j = 0; j < 31; ++j) { const f32x2 t = *(const f32x2*)(A.cdw + j * D + 2 * tid); w[j][0] = t[0]; w[j][1] = t[1]; }
    const f32x2 bias = *(const f32x2*)(A.cb + 2 * tid);
    for (int tileid = blockIdx.x; tileid < M / 32; tileid += gridDim.x) {
        const int row0 = tileid * 32, tl0 = row0 & (S - 1);
        float acc[32][2];
#pragma unroll
        for (int t = 0; t < 32; ++t) { acc[t][0] = bias[0]; acc[t][1] = bias[1]; }
        ConvRow<0>::run((const unsigned*)(G + (size_t)row0 * D) + tid, tl0, acc, w);
        __syncthreads();
#pragma unroll
        for (int t = 0; t < 32; ++t) *(LAS f32x2*)(tile + t * D + 2 * tid) = (f32x2){acc[t][0], acc[t][1]};
        __syncthreads();
#pragma unroll
        for (int q = 0; q < 4; ++q) { const int t = wave * 4 + q; const LAS float* tr = tile + t * D;
            f32x4 v[4]; float s = 0.f;
#pragma unroll
            for (int i = 0; i < 4; ++i) { v[i] = *(const LAS f32x4*)(tr + (i * 64 + lane) * 4); s += (v[i][0] + v[i][1]) + (v[i][2] + v[i][3]); }
            const float mu = wave_sum(s) * (1.f / D); float qq = 0.f;
#pragma unroll
            for (int i = 0; i < 4; ++i) { v[i] = v[i] - mu; qq += (v[i][0] * v[i][0] + v[i][1] * v[i][1]) + (v[i][2] * v[i][2] + v[i][3] * v[i][3]); }
            const float rs = rsqrtf(wave_sum(qq) * (1.f / D) + EPS);
#pragma unroll
            for (int i = 0; i < 4; ++i) { const int k = (i * 64 + lane) * 4; const f32x4 gg = *(const f32x4*)(A.clg + k), bb = *(const f32x4*)(A.clb + k); float y[4];
#pragma unroll
                for (int j = 0; j < 4; ++j) { const float z = v[i][j] * rs * gg[j] + bb[j]; y[j] = z * fast_sigmoid(z); }
                u32x2 o = {cvt_pk_bf16(y[0], y[1]), cvt_pk_bf16(y[2], y[3])}; *(u32x2*)(CV + (size_t)(row0 + t) * D + k) = o; }
        }
    }
}
typedef float f32x32v __attribute__((ext_vector_type(32)));
typedef _Float16 f16x32v __attribute__((ext_vector_type(32)));
typedef _Float16 f16x2v __attribute__((ext_vector_type(2)));
__device__ __forceinline__ unsigned pk_f16(float a, float b) { const f16x2v h = {(_Float16)a, (_Float16)b}; return __builtin_bit_cast(unsigned, h); }
struct EpiInProj {
    static constexpr bool PERM = true;
    unsigned char* ws;
    __device__ __forceinline__ void operator()(f32x4 (&acc)[2][2][4][2], const pg8::Unit& u, int wr, int wc, int fr, int fq) const {
        const int c8 = wc * 32 + 8 * fq;
#pragma unroll
        for (int ai = 0; ai < 2; ++ai)
#pragma unroll
            for (int m = 0; m < 4; ++m) {
                const int row = u.pm * 256 + ai * 128 + wr * 64 + m * 16 + fr;
                if (u.kind == 0) {
                    bf16_t* p = (bf16_t*)(ws + WS_Q) + (size_t)row * D + u.pn * 256 + c8;
#pragma unroll
                    for (int bj = 0; bj < 2; ++bj) { const f32x4 v0 = acc[ai][bj][m][0], v1 = acc[ai][bj][m][1];
                        u32x4 w = {cvt_pk_bf16(v0[0], v0[1]), cvt_pk_bf16(v0[2], v0[3]), cvt_pk_bf16(v1[0], v1[1]), cvt_pk_bf16(v1[2], v1[3])}; *(u32x4*)(p + bj * 128) = w; }
                } else if (u.kind == 1 || u.kind == 2 || u.kind == 5 || u.kind == 6) {
                    const bool ctxu = u.kind >= 5;
                    const int kvrow = ctxu ? (row >> 8) * SKV + S + (row & 255) : (row >> 12) * SKV + (row & (S - 1));
                    bf16_t* p = (bf16_t*)(ws + ((u.kind == 1 || u.kind == 5) ? WS_KB : WS_VB)) + (size_t)kvrow * 256 + c8;
#pragma unroll
                    for (int bj = 0; bj < 2; ++bj) { const f32x4 v0 = acc[ai][bj][m][0], v1 = acc[ai][bj][m][1];
                        u32x4 w = {cvt_pk_bf16(v0[0], v0[1]), cvt_pk_bf16(v0[2], v0[3]), cvt_pk_bf16(v1[0], v1[1]), cvt_pk_bf16(v1[2], v1[3])}; *(u32x4*)(p + bj * 128) = w; }
                } else if (u.kind == 3) {
                    float g[8];
#pragma unroll
                    for (int n = 0; n < 2; ++n)
#pragma unroll
                        for (int j = 0; j < 4; ++j) g[4 * n + j] = acc[ai][0][m][n][j] * fast_sigmoid(acc[ai][1][m][n][j]);
                    u32x4 w = {cvt_pk_bf16(g[0], g[1]), cvt_pk_bf16(g[2], g[3]), cvt_pk_bf16(g[4], g[5]), cvt_pk_bf16(g[6], g[7])};
                    *(u32x4*)((bf16_t*)(ws + WS_G) + (size_t)row * D + (u.pn - 6) * 128 + c8) = w;
                } else {
                    float rt[8], sg[8];
#pragma unroll
                    for (int n = 0; n < 2; ++n)
#pragma unroll
                        for (int j = 0; j < 4; ++j) { const float ea = __builtin_amdgcn_exp2f(-1.4426950408889634f * acc[ai][0][m][n][j]), ec = __builtin_amdgcn_exp2f(-1.4426950408889634f * acc[ai][1][m][n][j]);
                            sg[4 * n + j] = __builtin_amdgcn_rcpf(1.f + ec); rt[4 * n + j] = (1.f + ec) * __builtin_amdgcn_rcpf(1.f + ea); }
                    const size_t off = (size_t)row * D + (u.pn - 14) * 128 + c8;
                    u32x4 w = {cvt_pk_bf16(rt[0], rt[1]), cvt_pk_bf16(rt[2], rt[3]), cvt_pk_bf16(rt[4], rt[5]), cvt_pk_bf16(rt[6], rt[7])}; *(u32x4*)((bf16_t*)(ws + WS_RT) + off) = w;
                    u32x4 w2 = {cvt_pk_bf16(sg[0], sg[1]), cvt_pk_bf16(sg[2], sg[3]), cvt_pk_bf16(sg[4], sg[5]), cvt_pk_bf16(sg[6], sg[7])}; *(u32x4*)((bf16_t*)(ws + WS_SGC) + off) = w2;
                }
            }
    }
};
struct SchedInProj {
    const char* hx; const char* hc; const char* w; int G, c;
    __device__ __forceinline__ bool next(int i, pg8::Unit& u) const {
        constexpr int nM = M / 256, nN = INW / 256, NMAIN = nM * nN, NCTX = (MC / 256) * 2;
        const int L = i * G + c; if (L >= NMAIN + NCTX) return false;
        if (L < NMAIN) { pg8::tile_of(L, nM, nN, u.pm, u.pn); u.a = hx + (size_t)u.pm * 256 * D * 2; u.kind = u.pn < 4 ? 0 : (u.pn == 4 ? 1 : (u.pn == 5 ? 2 : (u.pn < 14 ? 3 : 4))); }
        else { const int j = L - NMAIN; u.pm = j >> 1; u.pn = 4 + (j & 1); u.a = hc + (size_t)u.pm * 256 * D * 2; u.kind = 5 + (j & 1); }
        u.b = w + (size_t)u.pn * 256 * D * 2; u.keep = 0; return true;
    }
};
struct EpiMerge {
    static constexpr bool PERM = true;
    unsigned char* ws;
    __device__ __forceinline__ void operator()(f32x4 (&acc)[2][2][4][2], const pg8::Unit& u, int wr, int wc, int fr, int fq) const {
        const int c8 = u.pn * 256 + wc * 32 + 8 * fq;
        const bf16_t* __restrict__ F = (const bf16_t*)(ws + (u.kind == 0 ? WS_RT : WS_SGC));
#pragma unroll
        for (int ai = 0; ai < 2; ++ai)
#pragma unroll
            for (int m = 0; m < 4; ++m) { const size_t off = (size_t)(u.pm * 256 + ai * 128 + wr * 64 + m * 16 + fr) * D + c8;
#pragma unroll
                for (int bj = 0; bj < 2; ++bj) { const u32x4 f = *(const u32x4*)(F + off + bj * 128);
                    f32x4 v0 = acc[ai][bj][m][0], v1 = acc[ai][bj][m][1];
                    v0[0] *= bf_lo(f[0]); v0[1] *= bf_hi(f[0]); v0[2] *= bf_lo(f[1]); v0[3] *= bf_hi(f[1]); v1[0] *= bf_lo(f[2]); v1[1] *= bf_hi(f[2]); v1[2] *= bf_lo(f[3]); v1[3] *= bf_hi(f[3]);
                    if (u.kind == 0) { acc[ai][bj][m][0] = v0; acc[ai][bj][m][1] = v1; }
                    else { u32x4 w = {cvt_pk_bf16(v0[0], v0[1]), cvt_pk_bf16(v0[2], v0[3]), cvt_pk_bf16(v1[0], v1[1]), cvt_pk_bf16(v1[2], v1[3])}; *(u32x4*)((bf16_t*)(ws + WS_G) + off + bj * 128) = w; } } }
    }
};
struct SchedMerge {
    const char* att; const char* cv; const char* wa; const char* wc; int G, c;
    __device__ __forceinline__ bool next(int i, pg8::Unit& u) const {
        constexpr int nM = M / 256, nN = D / 256;
        const int L = (i >> 1) * G + c, sub = i & 1; if (L >= nM * nN) return false;
        pg8::tile_of(L, nM, nN, u.pm, u.pn);
        u.a = (sub ? cv : att) + (size_t)u.pm * 256 * D * 2; u.b = (sub ? wc : wa) + (size_t)u.pn * 256 * D * 2; u.kind = sub; u.keep = sub ^ 1; return true;
    }
};
struct SchedPlain {
    const char* a; const char* b; int nM, nN, G, c;
    __device__ __forceinline__ bool next(int i, pg8::Unit& u) const {
        const int L = i * G + c; if (L >= nM * nN) return false;
        pg8::tile_of(L, nM, nN, u.pm, u.pn); u.a = a + (size_t)u.pm * 256 * D * 2; u.b = b + (size_t)u.pn * 256 * D * 2; u.kind = 0; u.keep = 0; return true;
    }
};
struct EpiOut {
    static constexpr bool PERM = true;
    const float* __restrict__ x; const float* __restrict__ mod; const float* __restrict__ n2g; bf16_t* __restrict__ xs; bf16_t* __restrict__ xg; float* __restrict__ ssq;
    __device__ __forceinline__ void operator()(f32x4 (&acc)[2][2][4][2], const pg8::Unit& u, int wr, int wc, int fr, int fq) const {
        const int col0 = u.pn * 256 + wc * 32 + 8 * fq; const float* mb = mod + ((u.pm * 256) >> 12) * NMOD;
        f32x4 gv[2][2], nv[2][2];
#pragma unroll
        for (int bj = 0; bj < 2; ++bj)
#pragma unroll
            for (int n = 0; n < 2; ++n) { const int c = col0 + bj * 128 + n * 4; gv[bj][n] = *(const f32x4*)(mb + 2 * D + c); nv[bj][n] = *(const f32x4*)(n2g + c) * (*(const f32x4*)(mb + 4 * D + c) + 1.f); }
        f32x4 xa[2][2], xb[2][2];
#define XLOAD(dst, k) do { _Pragma("unroll") for (int bj = 0; bj < 2; ++bj) _Pragma("unroll") for (int n = 0; n < 2; ++n) \
            dst[bj][n] = *(const f32x4*)(x + (size_t)(u.pm * 256 + ((k) >> 2) * 128 + wr * 64 + ((k) & 3) * 16 + fr) * D + col0 + bj * 128 + n * 4); } while (0)
#define XDONE(src, k) do { const int ai = (k) >> 2, m = (k) & 3; const int row = u.pm * 256 + ai * 128 + wr * 64 + m * 16 + fr; const size_t off = (size_t)row * D + col0; float ss = 0.f; \
            _Pragma("unroll") for (int bj = 0; bj < 2; ++bj) { const f32x4 v0 = src[bj][0] + gv[bj][0] * acc[ai][bj][m][0], v1 = src[bj][1] + gv[bj][1] * acc[ai][bj][m][1]; \
                ss += ((v0[0] * v0[0] + v0[1] * v0[1]) + (v0[2] * v0[2] + v0[3] * v0[3])) + ((v1[0] * v1[0] + v1[1] * v1[1]) + (v1[2] * v1[2] + v1[3] * v1[3])); \
                u32x4 w = {cvt_pk_bf16(v0[0], v0[1]), cvt_pk_bf16(v0[2], v0[3]), cvt_pk_bf16(v1[0], v1[1]), cvt_pk_bf16(v1[2], v1[3])}; *(u32x4*)(xs + off + bj * 128) = w; \
                const f32x4 g0 = v0 * nv[bj][0], g1 = v1 * nv[bj][1]; \
                u32x4 w2 = {cvt_pk_bf16(g0[0], g0[1]), cvt_pk_bf16(g0[2], g0[3]), cvt_pk_bf16(g1[0], g1[1]), cvt_pk_bf16(g1[2], g1[3])}; *(u32x4*)(xg + off + bj * 128) = w2; } \
            ss += __shfl_xor(ss, 16); ss += __shfl_xor(ss, 32); if (fq == 0) ssq[(size_t)row * 16 + u.pn * 4 + wc] = ss; } while (0)
        XLOAD(xa, 0); XLOAD(xb, 1); XDONE(xa, 0); XLOAD(xa, 2); XDONE(xb, 1); XLOAD(xb, 3); XDONE(xa, 2); XLOAD(xa, 4); XDONE(xb, 3); XLOAD(xb, 5); XDONE(xa, 4); XLOAD(xa, 6); XDONE(xb, 5); XLOAD(xb, 7); XDONE(xa, 6); XDONE(xb, 7);
#undef XLOAD
#undef XDONE
    }
};
__device__ __forceinline__ float row_rstd(const float* ssq, int row) {
    const f32x4 a = *(const f32x4*)(ssq + (size_t)row * 16), b = *(const f32x4*)(ssq + (size_t)row * 16 + 4), c = *(const f32x4*)(ssq + (size_t)row * 16 + 8), d = *(const f32x4*)(ssq + (size_t)row * 16 + 12);
    const float s = ((a[0] + a[1]) + (a[2] + a[3])) + ((b[0] + b[1]) + (b[2] + b[3])) + ((c[0] + c[1]) + (c[2] + c[3])) + ((d[0] + d[1]) + (d[2] + d[3]));
    return rsqrtf(s * (1.f / D) + EPS);
}
struct EpiScores {
    static constexpr bool PERM = true;
    unsigned short* sc; const float* ssq; const float* sbias;
    __device__ __forceinline__ void operator()(f32x4 (&acc)[2][2][4][2], const pg8::Unit& u, int wr, int wc, int fr, int fq) const {
        const float* sb = sbias + ((u.pm * 256) >> 12) * PW + u.pn * 256 + wc * 32 + 8 * fq;
        f32x4 bv[2][2];
#pragma unroll
        for (int bj = 0; bj < 2; ++bj)
#pragma unroll
            for (int n = 0; n < 2; ++n) bv[bj][n] = *(const f32x4*)(sb + bj * 128 + n * 4);
#pragma unroll
        for (int ai = 0; ai < 2; ++ai)
#pragma unroll
            for (int m = 0; m < 4; ++m) { const int row = u.pm * 256 + ai * 128 + wr * 64 + m * 16 + fr; unsigned short* p = sc + (size_t)(row >> 2) * 8192 + (row & 3) * 8; const float rs = row_rstd(ssq, row);
#pragma unroll
                for (int bj = 0; bj < 2; ++bj) { const int grp = u.pn * 2 + bj, nq = wc * 4 + fq; const f32x4 v0 = acc[ai][bj][m][0] * rs + bv[bj][0], v1 = acc[ai][bj][m][1] * rs + bv[bj][1];
                    u32x4 w = {pk_f16(v0[0], v0[1]), pk_f16(v0[2], v0[3]), pk_f16(v1[0], v1[1]), pk_f16(v1[2], v1[3])}; *(u32x4*)(p + (grp * 16 + nq) * 32) = w; } }
    }
};

#ifndef PROBE_HALFKEYS
#define PROBE_HALFKEYS 0
#endif
__device__ __forceinline__ void phase_attn(const Args& A, unsigned char* lds) {
    const int G = gridDim.x, X = blockIdx.x & 7, j = blockIdx.x >> 3, perx = G >> 3;
    bf16_t* Q = (bf16_t*)(A.ws + WS_Q); const unsigned char* K8 = A.ws + WS_K8; const unsigned char* VT8 = A.ws + WS_VT8;
    const float* cs = (const float*)(A.ws + WS_ROPE); const float* sn = cs + 2048;
    for (int idx = j; idx < 128; idx += perx) {
        const int grp = 2 * X + (idx >> 6), uu = idx & 63, b = grp >> 1, kv = grp & 1, h = kv * 4 + (uu >> 4), qb = uu & 15;
        bf16_t* qp = Q + ((size_t)b * S + qb * 256) * D + h * HD;
        bf16_t* op = A.dry ? (bf16_t*)(A.ws + WS_G) + ((size_t)b * S + qb * 256) * D + h * HD : qp;
        att::attn_unit(qp, K8 + (size_t)b * SKV * 256 + kv * HD, VT8 + (size_t)grp * (SKV / 64) * 8192, op, qb * 256, (A.dry && PROBE_HALFKEYS) ? SKV / 2 : SKV, A.qng, cs, sn, (char*)lds);
    }
}

__device__ __forceinline__ float gelu_exact(float v) {
    const float av = fabsf(v), t = __builtin_amdgcn_rcpf(av * 0.2316418882f + 1.0f);
    float q = t * 0.5307027145f + (-0.7265760135f); q = q * t + 0.7107068705f; q = q * t + (-0.142248368f); q = q * t + 0.127414796f; q = q * t;
    const float e = __builtin_amdgcn_exp2f((v * v) * (-0.72134752044f));
    const float m = v * (q * e);
    return v < 0.f ? m : v - m;
}
__device__ __forceinline__ void ins16(float (&t)[16], float v) {
#pragma unroll
    for (int i = 15; i >= 1; --i) t[i] = __builtin_amdgcn_fmed3f(t[i - 1], t[i], v);
    t[0] = fmaxf(t[0], v);
}

__device__ __forceinline__ float key_tag(float v, unsigned keepmask, unsigned tag) { return __uint_as_float((__float_as_uint(v) & keepmask) | tag); }
template <int I, int J> struct CandLoop {
    static __device__ __forceinline__ void run(const float (&a)[16], const float (&b)[16], float (&c)[16]) {
        if constexpr ((I + 1) * (J + 1) <= 16) { ins16(c, key_tag(a[I] + b[J], ~255u, 255u - (unsigned)(I * 16 + J))); CandLoop<I, J + 1>::run(a, b, c); }
        else if constexpr (I + 1 < 16) CandLoop<I + 1, 0>::run(a, b, c);
    }
};
__device__ __forceinline__ void phase_peer_u(const Args& A, LAS unsigned char* lds) {
    const int lane = threadIdx.x & 63, wave = threadIdx.x >> 6, gw = blockIdx.x * NWAVES + wave, NGW = gridDim.x * NWAVES;
    LAS unsigned char* wl = lds + wave * 10240;
    LAS float* topL = (LAS float*)wl; LAS int* eidA = (LAS int*)(wl + 4096); LAS float* wgtA = (LAS float*)(wl + 6144); LAS float* coefL = (LAS float*)(wl + 8192);
    LAS float* suL = (LAS float*)(wl + 8704); LAS float* svL = (LAS float*)(wl + 9216);
    const unsigned short* SC = (const unsigned short*)(A.ws + WS_SC); const bf16_t* HX = (const bf16_t*)(A.ws + WS_HX);
    const unsigned char* UT = A.ws + WS_UT; const float* SU = (const float*)(A.ws + WS_UT + WS_TSCALE); const float* SVs = (const float*)(A.ws + WS_VT + WS_TSCALE);
    const float* mod = (const float*)(A.ws + WS_MOD);
    int* PE = (int*)(A.ws + WS_PE); float* PC = (float*)(A.ws + WS_PC);
    const float NEG = -3.0e38f;
    const int h = lane >> 3, tk = (lane >> 1) & 3, p = lane & 1, grp = 2 * h + p;
    for (int pass = gw; pass < M / 4; pass += NGW) {
        {
            float t[16];
#pragma unroll
            for (int i = 0; i < 16; ++i) t[i] = NEG;
            const unsigned short* sp = SC + (size_t)pass * 8192 + (grp * 64 + tk) * 8;
            u32x4 sv[16];
#pragma unroll
            for (int i = 0; i < 16; ++i) sv[i] = *(const u32x4*)(sp + i * 32);
#pragma unroll
            for (int i = 0; i < 16; ++i)
#pragma unroll
                for (int q = 0; q < 4; ++q) { const unsigned w = sv[i][q]; const f16x2v hv = __builtin_bit_cast(f16x2v, w); const unsigned tg = 127u - (unsigned)(8 * i + 2 * q);
                    ins16(t, __uint_as_float(__float_as_uint((float)hv[0]) | tg)); ins16(t, __uint_as_float(__float_as_uint((float)hv[1]) | (tg - 1u))); }
            float pb[16];
#pragma unroll
            for (int i = 0; i < 16; ++i) { pb[i] = __shfl_xor(t[i], 1); topL[i * 64 + lane] = t[i]; }
            float c[16];
#pragma unroll
            for (int i = 0; i < 16; ++i) c[i] = NEG;
            CandLoop<0, 0>::run(t, pb, c);
            float e[16]; float es = 0.f;
#pragma unroll
            for (int k = 0; k < 16; ++k) { e[k] = __expf(c[k] - c[0]); es += e[k]; }
            const float inv = __builtin_amdgcn_rcpf(es);
            asm volatile("s_waitcnt lgkmcnt(0)" ::: "memory");
            if (p == 0) {
#pragma unroll
                for (int k = 0; k < 16; ++k) { const unsigned code = 255u - (__float_as_uint(c[k]) & 255u);
                    const unsigned ia = 127u - (__float_as_uint(topL[(code >> 4) * 64 + lane]) & 127u), ib = 127u - (__float_as_uint(topL[(code & 15u) * 64 + lane + 1]) & 127u);
                    eidA[tk * 128 + h * 16 + k] = (int)(ia * 128u + ib); wgtA[tk * 128 + h * 16 + k] = e[k] * inv; }
            }
            asm volatile("s_waitcnt lgkmcnt(0)" ::: "memory");
        }
#pragma unroll 1
        for (int tq = 0; tq < 4; ++tq) {
            const int t = pass * 4 + tq; const LAS int* eidL = eidA + tq * 128; const LAS float* wgtL = wgtA + tq * 128;
            const int g = lane & 31, hh = lane >> 5;
            f16x2v xh[16];
            { const float rs = row_rstd((const float*)(A.ws + WS_SSQ), t); const float* sh = mod + (t >> 12) * NMOD + 3 * D + g * 32; const bf16_t* xp = HX + (size_t)t * D + g * 32;
#pragma unroll
              for (int c = 0; c < 4; ++c) { const u32x4 w = *(const u32x4*)(xp + 8 * c); const f32x4 s0 = *(const f32x4*)(sh + 8 * c), s1 = *(const f32x4*)(sh + 8 * c + 4);
                xh[4 * c] = (f16x2v){(_Float16)(bf_lo(w[0]) * rs + s0[0]), (_Float16)(bf_hi(w[0]) * rs + s0[1])}; xh[4 * c + 1] = (f16x2v){(_Float16)(bf_lo(w[1]) * rs + s0[2]), (_Float16)(bf_hi(w[1]) * rs + s0[3])};
                xh[4 * c + 2] = (f16x2v){(_Float16)(bf_lo(w[2]) * rs + s1[0]), (_Float16)(bf_hi(w[2]) * rs + s1[1])}; xh[4 * c + 3] = (f16x2v){(_Float16)(bf_lo(w[3]) * rs + s1[2]), (_Float16)(bf_hi(w[3]) * rs + s1[3])}; } }
            { const int i0 = eidL[lane], i1 = eidL[64 + lane]; suL[lane] = SU[i0]; suL[64 + lane] = SU[i1]; svL[lane] = SVs[i0]; svL[64 + lane] = SVs[i1]; }
            u32x6 rb0[4], rb1[4], rb2[4], rb3[4];
#define LOAD8(buf, TB, hb) do { _Pragma("unroll") for (int r = 0; r < 4; ++r) { const int id = eidL[(hb) * 8 + 2 * r + hh]; const unsigned char* rp = (TB) + (size_t)id * ROWB; \
                const u32x4 lo = *(const u32x4*)(rp + g * 16); const u32x2 hi2 = *(const u32x2*)(rp + 512 + g * 8); buf[r] = (u32x6){lo[0], lo[1], lo[2], lo[3], hi2[0], hi2[1]}; } } while (0)
#define DOT8(buf, off) do { _Pragma("unroll") for (int r = 0; r < 4; ++r) { const f16x32v dq = __builtin_amdgcn_cvt_scalef32_pk32_f16_fp6(buf[r], 1.0f); \
                float sa = 0.f, sb = 0.f, sc = 0.f, sd = 0.f;     \
                _Pragma("unroll") for (int j = 0; j < 16; j += 4) { sa = __builtin_amdgcn_fdot2((f16x2v){dq[2 * j], dq[2 * j + 1]}, xh[j], sa, false); sb = __builtin_amdgcn_fdot2((f16x2v){dq[2 * j + 2], dq[2 * j + 3]}, xh[j + 1], sb, false); \
                    sc = __builtin_amdgcn_fdot2((f16x2v){dq[2 * j + 4], dq[2 * j + 5]}, xh[j + 2], sc, false); sd = __builtin_amdgcn_fdot2((f16x2v){dq[2 * j + 6], dq[2 * j + 7]}, xh[j + 3], sd, false); } \
                pp[(off) + r] = (sa + sb) + (sc + sd); } } while (0)
#define REDUCE16(kb) do { \
            _Pragma("unroll") for (int e = 0; e < 4; ++e) { const bool up = lane & 16; const float keep = up ? pp[e + 4] : pp[e], send = up ? pp[e] : pp[e + 4]; pp[e] = keep + __shfl_xor(send, 16); } \
            _Pragma("unroll") for (int e = 0; e < 2; ++e) { const bool up = lane & 8; const float keep = up ? pp[e + 2] : pp[e], send = up ? pp[e] : pp[e + 2]; pp[e] = keep + __shfl_xor(send, 8); } \
            { const bool up = lane & 4; const float keep = up ? pp[1] : pp[0], send = up ? pp[0] : pp[1]; pp[0] = keep + __shfl_xor(send, 4); } \
            float hsum = pp[0]; hsum += __shfl_xor(hsum, 2); hsum += __shfl_xor(hsum, 1); \
            const int ke = (kb) * 16 + 2 * ((lane >> 2) & 7) + hh; const float su = suL[ke], sv = svL[ke]; \
            const float cf = wgtL[ke] * gelu_exact(hsum * su) * sv; if ((lane & 3) == 0) coefL[ke] = cf; } while (0)
            float pp[8];
            LOAD8(rb0, UT, 0); LOAD8(rb1, UT, 1); LOAD8(rb2, UT, 2);
            LOAD8(rb3, UT, 3); DOT8(rb0, 0);
            LOAD8(rb0, UT, 4); DOT8(rb1, 4); REDUCE16(0);
            LOAD8(rb1, UT, 5); DOT8(rb2, 0);
            LOAD8(rb2, UT, 6); DOT8(rb3, 4); REDUCE16(1);
            LOAD8(rb3, UT, 7); DOT8(rb0, 0);
            LOAD8(rb0, UT, 8); DOT8(rb1, 4); REDUCE16(2);
            LOAD8(rb1, UT, 9); DOT8(rb2, 0);
            LOAD8(rb2, UT, 10); DOT8(rb3, 4); REDUCE16(3);
            LOAD8(rb3, UT, 11); DOT8(rb0, 0);
            LOAD8(rb0, UT, 12); DOT8(rb1, 4); REDUCE16(4);
            LOAD8(rb1, UT, 13); DOT8(rb2, 0);
            LOAD8(rb2, UT, 14); DOT8(rb3, 4); REDUCE16(5);
            LOAD8(rb3, UT, 15); DOT8(rb0, 0);
            DOT8(rb1, 4); REDUCE16(6);
            DOT8(rb2, 0);
            DOT8(rb3, 4); REDUCE16(7);
#undef LOAD8
#undef DOT8
#undef REDUCE16
            asm volatile("s_waitcnt lgkmcnt(0)" ::: "memory");
            PE[(size_t)t * 128 + lane] = eidL[lane]; PE[(size_t)t * 128 + 64 + lane] = eidL[64 + lane];
            PC[(size_t)t * 128 + lane] = coefL[lane]; PC[(size_t)t * 128 + 64 + lane] = coefL[64 + lane];
        }
    }
}
__device__ __forceinline__ void phase_peer_v(const Args& A, LAS unsigned char* lds) {
    const int lane = threadIdx.x & 63, wave = threadIdx.x >> 6, gw = blockIdx.x * NWAVES + wave, NGW = gridDim.x * NWAVES;
    LAS int* eidL = (LAS int*)(lds + wave * 1024); LAS float* coefL = (LAS float*)(lds + wave * 1024 + 512);
    const unsigned char* VT = A.ws + WS_VT; const float* mod = (const float*)(A.ws + WS_MOD);
    const int* PE = (const int*)(A.ws + WS_PE); const float* PC = (const float*)(A.ws + WS_PC);
    const int g = lane & 31, hh = lane >> 5;
    int pe0 = 0, pe1 = 0; float pc0 = 0.f, pc1 = 0.f;
    if (gw < M) { pe0 = PE[(size_t)gw * 128 + lane]; pe1 = PE[(size_t)gw * 128 + 64 + lane]; pc0 = PC[(size_t)gw * 128 + lane]; pc1 = PC[(size_t)gw * 128 + 64 + lane]; }
    for (int t = gw; t < M; t += NGW) {
        eidL[lane] = pe0; eidL[64 + lane] = pe1; coefL[lane] = pc0; coefL[64 + lane] = pc1;
        asm volatile("s_waitcnt lgkmcnt(0)" ::: "memory");
        { const int tn = t + NGW < M ? t + NGW : t; pe0 = PE[(size_t)tn * 128 + lane]; pe1 = PE[(size_t)tn * 128 + 64 + lane]; pc0 = PC[(size_t)tn * 128 + lane]; pc1 = PC[(size_t)tn * 128 + 64 + lane]; }
        u32x4 xsw[2];
        { const bf16_t* xrow = (const bf16_t*)(A.ws + WS_XSB) + (size_t)t * D + g * 32 + hh * 16; xsw[0] = *(const u32x4*)xrow; xsw[1] = *(const u32x4*)(xrow + 8); }
        u32x6 rb0[4], rb1[4], rb2[4], rb3[4];
#define LOAD8(buf, hb) do { _Pragma("unroll") for (int r = 0; r < 4; ++r) { const int id = eidL[(hb) * 8 + 2 * r + hh]; const unsigned char* rp = VT + (size_t)id * ROWB; \
            const u32x4 lo = *(const u32x4*)(rp + g * 16); const u32x2 hi2 = *(const u32x2*)(rp + 512 + g * 8); buf[r] = (u32x6){lo[0], lo[1], lo[2], lo[3], hi2[0], hi2[1]}; } } while (0)
#define VACC8(buf, hb) do { _Pragma("unroll") for (int r = 0; r < 4; ++r) { const _Float16 ch = (_Float16)coefL[(hb) * 8 + 2 * r + hh]; const f16x2v cf2 = {ch, ch}; \
            const f16x32v dq = __builtin_amdgcn_cvt_scalef32_pk32_f16_fp6(buf[r], 1.0f); \
            _Pragma("unroll") for (int j = 0; j < 16; ++j) yh[j] = cf2 * (f16x2v){dq[2 * j], dq[2 * j + 1]} + yh[j]; } } while (0)
        f16x2v yh[16];
#pragma unroll
        for (int j = 0; j < 16; ++j) yh[j] = (f16x2v){(_Float16)0.f, (_Float16)0.f};
        LOAD8(rb0, 0); LOAD8(rb1, 1); LOAD8(rb2, 2);
        LOAD8(rb3, 3); VACC8(rb0, 0);
        LOAD8(rb0, 4); VACC8(rb1, 1);
        LOAD8(rb1, 5); VACC8(rb2, 2);
        LOAD8(rb2, 6); VACC8(rb3, 3);
        LOAD8(rb3, 7); VACC8(rb0, 4);
        LOAD8(rb0, 8); VACC8(rb1, 5);
        LOAD8(rb1, 9); VACC8(rb2, 6);
        LOAD8(rb2, 10); VACC8(rb3, 7);
        LOAD8(rb3, 11); VACC8(rb0, 8);
        LOAD8(rb0, 12); VACC8(rb1, 9);
        LOAD8(rb1, 13); VACC8(rb2, 10);
        LOAD8(rb2, 14); VACC8(rb3, 11);
        LOAD8(rb3, 15); VACC8(rb0, 12);
        VACC8(rb1, 13);
        VACC8(rb2, 14);
        VACC8(rb3, 15);
#undef LOAD8
#undef VACC8
        float yy[16];
#pragma unroll
        for (int j = 0; j < 16; ++j) { const float y0 = (float)yh[j][0], y1 = (float)yh[j][1]; const float a = y0 + __shfl_xor(y0, 32), b = y1 + __shfl_xor(y1, 32); if ((j >> 3) == hh) { yy[2 * (j & 7)] = a; yy[2 * (j & 7) + 1] = b; } }
        const float* g2 = mod + (t >> 12) * NMOD + 5 * D; float* orow = A.out + (size_t)t * D;
        float z[16]; float ss = 0.f;
#pragma unroll
        for (int q = 0; q < 4; ++q) { const int k = g * 32 + hh * 16 + q * 4; const unsigned xw0 = xsw[q >> 1][2 * (q & 1)], xw1 = xsw[q >> 1][2 * (q & 1) + 1];
            const f32x4 xv = {bf_lo(xw0), bf_hi(xw0), bf_lo(xw1), bf_hi(xw1)}, gv = *(const f32x4*)(g2 + k);
#pragma unroll
            for (int j = 0; j < 4; ++j) { const float zz = xv[j] + gv[j] * yy[q * 4 + j]; z[q * 4 + j] = zz; ss += zz * zz; } }
        const float r = rsqrtf(wave_sum(ss) * (1.f / D) + EPS);
#pragma unroll
        for (int q = 0; q < 4; ++q) { const int k = g * 32 + hh * 16 + q * 4; const f32x4 fv = *(const f32x4*)(A.fg + k);
            f32x4 o;
#pragma unroll
            for (int j = 0; j < 4; ++j) o[j] = z[q * 4 + j] * r * fv[j];
            if (!A.dry || r < 0.f) *(f32x4*)(orow + k) = o; }
    }
}
#define XB_TMO      128
#define XB_XCNT(j)  (256  + 64 * (j))
#define XB_XSUB(j)  (1280 + 64 * (j))
#define XB_XGEN(j)  (2304 + 64 * (j))
#define XB_TOP      3328
#define XB_TOPGEN   3392
#define XCD_BAR_WORDS 3456
#define XB_SPIN_CAP (1u << 22)
__device__ __forceinline__ unsigned xb_ld(unsigned* p)              { return __hip_atomic_load(p, __ATOMIC_RELAXED, __HIP_MEMORY_SCOPE_AGENT); }
__device__ __forceinline__ unsigned xb_add(unsigned* p, unsigned v) { return __hip_atomic_fetch_add(p, v, __ATOMIC_RELAXED, __HIP_MEMORY_SCOPE_AGENT); }
__device__ __forceinline__ unsigned xb_xcc_id() { return (unsigned)__builtin_amdgcn_s_getreg((3 << 11) | 20) & 0xFu; }
#define XB_SPIN(cond, bar) do { unsigned _sp = 0; while (cond) { __builtin_amdgcn_s_sleep(1); \
    if ((++_sp & 255u) == 0u) { if (xb_ld(&(bar)[XB_TMO])) break; if (_sp > XB_SPIN_CAP) { atomicAdd(&(bar)[XB_TMO], 1u); break; } } } } while (0)
struct XcdBarrier { unsigned* bar; unsigned x; volatile LAS unsigned* st; };
__device__ __forceinline__ XcdBarrier xcd_barrier_post(unsigned* bar, volatile LAS unsigned* st) {
    XcdBarrier b; b.bar = bar; b.x = xb_xcc_id(); b.st = st;
    if (threadIdx.x == 0) (void)xb_add(&bar[XB_XCNT(b.x)], 1u);
    return b;
}
__device__ __forceinline__ void xcd_barrier_complete(unsigned* bar, unsigned x, unsigned& nloc, unsigned& nx) {
    const unsigned G = gridDim.x * gridDim.y * gridDim.z;
    unsigned sum, cnt, mine, sp = 0u;
    for (;;) {
        sum = 0u; cnt = 0u; mine = 0u;
#pragma unroll
        for (unsigned j = 0; j < 16; ++j) { const unsigned c = xb_ld(&bar[XB_XCNT(j)]); sum += c; cnt += (c > 0u) ? 1u : 0u; mine = (j == x) ? c : mine; }
        if (sum == G) break;
        __builtin_amdgcn_s_sleep(1);
        if ((++sp & 255u) == 0u) { if (xb_ld(&bar[XB_TMO])) break; if (sp > XB_SPIN_CAP) { atomicAdd(&bar[XB_TMO], 1u); break; } }
    }
    nloc = mine > 0u ? mine : 1u; nx = cnt > 0u ? cnt : 1u;
}
__device__ __forceinline__ void xcd_barrier(const XcdBarrier& b) {
    asm volatile("s_waitcnt vmcnt(0)" ::: "memory");
    __syncthreads();
    if (threadIdx.x == 0) {
        unsigned* bar = b.bar;
        __builtin_amdgcn_s_waitcnt(0);
        unsigned nloc = b.st[0], nx = b.st[1];
        if (nloc == 0u) { xcd_barrier_complete(bar, b.x, nloc, nx); b.st[0] = nloc; b.st[1] = nx; }
        const unsigned old = xb_add(&bar[XB_XSUB(b.x)], 1u);
        const unsigned gen = old / nloc;
        if (old + 1u == (gen + 1u) * nloc) {
            __builtin_amdgcn_fence(__ATOMIC_RELEASE, "agent");
            asm volatile("s_waitcnt vmcnt(0)" ::: "memory");
            const unsigned og = xb_add(&bar[XB_TOP], 1u);
            const unsigned tg = og / nx;
            if (og + 1u == (tg + 1u) * nx) xb_add(&bar[XB_TOPGEN], 1u);
            else XB_SPIN(xb_ld(&bar[XB_TOPGEN]) == tg, bar);
            __builtin_amdgcn_fence(__ATOMIC_ACQUIRE, "agent");
            xb_add(&bar[XB_XGEN(b.x)], 1u);
            asm volatile("s_waitcnt vmcnt(0)" ::: "memory");
        } else {
            XB_SPIN(xb_ld(&bar[XB_XGEN(b.x)]) == gen, bar);
            __builtin_amdgcn_fence(__ATOMIC_ACQUIRE, "agent");
            asm volatile("s_waitcnt vmcnt(0)" ::: "memory");
        }
    }
    __syncthreads();
}
constexpr int MISC_OFF = 135168;

constexpr int N_PHASES = 10;
__global__ void __launch_bounds__(NWAVES * 64, 2) mega_fwd(Args A) {
    extern __shared__ __attribute__((aligned(16))) unsigned char lds[];
    LAS unsigned char* L = (LAS unsigned char*)lds;
    cg::grid_group grid = cg::this_grid();
    const int lo = A.ph_lo, hi = A.ph_hi, G = gridDim.x, c = blockIdx.x;
#ifndef PH_MASK
#define PH_MASK 0x3FF
#endif
#define IN(k) (((PH_MASK >> (k)) & 1) && lo <= (k) && (k) < hi)
    unsigned* barw = (unsigned*)(A.ws + WS_CTL);
    volatile LAS unsigned* MISC = (volatile LAS unsigned*)(L + MISC_OFF);
    if (threadIdx.x < 2) MISC[threadIdx.x] = 0u;
    if (lo == 0 && hi > 1 && blockIdx.x == 0) for (int i = threadIdx.x; i < XCD_BAR_WORDS; i += NWAVES * 64) barw[i] = 0u;
    XcdBarrier xb; xb.bar = barw; xb.x = 0; xb.st = MISC;
#define SEAM(k) do { if (IN(k) && IN((k) + 1)) { if ((k) == 0) { grid.sync(); xb = xcd_barrier_post(barw, MISC); } else xcd_barrier(xb); } } while (0)
    if (IN(0)) phase_prologue(A, L);
    SEAM(0);
    if (IN(1)) phase_hx(A);
    SEAM(1);
    if (IN(2)) { SchedInProj Sd{(const char*)(A.ws + WS_HX), (const char*)(A.ws + WS_HC), (const char*)(A.ws + WS_WIN), G, c}; EpiInProj E{A.ws};
        pg8::gemm_phase<EpiInProj, SchedInProj, true>(L, D, Sd, E); }
    SEAM(2);
    if (IN(3)) { phase_kfix(A); phase_vt(A, L); __syncthreads(); phase_conv(A, L); }
    SEAM(3);
    if (IN(4)) phase_attn(A, lds);
    SEAM(4);
    if (IN(5)) { SchedMerge Sd{(const char*)(A.ws + WS_Q), (const char*)(A.ws + WS_HX), (const char*)(A.ws + WS_WA), (const char*)(A.ws + WS_WC), G, c}; EpiMerge E{A.ws};
        pg8::gemm_phase<EpiMerge, SchedMerge, true>(L, D, Sd, E); }
    SEAM(5);
    if (IN(6)) { SchedPlain Sd{(const char*)(A.ws + WS_G), (const char*)(A.ws + WS_WO), M / 256, D / 256, G, c};
        EpiOut E{A.x, (const float*)(A.ws + WS_MOD), A.n2g, (bf16_t*)(A.ws + WS_XSB), (bf16_t*)(A.ws + WS_HX), (float*)(A.ws + WS_SSQ)};
        pg8::gemm_phase<EpiOut, SchedPlain, true>(L, D, Sd, E); }
    SEAM(6);
    if (IN(7)) { SchedPlain Sd{(const char*)(A.ws + WS_HX), (const char*)(A.ws + WS_WP), M / 256, PW / 256, G, c};
        EpiScores E{(unsigned short*)(A.ws + WS_SC), (const float*)(A.ws + WS_SSQ), (const float*)(A.ws + WS_SBIAS)};
        pg8::gemm_phase<EpiScores, SchedPlain, true>(L, D, Sd, E); }
    SEAM(7);
    if (IN(8)) phase_peer_u(A, L);
    SEAM(8);
    if (IN(9)) phase_peer_v(A, L);
#undef IN
#undef SEAM
}

#ifndef MK_ONE_LAUNCH
#define MK_ONE_LAUNCH 1
#endif
extern "C" void kernel_launch(void* const* d_in, const int* in_sizes, int n_in, void* d_out, int out_size, void* d_ws, size_t ws_size, hipStream_t stream) {
    static int grid = 0;
    if (grid == 0) {
        if (n_in != 23 || out_size != M * D || ws_size < WS_END) { fprintf(stderr, "kernel_launch: unexpected shapes (n_in %d out %d ws %zu)\n", n_in, out_size, ws_size); grid = -1; return; }
        int dev = 0, cus = 0, per_cu = 0;
        hipGetDevice(&dev); hipDeviceGetAttribute(&cus, hipDeviceAttributeMultiprocessorCount, dev);
        if (hipFuncSetAttribute((const void*)mega_fwd, hipFuncAttributeMaxDynamicSharedMemorySize, LDS_BYTES) != hipSuccess) { fprintf(stderr, "kernel_launch: hipFuncSetAttribute failed\n"); grid = -1; return; }
        if (hipOccupancyMaxActiveBlocksPerMultiprocessor(&per_cu, (const void*)mega_fwd, NWAVES * 64, LDS_BYTES) != hipSuccess || per_cu < 1) { fprintf(stderr, "kernel_launch: occupancy query says %d\n", per_cu); per_cu = 1; }
        (void)hipGetLastError();
        grid = cus * 1;
        if (per_cu < 1) grid = -1;
    }
    if (grid < 0) return;
    Args a{};
    const float** f = (const float**)&a;
    for (int i = 0; i < 23; ++i) f[i] = (const float*)d_in[i];
    a.out = (float*)d_out; a.ws = (unsigned char*)d_ws;
#if MK_ONE_LAUNCH
    a.ph_lo = 0; a.ph_hi = N_PHASES;
    void* args[] = {&a};
    hipError_t e = hipLaunchCooperativeKernel((const void*)mega_fwd, dim3(grid), dim3(NWAVES * 64), args, LDS_BYTES, stream);
    if (e != hipSuccess) fprintf(stderr, "cooperative launch failed: %s (grid %d)\n", hipGetErrorString(e), grid);
#else
#ifndef REPEAT_PH
#define REPEAT_PH -1
#endif
    for (int p = 0; p < N_PHASES; ++p) { a.ph_lo = p; a.ph_hi = p + 1;
        if (p == REPEAT_PH) { a.dry = 1; hipLaunchKernelGGL(mega_fwd, dim3(grid), dim3(NWAVES * 64), LDS_BYTES, stream, a); a.dry = 0; }
        hipLaunchKernelGGL(mega_fwd, dim3(grid), dim3(NWAVES * 64), LDS_BYTES, stream, a); }
#endif
}
```

```cpp
#include <hip/hip_runtime.h>
#include <hip/hip_cooperative_groups.h>
#include <cstdio>
#include <cstdint>
namespace cg = cooperative_groups;

#define LAS __attribute__((address_space(3)))
typedef unsigned short bf16_t;
typedef short bf16x8 __attribute__((ext_vector_type(8)));
typedef short s16x4 __attribute__((ext_vector_type(4)));
typedef float f32x2 __attribute__((ext_vector_type(2)));
typedef float f32x4 __attribute__((ext_vector_type(4)));
typedef float f32x16 __attribute__((ext_vector_type(16)));
typedef unsigned u32x2 __attribute__((ext_vector_type(2)));
typedef unsigned u32x4 __attribute__((ext_vector_type(4)));
typedef __bf16 bf16x2_t __attribute__((ext_vector_type(2)));

constexpr int D = 1024, NB = 8, S = 4096, CTXL = 256, SKV = S + CTXL, HD = 128, HQ = 8, HKV = 2;
constexpr int M = NB * S;
constexpr int MC = NB * CTXL;
constexpr int INW = 5632, NMOD = 6144, NEXP = 16384, PW = 2048;
constexpr float EPS = 1e-6f;

__device__ __forceinline__ unsigned cvt_pk_bf16(float lo, float hi) { f32x2 v = {lo, hi}; bf16x2_t b = __builtin_convertvector(v, bf16x2_t); return __builtin_bit_cast(unsigned, b); }
__device__ __forceinline__ float bf_lo(unsigned u) { return __uint_as_float(u << 16); }
__device__ __forceinline__ float bf_hi(unsigned u) { return __uint_as_float(u & 0xffff0000u); }
__device__ __forceinline__ float fast_sigmoid(float x) { return __builtin_amdgcn_rcpf(1.f + __builtin_amdgcn_exp2f(-1.4426950408889634f * x)); }
__device__ __forceinline__ float wave_sum(float v) {
#pragma unroll
    for (int o = 1; o < 64; o <<= 1) v += __shfl_xor(v, o);
    return v;
}

namespace pg8 {
constexpr int BM = 256, BK = 64, HALF = 128, HTB = HALF * BK * 2  , STAGE_BYTES = 8 * HTB, NXCD = 8, WGM = 8;
__host__ __device__ __forceinline__ int lds_byte(int r, int c) { const int st = (r >> 4) * 2 + (c >> 5), rr = r & 15, cc = c & 31, ob = rr * 64 + cc * 2; return st * 1024 + (ob ^ (((ob >> 9) & 1) << 5)); }
__host__ __device__ __forceinline__ void stage_rc(int b, int& R, int& C) { const int st = b / 1024, sb = b % 1024, swz = sb ^ (((sb >> 9) & 1) << 5); R = (st >> 1) * 16 + swz / 64; C = (st & 1) * 32 + (swz % 64) / 2; }
__host__ __device__ __forceinline__ int perm32(int rho) { const int n = rho >> 4, i = rho & 15; return 8 * (i >> 2) + 4 * n + (i & 3); }

struct Unit { const char* a; const char* b; int pm, pn, kind, keep; };

__device__ __forceinline__ void tile_of(int L, int nM, int nN, int& pm, int& pn) {
    const int nwg = nM * nN; int wgid = L;
    { const int q = nwg / NXCD, r = nwg % NXCD, xcd = wgid % NXCD, off = wgid / NXCD; wgid = (xcd < r ? xcd * (q + 1) : r * (q + 1) + (xcd - r) * q) + off; }
    const int nig = WGM * nN, gid = wgid / nig, fm = gid * WGM, gsz = (nM - fm) < WGM ? (nM - fm) : WGM;
    pm = fm + ((wgid % nig) % gsz); pn = (wgid % nig) / gsz;
}

typedef int i32x4v __attribute__((ext_vector_type(4)));
typedef int i32x8v __attribute__((ext_vector_type(8)));
__device__ __forceinline__ i32x8v cat8(bf16x8 a, bf16x8 b) { const i32x4v x = __builtin_bit_cast(i32x4v, a), y = __builtin_bit_cast(i32x4v, b); return __builtin_shufflevector(x, y, 0, 1, 2, 3, 4, 5, 6, 7); }
__device__ __forceinline__ void mfma_f8_acc(f32x4& c, i32x8v a, i32x8v b) { asm volatile("v_mfma_f32_16x16x128_f8f6f4 %0, %1, %2, %0" : "+v"(c) : "v"(a), "v"(b)); }
template <class Epi, class Sched, bool ALIGN_EPI, bool F8 = false>
__device__ __forceinline__ void gemm_phase(LAS unsigned char* lds, const int K, const Sched& S, const Epi& E) {
    const int tid = threadIdx.x, wid = __builtin_amdgcn_readfirstlane(tid >> 6), lane = tid & 63, wr = wid >> 2, wc = wid & 3, fr = lane & 15, fq = lane >> 4;
    const int nt = K / BK;
    unsigned voffA[2], voffB[2];
#pragma unroll
    for (int i = 0; i < 2; ++i) { int R, C; stage_rc(tid * 16 + i * 8192, R, C); const int Rb = Epi::PERM ? ((R & ~31) + perm32(R & 31)) : R;
        voffA[i] = (unsigned)(R * K + C) * 2u; voffB[i] = (unsigned)(Rb * K + C) * 2u; }
    const size_t kstep = (size_t)(BK * 2);
    const size_t hstep = (size_t)HALF * K * 2;
    const unsigned ldsw = (unsigned)wid * 1024u;
    const int aoff = lds_byte(wr * 64 + fr, fq * 8), boff = lds_byte(wc * 32 + fr, fq * 8);
#define PG8_SA(b, h) (((b) * 2 + (h)) * HTB)
#define PG8_SB(b, h) ((4 + (b) * 2 + (h)) * HTB)
#define PG8_STAGE(bufoff, gbase, voff) do { _Pragma("unroll") for (int _i = 0; _i < 2; ++_i) \
        __builtin_amdgcn_global_load_lds((const unsigned*)((const char*)(gbase) + (voff)[_i]), (LAS unsigned*)(lds + (bufoff) + ldsw + _i * 8192), 16, 0, 0); } while (0)
#define PG8_LDA(dst, b, h) do { _Pragma("unroll") for (int m = 0; m < 4; ++m) _Pragma("unroll") for (int k = 0; k < 2; ++k) dst[m][k] = *(const LAS bf16x8*)(lds + PG8_SA(b, h) + aoff + m * 2048 + k * 1024); } while (0)
#define PG8_LDB(dst, b, h) do { _Pragma("unroll") for (int n = 0; n < 2; ++n) _Pragma("unroll") for (int k = 0; k < 2; ++k) dst[n][k] = *(const LAS bf16x8*)(lds + PG8_SB(b, h) + boff + n * 2048 + k * 1024); } while (0)
#define PG8_MMA(ai, bj, At, Bt) do { __builtin_amdgcn_s_setprio(1); if constexpr (F8) { _Pragma("unroll") for (int m = 0; m < 4; ++m) _Pragma("unroll") for (int n = 0; n < 2; ++n) \
        mfma_f8_acc(acc[ai][bj][m][n], cat8(Bt[n][0], Bt[n][1]), cat8(At[m][0], At[m][1])); } else { \
        _Pragma("unroll") for (int m = 0; m < 4; ++m) _Pragma("unroll") for (int n = 0; n < 2; ++n) _Pragma("unroll") for (int k = 0; k < 2; ++k) \
        acc[ai][bj][m][n] = __builtin_amdgcn_mfma_f32_16x16x32_bf16(Bt[n][k], At[m][k], acc[ai][bj][m][n], 0, 0, 0); } __builtin_amdgcn_s_setprio(0); } while (0)
#define PG8_WAIT_V(n) asm volatile("s_waitcnt vmcnt(" #n ")" ::: "memory")
#define PG8_WAIT_L(n) asm volatile("s_waitcnt lgkmcnt(" #n ")" ::: "memory")
#define PG8_BAR __builtin_amdgcn_s_barrier()
#define PG8_SCHED __builtin_amdgcn_sched_barrier(0)
    Unit cur, nxt; int ui = 0;
    if (!S.next(0, cur)) return;
    f32x4 acc[2][2][4][2];
#pragma unroll
    for (int a = 0; a < 2; ++a)
#pragma unroll
        for (int b = 0; b < 2; ++b)
#pragma unroll
            for (int m = 0; m < 4; ++m)
#pragma unroll
                for (int n = 0; n < 2; ++n) acc[a][b][m][n] = (f32x4){0.f, 0.f, 0.f, 0.f};
    bf16x8 At[4][2], B0[2][2], B1[2][2];
    const char* cA = cur.a; const char* cB = cur.b;
    PG8_STAGE(PG8_SB(0, 0), cB, voffB); PG8_STAGE(PG8_SB(0, 1), cB + hstep, voffB); PG8_STAGE(PG8_SA(0, 0), cA, voffA); PG8_STAGE(PG8_SA(0, 1), cA + hstep, voffA);
    if (wr == 1) PG8_BAR;
    PG8_WAIT_V(2); PG8_BAR;
    PG8_STAGE(PG8_SB(1, 0), cB + kstep, voffB); PG8_STAGE(PG8_SA(1, 0), cA + kstep, voffA); PG8_STAGE(PG8_SB(1, 1), cB + hstep + kstep, voffB);
    PG8_WAIT_V(6); PG8_BAR;
    for (;;) {
        const bool has_next = S.next(ui + 1, nxt);
        const char* nA = has_next ? nxt.a : cA; const char* nB = has_next ? nxt.b : cB;
#pragma unroll 1
        for (int t = 0; t < nt; t += 2) {
            const bool last = (t == nt - 2);
            const char* a1 = cA + (size_t)(t + 1) * kstep;
            const char* a2 = last ? nA : cA + (size_t)(t + 2) * kstep; const char* b2 = last ? nB : cB + (size_t)(t + 2) * kstep;
            const char* a3 = a2 + kstep; const char* b3 = b2 + kstep;
            PG8_LDB(B0, 0, 0); PG8_LDB(B1, 0, 1); PG8_SCHED; PG8_LDA(At, 0, 0); PG8_STAGE(PG8_SA(1, 1), a1 + hstep, voffA);
            PG8_WAIT_V(8); PG8_WAIT_L(0); PG8_BAR; PG8_MMA(0, 0, At, B0); PG8_MMA(0, 1, At, B1); PG8_BAR; PG8_SCHED;
            PG8_LDA(At, 0, 1); PG8_STAGE(PG8_SB(0, 0), b2, voffB); PG8_STAGE(PG8_SB(0, 1), b2 + hstep, voffB); PG8_STAGE(PG8_SA(0, 0), a2, voffA);
            PG8_WAIT_V(8); PG8_WAIT_L(0); PG8_BAR; PG8_MMA(1, 0, At, B0); PG8_MMA(1, 1, At, B1); PG8_BAR; PG8_SCHED;
            PG8_LDB(B0, 1, 0); PG8_LDB(B1, 1, 1); PG8_SCHED; PG8_LDA(At, 1, 0); PG8_STAGE(PG8_SA(0, 1), a2 + hstep, voffA);
            PG8_WAIT_V(8); PG8_WAIT_L(0); PG8_BAR; PG8_MMA(0, 0, At, B0); PG8_MMA(0, 1, At, B1); PG8_BAR; PG8_SCHED;
            PG8_LDA(At, 1, 1); PG8_STAGE(PG8_SB(1, 0), b3, voffB); PG8_STAGE(PG8_SB(1, 1), b3 + hstep, voffB); PG8_STAGE(PG8_SA(1, 0), a3, voffA);
            PG8_WAIT_V(8); PG8_WAIT_L(0); PG8_BAR; PG8_MMA(1, 0, At, B0); PG8_MMA(1, 1, At, B1); PG8_BAR; PG8_SCHED;
        }
        if constexpr (ALIGN_EPI) { if (wr == 0) PG8_BAR; }
        if constexpr (F8) { asm volatile("s_nop 15\n\ts_nop 15" ::: "memory");
#pragma unroll
            for (int a = 0; a < 2; ++a)
#pragma unroll
                for (int b = 0; b < 2; ++b)
#pragma unroll
                    for (int m = 0; m < 4; ++m)
#pragma unroll
                        for (int n = 0; n < 2; ++n) acc[a][b][m][n] *= (1.f / 8192.f); }
        E(acc, cur, wr, wc, fr, fq);
        if (!has_next) break;
        if (!cur.keep) {
#pragma unroll
        for (int a = 0; a < 2; ++a)
#pragma unroll
            for (int b = 0; b < 2; ++b)
#pragma unroll
                for (int m = 0; m < 4; ++m)
#pragma unroll
                    for (int n = 0; n < 2; ++n) acc[a][b][m][n] = (f32x4){0.f, 0.f, 0.f, 0.f};
        }
        cur = nxt; cA = nA; cB = nB; ++ui;
        if constexpr (ALIGN_EPI) { if (wr == 1) PG8_BAR; }
    }
    PG8_WAIT_V(0);
    if constexpr (!ALIGN_EPI) { if (wr == 0) PG8_BAR; }
    PG8_BAR;
#undef PG8_SA
#undef PG8_SB
#undef PG8_STAGE
#undef PG8_LDA
#undef PG8_LDB
#undef PG8_MMA
#undef PG8_WAIT_V
#undef PG8_WAIT_L
#undef PG8_BAR
#undef PG8_SCHED
}
}
namespace att {
typedef int v8i __attribute__((ext_vector_type(8)));
constexpr int NW = 8, QBLK = 32, KVBLK = 64;
constexpr float SCALE = 0.088388347648318440f;
constexpr float SC8 = SCALE / 256.f;
constexpr float THR = 3.f;
constexpr int LDQ = D, LDO = D;
constexpr int SHM_V = 8192, SHM_K = 8192, NRING = 3, OFF_K = NRING * SHM_V, OFF_WS = OFF_K + NRING * SHM_K, OST_OFF = OFF_WS + NW * 64 * 4, LDS_TOTAL = OST_OFF + NW * 8192;
#define SBAR() __builtin_amdgcn_sched_barrier(0)
#define MFMA8(a, b, c) __builtin_amdgcn_mfma_scale_f32_32x32x64_f8f6f4((a), (b), (c), 0, 0, 0, 0x7f7f7f7f, 0, 0x7f7f7f7f)
__device__ __forceinline__ int crow(int r, int hi) { return (r & 3) + 8 * (r >> 2) + 4 * hi; }
__device__ __forceinline__ int k_lds(int row, int chunk) { return row * 128 + ((chunk ^ ((row >> 1) & 7)) << 4); }
__device__ __forceinline__ int v_lds(int d, int slot) { return d * 64 + ((slot ^ ((d >> 2) & 3)) << 4); }
__device__ __forceinline__ float max3f(float a, float b, float c) { float r; asm("v_max3_f32 %0, %1, %2, %3" : "=v"(r) : "v"(a), "v"(b), "v"(c)); return r; }
__device__ __forceinline__ int pk4_fp8(float a, float b, float c, float d) { int w = __builtin_amdgcn_cvt_pk_fp8_f32(a, b, 0, false); return __builtin_amdgcn_cvt_pk_fp8_f32(c, d, w, true); }

__device__ __forceinline__ void partialSM(f32x16& p0, f32x16& p1, float& m_reg, float& mn, float& alpha) {
  constexpr float C = SC8 * 1.4426950408889634f;
  asm volatile("s_nop 15\n\ts_nop 7" : "+v"(p0), "+v"(p1));
  float mx[8];
#pragma unroll
  for (int i = 0; i < 8; ++i) mx[i] = max3f(p0[i], p0[8 + i], p1[i]);
  float m4[4];
#pragma unroll
  for (int i = 0; i < 4; ++i) m4[i] = max3f(mx[i], mx[4 + i], p1[8 + i]);
  float m2a = max3f(m4[0], m4[1], p1[12]), m2b = max3f(m4[2], m4[3], p1[13]);
  float pmax = max3f(m2a, m2b, p1[14]); pmax = max3f(pmax, p1[15], p1[15]);
  { auto rr = __builtin_amdgcn_permlane32_swap(__float_as_uint(pmax), __float_as_uint(pmax), false, false);
    pmax = fmaxf(__uint_as_float(rr[0]), __uint_as_float(rr[1])); }
  if (__builtin_expect(__all(pmax - m_reg <= THR / SC8), 1)) { mn = m_reg; alpha = 1.f; }
  else { mn = fmaxf(m_reg, pmax); alpha = __builtin_amdgcn_exp2f((m_reg - mn) * C); m_reg = mn; }
  float mnC = 4.f - mn * C;
  for (int r = 0; r < 16; ++r) p0[r] = fmaf(p0[r], C, mnC); for (int r = 0; r < 16; ++r) p1[r] = fmaf(p1[r], C, mnC);
  for (int r = 0; r < 16; ++r) p0[r] = __builtin_amdgcn_exp2f(p0[r]);
}
__device__ __forceinline__ void finishSM(f32x16& p0, f32x16& p1, float alpha, float& l_reg, v8i& pa) {
  for (int r = 0; r < 16; ++r) p1[r] = __builtin_amdgcn_exp2f(p1[r]);
  float sm[8];
#pragma unroll
  for (int i = 0; i < 8; ++i) sm[i] = (p0[i] + p0[8 + i]) + (p1[i] + p1[8 + i]);
  float ps = ((sm[0] + sm[1]) + (sm[2] + sm[3])) + ((sm[4] + sm[5]) + (sm[6] + sm[7]));
  { auto rr = __builtin_amdgcn_permlane32_swap(__float_as_uint(ps), __float_as_uint(ps), false, false);
    ps = __uint_as_float(rr[0]) + __uint_as_float(rr[1]); }
  l_reg = l_reg * alpha + ps;
  pa[0] = pk4_fp8(p0[0], p0[1], p0[2], p0[3]); pa[1] = pk4_fp8(p0[4], p0[5], p0[6], p0[7]); pa[2] = pk4_fp8(p0[8], p0[9], p0[10], p0[11]); pa[3] = pk4_fp8(p0[12], p0[13], p0[14], p0[15]);
  pa[4] = pk4_fp8(p1[0], p1[1], p1[2], p1[3]); pa[5] = pk4_fp8(p1[4], p1[5], p1[6], p1[7]); pa[6] = pk4_fp8(p1[8], p1[9], p1[10], p1[11]); pa[7] = pk4_fp8(p1[12], p1[13], p1[14], p1[15]);
}
__device__ __forceinline__ v8i ld32(const char* p0, const char* p1) { const u32x4 a = *reinterpret_cast<const u32x4*>(p0), b = *reinterpret_cast<const u32x4*>(p1);
  v8i r; r[0] = (int)a[0]; r[1] = (int)a[1]; r[2] = (int)a[2]; r[3] = (int)a[3]; r[4] = (int)b[0]; r[5] = (int)b[1]; r[6] = (int)b[2]; r[7] = (int)b[3]; return r; }
__device__ __forceinline__ void qkt(f32x16& p0, f32x16& p1, const char* Ks, const v8i* qf, int r32, int hi) {
  p0 = f32x16{}; p1 = f32x16{};
#pragma unroll
  for (int s = 0; s < 2; ++s) {
    const v8i a0 = ld32(Ks + k_lds(r32, 4 * s + hi), Ks + k_lds(r32, 4 * s + 2 + hi)), a1 = ld32(Ks + k_lds(32 + r32, 4 * s + hi), Ks + k_lds(32 + r32, 4 * s + 2 + hi));
    p0 = MFMA8(a0, qf[s], p0); p1 = MFMA8(a1, qf[s], p1); }
}
__device__ __forceinline__ void pv(f32x16* o, const char* Vs, const v8i pa, int r32, int hi) {
#pragma unroll
  for (int d0 = 0; d0 < 4; ++d0) { const int d = 32 * d0 + r32; const v8i b = ld32(Vs + v_lds(d, 2 * hi), Vs + v_lds(d, 2 * hi + 1)); o[d0] = MFMA8(pa, b, o[d0]); }
}

__device__ __forceinline__ void attn_unit(const bf16_t* Qb, const unsigned char* __restrict__ K8, const unsigned char* __restrict__ VT, bf16_t* Ob, int t0, int seq,
                                          const float* __restrict__ qng, const float* __restrict__ cst, const float* __restrict__ snt, char* lds) {
  int tid_ = threadIdx.x; asm volatile("" : "+v"(tid_));
  const int tid = tid_, wid = tid >> 6, lane = tid & 63, r32 = lane & 31, hi = lane >> 5;
  char* V_lds = lds; char* K_lds = lds + OFF_K;
  float* ws = (float*)(lds + OFF_WS) + wid * 64; float* li_l = ws; float* al_l = ws + 32;
  float m_reg = -1e30f, l_reg = 0; f32x16 o[4] = {}; v8i qf[2];
  {
    const bf16_t* Qw = Qb + (long)(wid * QBLK + r32) * LDQ + 16 * hi;
    float y[2][32]; float ss = 0.f;
#pragma unroll
    for (int s = 0; s < 2; ++s)
#pragma unroll
      for (int part = 0; part < 2; ++part)
#pragma unroll
        for (int c = 0; c < 2; ++c) { const u32x4 w = *reinterpret_cast<const u32x4*>(Qw + 64 * s + 32 * part + 8 * c);
#pragma unroll
          for (int j = 0; j < 4; ++j) { const float a = bf_lo(w[j]), b = bf_hi(w[j]); y[s][16 * part + 8 * c + 2 * j] = a; y[s][16 * part + 8 * c + 2 * j + 1] = b; ss += a * a + b * b; } }
    ss += __shfl_xor(ss, 32);
    const float rstd = rsqrtf(ss * (1.f / HD) + EPS) * 16.f;
    const int t = t0 + wid * QBLK + r32;
#pragma unroll
    for (int s = 0; s < 2; ++s) { const int pos = s == 0 ? (t >> 6) : (t & 63);
#pragma unroll
      for (int c = 0; c < 4; ++c) { const int i0 = 16 * hi + 4 * c;
        const f32x4 g1 = *reinterpret_cast<const f32x4*>(qng + 64 * s + i0), g2 = *reinterpret_cast<const f32x4*>(qng + 64 * s + 32 + i0);
        const f32x4 c4 = *reinterpret_cast<const f32x4*>(cst + pos * 32 + i0), s4 = *reinterpret_cast<const f32x4*>(snt + pos * 32 + i0);
#pragma unroll
        for (int j = 0; j < 4; ++j) { const float x1 = y[s][4 * c + j] * rstd * g1[j], x2 = y[s][16 + 4 * c + j] * rstd * g2[j]; y[s][4 * c + j] = x1 * c4[j] - x2 * s4[j]; y[s][16 + 4 * c + j] = x1 * s4[j] + x2 * c4[j]; } }
#pragma unroll
      for (int w = 0; w < 8; ++w) qf[s][w] = pk4_fp8(y[s][4 * w], y[s][4 * w + 1], y[s][4 * w + 2], y[s][4 * w + 3]); }
  }
  const int krow = tid >> 3, kch = tid & 7, kst = k_lds(krow, kch), vst = v_lds(tid >> 2, tid & 3);
  const unsigned char* kg = K8 + (long)krow * 256 + kch * 16; const unsigned char* vg = VT + tid * 16;
  struct { u32x4 k, v; } sr_[2];
#define SLOAD(i, kt) do { sr_[i].k = *reinterpret_cast<const u32x4*>(kg + (long)(kt) * (KVBLK * 256)); sr_[i].v = *reinterpret_cast<const u32x4*>(vg + (long)(kt) * 8192); } while (0)
#define SWRITE(boff, i) do { *(u32x4*)(V_lds + (boff) + vst) = sr_[i].v; *(u32x4*)(K_lds + (boff) + kst) = sr_[i].k; } while (0)
#define SWAIT() asm volatile("s_waitcnt vmcnt(2)" ::: "memory")
#define RESC(a) do { if (__any((a) < 1.f)) { if (hi == 0) al_l[r32] = (a); asm volatile("s_waitcnt lgkmcnt(0)" ::: "memory"); \
    for (int d = 0; d < 4; ++d) for (int r = 0; r < 16; ++r) o[d][r] *= al_l[crow(r, hi)]; } } while (0)
  f32x16 pA0, pA1, pB0, pB1; float mnA, mnB, alA, alB; v8i pa; const int NT = seq / KVBLK;
  constexpr int SE = 0, SO = 1;
  int bprev = 0, bcur = SHM_K, bnext = 2 * SHM_K;
#define ROT() do { const int t_ = bprev; bprev = bcur; bcur = bnext; bnext = t_; } while (0)
  SLOAD(SE, 0); asm volatile("s_waitcnt vmcnt(0)" ::: "memory"); SWRITE(0, SE); __syncthreads();
  qkt(pA0, pA1, K_lds, qf, r32, hi); partialSM(pA0, pA1, m_reg, mnA, alA);
  SLOAD(SO, 1); if (2 < NT) SLOAD(SE, 2);
  SWAIT(); SWRITE(SHM_K, SO); __syncthreads();
  for (int j = 1; j + 1 < NT; j += 2) {
    SBAR(); qkt(pB0, pB1, K_lds + bcur, qf, r32, hi);
    finishSM(pA0, pA1, alA, l_reg, pa); SBAR();
    SLOAD(SO, j + 2); SBAR();
    pv(o, V_lds + bprev, pa, r32, hi); partialSM(pB0, pB1, m_reg, mnB, alB);
    SWAIT(); SWRITE(bnext, SE);
    RESC(alB); __syncthreads(); ROT();
    SBAR(); qkt(pA0, pA1, K_lds + bcur, qf, r32, hi);
    finishSM(pB0, pB1, alB, l_reg, pa); SBAR();
    if (j + 3 < NT) SLOAD(SE, j + 3); SBAR();
    pv(o, V_lds + bprev, pa, r32, hi); partialSM(pA0, pA1, m_reg, mnA, alA);
    SWAIT(); SWRITE(bnext, SO);
    RESC(alA); __syncthreads(); ROT();
  }
  SBAR(); qkt(pB0, pB1, K_lds + bcur, qf, r32, hi);
  finishSM(pA0, pA1, alA, l_reg, pa); SBAR();
  pv(o, V_lds + bprev, pa, r32, hi); partialSM(pB0, pB1, m_reg, mnB, alB);
  RESC(alB);
  finishSM(pB0, pB1, alB, l_reg, pa); SBAR();
  pv(o, V_lds + bcur, pa, r32, hi);
  __syncthreads();
#undef ROT
  if (hi == 0) li_l[r32] = l_reg; asm volatile("s_waitcnt lgkmcnt(0)" ::: "memory");
  float rli[16];
#pragma unroll
  for (int r = 0; r < 16; ++r) rli[r] = __builtin_amdgcn_rcpf(16.f * li_l[crow(r, hi)]);
  { bf16_t* stg = (bf16_t*)(lds + OST_OFF) + wid * 4096;
#pragma unroll
    for (int r = 0; r < 16; ++r) { const int orow = crow(r, hi);
#pragma unroll
      for (int d0 = 0; d0 < 4; ++d0) stg[orow * 128 + d0 * 32 + r32] = (bf16_t)(cvt_pk_bf16(o[d0][r] * rli[r], 0.f) & 0xffffu); }
    asm volatile("s_waitcnt lgkmcnt(0)" ::: "memory");
    bf16_t* Ow = Ob + (long)(wid * QBLK) * LDO;
#pragma unroll
    for (int i = 0; i < 8; ++i) { const int row = i * 4 + (lane >> 4), ch = lane & 15; const u32x4 v = *(const u32x4*)(stg + row * 128 + ch * 8); *(u32x4*)(Ow + (long)row * LDO + ch * 8) = v; }
  }
#undef SLOAD
#undef SWRITE
#undef SWAIT
#undef RESC
}
#undef SBAR
#undef MFMA8
}
constexpr size_t MiB = 1u << 20;
constexpr size_t WS_CTL = 0, CTL_ZERO_BYTES = 64 * 1024;
constexpr size_t WS_MOD = 1 * MiB;
constexpr size_t WS_ROPE = WS_MOD + 256 * 1024;
constexpr size_t WS_SBIAS = WS_MOD + 512 * 1024;
constexpr size_t WS_HC = 2 * MiB;
constexpr size_t WS_WIN = 6 * MiB;
constexpr size_t WS_WA = 17 * MiB, WS_WC = 19 * MiB, WS_WO = 21 * MiB;
constexpr size_t WS_WP = 23 * MiB;
constexpr size_t WS_UT = 27 * MiB, WS_VT = 59 * MiB;
constexpr size_t WS_TSCALE = 16 * MiB;
constexpr size_t WS_KB = 91 * MiB, WS_VB = 108 * MiB;
constexpr size_t WS_HX = 125 * MiB;
constexpr size_t WS_Q = 189 * MiB;
constexpr size_t WS_G = 253 * MiB;
constexpr size_t WS_RT = 317 * MiB;
constexpr size_t WS_XSB = WS_RT;
constexpr size_t WS_SGC = 381 * MiB;
constexpr size_t WS_SC = 189 * MiB;
constexpr size_t WS_SSQ = 445 * MiB;
constexpr size_t WS_K8 = 447 * MiB;
constexpr size_t WS_VT8 = 456 * MiB;
constexpr size_t WS_PE = 465 * MiB, WS_PC = 481 * MiB;
constexpr size_t WS_END = 497 * MiB;

constexpr int NWAVES = 8;
constexpr int LDS_BYTES = 147456;

struct Args {
    const float *x, *c, *ctx, *c_ctx, *w_mod, *b_mod, *n1g, *n2g, *w_in, *qng, *kng, *w_ao, *cdw, *cb, *clg, *clb, *w_co, *w_o, *wq, *keys, *ut, *vt, *fg;
    float* out; unsigned char* ws; int ph_lo, ph_hi, dry, pad;
};

__host__ __device__ __forceinline__ int win_row(int n) {
    if (n < 1536) return n;
    const int base = n < 3584 ? 1536 : 3584, m = n - base, half = m >> 10, idx = m & 1023;
    return base + (idx >> 7) * 256 + half * 128 + (idx & 127);
}

__device__ __forceinline__ void task_mod(const Args& A, int task, int lane, const LAS float* sc) {
    const int n0 = task * 8, col = lane & 7, kg = lane >> 3;
    float acc[9];
#pragma unroll
    for (int b = 0; b < 9; ++b) acc[b] = 0.f;
    const float* wp = A.w_mod + (size_t)kg * NMOD + n0 + col;
    for (int i0 = 0; i0 < 128; i0 += 8) {
        float w[8];
#pragma unroll
        for (int u = 0; u < 8; ++u) w[u] = wp[(size_t)(i0 + u) * 8 * NMOD];
#pragma unroll
        for (int u = 0; u < 8; ++u) { const int k = kg + 8 * (i0 + u);
#pragma unroll
            for (int b = 0; b < 9; ++b) acc[b] += sc[b * D + k] * w[u]; }
    }
#pragma unroll
    for (int b = 0; b < 9; ++b) { float v = acc[b]; v += __shfl_xor(v, 8); v += __shfl_xor(v, 16); v += __shfl_xor(v, 32); acc[b] = v; }
    if (lane < 8) { float* mod = (float*)(A.ws + WS_MOD); const float bm = A.b_mod[n0 + col];
#pragma unroll
        for (int b = 0; b < 9; ++b) mod[b * NMOD + n0 + col] = acc[b] + bm; }
}
__device__ __forceinline__ void task_transpose(const float* W, int K, int N, bf16_t* WT, int k0, int n0, int row0, LAS float* scr, int lane) {
#pragma unroll 8
    for (int i = 0; i < 32; ++i) { const int kk = 2 * i + (lane >> 5); scr[kk * 33 + (lane & 31)] = W[(size_t)(k0 + kk) * N + n0 + (lane & 31)]; }
    asm volatile("s_waitcnt lgkmcnt(0)" ::: "memory");
    const int c = lane & 7;
#pragma unroll
    for (int j = 0; j < 4; ++j) { const int n = (lane >> 3) + 8 * j; const LAS float* s = scr + (8 * c) * 33 + n;
        u32x4 o; o.x = cvt_pk_bf16(s[0 * 33], s[1 * 33]); o.y = cvt_pk_bf16(s[2 * 33], s[3 * 33]); o.z = cvt_pk_bf16(s[4 * 33], s[5 * 33]); o.w = cvt_pk_bf16(s[6 * 33], s[7 * 33]);
        *(u32x4*)(WT + (size_t)(row0 + n) * K + k0 + 8 * c) = o; }
    asm volatile("s_waitcnt lgkmcnt(0)" ::: "memory");
}
__device__ __forceinline__ void task_transpose_f8(const float* W, int K, int N, unsigned char* WT, int k0, int n0, int row0, LAS float* scr, int lane) {
#pragma unroll 8
    for (int i = 0; i < 32; ++i) { const int kk = 2 * i + (lane >> 5); scr[kk * 33 + (lane & 31)] = W[(size_t)(k0 + kk) * N + n0 + (lane & 31)]; }
    asm volatile("s_waitcnt lgkmcnt(0)" ::: "memory");
    const int c = lane & 7;
#pragma unroll
    for (int j = 0; j < 4; ++j) { const int n = (lane >> 3) + 8 * j; const LAS float* s = scr + (8 * c) * 33 + n;
        u32x2 o = {(unsigned)att::pk4_fp8(s[0 * 33] * 512.f, s[1 * 33] * 512.f, s[2 * 33] * 512.f, s[3 * 33] * 512.f), (unsigned)att::pk4_fp8(s[4 * 33] * 512.f, s[5 * 33] * 512.f, s[6 * 33] * 512.f, s[7 * 33] * 512.f)};
        *(u32x2*)(WT + (size_t)(row0 + n) * K + k0 + 8 * c) = o; }
    asm volatile("s_waitcnt lgkmcnt(0)" ::: "memory");
}
typedef float f32x16v __attribute__((ext_vector_type(16)));
typedef unsigned u32x6 __attribute__((ext_vector_type(6)));
constexpr int ROWB = 768;
__device__ __forceinline__ void task_quant_rows4(const float* src, unsigned char* dst, float* scale_out, int lane) {
    const int g = lane & 31, hh = lane >> 5;
    f32x4 v[2][8];
#pragma unroll
    for (int r = 0; r < 2; ++r)
#pragma unroll
        for (int i = 0; i < 8; ++i) v[r][i] = *(const f32x4*)(src + (size_t)(2 * r + hh) * D + g * 32 + i * 4);
#pragma unroll
    for (int r = 0; r < 2; ++r) {
        float am = 0.f;
#pragma unroll
        for (int i = 0; i < 8; ++i) am = fmaxf(fmaxf(am, fmaxf(fabsf(v[r][i][0]), fabsf(v[r][i][1]))), fmaxf(fabsf(v[r][i][2]), fabsf(v[r][i][3])));
#pragma unroll
        for (int o = 1; o < 32; o <<= 1) am = fmaxf(am, __shfl_xor(am, o));
        const float inv = am > 0.f ? 7.5f / am : 0.f;
        f32x16v a, b;
#pragma unroll
        for (int i = 0; i < 4; ++i)
#pragma unroll
            for (int j = 0; j < 4; ++j) { const int e0 = 4 * i + j;
                a[e0] = v[r][(2 * e0) >> 2][(2 * e0) & 3] * inv; b[e0] = v[r][(2 * e0 + 1) >> 2][(2 * e0 + 1) & 3] * inv; }
        const u32x6 p = __builtin_amdgcn_cvt_scalef32_2xpk16_fp6_f32(a, b, 1.0f);
        unsigned char* rowp = dst + (size_t)(2 * r + hh) * ROWB;
        *(u32x4*)(rowp + g * 16) = (u32x4){p[0], p[1], p[2], p[3]}; *(u32x2*)(rowp + 512 + g * 8) = (u32x2){p[4], p[5]};
        if (g == 0) scale_out[2 * r + hh] = am * (1.f / 7.5f);
    }
}
__device__ __forceinline__ bf16x8 ld8_f32_bf16(const float* p) { const f32x4 a = *(const f32x4*)p, b = *(const f32x4*)(p + 4); u32x4 w = {cvt_pk_bf16(a[0], a[1]), cvt_pk_bf16(a[2], a[3]), cvt_pk_bf16(b[0], b[1]), cvt_pk_bf16(b[2], b[3])}; return *reinterpret_cast<bf16x8*>(&w); }
__device__ __forceinline__ void task_wprime(const Args& A, int id, int lane) {
    const int hp = id >> 7, rem = id & 127, n0 = (rem >> 5) * 32, k0 = (rem & 31) * 32, r32 = lane & 31, hi = lane >> 5;
    f32x16 acc = {};
    const float* ka = A.keys + ((size_t)(hp * 128 + n0 + r32)) * 128 + hi * 8;
    const float* wb = A.wq + (size_t)(k0 + r32) * PW + hp * 128 + hi * 8;
#pragma unroll
    for (int s = 0; s < 8; ++s) acc = __builtin_amdgcn_mfma_f32_32x32x16_bf16(ld8_f32_bf16(ka + s * 16), ld8_f32_bf16(wb + s * 16), acc, 0, 0, 0);
    bf16_t* o = (bf16_t*)(A.ws + WS_WP);
#pragma unroll
    for (int r = 0; r < 16; ++r) { const int n = (r & 3) + 8 * (r >> 2) + 4 * hi; o[(size_t)(hp * 128 + n0 + n) * D + k0 + r32] = (bf16_t)(cvt_pk_bf16(acc[r], 0.f) & 0xffffu); }
}
__device__ __forceinline__ void phase_prologue(const Args& A, LAS unsigned char* lds) {
    const int tid = threadIdx.x, lane = tid & 63, wave = __builtin_amdgcn_readfirstlane(tid >> 6);
    LAS float* sc = (LAS float*)lds;
    for (int i = tid; i < 9 * D; i += 512) { const float v = i < 8 * D ? A.c[i] : A.c_ctx[i - 8 * D]; sc[i] = v / (1.f + __expf(-v)); }
    __syncthreads();
    LAS float* scr = (LAS float*)(lds + 36864 + wave * 8448);
    constexpr int T_MOD = NMOD / 8, T_WIN = (D / 64) * (INW / 32), T_SQ = (D / 64) * (D / 32), T_UV = 2 * NEXP / 4, T_WP = 2048, T_ROPE = 1;
    constexpr int NT = T_MOD + T_WIN + 3 * T_SQ + T_UV + T_WP + T_ROPE;
    const int G = gridDim.x;
    for (int task = wave * G + blockIdx.x; task < NT; task += NWAVES * G) {
        int r = task;
        if (r < T_MOD) { task_mod(A, r, lane, sc); continue; } r -= T_MOD;
        if (r < T_WIN) { const int nblk = INW / 32, kb = r / nblk, nb = r % nblk; task_transpose_f8(A.w_in, D, INW, A.ws + WS_WIN, 64 * kb, 32 * nb, win_row(32 * nb), scr, lane); continue; } r -= T_WIN;
        if (r < 3 * T_SQ) { const int wsel = r / T_SQ, q = r % T_SQ, kb = q / 32, nb = q % 32;
            const float* W = wsel == 0 ? A.w_ao : (wsel == 1 ? A.w_co : A.w_o); bf16_t* WT = (bf16_t*)(A.ws + (wsel == 0 ? WS_WA : (wsel == 1 ? WS_WC : WS_WO)));
            task_transpose(W, D, D, WT, 64 * kb, 32 * nb, 32 * nb, scr, lane); continue; } r -= 3 * T_SQ;
        if (r < T_UV) { const int tb = r / (NEXP / 4), row = (r % (NEXP / 4)) * 4; unsigned char* tbase = A.ws + (tb ? WS_VT : WS_UT);
            task_quant_rows4((tb ? A.vt : A.ut) + (size_t)row * D, tbase + (size_t)row * ROWB, (float*)(tbase + WS_TSCALE) + row, lane); continue; } r -= T_UV;
        if (r < T_WP) { task_wprime(A, r, lane); continue; } r -= T_WP;
        { float* cs = (float*)(A.ws + WS_ROPE); float* sn = cs + 2048;
          for (int e = lane; e < 2048; e += 64) { const int p = e >> 5, i = e & 31; const float inv = powf(10000.f, -(float)(2 * i) / 64.f); const float a = (float)p * inv; cs[e] = cosf(a); sn[e] = sinf(a); } }
    }
}
__device__ __forceinline__ void normmod_row(const float* xr, const float* g, const float* modr, int sh_off, int sc_off, unsigned char* orow, int lane) {
    f32x4 v[4]; float ss = 0.f;
#pragma unroll
    for (int i = 0; i < 4; ++i) { v[i] = *(const f32x4*)(xr + (i * 64 + lane) * 4); ss += (v[i][0] * v[i][0] + v[i][1] * v[i][1]) + (v[i][2] * v[i][2] + v[i][3] * v[i][3]); }
    const float r = rsqrtf(wave_sum(ss) * (1.f / D) + EPS);
#pragma unroll
    for (int i = 0; i < 4; ++i) { const int k = (i * 64 + lane) * 4; const f32x4 gg = *(const f32x4*)(g + k), s1 = *(const f32x4*)(modr + sc_off + k), h1 = *(const f32x4*)(modr + sh_off + k);
        float y[4];
#pragma unroll
        for (int j = 0; j < 4; ++j) y[j] = v[i][j] * r * gg[j] * (1.f + s1[j]) + h1[j];
        *(unsigned*)(orow + k) = (unsigned)att::pk4_fp8(y[0] * 16.f, y[1] * 16.f, y[2] * 16.f, y[3] * 16.f); }
}
__device__ __forceinline__ void phase_hx(const Args& A) {
    const int lane = threadIdx.x & 63, gw = blockIdx.x * NWAVES + (threadIdx.x >> 6), NGW = gridDim.x * NWAVES;
    const float* mod = (const float*)(A.ws + WS_MOD);
    for (int m = gw; m < M + MC; m += NGW) {
        if (m < M) normmod_row(A.x + (size_t)m * D, A.n1g, mod + (m >> 12) * NMOD, 0, D, A.ws + WS_HX + (size_t)m * D, lane);
        else { const int r = m - M; normmod_row(A.ctx + (size_t)r * D, A.n1g, mod + 8 * NMOD, 0, D, A.ws + WS_HC + (size_t)r * D, lane); }
    }
    const bf16_t* WP = (const bf16_t*)(A.ws + WS_WP); float* sb = (float*)(A.ws + WS_SBIAS);
    for (int col = gw; col < PW; col += NGW) {
        const u32x4 w0 = *(const u32x4*)(WP + (size_t)col * D + lane * 16), w1 = *(const u32x4*)(WP + (size_t)col * D + lane * 16 + 8);
        float wv[16];
#pragma unroll
        for (int j = 0; j < 4; ++j) { wv[2 * j] = bf_lo(w0[j]); wv[2 * j + 1] = bf_hi(w0[j]); wv[8 + 2 * j] = bf_lo(w1[j]); wv[8 + 2 * j + 1] = bf_hi(w1[j]); }
#pragma unroll 1
        for (int b = 0; b < NB; ++b) { const float* sh = mod + b * NMOD + 3 * D + lane * 16; float s = 0.f;
#pragma unroll
            for (int q = 0; q < 4; ++q) { const f32x4 v = *(const f32x4*)(sh + 4 * q); s += v[0] * wv[4 * q] + v[1] * wv[4 * q + 1] + v[2] * wv[4 * q + 2] + v[3] * wv[4 * q + 3]; }
            s = wave_sum(s); if (lane == 0) sb[b * PW + col] = s; }
    }
}
__device__ __forceinline__ void phase_kfix(const Args& A) {
    const int lane = threadIdx.x & 63, gw = blockIdx.x * NWAVES + (threadIdx.x >> 6), NGW = gridDim.x * NWAVES, li = lane & 15, sub = lane >> 4;
    const bf16_t* KB = (const bf16_t*)(A.ws + WS_KB); const float* cs = (const float*)(A.ws + WS_ROPE); const float* sn = cs + 2048;
    constexpr int NITEM = NB * SKV * HKV;
    const f32x4 g0 = *(const f32x4*)(A.kng + li * 8), g1 = *(const f32x4*)(A.kng + li * 8 + 4);
    const f32x4 p0 = *(const f32x4*)(A.kng + (li ^ 4) * 8), p1 = *(const f32x4*)(A.kng + (li ^ 4) * 8 + 4);
    for (int it = gw * 4 + sub; it < NITEM; it += NGW * 4) {
        const int row = it >> 1, h = it & 1, t = row % SKV;
        const bf16_t* p = KB + (size_t)row * 256 + h * HD + li * 8;
        const u32x4 w = *(const u32x4*)p;
        float x[8], xp[8]; float ss = 0.f;
#pragma unroll
        for (int j = 0; j < 4; ++j) { x[2 * j] = bf_lo(w[j]); x[2 * j + 1] = bf_hi(w[j]); ss += x[2 * j] * x[2 * j] + x[2 * j + 1] * x[2 * j + 1];
            const unsigned pw = (unsigned)__shfl_xor((int)w[j], 4); xp[2 * j] = bf_lo(pw); xp[2 * j + 1] = bf_hi(pw); }
        ss += __shfl_xor(ss, 1); ss += __shfl_xor(ss, 2); ss += __shfl_xor(ss, 4); ss += __shfl_xor(ss, 8);
        const float r = rsqrtf(ss * (1.f / HD) + EPS);
        float y[8];
#pragma unroll
        for (int j = 0; j < 8; ++j) { x[j] *= r * (j < 4 ? g0[j] : g1[j - 4]); xp[j] *= r * (j < 4 ? p0[j] : p1[j - 4]); y[j] = x[j]; }
        if (t < S) {
            const int blk = li >> 3, pos = blk == 0 ? (t >> 6) : (t & 63), second = (li >> 2) & 1, i0 = (li & 3) * 8;
            const f32x4 c0 = *(const f32x4*)(cs + pos * 32 + i0), c1 = *(const f32x4*)(cs + pos * 32 + i0 + 4), s0 = *(const f32x4*)(sn + pos * 32 + i0), s1 = *(const f32x4*)(sn + pos * 32 + i0 + 4);
#pragma unroll
            for (int j = 0; j < 8; ++j) { const float c = j < 4 ? c0[j] : c1[j - 4], s = j < 4 ? s0[j] : s1[j - 4];
                y[j] = second ? (xp[j] * s + x[j] * c) : (x[j] * c - xp[j] * s); }
        }
        u32x2 o = {(unsigned)att::pk4_fp8(y[0] * 16.f, y[1] * 16.f, y[2] * 16.f, y[3] * 16.f), (unsigned)att::pk4_fp8(y[4] * 16.f, y[5] * 16.f, y[6] * 16.f, y[7] * 16.f)};
        *(u32x2*)(A.ws + WS_K8 + (size_t)row * 256 + h * HD + li * 8) = o;
    }
}
__device__ __forceinline__ void phase_vt(const Args& A, LAS unsigned char* lds) {
    const int lane = threadIdx.x & 63, wave = threadIdx.x >> 6, gw = blockIdx.x * NWAVES + wave, NGW = gridDim.x * NWAVES;
    LAS unsigned char* tl = lds + wave * 4096;
    const bf16_t* VB = (const bf16_t*)(A.ws + WS_VB);
    const int kk = lane & 31, pos = 32 * ((kk >> 2) & 1) + (kk & 3) + 4 * (kk >> 3) + 16 * (lane >> 5);
    constexpr int NTILE = SKV / 64;
    for (int it2 = gw; it2 < NB * HKV * NTILE * 2; it2 += NGW) {
        const int dh = it2 & 1, it = it2 >> 1, j = it % NTILE, bk = it / NTILE, b = bk >> 1, kv = bk & 1;
        const bf16_t* src = VB + ((size_t)b * SKV + j * 64 + lane) * 256 + kv * HD + dh * 64;
        u32x4 w[8];
#pragma unroll
        for (int c = 0; c < 8; ++c) w[c] = *(const u32x4*)(src + c * 8);
#pragma unroll
        for (int c = 0; c < 8; ++c)
#pragma unroll
            for (int q = 0; q < 4; ++q) { const int pk = __builtin_amdgcn_cvt_pk_fp8_f32(bf_lo(w[c][q]) * 16.f, bf_hi(w[c][q]) * 16.f, 0, false);
                tl[(c * 8 + 2 * q) * 64 + pos] = (unsigned char)(pk & 0xff); tl[(c * 8 + 2 * q + 1) * 64 + pos] = (unsigned char)((pk >> 8) & 0xff); }
        asm volatile("s_waitcnt lgkmcnt(0)" ::: "memory");
        unsigned char* dst = A.ws + WS_VT8 + (size_t)it * 8192 + dh * 4096;
#pragma unroll
        for (int i = 0; i < 4; ++i) *(u32x4*)(dst + (i * 64 + lane) * 16) = *(const LAS u32x4*)(tl + (i * 64 + lane) * 16);
        asm volatile("s_waitcnt lgkmcnt(0)" ::: "memory");
    }
}
template <int R> struct ConvRow {
    static __device__ __forceinline__ void run(const unsigned* gp, int tl0, float (&acc)[32][2], const float (&w)[31][2]) {
        const int tl = tl0 + R - 15;
        unsigned v = 0u; if (tl >= 0 && tl < S) v = gp[(long)(R - 15) * (D / 2)];
        const float a = bf_lo(v), b = bf_hi(v);
#pragma unroll
        for (int t = (R - 30 > 0 ? R - 30 : 0); t <= (R < 31 ? R : 31); ++t) { acc[t][0] += w[R - t][0] * a; acc[t][1] += w[R - t][1] * b; }
        if constexpr (R + 1 < 62) ConvRow<R + 1>::run(gp, tl0, acc, w);
    }
};
__device__ __forceinline__ void phase_conv(const Args& A, LAS unsigned char* lds) {
    const int tid = threadIdx.x, lane = tid & 63, wave = tid >> 6;
    LAS float* tile = (LAS float*)lds;
    const bf16_t* G = (const bf16_t*)(A.ws + WS_G); bf16_t* CV = (bf16_t*)(A.ws + WS_HX);
    float w[31][2];
#pragma unroll
    for (int j = 0; j < 31; ++j) { const f32x2 t = *(const f32x2*)(A.cdw + j * D + 2 * tid); w[j][0] = t[0]; w[j][1] = t[1]; }
    const f32x2 bias = *(const f32x2*)(A.cb + 2 * tid);
    for (int tileid = blockIdx.x; tileid < M / 32; tileid += gridDim.x) {
        const int row0 = tileid * 32, tl0 = row0 & (S - 1);
        float acc[32][2];
#pragma unroll
        for (int t = 0; t < 32; ++t) { acc[t][0] = bias[0]; acc[t][1] = bias[1]; }
        ConvRow<0>::run((const unsigned*)(G + (size_t)row0 * D) + tid, tl0, acc, w);
        __syncthreads();
#pragma unroll
        for (int t = 0; t < 32; ++t) *(LAS f32x2*)(tile + t * D + 2 * tid) = (f32x2){acc[t][0], acc[t][1]};
        __syncthreads();
#pragma unroll
        for (int q = 0; q < 4; ++q) { const int t = wave * 4 + q; const LAS float* tr = tile + t * D;
            f32x4 v[4]; float s = 0.f;
#pragma unroll
            for (int i = 0; i < 4; ++i) { v[i] = *(const LAS f32x4*)(tr + (i * 64 + lane) * 4); s += (v[i][0] + v[i][1]) + (v[i][2] + v[i][3]); }
            const float mu = wave_sum(s) * (1.f / D); float qq = 0.f;
#pragma unroll
            for (int i = 0; i < 4; ++i) { v[i] = v[i] - mu; qq += (v[i][0] * v[i][0] + v[i][1] * v[i][1]) + (v[i][2] * v[i][2] + v[i][3] * v[i][3]); }
            const float rs = rsqrtf(wave_sum(qq) * (1.f / D) + EPS);
#pragma unroll
            for (int i = 0; i < 4; ++i) { const int k = (i * 64 + lane) * 4; const f32x4 gg = *(const f32x4*)(A.clg + k), bb = *(const f32x4*)(A.clb + k); float y[4];
#pragma unroll
                for (int j = 0; j < 4; ++j) { const float z = v[i][j] * rs * gg[j] + bb[j]; y[j] = z * fast_sigmoid(z); }
                u32x2 o = {cvt_pk_bf16(y[0], y[1]), cvt_pk_bf16(y[2], y[3])}; *(u32x2*)(CV + (size_t)(row0 + t) * D + k) = o; }
        }
    }
}
typedef float f32x32v __attribute__((ext_vector_type(32)));
typedef _Float16 f16x32v __attribute__((ext_vector_type(32)));
typedef _Float16 f16x2v __attribute__((ext_vector_type(2)));
__device__ __forceinline__ unsigned pk_f16(float a, float b) { const f16x2v h = {(_Float16)a, (_Float16)b}; return __builtin_bit_cast(unsigned, h); }
struct EpiInProj {
    static constexpr bool PERM = true;
    unsigned char* ws;
    __device__ __forceinline__ void operator()(f32x4 (&acc)[2][2][4][2], const pg8::Unit& u, int wr, int wc, int fr, int fq) const {
        const int c8 = wc * 32 + 8 * fq;
#pragma unroll
        for (int ai = 0; ai < 2; ++ai)
#pragma unroll
            for (int m = 0; m < 4; ++m) {
                const int row = u.pm * 256 + ai * 128 + wr * 64 + m * 16 + fr;
                if (u.kind == 0) {
                    bf16_t* p = (bf16_t*)(ws + WS_Q) + (size_t)row * D + u.pn * 256 + c8;
#pragma unroll
                    for (int bj = 0; bj < 2; ++bj) { const f32x4 v0 = acc[ai][bj][m][0], v1 = acc[ai][bj][m][1];
                        u32x4 w = {cvt_pk_bf16(v0[0], v0[1]), cvt_pk_bf16(v0[2], v0[3]), cvt_pk_bf16(v1[0], v1[1]), cvt_pk_bf16(v1[2], v1[3])}; *(u32x4*)(p + bj * 128) = w; }
                } else if (u.kind == 1 || u.kind == 2 || u.kind == 5 || u.kind == 6) {
                    const bool ctxu = u.kind >= 5;
                    const int kvrow = ctxu ? (row >> 8) * SKV + S + (row & 255) : (row >> 12) * SKV + (row & (S - 1));
                    bf16_t* p = (bf16_t*)(ws + ((u.kind == 1 || u.kind == 5) ? WS_KB : WS_VB)) + (size_t)kvrow * 256 + c8;
#pragma unroll
                    for (int bj = 0; bj < 2; ++bj) { const f32x4 v0 = acc[ai][bj][m][0], v1 = acc[ai][bj][m][1];
                        u32x4 w = {cvt_pk_bf16(v0[0], v0[1]), cvt_pk_bf16(v0[2], v0[3]), cvt_pk_bf16(v1[0], v1[1]), cvt_pk_bf16(v1[2], v1[3])}; *(u32x4*)(p + bj * 128) = w; }
                } else if (u.kind == 3) {
                    float g[8];
#pragma unroll
                    for (int n = 0; n < 2; ++n)
#pragma unroll
                        for (int j = 0; j < 4; ++j) g[4 * n + j] = acc[ai][0][m][n][j] * fast_sigmoid(acc[ai][1][m][n][j]);
                    u32x4 w = {cvt_pk_bf16(g[0], g[1]), cvt_pk_bf16(g[2], g[3]), cvt_pk_bf16(g[4], g[5]), cvt_pk_bf16(g[6], g[7])};
                    *(u32x4*)((bf16_t*)(ws + WS_G) + (size_t)row * D + (u.pn - 6) * 128 + c8) = w;
                } else {
                    float rt[8], sg[8];
#pragma unroll
                    for (int n = 0; n < 2; ++n)
#pragma unroll
                        for (int j = 0; j < 4; ++j) { const float ea = __builtin_amdgcn_exp2f(-1.4426950408889634f * acc[ai][0][m][n][j]), ec = __builtin_amdgcn_exp2f(-1.4426950408889634f * acc[ai][1][m][n][j]);
                            sg[4 * n + j] = __builtin_amdgcn_rcpf(1.f + ec); rt[4 * n + j] = (1.f + ec) * __builtin_amdgcn_rcpf(1.f + ea); }
                    const size_t off = (size_t)row * D + (u.pn - 14) * 128 + c8;
                    u32x4 w = {cvt_pk_bf16(rt[0], rt[1]), cvt_pk_bf16(rt[2], rt[3]), cvt_pk_bf16(rt[4], rt[5]), cvt_pk_bf16(rt[6], rt[7])}; *(u32x4*)((bf16_t*)(ws + WS_RT) + off) = w;
                    u32x4 w2 = {cvt_pk_bf16(sg[0], sg[1]), cvt_pk_bf16(sg[2], sg[3]), cvt_pk_bf16(sg[4], sg[5]), cvt_pk_bf16(sg[6], sg[7])}; *(u32x4*)((bf16_t*)(ws + WS_SGC) + off) = w2;
                }
            }
    }
};
struct SchedInProj {
    const char* hx; const char* hc; const char* w; int G, c;
    __device__ __forceinline__ bool next(int i, pg8::Unit& u) const {
        constexpr int nM = M / 256, nN = INW / 256, NMAIN = nM * nN, NCTX = (MC / 256) * 2;
        const int L = i * G + c; if (L >= NMAIN + NCTX) return false;
        if (L < NMAIN) { pg8::tile_of(L, nM, nN, u.pm, u.pn); u.a = hx + (size_t)u.pm * 256 * D; u.kind = u.pn < 4 ? 0 : (u.pn == 4 ? 1 : (u.pn == 5 ? 2 : (u.pn < 14 ? 3 : 4))); }
        else { const int j = L - NMAIN; u.pm = j >> 1; u.pn = 4 + (j & 1); u.a = hc + (size_t)u.pm * 256 * D; u.kind = 5 + (j & 1); }
        u.b = w + (size_t)u.pn * 256 * D; u.keep = 0; return true;
    }
};
struct EpiMerge {
    static constexpr bool PERM = true;
    unsigned char* ws;
    __device__ __forceinline__ void operator()(f32x4 (&acc)[2][2][4][2], const pg8::Unit& u, int wr, int wc, int fr, int fq) const {
        const int c8 = u.pn * 256 + wc * 32 + 8 * fq;
        const bf16_t* __restrict__ F = (const bf16_t*)(ws + (u.kind == 0 ? WS_RT : WS_SGC));
#pragma unroll
        for (int ai = 0; ai < 2; ++ai)
#pragma unroll
            for (int m = 0; m < 4; ++m) { const size_t off = (size_t)(u.pm * 256 + ai * 128 + wr * 64 + m * 16 + fr) * D + c8;
#pragma unroll
                for (int bj = 0; bj < 2; ++bj) { const u32x4 f = *(const u32x4*)(F + off + bj * 128);
                    f32x4 v0 = acc[ai][bj][m][0], v1 = acc[ai][bj][m][1];
                    v0[0] *= bf_lo(f[0]); v0[1] *= bf_hi(f[0]); v0[2] *= bf_lo(f[1]); v0[3] *= bf_hi(f[1]); v1[0] *= bf_lo(f[2]); v1[1] *= bf_hi(f[2]); v1[2] *= bf_lo(f[3]); v1[3] *= bf_hi(f[3]);
                    if (u.kind == 0) { acc[ai][bj][m][0] = v0; acc[ai][bj][m][1] = v1; }
                    else { u32x4 w = {cvt_pk_bf16(v0[0], v0[1]), cvt_pk_bf16(v0[2], v0[3]), cvt_pk_bf16(v1[0], v1[1]), cvt_pk_bf16(v1[2], v1[3])}; *(u32x4*)((bf16_t*)(ws + WS_G) + off + bj * 128) = w; } } }
    }
};
struct SchedMerge {
    const char* att; const char* cv; const char* wa; const char* wc; int G, c;
    __device__ __forceinline__ bool next(int i, pg8::Unit& u) const {
        constexpr int nM = M / 256, nN = D / 256;
        const int L = (i >> 1) * G + c, sub = i & 1; if (L >= nM * nN) return false;
        pg8::tile_of(L, nM, nN, u.pm, u.pn);
        u.a = (sub ? cv : att) + (size_t)u.pm * 256 * D * 2; u.b = (sub ? wc : wa) + (size_t)u.pn * 256 * D * 2; u.kind = sub; u.keep = sub ^ 1; return true;
    }
};
struct SchedPlain {
    const char* a; const char* b; int nM, nN, G, c;
    __device__ __forceinline__ bool next(int i, pg8::Unit& u) const {
        const int L = i * G + c; if (L >= nM * nN) return false;
        pg8::tile_of(L, nM, nN, u.pm, u.pn); u.a = a + (size_t)u.pm * 256 * D * 2; u.b = b + (size_t)u.pn * 256 * D * 2; u.kind = 0; u.keep = 0; return true;
    }
};
struct EpiOut {
    static constexpr bool PERM = true;
    const float* __restrict__ x; const float* __restrict__ mod; const float* __restrict__ n2g; bf16_t* __restrict__ xs; bf16_t* __restrict__ xg; float* __restrict__ ssq;
    __device__ __forceinline__ void operator()(f32x4 (&acc)[2][2][4][2], const pg8::Unit& u, int wr, int wc, int fr, int fq) const {
        const int col0 = u.pn * 256 + wc * 32 + 8 * fq; const float* mb = mod + ((u.pm * 256) >> 12) * NMOD;
        f32x4 gv[2][2], nv[2][2];
#pragma unroll
        for (int bj = 0; bj < 2; ++bj)
#pragma unroll
            for (int n = 0; n < 2; ++n) { const int c = col0 + bj * 128 + n * 4; gv[bj][n] = *(const f32x4*)(mb + 2 * D + c); nv[bj][n] = *(const f32x4*)(n2g + c) * (*(const f32x4*)(mb + 4 * D + c) + 1.f); }
        f32x4 xa[2][2], xb[2][2];
#define XLOAD(dst, k) do { _Pragma("unroll") for (int bj = 0; bj < 2; ++bj) _Pragma("unroll") for (int n = 0; n < 2; ++n) \
            dst[bj][n] = *(const f32x4*)(x + (size_t)(u.pm * 256 + ((k) >> 2) * 128 + wr * 64 + ((k) & 3) * 16 + fr) * D + col0 + bj * 128 + n * 4); } while (0)
#define XDONE(src, k) do { const int ai = (k) >> 2, m = (k) & 3; const int row = u.pm * 256 + ai * 128 + wr * 64 + m * 16 + fr; const size_t off = (size_t)row * D + col0; float ss = 0.f; \
            _Pragma("unroll") for (int bj = 0; bj < 2; ++bj) { const f32x4 v0 = src[bj][0] + gv[bj][0] * acc[ai][bj][m][0], v1 = src[bj][1] + gv[bj][1] * acc[ai][bj][m][1]; \
                ss += ((v0[0] * v0[0] + v0[1] * v0[1]) + (v0[2] * v0[2] + v0[3] * v0[3])) + ((v1[0] * v1[0] + v1[1] * v1[1]) + (v1[2] * v1[2] + v1[3] * v1[3])); \
                u32x4 w = {cvt_pk_bf16(v0[0], v0[1]), cvt_pk_bf16(v0[2], v0[3]), cvt_pk_bf16(v1[0], v1[1]), cvt_pk_bf16(v1[2], v1[3])}; *(u32x4*)(xs + off + bj * 128) = w; \
                const f32x4 g0 = v0 * nv[bj][0], g1 = v1 * nv[bj][1]; \
                u32x4 w2 = {cvt_pk_bf16(g0[0], g0[1]), cvt_pk_bf16(g0[2], g0[3]), cvt_pk_bf16(g1[0], g1[1]), cvt_pk_bf16(g1[2], g1[3])}; *(u32x4*)(xg + off + bj * 128) = w2; } \
            ss += __shfl_xor(ss, 16); ss += __shfl_xor(ss, 32); if (fq == 0) ssq[(size_t)row * 16 + u.pn * 4 + wc] = ss; } while (0)
        XLOAD(xa, 0); XLOAD(xb, 1); XDONE(xa, 0); XLOAD(xa, 2); XDONE(xb, 1); XLOAD(xb, 3); XDONE(xa, 2); XLOAD(xa, 4); XDONE(xb, 3); XLOAD(xb, 5); XDONE(xa, 4); XLOAD(xa, 6); XDONE(xb, 5); XLOAD(xb, 7); XDONE(xa, 6); XDONE(xb, 7);
#undef XLOAD
#undef XDONE
    }
};
__device__ __forceinline__ float row_rstd(const float* ssq, int row) {
    const f32x4 a = *(const f32x4*)(ssq + (size_t)row * 16), b = *(const f32x4*)(ssq + (size_t)row * 16 + 4), c = *(const f32x4*)(ssq + (size_t)row * 16 + 8), d = *(const f32x4*)(ssq + (size_t)row * 16 + 12);
    const float s = ((a[0] + a[1]) + (a[2] + a[3])) + ((b[0] + b[1]) + (b[2] + b[3])) + ((c[0] + c[1]) + (c[2] + c[3])) + ((d[0] + d[1]) + (d[2] + d[3]));
    return rsqrtf(s * (1.f / D) + EPS);
}
struct EpiScores {
    static constexpr bool PERM = true;
    unsigned short* sc; const float* ssq; const float* sbias;
    __device__ __forceinline__ void operator()(f32x4 (&acc)[2][2][4][2], const pg8::Unit& u, int wr, int wc, int fr, int fq) const {
        const float* sb = sbias + ((u.pm * 256) >> 12) * PW + u.pn * 256 + wc * 32 + 8 * fq;
        f32x4 bv[2][2];
#pragma unroll
        for (int bj = 0; bj < 2; ++bj)
#pragma unroll
            for (int n = 0; n < 2; ++n) bv[bj][n] = *(const f32x4*)(sb + bj * 128 + n * 4);
#pragma unroll
        for (int ai = 0; ai < 2; ++ai)
#pragma unroll
            for (int m = 0; m < 4; ++m) { const int row = u.pm * 256 + ai * 128 + wr * 64 + m * 16 + fr; unsigned short* p = sc + (size_t)(row >> 2) * 8192 + (row & 3) * 8; const float rs = row_rstd(ssq, row);
#pragma unroll
                for (int bj = 0; bj < 2; ++bj) { const int grp = u.pn * 2 + bj, nq = wc * 4 + fq; const f32x4 v0 = acc[ai][bj][m][0] * rs + bv[bj][0], v1 = acc[ai][bj][m][1] * rs + bv[bj][1];
                    u32x4 w = {pk_f16(v0[0], v0[1]), pk_f16(v0[2], v0[3]), pk_f16(v1[0], v1[1]), pk_f16(v1[2], v1[3])}; *(u32x4*)(p + (grp * 16 + nq) * 32) = w; } }
    }
};

#ifndef PROBE_HALFKEYS
#define PROBE_HALFKEYS 0
#endif
__device__ __forceinline__ void phase_attn(const Args& A, unsigned char* lds) {
    const int G = gridDim.x, X = blockIdx.x & 7, j = blockIdx.x >> 3, perx = G >> 3;
    bf16_t* Q = (bf16_t*)(A.ws + WS_Q); const unsigned char* K8 = A.ws + WS_K8; const unsigned char* VT8 = A.ws + WS_VT8;
    const float* cs = (const float*)(A.ws + WS_ROPE); const float* sn = cs + 2048;
    for (int idx = j; idx < 128; idx += perx) {
        const int grp = 2 * X + (idx >> 6), uu = idx & 63, b = grp >> 1, kv = grp & 1, h = kv * 4 + (uu >> 4), qb = uu & 15;
        bf16_t* qp = Q + ((size_t)b * S + qb * 256) * D + h * HD;
        bf16_t* op = A.dry ? (bf16_t*)(A.ws + WS_G) + ((size_t)b * S + qb * 256) * D + h * HD : qp;
        att::attn_unit(qp, K8 + (size_t)b * SKV * 256 + kv * HD, VT8 + (size_t)grp * (SKV / 64) * 8192, op, qb * 256, (A.dry && PROBE_HALFKEYS) ? SKV / 2 : SKV, A.qng, cs, sn, (char*)lds);
    }
}

__device__ __forceinline__ float gelu_exact(float v) {
    const float av = fabsf(v), t = __builtin_amdgcn_rcpf(av * 0.2316418882f + 1.0f);
    float q = t * 0.5307027145f + (-0.7265760135f); q = q * t + 0.7107068705f; q = q * t + (-0.142248368f); q = q * t + 0.127414796f; q = q * t;
    const float e = __builtin_amdgcn_exp2f((v * v) * (-0.72134752044f));
    const float m = v * (q * e);
    return v < 0.f ? m : v - m;
}
__device__ __forceinline__ void ins16(float (&t)[16], float v) {
#pragma unroll
    for (int i = 15; i >= 1; --i) t[i] = __builtin_amdgcn_fmed3f(t[i - 1], t[i], v);
    t[0] = fmaxf(t[0], v);
}

__device__ __forceinline__ float key_tag(float v, unsigned keepmask, unsigned tag) { return __uint_as_float((__float_as_uint(v) & keepmask) | tag); }
template <int I, int J> struct CandLoop {
    static __device__ __forceinline__ void run(const float (&a)[16], const float (&b)[16], float (&c)[16]) {
        if constexpr ((I + 1) * (J + 1) <= 16) { ins16(c, key_tag(a[I] + b[J], ~255u, 255u - (unsigned)(I * 16 + J))); CandLoop<I, J + 1>::run(a, b, c); }
        else if constexpr (I + 1 < 16) CandLoop<I + 1, 0>::run(a, b, c);
    }
};
__device__ __forceinline__ void phase_peer_u(const Args& A, LAS unsigned char* lds) {
    const int lane = threadIdx.x & 63, wave = threadIdx.x >> 6, gw = blockIdx.x * NWAVES + wave, NGW = gridDim.x * NWAVES;
    LAS unsigned char* wl = lds + wave * 10240;
    LAS float* topL = (LAS float*)wl; LAS int* eidA = (LAS int*)(wl + 4096); LAS float* wgtA = (LAS float*)(wl + 6144); LAS float* coefL = (LAS float*)(wl + 8192);
    LAS float* suL = (LAS float*)(wl + 8704); LAS float* svL = (LAS float*)(wl + 9216);
    const unsigned short* SC = (const unsigned short*)(A.ws + WS_SC); const bf16_t* HX = (const bf16_t*)(A.ws + WS_HX);
    const unsigned char* UT = A.ws + WS_UT; const float* SU = (const float*)(A.ws + WS_UT + WS_TSCALE); const float* SVs = (const float*)(A.ws + WS_VT + WS_TSCALE);
    const float* mod = (const float*)(A.ws + WS_MOD);
    int* PE = (int*)(A.ws + WS_PE); float* PC = (float*)(A.ws + WS_PC);
    const float NEG = -3.0e38f;
    const int h = lane >> 3, tk = (lane >> 1) & 3, p = lane & 1, grp = 2 * h + p;
    for (int pass = gw; pass < M / 4; pass += NGW) {
        {
            float t[16];
#pragma unroll
            for (int i = 0; i < 16; ++i) t[i] = NEG;
            const unsigned short* sp = SC + (size_t)pass * 8192 + (grp * 64 + tk) * 8;
            u32x4 sv[16];
#pragma unroll
            for (int i = 0; i < 16; ++i) sv[i] = *(const u32x4*)(sp + i * 32);
#pragma unroll
            for (int i = 0; i < 16; ++i)
#pragma unroll
                for (int q = 0; q < 4; ++q) { const unsigned w = sv[i][q]; const f16x2v hv = __builtin_bit_cast(f16x2v, w); const unsigned tg = 127u - (unsigned)(8 * i + 2 * q);
                    ins16(t, __uint_as_float(__float_as_uint((float)hv[0]) | tg)); ins16(t, __uint_as_float(__float_as_uint((float)hv[1]) | (tg - 1u))); }
            float pb[16];
#pragma unroll
            for (int i = 0; i < 16; ++i) { pb[i] = __shfl_xor(t[i], 1); topL[i * 64 + lane] = t[i]; }
            float c[16];
#pragma unroll
            for (int i = 0; i < 16; ++i) c[i] = NEG;
            CandLoop<0, 0>::run(t, pb, c);
            float e[16]; float es = 0.f;
#pragma unroll
            for (int k = 0; k < 16; ++k) { e[k] = __expf(c[k] - c[0]); es += e[k]; }
            const float inv = __builtin_amdgcn_rcpf(es);
            asm volatile("s_waitcnt lgkmcnt(0)" ::: "memory");
            if (p == 0) {
#pragma unroll
                for (int k = 0; k < 16; ++k) { const unsigned code = 255u - (__float_as_uint(c[k]) & 255u);
                    const unsigned ia = 127u - (__float_as_uint(topL[(code >> 4) * 64 + lane]) & 127u), ib = 127u - (__float_as_uint(topL[(code & 15u) * 64 + lane + 1]) & 127u);
                    eidA[tk * 128 + h * 16 + k] = (int)(ia * 128u + ib); wgtA[tk * 128 + h * 16 + k] = e[k] * inv; }
            }
            asm volatile("s_waitcnt lgkmcnt(0)" ::: "memory");
        }
#pragma unroll 1
        for (int tq = 0; tq < 4; ++tq) {
            const int t = pass * 4 + tq; const LAS int* eidL = eidA + tq * 128; const LAS float* wgtL = wgtA + tq * 128;
            const int g = lane & 31, hh = lane >> 5;
            f16x2v xh[16];
            { const float rs = row_rstd((const float*)(A.ws + WS_SSQ), t); const float* sh = mod + (t >> 12) * NMOD + 3 * D + g * 32; const bf16_t* xp = HX + (size_t)t * D + g * 32;
#pragma unroll
              for (int c = 0; c < 4; ++c) { const u32x4 w = *(const u32x4*)(xp + 8 * c); const f32x4 s0 = *(const f32x4*)(sh + 8 * c), s1 = *(const f32x4*)(sh + 8 * c + 4);
                xh[4 * c] = (f16x2v){(_Float16)(bf_lo(w[0]) * rs + s0[0]), (_Float16)(bf_hi(w[0]) * rs + s0[1])}; xh[4 * c + 1] = (f16x2v){(_Float16)(bf_lo(w[1]) * rs + s0[2]), (_Float16)(bf_hi(w[1]) * rs + s0[3])};
                xh[4 * c + 2] = (f16x2v){(_Float16)(bf_lo(w[2]) * rs + s1[0]), (_Float16)(bf_hi(w[2]) * rs + s1[1])}; xh[4 * c + 3] = (f16x2v){(_Float16)(bf_lo(w[3]) * rs + s1[2]), (_Float16)(bf_hi(w[3]) * rs + s1[3])}; } }
            { const int i0 = eidL[lane], i1 = eidL[64 + lane]; suL[lane] = SU[i0]; suL[64 + lane] = SU[i1]; svL[lane] = SVs[i0]; svL[64 + lane] = SVs[i1]; }
            u32x6 rb0[4], rb1[4], rb2[4], rb3[4];
#define LOAD8(buf, TB, hb) do { _Pragma("unroll") for (int r = 0; r < 4; ++r) { const int id = eidL[(hb) * 8 + 2 * r + hh]; const unsigned char* rp = (TB) + (size_t)id * ROWB; \
                const u32x4 lo = *(const u32x4*)(rp + g * 16); const u32x2 hi2 = *(const u32x2*)(rp + 512 + g * 8); buf[r] = (u32x6){lo[0], lo[1], lo[2], lo[3], hi2[0], hi2[1]}; } } while (0)
#define DOT8(buf, off) do { _Pragma("unroll") for (int r = 0; r < 4; ++r) { const f16x32v dq = __builtin_amdgcn_cvt_scalef32_pk32_f16_fp6(buf[r], 1.0f); \
                float sa = 0.f, sb = 0.f, sc = 0.f, sd = 0.f;     \
                _Pragma("unroll") for (int j = 0; j < 16; j += 4) { sa = __builtin_amdgcn_fdot2((f16x2v){dq[2 * j], dq[2 * j + 1]}, xh[j], sa, false); sb = __builtin_amdgcn_fdot2((f16x2v){dq[2 * j + 2], dq[2 * j + 3]}, xh[j + 1], sb, false); \
                    sc = __builtin_amdgcn_fdot2((f16x2v){dq[2 * j + 4], dq[2 * j + 5]}, xh[j + 2], sc, false); sd = __builtin_amdgcn_fdot2((f16x2v){dq[2 * j + 6], dq[2 * j + 7]}, xh[j + 3], sd, false); } \
                pp[(off) + r] = (sa + sb) + (sc + sd); } } while (0)
#define REDUCE16(kb) do { \
            _Pragma("unroll") for (int e = 0; e < 4; ++e) { const bool up = lane & 16; const float keep = up ? pp[e + 4] : pp[e], send = up ? pp[e] : pp[e + 4]; pp[e] = keep + __shfl_xor(send, 16); } \
            _Pragma("unroll") for (int e = 0; e < 2; ++e) { const bool up = lane & 8; const float keep = up ? pp[e + 2] : pp[e], send = up ? pp[e] : pp[e + 2]; pp[e] = keep + __shfl_xor(send, 8); } \
            { const bool up = lane & 4; const float keep = up ? pp[1] : pp[0], send = up ? pp[0] : pp[1]; pp[0] = keep + __shfl_xor(send, 4); } \
            float hsum = pp[0]; hsum += __shfl_xor(hsum, 2); hsum += __shfl_xor(hsum, 1); \
            const int ke = (kb) * 16 + 2 * ((lane >> 2) & 7) + hh; const float su = suL[ke], sv = svL[ke]; \
            const float cf = wgtL[ke] * gelu_exact(hsum * su) * sv; if ((lane & 3) == 0) coefL[ke] = cf; } while (0)
            float pp[8];
            LOAD8(rb0, UT, 0); LOAD8(rb1, UT, 1); LOAD8(rb2, UT, 2);
            LOAD8(rb3, UT, 3); DOT8(rb0, 0);
            LOAD8(rb0, UT, 4); DOT8(rb1, 4); REDUCE16(0);
            LOAD8(rb1, UT, 5); DOT8(rb2, 0);
            LOAD8(rb2, UT, 6); DOT8(rb3, 4); REDUCE16(1);
            LOAD8(rb3, UT, 7); DOT8(rb0, 0);
            LOAD8(rb0, UT, 8); DOT8(rb1, 4); REDUCE16(2);
            LOAD8(rb1, UT, 9); DOT8(rb2, 0);
            LOAD8(rb2, UT, 10); DOT8(rb3, 4); REDUCE16(3);
            LOAD8(rb3, UT, 11); DOT8(rb0, 0);
            LOAD8(rb0, UT, 12); DOT8(rb1, 4); REDUCE16(4);
            LOAD8(rb1, UT, 13); DOT8(rb2, 0);
            LOAD8(rb2, UT, 14); DOT8(rb3, 4); REDUCE16(5);
            LOAD8(rb3, UT, 15); DOT8(rb0, 0);
            DOT8(rb1, 4); REDUCE16(6);
            DOT8(rb2, 0);
            DOT8(rb3, 4); REDUCE16(7);
#undef LOAD8
#undef DOT8
#undef REDUCE16
            asm volatile("s_waitcnt lgkmcnt(0)" ::: "memory");
            PE[(size_t)t * 128 + lane] = eidL[lane]; PE[(size_t)t * 128 + 64 + lane] = eidL[64 + lane];
            PC[(size_t)t * 128 + lane] = coefL[lane]; PC[(size_t)t * 128 + 64 + lane] = coefL[64 + lane];
        }
    }
}
__device__ __forceinline__ void phase_peer_v(const Args& A, LAS unsigned char* lds) {
    const int lane = threadIdx.x & 63, wave = threadIdx.x >> 6, gw = blockIdx.x * NWAVES + wave, NGW = gridDim.x * NWAVES;
    LAS int* eidL = (LAS int*)(lds + wave * 1024); LAS float* coefL = (LAS float*)(lds + wave * 1024 + 512);
    const unsigned char* VT = A.ws + WS_VT; const float* mod = (const float*)(A.ws + WS_MOD);
    const int* PE = (const int*)(A.ws + WS_PE); const float* PC = (const float*)(A.ws + WS_PC);
    const int g = lane & 31, hh = lane >> 5;
    int pe0 = 0, pe1 = 0; float pc0 = 0.f, pc1 = 0.f;
    if (gw < M) { pe0 = PE[(size_t)gw * 128 + lane]; pe1 = PE[(size_t)gw * 128 + 64 + lane]; pc0 = PC[(size_t)gw * 128 + lane]; pc1 = PC[(size_t)gw * 128 + 64 + lane]; }
    for (int t = gw; t < M; t += NGW) {
        eidL[lane] = pe0; eidL[64 + lane] = pe1; coefL[lane] = pc0; coefL[64 + lane] = pc1;
        asm volatile("s_waitcnt lgkmcnt(0)" ::: "memory");
        { const int tn = t + NGW < M ? t + NGW : t; pe0 = PE[(size_t)tn * 128 + lane]; pe1 = PE[(size_t)tn * 128 + 64 + lane]; pc0 = PC[(size_t)tn * 128 + lane]; pc1 = PC[(size_t)tn * 128 + 64 + lane]; }
        u32x4 xsw[2];
        { const bf16_t* xrow = (const bf16_t*)(A.ws + WS_XSB) + (size_t)t * D + g * 32 + hh * 16; xsw[0] = *(const u32x4*)xrow; xsw[1] = *(const u32x4*)(xrow + 8); }
        u32x6 rb0[4], rb1[4], rb2[4], rb3[4];
#define LOAD8(buf, hb) do { _Pragma("unroll") for (int r = 0; r < 4; ++r) { const int id = eidL[(hb) * 8 + 2 * r + hh]; const unsigned char* rp = VT + (size_t)id * ROWB; \
            const u32x4 lo = *(const u32x4*)(rp + g * 16); const u32x2 hi2 = *(const u32x2*)(rp + 512 + g * 8); buf[r] = (u32x6){lo[0], lo[1], lo[2], lo[3], hi2[0], hi2[1]}; } } while (0)
#define VACC8(buf, hb) do { _Pragma("unroll") for (int r = 0; r < 4; ++r) { const _Float16 ch = (_Float16)coefL[(hb) * 8 + 2 * r + hh]; const f16x2v cf2 = {ch, ch}; \
            const f16x32v dq = __builtin_amdgcn_cvt_scalef32_pk32_f16_fp6(buf[r], 1.0f); \
            _Pragma("unroll") for (int j = 0; j < 16; ++j) yh[j] = cf2 * (f16x2v){dq[2 * j], dq[2 * j + 1]} + yh[j]; } } while (0)
        f16x2v yh[16];
#pragma unroll
        for (int j = 0; j < 16; ++j) yh[j] = (f16x2v){(_Float16)0.f, (_Float16)0.f};
        LOAD8(rb0, 0); LOAD8(rb1, 1); LOAD8(rb2, 2);
        LOAD8(rb3, 3); VACC8(rb0, 0);
        LOAD8(rb0, 4); VACC8(rb1, 1);
        LOAD8(rb1, 5); VACC8(rb2, 2);
        LOAD8(rb2, 6); VACC8(rb3, 3);
        LOAD8(rb3, 7); VACC8(rb0, 4);
        LOAD8(rb0, 8); VACC8(rb1, 5);
        LOAD8(rb1, 9); VACC8(rb2, 6);
        LOAD8(rb2, 10); VACC8(rb3, 7);
        LOAD8(rb3, 11); VACC8(rb0, 8);
        LOAD8(rb0, 12); VACC8(rb1, 9);
        LOAD8(rb1, 13); VACC8(rb2, 10);
        LOAD8(rb2, 14); VACC8(rb3, 11);
        LOAD8(rb3, 15); VACC8(rb0, 12);
        VACC8(rb1, 13);
        VACC8(rb2, 14);
        VACC8(rb3, 15);
#undef LOAD8
#undef VACC8
        float yy[16];
#pragma unroll
        for (int j = 0; j < 16; ++j) { const float y0 = (float)yh[j][0], y1 = (float)yh[j][1]; const float a = y0 + __shfl_xor(y0, 32), b = y1 + __shfl_xor(y1, 32); if ((j >> 3) == hh) { yy[2 * (j & 7)] = a; yy[2 * (j & 7) + 1] = b; } }
        const float* g2 = mod + (t >> 12) * NMOD + 5 * D; float* orow = A.out + (size_t)t * D;
        float z[16]; float ss = 0.f;
#pragma unroll
        for (int q = 0; q < 4; ++q) { const int k = g * 32 + hh * 16 + q * 4; const unsigned xw0 = xsw[q >> 1][2 * (q & 1)], xw1 = xsw[q >> 1][2 * (q & 1) + 1];
            const f32x4 xv = {bf_lo(xw0), bf_hi(xw0), bf_lo(xw1), bf_hi(xw1)}, gv = *(const f32x4*)(g2 + k);
#pragma unroll
            for (int j = 0; j < 4; ++j) { const float zz = xv[j] + gv[j] * yy[q * 4 + j]; z[q * 4 + j] = zz; ss += zz * zz; } }
        const float r = rsqrtf(wave_sum(ss) * (1.f / D) + EPS);
#pragma unroll
        for (int q = 0; q < 4; ++q) { const int k = g * 32 + hh * 16 + q * 4; const f32x4 fv = *(const f32x4*)(A.fg + k);
            f32x4 o;
#pragma unroll
            for (int j = 0; j < 4; ++j) o[j] = z[q * 4 + j] * r * fv[j];
            if (!A.dry || r < 0.f) *(f32x4*)(orow + k) = o; }
    }
}
#define XB_TMO      128
#define XB_XCNT(j)  (256  + 64 * (j))
#define XB_XSUB(j)  (1280 + 64 * (j))
#define XB_XGEN(j)  (2304 + 64 * (j))
#define XB_TOP      3328
#define XB_TOPGEN   3392
#define XCD_BAR_WORDS 3456
#define XB_SPIN_CAP (1u << 22)
__device__ __forceinline__ unsigned xb_ld(unsigned* p)              { return __hip_atomic_load(p, __ATOMIC_RELAXED, __HIP_MEMORY_SCOPE_AGENT); }
__device__ __forceinline__ unsigned xb_add(unsigned* p, unsigned v) { return __hip_atomic_fetch_add(p, v, __ATOMIC_RELAXED, __HIP_MEMORY_SCOPE_AGENT); }
__device__ __forceinline__ unsigned xb_xcc_id() { return (unsigned)__builtin_amdgcn_s_getreg((3 << 11) | 20) & 0xFu; }
#define XB_SPIN(cond, bar) do { unsigned _sp = 0; while (cond) { __builtin_amdgcn_s_sleep(1); \
    if ((++_sp & 255u) == 0u) { if (xb_ld(&(bar)[XB_TMO])) break; if (_sp > XB_SPIN_CAP) { atomicAdd(&(bar)[XB_TMO], 1u); break; } } } } while (0)
struct XcdBarrier { unsigned* bar; unsigned x; volatile LAS unsigned* st; };
__device__ __forceinline__ XcdBarrier xcd_barrier_post(unsigned* bar, volatile LAS unsigned* st) {
    XcdBarrier b; b.bar = bar; b.x = xb_xcc_id(); b.st = st;
    if (threadIdx.x == 0) (void)xb_add(&bar[XB_XCNT(b.x)], 1u);
    return b;
}
__device__ __forceinline__ void xcd_barrier_complete(unsigned* bar, unsigned x, unsigned& nloc, unsigned& nx) {
    const unsigned G = gridDim.x * gridDim.y * gridDim.z;
    unsigned sum, cnt, mine, sp = 0u;
    for (;;) {
        sum = 0u; cnt = 0u; mine = 0u;
#pragma unroll
        for (unsigned j = 0; j < 16; ++j) { const unsigned c = xb_ld(&bar[XB_XCNT(j)]); sum += c; cnt += (c > 0u) ? 1u : 0u; mine = (j == x) ? c : mine; }
        if (sum == G) break;
        __builtin_amdgcn_s_sleep(1);
        if ((++sp & 255u) == 0u) { if (xb_ld(&bar[XB_TMO])) break; if (sp > XB_SPIN_CAP) { atomicAdd(&bar[XB_TMO], 1u); break; } }
    }
    nloc = mine > 0u ? mine : 1u; nx = cnt > 0u ? cnt : 1u;
}
__device__ __forceinline__ void xcd_barrier(const XcdBarrier& b) {
    asm volatile("s_waitcnt vmcnt(0)" ::: "memory");
    __syncthreads();
    if (threadIdx.x == 0) {
        unsigned* bar = b.bar;
        __builtin_amdgcn_s_waitcnt(0);
        unsigned nloc = b.st[0], nx = b.st[1];
        if (nloc == 0u) { xcd_barrier_complete(bar, b.x, nloc, nx); b.st[0] = nloc; b.st[1] = nx; }
        const unsigned old = xb_add(&bar[XB_XSUB(b.x)], 1u);
        const unsigned gen = old / nloc;
        if (old + 1u == (gen + 1u) * nloc) {
            __builtin_amdgcn_fence(__ATOMIC_RELEASE, "agent");
            asm volatile("s_waitcnt vmcnt(0)" ::: "memory");
            const unsigned og = xb_add(&bar[XB_TOP], 1u);
            const unsigned tg = og / nx;
            if (og + 1u == (tg + 1u) * nx) xb_add(&bar[XB_TOPGEN], 1u);
            else XB_SPIN(xb_ld(&bar[XB_TOPGEN]) == tg, bar);
            __builtin_amdgcn_fence(__ATOMIC_ACQUIRE, "agent");
            xb_add(&bar[XB_XGEN(b.x)], 1u);
            asm volatile("s_waitcnt vmcnt(0)" ::: "memory");
        } else {
            XB_SPIN(xb_ld(&bar[XB_XGEN(b.x)]) == gen, bar);
            __builtin_amdgcn_fence(__ATOMIC_ACQUIRE, "agent");
            asm volatile("s_waitcnt vmcnt(0)" ::: "memory");
        }
    }
    __syncthreads();
}
constexpr int MISC_OFF = 135168;

constexpr int N_PHASES = 10;
__global__ void __launch_bounds__(NWAVES * 64, 2) mega_fwd(Args A) {
    extern __shared__ __attribute__((aligned(16))) unsigned char lds[];
    LAS unsigned char* L = (LAS unsigned char*)lds;
    cg::grid_group grid = cg::this_grid();
    const int lo = A.ph_lo, hi = A.ph_hi, G = gridDim.x, c = blockIdx.x;
#ifndef PH_MASK
#define PH_MASK 0x3FF
#endif
#define IN(k) (((PH_MASK >> (k)) & 1) && lo <= (k) && (k) < hi)
    unsigned* barw = (unsigned*)(A.ws + WS_CTL);
    volatile LAS unsigned* MISC = (volatile LAS unsigned*)(L + MISC_OFF);
    if (threadIdx.x < 2) MISC[threadIdx.x] = 0u;
    if (lo == 0 && hi > 1 && blockIdx.x == 0) for (int i = threadIdx.x; i < XCD_BAR_WORDS; i += NWAVES * 64) barw[i] = 0u;
    XcdBarrier xb; xb.bar = barw; xb.x = 0; xb.st = MISC;
#define SEAM(k) do { if (IN(k) && IN((k) + 1)) { if ((k) == 0) { grid.sync(); xb = xcd_barrier_post(barw, MISC); } else xcd_barrier(xb); } } while (0)
    if (IN(0)) phase_prologue(A, L);
    SEAM(0);
    if (IN(1)) phase_hx(A);
    SEAM(1);
    if (IN(2)) { SchedInProj Sd{(const char*)(A.ws + WS_HX), (const char*)(A.ws + WS_HC), (const char*)(A.ws + WS_WIN), G, c}; EpiInProj E{A.ws};
        pg8::gemm_phase<EpiInProj, SchedInProj, true, true>(L, D / 2, Sd, E); }
    SEAM(2);
    if (IN(3)) { phase_kfix(A); phase_vt(A, L); __syncthreads(); phase_conv(A, L); }
    SEAM(3);
    if (IN(4)) phase_attn(A, lds);
    SEAM(4);
    if (IN(5)) { SchedMerge Sd{(const char*)(A.ws + WS_Q), (const char*)(A.ws + WS_HX), (const char*)(A.ws + WS_WA), (const char*)(A.ws + WS_WC), G, c}; EpiMerge E{A.ws};
        pg8::gemm_phase<EpiMerge, SchedMerge, true>(L, D, Sd, E); }
    SEAM(5);
    if (IN(6)) { SchedPlain Sd{(const char*)(A.ws + WS_G), (const char*)(A.ws + WS_WO), M / 256, D / 256, G, c};
        EpiOut E{A.x, (const float*)(A.ws + WS_MOD), A.n2g, (bf16_t*)(A.ws + WS_XSB), (bf16_t*)(A.ws + WS_HX), (float*)(A.ws + WS_SSQ)};
        pg8::gemm_phase<EpiOut, SchedPlain, true>(L, D, Sd, E); }
    SEAM(6);
    if (IN(7)) { SchedPlain Sd{(const char*)(A.ws + WS_HX), (const char*)(A.ws + WS_WP), M / 256, PW / 256, G, c};
        EpiScores E{(unsigned short*)(A.ws + WS_SC), (const float*)(A.ws + WS_SSQ), (const float*)(A.ws + WS_SBIAS)};
        pg8::gemm_phase<EpiScores, SchedPlain, true>(L, D, Sd, E); }
    SEAM(7);
    if (IN(8)) phase_peer_u(A, L);
    SEAM(8);
    if (IN(9)) phase_peer_v(A, L);
#undef IN
#undef SEAM
}

#ifndef MK_ONE_LAUNCH
#define MK_ONE_LAUNCH 1
#endif
extern "C" void kernel_launch(void* const* d_in, const int* in_sizes, int n_in, void* d_out, int out_size, void* d_ws, size_t ws_size, hipStream_t stream) {
    static int grid = 0;
    if (grid == 0) {
        if (n_in != 23 || out_size != M * D || ws_size < WS_END) { fprintf(stderr, "kernel_launch: unexpected shapes (n_in %d out %d ws %zu)\n", n_in, out_size, ws_size); grid = -1; return; }
        int dev = 0, cus = 0, per_cu = 0;
        hipGetDevice(&dev); hipDeviceGetAttribute(&cus, hipDeviceAttributeMultiprocessorCount, dev);
        if (hipFuncSetAttribute((const void*)mega_fwd, hipFuncAttributeMaxDynamicSharedMemorySize, LDS_BYTES) != hipSuccess) { fprintf(stderr, "kernel_launch: hipFuncSetAttribute failed\n"); grid = -1; return; }
        if (hipOccupancyMaxActiveBlocksPerMultiprocessor(&per_cu, (const void*)mega_fwd, NWAVES * 64, LDS_BYTES) != hipSuccess || per_cu < 1) { fprintf(stderr, "kernel_launch: occupancy query says %d\n", per_cu); per_cu = 1; }
        (void)hipGetLastError();
        grid = cus * 1;
        if (per_cu < 1) grid = -1;
    }
    if (grid < 0) return;
    Args a{};
    const float** f = (const float**)&a;
    for (int i = 0; i < 23; ++i) f[i] = (const float*)d_in[i];
    a.out = (float*)d_out; a.ws = (unsigned char*)d_ws;
#if MK_ONE_LAUNCH
    a.ph_lo = 0; a.ph_hi = N_PHASES;
    void* args[] = {&a};
    hipError_t e = hipLaunchCooperativeKernel((const void*)mega_fwd, dim3(grid), dim3(NWAVES * 64), args, LDS_BYTES, stream);
    if (e != hipSuccess) fprintf(stderr, "cooperative launch failed: %s (grid %d)\n", hipGetErrorString(e), grid);
#else
#ifndef REPEAT_PH
#define REPEAT_PH -1
#endif
    for (int p = 0; p < N_PHASES; ++p) { a.ph_lo = p; a.ph_hi = p + 1;
        if (p == REPEAT_PH) { a.dry = 1; hipLaunchKernelGGL(mega_fwd, dim3(grid), dim3(NWAVES * 64), LDS_BYTES, stream, a); a.dry = 0; }
        hipLaunchKernelGGL(mega_fwd, dim3(grid), dim3(NWAVES * 64), LDS_BYTES, stream, a); }
#endif
}
```

```cpp
#include <hip/hip_runtime.h>
#include <hip/hip_cooperative_groups.h>
#include <cstdio>
#include <cstdint>
namespace cg = cooperative_groups;

#define LAS __attribute__((address_space(3)))
typedef unsigned short bf16_t;
typedef short bf16x8 __attribute__((ext_vector_type(8)));
typedef short s16x4 __attribute__((ext_vector_type(4)));
typedef float f32x2 __attribute__((ext_vector_type(2)));
typedef float f32x4 __attribute__((ext_vector_type(4)));
typedef float f32x16 __attribute__((ext_vector_type(16)));
typedef unsigned u32x2 __attribute__((ext_vector_type(2)));
typedef unsigned u32x4 __attribute__((ext_vector_type(4)));
typedef __bf16 bf16x2_t __attribute__((ext_vector_type(2)));

constexpr int D = 1024, NB = 8, S = 4096, CTXL = 256, SKV = S + CTXL, HD = 128, HQ = 8, HKV = 2;
constexpr int M = NB * S;
constexpr int MC = NB * CTXL;
constexpr int INW = 5632, NMOD = 6144, NEXP = 16384, PW = 2048;
constexpr float EPS = 1e-6f;

__device__ __forceinline__ unsigned cvt_pk_bf16(float lo, float hi) { f32x2 v = {lo, hi}; bf16x2_t b = __builtin_convertvector(v, bf16x2_t); return __builtin_bit_cast(unsigned, b); }
__device__ __forceinline__ float bf_lo(unsigned u) { return __uint_as_float(u << 16); }
__device__ __forceinline__ float bf_hi(unsigned u) { return __uint_as_float(u & 0xffff0000u); }
__device__ __forceinline__ float fast_sigmoid(float x) { return __builtin_amdgcn_rcpf(1.f + __builtin_amdgcn_exp2f(-1.4426950408889634f * x)); }
__device__ __forceinline__ float wave_sum(float v) {
#pragma unroll
    for (int o = 1; o < 64; o <<= 1) v += __shfl_xor(v, o);
    return v;
}

namespace pg8 {
constexpr int BM = 256, BK = 64, HALF = 128, HTB = HALF * BK * 2  , STAGE_BYTES = 8 * HTB, NXCD = 8, WGM = 8;
__host__ __device__ __forceinline__ int lds_byte(int r, int c) { const int st = (r >> 4) * 2 + (c >> 5), rr = r & 15, cc = c & 31, ob = rr * 64 + cc * 2; return st * 1024 + (ob ^ (((ob >> 9) & 1) << 5)); }
__host__ __device__ __forceinline__ void stage_rc(int b, int& R, int& C) { const int st = b / 1024, sb = b % 1024, swz = sb ^ (((sb >> 9) & 1) << 5); R = (st >> 1) * 16 + swz / 64; C = (st & 1) * 32 + (swz % 64) / 2; }
__host__ __device__ __forceinline__ int perm32(int rho) { const int n = rho >> 4, i = rho & 15; return 8 * (i >> 2) + 4 * n + (i & 3); }

struct Unit { const char* a; const char* b; int pm, pn, kind, keep; };

__device__ __forceinline__ void tile_of(int L, int nM, int nN, int& pm, int& pn) {
    const int nwg = nM * nN; int wgid = L;
    { const int q = nwg / NXCD, r = nwg % NXCD, xcd = wgid % NXCD, off = wgid / NXCD; wgid = (xcd < r ? xcd * (q + 1) : r * (q + 1) + (xcd - r) * q) + off; }
    const int nig = WGM * nN, gid = wgid / nig, fm = gid * WGM, gsz = (nM - fm) < WGM ? (nM - fm) : WGM;
    pm = fm + ((wgid % nig) % gsz); pn = (wgid % nig) / gsz;
}

typedef int i32x4v __attribute__((ext_vector_type(4)));
typedef int i32x8v __attribute__((ext_vector_type(8)));
__device__ __forceinline__ i32x8v cat8(bf16x8 a, bf16x8 b) { const i32x4v x = __builtin_bit_cast(i32x4v, a), y = __builtin_bit_cast(i32x4v, b); return __builtin_shufflevector(x, y, 0, 1, 2, 3, 4, 5, 6, 7); }
__device__ __forceinline__ void mfma_f8_acc(f32x4& c, i32x8v a, i32x8v b) { asm volatile("v_mfma_f32_16x16x128_f8f6f4 %0, %1, %2, %0" : "+v"(c) : "v"(a), "v"(b)); }
template <class Epi, class Sched, bool ALIGN_EPI, bool F8 = false>
__device__ __forceinline__ void gemm_phase(LAS unsigned char* lds, const int K, const Sched& S, const Epi& E) {
    const int tid = threadIdx.x, wid = __builtin_amdgcn_readfirstlane(tid >> 6), lane = tid & 63, wr = wid >> 2, wc = wid & 3, fr = lane & 15, fq = lane >> 4;
    const int nt = K / BK;
    unsigned voffA[2], voffB[2];
#pragma unroll
    for (int i = 0; i < 2; ++i) { int R, C; stage_rc(tid * 16 + i * 8192, R, C); const int Rb = Epi::PERM ? ((R & ~31) + perm32(R & 31)) : R;
        voffA[i] = (unsigned)(R * K + C) * 2u; voffB[i] = (unsigned)(Rb * K + C) * 2u; }
    const size_t kstep = (size_t)(BK * 2);
    const size_t hstep = (size_t)HALF * K * 2;
    const unsigned ldsw = (unsigned)wid * 1024u;
    const int aoff = lds_byte(wr * 64 + fr, fq * 8), boff = lds_byte(wc * 32 + fr, fq * 8);
#define PG8_SA(b, h) (((b) * 2 + (h)) * HTB)
#define PG8_SB(b, h) ((4 + (b) * 2 + (h)) * HTB)
#define PG8_STAGE(bufoff, gbase, voff) do { _Pragma("unroll") for (int _i = 0; _i < 2; ++_i) \
        __builtin_amdgcn_global_load_lds((const unsigned*)((const char*)(gbase) + (voff)[_i]), (LAS unsigned*)(lds + (bufoff) + ldsw + _i * 8192), 16, 0, 0); } while (0)
#define PG8_LDA(dst, b, h) do { _Pragma("unroll") for (int m = 0; m < 4; ++m) _Pragma("unroll") for (int k = 0; k < 2; ++k) dst[m][k] = *(const LAS bf16x8*)(lds + PG8_SA(b, h) + aoff + m * 2048 + k * 1024); } while (0)
#define PG8_LDB(dst, b, h) do { _Pragma("unroll") for (int n = 0; n < 2; ++n) _Pragma("unroll") for (int k = 0; k < 2; ++k) dst[n][k] = *(const LAS bf16x8*)(lds + PG8_SB(b, h) + boff + n * 2048 + k * 1024); } while (0)
#define PG8_MMA(ai, bj, At, Bt) do { __builtin_amdgcn_s_setprio(1); if constexpr (F8) { _Pragma("unroll") for (int m = 0; m < 4; ++m) _Pragma("unroll") for (int n = 0; n < 2; ++n) \
        mfma_f8_acc(acc[ai][bj][m][n], cat8(Bt[n][0], Bt[n][1]), cat8(At[m][0], At[m][1])); } else { \
        _Pragma("unroll") for (int m = 0; m < 4; ++m) _Pragma("unroll") for (int n = 0; n < 2; ++n) _Pragma("unroll") for (int k = 0; k < 2; ++k) \
        acc[ai][bj][m][n] = __builtin_amdgcn_mfma_f32_16x16x32_bf16(Bt[n][k], At[m][k], acc[ai][bj][m][n], 0, 0, 0); } __builtin_amdgcn_s_setprio(0); } while (0)
#define PG8_WAIT_V(n) asm volatile("s_waitcnt vmcnt(" #n ")" ::: "memory")
#define PG8_WAIT_L(n) asm volatile("s_waitcnt lgkmcnt(" #n ")" ::: "memory")
#define PG8_BAR __builtin_amdgcn_s_barrier()
#define PG8_SCHED __builtin_amdgcn_sched_barrier(0)
    Unit cur, nxt; int ui = 0;
    if (!S.next(0, cur)) return;
    f32x4 acc[2][2][4][2];
#pragma unroll
    for (int a = 0; a < 2; ++a)
#pragma unroll
        for (int b = 0; b < 2; ++b)
#pragma unroll
            for (int m = 0; m < 4; ++m)
#pragma unroll
                for (int n = 0; n < 2; ++n) acc[a][b][m][n] = (f32x4){0.f, 0.f, 0.f, 0.f};
    bf16x8 At[4][2], B0[2][2], B1[2][2];
    const char* cA = cur.a; const char* cB = cur.b;
    PG8_STAGE(PG8_SB(0, 0), cB, voffB); PG8_STAGE(PG8_SB(0, 1), cB + hstep, voffB); PG8_STAGE(PG8_SA(0, 0), cA, voffA); PG8_STAGE(PG8_SA(0, 1), cA + hstep, voffA);
    if (wr == 1) PG8_BAR;
    PG8_WAIT_V(2); PG8_BAR;
    PG8_STAGE(PG8_SB(1, 0), cB + kstep, voffB); PG8_STAGE(PG8_SA(1, 0), cA + kstep, voffA); PG8_STAGE(PG8_SB(1, 1), cB + hstep + kstep, voffB);
    PG8_WAIT_V(6); PG8_BAR;
    for (;;) {
        const bool has_next = S.next(ui + 1, nxt);
        const char* nA = has_next ? nxt.a : cA; const char* nB = has_next ? nxt.b : cB;
#pragma unroll 1
        for (int t = 0; t < nt; t += 2) {
            const bool last = (t == nt - 2);
            const char* a1 = cA + (size_t)(t + 1) * kstep;
            const char* a2 = last ? nA : cA + (size_t)(t + 2) * kstep; const char* b2 = last ? nB : cB + (size_t)(t + 2) * kstep;
            const char* a3 = a2 + kstep; const char* b3 = b2 + kstep;
            PG8_LDB(B0, 0, 0); PG8_LDB(B1, 0, 1); PG8_SCHED; PG8_LDA(At, 0, 0); PG8_STAGE(PG8_SA(1, 1), a1 + hstep, voffA);
            PG8_WAIT_V(8); PG8_WAIT_L(0); PG8_BAR; PG8_MMA(0, 0, At, B0); PG8_MMA(0, 1, At, B1); PG8_BAR; PG8_SCHED;
            PG8_LDA(At, 0, 1); PG8_STAGE(PG8_SB(0, 0), b2, voffB); PG8_STAGE(PG8_SB(0, 1), b2 + hstep, voffB); PG8_STAGE(PG8_SA(0, 0), a2, voffA);
            PG8_WAIT_V(8); PG8_WAIT_L(0); PG8_BAR; PG8_MMA(1, 0, At, B0); PG8_MMA(1, 1, At, B1); PG8_BAR; PG8_SCHED;
            PG8_LDB(B0, 1, 0); PG8_LDB(B1, 1, 1); PG8_SCHED; PG8_LDA(At, 1, 0); PG8_STAGE(PG8_SA(0, 1), a2 + hstep, voffA);
            PG8_WAIT_V(8); PG8_WAIT_L(0); PG8_BAR; PG8_MMA(0, 0, At, B0); PG8_MMA(0, 1, At, B1); PG8_BAR; PG8_SCHED;
            PG8_LDA(At, 1, 1); PG8_STAGE(PG8_SB(1, 0), b3, voffB); PG8_STAGE(PG8_SB(1, 1), b3 + hstep, voffB); PG8_STAGE(PG8_SA(1, 0), a3, voffA);
            PG8_WAIT_V(8); PG8_WAIT_L(0); PG8_BAR; PG8_MMA(1, 0, At, B0); PG8_MMA(1, 1, At, B1); PG8_BAR; PG8_SCHED;
        }
        if constexpr (ALIGN_EPI) { if (wr == 0) PG8_BAR; }
        if constexpr (F8) { asm volatile("s_nop 15\n\ts_nop 15" ::: "memory");
            if (!cur.keep)
#pragma unroll
            for (int a = 0; a < 2; ++a)
#pragma unroll
                for (int b = 0; b < 2; ++b)
#pragma unroll
                    for (int m = 0; m < 4; ++m)
#pragma unroll
                        for (int n = 0; n < 2; ++n) acc[a][b][m][n] *= (1.f / 8192.f); }
        E(acc, cur, wr, wc, fr, fq);
        if (!has_next) break;
        if (!cur.keep) {
#pragma unroll
        for (int a = 0; a < 2; ++a)
#pragma unroll
            for (int b = 0; b < 2; ++b)
#pragma unroll
                for (int m = 0; m < 4; ++m)
#pragma unroll
                    for (int n = 0; n < 2; ++n) acc[a][b][m][n] = (f32x4){0.f, 0.f, 0.f, 0.f};
        }
        cur = nxt; cA = nA; cB = nB; ++ui;
        if constexpr (ALIGN_EPI) { if (wr == 1) PG8_BAR; }
    }
    PG8_WAIT_V(0);
    if constexpr (!ALIGN_EPI) { if (wr == 0) PG8_BAR; }
    PG8_BAR;
#undef PG8_SA
#undef PG8_SB
#undef PG8_STAGE
#undef PG8_LDA
#undef PG8_LDB
#undef PG8_MMA
#undef PG8_WAIT_V
#undef PG8_WAIT_L
#undef PG8_BAR
#undef PG8_SCHED
}
}
namespace att {
typedef int v8i __attribute__((ext_vector_type(8)));
constexpr int NW = 8, QBLK = 32, KVBLK = 64;
constexpr float SCALE = 0.088388347648318440f;
constexpr float SC8 = SCALE / 256.f;
constexpr float THR = 3.f;
constexpr int LDQ = D, LDO = D;
constexpr int SHM_V = 8192, SHM_K = 8192, NRING = 3, OFF_K = NRING * SHM_V, OFF_WS = OFF_K + NRING * SHM_K, OST_OFF = OFF_WS + NW * 64 * 4, LDS_TOTAL = OST_OFF + NW * 8192;
#define SBAR() __builtin_amdgcn_sched_barrier(0)
#define MFMA8(a, b, c) __builtin_amdgcn_mfma_scale_f32_32x32x64_f8f6f4((a), (b), (c), 0, 0, 0, 0x7f7f7f7f, 0, 0x7f7f7f7f)
__device__ __forceinline__ int crow(int r, int hi) { return (r & 3) + 8 * (r >> 2) + 4 * hi; }
__device__ __forceinline__ int k_lds(int row, int chunk) { return row * 128 + ((chunk ^ ((row >> 1) & 7)) << 4); }
__device__ __forceinline__ int v_lds(int d, int slot) { return d * 64 + ((slot ^ ((d >> 2) & 3)) << 4); }
__device__ __forceinline__ float max3f(float a, float b, float c) { float r; asm("v_max3_f32 %0, %1, %2, %3" : "=v"(r) : "v"(a), "v"(b), "v"(c)); return r; }
__device__ __forceinline__ int pk4_fp8(float a, float b, float c, float d) { int w = __builtin_amdgcn_cvt_pk_fp8_f32(a, b, 0, false); return __builtin_amdgcn_cvt_pk_fp8_f32(c, d, w, true); }

__device__ __forceinline__ void partialSM(f32x16& p0, f32x16& p1, float& m_reg, float& mn, float& alpha) {
  constexpr float C = SC8 * 1.4426950408889634f;
  asm volatile("s_nop 15\n\ts_nop 7" : "+v"(p0), "+v"(p1));
  float mx[8];
#pragma unroll
  for (int i = 0; i < 8; ++i) mx[i] = max3f(p0[i], p0[8 + i], p1[i]);
  float m4[4];
#pragma unroll
  for (int i = 0; i < 4; ++i) m4[i] = max3f(mx[i], mx[4 + i], p1[8 + i]);
  float m2a = max3f(m4[0], m4[1], p1[12]), m2b = max3f(m4[2], m4[3], p1[13]);
  float pmax = max3f(m2a, m2b, p1[14]); pmax = max3f(pmax, p1[15], p1[15]);
  { auto rr = __builtin_amdgcn_permlane32_swap(__float_as_uint(pmax), __float_as_uint(pmax), false, false);
    pmax = fmaxf(__uint_as_float(rr[0]), __uint_as_float(rr[1])); }
  if (__builtin_expect(__all(pmax - m_reg <= THR / SC8), 1)) { mn = m_reg; alpha = 1.f; }
  else { mn = fmaxf(m_reg, pmax); alpha = __builtin_amdgcn_exp2f((m_reg - mn) * C); m_reg = mn; }
  float mnC = 4.f - mn * C;
  for (int r = 0; r < 16; ++r) p0[r] = fmaf(p0[r], C, mnC); for (int r = 0; r < 16; ++r) p1[r] = fmaf(p1[r], C, mnC);
  for (int r = 0; r < 16; ++r) p0[r] = __builtin_amdgcn_exp2f(p0[r]);
}
__device__ __forceinline__ void finishSM(f32x16& p0, f32x16& p1, float alpha, float& l_reg, v8i& pa) {
  for (int r = 0; r < 16; ++r) p1[r] = __builtin_amdgcn_exp2f(p1[r]);
  float sm[8];
#pragma unroll
  for (int i = 0; i < 8; ++i) sm[i] = (p0[i] + p0[8 + i]) + (p1[i] + p1[8 + i]);
  float ps = ((sm[0] + sm[1]) + (sm[2] + sm[3])) + ((sm[4] + sm[5]) + (sm[6] + sm[7]));
  { auto rr = __builtin_amdgcn_permlane32_swap(__float_as_uint(ps), __float_as_uint(ps), false, false);
    ps = __uint_as_float(rr[0]) + __uint_as_float(rr[1]); }
  l_reg = l_reg * alpha + ps;
  pa[0] = pk4_fp8(p0[0], p0[1], p0[2], p0[3]); pa[1] = pk4_fp8(p0[4], p0[5], p0[6], p0[7]); pa[2] = pk4_fp8(p0[8], p0[9], p0[10], p0[11]); pa[3] = pk4_fp8(p0[12], p0[13], p0[14], p0[15]);
  pa[4] = pk4_fp8(p1[0], p1[1], p1[2], p1[3]); pa[5] = pk4_fp8(p1[4], p1[5], p1[6], p1[7]); pa[6] = pk4_fp8(p1[8], p1[9], p1[10], p1[11]); pa[7] = pk4_fp8(p1[12], p1[13], p1[14], p1[15]);
}
__device__ __forceinline__ v8i ld32(const char* p0, const char* p1) { const u32x4 a = *reinterpret_cast<const u32x4*>(p0), b = *reinterpret_cast<const u32x4*>(p1);
  v8i r; r[0] = (int)a[0]; r[1] = (int)a[1]; r[2] = (int)a[2]; r[3] = (int)a[3]; r[4] = (int)b[0]; r[5] = (int)b[1]; r[6] = (int)b[2]; r[7] = (int)b[3]; return r; }
__device__ __forceinline__ void qkt(f32x16& p0, f32x16& p1, const char* Ks, const v8i* qf, int r32, int hi) {
  p0 = f32x16{}; p1 = f32x16{};
#pragma unroll
  for (int s = 0; s < 2; ++s) {
    const v8i a0 = ld32(Ks + k_lds(r32, 4 * s + hi), Ks + k_lds(r32, 4 * s + 2 + hi)), a1 = ld32(Ks + k_lds(32 + r32, 4 * s + hi), Ks + k_lds(32 + r32, 4 * s + 2 + hi));
    p0 = MFMA8(a0, qf[s], p0); p1 = MFMA8(a1, qf[s], p1); }
}
__device__ __forceinline__ void pv(f32x16* o, const char* Vs, const v8i pa, int r32, int hi) {
#pragma unroll
  for (int d0 = 0; d0 < 4; ++d0) { const int d = 32 * d0 + r32; const v8i b = ld32(Vs + v_lds(d, 2 * hi), Vs + v_lds(d, 2 * hi + 1)); o[d0] = MFMA8(pa, b, o[d0]); }
}

__device__ __forceinline__ void attn_unit(const bf16_t* Qb, const unsigned char* __restrict__ K8, const unsigned char* __restrict__ VT, unsigned char* Ob, int t0, int seq,
                                          const float* __restrict__ qng, const float* __restrict__ cst, const float* __restrict__ snt, char* lds) {
  int tid_ = threadIdx.x; asm volatile("" : "+v"(tid_));
  const int tid = tid_, wid = tid >> 6, lane = tid & 63, r32 = lane & 31, hi = lane >> 5;
  char* V_lds = lds; char* K_lds = lds + OFF_K;
  float* ws = (float*)(lds + OFF_WS) + wid * 64; float* li_l = ws; float* al_l = ws + 32;
  float m_reg = -1e30f, l_reg = 0; f32x16 o[4] = {}; v8i qf[2];
  {
    const bf16_t* Qw = Qb + (long)(wid * QBLK + r32) * LDQ + 16 * hi;
    float y[2][32]; float ss = 0.f;
#pragma unroll
    for (int s = 0; s < 2; ++s)
#pragma unroll
      for (int part = 0; part < 2; ++part)
#pragma unroll
        for (int c = 0; c < 2; ++c) { const u32x4 w = *reinterpret_cast<const u32x4*>(Qw + 64 * s + 32 * part + 8 * c);
#pragma unroll
          for (int j = 0; j < 4; ++j) { const float a = bf_lo(w[j]), b = bf_hi(w[j]); y[s][16 * part + 8 * c + 2 * j] = a; y[s][16 * part + 8 * c + 2 * j + 1] = b; ss += a * a + b * b; } }
    ss += __shfl_xor(ss, 32);
    const float rstd = rsqrtf(ss * (1.f / HD) + EPS) * 16.f;
    const int t = t0 + wid * QBLK + r32;
#pragma unroll
    for (int s = 0; s < 2; ++s) { const int pos = s == 0 ? (t >> 6) : (t & 63);
#pragma unroll
      for (int c = 0; c < 4; ++c) { const int i0 = 16 * hi + 4 * c;
        const f32x4 g1 = *reinterpret_cast<const f32x4*>(qng + 64 * s + i0), g2 = *reinterpret_cast<const f32x4*>(qng + 64 * s + 32 + i0);
        const f32x4 c4 = *reinterpret_cast<const f32x4*>(cst + pos * 32 + i0), s4 = *reinterpret_cast<const f32x4*>(snt + pos * 32 + i0);
#pragma unroll
        for (int j = 0; j < 4; ++j) { const float x1 = y[s][4 * c + j] * rstd * g1[j], x2 = y[s][16 + 4 * c + j] * rstd * g2[j]; y[s][4 * c + j] = x1 * c4[j] - x2 * s4[j]; y[s][16 + 4 * c + j] = x1 * s4[j] + x2 * c4[j]; } }
#pragma unroll
      for (int w = 0; w < 8; ++w) qf[s][w] = pk4_fp8(y[s][4 * w], y[s][4 * w + 1], y[s][4 * w + 2], y[s][4 * w + 3]); }
  }
  const int krow = tid >> 3, kch = tid & 7, kst = k_lds(krow, kch), vst = v_lds(tid >> 2, tid & 3);
  const unsigned char* kg = K8 + (long)krow * 256 + kch * 16; const unsigned char* vg = VT + tid * 16;
  struct { u32x4 k, v; } sr_[2];
#define SLOAD(i, kt) do { sr_[i].k = *reinterpret_cast<const u32x4*>(kg + (long)(kt) * (KVBLK * 256)); sr_[i].v = *reinterpret_cast<const u32x4*>(vg + (long)(kt) * 8192); } while (0)
#define SWRITE(boff, i) do { *(u32x4*)(V_lds + (boff) + vst) = sr_[i].v; *(u32x4*)(K_lds + (boff) + kst) = sr_[i].k; } while (0)
#define SWAIT() asm volatile("s_waitcnt vmcnt(2)" ::: "memory")
#define RESC(a) do { if (__any((a) < 1.f)) { if (hi == 0) al_l[r32] = (a); asm volatile("s_waitcnt lgkmcnt(0)" ::: "memory"); \
    for (int d = 0; d < 4; ++d) for (int r = 0; r < 16; ++r) o[d][r] *= al_l[crow(r, hi)]; } } while (0)
  f32x16 pA0, pA1, pB0, pB1; float mnA, mnB, alA, alB; v8i pa; const int NT = seq / KVBLK;
  constexpr int SE = 0, SO = 1;
  int bprev = 0, bcur = SHM_K, bnext = 2 * SHM_K;
#define ROT() do { const int t_ = bprev; bprev = bcur; bcur = bnext; bnext = t_; } while (0)
  SLOAD(SE, 0); asm volatile("s_waitcnt vmcnt(0)" ::: "memory"); SWRITE(0, SE); __syncthreads();
  qkt(pA0, pA1, K_lds, qf, r32, hi); partialSM(pA0, pA1, m_reg, mnA, alA);
  SLOAD(SO, 1); if (2 < NT) SLOAD(SE, 2);
  SWAIT(); SWRITE(SHM_K, SO); __syncthreads();
  for (int j = 1; j + 1 < NT; j += 2) {
    SBAR(); qkt(pB0, pB1, K_lds + bcur, qf, r32, hi);
    finishSM(pA0, pA1, alA, l_reg, pa); SBAR();
    SLOAD(SO, j + 2); SBAR();
    pv(o, V_lds + bprev, pa, r32, hi); partialSM(pB0, pB1, m_reg, mnB, alB);
    SWAIT(); SWRITE(bnext, SE);
    RESC(alB); __syncthreads(); ROT();
    SBAR(); qkt(pA0, pA1, K_lds + bcur, qf, r32, hi);
    finishSM(pB0, pB1, alB, l_reg, pa); SBAR();
    if (j + 3 < NT) SLOAD(SE, j + 3); SBAR();
    pv(o, V_lds + bprev, pa, r32, hi); partialSM(pA0, pA1, m_reg, mnA, alA);
    SWAIT(); SWRITE(bnext, SO);
    RESC(alA); __syncthreads(); ROT();
  }
  SBAR(); qkt(pB0, pB1, K_lds + bcur, qf, r32, hi);
  finishSM(pA0, pA1, alA, l_reg, pa); SBAR();
  pv(o, V_lds + bprev, pa, r32, hi); partialSM(pB0, pB1, m_reg, mnB, alB);
  RESC(alB);
  finishSM(pB0, pB1, alB, l_reg, pa); SBAR();
  pv(o, V_lds + bcur, pa, r32, hi);
  __syncthreads();
#undef ROT
  if (hi == 0) li_l[r32] = l_reg; asm volatile("s_waitcnt lgkmcnt(0)" ::: "memory");
  float rli[16];
#pragma unroll
  for (int r = 0; r < 16; ++r) rli[r] = __builtin_amdgcn_rcpf(16.f * li_l[crow(r, hi)]);
  { bf16_t* stg = (bf16_t*)(lds + OST_OFF) + wid * 4096;
#pragma unroll
    for (int r = 0; r < 16; ++r) { const int orow = crow(r, hi);
#pragma unroll
      for (int d0 = 0; d0 < 4; ++d0) stg[orow * 128 + d0 * 32 + r32] = (bf16_t)(cvt_pk_bf16(o[d0][r] * rli[r], 0.f) & 0xffffu); }
    asm volatile("s_waitcnt lgkmcnt(0)" ::: "memory");
    unsigned char* Ow = Ob + (long)(wid * QBLK) * LDO;
#pragma unroll
    for (int i = 0; i < 8; ++i) { const int row = i * 4 + (lane >> 4), ch = lane & 15; const u32x4 v = *(const u32x4*)(stg + row * 128 + ch * 8);
      u32x2 w8 = {(unsigned)pk4_fp8(bf_lo(v[0]) * 16.f, bf_hi(v[0]) * 16.f, bf_lo(v[1]) * 16.f, bf_hi(v[1]) * 16.f), (unsigned)pk4_fp8(bf_lo(v[2]) * 16.f, bf_hi(v[2]) * 16.f, bf_lo(v[3]) * 16.f, bf_hi(v[3]) * 16.f)};
      *(u32x2*)(Ow + (long)row * LDO + ch * 8) = w8; }
  }
#undef SLOAD
#undef SWRITE
#undef SWAIT
#undef RESC
}
#undef SBAR
#undef MFMA8
}
constexpr size_t MiB = 1u << 20;
constexpr size_t WS_CTL = 0, CTL_ZERO_BYTES = 64 * 1024;
constexpr size_t WS_MOD = 1 * MiB;
constexpr size_t WS_ROPE = WS_MOD + 256 * 1024;
constexpr size_t WS_SBIAS = WS_MOD + 512 * 1024;
constexpr size_t WS_HC = 2 * MiB;
constexpr size_t WS_WIN = 6 * MiB;
constexpr size_t WS_WA = 17 * MiB, WS_WC = 19 * MiB, WS_WO = 21 * MiB;
constexpr size_t WS_WP = 23 * MiB;
constexpr size_t WS_UT = 27 * MiB, WS_VT = 59 * MiB;
constexpr size_t WS_TSCALE = 16 * MiB;
constexpr size_t WS_KB = 91 * MiB, WS_VB = 108 * MiB;
constexpr size_t WS_HX = 125 * MiB;
constexpr size_t WS_ATT8 = WS_HX + 32 * MiB;
constexpr size_t WS_Q = 189 * MiB;
constexpr size_t WS_G = 253 * MiB;
constexpr size_t WS_RT = 317 * MiB;
constexpr size_t WS_XSB = WS_RT;
constexpr size_t WS_SGC = 381 * MiB;
constexpr size_t WS_SC = 189 * MiB;
constexpr size_t WS_SSQ = 445 * MiB;
constexpr size_t WS_K8 = 447 * MiB;
constexpr size_t WS_VT8 = 456 * MiB;
constexpr size_t WS_PE = 465 * MiB, WS_PC = 481 * MiB;
constexpr size_t WS_END = 497 * MiB;

constexpr int NWAVES = 8;
constexpr int LDS_BYTES = 147456;

struct Args {
    const float *x, *c, *ctx, *c_ctx, *w_mod, *b_mod, *n1g, *n2g, *w_in, *qng, *kng, *w_ao, *cdw, *cb, *clg, *clb, *w_co, *w_o, *wq, *keys, *ut, *vt, *fg;
    float* out; unsigned char* ws; int ph_lo, ph_hi, dry, pad;
};

__host__ __device__ __forceinline__ int win_row(int n) {
    if (n < 1536) return n;
    const int base = n < 3584 ? 1536 : 3584, m = n - base, half = m >> 10, idx = m & 1023;
    return base + (idx >> 7) * 256 + half * 128 + (idx & 127);
}

__device__ __forceinline__ void task_mod(const Args& A, int task, int lane, const LAS float* sc) {
    const int n0 = task * 8, col = lane & 7, kg = lane >> 3;
    float acc[9];
#pragma unroll
    for (int b = 0; b < 9; ++b) acc[b] = 0.f;
    const float* wp = A.w_mod + (size_t)kg * NMOD + n0 + col;
    for (int i0 = 0; i0 < 128; i0 += 8) {
        float w[8];
#pragma unroll
        for (int u = 0; u < 8; ++u) w[u] = wp[(size_t)(i0 + u) * 8 * NMOD];
#pragma unroll
        for (int u = 0; u < 8; ++u) { const int k = kg + 8 * (i0 + u);
#pragma unroll
            for (int b = 0; b < 9; ++b) acc[b] += sc[b * D + k] * w[u]; }
    }
#pragma unroll
    for (int b = 0; b < 9; ++b) { float v = acc[b]; v += __shfl_xor(v, 8); v += __shfl_xor(v, 16); v += __shfl_xor(v, 32); acc[b] = v; }
    if (lane < 8) { float* mod = (float*)(A.ws + WS_MOD); const float bm = A.b_mod[n0 + col];
#pragma unroll
        for (int b = 0; b < 9; ++b) mod[b * NMOD + n0 + col] = acc[b] + bm; }
}
__device__ __forceinline__ void task_transpose(const float* W, int K, int N, bf16_t* WT, int k0, int n0, int row0, LAS float* scr, int lane) {
#pragma unroll 8
    for (int i = 0; i < 32; ++i) { const int kk = 2 * i + (lane >> 5); scr[kk * 33 + (lane & 31)] = W[(size_t)(k0 + kk) * N + n0 + (lane & 31)]; }
    asm volatile("s_waitcnt lgkmcnt(0)" ::: "memory");
    const int c = lane & 7;
#pragma unroll
    for (int j = 0; j < 4; ++j) { const int n = (lane >> 3) + 8 * j; const LAS float* s = scr + (8 * c) * 33 + n;
        u32x4 o; o.x = cvt_pk_bf16(s[0 * 33], s[1 * 33]); o.y = cvt_pk_bf16(s[2 * 33], s[3 * 33]); o.z = cvt_pk_bf16(s[4 * 33], s[5 * 33]); o.w = cvt_pk_bf16(s[6 * 33], s[7 * 33]);
        *(u32x4*)(WT + (size_t)(row0 + n) * K + k0 + 8 * c) = o; }
    asm volatile("s_waitcnt lgkmcnt(0)" ::: "memory");
}
__device__ __forceinline__ void task_transpose_f8(const float* W, int K, int N, unsigned char* WT, int k0, int n0, int row0, LAS float* scr, int lane) {
#pragma unroll 8
    for (int i = 0; i < 32; ++i) { const int kk = 2 * i + (lane >> 5); scr[kk * 33 + (lane & 31)] = W[(size_t)(k0 + kk) * N + n0 + (lane & 31)]; }
    asm volatile("s_waitcnt lgkmcnt(0)" ::: "memory");
    const int c = lane & 7;
#pragma unroll
    for (int j = 0; j < 4; ++j) { const int n = (lane >> 3) + 8 * j; const LAS float* s = scr + (8 * c) * 33 + n;
        u32x2 o = {(unsigned)att::pk4_fp8(s[0 * 33] * 512.f, s[1 * 33] * 512.f, s[2 * 33] * 512.f, s[3 * 33] * 512.f), (unsigned)att::pk4_fp8(s[4 * 33] * 512.f, s[5 * 33] * 512.f, s[6 * 33] * 512.f, s[7 * 33] * 512.f)};
        *(u32x2*)(WT + (size_t)(row0 + n) * K + k0 + 8 * c) = o; }
    asm volatile("s_waitcnt lgkmcnt(0)" ::: "memory");
}
typedef float f32x16v __attribute__((ext_vector_type(16)));
typedef unsigned u32x6 __attribute__((ext_vector_type(6)));
constexpr int ROWB = 768;
__device__ __forceinline__ void task_quant_rows4(const float* src, unsigned char* dst, float* scale_out, int lane) {
    const int g = lane & 31, hh = lane >> 5;
    f32x4 v[2][8];
#pragma unroll
    for (int r = 0; r < 2; ++r)
#pragma unroll
        for (int i = 0; i < 8; ++i) v[r][i] = *(const f32x4*)(src + (size_t)(2 * r + hh) * D + g * 32 + i * 4);
#pragma unroll
    for (int r = 0; r < 2; ++r) {
        float am = 0.f;
#pragma unroll
        for (int i = 0; i < 8; ++i) am = fmaxf(fmaxf(am, fmaxf(fabsf(v[r][i][0]), fabsf(v[r][i][1]))), fmaxf(fabsf(v[r][i][2]), fabsf(v[r][i][3])));
#pragma unroll
        for (int o = 1; o < 32; o <<= 1) am = fmaxf(am, __shfl_xor(am, o));
        const float inv = am > 0.f ? 7.5f / am : 0.f;
        f32x16v a, b;
#pragma unroll
        for (int i = 0; i < 4; ++i)
#pragma unroll
            for (int j = 0; j < 4; ++j) { const int e0 = 4 * i + j;
                a[e0] = v[r][(2 * e0) >> 2][(2 * e0) & 3] * inv; b[e0] = v[r][(2 * e0 + 1) >> 2][(2 * e0 + 1) & 3] * inv; }
        const u32x6 p = __builtin_amdgcn_cvt_scalef32_2xpk16_fp6_f32(a, b, 1.0f);
        unsigned char* rowp = dst + (size_t)(2 * r + hh) * ROWB;
        *(u32x4*)(rowp + g * 16) = (u32x4){p[0], p[1], p[2], p[3]}; *(u32x2*)(rowp + 512 + g * 8) = (u32x2){p[4], p[5]};
        if (g == 0) scale_out[2 * r + hh] = am * (1.f / 7.5f);
    }
}
__device__ __forceinline__ bf16x8 ld8_f32_bf16(const float* p) { const f32x4 a = *(const f32x4*)p, b = *(const f32x4*)(p + 4); u32x4 w = {cvt_pk_bf16(a[0], a[1]), cvt_pk_bf16(a[2], a[3]), cvt_pk_bf16(b[0], b[1]), cvt_pk_bf16(b[2], b[3])}; return *reinterpret_cast<bf16x8*>(&w); }
__device__ __forceinline__ void task_wprime(const Args& A, int id, int lane) {
    const int hp = id >> 7, rem = id & 127, n0 = (rem >> 5) * 32, k0 = (rem & 31) * 32, r32 = lane & 31, hi = lane >> 5;
    f32x16 acc = {};
    const float* ka = A.keys + ((size_t)(hp * 128 + n0 + r32)) * 128 + hi * 8;
    const float* wb = A.wq + (size_t)(k0 + r32) * PW + hp * 128 + hi * 8;
#pragma unroll
    for (int s = 0; s < 8; ++s) acc = __builtin_amdgcn_mfma_f32_32x32x16_bf16(ld8_f32_bf16(ka + s * 16), ld8_f32_bf16(wb + s * 16), acc, 0, 0, 0);
    bf16_t* o = (bf16_t*)(A.ws + WS_WP);
#pragma unroll
    for (int r = 0; r < 16; ++r) { const int n = (r & 3) + 8 * (r >> 2) + 4 * hi; o[(size_t)(hp * 128 + n0 + n) * D + k0 + r32] = (bf16_t)(cvt_pk_bf16(acc[r], 0.f) & 0xffffu); }
}
__device__ __forceinline__ void phase_prologue(const Args& A, LAS unsigned char* lds) {
    const int tid = threadIdx.x, lane = tid & 63, wave = __builtin_amdgcn_readfirstlane(tid >> 6);
    LAS float* sc = (LAS float*)lds;
    for (int i = tid; i < 9 * D; i += 512) { const float v = i < 8 * D ? A.c[i] : A.c_ctx[i - 8 * D]; sc[i] = v / (1.f + __expf(-v)); }
    __syncthreads();
    LAS float* scr = (LAS float*)(lds + 36864 + wave * 8448);
    constexpr int T_MOD = NMOD / 8, T_WIN = (D / 64) * (INW / 32), T_SQ = (D / 64) * (D / 32), T_UV = 2 * NEXP / 4, T_WP = 2048, T_ROPE = 1;
    constexpr int NT = T_MOD + T_WIN + 3 * T_SQ + T_UV + T_WP + T_ROPE;
    const int G = gridDim.x;
    for (int task = wave * G + blockIdx.x; task < NT; task += NWAVES * G) {
        int r = task;
        if (r < T_MOD) { task_mod(A, r, lane, sc); continue; } r -= T_MOD;
        if (r < T_WIN) { const int nblk = INW / 32, kb = r / nblk, nb = r % nblk; task_transpose_f8(A.w_in, D, INW, A.ws + WS_WIN, 64 * kb, 32 * nb, win_row(32 * nb), scr, lane); continue; } r -= T_WIN;
        if (r < 3 * T_SQ) { const int wsel = r / T_SQ, q = r % T_SQ, kb = q / 32, nb = q % 32;
            const float* W = wsel == 0 ? A.w_ao : (wsel == 1 ? A.w_co : A.w_o); unsigned char* WT = A.ws + (wsel == 0 ? WS_WA : (wsel == 1 ? WS_WC : WS_WO));
            task_transpose_f8(W, D, D, WT, 64 * kb, 32 * nb, 32 * nb, scr, lane); continue; } r -= 3 * T_SQ;
        if (r < T_UV) { const int tb = r / (NEXP / 4), row = (r % (NEXP / 4)) * 4; unsigned char* tbase = A.ws + (tb ? WS_VT : WS_UT);
            task_quant_rows4((tb ? A.vt : A.ut) + (size_t)row * D, tbase + (size_t)row * ROWB, (float*)(tbase + WS_TSCALE) + row, lane); continue; } r -= T_UV;
        if (r < T_WP) { task_wprime(A, r, lane); continue; } r -= T_WP;
        { float* cs = (float*)(A.ws + WS_ROPE); float* sn = cs + 2048;
          for (int e = lane; e < 2048; e += 64) { const int p = e >> 5, i = e & 31; const float inv = powf(10000.f, -(float)(2 * i) / 64.f); const float a = (float)p * inv; cs[e] = cosf(a); sn[e] = sinf(a); } }
    }
}
__device__ __forceinline__ void normmod_row(const float* xr, const float* g, const float* modr, int sh_off, int sc_off, unsigned char* orow, int lane) {
    f32x4 v[4]; float ss = 0.f;
#pragma unroll
    for (int i = 0; i < 4; ++i) { v[i] = *(const f32x4*)(xr + (i * 64 + lane) * 4); ss += (v[i][0] * v[i][0] + v[i][1] * v[i][1]) + (v[i][2] * v[i][2] + v[i][3] * v[i][3]); }
    const float r = rsqrtf(wave_sum(ss) * (1.f / D) + EPS);
#pragma unroll
    for (int i = 0; i < 4; ++i) { const int k = (i * 64 + lane) * 4; const f32x4 gg = *(const f32x4*)(g + k), s1 = *(const f32x4*)(modr + sc_off + k), h1 = *(const f32x4*)(modr + sh_off + k);
        float y[4];
#pragma unroll
        for (int j = 0; j < 4; ++j) y[j] = v[i][j] * r * gg[j] * (1.f + s1[j]) + h1[j];
        *(unsigned*)(orow + k) = (unsigned)att::pk4_fp8(y[0] * 16.f, y[1] * 16.f, y[2] * 16.f, y[3] * 16.f); }
}
__device__ __forceinline__ void phase_hx(const Args& A) {
    const int lane = threadIdx.x & 63, gw = blockIdx.x * NWAVES + (threadIdx.x >> 6), NGW = gridDim.x * NWAVES;
    const float* mod = (const float*)(A.ws + WS_MOD);
    for (int m = gw; m < M + MC; m += NGW) {
        if (m < M) normmod_row(A.x + (size_t)m * D, A.n1g, mod + (m >> 12) * NMOD, 0, D, A.ws + WS_HX + (size_t)m * D, lane);
        else { const int r = m - M; normmod_row(A.ctx + (size_t)r * D, A.n1g, mod + 8 * NMOD, 0, D, A.ws + WS_HC + (size_t)r * D, lane); }
    }
    const bf16_t* WP = (const bf16_t*)(A.ws + WS_WP); float* sb = (float*)(A.ws + WS_SBIAS);
    for (int col = gw; col < PW; col += NGW) {
        const u32x4 w0 = *(const u32x4*)(WP + (size_t)col * D + lane * 16), w1 = *(const u32x4*)(WP + (size_t)col * D + lane * 16 + 8);
        float wv[16];
#pragma unroll
        for (int j = 0; j < 4; ++j) { wv[2 * j] = bf_lo(w0[j]); wv[2 * j + 1] = bf_hi(w0[j]); wv[8 + 2 * j] = bf_lo(w1[j]); wv[8 + 2 * j + 1] = bf_hi(w1[j]); }
#pragma unroll 1
        for (int b = 0; b < NB; ++b) { const float* sh = mod + b * NMOD + 3 * D + lane * 16; float s = 0.f;
#pragma unroll
            for (int q = 0; q < 4; ++q) { const f32x4 v = *(const f32x4*)(sh + 4 * q); s += v[0] * wv[4 * q] + v[1] * wv[4 * q + 1] + v[2] * wv[4 * q + 2] + v[3] * wv[4 * q + 3]; }
            s = wave_sum(s); if (lane == 0) sb[b * PW + col] = s; }
    }
}
__device__ __forceinline__ void phase_kfix(const Args& A) {
    const int lane = threadIdx.x & 63, gw = blockIdx.x * NWAVES + (threadIdx.x >> 6), NGW = gridDim.x * NWAVES, li = lane & 15, sub = lane >> 4;
    const bf16_t* KB = (const bf16_t*)(A.ws + WS_KB); const float* cs = (const float*)(A.ws + WS_ROPE); const float* sn = cs + 2048;
    constexpr int NITEM = NB * SKV * HKV;
    const f32x4 g0 = *(const f32x4*)(A.kng + li * 8), g1 = *(const f32x4*)(A.kng + li * 8 + 4);
    const f32x4 p0 = *(const f32x4*)(A.kng + (li ^ 4) * 8), p1 = *(const f32x4*)(A.kng + (li ^ 4) * 8 + 4);
    for (int it = gw * 4 + sub; it < NITEM; it += NGW * 4) {
        const int row = it >> 1, h = it & 1, t = row % SKV;
        const bf16_t* p = KB + (size_t)row * 256 + h * HD + li * 8;
        const u32x4 w = *(const u32x4*)p;
        float x[8], xp[8]; float ss = 0.f;
#pragma unroll
        for (int j = 0; j < 4; ++j) { x[2 * j] = bf_lo(w[j]); x[2 * j + 1] = bf_hi(w[j]); ss += x[2 * j] * x[2 * j] + x[2 * j + 1] * x[2 * j + 1];
            const unsigned pw = (unsigned)__shfl_xor((int)w[j], 4); xp[2 * j] = bf_lo(pw); xp[2 * j + 1] = bf_hi(pw); }
        ss += __shfl_xor(ss, 1); ss += __shfl_xor(ss, 2); ss += __shfl_xor(ss, 4); ss += __shfl_xor(ss, 8);
        const float r = rsqrtf(ss * (1.f / HD) + EPS);
        float y[8];
#pragma unroll
        for (int j = 0; j < 8; ++j) { x[j] *= r * (j < 4 ? g0[j] : g1[j - 4]); xp[j] *= r * (j < 4 ? p0[j] : p1[j - 4]); y[j] = x[j]; }
        if (t < S) {
            const int blk = li >> 3, pos = blk == 0 ? (t >> 6) : (t & 63), second = (li >> 2) & 1, i0 = (li & 3) * 8;
            const f32x4 c0 = *(const f32x4*)(cs + pos * 32 + i0), c1 = *(const f32x4*)(cs + pos * 32 + i0 + 4), s0 = *(const f32x4*)(sn + pos * 32 + i0), s1 = *(const f32x4*)(sn + pos * 32 + i0 + 4);
#pragma unroll
            for (int j = 0; j < 8; ++j) { const float c = j < 4 ? c0[j] : c1[j - 4], s = j < 4 ? s0[j] : s1[j - 4];
                y[j] = second ? (xp[j] * s + x[j] * c) : (x[j] * c - xp[j] * s); }
        }
        u32x2 o = {(unsigned)att::pk4_fp8(y[0] * 16.f, y[1] * 16.f, y[2] * 16.f, y[3] * 16.f), (unsigned)att::pk4_fp8(y[4] * 16.f, y[5] * 16.f, y[6] * 16.f, y[7] * 16.f)};
        *(u32x2*)(A.ws + WS_K8 + (size_t)row * 256 + h * HD + li * 8) = o;
    }
}
__device__ __forceinline__ void phase_vt(const Args& A, LAS unsigned char* lds) {
    const int lane = threadIdx.x & 63, wave = threadIdx.x >> 6, gw = blockIdx.x * NWAVES + wave, NGW = gridDim.x * NWAVES;
    LAS unsigned char* tl = lds + wave * 4096;
    const bf16_t* VB = (const bf16_t*)(A.ws + WS_VB);
    const int kk = lane & 31, pos = 32 * ((kk >> 2) & 1) + (kk & 3) + 4 * (kk >> 3) + 16 * (lane >> 5);
    constexpr int NTILE = SKV / 64;
    for (int it2 = gw; it2 < NB * HKV * NTILE * 2; it2 += NGW) {
        const int dh = it2 & 1, it = it2 >> 1, j = it % NTILE, bk = it / NTILE, b = bk >> 1, kv = bk & 1;
        const bf16_t* src = VB + ((size_t)b * SKV + j * 64 + lane) * 256 + kv * HD + dh * 64;
        u32x4 w[8];
#pragma unroll
        for (int c = 0; c < 8; ++c) w[c] = *(const u32x4*)(src + c * 8);
#pragma unroll
        for (int c = 0; c < 8; ++c)
#pragma unroll
            for (int q = 0; q < 4; ++q) { const int pk = __builtin_amdgcn_cvt_pk_fp8_f32(bf_lo(w[c][q]) * 16.f, bf_hi(w[c][q]) * 16.f, 0, false);
                tl[(c * 8 + 2 * q) * 64 + pos] = (unsigned char)(pk & 0xff); tl[(c * 8 + 2 * q + 1) * 64 + pos] = (unsigned char)((pk >> 8) & 0xff); }
        asm volatile("s_waitcnt lgkmcnt(0)" ::: "memory");
        unsigned char* dst = A.ws + WS_VT8 + (size_t)it * 8192 + dh * 4096;
#pragma unroll
        for (int i = 0; i < 4; ++i) *(u32x4*)(dst + (i * 64 + lane) * 16) = *(const LAS u32x4*)(tl + (i * 64 + lane) * 16);
        asm volatile("s_waitcnt lgkmcnt(0)" ::: "memory");
    }
}
template <int R> struct ConvRow {
    static __device__ __forceinline__ void run(const unsigned* gp, int tl0, float (&acc)[32][2], const float (&w)[31][2]) {
        const int tl = tl0 + R - 15;
        unsigned v = 0u; if (tl >= 0 && tl < S) v = gp[(long)(R - 15) * (D / 2)];
        const float a = bf_lo(v), b = bf_hi(v);
#pragma unroll
        for (int t = (R - 30 > 0 ? R - 30 : 0); t <= (R < 31 ? R : 31); ++t) { acc[t][0] += w[R - t][0] * a; acc[t][1] += w[R - t][1] * b; }
        if constexpr (R + 1 < 62) ConvRow<R + 1>::run(gp, tl0, acc, w);
    }
};
__device__ __forceinline__ void phase_conv(const Args& A, LAS unsigned char* lds) {
    const int tid = threadIdx.x, lane = tid & 63, wave = tid >> 6;
    LAS float* tile = (LAS float*)lds;
    const bf16_t* G = (const bf16_t*)(A.ws + WS_G); unsigned char* CV = A.ws + WS_HX;
    float w[31][2];
#pragma unroll
    for (int j = 0; j < 31; ++j) { const f32x2 t = *(const f32x2*)(A.cdw + j * D + 2 * tid); w[j][0] = t[0]; w[j][1] = t[1]; }
    const f32x2 bias = *(const f32x2*)(A.cb + 2 * tid);
    for (int tileid = blockIdx.x; tileid < M / 32; tileid += gridDim.x) {
        const int row0 = tileid * 32, tl0 = row0 & (S - 1);
        float acc[32][2];
#pragma unroll
        for (int t = 0; t < 32; ++t) { acc[t][0] = bias[0]; acc[t][1] = bias[1]; }
        ConvRow<0>::run((const unsigned*)(G + (size_t)row0 * D) + tid, tl0, acc, w);
        __syncthreads();
#pragma unroll
        for (int t = 0; t < 32; ++t) *(LAS f32x2*)(tile + t * D + 2 * tid) = (f32x2){acc[t][0], acc[t][1]};
        __syncthreads();
#pragma unroll
        for (int q = 0; q < 4; ++q) { const int t = wave * 4 + q; const LAS float* tr = tile + t * D;
            f32x4 v[4]; float s = 0.f;
#pragma unroll
            for (int i = 0; i < 4; ++i) { v[i] = *(const LAS f32x4*)(tr + (i * 64 + lane) * 4); s += (v[i][0] + v[i][1]) + (v[i][2] + v[i][3]); }
            const float mu = wave_sum(s) * (1.f / D); float qq = 0.f;
#pragma unroll
            for (int i = 0; i < 4; ++i) { v[i] = v[i] - mu; qq += (v[i][0] * v[i][0] + v[i][1] * v[i][1]) + (v[i][2] * v[i][2] + v[i][3] * v[i][3]); }
            const float rs = rsqrtf(wave_sum(qq) * (1.f / D) + EPS);
#pragma unroll
            for (int i = 0; i < 4; ++i) { const int k = (i * 64 + lane) * 4; const f32x4 gg = *(const f32x4*)(A.clg + k), bb = *(const f32x4*)(A.clb + k); float y[4];
#pragma unroll
                for (int j = 0; j < 4; ++j) { const float z = v[i][j] * rs * gg[j] + bb[j]; y[j] = z * fast_sigmoid(z); }
                *(unsigned*)(CV + (size_t)(row0 + t) * D + k) = (unsigned)att::pk4_fp8(y[0] * 16.f, y[1] * 16.f, y[2] * 16.f, y[3] * 16.f); }
        }
    }
}
typedef float f32x32v __attribute__((ext_vector_type(32)));
typedef _Float16 f16x32v __attribute__((ext_vector_type(32)));
typedef _Float16 f16x2v __attribute__((ext_vector_type(2)));
__device__ __forceinline__ unsigned pk_f16(float a, float b) { const f16x2v h = {(_Float16)a, (_Float16)b}; return __builtin_bit_cast(unsigned, h); }
struct EpiInProj {
    static constexpr bool PERM = true;
    unsigned char* ws;
    __device__ __forceinline__ void operator()(f32x4 (&acc)[2][2][4][2], const pg8::Unit& u, int wr, int wc, int fr, int fq) const {
        const int c8 = wc * 32 + 8 * fq;
#pragma unroll
        for (int ai = 0; ai < 2; ++ai)
#pragma unroll
            for (int m = 0; m < 4; ++m) {
                const int row = u.pm * 256 + ai * 128 + wr * 64 + m * 16 + fr;
                if (u.kind == 0) {
                    bf16_t* p = (bf16_t*)(ws + WS_Q) + (size_t)row * D + u.pn * 256 + c8;
#pragma unroll
                    for (int bj = 0; bj < 2; ++bj) { const f32x4 v0 = acc[ai][bj][m][0], v1 = acc[ai][bj][m][1];
                        u32x4 w = {cvt_pk_bf16(v0[0], v0[1]), cvt_pk_bf16(v0[2], v0[3]), cvt_pk_bf16(v1[0], v1[1]), cvt_pk_bf16(v1[2], v1[3])}; *(u32x4*)(p + bj * 128) = w; }
                } else if (u.kind == 1 || u.kind == 2 || u.kind == 5 || u.kind == 6) {
                    const bool ctxu = u.kind >= 5;
                    const int kvrow = ctxu ? (row >> 8) * SKV + S + (row & 255) : (row >> 12) * SKV + (row & (S - 1));
                    bf16_t* p = (bf16_t*)(ws + ((u.kind == 1 || u.kind == 5) ? WS_KB : WS_VB)) + (size_t)kvrow * 256 + c8;
#pragma unroll
                    for (int bj = 0; bj < 2; ++bj) { const f32x4 v0 = acc[ai][bj][m][0], v1 = acc[ai][bj][m][1];
                        u32x4 w = {cvt_pk_bf16(v0[0], v0[1]), cvt_pk_bf16(v0[2], v0[3]), cvt_pk_bf16(v1[0], v1[1]), cvt_pk_bf16(v1[2], v1[3])}; *(u32x4*)(p + bj * 128) = w; }
                } else if (u.kind == 3) {
                    float g[8];
#pragma unroll
                    for (int n = 0; n < 2; ++n)
#pragma unroll
                        for (int j = 0; j < 4; ++j) g[4 * n + j] = acc[ai][0][m][n][j] * fast_sigmoid(acc[ai][1][m][n][j]);
                    u32x4 w = {cvt_pk_bf16(g[0], g[1]), cvt_pk_bf16(g[2], g[3]), cvt_pk_bf16(g[4], g[5]), cvt_pk_bf16(g[6], g[7])};
                    *(u32x4*)((bf16_t*)(ws + WS_G) + (size_t)row * D + (u.pn - 6) * 128 + c8) = w;
                } else {
                    float rt[8], sg[8];
#pragma unroll
                    for (int n = 0; n < 2; ++n)
#pragma unroll
                        for (int j = 0; j < 4; ++j) { const float ea = __builtin_amdgcn_exp2f(-1.4426950408889634f * acc[ai][0][m][n][j]), ec = __builtin_amdgcn_exp2f(-1.4426950408889634f * acc[ai][1][m][n][j]);
                            sg[4 * n + j] = __builtin_amdgcn_rcpf(1.f + ec); rt[4 * n + j] = (1.f + ec) * __builtin_amdgcn_rcpf(1.f + ea); }
                    const size_t off = (size_t)row * D + (u.pn - 14) * 128 + c8;
                    u32x4 w = {cvt_pk_bf16(rt[0], rt[1]), cvt_pk_bf16(rt[2], rt[3]), cvt_pk_bf16(rt[4], rt[5]), cvt_pk_bf16(rt[6], rt[7])}; *(u32x4*)((bf16_t*)(ws + WS_RT) + off) = w;
                    u32x4 w2 = {cvt_pk_bf16(sg[0], sg[1]), cvt_pk_bf16(sg[2], sg[3]), cvt_pk_bf16(sg[4], sg[5]), cvt_pk_bf16(sg[6], sg[7])}; *(u32x4*)((bf16_t*)(ws + WS_SGC) + off) = w2;
                }
            }
    }
};
struct SchedInProj {
    const char* hx; const char* hc; const char* w; int G, c;
    __device__ __forceinline__ bool next(int i, pg8::Unit& u) const {
        constexpr int nM = M / 256, nN = INW / 256, NMAIN = nM * nN, NCTX = (MC / 256) * 2;
        const int L = i * G + c; if (L >= NMAIN + NCTX) return false;
        if (L < NMAIN) { pg8::tile_of(L, nM, nN, u.pm, u.pn); u.a = hx + (size_t)u.pm * 256 * D; u.kind = u.pn < 4 ? 0 : (u.pn == 4 ? 1 : (u.pn == 5 ? 2 : (u.pn < 14 ? 3 : 4))); }
        else { const int j = L - NMAIN; u.pm = j >> 1; u.pn = 4 + (j & 1); u.a = hc + (size_t)u.pm * 256 * D; u.kind = 5 + (j & 1); }
        u.b = w + (size_t)u.pn * 256 * D; u.keep = 0; return true;
    }
};
struct EpiMerge {
    static constexpr bool PERM = true;
    unsigned char* ws;
    __device__ __forceinline__ void operator()(f32x4 (&acc)[2][2][4][2], const pg8::Unit& u, int wr, int wc, int fr, int fq) const {
        const int c8 = u.pn * 256 + wc * 32 + 8 * fq;
        const bf16_t* __restrict__ F = (const bf16_t*)(ws + (u.kind == 0 ? WS_RT : WS_SGC));
#pragma unroll
        for (int ai = 0; ai < 2; ++ai)
#pragma unroll
            for (int m = 0; m < 4; ++m) { const size_t off = (size_t)(u.pm * 256 + ai * 128 + wr * 64 + m * 16 + fr) * D + c8;
#pragma unroll
                for (int bj = 0; bj < 2; ++bj) { const u32x4 f = *(const u32x4*)(F + off + bj * 128);
                    f32x4 v0 = acc[ai][bj][m][0], v1 = acc[ai][bj][m][1];
                    v0[0] *= bf_lo(f[0]); v0[1] *= bf_hi(f[0]); v0[2] *= bf_lo(f[1]); v0[3] *= bf_hi(f[1]); v1[0] *= bf_lo(f[2]); v1[1] *= bf_hi(f[2]); v1[2] *= bf_lo(f[3]); v1[3] *= bf_hi(f[3]);
                    if (u.kind == 0) { acc[ai][bj][m][0] = v0; acc[ai][bj][m][1] = v1; }
                    else { u32x2 w = {(unsigned)att::pk4_fp8(v0[0] * 16.f, v0[1] * 16.f, v0[2] * 16.f, v0[3] * 16.f), (unsigned)att::pk4_fp8(v1[0] * 16.f, v1[1] * 16.f, v1[2] * 16.f, v1[3] * 16.f)}; *(u32x2*)(ws + WS_G + off + bj * 128) = w; } } }
    }
};
struct SchedMerge {
    const char* att; const char* cv; const char* wa; const char* wc; int G, c;
    __device__ __forceinline__ bool next(int i, pg8::Unit& u) const {
        constexpr int nM = M / 256, nN = D / 256;
        const int L = (i >> 1) * G + c, sub = i & 1; if (L >= nM * nN) return false;
        pg8::tile_of(L, nM, nN, u.pm, u.pn);
        u.a = (sub ? cv : att) + (size_t)u.pm * 256 * D; u.b = (sub ? wc : wa) + (size_t)u.pn * 256 * D; u.kind = sub; u.keep = sub ^ 1; return true;
    }
};
struct SchedPlain {
    const char* a; const char* b; int nM, nN, G, c, rowb;
    __device__ __forceinline__ bool next(int i, pg8::Unit& u) const {
        const int L = i * G + c; if (L >= nM * nN) return false;
        pg8::tile_of(L, nM, nN, u.pm, u.pn); u.a = a + (size_t)u.pm * 256 * rowb; u.b = b + (size_t)u.pn * 256 * rowb; u.kind = 0; u.keep = 0; return true;
    }
};
struct EpiOut {
    static constexpr bool PERM = true;
    const float* __restrict__ x; const float* __restrict__ mod; const float* __restrict__ n2g; bf16_t* __restrict__ xs; bf16_t* __restrict__ xg; float* __restrict__ ssq;
    __device__ __forceinline__ void operator()(f32x4 (&acc)[2][2][4][2], const pg8::Unit& u, int wr, int wc, int fr, int fq) const {
        const int col0 = u.pn * 256 + wc * 32 + 8 * fq; const float* mb = mod + ((u.pm * 256) >> 12) * NMOD;
        f32x4 gv[2][2], nv[2][2];
#pragma unroll
        for (int bj = 0; bj < 2; ++bj)
#pragma unroll
            for (int n = 0; n < 2; ++n) { const int c = col0 + bj * 128 + n * 4; gv[bj][n] = *(const f32x4*)(mb + 2 * D + c); nv[bj][n] = *(const f32x4*)(n2g + c) * (*(const f32x4*)(mb + 4 * D + c) + 1.f); }
        f32x4 xa[2][2], xb[2][2];
#define XLOAD(dst, k) do { _Pragma("unroll") for (int bj = 0; bj < 2; ++bj) _Pragma("unroll") for (int n = 0; n < 2; ++n) \
            dst[bj][n] = *(const f32x4*)(x + (size_t)(u.pm * 256 + ((k) >> 2) * 128 + wr * 64 + ((k) & 3) * 16 + fr) * D + col0 + bj * 128 + n * 4); } while (0)
#define XDONE(src, k) do { const int ai = (k) >> 2, m = (k) & 3; const int row = u.pm * 256 + ai * 128 + wr * 64 + m * 16 + fr; const size_t off = (size_t)row * D + col0; float ss = 0.f; \
            _Pragma("unroll") for (int bj = 0; bj < 2; ++bj) { const f32x4 v0 = src[bj][0] + gv[bj][0] * acc[ai][bj][m][0], v1 = src[bj][1] + gv[bj][1] * acc[ai][bj][m][1]; \
                ss += ((v0[0] * v0[0] + v0[1] * v0[1]) + (v0[2] * v0[2] + v0[3] * v0[3])) + ((v1[0] * v1[0] + v1[1] * v1[1]) + (v1[2] * v1[2] + v1[3] * v1[3])); \
                u32x4 w = {cvt_pk_bf16(v0[0], v0[1]), cvt_pk_bf16(v0[2], v0[3]), cvt_pk_bf16(v1[0], v1[1]), cvt_pk_bf16(v1[2], v1[3])}; *(u32x4*)(xs + off + bj * 128) = w; \
                const f32x4 g0 = v0 * nv[bj][0], g1 = v1 * nv[bj][1]; \
                u32x4 w2 = {cvt_pk_bf16(g0[0], g0[1]), cvt_pk_bf16(g0[2], g0[3]), cvt_pk_bf16(g1[0], g1[1]), cvt_pk_bf16(g1[2], g1[3])}; *(u32x4*)(xg + off + bj * 128) = w2; } \
            ss += __shfl_xor(ss, 16); ss += __shfl_xor(ss, 32); if (fq == 0) ssq[(size_t)row * 16 + u.pn * 4 + wc] = ss; } while (0)
        XLOAD(xa, 0); XLOAD(xb, 1); XDONE(xa, 0); XLOAD(xa, 2); XDONE(xb, 1); XLOAD(xb, 3); XDONE(xa, 2); XLOAD(xa, 4); XDONE(xb, 3); XLOAD(xb, 5); XDONE(xa, 4); XLOAD(xa, 6); XDONE(xb, 5); XLOAD(xb, 7); XDONE(xa, 6); XDONE(xb, 7);
#undef XLOAD
#undef XDONE
    }
};
__device__ __forceinline__ float row_rstd(const float* ssq, int row) {
    const f32x4 a = *(const f32x4*)(ssq + (size_t)row * 16), b = *(const f32x4*)(ssq + (size_t)row * 16 + 4), c = *(const f32x4*)(ssq + (size_t)row * 16 + 8), d = *(const f32x4*)(ssq + (size_t)row * 16 + 12);
    const float s = ((a[0] + a[1]) + (a[2] + a[3])) + ((b[0] + b[1]) + (b[2] + b[3])) + ((c[0] + c[1]) + (c[2] + c[3])) + ((d[0] + d[1]) + (d[2] + d[3]));
    return rsqrtf(s * (1.f / D) + EPS);
}
struct EpiScores {
    static constexpr bool PERM = true;
    unsigned short* sc; const float* ssq; const float* sbias;
    __device__ __forceinline__ void operator()(f32x4 (&acc)[2][2][4][2], const pg8::Unit& u, int wr, int wc, int fr, int fq) const {
        const float* sb = sbias + ((u.pm * 256) >> 12) * PW + u.pn * 256 + wc * 32 + 8 * fq;
        f32x4 bv[2][2];
#pragma unroll
        for (int bj = 0; bj < 2; ++bj)
#pragma unroll
            for (int n = 0; n < 2; ++n) bv[bj][n] = *(const f32x4*)(sb + bj * 128 + n * 4);
#pragma unroll
        for (int ai = 0; ai < 2; ++ai)
#pragma unroll
            for (int m = 0; m < 4; ++m) { const int row = u.pm * 256 + ai * 128 + wr * 64 + m * 16 + fr; unsigned short* p = sc + (size_t)(row >> 2) * 8192 + (row & 3) * 8; const float rs = row_rstd(ssq, row);
#pragma unroll
                for (int bj = 0; bj < 2; ++bj) { const int grp = u.pn * 2 + bj, nq = wc * 4 + fq; const f32x4 v0 = acc[ai][bj][m][0] * rs + bv[bj][0], v1 = acc[ai][bj][m][1] * rs + bv[bj][1];
                    u32x4 w = {pk_f16(v0[0], v0[1]), pk_f16(v0[2], v0[3]), pk_f16(v1[0], v1[1]), pk_f16(v1[2], v1[3])}; *(u32x4*)(p + (grp * 16 + nq) * 32) = w; } }
    }
};

#ifndef PROBE_HALFKEYS
#define PROBE_HALFKEYS 0
#endif
__device__ __forceinline__ void phase_attn(const Args& A, unsigned char* lds) {
    const int G = gridDim.x, X = blockIdx.x & 7, j = blockIdx.x >> 3, perx = G >> 3;
    bf16_t* Q = (bf16_t*)(A.ws + WS_Q); const unsigned char* K8 = A.ws + WS_K8; const unsigned char* VT8 = A.ws + WS_VT8;
    const float* cs = (const float*)(A.ws + WS_ROPE); const float* sn = cs + 2048;
    for (int idx = j; idx < 128; idx += perx) {
        const int grp = 2 * X + (idx >> 6), uu = idx & 63, b = grp >> 1, kv = grp & 1, h = kv * 4 + (uu >> 4), qb = uu & 15;
        bf16_t* qp = Q + ((size_t)b * S + qb * 256) * D + h * HD;
        unsigned char* op = A.ws + WS_ATT8 + ((size_t)b * S + qb * 256) * D + h * HD;
        att::attn_unit(qp, K8 + (size_t)b * SKV * 256 + kv * HD, VT8 + (size_t)grp * (SKV / 64) * 8192, op, qb * 256, (A.dry && PROBE_HALFKEYS) ? SKV / 2 : SKV, A.qng, cs, sn, (char*)lds);
    }
}

__device__ __forceinline__ float gelu_exact(float v) {
    const float av = fabsf(v), t = __builtin_amdgcn_rcpf(av * 0.2316418882f + 1.0f);
    float q = t * 0.5307027145f + (-0.7265760135f); q = q * t + 0.7107068705f; q = q * t + (-0.142248368f); q = q * t + 0.127414796f; q = q * t;
    const float e = __builtin_amdgcn_exp2f((v * v) * (-0.72134752044f));
    const float m = v * (q * e);
    return v < 0.f ? m : v - m;
}
__device__ __forceinline__ void ins16(float (&t)[16], float v) {
#pragma unroll
    for (int i = 15; i >= 1; --i) t[i] = __builtin_amdgcn_fmed3f(t[i - 1], t[i], v);
    t[0] = fmaxf(t[0], v);
}

__device__ __forceinline__ float key_tag(float v, unsigned keepmask, unsigned tag) { return __uint_as_float((__float_as_uint(v) & keepmask) | tag); }
template <int I, int J> struct CandLoop {
    static __device__ __forceinline__ void run(const float (&a)[16], const float (&b)[16], float (&c)[16]) {
        if constexpr ((I + 1) * (J + 1) <= 16) { ins16(c, key_tag(a[I] + b[J], ~255u, 255u - (unsigned)(I * 16 + J))); CandLoop<I, J + 1>::run(a, b, c); }
        else if constexpr (I + 1 < 16) CandLoop<I + 1, 0>::run(a, b, c);
    }
};
__device__ __forceinline__ void phase_peer_u(const Args& A, LAS unsigned char* lds) {
    const int lane = threadIdx.x & 63, wave = threadIdx.x >> 6, gw = blockIdx.x * NWAVES + wave, NGW = gridDim.x * NWAVES;
    LAS unsigned char* wl = lds + wave * 10240;
    LAS float* topL = (LAS float*)wl; LAS int* eidA = (LAS int*)(wl + 4096); LAS float* wgtA = (LAS float*)(wl + 6144); LAS float* coefL = (LAS float*)(wl + 8192);
    LAS float* suL = (LAS float*)(wl + 8704); LAS float* svL = (LAS float*)(wl + 9216);
    const unsigned short* SC = (const unsigned short*)(A.ws + WS_SC); const bf16_t* HX = (const bf16_t*)(A.ws + WS_HX);
    const unsigned char* UT = A.ws + WS_UT; const float* SU = (const float*)(A.ws + WS_UT + WS_TSCALE); const float* SVs = (const float*)(A.ws + WS_VT + WS_TSCALE);
    const float* mod = (const float*)(A.ws + WS_MOD);
    int* PE = (int*)(A.ws + WS_PE); float* PC = (float*)(A.ws + WS_PC);
    const float NEG = -3.0e38f;
    const int h = lane >> 3, tk = (lane >> 1) & 3, p = lane & 1, grp = 2 * h + p;
    for (int pass = gw; pass < M / 4; pass += NGW) {
        {
            float t[16];
#pragma unroll
            for (int i = 0; i < 16; ++i) t[i] = NEG;
            const unsigned short* sp = SC + (size_t)pass * 8192 + (grp * 64 + tk) * 8;
            u32x4 sv[16];
#pragma unroll
            for (int i = 0; i < 16; ++i) sv[i] = *(const u32x4*)(sp + i * 32);
#pragma unroll
            for (int i = 0; i < 16; ++i)
#pragma unroll
                for (int q = 0; q < 4; ++q) { const unsigned w = sv[i][q]; const f16x2v hv = __builtin_bit_cast(f16x2v, w); const unsigned tg = 127u - (unsigned)(8 * i + 2 * q);
                    ins16(t, __uint_as_float(__float_as_uint((float)hv[0]) | tg)); ins16(t, __uint_as_float(__float_as_uint((float)hv[1]) | (tg - 1u))); }
            float pb[16];
#pragma unroll
            for (int i = 0; i < 16; ++i) { pb[i] = __shfl_xor(t[i], 1); topL[i * 64 + lane] = t[i]; }
            float c[16];
#pragma unroll
            for (int i = 0; i < 16; ++i) c[i] = NEG;
            CandLoop<0, 0>::run(t, pb, c);
            float e[16]; float es = 0.f;
#pragma unroll
            for (int k = 0; k < 16; ++k) { e[k] = __expf(c[k] - c[0]); es += e[k]; }
            const float inv = __builtin_amdgcn_rcpf(es);
            asm volatile("s_waitcnt lgkmcnt(0)" ::: "memory");
            if (p == 0) {
#pragma unroll
                for (int k = 0; k < 16; ++k) { const unsigned code = 255u - (__float_as_uint(c[k]) & 255u);
                    const unsigned ia = 127u - (__float_as_uint(topL[(code >> 4) * 64 + lane]) & 127u), ib = 127u - (__float_as_uint(topL[(code & 15u) * 64 + lane + 1]) & 127u);
                    eidA[tk * 128 + h * 16 + k] = (int)(ia * 128u + ib); wgtA[tk * 128 + h * 16 + k] = e[k] * inv; }
            }
            asm volatile("s_waitcnt lgkmcnt(0)" ::: "memory");
        }
#pragma unroll 1
        for (int tq = 0; tq < 4; ++tq) {
            const int t = pass * 4 + tq; const LAS int* eidL = eidA + tq * 128; const LAS float* wgtL = wgtA + tq * 128;
            const int g = lane & 31, hh = lane >> 5;
            f16x2v xh[16];
            { const float rs = row_rstd((const float*)(A.ws + WS_SSQ), t); const float* sh = mod + (t >> 12) * NMOD + 3 * D + g * 32; const bf16_t* xp = HX + (size_t)t * D + g * 32;
#pragma unroll
              for (int c = 0; c < 4; ++c) { const u32x4 w = *(const u32x4*)(xp + 8 * c); const f32x4 s0 = *(const f32x4*)(sh + 8 * c), s1 = *(const f32x4*)(sh + 8 * c + 4);
                xh[4 * c] = (f16x2v){(_Float16)(bf_lo(w[0]) * rs + s0[0]), (_Float16)(bf_hi(w[0]) * rs + s0[1])}; xh[4 * c + 1] = (f16x2v){(_Float16)(bf_lo(w[1]) * rs + s0[2]), (_Float16)(bf_hi(w[1]) * rs + s0[3])};
                xh[4 * c + 2] = (f16x2v){(_Float16)(bf_lo(w[2]) * rs + s1[0]), (_Float16)(bf_hi(w[2]) * rs + s1[1])}; xh[4 * c + 3] = (f16x2v){(_Float16)(bf_lo(w[3]) * rs + s1[2]), (_Float16)(bf_hi(w[3]) * rs + s1[3])}; } }
            { const int i0 = eidL[lane], i1 = eidL[64 + lane]; suL[lane] = SU[i0]; suL[64 + lane] = SU[i1]; svL[lane] = SVs[i0]; svL[64 + lane] = SVs[i1]; }
            u32x6 rb0[4], rb1[4], rb2[4], rb3[4];
#define LOAD8(buf, TB, hb) do { _Pragma("unroll") for (int r = 0; r < 4; ++r) { const int id = eidL[(hb) * 8 + 2 * r + hh]; const unsigned char* rp = (TB) + (size_t)id * ROWB; \
                const u32x4 lo = *(const u32x4*)(rp + g * 16); const u32x2 hi2 = *(const u32x2*)(rp + 512 + g * 8); buf[r] = (u32x6){lo[0], lo[1], lo[2], lo[3], hi2[0], hi2[1]}; } } while (0)
#define DOT8(buf, off) do { _Pragma("unroll") for (int r = 0; r < 4; ++r) { const f16x32v dq = __builtin_amdgcn_cvt_scalef32_pk32_f16_fp6(buf[r], 1.0f); \
                float sa = 0.f, sb = 0.f, sc = 0.f, sd = 0.f;     \
                _Pragma("unroll") for (int j = 0; j < 16; j += 4) { sa = __builtin_amdgcn_fdot2((f16x2v){dq[2 * j], dq[2 * j + 1]}, xh[j], sa, false); sb = __builtin_amdgcn_fdot2((f16x2v){dq[2 * j + 2], dq[2 * j + 3]}, xh[j + 1], sb, false); \
                    sc = __builtin_amdgcn_fdot2((f16x2v){dq[2 * j + 4], dq[2 * j + 5]}, xh[j + 2], sc, false); sd = __builtin_amdgcn_fdot2((f16x2v){dq[2 * j + 6], dq[2 * j + 7]}, xh[j + 3], sd, false); } \
                pp[(off) + r] = (sa + sb) + (sc + sd); } } while (0)
#define REDUCE16(kb) do { \
            _Pragma("unroll") for (int e = 0; e < 4; ++e) { const bool up = lane & 16; const float keep = up ? pp[e + 4] : pp[e], send = up ? pp[e] : pp[e + 4]; pp[e] = keep + __shfl_xor(send, 16); } \
            _Pragma("unroll") for (int e = 0; e < 2; ++e) { const bool up = lane & 8; const float keep = up ? pp[e + 2] : pp[e], send = up ? pp[e] : pp[e + 2]; pp[e] = keep + __shfl_xor(send, 8); } \
            { const bool up = lane & 4; const float keep = up ? pp[1] : pp[0], send = up ? pp[0] : pp[1]; pp[0] = keep + __shfl_xor(send, 4); } \
            float hsum = pp[0]; hsum += __shfl_xor(hsum, 2); hsum += __shfl_xor(hsum, 1); \
            const int ke = (kb) * 16 + 2 * ((lane >> 2) & 7) + hh; const float su = suL[ke], sv = svL[ke]; \
            const float cf = wgtL[ke] * gelu_exact(hsum * su) * sv; if ((lane & 3) == 0) coefL[ke] = cf; } while (0)
            float pp[8];
            LOAD8(rb0, UT, 0); LOAD8(rb1, UT, 1); LOAD8(rb2, UT, 2);
            LOAD8(rb3, UT, 3); DOT8(rb0, 0);
            LOAD8(rb0, UT, 4); DOT8(rb1, 4); REDUCE16(0);
            LOAD8(rb1, UT, 5); DOT8(rb2, 0);
            LOAD8(rb2, UT, 6); DOT8(rb3, 4); REDUCE16(1);
            LOAD8(rb3, UT, 7); DOT8(rb0, 0);
            LOAD8(rb0, UT, 8); DOT8(rb1, 4); REDUCE16(2);
            LOAD8(rb1, UT, 9); DOT8(rb2, 0);
            LOAD8(rb2, UT, 10); DOT8(rb3, 4); REDUCE16(3);
            LOAD8(rb3, UT, 11); DOT8(rb0, 0);
            LOAD8(rb0, UT, 12); DOT8(rb1, 4); REDUCE16(4);
            LOAD8(rb1, UT, 13); DOT8(rb2, 0);
            LOAD8(rb2, UT, 14); DOT8(rb3, 4); REDUCE16(5);
            LOAD8(rb3, UT, 15); DOT8(rb0, 0);
            DOT8(rb1, 4); REDUCE16(6);
            DOT8(rb2, 0);
            DOT8(rb3, 4); REDUCE16(7);
#undef LOAD8
#undef DOT8
#undef REDUCE16
            asm volatile("s_waitcnt lgkmcnt(0)" ::: "memory");
            PE[(size_t)t * 128 + lane] = eidL[lane]; PE[(size_t)t * 128 + 64 + lane] = eidL[64 + lane];
            PC[(size_t)t * 128 + lane] = coefL[lane]; PC[(size_t)t * 128 + 64 + lane] = coefL[64 + lane];
        }
    }
}
__device__ __forceinline__ void phase_peer_v(const Args& A, LAS unsigned char* lds) {
    const int lane = threadIdx.x & 63, wave = threadIdx.x >> 6, gw = blockIdx.x * NWAVES + wave, NGW = gridDim.x * NWAVES;
    LAS int* eidL = (LAS int*)(lds + wave * 1024); LAS float* coefL = (LAS float*)(lds + wave * 1024 + 512);
    const unsigned char* VT = A.ws + WS_VT; const float* mod = (const float*)(A.ws + WS_MOD);
    const int* PE = (const int*)(A.ws + WS_PE); const float* PC = (const float*)(A.ws + WS_PC);
    const int g = lane & 31, hh = lane >> 5;
    int pe0 = 0, pe1 = 0; float pc0 = 0.f, pc1 = 0.f;
    if (gw < M) { pe0 = PE[(size_t)gw * 128 + lane]; pe1 = PE[(size_t)gw * 128 + 64 + lane]; pc0 = PC[(size_t)gw * 128 + lane]; pc1 = PC[(size_t)gw * 128 + 64 + lane]; }
    for (int t = gw; t < M; t += NGW) {
        eidL[lane] = pe0; eidL[64 + lane] = pe1; coefL[lane] = pc0; coefL[64 + lane] = pc1;
        asm volatile("s_waitcnt lgkmcnt(0)" ::: "memory");
        { const int tn = t + NGW < M ? t + NGW : t; pe0 = PE[(size_t)tn * 128 + lane]; pe1 = PE[(size_t)tn * 128 + 64 + lane]; pc0 = PC[(size_t)tn * 128 + lane]; pc1 = PC[(size_t)tn * 128 + 64 + lane]; }
        u32x4 xsw[2];
        { const bf16_t* xrow = (const bf16_t*)(A.ws + WS_XSB) + (size_t)t * D + g * 32 + hh * 16; xsw[0] = *(const u32x4*)xrow; xsw[1] = *(const u32x4*)(xrow + 8); }
        u32x6 rb0[4], rb1[4], rb2[4], rb3[4];
#define LOAD8(buf, hb) do { _Pragma("unroll") for (int r = 0; r < 4; ++r) { const int id = eidL[(hb) * 8 + 2 * r + hh]; const unsigned char* rp = VT + (size_t)id * ROWB; \
            const u32x4 lo = *(const u32x4*)(rp + g * 16); const u32x2 hi2 = *(const u32x2*)(rp + 512 + g * 8); buf[r] = (u32x6){lo[0], lo[1], lo[2], lo[3], hi2[0], hi2[1]}; } } while (0)
#define VACC8(buf, hb) do { _Pragma("unroll") for (int r = 0; r < 4; ++r) { const _Float16 ch = (_Float16)coefL[(hb) * 8 + 2 * r + hh]; const f16x2v cf2 = {ch, ch}; \
            const f16x32v dq = __builtin_amdgcn_cvt_scalef32_pk32_f16_fp6(buf[r], 1.0f); \
            _Pragma("unroll") for (int j = 0; j < 16; ++j) yh[j] = cf2 * (f16x2v){dq[2 * j], dq[2 * j + 1]} + yh[j]; } } while (0)
        f16x2v yh[16];
#pragma unroll
        for (int j = 0; j < 16; ++j) yh[j] = (f16x2v){(_Float16)0.f, (_Float16)0.f};
        LOAD8(rb0, 0); LOAD8(rb1, 1); LOAD8(rb2, 2);
        LOAD8(rb3, 3); VACC8(rb0, 0);
        LOAD8(rb0, 4); VACC8(rb1, 1);
        LOAD8(rb1, 5); VACC8(rb2, 2);
        LOAD8(rb2, 6); VACC8(rb3, 3);
        LOAD8(rb3, 7); VACC8(rb0, 4);
        LOAD8(rb0, 8); VACC8(rb1, 5);
        LOAD8(rb1, 9); VACC8(rb2, 6);
        LOAD8(rb2, 10); VACC8(rb3, 7);
        LOAD8(rb3, 11); VACC8(rb0, 8);
        LOAD8(rb0, 12); VACC8(rb1, 9);
        LOAD8(rb1, 13); VACC8(rb2, 10);
        LOAD8(rb2, 14); VACC8(rb3, 11);
        LOAD8(rb3, 15); VACC8(rb0, 12);
        VACC8(rb1, 13);
        VACC8(rb2, 14);
        VACC8(rb3, 15);
#undef LOAD8
#undef VACC8
        float yy[16];
#pragma unroll
        for (int j = 0; j < 16; ++j) { const float y0 = (float)yh[j][0], y1 = (float)yh[j][1]; const float a = y0 + __shfl_xor(y0, 32), b = y1 + __shfl_xor(y1, 32); if ((j >> 3) == hh) { yy[2 * (j & 7)] = a; yy[2 * (j & 7) + 1] = b; } }
        const float* g2 = mod + (t >> 12) * NMOD + 5 * D; float* orow = A.out + (size_t)t * D;
        float z[16]; float ss = 0.f;
#pragma unroll
        for (int q = 0; q < 4; ++q) { const int k = g * 32 + hh * 16 + q * 4; const unsigned xw0 = xsw[q >> 1][2 * (q & 1)], xw1 = xsw[q >> 1][2 * (q & 1) + 1];
            const f32x4 xv = {bf_lo(xw0), bf_hi(xw0), bf_lo(xw1), bf_hi(xw1)}, gv = *(const f32x4*)(g2 + k);
#pragma unroll
            for (int j = 0; j < 4; ++j) { const float zz = xv[j] + gv[j] * yy[q * 4 + j]; z[q * 4 + j] = zz; ss += zz * zz; } }
        const float r = rsqrtf(wave_sum(ss) * (1.f / D) + EPS);
#pragma unroll
        for (int q = 0; q < 4; ++q) { const int k = g * 32 + hh * 16 + q * 4; const f32x4 fv = *(const f32x4*)(A.fg + k);
            f32x4 o;
#pragma unroll
            for (int j = 0; j < 4; ++j) o[j] = z[q * 4 + j] * r * fv[j];
            if (!A.dry || r < 0.f) *(f32x4*)(orow + k) = o; }
    }
}
#define XB_TMO      128
#define XB_XCNT(j)  (256  + 64 * (j))
#define XB_XSUB(j)  (1280 + 64 * (j))
#define XB_XGEN(j)  (2304 + 64 * (j))
#define XB_TOP      3328
#define XB_TOPGEN   3392
#define XCD_BAR_WORDS 3456
#define XB_SPIN_CAP (1u << 22)
__device__ __forceinline__ unsigned xb_ld(unsigned* p)              { return __hip_atomic_load(p, __ATOMIC_RELAXED, __HIP_MEMORY_SCOPE_AGENT); }
__device__ __forceinline__ unsigned xb_add(unsigned* p, unsigned v) { return __hip_atomic_fetch_add(p, v, __ATOMIC_RELAXED, __HIP_MEMORY_SCOPE_AGENT); }
__device__ __forceinline__ unsigned xb_xcc_id() { return (unsigned)__builtin_amdgcn_s_getreg((3 << 11) | 20) & 0xFu; }
#define XB_SPIN(cond, bar) do { unsigned _sp = 0; while (cond) { __builtin_amdgcn_s_sleep(1); \
    if ((++_sp & 255u) == 0u) { if (xb_ld(&(bar)[XB_TMO])) break; if (_sp > XB_SPIN_CAP) { atomicAdd(&(bar)[XB_TMO], 1u); break; } } } } while (0)
struct XcdBarrier { unsigned* bar; unsigned x; volatile LAS unsigned* st; };
__device__ __forceinline__ XcdBarrier xcd_barrier_post(unsigned* bar, volatile LAS unsigned* st) {
    XcdBarrier b; b.bar = bar; b.x = xb_xcc_id(); b.st = st;
    if (threadIdx.x == 0) (void)xb_add(&bar[XB_XCNT(b.x)], 1u);
    return b;
}
__device__ __forceinline__ void xcd_barrier_complete(unsigned* bar, unsigned x, unsigned& nloc, unsigned& nx) {
    const unsigned G = gridDim.x * gridDim.y * gridDim.z;
    unsigned sum, cnt, mine, sp = 0u;
    for (;;) {
        sum = 0u; cnt = 0u; mine = 0u;
#pragma unroll
        for (unsigned j = 0; j < 16; ++j) { const unsigned c = xb_ld(&bar[XB_XCNT(j)]); sum += c; cnt += (c > 0u) ? 1u : 0u; mine = (j == x) ? c : mine; }
        if (sum == G) break;
        __builtin_amdgcn_s_sleep(1);
        if ((++sp & 255u) == 0u) { if (xb_ld(&bar[XB_TMO])) break; if (sp > XB_SPIN_CAP) { atomicAdd(&bar[XB_TMO], 1u); break; } }
    }
    nloc = mine > 0u ? mine : 1u; nx = cnt > 0u ? cnt : 1u;
}
__device__ __forceinline__ void xcd_barrier(const XcdBarrier& b) {
    asm volatile("s_waitcnt vmcnt(0)" ::: "memory");
    __syncthreads();
    if (threadIdx.x == 0) {
        unsigned* bar = b.bar;
        __builtin_amdgcn_s_waitcnt(0);
        unsigned nloc = b.st[0], nx = b.st[1];
        if (nloc == 0u) { xcd_barrier_complete(bar, b.x, nloc, nx); b.st[0] = nloc; b.st[1] = nx; }
        const unsigned old = xb_add(&bar[XB_XSUB(b.x)], 1u);
        const unsigned gen = old / nloc;
        if (old + 1u == (gen + 1u) * nloc) {
            __builtin_amdgcn_fence(__ATOMIC_RELEASE, "agent");
            asm volatile("s_waitcnt vmcnt(0)" ::: "memory");
            const unsigned og = xb_add(&bar[XB_TOP], 1u);
            const unsigned tg = og / nx;
            if (og + 1u == (tg + 1u) * nx) xb_add(&bar[XB_TOPGEN], 1u);
            else XB_SPIN(xb_ld(&bar[XB_TOPGEN]) == tg, bar);
            __builtin_amdgcn_fence(__ATOMIC_ACQUIRE, "agent");
            xb_add(&bar[XB_XGEN(b.x)], 1u);
            asm volatile("s_waitcnt vmcnt(0)" ::: "memory");
        } else {
            XB_SPIN(xb_ld(&bar[XB_XGEN(b.x)]) == gen, bar);
            __builtin_amdgcn_fence(__ATOMIC_ACQUIRE, "agent");
            asm volatile("s_waitcnt vmcnt(0)" ::: "memory");
        }
    }
    __syncthreads();
}
constexpr int MISC_OFF = 135168;

constexpr int N_PHASES = 10;
__global__ void __launch_bounds__(NWAVES * 64, 2) mega_fwd(Args A) {
    extern __shared__ __attribute__((aligned(16))) unsigned char lds[];
    LAS unsigned char* L = (LAS unsigned char*)lds;
    cg::grid_group grid = cg::this_grid();
    const int lo = A.ph_lo, hi = A.ph_hi, G = gridDim.x, c = blockIdx.x;
#ifndef PH_MASK
#define PH_MASK 0x3FF
#endif
#define IN(k) (((PH_MASK >> (k)) & 1) && lo <= (k) && (k) < hi)
    unsigned* barw = (unsigned*)(A.ws + WS_CTL);
    volatile LAS unsigned* MISC = (volatile LAS unsigned*)(L + MISC_OFF);
    if (threadIdx.x < 2) MISC[threadIdx.x] = 0u;
    if (lo == 0 && hi > 1 && blockIdx.x == 0) for (int i = threadIdx.x; i < XCD_BAR_WORDS; i += NWAVES * 64) barw[i] = 0u;
    XcdBarrier xb; xb.bar = barw; xb.x = 0; xb.st = MISC;
#define SEAM(k) do { if (IN(k) && IN((k) + 1)) { if ((k) == 0) { grid.sync(); xb = xcd_barrier_post(barw, MISC); } else xcd_barrier(xb); } } while (0)
    if (IN(0)) phase_prologue(A, L);
    SEAM(0);
    if (IN(1)) phase_hx(A);
    SEAM(1);
    if (IN(2)) { SchedInProj Sd{(const char*)(A.ws + WS_HX), (const char*)(A.ws + WS_HC), (const char*)(A.ws + WS_WIN), G, c}; EpiInProj E{A.ws};
        pg8::gemm_phase<EpiInProj, SchedInProj, true, true>(L, D / 2, Sd, E); }
    SEAM(2);
    if (IN(3)) { phase_kfix(A); phase_vt(A, L); __syncthreads(); phase_conv(A, L); }
    SEAM(3);
    if (IN(4)) phase_attn(A, lds);
    SEAM(4);
    if (IN(5)) { SchedMerge Sd{(const char*)(A.ws + WS_ATT8), (const char*)(A.ws + WS_HX), (const char*)(A.ws + WS_WA), (const char*)(A.ws + WS_WC), G, c}; EpiMerge E{A.ws};
        pg8::gemm_phase<EpiMerge, SchedMerge, true, true>(L, D / 2, Sd, E); }
    SEAM(5);
    if (IN(6)) { SchedPlain Sd{(const char*)(A.ws + WS_G), (const char*)(A.ws + WS_WO), M / 256, D / 256, G, c, D};
        EpiOut E{A.x, (const float*)(A.ws + WS_MOD), A.n2g, (bf16_t*)(A.ws + WS_XSB), (bf16_t*)(A.ws + WS_HX), (float*)(A.ws + WS_SSQ)};
        pg8::gemm_phase<EpiOut, SchedPlain, true, true>(L, D / 2, Sd, E); }
    SEAM(6);
    if (IN(7)) { SchedPlain Sd{(const char*)(A.ws + WS_HX), (const char*)(A.ws + WS_WP), M / 256, PW / 256, G, c, 2 * D};
        EpiScores E{(unsigned short*)(A.ws + WS_SC), (const float*)(A.ws + WS_SSQ), (const float*)(A.ws + WS_SBIAS)};
        pg8::gemm_phase<EpiScores, SchedPlain, true>(L, D, Sd, E); }
    SEAM(7);
    if (IN(8)) phase_peer_u(A, L);
    SEAM(8);
    if (IN(9)) phase_peer_v(A, L);
#undef IN
#undef SEAM
}

#ifndef MK_ONE_LAUNCH
#define MK_ONE_LAUNCH 1
#endif
extern "C" void kernel_launch(void* const* d_in, const int* in_sizes, int n_in, void* d_out, int out_size, void* d_ws, size_t ws_size, hipStream_t stream) {
    static int grid = 0;
    if (grid == 0) {
        if (n_in != 23 || out_size != M * D || ws_size < WS_END) { fprintf(stderr, "kernel_launch: unexpected shapes (n_in %d out %d ws %zu)\n", n_in, out_size, ws_size); grid = -1; return; }
        int dev = 0, cus = 0, per_cu = 0;
        hipGetDevice(&dev); hipDeviceGetAttribute(&cus, hipDeviceAttributeMultiprocessorCount, dev);
        if (hipFuncSetAttribute((const void*)mega_fwd, hipFuncAttributeMaxDynamicSharedMemorySize, LDS_BYTES) != hipSuccess) { fprintf(stderr, "kernel_launch: hipFuncSetAttribute failed\n"); grid = -1; return; }
        if (hipOccupancyMaxActiveBlocksPerMultiprocessor(&per_cu, (const void*)mega_fwd, NWAVES * 64, LDS_BYTES) != hipSuccess || per_cu < 1) { fprintf(stderr, "kernel_launch: occupancy query says %d\n", per_cu); per_cu = 1; }
        (void)hipGetLastError();
        grid = cus * 1;
        if (per_cu < 1) grid = -1;
    }
    if (grid < 0) return;
    Args a{};
    const float** f = (const float**)&a;
    for (int i = 0; i < 23; ++i) f[i] = (const float*)d_in[i];
    a.out = (float*)d_out; a.ws = (unsigned char*)d_ws;
#if MK_ONE_LAUNCH
    a.ph_lo = 0; a.ph_hi = N_PHASES;
    void* args[] = {&a};
    hipError_t e = hipLaunchCooperativeKernel((const void*)mega_fwd, dim3(grid), dim3(NWAVES * 64), args, LDS_BYTES, stream);
    if (e != hipSuccess) fprintf(stderr, "cooperative launch failed: %s (grid %d)\n", hipGetErrorString(e), grid);
#else
#ifndef REPEAT_PH
#define REPEAT_PH -1
#endif
    for (int p = 0; p < N_PHASES; ++p) { a.ph_lo = p; a.ph_hi = p + 1;
        if (p == REPEAT_PH) { a.dry = 1; hipLaunchKernelGGL(mega_fwd, dim3(grid), dim3(NWAVES * 64), LDS_BYTES, stream, a); a.dry = 0; }
        hipLaunchKernelGGL(mega_fwd, dim3(grid), dim3(NWAVES * 64), LDS_BYTES, stream, a); }
#endif
}
```

```cpp
#include <hip/hip_runtime.h>
#include <hip/hip_cooperative_groups.h>
#include <cstdio>
#include <cstdint>
namespace cg = cooperative_groups;

#define LAS __attribute__((address_space(3)))
typedef unsigned short bf16_t;
typedef short bf16x8 __attribute__((ext_vector_type(8)));
typedef short s16x4 __attribute__((ext_vector_type(4)));
typedef float f32x2 __attribute__((ext_vector_type(2)));
typedef float f32x4 __attribute__((ext_vector_type(4)));
typedef float f32x16 __attribute__((ext_vector_type(16)));
typedef unsigned u32x2 __attribute__((ext_vector_type(2)));
typedef unsigned u32x4 __attribute__((ext_vector_type(4)));
typedef __bf16 bf16x2_t __attribute__((ext_vector_type(2)));

constexpr int D = 1024, NB = 8, S = 4096, CTXL = 256, SKV = S + CTXL, HD = 128, HQ = 8, HKV = 2;
constexpr int M = NB * S;
constexpr int MC = NB * CTXL;
constexpr int INW = 5632, NMOD = 6144, NEXP = 16384, PW = 2048;
constexpr float EPS = 1e-6f;

__device__ __forceinline__ unsigned cvt_pk_bf16(float lo, float hi) { f32x2 v = {lo, hi}; bf16x2_t b = __builtin_convertvector(v, bf16x2_t); return __builtin_bit_cast(unsigned, b); }
__device__ __forceinline__ float bf_lo(unsigned u) { return __uint_as_float(u << 16); }
__device__ __forceinline__ float bf_hi(unsigned u) { return __uint_as_float(u & 0xffff0000u); }
__device__ __forceinline__ float fast_sigmoid(float x) { return __builtin_amdgcn_rcpf(1.f + __builtin_amdgcn_exp2f(-1.4426950408889634f * x)); }
__device__ __forceinline__ float wave_sum(float v) {
#pragma unroll
    for (int o = 1; o < 64; o <<= 1) v += __shfl_xor(v, o);
    return v;
}

namespace pg8 {
constexpr int BM = 256, BK = 64, HALF = 128, HTB = HALF * BK * 2  , STAGE_BYTES = 8 * HTB, NXCD = 8, WGM = 8;
__host__ __device__ __forceinline__ int lds_byte(int r, int c) { const int st = (r >> 4) * 2 + (c >> 5), rr = r & 15, cc = c & 31, ob = rr * 64 + cc * 2; return st * 1024 + (ob ^ (((ob >> 9) & 1) << 5)); }
__host__ __device__ __forceinline__ void stage_rc(int b, int& R, int& C) { const int st = b / 1024, sb = b % 1024, swz = sb ^ (((sb >> 9) & 1) << 5); R = (st >> 1) * 16 + swz / 64; C = (st & 1) * 32 + (swz % 64) / 2; }
__host__ __device__ __forceinline__ int perm32(int rho) { const int n = rho >> 4, i = rho & 15; return 8 * (i >> 2) + 4 * n + (i & 3); }

struct Unit { const char* a; const char* b; int pm, pn, kind, keep; };

__device__ __forceinline__ void tile_of(int L, int nM, int nN, int& pm, int& pn) {
    const int nwg = nM * nN; int wgid = L;
    { const int q = nwg / NXCD, r = nwg % NXCD, xcd = wgid % NXCD, off = wgid / NXCD; wgid = (xcd < r ? xcd * (q + 1) : r * (q + 1) + (xcd - r) * q) + off; }
    const int nig = WGM * nN, gid = wgid / nig, fm = gid * WGM, gsz = (nM - fm) < WGM ? (nM - fm) : WGM;
    pm = fm + ((wgid % nig) % gsz); pn = (wgid % nig) / gsz;
}

typedef int i32x4v __attribute__((ext_vector_type(4)));
typedef int i32x8v __attribute__((ext_vector_type(8)));
__device__ __forceinline__ i32x8v cat8(bf16x8 a, bf16x8 b) { const i32x4v x = __builtin_bit_cast(i32x4v, a), y = __builtin_bit_cast(i32x4v, b); return __builtin_shufflevector(x, y, 0, 1, 2, 3, 4, 5, 6, 7); }
__device__ __forceinline__ void mfma_f8_acc(f32x4& c, i32x8v a, i32x8v b) { asm volatile("v_mfma_f32_16x16x128_f8f6f4 %0, %1, %2, %0" : "+v"(c) : "v"(a), "v"(b)); }
template <class Epi, class Sched, bool ALIGN_EPI, bool F8 = false>
__device__ __forceinline__ void gemm_phase(LAS unsigned char* lds, const int K, const Sched& S, const Epi& E) {
    const int tid = threadIdx.x, wid = __builtin_amdgcn_readfirstlane(tid >> 6), lane = tid & 63, wr = wid >> 2, wc = wid & 3, fr = lane & 15, fq = lane >> 4;
    const int nt = K / BK;
    unsigned voffA[2], voffB[2];
#pragma unroll
    for (int i = 0; i < 2; ++i) { int R, C; stage_rc(tid * 16 + i * 8192, R, C); const int Rb = Epi::PERM ? ((R & ~31) + perm32(R & 31)) : R;
        voffA[i] = (unsigned)(R * K + C) * 2u; voffB[i] = (unsigned)(Rb * K + C) * 2u; }
    const size_t kstep = (size_t)(BK * 2);
    const size_t hstep = (size_t)HALF * K * 2;
    const unsigned ldsw = (unsigned)wid * 1024u;
    const int aoff = lds_byte(wr * 64 + fr, fq * 8), boff = lds_byte(wc * 32 + fr, fq * 8);
#define PG8_SA(b, h) (((b) * 2 + (h)) * HTB)
#define PG8_SB(b, h) ((4 + (b) * 2 + (h)) * HTB)
#define PG8_STAGE(bufoff, gbase, voff) do { _Pragma("unroll") for (int _i = 0; _i < 2; ++_i) \
        __builtin_amdgcn_global_load_lds((const unsigned*)((const char*)(gbase) + (voff)[_i]), (LAS unsigned*)(lds + (bufoff) + ldsw + _i * 8192), 16, 0, 0); } while (0)
#define PG8_LDA(dst, b, h) do { _Pragma("unroll") for (int m = 0; m < 4; ++m) _Pragma("unroll") for (int k = 0; k < 2; ++k) dst[m][k] = *(const LAS bf16x8*)(lds + PG8_SA(b, h) + aoff + m * 2048 + k * 1024); } while (0)
#define PG8_LDB(dst, b, h) do { _Pragma("unroll") for (int n = 0; n < 2; ++n) _Pragma("unroll") for (int k = 0; k < 2; ++k) dst[n][k] = *(const LAS bf16x8*)(lds + PG8_SB(b, h) + boff + n * 2048 + k * 1024); } while (0)
#define PG8_MMA(ai, bj, At, Bt) do { __builtin_amdgcn_s_setprio(1); if constexpr (F8) { _Pragma("unroll") for (int m = 0; m < 4; ++m) _Pragma("unroll") for (int n = 0; n < 2; ++n) \
        mfma_f8_acc(acc[ai][bj][m][n], cat8(Bt[n][0], Bt[n][1]), cat8(At[m][0], At[m][1])); } else { \
        _Pragma("unroll") for (int m = 0; m < 4; ++m) _Pragma("unroll") for (int n = 0; n < 2; ++n) _Pragma("unroll") for (int k = 0; k < 2; ++k) \
        acc[ai][bj][m][n] = __builtin_amdgcn_mfma_f32_16x16x32_bf16(Bt[n][k], At[m][k], acc[ai][bj][m][n], 0, 0, 0); } __builtin_amdgcn_s_setprio(0); } while (0)
#define PG8_WAIT_V(n) asm volatile("s_waitcnt vmcnt(" #n ")" ::: "memory")
#define PG8_WAIT_L(n) asm volatile("s_waitcnt lgkmcnt(" #n ")" ::: "memory")
#define PG8_BAR __builtin_amdgcn_s_barrier()
#define PG8_SCHED __builtin_amdgcn_sched_barrier(0)
    Unit cur, nxt; int ui = 0;
    if (!S.next(0, cur)) return;
    f32x4 acc[2][2][4][2];
#pragma unroll
    for (int a = 0; a < 2; ++a)
#pragma unroll
        for (int b = 0; b < 2; ++b)
#pragma unroll
            for (int m = 0; m < 4; ++m)
#pragma unroll
                for (int n = 0; n < 2; ++n) acc[a][b][m][n] = (f32x4){0.f, 0.f, 0.f, 0.f};
    bf16x8 At[4][2], B0[2][2], B1[2][2];
    const char* cA = cur.a; const char* cB = cur.b;
    PG8_STAGE(PG8_SB(0, 0), cB, voffB); PG8_STAGE(PG8_SB(0, 1), cB + hstep, voffB); PG8_STAGE(PG8_SA(0, 0), cA, voffA); PG8_STAGE(PG8_SA(0, 1), cA + hstep, voffA);
    if (wr == 1) PG8_BAR;
    PG8_WAIT_V(2); PG8_BAR;
    PG8_STAGE(PG8_SB(1, 0), cB + kstep, voffB); PG8_STAGE(PG8_SA(1, 0), cA + kstep, voffA); PG8_STAGE(PG8_SB(1, 1), cB + hstep + kstep, voffB);
    PG8_WAIT_V(6); PG8_BAR;
    for (;;) {
        const bool has_next = S.next(ui + 1, nxt);
        const char* nA = has_next ? nxt.a : cA; const char* nB = has_next ? nxt.b : cB;
#pragma unroll 1
        for (int t = 0; t < nt; t += 2) {
            const bool last = (t == nt - 2);
            const char* a1 = cA + (size_t)(t + 1) * kstep;
            const char* a2 = last ? nA : cA + (size_t)(t + 2) * kstep; const char* b2 = last ? nB : cB + (size_t)(t + 2) * kstep;
            const char* a3 = a2 + kstep; const char* b3 = b2 + kstep;
            PG8_LDB(B0, 0, 0); PG8_LDB(B1, 0, 1); PG8_SCHED; PG8_LDA(At, 0, 0); PG8_STAGE(PG8_SA(1, 1), a1 + hstep, voffA);
            PG8_WAIT_V(8); PG8_WAIT_L(0); PG8_BAR; PG8_MMA(0, 0, At, B0); PG8_MMA(0, 1, At, B1); PG8_BAR; PG8_SCHED;
            PG8_LDA(At, 0, 1); PG8_STAGE(PG8_SB(0, 0), b2, voffB); PG8_STAGE(PG8_SB(0, 1), b2 + hstep, voffB); PG8_STAGE(PG8_SA(0, 0), a2, voffA);
            PG8_WAIT_V(8); PG8_WAIT_L(0); PG8_BAR; PG8_MMA(1, 0, At, B0); PG8_MMA(1, 1, At, B1); PG8_BAR; PG8_SCHED;
            PG8_LDB(B0, 1, 0); PG8_LDB(B1, 1, 1); PG8_SCHED; PG8_LDA(At, 1, 0); PG8_STAGE(PG8_SA(0, 1), a2 + hstep, voffA);
            PG8_WAIT_V(8); PG8_WAIT_L(0); PG8_BAR; PG8_MMA(0, 0, At, B0); PG8_MMA(0, 1, At, B1); PG8_BAR; PG8_SCHED;
            PG8_LDA(At, 1, 1); PG8_STAGE(PG8_SB(1, 0), b3, voffB); PG8_STAGE(PG8_SB(1, 1), b3 + hstep, voffB); PG8_STAGE(PG8_SA(1, 0), a3, voffA);
            PG8_WAIT_V(8); PG8_WAIT_L(0); PG8_BAR; PG8_MMA(1, 0, At, B0); PG8_MMA(1, 1, At, B1); PG8_BAR; PG8_SCHED;
        }
        if constexpr (ALIGN_EPI) { if (wr == 0) PG8_BAR; }
        if constexpr (F8) { asm volatile("s_nop 15\n\ts_nop 15" ::: "memory");
            if (!cur.keep)
#pragma unroll
            for (int a = 0; a < 2; ++a)
#pragma unroll
                for (int b = 0; b < 2; ++b)
#pragma unroll
                    for (int m = 0; m < 4; ++m)
#pragma unroll
                        for (int n = 0; n < 2; ++n) acc[a][b][m][n] *= (1.f / 8192.f); }
        E(acc, cur, wr, wc, fr, fq);
        if (!has_next) break;
        if (!cur.keep) {
#pragma unroll
        for (int a = 0; a < 2; ++a)
#pragma unroll
            for (int b = 0; b < 2; ++b)
#pragma unroll
                for (int m = 0; m < 4; ++m)
#pragma unroll
                    for (int n = 0; n < 2; ++n) acc[a][b][m][n] = (f32x4){0.f, 0.f, 0.f, 0.f};
        }
        cur = nxt; cA = nA; cB = nB; ++ui;
        if constexpr (ALIGN_EPI) { if (wr == 1) PG8_BAR; }
    }
    PG8_WAIT_V(0);
    if constexpr (!ALIGN_EPI) { if (wr == 0) PG8_BAR; }
    PG8_BAR;
#undef PG8_SA
#undef PG8_SB
#undef PG8_STAGE
#undef PG8_LDA
#undef PG8_LDB
#undef PG8_MMA
#undef PG8_WAIT_V
#undef PG8_WAIT_L
#undef PG8_BAR
#undef PG8_SCHED
}
}
namespace att {
typedef int v8i __attribute__((ext_vector_type(8)));
constexpr int NW = 8, QBLK = 32, KVBLK = 64;
constexpr float SCALE = 0.088388347648318440f;
constexpr float SC8 = SCALE / 256.f;
constexpr float THR = 3.f;
constexpr int LDQ = D, LDO = D;
constexpr int SHM_V = 8192, SHM_K = 8192, NRING = 3, OFF_K = NRING * SHM_V, OFF_WS = OFF_K + NRING * SHM_K, OST_OFF = OFF_WS + NW * 64 * 4, LDS_TOTAL = OST_OFF + NW * 8192;
#define SBAR() __builtin_amdgcn_sched_barrier(0)
#define MFMA8(a, b, c) __builtin_amdgcn_mfma_scale_f32_32x32x64_f8f6f4((a), (b), (c), 0, 0, 0, 0x7f7f7f7f, 0, 0x7f7f7f7f)
__device__ __forceinline__ int crow(int r, int hi) { return (r & 3) + 8 * (r >> 2) + 4 * hi; }
__device__ __forceinline__ int k_lds(int row, int chunk) { return row * 128 + ((chunk ^ ((row >> 1) & 7)) << 4); }
__device__ __forceinline__ int v_lds(int d, int slot) { return d * 64 + ((slot ^ ((d >> 2) & 3)) << 4); }
__device__ __forceinline__ float max3f(float a, float b, float c) { float r; asm("v_max3_f32 %0, %1, %2, %3" : "=v"(r) : "v"(a), "v"(b), "v"(c)); return r; }
__device__ __forceinline__ int pk4_fp8(float a, float b, float c, float d) { int w = __builtin_amdgcn_cvt_pk_fp8_f32(a, b, 0, false); return __builtin_amdgcn_cvt_pk_fp8_f32(c, d, w, true); }

__device__ __forceinline__ void partialSM(f32x16& p0, f32x16& p1, float& m_reg, float& mn, float& alpha) {
  constexpr float C = SC8 * 1.4426950408889634f;
  asm volatile("s_nop 15\n\ts_nop 7" : "+v"(p0), "+v"(p1));
  float mx[8];
#pragma unroll
  for (int i = 0; i < 8; ++i) mx[i] = max3f(p0[i], p0[8 + i], p1[i]);
  float m4[4];
#pragma unroll
  for (int i = 0; i < 4; ++i) m4[i] = max3f(mx[i], mx[4 + i], p1[8 + i]);
  float m2a = max3f(m4[0], m4[1], p1[12]), m2b = max3f(m4[2], m4[3], p1[13]);
  float pmax = max3f(m2a, m2b, p1[14]); pmax = max3f(pmax, p1[15], p1[15]);
  { auto rr = __builtin_amdgcn_permlane32_swap(__float_as_uint(pmax), __float_as_uint(pmax), false, false);
    pmax = fmaxf(__uint_as_float(rr[0]), __uint_as_float(rr[1])); }
  if (__builtin_expect(__all(pmax - m_reg <= THR / SC8), 1)) { mn = m_reg; alpha = 1.f; }
  else { mn = fmaxf(m_reg, pmax); alpha = __builtin_amdgcn_exp2f((m_reg - mn) * C); m_reg = mn; }
  float mnC = 4.f - mn * C;
  for (int r = 0; r < 16; ++r) p0[r] = fmaf(p0[r], C, mnC); for (int r = 0; r < 16; ++r) p1[r] = fmaf(p1[r], C, mnC);
  for (int r = 0; r < 16; ++r) p0[r] = __builtin_amdgcn_exp2f(p0[r]);
}
__device__ __forceinline__ void finishSM(f32x16& p0, f32x16& p1, float alpha, float& l_reg, v8i& pa) {
  for (int r = 0; r < 16; ++r) p1[r] = __builtin_amdgcn_exp2f(p1[r]);
  float sm[8];
#pragma unroll
  for (int i = 0; i < 8; ++i) sm[i] = (p0[i] + p0[8 + i]) + (p1[i] + p1[8 + i]);
  float ps = ((sm[0] + sm[1]) + (sm[2] + sm[3])) + ((sm[4] + sm[5]) + (sm[6] + sm[7]));
  { auto rr = __builtin_amdgcn_permlane32_swap(__float_as_uint(ps), __float_as_uint(ps), false, false);
    ps = __uint_as_float(rr[0]) + __uint_as_float(rr[1]); }
  l_reg = l_reg * alpha + ps;
  pa[0] = pk4_fp8(p0[0], p0[1], p0[2], p0[3]); pa[1] = pk4_fp8(p0[4], p0[5], p0[6], p0[7]); pa[2] = pk4_fp8(p0[8], p0[9], p0[10], p0[11]); pa[3] = pk4_fp8(p0[12], p0[13], p0[14], p0[15]);
  pa[4] = pk4_fp8(p1[0], p1[1], p1[2], p1[3]); pa[5] = pk4_fp8(p1[4], p1[5], p1[6], p1[7]); pa[6] = pk4_fp8(p1[8], p1[9], p1[10], p1[11]); pa[7] = pk4_fp8(p1[12], p1[13], p1[14], p1[15]);
}
__device__ __forceinline__ v8i ld32(const char* p0, const char* p1) { const u32x4 a = *reinterpret_cast<const u32x4*>(p0), b = *reinterpret_cast<const u32x4*>(p1);
  v8i r; r[0] = (int)a[0]; r[1] = (int)a[1]; r[2] = (int)a[2]; r[3] = (int)a[3]; r[4] = (int)b[0]; r[5] = (int)b[1]; r[6] = (int)b[2]; r[7] = (int)b[3]; return r; }
__device__ __forceinline__ void qkt(f32x16& p0, f32x16& p1, const char* Ks, const v8i* qf, int r32, int hi) {
  p0 = f32x16{}; p1 = f32x16{};
#pragma unroll
  for (int s = 0; s < 2; ++s) {
    const v8i a0 = ld32(Ks + k_lds(r32, 4 * s + hi), Ks + k_lds(r32, 4 * s + 2 + hi)), a1 = ld32(Ks + k_lds(32 + r32, 4 * s + hi), Ks + k_lds(32 + r32, 4 * s + 2 + hi));
    p0 = MFMA8(a0, qf[s], p0); p1 = MFMA8(a1, qf[s], p1); }
}
__device__ __forceinline__ void pv(f32x16* o, const char* Vs, const v8i pa, int r32, int hi) {
#pragma unroll
  for (int d0 = 0; d0 < 4; ++d0) { const int d = 32 * d0 + r32; const v8i b = ld32(Vs + v_lds(d, 2 * hi), Vs + v_lds(d, 2 * hi + 1)); o[d0] = MFMA8(pa, b, o[d0]); }
}

__device__ __forceinline__ void attn_unit(const bf16_t* Qb, const unsigned char* __restrict__ K8, const unsigned char* __restrict__ VT, unsigned char* Ob, int t0, int seq,
                                          const float* __restrict__ qng, const float* __restrict__ cst, const float* __restrict__ snt, char* lds) {
  int tid_ = threadIdx.x; asm volatile("" : "+v"(tid_));
  const int tid = tid_, wid = tid >> 6, lane = tid & 63, r32 = lane & 31, hi = lane >> 5;
  char* V_lds = lds; char* K_lds = lds + OFF_K;
  float* ws = (float*)(lds + OFF_WS) + wid * 64; float* li_l = ws; float* al_l = ws + 32;
  float m_reg = -1e30f, l_reg = 0; f32x16 o[4] = {}; v8i qf[2];
  {
    const bf16_t* Qw = Qb + (long)(wid * QBLK + r32) * LDQ + 16 * hi;
    float y[2][32]; float ss = 0.f;
#pragma unroll
    for (int s = 0; s < 2; ++s)
#pragma unroll
      for (int part = 0; part < 2; ++part)
#pragma unroll
        for (int c = 0; c < 2; ++c) { const u32x4 w = *reinterpret_cast<const u32x4*>(Qw + 64 * s + 32 * part + 8 * c);
#pragma unroll
          for (int j = 0; j < 4; ++j) { const float a = bf_lo(w[j]), b = bf_hi(w[j]); y[s][16 * part + 8 * c + 2 * j] = a; y[s][16 * part + 8 * c + 2 * j + 1] = b; ss += a * a + b * b; } }
    ss += __shfl_xor(ss, 32);
    const float rstd = rsqrtf(ss * (1.f / HD) + EPS) * 16.f;
    const int t = t0 + wid * QBLK + r32;
#pragma unroll
    for (int s = 0; s < 2; ++s) { const int pos = s == 0 ? (t >> 6) : (t & 63);
#pragma unroll
      for (int c = 0; c < 4; ++c) { const int i0 = 16 * hi + 4 * c;
        const f32x4 g1 = *reinterpret_cast<const f32x4*>(qng + 64 * s + i0), g2 = *reinterpret_cast<const f32x4*>(qng + 64 * s + 32 + i0);
        const f32x4 c4 = *reinterpret_cast<const f32x4*>(cst + pos * 32 + i0), s4 = *reinterpret_cast<const f32x4*>(snt + pos * 32 + i0);
#pragma unroll
        for (int j = 0; j < 4; ++j) { const float x1 = y[s][4 * c + j] * rstd * g1[j], x2 = y[s][16 + 4 * c + j] * rstd * g2[j]; y[s][4 * c + j] = x1 * c4[j] - x2 * s4[j]; y[s][16 + 4 * c + j] = x1 * s4[j] + x2 * c4[j]; } }
#pragma unroll
      for (int w = 0; w < 8; ++w) qf[s][w] = pk4_fp8(y[s][4 * w], y[s][4 * w + 1], y[s][4 * w + 2], y[s][4 * w + 3]); }
  }
  const int krow = tid >> 3, kch = tid & 7, kst = k_lds(krow, kch), vst = v_lds(tid >> 2, tid & 3);
  const unsigned char* kg = K8 + (long)krow * 256 + kch * 16; const unsigned char* vg = VT + tid * 16;
  struct { u32x4 k, v; } sr_[2];
#define SLOAD(i, kt) do { sr_[i].k = *reinterpret_cast<const u32x4*>(kg + (long)(kt) * (KVBLK * 256)); sr_[i].v = *reinterpret_cast<const u32x4*>(vg + (long)(kt) * 8192); } while (0)
#define SWRITE(boff, i) do { *(u32x4*)(V_lds + (boff) + vst) = sr_[i].v; *(u32x4*)(K_lds + (boff) + kst) = sr_[i].k; } while (0)
#define SWAIT() asm volatile("s_waitcnt vmcnt(2)" ::: "memory")
#define RESC(a) do { if (__any((a) < 1.f)) { if (hi == 0) al_l[r32] = (a); asm volatile("s_waitcnt lgkmcnt(0)" ::: "memory"); \
    for (int d = 0; d < 4; ++d) for (int r = 0; r < 16; ++r) o[d][r] *= al_l[crow(r, hi)]; } } while (0)
  f32x16 pA0, pA1, pB0, pB1; float mnA, mnB, alA, alB; v8i pa; const int NT = seq / KVBLK;
  constexpr int SE = 0, SO = 1;
  int bprev = 0, bcur = SHM_K, bnext = 2 * SHM_K;
#define ROT() do { const int t_ = bprev; bprev = bcur; bcur = bnext; bnext = t_; } while (0)
  SLOAD(SE, 0); asm volatile("s_waitcnt vmcnt(0)" ::: "memory"); SWRITE(0, SE); __syncthreads();
  qkt(pA0, pA1, K_lds, qf, r32, hi); partialSM(pA0, pA1, m_reg, mnA, alA);
  SLOAD(SO, 1); if (2 < NT) SLOAD(SE, 2);
  SWAIT(); SWRITE(SHM_K, SO); __syncthreads();
  for (int j = 1; j + 1 < NT; j += 2) {
    SBAR(); qkt(pB0, pB1, K_lds + bcur, qf, r32, hi);
    finishSM(pA0, pA1, alA, l_reg, pa); SBAR();
    SLOAD(SO, j + 2); SBAR();
    pv(o, V_lds + bprev, pa, r32, hi); partialSM(pB0, pB1, m_reg, mnB, alB);
    SWAIT(); SWRITE(bnext, SE);
    RESC(alB); __syncthreads(); ROT();
    SBAR(); qkt(pA0, pA1, K_lds + bcur, qf, r32, hi);
    finishSM(pB0, pB1, alB, l_reg, pa); SBAR();
    if (j + 3 < NT) SLOAD(SE, j + 3); SBAR();
    pv(o, V_lds + bprev, pa, r32, hi); partialSM(pA0, pA1, m_reg, mnA, alA);
    SWAIT(); SWRITE(bnext, SO);
    RESC(alA); __syncthreads(); ROT();
  }
  SBAR(); qkt(pB0, pB1, K_lds + bcur, qf, r32, hi);
  finishSM(pA0, pA1, alA, l_reg, pa); SBAR();
  pv(o, V_lds + bprev, pa, r32, hi); partialSM(pB0, pB1, m_reg, mnB, alB);
  RESC(alB);
  finishSM(pB0, pB1, alB, l_reg, pa); SBAR();
  pv(o, V_lds + bcur, pa, r32, hi);
  __syncthreads();
#undef ROT
  if (hi == 0) li_l[r32] = l_reg; asm volatile("s_waitcnt lgkmcnt(0)" ::: "memory");
  float rli[16];
#pragma unroll
  for (int r = 0; r < 16; ++r) rli[r] = __builtin_amdgcn_rcpf(16.f * li_l[crow(r, hi)]);
  { bf16_t* stg = (bf16_t*)(lds + OST_OFF) + wid * 4096;
#pragma unroll
    for (int r = 0; r < 16; ++r) { const int orow = crow(r, hi);
#pragma unroll
      for (int d0 = 0; d0 < 4; ++d0) stg[orow * 128 + d0 * 32 + r32] = (bf16_t)(cvt_pk_bf16(o[d0][r] * rli[r], 0.f) & 0xffffu); }
    asm volatile("s_waitcnt lgkmcnt(0)" ::: "memory");
    unsigned char* Ow = Ob + (long)(wid * QBLK) * LDO;
#pragma unroll
    for (int i = 0; i < 8; ++i) { const int row = i * 4 + (lane >> 4), ch = lane & 15; const u32x4 v = *(const u32x4*)(stg + row * 128 + ch * 8);
      u32x2 w8 = {(unsigned)pk4_fp8(bf_lo(v[0]) * 16.f, bf_hi(v[0]) * 16.f, bf_lo(v[1]) * 16.f, bf_hi(v[1]) * 16.f), (unsigned)pk4_fp8(bf_lo(v[2]) * 16.f, bf_hi(v[2]) * 16.f, bf_lo(v[3]) * 16.f, bf_hi(v[3]) * 16.f)};
      *(u32x2*)(Ow + (long)row * LDO + ch * 8) = w8; }
  }
#undef SLOAD
#undef SWRITE
#undef SWAIT
#undef RESC
}
#undef SBAR
#undef MFMA8
}
constexpr size_t MiB = 1u << 20;
constexpr size_t WS_CTL = 0, CTL_ZERO_BYTES = 64 * 1024;
constexpr size_t WS_MOD = 1 * MiB;
constexpr size_t WS_ROPE = WS_MOD + 256 * 1024;
constexpr size_t WS_SBIAS = WS_MOD + 512 * 1024;
constexpr size_t WS_HC = 2 * MiB;
constexpr size_t WS_WIN = 6 * MiB;
constexpr size_t WS_WA = 17 * MiB, WS_WC = 19 * MiB, WS_WO = 21 * MiB;
constexpr size_t WS_WP = 23 * MiB;
constexpr size_t WS_UT = 27 * MiB, WS_VT = 59 * MiB;
constexpr size_t WS_TSCALE = 16 * MiB;
constexpr size_t WS_KB = 91 * MiB, WS_VB = 108 * MiB;
constexpr size_t WS_HX = 125 * MiB;
constexpr size_t WS_ATT8 = WS_HX + 32 * MiB;
constexpr size_t WS_Q = 189 * MiB;
constexpr size_t WS_G = 253 * MiB;
constexpr size_t WS_RT = 317 * MiB;
constexpr size_t WS_XSB = WS_RT;
constexpr size_t WS_SGC = 381 * MiB;
constexpr size_t WS_SC = 189 * MiB;
constexpr size_t WS_SSQ = 445 * MiB;
constexpr size_t WS_K8 = 447 * MiB;
constexpr size_t WS_VT8 = 456 * MiB;
constexpr size_t WS_PE = 465 * MiB, WS_PC = 481 * MiB;
constexpr size_t WS_END = 497 * MiB;

constexpr int NWAVES = 8;
constexpr int LDS_BYTES = 147456;

struct Args {
    const float *x, *c, *ctx, *c_ctx, *w_mod, *b_mod, *n1g, *n2g, *w_in, *qng, *kng, *w_ao, *cdw, *cb, *clg, *clb, *w_co, *w_o, *wq, *keys, *ut, *vt, *fg;
    float* out; unsigned char* ws; int ph_lo, ph_hi, dry, pad;
};

__host__ __device__ __forceinline__ int win_row(int n) {
    if (n < 1536) return n;
    const int base = n < 3584 ? 1536 : 3584, m = n - base, half = m >> 10, idx = m & 1023;
    return base + (idx >> 7) * 256 + half * 128 + (idx & 127);
}

__device__ __forceinline__ void task_mod(const Args& A, int task, int lane, const LAS float* sc) {
    const int n0 = task * 8, col = lane & 7, kg = lane >> 3;
    float acc[9];
#pragma unroll
    for (int b = 0; b < 9; ++b) acc[b] = 0.f;
    const float* wp = A.w_mod + (size_t)kg * NMOD + n0 + col;
    for (int i0 = 0; i0 < 128; i0 += 8) {
        float w[8];
#pragma unroll
        for (int u = 0; u < 8; ++u) w[u] = wp[(size_t)(i0 + u) * 8 * NMOD];
#pragma unroll
        for (int u = 0; u < 8; ++u) { const int k = kg + 8 * (i0 + u);
#pragma unroll
            for (int b = 0; b < 9; ++b) acc[b] += sc[b * D + k] * w[u]; }
    }
#pragma unroll
    for (int b = 0; b < 9; ++b) { float v = acc[b]; v += __shfl_xor(v, 8); v += __shfl_xor(v, 16); v += __shfl_xor(v, 32); acc[b] = v; }
    if (lane < 8) { float* mod = (float*)(A.ws + WS_MOD); const float bm = A.b_mod[n0 + col];
#pragma unroll
        for (int b = 0; b < 9; ++b) mod[b * NMOD + n0 + col] = acc[b] + bm; }
}
__device__ __forceinline__ void task_transpose_f8(const float* W, int K, int N, unsigned char* WT, int k0, int n0, int row0, LAS float* scr, int lane) {
#pragma unroll 8
    for (int i = 0; i < 32; ++i) { const int kk = 2 * i + (lane >> 5); scr[kk * 33 + (lane & 31)] = W[(size_t)(k0 + kk) * N + n0 + (lane & 31)]; }
    asm volatile("s_waitcnt lgkmcnt(0)" ::: "memory");
    const int c = lane & 7;
#pragma unroll
    for (int j = 0; j < 4; ++j) { const int n = (lane >> 3) + 8 * j; const LAS float* s = scr + (8 * c) * 33 + n;
        u32x2 o = {(unsigned)att::pk4_fp8(s[0 * 33] * 512.f, s[1 * 33] * 512.f, s[2 * 33] * 512.f, s[3 * 33] * 512.f), (unsigned)att::pk4_fp8(s[4 * 33] * 512.f, s[5 * 33] * 512.f, s[6 * 33] * 512.f, s[7 * 33] * 512.f)};
        *(u32x2*)(WT + (size_t)(row0 + n) * K + k0 + 8 * c) = o; }
    asm volatile("s_waitcnt lgkmcnt(0)" ::: "memory");
}
typedef float f32x16v __attribute__((ext_vector_type(16)));
typedef unsigned u32x6 __attribute__((ext_vector_type(6)));
constexpr int ROWB = 768;
__device__ __forceinline__ void task_quant_rows4(const float* src, unsigned char* dst, float* scale_out, int lane) {
    const int g = lane & 31, hh = lane >> 5;
    f32x4 v[2][8];
#pragma unroll
    for (int r = 0; r < 2; ++r)
#pragma unroll
        for (int i = 0; i < 8; ++i) v[r][i] = *(const f32x4*)(src + (size_t)(2 * r + hh) * D + g * 32 + i * 4);
#pragma unroll
    for (int r = 0; r < 2; ++r) {
        float am = 0.f;
#pragma unroll
        for (int i = 0; i < 8; ++i) am = fmaxf(fmaxf(am, fmaxf(fabsf(v[r][i][0]), fabsf(v[r][i][1]))), fmaxf(fabsf(v[r][i][2]), fabsf(v[r][i][3])));
#pragma unroll
        for (int o = 1; o < 32; o <<= 1) am = fmaxf(am, __shfl_xor(am, o));
        const float inv = am > 0.f ? 7.5f / am : 0.f;
        f32x16v a, b;
#pragma unroll
        for (int i = 0; i < 4; ++i)
#pragma unroll
            for (int j = 0; j < 4; ++j) { const int e0 = 4 * i + j;
                a[e0] = v[r][(2 * e0) >> 2][(2 * e0) & 3] * inv; b[e0] = v[r][(2 * e0 + 1) >> 2][(2 * e0 + 1) & 3] * inv; }
        const u32x6 p = __builtin_amdgcn_cvt_scalef32_2xpk16_fp6_f32(a, b, 1.0f);
        unsigned char* rowp = dst + (size_t)(2 * r + hh) * ROWB;
        *(u32x4*)(rowp + g * 16) = (u32x4){p[0], p[1], p[2], p[3]}; *(u32x2*)(rowp + 512 + g * 8) = (u32x2){p[4], p[5]};
        if (g == 0) scale_out[2 * r + hh] = am * (1.f / 7.5f);
    }
}
__device__ __forceinline__ bf16x8 ld8_f32_bf16(const float* p) { const f32x4 a = *(const f32x4*)p, b = *(const f32x4*)(p + 4); u32x4 w = {cvt_pk_bf16(a[0], a[1]), cvt_pk_bf16(a[2], a[3]), cvt_pk_bf16(b[0], b[1]), cvt_pk_bf16(b[2], b[3])}; return *reinterpret_cast<bf16x8*>(&w); }
__device__ __forceinline__ void task_wprime(const Args& A, int id, int lane) {
    const int hp = id >> 7, rem = id & 127, n0 = (rem >> 5) * 32, k0 = (rem & 31) * 32, r32 = lane & 31, hi = lane >> 5;
    f32x16 acc = {};
    const float* ka = A.keys + ((size_t)(hp * 128 + n0 + r32)) * 128 + hi * 8;
    const float* wb = A.wq + (size_t)(k0 + r32) * PW + hp * 128 + hi * 8;
#pragma unroll
    for (int s = 0; s < 8; ++s) acc = __builtin_amdgcn_mfma_f32_32x32x16_bf16(ld8_f32_bf16(ka + s * 16), ld8_f32_bf16(wb + s * 16), acc, 0, 0, 0);
    bf16_t* o = (bf16_t*)(A.ws + WS_WP);
#pragma unroll
    for (int r = 0; r < 16; ++r) { const int n = (r & 3) + 8 * (r >> 2) + 4 * hi; o[(size_t)(hp * 128 + n0 + n) * D + k0 + r32] = (bf16_t)(cvt_pk_bf16(acc[r], 0.f) & 0xffffu); }
}
__device__ __forceinline__ void phase_prologue(const Args& A, LAS unsigned char* lds) {
    const int tid = threadIdx.x, lane = tid & 63, wave = __builtin_amdgcn_readfirstlane(tid >> 6);
    LAS float* sc = (LAS float*)lds;
    for (int i = tid; i < 9 * D; i += 512) { const float v = i < 8 * D ? A.c[i] : A.c_ctx[i - 8 * D]; sc[i] = v / (1.f + __expf(-v)); }
    __syncthreads();
    LAS float* scr = (LAS float*)(lds + 36864 + wave * 8448);
    constexpr int T_MOD = NMOD / 8, T_WIN = (D / 64) * (INW / 32), T_SQ = (D / 64) * (D / 32), T_UV = 2 * NEXP / 4, T_WP = 2048, T_ROPE = 1;
    constexpr int NT = T_MOD + T_WIN + 3 * T_SQ + T_UV + T_WP + T_ROPE;
    const int G = gridDim.x;
    for (int task = wave * G + blockIdx.x; task < NT; task += NWAVES * G) {
        int r = task;
        if (r < T_MOD) { task_mod(A, r, lane, sc); continue; } r -= T_MOD;
        if (r < T_WIN) { const int nblk = INW / 32, kb = r / nblk, nb = r % nblk; task_transpose_f8(A.w_in, D, INW, A.ws + WS_WIN, 64 * kb, 32 * nb, win_row(32 * nb), scr, lane); continue; } r -= T_WIN;
        if (r < 3 * T_SQ) { const int wsel = r / T_SQ, q = r % T_SQ, kb = q / 32, nb = q % 32;
            const float* W = wsel == 0 ? A.w_ao : (wsel == 1 ? A.w_co : A.w_o); unsigned char* WT = A.ws + (wsel == 0 ? WS_WA : (wsel == 1 ? WS_WC : WS_WO));
            task_transpose_f8(W, D, D, WT, 64 * kb, 32 * nb, 32 * nb, scr, lane); continue; } r -= 3 * T_SQ;
        if (r < T_UV) { const int tb = r / (NEXP / 4), row = (r % (NEXP / 4)) * 4; unsigned char* tbase = A.ws + (tb ? WS_VT : WS_UT);
            task_quant_rows4((tb ? A.vt : A.ut) + (size_t)row * D, tbase + (size_t)row * ROWB, (float*)(tbase + WS_TSCALE) + row, lane); continue; } r -= T_UV;
        if (r < T_WP) { task_wprime(A, r, lane); continue; } r -= T_WP;
        { float* cs = (float*)(A.ws + WS_ROPE); float* sn = cs + 2048;
          for (int e = lane; e < 2048; e += 64) { const int p = e >> 5, i = e & 31; const float inv = powf(10000.f, -(float)(2 * i) / 64.f); const float a = (float)p * inv; cs[e] = cosf(a); sn[e] = sinf(a); } }
    }
}
__device__ __forceinline__ void normmod_row(const float* xr, const float* g, const float* modr, int sh_off, int sc_off, unsigned char* orow, int lane) {
    f32x4 v[4]; float ss = 0.f;
#pragma unroll
    for (int i = 0; i < 4; ++i) { v[i] = *(const f32x4*)(xr + (i * 64 + lane) * 4); ss += (v[i][0] * v[i][0] + v[i][1] * v[i][1]) + (v[i][2] * v[i][2] + v[i][3] * v[i][3]); }
    const float r = rsqrtf(wave_sum(ss) * (1.f / D) + EPS);
#pragma unroll
    for (int i = 0; i < 4; ++i) { const int k = (i * 64 + lane) * 4; const f32x4 gg = *(const f32x4*)(g + k), s1 = *(const f32x4*)(modr + sc_off + k), h1 = *(const f32x4*)(modr + sh_off + k);
        float y[4];
#pragma unroll
        for (int j = 0; j < 4; ++j) y[j] = v[i][j] * r * gg[j] * (1.f + s1[j]) + h1[j];
        *(unsigned*)(orow + k) = (unsigned)att::pk4_fp8(y[0] * 16.f, y[1] * 16.f, y[2] * 16.f, y[3] * 16.f); }
}
__device__ __forceinline__ void phase_hx(const Args& A) {
    const int lane = threadIdx.x & 63, gw = blockIdx.x * NWAVES + (threadIdx.x >> 6), NGW = gridDim.x * NWAVES;
    const float* mod = (const float*)(A.ws + WS_MOD);
    for (int m = gw; m < M + MC; m += NGW) {
        if (m < M) normmod_row(A.x + (size_t)m * D, A.n1g, mod + (m >> 12) * NMOD, 0, D, A.ws + WS_HX + (size_t)m * D, lane);
        else { const int r = m - M; normmod_row(A.ctx + (size_t)r * D, A.n1g, mod + 8 * NMOD, 0, D, A.ws + WS_HC + (size_t)r * D, lane); }
    }
    const bf16_t* WP = (const bf16_t*)(A.ws + WS_WP); float* sb = (float*)(A.ws + WS_SBIAS);
    for (int col = gw; col < PW; col += NGW) {
        const u32x4 w0 = *(const u32x4*)(WP + (size_t)col * D + lane * 16), w1 = *(const u32x4*)(WP + (size_t)col * D + lane * 16 + 8);
        float wv[16];
#pragma unroll
        for (int j = 0; j < 4; ++j) { wv[2 * j] = bf_lo(w0[j]); wv[2 * j + 1] = bf_hi(w0[j]); wv[8 + 2 * j] = bf_lo(w1[j]); wv[8 + 2 * j + 1] = bf_hi(w1[j]); }
#pragma unroll 1
        for (int b = 0; b < NB; ++b) { const float* sh = mod + b * NMOD + 3 * D + lane * 16; float s = 0.f;
#pragma unroll
            for (int q = 0; q < 4; ++q) { const f32x4 v = *(const f32x4*)(sh + 4 * q); s += v[0] * wv[4 * q] + v[1] * wv[4 * q + 1] + v[2] * wv[4 * q + 2] + v[3] * wv[4 * q + 3]; }
            s = wave_sum(s); if (lane == 0) sb[b * PW + col] = s; }
    }
}
__device__ __forceinline__ void phase_kfix(const Args& A) {
    const int lane = threadIdx.x & 63, gw = blockIdx.x * NWAVES + (threadIdx.x >> 6), NGW = gridDim.x * NWAVES, li = lane & 15, sub = lane >> 4;
    const bf16_t* KB = (const bf16_t*)(A.ws + WS_KB); const float* cs = (const float*)(A.ws + WS_ROPE); const float* sn = cs + 2048;
    constexpr int NITEM = NB * SKV * HKV;
    const f32x4 g0 = *(const f32x4*)(A.kng + li * 8), g1 = *(const f32x4*)(A.kng + li * 8 + 4);
    const f32x4 p0 = *(const f32x4*)(A.kng + (li ^ 4) * 8), p1 = *(const f32x4*)(A.kng + (li ^ 4) * 8 + 4);
    for (int it = gw * 4 + sub; it < NITEM; it += NGW * 4) {
        const int row = it >> 1, h = it & 1, t = row % SKV;
        const bf16_t* p = KB + (size_t)row * 256 + h * HD + li * 8;
        const u32x4 w = *(const u32x4*)p;
        float x[8], xp[8]; float ss = 0.f;
#pragma unroll
        for (int j = 0; j < 4; ++j) { x[2 * j] = bf_lo(w[j]); x[2 * j + 1] = bf_hi(w[j]); ss += x[2 * j] * x[2 * j] + x[2 * j + 1] * x[2 * j + 1];
            const unsigned pw = (unsigned)__shfl_xor((int)w[j], 4); xp[2 * j] = bf_lo(pw); xp[2 * j + 1] = bf_hi(pw); }
        ss += __shfl_xor(ss, 1); ss += __shfl_xor(ss, 2); ss += __shfl_xor(ss, 4); ss += __shfl_xor(ss, 8);
        const float r = rsqrtf(ss * (1.f / HD) + EPS);
        float y[8];
#pragma unroll
        for (int j = 0; j < 8; ++j) { x[j] *= r * (j < 4 ? g0[j] : g1[j - 4]); xp[j] *= r * (j < 4 ? p0[j] : p1[j - 4]); y[j] = x[j]; }
        if (t < S) {
            const int blk = li >> 3, pos = blk == 0 ? (t >> 6) : (t & 63), second = (li >> 2) & 1, i0 = (li & 3) * 8;
            const f32x4 c0 = *(const f32x4*)(cs + pos * 32 + i0), c1 = *(const f32x4*)(cs + pos * 32 + i0 + 4), s0 = *(const f32x4*)(sn + pos * 32 + i0), s1 = *(const f32x4*)(sn + pos * 32 + i0 + 4);
#pragma unroll
            for (int j = 0; j < 8; ++j) { const float c = j < 4 ? c0[j] : c1[j - 4], s = j < 4 ? s0[j] : s1[j - 4];
                y[j] = second ? (xp[j] * s + x[j] * c) : (x[j] * c - xp[j] * s); }
        }
        u32x2 o = {(unsigned)att::pk4_fp8(y[0] * 16.f, y[1] * 16.f, y[2] * 16.f, y[3] * 16.f), (unsigned)att::pk4_fp8(y[4] * 16.f, y[5] * 16.f, y[6] * 16.f, y[7] * 16.f)};
        *(u32x2*)(A.ws + WS_K8 + (size_t)row * 256 + h * HD + li * 8) = o;
    }
}
__device__ __forceinline__ void phase_vt(const Args& A, LAS unsigned char* lds) {
    const int lane = threadIdx.x & 63, wave = threadIdx.x >> 6, gw = blockIdx.x * NWAVES + wave, NGW = gridDim.x * NWAVES;
    LAS unsigned char* tl = lds + wave * 4096;
    const bf16_t* VB = (const bf16_t*)(A.ws + WS_VB);
    const int kk = lane & 31, pos = 32 * ((kk >> 2) & 1) + (kk & 3) + 4 * (kk >> 3) + 16 * (lane >> 5);
    constexpr int NTILE = SKV / 64;
    for (int it2 = gw; it2 < NB * HKV * NTILE * 2; it2 += NGW) {
        const int dh = it2 & 1, it = it2 >> 1, j = it % NTILE, bk = it / NTILE, b = bk >> 1, kv = bk & 1;
        const bf16_t* src = VB + ((size_t)b * SKV + j * 64 + lane) * 256 + kv * HD + dh * 64;
        u32x4 w[8];
#pragma unroll
        for (int c = 0; c < 8; ++c) w[c] = *(const u32x4*)(src + c * 8);
#pragma unroll
        for (int c = 0; c < 8; ++c)
#pragma unroll
            for (int q = 0; q < 4; ++q) { const int pk = __builtin_amdgcn_cvt_pk_fp8_f32(bf_lo(w[c][q]) * 16.f, bf_hi(w[c][q]) * 16.f, 0, false);
                tl[(c * 8 + 2 * q) * 64 + pos] = (unsigned char)(pk & 0xff); tl[(c * 8 + 2 * q + 1) * 64 + pos] = (unsigned char)((pk >> 8) & 0xff); }
        asm volatile("s_waitcnt lgkmcnt(0)" ::: "memory");
        unsigned char* dst = A.ws + WS_VT8 + (size_t)it * 8192 + dh * 4096;
#pragma unroll
        for (int i = 0; i < 4; ++i) *(u32x4*)(dst + (i * 64 + lane) * 16) = *(const LAS u32x4*)(tl + (i * 64 + lane) * 16);
        asm volatile("s_waitcnt lgkmcnt(0)" ::: "memory");
    }
}
template <int R> struct ConvRow {
    static __device__ __forceinline__ void run(const unsigned* gp, int tl0, float (&acc)[32][2], const float (&w)[31][2]) {
        const int tl = tl0 + R - 15;
        unsigned v = 0u; if (tl >= 0 && tl < S) v = gp[(long)(R - 15) * (D / 2)];
        const float a = bf_lo(v), b = bf_hi(v);
#pragma unroll
        for (int t = (R - 30 > 0 ? R - 30 : 0); t <= (R < 31 ? R : 31); ++t) { acc[t][0] += w[R - t][0] * a; acc[t][1] += w[R - t][1] * b; }
        if constexpr (R + 1 < 62) ConvRow<R + 1>::run(gp, tl0, acc, w);
    }
};
__device__ __forceinline__ void phase_conv(const Args& A, LAS unsigned char* lds) {
    const int tid = threadIdx.x, lane = tid & 63, wave = tid >> 6;
    LAS float* tile = (LAS float*)lds;
    const bf16_t* G = (const bf16_t*)(A.ws + WS_G); unsigned char* CV = A.ws + WS_HX;
    float w[31][2];
#pragma unroll
    for (int j = 0; j < 31; ++j) { const f32x2 t = *(const f32x2*)(A.cdw + j * D + 2 * tid); w[j][0] = t[0]; w[j][1] = t[1]; }
    const f32x2 bias = *(const f32x2*)(A.cb + 2 * tid);
    for (int tileid = blockIdx.x; tileid < M / 32; tileid += gridDim.x) {
        const int row0 = tileid * 32, tl0 = row0 & (S - 1);
        float acc[32][2];
#pragma unroll
        for (int t = 0; t < 32; ++t) { acc[t][0] = bias[0]; acc[t][1] = bias[1]; }
        ConvRow<0>::run((const unsigned*)(G + (size_t)row0 * D) + tid, tl0, acc, w);
        __syncthreads();
#pragma unroll
        for (int t = 0; t < 32; ++t) *(LAS f32x2*)(tile + t * D + 2 * tid) = (f32x2){acc[t][0], acc[t][1]};
        __syncthreads();
#pragma unroll
        for (int q = 0; q < 4; ++q) { const int t = wave * 4 + q; const LAS float* tr = tile + t * D;
            f32x4 v[4]; float s = 0.f;
#pragma unroll
            for (int i = 0; i < 4; ++i) { v[i] = *(const LAS f32x4*)(tr + (i * 64 + lane) * 4); s += (v[i][0] + v[i][1]) + (v[i][2] + v[i][3]); }
            const float mu = wave_sum(s) * (1.f / D); float qq = 0.f;
#pragma unroll
            for (int i = 0; i < 4; ++i) { v[i] = v[i] - mu; qq += (v[i][0] * v[i][0] + v[i][1] * v[i][1]) + (v[i][2] * v[i][2] + v[i][3] * v[i][3]); }
            const float rs = rsqrtf(wave_sum(qq) * (1.f / D) + EPS);
#pragma unroll
            for (int i = 0; i < 4; ++i) { const int k = (i * 64 + lane) * 4; const f32x4 gg = *(const f32x4*)(A.clg + k), bb = *(const f32x4*)(A.clb + k); float y[4];
#pragma unroll
                for (int j = 0; j < 4; ++j) { const float z = v[i][j] * rs * gg[j] + bb[j]; y[j] = z * fast_sigmoid(z); }
                *(unsigned*)(CV + (size_t)(row0 + t) * D + k) = (unsigned)att::pk4_fp8(y[0] * 16.f, y[1] * 16.f, y[2] * 16.f, y[3] * 16.f); }
        }
    }
}
typedef float f32x32v __attribute__((ext_vector_type(32)));
typedef _Float16 f16x32v __attribute__((ext_vector_type(32)));
typedef _Float16 f16x2v __attribute__((ext_vector_type(2)));
__device__ __forceinline__ unsigned pk_f16(float a, float b) { const f16x2v h = {(_Float16)a, (_Float16)b}; return __builtin_bit_cast(unsigned, h); }
struct EpiInProj {
    static constexpr bool PERM = true;
    unsigned char* ws;
    __device__ __forceinline__ void operator()(f32x4 (&acc)[2][2][4][2], const pg8::Unit& u, int wr, int wc, int fr, int fq) const {
        const int c8 = wc * 32 + 8 * fq;
#pragma unroll
        for (int ai = 0; ai < 2; ++ai)
#pragma unroll
            for (int m = 0; m < 4; ++m) {
                const int row = u.pm * 256 + ai * 128 + wr * 64 + m * 16 + fr;
                if (u.kind == 0) {
                    bf16_t* p = (bf16_t*)(ws + WS_Q) + (size_t)row * D + u.pn * 256 + c8;
#pragma unroll
                    for (int bj = 0; bj < 2; ++bj) { const f32x4 v0 = acc[ai][bj][m][0], v1 = acc[ai][bj][m][1];
                        u32x4 w = {cvt_pk_bf16(v0[0], v0[1]), cvt_pk_bf16(v0[2], v0[3]), cvt_pk_bf16(v1[0], v1[1]), cvt_pk_bf16(v1[2], v1[3])}; *(u32x4*)(p + bj * 128) = w; }
                } else if (u.kind == 1 || u.kind == 2 || u.kind == 5 || u.kind == 6) {
                    const bool ctxu = u.kind >= 5;
                    const int kvrow = ctxu ? (row >> 8) * SKV + S + (row & 255) : (row >> 12) * SKV + (row & (S - 1));
                    bf16_t* p = (bf16_t*)(ws + ((u.kind == 1 || u.kind == 5) ? WS_KB : WS_VB)) + (size_t)kvrow * 256 + c8;
#pragma unroll
                    for (int bj = 0; bj < 2; ++bj) { const f32x4 v0 = acc[ai][bj][m][0], v1 = acc[ai][bj][m][1];
                        u32x4 w = {cvt_pk_bf16(v0[0], v0[1]), cvt_pk_bf16(v0[2], v0[3]), cvt_pk_bf16(v1[0], v1[1]), cvt_pk_bf16(v1[2], v1[3])}; *(u32x4*)(p + bj * 128) = w; }
                } else if (u.kind == 3) {
                    float g[8];
#pragma unroll
                    for (int n = 0; n < 2; ++n)
#pragma unroll
                        for (int j = 0; j < 4; ++j) g[4 * n + j] = acc[ai][0][m][n][j] * fast_sigmoid(acc[ai][1][m][n][j]);
                    u32x4 w = {cvt_pk_bf16(g[0], g[1]), cvt_pk_bf16(g[2], g[3]), cvt_pk_bf16(g[4], g[5]), cvt_pk_bf16(g[6], g[7])};
                    *(u32x4*)((bf16_t*)(ws + WS_G) + (size_t)row * D + (u.pn - 6) * 128 + c8) = w;
                } else {
                    float rt[8], sg[8];
#pragma unroll
                    for (int n = 0; n < 2; ++n)
#pragma unroll
                        for (int j = 0; j < 4; ++j) { const float ea = __builtin_amdgcn_exp2f(-1.4426950408889634f * acc[ai][0][m][n][j]), ec = __builtin_amdgcn_exp2f(-1.4426950408889634f * acc[ai][1][m][n][j]);
                            sg[4 * n + j] = __builtin_amdgcn_rcpf(1.f + ec); rt[4 * n + j] = (1.f + ec) * __builtin_amdgcn_rcpf(1.f + ea); }
                    const size_t off = (size_t)row * D + (u.pn - 14) * 128 + c8;
                    u32x4 w = {cvt_pk_bf16(rt[0], rt[1]), cvt_pk_bf16(rt[2], rt[3]), cvt_pk_bf16(rt[4], rt[5]), cvt_pk_bf16(rt[6], rt[7])}; *(u32x4*)((bf16_t*)(ws + WS_RT) + off) = w;
                    u32x4 w2 = {cvt_pk_bf16(sg[0], sg[1]), cvt_pk_bf16(sg[2], sg[3]), cvt_pk_bf16(sg[4], sg[5]), cvt_pk_bf16(sg[6], sg[7])}; *(u32x4*)((bf16_t*)(ws + WS_SGC) + off) = w2;
                }
            }
    }
};
struct SchedInProj {
    const char* hx; const char* hc; const char* w; int G, c;
    __device__ __forceinline__ bool next(int i, pg8::Unit& u) const {
        constexpr int nM = M / 256, nN = INW / 256, NMAIN = nM * nN, NCTX = (MC / 256) * 2;
        const int L = i * G + c; if (L >= NMAIN + NCTX) return false;
        if (L < NMAIN) { pg8::tile_of(L, nM, nN, u.pm, u.pn); u.a = hx + (size_t)u.pm * 256 * D; u.kind = u.pn < 4 ? 0 : (u.pn == 4 ? 1 : (u.pn == 5 ? 2 : (u.pn < 14 ? 3 : 4))); }
        else { const int j = L - NMAIN; u.pm = j >> 1; u.pn = 4 + (j & 1); u.a = hc + (size_t)u.pm * 256 * D; u.kind = 5 + (j & 1); }
        u.b = w + (size_t)u.pn * 256 * D; u.keep = 0; return true;
    }
};
struct EpiMerge {
    static constexpr bool PERM = true;
    unsigned char* ws;
    __device__ __forceinline__ void operator()(f32x4 (&acc)[2][2][4][2], const pg8::Unit& u, int wr, int wc, int fr, int fq) const {
        const int c8 = u.pn * 256 + wc * 32 + 8 * fq;
        const bf16_t* __restrict__ F = (const bf16_t*)(ws + (u.kind == 0 ? WS_RT : WS_SGC));
#pragma unroll
        for (int ai = 0; ai < 2; ++ai)
#pragma unroll
            for (int m = 0; m < 4; ++m) { const size_t off = (size_t)(u.pm * 256 + ai * 128 + wr * 64 + m * 16 + fr) * D + c8;
#pragma unroll
                for (int bj = 0; bj < 2; ++bj) { const u32x4 f = *(const u32x4*)(F + off + bj * 128);
                    f32x4 v0 = acc[ai][bj][m][0], v1 = acc[ai][bj][m][1];
                    v0[0] *= bf_lo(f[0]); v0[1] *= bf_hi(f[0]); v0[2] *= bf_lo(f[1]); v0[3] *= bf_hi(f[1]); v1[0] *= bf_lo(f[2]); v1[1] *= bf_hi(f[2]); v1[2] *= bf_lo(f[3]); v1[3] *= bf_hi(f[3]);
                    if (u.kind == 0) { acc[ai][bj][m][0] = v0; acc[ai][bj][m][1] = v1; }
                    else { u32x2 w = {(unsigned)att::pk4_fp8(v0[0] * 16.f, v0[1] * 16.f, v0[2] * 16.f, v0[3] * 16.f), (unsigned)att::pk4_fp8(v1[0] * 16.f, v1[1] * 16.f, v1[2] * 16.f, v1[3] * 16.f)}; *(u32x2*)(ws + WS_G + off + bj * 128) = w; } } }
    }
};
struct SchedMerge {
    const char* att; const char* cv; const char* wa; const char* wc; int G, c;
    __device__ __forceinline__ bool next(int i, pg8::Unit& u) const {
        constexpr int nM = M / 256, nN = D / 256;
        const int L = (i >> 1) * G + c, sub = i & 1; if (L >= nM * nN) return false;
        pg8::tile_of(L, nM, nN, u.pm, u.pn);
        u.a = (sub ? cv : att) + (size_t)u.pm * 256 * D; u.b = (sub ? wc : wa) + (size_t)u.pn * 256 * D; u.kind = sub; u.keep = sub ^ 1; return true;
    }
};
struct SchedPlain {
    const char* a; const char* b; int nM, nN, G, c, rowb;
    __device__ __forceinline__ bool next(int i, pg8::Unit& u) const {
        const int L = i * G + c; if (L >= nM * nN) return false;
        pg8::tile_of(L, nM, nN, u.pm, u.pn); u.a = a + (size_t)u.pm * 256 * rowb; u.b = b + (size_t)u.pn * 256 * rowb; u.kind = 0; u.keep = 0; return true;
    }
};
struct EpiOut {
    static constexpr bool PERM = true;
    const float* __restrict__ x; const float* __restrict__ mod; const float* __restrict__ n2g; bf16_t* __restrict__ xs; bf16_t* __restrict__ xg; float* __restrict__ ssq;
    __device__ __forceinline__ void operator()(f32x4 (&acc)[2][2][4][2], const pg8::Unit& u, int wr, int wc, int fr, int fq) const {
        const int col0 = u.pn * 256 + wc * 32 + 8 * fq; const float* mb = mod + ((u.pm * 256) >> 12) * NMOD;
        f32x4 gv[2][2], nv[2][2];
#pragma unroll
        for (int bj = 0; bj < 2; ++bj)
#pragma unroll
            for (int n = 0; n < 2; ++n) { const int c = col0 + bj * 128 + n * 4; gv[bj][n] = *(const f32x4*)(mb + 2 * D + c); nv[bj][n] = *(const f32x4*)(n2g + c) * (*(const f32x4*)(mb + 4 * D + c) + 1.f); }
        f32x4 xa[2][2], xb[2][2];
#define XLOAD(dst, k) do { _Pragma("unroll") for (int bj = 0; bj < 2; ++bj) _Pragma("unroll") for (int n = 0; n < 2; ++n) \
            dst[bj][n] = *(const f32x4*)(x + (size_t)(u.pm * 256 + ((k) >> 2) * 128 + wr * 64 + ((k) & 3) * 16 + fr) * D + col0 + bj * 128 + n * 4); } while (0)
#define XDONE(src, k) do { const int ai = (k) >> 2, m = (k) & 3; const int row = u.pm * 256 + ai * 128 + wr * 64 + m * 16 + fr; const size_t off = (size_t)row * D + col0; float ss = 0.f; \
            _Pragma("unroll") for (int bj = 0; bj < 2; ++bj) { const f32x4 v0 = src[bj][0] + gv[bj][0] * acc[ai][bj][m][0], v1 = src[bj][1] + gv[bj][1] * acc[ai][bj][m][1]; \
                ss += ((v0[0] * v0[0] + v0[1] * v0[1]) + (v0[2] * v0[2] + v0[3] * v0[3])) + ((v1[0] * v1[0] + v1[1] * v1[1]) + (v1[2] * v1[2] + v1[3] * v1[3])); \
                u32x4 w = {cvt_pk_bf16(v0[0], v0[1]), cvt_pk_bf16(v0[2], v0[3]), cvt_pk_bf16(v1[0], v1[1]), cvt_pk_bf16(v1[2], v1[3])}; *(u32x4*)(xs + off + bj * 128) = w; \
                const f32x4 g0 = v0 * nv[bj][0], g1 = v1 * nv[bj][1]; \
                u32x4 w2 = {cvt_pk_bf16(g0[0], g0[1]), cvt_pk_bf16(g0[2], g0[3]), cvt_pk_bf16(g1[0], g1[1]), cvt_pk_bf16(g1[2], g1[3])}; *(u32x4*)(xg + off + bj * 128) = w2; } \
            ss += __shfl_xor(ss, 16); ss += __shfl_xor(ss, 32); if (fq == 0) ssq[(size_t)row * 16 + u.pn * 4 + wc] = ss; } while (0)
        XLOAD(xa, 0); XLOAD(xb, 1); XDONE(xa, 0); XLOAD(xa, 2); XDONE(xb, 1); XLOAD(xb, 3); XDONE(xa, 2); XLOAD(xa, 4); XDONE(xb, 3); XLOAD(xb, 5); XDONE(xa, 4); XLOAD(xa, 6); XDONE(xb, 5); XLOAD(xb, 7); XDONE(xa, 6); XDONE(xb, 7);
#undef XLOAD
#undef XDONE
    }
};
__device__ __forceinline__ float row_rstd(const float* ssq, int row) {
    const f32x4 a = *(const f32x4*)(ssq + (size_t)row * 16), b = *(const f32x4*)(ssq + (size_t)row * 16 + 4), c = *(const f32x4*)(ssq + (size_t)row * 16 + 8), d = *(const f32x4*)(ssq + (size_t)row * 16 + 12);
    const float s = ((a[0] + a[1]) + (a[2] + a[3])) + ((b[0] + b[1]) + (b[2] + b[3])) + ((c[0] + c[1]) + (c[2] + c[3])) + ((d[0] + d[1]) + (d[2] + d[3]));
    return rsqrtf(s * (1.f / D) + EPS);
}
struct EpiScores {
    static constexpr bool PERM = true;
    unsigned short* sc; const float* ssq; const float* sbias;
    __device__ __forceinline__ void operator()(f32x4 (&acc)[2][2][4][2], const pg8::Unit& u, int wr, int wc, int fr, int fq) const {
        const float* sb = sbias + ((u.pm * 256) >> 12) * PW + u.pn * 256 + wc * 32 + 8 * fq;
        f32x4 bv[2][2];
#pragma unroll
        for (int bj = 0; bj < 2; ++bj)
#pragma unroll
            for (int n = 0; n < 2; ++n) bv[bj][n] = *(const f32x4*)(sb + bj * 128 + n * 4);
#pragma unroll
        for (int ai = 0; ai < 2; ++ai)
#pragma unroll
            for (int m = 0; m < 4; ++m) { const int row = u.pm * 256 + ai * 128 + wr * 64 + m * 16 + fr; unsigned short* p = sc + (size_t)(row >> 2) * 8192 + (row & 3) * 8; const float rs = row_rstd(ssq, row);
#pragma unroll
                for (int bj = 0; bj < 2; ++bj) { const int grp = u.pn * 2 + bj, nq = wc * 4 + fq; const f32x4 v0 = acc[ai][bj][m][0] * rs + bv[bj][0], v1 = acc[ai][bj][m][1] * rs + bv[bj][1];
                    u32x4 w = {pk_f16(v0[0], v0[1]), pk_f16(v0[2], v0[3]), pk_f16(v1[0], v1[1]), pk_f16(v1[2], v1[3])}; *(u32x4*)(p + (grp * 16 + nq) * 32) = w; } }
    }
};

#ifndef PROBE_HALFKEYS
#define PROBE_HALFKEYS 0
#endif
__device__ __forceinline__ void phase_attn(const Args& A, unsigned char* lds) {
    const int G = gridDim.x, X = blockIdx.x & 7, j = blockIdx.x >> 3, perx = G >> 3;
    bf16_t* Q = (bf16_t*)(A.ws + WS_Q); const unsigned char* K8 = A.ws + WS_K8; const unsigned char* VT8 = A.ws + WS_VT8;
    const float* cs = (const float*)(A.ws + WS_ROPE); const float* sn = cs + 2048;
    for (int idx = j; idx < 128; idx += perx) {
        const int grp = 2 * X + (idx >> 6), uu = idx & 63, b = grp >> 1, kv = grp & 1, h = kv * 4 + (uu >> 4), qb = uu & 15;
        bf16_t* qp = Q + ((size_t)b * S + qb * 256) * D + h * HD;
        unsigned char* op = A.ws + WS_ATT8 + ((size_t)b * S + qb * 256) * D + h * HD;
        att::attn_unit(qp, K8 + (size_t)b * SKV * 256 + kv * HD, VT8 + (size_t)grp * (SKV / 64) * 8192, op, qb * 256, (A.dry && PROBE_HALFKEYS) ? SKV / 2 : SKV, A.qng, cs, sn, (char*)lds);
    }
}

__device__ __forceinline__ float gelu_exact(float v) {
    const float av = fabsf(v), t = __builtin_amdgcn_rcpf(av * 0.2316418882f + 1.0f);
    float q = t * 0.5307027145f + (-0.7265760135f); q = q * t + 0.7107068705f; q = q * t + (-0.142248368f); q = q * t + 0.127414796f; q = q * t;
    const float e = __builtin_amdgcn_exp2f((v * v) * (-0.72134752044f));
    const float m = v * (q * e);
    return v < 0.f ? m : v - m;
}
__device__ __forceinline__ void ins16(float (&t)[16], float v) {
#pragma unroll
    for (int i = 15; i >= 1; --i) t[i] = __builtin_amdgcn_fmed3f(t[i - 1], t[i], v);
    t[0] = fmaxf(t[0], v);
}

__device__ __forceinline__ float key_tag(float v, unsigned keepmask, unsigned tag) { return __uint_as_float((__float_as_uint(v) & keepmask) | tag); }
template <int I, int J> struct CandLoop {
    static __device__ __forceinline__ void run(const float (&a)[16], const float (&b)[16], float (&c)[16]) {
        if constexpr ((I + 1) * (J + 1) <= 16) { ins16(c, key_tag(a[I] + b[J], ~255u, 255u - (unsigned)(I * 16 + J))); CandLoop<I, J + 1>::run(a, b, c); }
        else if constexpr (I + 1 < 16) CandLoop<I + 1, 0>::run(a, b, c);
    }
};
__device__ __forceinline__ void phase_peer_u(const Args& A, LAS unsigned char* lds) {
    const int lane = threadIdx.x & 63, wave = threadIdx.x >> 6, gw = blockIdx.x * NWAVES + wave, NGW = gridDim.x * NWAVES;
    LAS unsigned char* wl = lds + wave * 10240;
    LAS float* topL = (LAS float*)wl; LAS int* eidA = (LAS int*)(wl + 4096); LAS float* wgtA = (LAS float*)(wl + 6144); LAS float* coefL = (LAS float*)(wl + 8192);
    LAS float* suL = (LAS float*)(wl + 8704); LAS float* svL = (LAS float*)(wl + 9216);
    const unsigned short* SC = (const unsigned short*)(A.ws + WS_SC); const bf16_t* HX = (const bf16_t*)(A.ws + WS_HX);
    const unsigned char* UT = A.ws + WS_UT; const float* SU = (const float*)(A.ws + WS_UT + WS_TSCALE); const float* SVs = (const float*)(A.ws + WS_VT + WS_TSCALE);
    const float* mod = (const float*)(A.ws + WS_MOD);
    int* PE = (int*)(A.ws + WS_PE); float* PC = (float*)(A.ws + WS_PC);
    const float NEG = -3.0e38f;
    const int h = lane >> 3, tk = (lane >> 1) & 3, p = lane & 1, grp = 2 * h + p;
    for (int pass = gw; pass < M / 4; pass += NGW) {
        {
            float t[16];
#pragma unroll
            for (int i = 0; i < 16; ++i) t[i] = NEG;
            const unsigned short* sp = SC + (size_t)pass * 8192 + (grp * 64 + tk) * 8;
            u32x4 sv[16];
#pragma unroll
            for (int i = 0; i < 16; ++i) sv[i] = *(const u32x4*)(sp + i * 32);
#pragma unroll
            for (int i = 0; i < 16; ++i)
#pragma unroll
                for (int q = 0; q < 4; ++q) { const unsigned w = sv[i][q]; const f16x2v hv = __builtin_bit_cast(f16x2v, w); const unsigned tg = 127u - (unsigned)(8 * i + 2 * q);
                    ins16(t, __uint_as_float(__float_as_uint((float)hv[0]) | tg)); ins16(t, __uint_as_float(__float_as_uint((float)hv[1]) | (tg - 1u))); }
            float pb[16];
#pragma unroll
            for (int i = 0; i < 16; ++i) { pb[i] = __shfl_xor(t[i], 1); topL[i * 64 + lane] = t[i]; }
            float c[16];
#pragma unroll
            for (int i = 0; i < 16; ++i) c[i] = NEG;
            CandLoop<0, 0>::run(t, pb, c);
            float e[16]; float es = 0.f;
#pragma unroll
            for (int k = 0; k < 16; ++k) { e[k] = __expf(c[k] - c[0]); es += e[k]; }
            const float inv = __builtin_amdgcn_rcpf(es);
            asm volatile("s_waitcnt lgkmcnt(0)" ::: "memory");
            if (p == 0) {
#pragma unroll
                for (int k = 0; k < 16; ++k) { const unsigned code = 255u - (__float_as_uint(c[k]) & 255u);
                    const unsigned ia = 127u - (__float_as_uint(topL[(code >> 4) * 64 + lane]) & 127u), ib = 127u - (__float_as_uint(topL[(code & 15u) * 64 + lane + 1]) & 127u);
                    eidA[tk * 128 + h * 16 + k] = (int)(ia * 128u + ib); wgtA[tk * 128 + h * 16 + k] = e[k] * inv; }
            }
            asm volatile("s_waitcnt lgkmcnt(0)" ::: "memory");
        }
#pragma unroll 1
        for (int tq = 0; tq < 4; ++tq) {
            const int t = pass * 4 + tq; const LAS int* eidL = eidA + tq * 128; const LAS float* wgtL = wgtA + tq * 128;
            const int g = lane & 31, hh = lane >> 5;
            f16x2v xh[16];
            { const float rs = row_rstd((const float*)(A.ws + WS_SSQ), t); const float* sh = mod + (t >> 12) * NMOD + 3 * D + g * 32; const bf16_t* xp = HX + (size_t)t * D + g * 32;
#pragma unroll
              for (int c = 0; c < 4; ++c) { const u32x4 w = *(const u32x4*)(xp + 8 * c); const f32x4 s0 = *(const f32x4*)(sh + 8 * c), s1 = *(const f32x4*)(sh + 8 * c + 4);
                xh[4 * c] = (f16x2v){(_Float16)(bf_lo(w[0]) * rs + s0[0]), (_Float16)(bf_hi(w[0]) * rs + s0[1])}; xh[4 * c + 1] = (f16x2v){(_Float16)(bf_lo(w[1]) * rs + s0[2]), (_Float16)(bf_hi(w[1]) * rs + s0[3])};
                xh[4 * c + 2] = (f16x2v){(_Float16)(bf_lo(w[2]) * rs + s1[0]), (_Float16)(bf_hi(w[2]) * rs + s1[1])}; xh[4 * c + 3] = (f16x2v){(_Float16)(bf_lo(w[3]) * rs + s1[2]), (_Float16)(bf_hi(w[3]) * rs + s1[3])}; } }
            { const int i0 = eidL[lane], i1 = eidL[64 + lane]; suL[lane] = SU[i0]; suL[64 + lane] = SU[i1]; svL[lane] = SVs[i0]; svL[64 + lane] = SVs[i1]; }
            u32x6 rb0[4], rb1[4], rb2[4], rb3[4];
#define LOAD8(buf, TB, hb) do { _Pragma("unroll") for (int r = 0; r < 4; ++r) { const int id = eidL[(hb) * 8 + 2 * r + hh]; const unsigned char* rp = (TB) + (size_t)id * ROWB; \
                const u32x4 lo = *(const u32x4*)(rp + g * 16); const u32x2 hi2 = *(const u32x2*)(rp + 512 + g * 8); buf[r] = (u32x6){lo[0], lo[1], lo[2], lo[3], hi2[0], hi2[1]}; } } while (0)
#define DOT8(buf, off) do { _Pragma("unroll") for (int r = 0; r < 4; ++r) { const f16x32v dq = __builtin_amdgcn_cvt_scalef32_pk32_f16_fp6(buf[r], 1.0f); \
                float sa = 0.f, sb = 0.f, sc = 0.f, sd = 0.f;     \
                _Pragma("unroll") for (int j = 0; j < 16; j += 4) { sa = __builtin_amdgcn_fdot2((f16x2v){dq[2 * j], dq[2 * j + 1]}, xh[j], sa, false); sb = __builtin_amdgcn_fdot2((f16x2v){dq[2 * j + 2], dq[2 * j + 3]}, xh[j + 1], sb, false); \
                    sc = __builtin_amdgcn_fdot2((f16x2v){dq[2 * j + 4], dq[2 * j + 5]}, xh[j + 2], sc, false); sd = __builtin_amdgcn_fdot2((f16x2v){dq[2 * j + 6], dq[2 * j + 7]}, xh[j + 3], sd, false); } \
                pp[(off) + r] = (sa + sb) + (sc + sd); } } while (0)
#define REDUCE16(kb) do { \
            _Pragma("unroll") for (int e = 0; e < 4; ++e) { const bool up = lane & 16; const float keep = up ? pp[e + 4] : pp[e], send = up ? pp[e] : pp[e + 4]; pp[e] = keep + __shfl_xor(send, 16); } \
            _Pragma("unroll") for (int e = 0; e < 2; ++e) { const bool up = lane & 8; const float keep = up ? pp[e + 2] : pp[e], send = up ? pp[e] : pp[e + 2]; pp[e] = keep + __shfl_xor(send, 8); } \
            { const bool up = lane & 4; const float keep = up ? pp[1] : pp[0], send = up ? pp[0] : pp[1]; pp[0] = keep + __shfl_xor(send, 4); } \
            float hsum = pp[0]; hsum += __shfl_xor(hsum, 2); hsum += __shfl_xor(hsum, 1); \
            const int ke = (kb) * 16 + 2 * ((lane >> 2) & 7) + hh; const float su = suL[ke], sv = svL[ke]; \
            const float cf = wgtL[ke] * gelu_exact(hsum * su) * sv; if ((lane & 3) == 0) coefL[ke] = cf; } while (0)
            float pp[8];
            LOAD8(rb0, UT, 0); LOAD8(rb1, UT, 1); LOAD8(rb2, UT, 2);
            LOAD8(rb3, UT, 3); DOT8(rb0, 0);
            LOAD8(rb0, UT, 4); DOT8(rb1, 4); REDUCE16(0);
            LOAD8(rb1, UT, 5); DOT8(rb2, 0);
            LOAD8(rb2, UT, 6); DOT8(rb3, 4); REDUCE16(1);
            LOAD8(rb3, UT, 7); DOT8(rb0, 0);
            LOAD8(rb0, UT, 8); DOT8(rb1, 4); REDUCE16(2);
            LOAD8(rb1, UT, 9); DOT8(rb2, 0);
            LOAD8(rb2, UT, 10); DOT8(rb3, 4); REDUCE16(3);
            LOAD8(rb3, UT, 11); DOT8(rb0, 0);
            LOAD8(rb0, UT, 12); DOT8(rb1, 4); REDUCE16(4);
            LOAD8(rb1, UT, 13); DOT8(rb2, 0);
            LOAD8(rb2, UT, 14); DOT8(rb3, 4); REDUCE16(5);
            LOAD8(rb3, UT, 15); DOT8(rb0, 0);
            DOT8(rb1, 4); REDUCE16(6);
            DOT8(rb2, 0);
            DOT8(rb3, 4); REDUCE16(7);
#undef LOAD8
#undef DOT8
#undef REDUCE16
            asm volatile("s_waitcnt lgkmcnt(0)" ::: "memory");
            PE[(size_t)t * 128 + lane] = eidL[lane]; PE[(size_t)t * 128 + 64 + lane] = eidL[64 + lane];
            PC[(size_t)t * 128 + lane] = coefL[lane]; PC[(size_t)t * 128 + 64 + lane] = coefL[64 + lane];
        }
    }
}
__device__ __forceinline__ void phase_peer_v(const Args& A, LAS unsigned char* lds) {
    const int lane = threadIdx.x & 63, wave = threadIdx.x >> 6, gw = blockIdx.x * NWAVES + wave, NGW = gridDim.x * NWAVES;
    LAS int* eidL = (LAS int*)(lds + wave * 1024); LAS float* coefL = (LAS float*)(lds + wave * 1024 + 512);
    const unsigned char* VT = A.ws + WS_VT; const float* mod = (const float*)(A.ws + WS_MOD);
    const int* PE = (const int*)(A.ws + WS_PE); const float* PC = (const float*)(A.ws + WS_PC);
    const int g = lane & 31, hh = lane >> 5;
    int pe0 = 0, pe1 = 0; float pc0 = 0.f, pc1 = 0.f;
    if (gw < M) { pe0 = PE[(size_t)gw * 128 + lane]; pe1 = PE[(size_t)gw * 128 + 64 + lane]; pc0 = PC[(size_t)gw * 128 + lane]; pc1 = PC[(size_t)gw * 128 + 64 + lane]; }
    for (int t = gw; t < M; t += NGW) {
        eidL[lane] = pe0; eidL[64 + lane] = pe1; coefL[lane] = pc0; coefL[64 + lane] = pc1;
        asm volatile("s_waitcnt lgkmcnt(0)" ::: "memory");
        { const int tn = t + NGW < M ? t + NGW : t; pe0 = PE[(size_t)tn * 128 + lane]; pe1 = PE[(size_t)tn * 128 + 64 + lane]; pc0 = PC[(size_t)tn * 128 + lane]; pc1 = PC[(size_t)tn * 128 + 64 + lane]; }
        u32x4 xsw[2];
        { const bf16_t* xrow = (const bf16_t*)(A.ws + WS_XSB) + (size_t)t * D + g * 32 + hh * 16; xsw[0] = *(const u32x4*)xrow; xsw[1] = *(const u32x4*)(xrow + 8); }
        u32x6 rb0[4], rb1[4], rb2[4], rb3[4];
#define LOAD8(buf, hb) do { _Pragma("unroll") for (int r = 0; r < 4; ++r) { const int id = eidL[(hb) * 8 + 2 * r + hh]; const unsigned char* rp = VT + (size_t)id * ROWB; \
            const u32x4 lo = *(const u32x4*)(rp + g * 16); const u32x2 hi2 = *(const u32x2*)(rp + 512 + g * 8); buf[r] = (u32x6){lo[0], lo[1], lo[2], lo[3], hi2[0], hi2[1]}; } } while (0)
#define VACC8(buf, hb) do { _Pragma("unroll") for (int r = 0; r < 4; ++r) { const _Float16 ch = (_Float16)coefL[(hb) * 8 + 2 * r + hh]; const f16x2v cf2 = {ch, ch}; \
            const f16x32v dq = __builtin_amdgcn_cvt_scalef32_pk32_f16_fp6(buf[r], 1.0f); \
            _Pragma("unroll") for (int j = 0; j < 16; ++j) yh[j] = cf2 * (f16x2v){dq[2 * j], dq[2 * j + 1]} + yh[j]; } } while (0)
        f16x2v yh[16];
#pragma unroll
        for (int j = 0; j < 16; ++j) yh[j] = (f16x2v){(_Float16)0.f, (_Float16)0.f};
        LOAD8(rb0, 0); LOAD8(rb1, 1); LOAD8(rb2, 2);
        LOAD8(rb3, 3); VACC8(rb0, 0);
        LOAD8(rb0, 4); VACC8(rb1, 1);
        LOAD8(rb1, 5); VACC8(rb2, 2);
        LOAD8(rb2, 6); VACC8(rb3, 3);
        LOAD8(rb3, 7); VACC8(rb0, 4);
        LOAD8(rb0, 8); VACC8(rb1, 5);
        LOAD8(rb1, 9); VACC8(rb2, 6);
        LOAD8(rb2, 10); VACC8(rb3, 7);
        LOAD8(rb3, 11); VACC8(rb0, 8);
        LOAD8(rb0, 12); VACC8(rb1, 9);
        LOAD8(rb1, 13); VACC8(rb2, 10);
        LOAD8(rb2, 14); VACC8(rb3, 11);
        LOAD8(rb3, 15); VACC8(rb0, 12);
        VACC8(rb1, 13);
        VACC8(rb2, 14);
        VACC8(rb3, 15);
#undef LOAD8
#undef VACC8
        float yy[16];
#pragma unroll
        for (int j = 0; j < 16; ++j) { const float y0 = (float)yh[j][0], y1 = (float)yh[j][1]; const float a = y0 + __shfl_xor(y0, 32), b = y1 + __shfl_xor(y1, 32); if ((j >> 3) == hh) { yy[2 * (j & 7)] = a; yy[2 * (j & 7) + 1] = b; } }
        const float* g2 = mod + (t >> 12) * NMOD + 5 * D; float* orow = A.out + (size_t)t * D;
        float z[16]; float ss = 0.f;
#pragma unroll
        for (int q = 0; q < 4; ++q) { const int k = g * 32 + hh * 16 + q * 4; const unsigned xw0 = xsw[q >> 1][2 * (q & 1)], xw1 = xsw[q >> 1][2 * (q & 1) + 1];
            const f32x4 xv = {bf_lo(xw0), bf_hi(xw0), bf_lo(xw1), bf_hi(xw1)}, gv = *(const f32x4*)(g2 + k);
#pragma unroll
            for (int j = 0; j < 4; ++j) { const float zz = xv[j] + gv[j] * yy[q * 4 + j]; z[q * 4 + j] = zz; ss += zz * zz; } }
        const float r = rsqrtf(wave_sum(ss) * (1.f / D) + EPS);
#pragma unroll
        for (int q = 0; q < 4; ++q) { const int k = g * 32 + hh * 16 + q * 4; const f32x4 fv = *(const f32x4*)(A.fg + k);
            f32x4 o;
#pragma unroll
            for (int j = 0; j < 4; ++j) o[j] = z[q * 4 + j] * r * fv[j];
            if (!A.dry || r < 0.f) *(f32x4*)(orow + k) = o; }
    }
}
#define XB_TMO      128
#define XB_XCNT(j)  (256  + 64 * (j))
#define XB_XSUB(j)  (1280 + 64 * (j))
#define XB_XGEN(j)  (2304 + 64 * (j))
#define XB_TOP      3328
#define XB_TOPGEN   3392
#define XCD_BAR_WORDS 3456
#define XB_SPIN_CAP (1u << 22)
__device__ __forceinline__ unsigned xb_ld(unsigned* p)              { return __hip_atomic_load(p, __ATOMIC_RELAXED, __HIP_MEMORY_SCOPE_AGENT); }
__device__ __forceinline__ unsigned xb_add(unsigned* p, unsigned v) { return __hip_atomic_fetch_add(p, v, __ATOMIC_RELAXED, __HIP_MEMORY_SCOPE_AGENT); }
__device__ __forceinline__ unsigned xb_xcc_id() { return (unsigned)__builtin_amdgcn_s_getreg((3 << 11) | 20) & 0xFu; }
#define XB_SPIN(cond, bar) do { unsigned _sp = 0; while (cond) { __builtin_amdgcn_s_sleep(1); \
    if ((++_sp & 255u) == 0u) { if (xb_ld(&(bar)[XB_TMO])) break; if (_sp > XB_SPIN_CAP) { atomicAdd(&(bar)[XB_TMO], 1u); break; } } } } while (0)
struct XcdBarrier { unsigned* bar; unsigned x; volatile LAS unsigned* st; };
__device__ __forceinline__ XcdBarrier xcd_barrier_post(unsigned* bar, volatile LAS unsigned* st) {
    XcdBarrier b; b.bar = bar; b.x = xb_xcc_id(); b.st = st;
    if (threadIdx.x == 0) (void)xb_add(&bar[XB_XCNT(b.x)], 1u);
    return b;
}
__device__ __forceinline__ void xcd_barrier_complete(unsigned* bar, unsigned x, unsigned& nloc, unsigned& nx) {
    const unsigned G = gridDim.x * gridDim.y * gridDim.z;
    unsigned sum, cnt, mine, sp = 0u;
    for (;;) {
        sum = 0u; cnt = 0u; mine = 0u;
#pragma unroll
        for (unsigned j = 0; j < 16; ++j) { const unsigned c = xb_ld(&bar[XB_XCNT(j)]); sum += c; cnt += (c > 0u) ? 1u : 0u; mine = (j == x) ? c : mine; }
        if (sum == G) break;
        __builtin_amdgcn_s_sleep(1);
        if ((++sp & 255u) == 0u) { if (xb_ld(&bar[XB_TMO])) break; if (sp > XB_SPIN_CAP) { atomicAdd(&bar[XB_TMO], 1u); break; } }
    }
    nloc = mine > 0u ? mine : 1u; nx = cnt > 0u ? cnt : 1u;
}
__device__ __forceinline__ void xcd_barrier(const XcdBarrier& b) {
    asm volatile("s_waitcnt vmcnt(0)" ::: "memory");
    __syncthreads();
    if (threadIdx.x == 0) {
        unsigned* bar = b.bar;
        __builtin_amdgcn_s_waitcnt(0);
        unsigned nloc = b.st[0], nx = b.st[1];
        if (nloc == 0u) { xcd_barrier_complete(bar, b.x, nloc, nx); b.st[0] = nloc; b.st[1] = nx; }
        const unsigned old = xb_add(&bar[XB_XSUB(b.x)], 1u);
        const unsigned gen = old / nloc;
        if (old + 1u == (gen + 1u) * nloc) {
            __builtin_amdgcn_fence(__ATOMIC_RELEASE, "agent");
            asm volatile("s_waitcnt vmcnt(0)" ::: "memory");
            const unsigned og = xb_add(&bar[XB_TOP], 1u);
            const unsigned tg = og / nx;
            if (og + 1u == (tg + 1u) * nx) xb_add(&bar[XB_TOPGEN], 1u);
            else XB_SPIN(xb_ld(&bar[XB_TOPGEN]) == tg, bar);
            __builtin_amdgcn_fence(__ATOMIC_ACQUIRE, "agent");
            xb_add(&bar[XB_XGEN(b.x)], 1u);
            asm volatile("s_waitcnt vmcnt(0)" ::: "memory");
        } else {
            XB_SPIN(xb_ld(&bar[XB_XGEN(b.x)]) == gen, bar);
            __builtin_amdgcn_fence(__ATOMIC_ACQUIRE, "agent");
            asm volatile("s_waitcnt vmcnt(0)" ::: "memory");
        }
    }
    __syncthreads();
}
constexpr int MISC_OFF = 135168;

constexpr int N_PHASES = 10;
__global__ void __launch_bounds__(NWAVES * 64, 2) mega_fwd(Args A) {
    extern __shared__ __attribute__((aligned(16))) unsigned char lds[];
    LAS unsigned char* L = (LAS unsigned char*)lds;
    cg::grid_group grid = cg::this_grid();
    const int lo = A.ph_lo, hi = A.ph_hi, G = gridDim.x, c = blockIdx.x;
#ifndef PH_MASK
#define PH_MASK 0x3FF
#endif
#define IN(k) (((PH_MASK >> (k)) & 1) && lo <= (k) && (k) < hi)
    unsigned* barw = (unsigned*)(A.ws + WS_CTL);
    volatile LAS unsigned* MISC = (volatile LAS unsigned*)(L + MISC_OFF);
    if (threadIdx.x < 2) MISC[threadIdx.x] = 0u;
    if (lo == 0 && hi > 1 && blockIdx.x == 0) for (int i = threadIdx.x; i < XCD_BAR_WORDS; i += NWAVES * 64) barw[i] = 0u;
    XcdBarrier xb; xb.bar = barw; xb.x = 0; xb.st = MISC;
#define SEAM(k) do { if (IN(k) && IN((k) + 1)) { if ((k) == 0) { grid.sync(); xb = xcd_barrier_post(barw, MISC); } else xcd_barrier(xb); } } while (0)
    if (IN(0)) phase_prologue(A, L);
    SEAM(0);
    if (IN(1)) phase_hx(A);
    SEAM(1);
    if (IN(2)) { SchedInProj Sd{(const char*)(A.ws + WS_HX), (const char*)(A.ws + WS_HC), (const char*)(A.ws + WS_WIN), G, c}; EpiInProj E{A.ws};
        pg8::gemm_phase<EpiInProj, SchedInProj, true, true>(L, D / 2, Sd, E); }
    SEAM(2);
    if (IN(3)) { phase_kfix(A); phase_vt(A, L); __syncthreads(); phase_conv(A, L); }
    SEAM(3);
    if (IN(4)) phase_attn(A, lds);
    SEAM(4);
    if (IN(5)) { SchedMerge Sd{(const char*)(A.ws + WS_ATT8), (const char*)(A.ws + WS_HX), (const char*)(A.ws + WS_WA), (const char*)(A.ws + WS_WC), G, c}; EpiMerge E{A.ws};
        pg8::gemm_phase<EpiMerge, SchedMerge, true, true>(L, D / 2, Sd, E); }
    SEAM(5);
    if (IN(6)) { SchedPlain Sd{(const char*)(A.ws + WS_G), (const char*)(A.ws + WS_WO), M / 256, D / 256, G, c, D};
        EpiOut E{A.x, (const float*)(A.ws + WS_MOD), A.n2g, (bf16_t*)(A.ws + WS_XSB), (bf16_t*)(A.ws + WS_HX), (float*)(A.ws + WS_SSQ)};
        pg8::gemm_phase<EpiOut, SchedPlain, true, true>(L, D / 2, Sd, E); }
    SEAM(6);
    if (IN(7)) { SchedPlain Sd{(const char*)(A.ws + WS_HX), (const char*)(A.ws + WS_WP), M / 256, PW / 256, G, c, 2 * D};
        EpiScores E{(unsigned short*)(A.ws + WS_SC), (const float*)(A.ws + WS_SSQ), (const float*)(A.ws + WS_SBIAS)};
        pg8::gemm_phase<EpiScores, SchedPlain, true>(L, D, Sd, E); }
    SEAM(7);
    if (IN(8)) phase_peer_u(A, L);
    SEAM(8);
    if (IN(9)) phase_peer_v(A, L);
#undef IN
#undef SEAM
}

#ifndef MK_ONE_LAUNCH
#define MK_ONE_LAUNCH 1
#endif
extern "C" void kernel_launch(void* const* d_in, const int* in_sizes, int n_in, void* d_out, int out_size, void* d_ws, size_t ws_size, hipStream_t stream) {
    static int grid = 0;
    if (grid == 0) {
        if (n_in != 23 || out_size != M * D || ws_size < WS_END) { fprintf(stderr, "kernel_launch: unexpected shapes (n_in %d out %d ws %zu)\n", n_in, out_size, ws_size); grid = -1; return; }
        int dev = 0, cus = 0, per_cu = 0;
        hipGetDevice(&dev); hipDeviceGetAttribute(&cus, hipDeviceAttributeMultiprocessorCount, dev);
        if (hipFuncSetAttribute((const void*)mega_fwd, hipFuncAttributeMaxDynamicSharedMemorySize, LDS_BYTES) != hipSuccess) { fprintf(stderr, "kernel_launch: hipFuncSetAttribute failed\n"); grid = -1; return; }
        if (hipOccupancyMaxActiveBlocksPerMultiprocessor(&per_cu, (const void*)mega_fwd, NWAVES * 64, LDS_BYTES) != hipSuccess || per_cu < 1) { fprintf(stderr, "kernel_launch: occupancy query says %d\n", per_cu); per_cu = 1; }
        (void)hipGetLastError();
        grid = cus * 1;
        if (per_cu < 1) grid = -1;
    }
    if (grid < 0) return;
    Args a{};
    const float** f = (const float**)&a;
    for (int i = 0; i < 23; ++i) f[i] = (const float*)d_in[i];
    a.out = (float*)d_out; a.ws = (unsigned char*)d_ws;
#if MK_ONE_LAUNCH
    a.ph_lo = 0; a.ph_hi = N_PHASES;
    void* args[] = {&a};
    hipError_t e = hipLaunchCooperativeKernel((const void*)mega_fwd, dim3(grid), dim3(NWAVES * 64), args, LDS_BYTES, stream);
    if (e != hipSuccess) fprintf(stderr, "cooperative launch failed: %s (grid %d)\n", hipGetErrorString(e), grid);
#else
#ifndef REPEAT_PH
#define REPEAT_PH -1
#endif
    for (int p = 0; p < N_PHASES; ++p) { a.ph_lo = p; a.ph_hi = p + 1;
        if (p == REPEAT_PH) { a.dry = 1; hipLaunchKernelGGL(mega_fwd, dim3(grid), dim3(NWAVES * 64), LDS_BYTES, stream, a); a.dry = 0; }
        hipLaunchKernelGGL(mega_fwd, dim3(grid), dim3(NWAVES * 64), LDS_BYTES, stream, a); }
#endif
}
```

```cpp
#include <hip/hip_runtime.h>
#include <hip/hip_cooperative_groups.h>
#include <cstdio>
#include <cstdint>
namespace cg = cooperative_groups;

#define LAS __attribute__((address_space(3)))
typedef unsigned short bf16_t;
typedef short bf16x8 __attribute__((ext_vector_type(8)));
typedef short s16x4 __attribute__((ext_vector_type(4)));
typedef float f32x2 __attribute__((ext_vector_type(2)));
typedef float f32x4 __attribute__((ext_vector_type(4)));
typedef float f32x16 __attribute__((ext_vector_type(16)));
typedef unsigned u32x2 __attribute__((ext_vector_type(2)));
typedef unsigned u32x4 __attribute__((ext_vector_type(4)));
typedef __bf16 bf16x2_t __attribute__((ext_vector_type(2)));

constexpr int D = 1024, NB = 8, S = 4096, CTXL = 256, SKV = S + CTXL, HD = 128, HQ = 8, HKV = 2;
constexpr int M = NB * S;
constexpr int MC = NB * CTXL;
constexpr int INW = 5632, NMOD = 6144, NEXP = 16384, PW = 2048;
constexpr float EPS = 1e-6f;

__device__ __forceinline__ unsigned cvt_pk_bf16(float lo, float hi) { f32x2 v = {lo, hi}; bf16x2_t b = __builtin_convertvector(v, bf16x2_t); return __builtin_bit_cast(unsigned, b); }
__device__ __forceinline__ float bf_lo(unsigned u) { return __uint_as_float(u << 16); }
__device__ __forceinline__ float bf_hi(unsigned u) { return __uint_as_float(u & 0xffff0000u); }
__device__ __forceinline__ float fast_sigmoid(float x) { return __builtin_amdgcn_rcpf(1.f + __builtin_amdgcn_exp2f(-1.4426950408889634f * x)); }
__device__ __forceinline__ float wave_sum(float v) {
#pragma unroll
    for (int o = 1; o < 64; o <<= 1) v += __shfl_xor(v, o);
    return v;
}

namespace pg8 {
constexpr int BM = 256, BK = 64, HALF = 128, HTB = HALF * BK * 2  , STAGE_BYTES = 8 * HTB, NXCD = 8, WGM = 8;
__host__ __device__ __forceinline__ int lds_byte(int r, int c) { const int st = (r >> 4) * 2 + (c >> 5), rr = r & 15, cc = c & 31, ob = rr * 64 + cc * 2; return st * 1024 + (ob ^ (((ob >> 9) & 1) << 5)); }
__host__ __device__ __forceinline__ void stage_rc(int b, int& R, int& C) { const int st = b / 1024, sb = b % 1024, swz = sb ^ (((sb >> 9) & 1) << 5); R = (st >> 1) * 16 + swz / 64; C = (st & 1) * 32 + (swz % 64) / 2; }
__host__ __device__ __forceinline__ int perm32(int rho) { const int n = rho >> 4, i = rho & 15; return 8 * (i >> 2) + 4 * n + (i & 3); }

struct Unit { const char* a; const char* b; int pm, pn, kind, keep; };

__device__ __forceinline__ void tile_of(int L, int nM, int nN, int& pm, int& pn) {
    const int nwg = nM * nN; int wgid = L;
    { const int q = nwg / NXCD, r = nwg % NXCD, xcd = wgid % NXCD, off = wgid / NXCD; wgid = (xcd < r ? xcd * (q + 1) : r * (q + 1) + (xcd - r) * q) + off; }
    const int nig = WGM * nN, gid = wgid / nig, fm = gid * WGM, gsz = (nM - fm) < WGM ? (nM - fm) : WGM;
    pm = fm + ((wgid % nig) % gsz); pn = (wgid % nig) / gsz;
}

typedef int i32x4v __attribute__((ext_vector_type(4)));
typedef int i32x8v __attribute__((ext_vector_type(8)));
__device__ __forceinline__ i32x8v cat8(bf16x8 a, bf16x8 b) { const i32x4v x = __builtin_bit_cast(i32x4v, a), y = __builtin_bit_cast(i32x4v, b); return __builtin_shufflevector(x, y, 0, 1, 2, 3, 4, 5, 6, 7); }
__device__ __forceinline__ void mfma_f8_acc(f32x4& c, i32x8v a, i32x8v b) { asm volatile("v_mfma_f32_16x16x128_f8f6f4 %0, %1, %2, %0" : "+v"(c) : "v"(a), "v"(b)); }
template <class Epi, class Sched, bool ALIGN_EPI, bool F8 = false, bool ONEBAR = false>
__device__ __forceinline__ void gemm_phase(LAS unsigned char* lds, const int K, const Sched& S, const Epi& E) {
    const int tid = threadIdx.x, wid = __builtin_amdgcn_readfirstlane(tid >> 6), lane = tid & 63, wr = wid >> 2, wc = wid & 3, fr = lane & 15, fq = lane >> 4;
    const int nt = K / BK;
    unsigned voffA[2], voffB[2];
#pragma unroll
    for (int i = 0; i < 2; ++i) { int R, C; stage_rc(tid * 16 + i * 8192, R, C); const int Rb = Epi::PERM ? ((R & ~31) + perm32(R & 31)) : R;
        voffA[i] = (unsigned)(R * K + C) * 2u; voffB[i] = (unsigned)(Rb * K + C) * 2u; }
    const size_t kstep = (size_t)(BK * 2);
    const size_t hstep = (size_t)HALF * K * 2;
    const unsigned ldsw = (unsigned)wid * 1024u;
    const int aoff = lds_byte(wr * 64 + fr, fq * 8), boff = lds_byte(wc * 32 + fr, fq * 8);
#define PG8_SA(b, h) (((b) * 2 + (h)) * HTB)
#define PG8_SB(b, h) ((4 + (b) * 2 + (h)) * HTB)
#define PG8_STAGE(bufoff, gbase, voff) do { _Pragma("unroll") for (int _i = 0; _i < 2; ++_i) \
        __builtin_amdgcn_global_load_lds((const unsigned*)((const char*)(gbase) + (voff)[_i]), (LAS unsigned*)(lds + (bufoff) + ldsw + _i * 8192), 16, 0, 0); } while (0)
#define PG8_LDA(dst, b, h) do { _Pragma("unroll") for (int m = 0; m < 4; ++m) _Pragma("unroll") for (int k = 0; k < 2; ++k) dst[m][k] = *(const LAS bf16x8*)(lds + PG8_SA(b, h) + aoff + m * 2048 + k * 1024); } while (0)
#define PG8_LDB(dst, b, h) do { _Pragma("unroll") for (int n = 0; n < 2; ++n) _Pragma("unroll") for (int k = 0; k < 2; ++k) dst[n][k] = *(const LAS bf16x8*)(lds + PG8_SB(b, h) + boff + n * 2048 + k * 1024); } while (0)
#define PG8_MMA(ai, bj, At, Bt) do { __builtin_amdgcn_s_setprio(1); if constexpr (F8) { _Pragma("unroll") for (int m = 0; m < 4; ++m) _Pragma("unroll") for (int n = 0; n < 2; ++n) \
        mfma_f8_acc(acc[ai][bj][m][n], cat8(Bt[n][0], Bt[n][1]), cat8(At[m][0], At[m][1])); } else { \
        _Pragma("unroll") for (int m = 0; m < 4; ++m) _Pragma("unroll") for (int n = 0; n < 2; ++n) _Pragma("unroll") for (int k = 0; k < 2; ++k) \
        acc[ai][bj][m][n] = __builtin_amdgcn_mfma_f32_16x16x32_bf16(Bt[n][k], At[m][k], acc[ai][bj][m][n], 0, 0, 0); } __builtin_amdgcn_s_setprio(0); } while (0)
#define PG8_WAIT_V(n) asm volatile("s_waitcnt vmcnt(" #n ")" ::: "memory")
#define PG8_WAIT_L(n) asm volatile("s_waitcnt lgkmcnt(" #n ")" ::: "memory")
#define PG8_BAR __builtin_amdgcn_s_barrier()
#define PG8_BAR_PRE do { if constexpr (ONEBAR) { if (wr == 1) PG8_BAR; } else PG8_BAR; } while (0)
#define PG8_BAR_POST do { if constexpr (ONEBAR) { if (wr == 0) PG8_BAR; } else PG8_BAR; } while (0)
#define PG8_SCHED __builtin_amdgcn_sched_barrier(0)
    Unit cur, nxt; int ui = 0;
    if (!S.next(0, cur)) return;
    f32x4 acc[2][2][4][2];
#pragma unroll
    for (int a = 0; a < 2; ++a)
#pragma unroll
        for (int b = 0; b < 2; ++b)
#pragma unroll
            for (int m = 0; m < 4; ++m)
#pragma unroll
                for (int n = 0; n < 2; ++n) acc[a][b][m][n] = (f32x4){0.f, 0.f, 0.f, 0.f};
    bf16x8 At[4][2], B0[2][2], B1[2][2];
    const char* cA = cur.a; const char* cB = cur.b;
    PG8_STAGE(PG8_SB(0, 0), cB, voffB); PG8_STAGE(PG8_SB(0, 1), cB + hstep, voffB); PG8_STAGE(PG8_SA(0, 0), cA, voffA); PG8_STAGE(PG8_SA(0, 1), cA + hstep, voffA);
    if constexpr (!ONEBAR) { if (wr == 1) PG8_BAR; }
    PG8_WAIT_V(2); PG8_BAR;
    PG8_STAGE(PG8_SB(1, 0), cB + kstep, voffB); PG8_STAGE(PG8_SA(1, 0), cA + kstep, voffA); PG8_STAGE(PG8_SB(1, 1), cB + hstep + kstep, voffB);
    PG8_WAIT_V(6); PG8_BAR;
    for (;;) {
        const bool has_next = S.next(ui + 1, nxt);
        const char* nA = has_next ? nxt.a : cA; const char* nB = has_next ? nxt.b : cB;
#pragma unroll 1
        for (int t = 0; t < nt; t += 2) {
            const bool last = (t == nt - 2);
            const char* a1 = cA + (size_t)(t + 1) * kstep;
            const char* a2 = last ? nA : cA + (size_t)(t + 2) * kstep; const char* b2 = last ? nB : cB + (size_t)(t + 2) * kstep;
            const char* a3 = a2 + kstep; const char* b3 = b2 + kstep;
            PG8_LDB(B0, 0, 0); PG8_LDB(B1, 0, 1); PG8_SCHED; PG8_LDA(At, 0, 0); PG8_STAGE(PG8_SA(1, 1), a1 + hstep, voffA);
            PG8_WAIT_V(8); PG8_WAIT_L(0); PG8_BAR_PRE; PG8_MMA(0, 0, At, B0); PG8_MMA(0, 1, At, B1); PG8_BAR_POST; PG8_SCHED;
            PG8_LDA(At, 0, 1); PG8_STAGE(PG8_SB(0, 0), b2, voffB); PG8_STAGE(PG8_SB(0, 1), b2 + hstep, voffB); PG8_STAGE(PG8_SA(0, 0), a2, voffA);
            PG8_WAIT_V(8); PG8_WAIT_L(0); PG8_BAR_PRE; PG8_MMA(1, 0, At, B0); PG8_MMA(1, 1, At, B1); PG8_BAR_POST; PG8_SCHED;
            PG8_LDB(B0, 1, 0); PG8_LDB(B1, 1, 1); PG8_SCHED; PG8_LDA(At, 1, 0); PG8_STAGE(PG8_SA(0, 1), a2 + hstep, voffA);
            PG8_WAIT_V(8); PG8_WAIT_L(0); PG8_BAR_PRE; PG8_MMA(0, 0, At, B0); PG8_MMA(0, 1, At, B1); PG8_BAR_POST; PG8_SCHED;
            PG8_LDA(At, 1, 1); PG8_STAGE(PG8_SB(1, 0), b3, voffB); PG8_STAGE(PG8_SB(1, 1), b3 + hstep, voffB); PG8_STAGE(PG8_SA(1, 0), a3, voffA);
            PG8_WAIT_V(8); PG8_WAIT_L(0); PG8_BAR_PRE; PG8_MMA(1, 0, At, B0); PG8_MMA(1, 1, At, B1); PG8_BAR_POST; PG8_SCHED;
        }
        if constexpr (ALIGN_EPI && !ONEBAR) { if (wr == 0) PG8_BAR; }
        if constexpr (F8) { asm volatile("s_nop 15\n\ts_nop 15" ::: "memory");
            if (!cur.keep)
#pragma unroll
            for (int a = 0; a < 2; ++a)
#pragma unroll
                for (int b = 0; b < 2; ++b)
#pragma unroll
                    for (int m = 0; m < 4; ++m)
#pragma unroll
                        for (int n = 0; n < 2; ++n) acc[a][b][m][n] *= (1.f / 8192.f); }
        E(acc, cur, wr, wc, fr, fq);
        if (!has_next) break;
        if (!cur.keep) {
#pragma unroll
        for (int a = 0; a < 2; ++a)
#pragma unroll
            for (int b = 0; b < 2; ++b)
#pragma unroll
                for (int m = 0; m < 4; ++m)
#pragma unroll
                    for (int n = 0; n < 2; ++n) acc[a][b][m][n] = (f32x4){0.f, 0.f, 0.f, 0.f};
        }
        cur = nxt; cA = nA; cB = nB; ++ui;
        if constexpr (ALIGN_EPI && !ONEBAR) { if (wr == 1) PG8_BAR; }
    }
    PG8_WAIT_V(0);
    if constexpr (!ALIGN_EPI && !ONEBAR) { if (wr == 0) PG8_BAR; }
    PG8_BAR;
#undef PG8_SA
#undef PG8_SB
#undef PG8_STAGE
#undef PG8_LDA
#undef PG8_LDB
#undef PG8_MMA
#undef PG8_WAIT_V
#undef PG8_WAIT_L
#undef PG8_BAR
#undef PG8_BAR_PRE
#undef PG8_BAR_POST
#undef PG8_SCHED
}
}
namespace att {
typedef int v8i __attribute__((ext_vector_type(8)));
constexpr int NW = 8, QBLK = 32, KVBLK = 64;
constexpr float SCALE = 0.088388347648318440f;
constexpr float SC8 = SCALE / 256.f;
constexpr float THR = 3.f;
constexpr int LDQ = D, LDO = D;
constexpr int SHM_V = 8192, SHM_K = 8192, NRING = 5, OFF_K = NRING * SHM_V, OFF_WS = OFF_K + NRING * SHM_K, OST_OFF = 0, LDS_TOTAL = OFF_WS + NW * 64 * 4;
#define SBAR() __builtin_amdgcn_sched_barrier(0)
#define MFMA8(a, b, c) __builtin_amdgcn_mfma_scale_f32_32x32x64_f8f6f4((a), (b), (c), 0, 0, 0, 0x7f7f7f7f, 0, 0x7f7f7f7f)
#define MFMA8S(a, b, c) __builtin_amdgcn_mfma_scale_f32_32x32x64_f8f6f4((a), (b), (c), 0, 0, 0, 0x7f7f7f7f, 0, 0x74747474)
constexpr float QFRAC = (SCALE * 1.4426950408889634f / 256.f) * 2048.f;
constexpr float THRL = THR * 1.4426950408889634f;
__device__ __forceinline__ int crow(int r, int hi) { return (r & 3) + 8 * (r >> 2) + 4 * hi; }
__device__ __forceinline__ int k_lds(int row, int chunk) { return row * 128 + ((chunk ^ ((row >> 1) & 7)) << 4); }
__device__ __forceinline__ int v_lds(int d, int slot) { return d * 64 + ((slot ^ ((d >> 2) & 3)) << 4); }
__device__ __forceinline__ float max3f(float a, float b, float c) { float r; asm("v_max3_f32 %0, %1, %2, %3" : "=v"(r) : "v"(a), "v"(b), "v"(c)); return r; }
__device__ __forceinline__ int pk4_fp8(float a, float b, float c, float d) { int w = __builtin_amdgcn_cvt_pk_fp8_f32(a, b, 0, false); return __builtin_amdgcn_cvt_pk_fp8_f32(c, d, w, true); }

__device__ __forceinline__ void partialSM(f32x16& p0, f32x16& p1, float& m_ref, float& nm, float& alpha, bool force) {
  asm volatile("s_nop 15\n\ts_nop 7" : "+v"(p0), "+v"(p1));
  float mx[8];
#pragma unroll
  for (int i = 0; i < 8; ++i) mx[i] = max3f(p0[i], p0[8 + i], p1[i]);
  float m4[4];
#pragma unroll
  for (int i = 0; i < 4; ++i) m4[i] = max3f(mx[i], mx[4 + i], p1[8 + i]);
  float m2a = max3f(m4[0], m4[1], p1[12]), m2b = max3f(m4[2], m4[3], p1[13]);
  float pmax = max3f(m2a, m2b, p1[14]); pmax = max3f(pmax, p1[15], p1[15]);
  { auto rr = __builtin_amdgcn_permlane32_swap(__float_as_uint(pmax), __float_as_uint(pmax), false, false);
    pmax = fmaxf(__uint_as_float(rr[0]), __uint_as_float(rr[1])); }
  const float dl0 = pmax - 4.f;
  if (__builtin_expect(!force && __all(dl0 <= THRL), 1)) { alpha = 1.f; }
  else { const float dl = force ? dl0 : fmaxf(dl0, 0.f); m_ref += dl; alpha = __builtin_amdgcn_exp2f(-dl);
    nm = 4.f - m_ref;
    for (int r = 0; r < 16; ++r) { p0[r] -= dl; p1[r] -= dl; } }
  for (int r = 0; r < 16; ++r) p0[r] = __builtin_amdgcn_exp2f(p0[r]);
}
__device__ __forceinline__ void finishSM(f32x16& p0, f32x16& p1, f32x4& lacc, v8i& pa, const v8i& bones) {
  for (int r = 0; r < 16; ++r) p1[r] = __builtin_amdgcn_exp2f(p1[r]);
  pa[0] = pk4_fp8(p0[0], p0[1], p0[2], p0[3]); pa[1] = pk4_fp8(p0[4], p0[5], p0[6], p0[7]); pa[2] = pk4_fp8(p0[8], p0[9], p0[10], p0[11]); pa[3] = pk4_fp8(p0[12], p0[13], p0[14], p0[15]);
  pa[4] = pk4_fp8(p1[0], p1[1], p1[2], p1[3]); pa[5] = pk4_fp8(p1[4], p1[5], p1[6], p1[7]); pa[6] = pk4_fp8(p1[8], p1[9], p1[10], p1[11]); pa[7] = pk4_fp8(p1[12], p1[13], p1[14], p1[15]);
  lacc = __builtin_amdgcn_mfma_scale_f32_16x16x128_f8f6f4(pa, bones, lacc, 0, 4, 0, 0x7f7f7f7f, 0, 0x7f7f7f7f);
}
__device__ __forceinline__ v8i ld32(const char* p0, const char* p1) { const u32x4 a = *reinterpret_cast<const u32x4*>(p0), b = *reinterpret_cast<const u32x4*>(p1);
  v8i r; r[0] = (int)a[0]; r[1] = (int)a[1]; r[2] = (int)a[2]; r[3] = (int)a[3]; r[4] = (int)b[0]; r[5] = (int)b[1]; r[6] = (int)b[2]; r[7] = (int)b[3]; return r; }
__device__ __forceinline__ void qkt(f32x16& p0, f32x16& p1, const char* Ks, const v8i* qf, const float nm, int r32, int hi) {
  f32x16 negm;
#pragma unroll
  for (int r = 0; r < 16; ++r) negm[r] = nm;
  { const v8i a0 = ld32(Ks + k_lds(r32, hi), Ks + k_lds(r32, 2 + hi)), a1 = ld32(Ks + k_lds(32 + r32, hi), Ks + k_lds(32 + r32, 2 + hi));
    p0 = MFMA8S(a0, qf[0], negm); p1 = MFMA8S(a1, qf[0], negm); }
  { const v8i a0 = ld32(Ks + k_lds(r32, 4 + hi), Ks + k_lds(r32, 6 + hi)), a1 = ld32(Ks + k_lds(32 + r32, 4 + hi), Ks + k_lds(32 + r32, 6 + hi));
    p0 = MFMA8S(a0, qf[1], p0); p1 = MFMA8S(a1, qf[1], p1); }
}
__device__ __forceinline__ void pv(f32x16* o, const char* Vs, const v8i pa, int r32, int hi) {
#pragma unroll
  for (int d0 = 0; d0 < 4; ++d0) { const int d = 32 * d0 + r32; const v8i b = ld32(Vs + v_lds(d, 2 * hi), Vs + v_lds(d, 2 * hi + 1)); o[d0] = MFMA8(pa, b, o[d0]); }
}

__device__ __forceinline__ void attn_unit(const bf16_t* Qb, const unsigned char* __restrict__ K8, const unsigned char* __restrict__ VT, unsigned char* Ob, int t0, int seq,
                                          const float* __restrict__ qng, const float* __restrict__ cst, const float* __restrict__ snt, char* lds) {
  int tid_ = threadIdx.x; asm volatile("" : "+v"(tid_));
  const int tid = tid_, wid = tid >> 6, lane = tid & 63, r32 = lane & 31, hi = lane >> 5;
  char* V_lds = lds; char* K_lds = lds + OFF_K;
  float* ws = (float*)(lds + OFF_WS) + wid * 64; float* li_l = ws; float* al_l = ws + 32;
  float m_ref = 0.f, nm = 4.f; f32x16 o[4] = {}; v8i qf[2]; f32x4 lacc = {0.f, 0.f, 0.f, 0.f};
  const int lj = lane & 15, lq = lane >> 4, lrow = 16 * (lj & 1) + 4 * lq;
  v8i bones; { const int b01 = lj == 0 ? 0x22222222 : 0, b23 = lj == 1 ? 0x22222222 : 0;
    bones[0] = b01; bones[1] = b01; bones[2] = b23; bones[3] = b23; bones[4] = 0; bones[5] = 0; bones[6] = 0; bones[7] = 0; }
  asm volatile("" : "+v"(nm));
  {
    const bf16_t* Qw = Qb + (long)(wid * QBLK + r32) * LDQ + 16 * hi;
    float y[2][32]; float ss = 0.f;
#pragma unroll
    for (int s = 0; s < 2; ++s)
#pragma unroll
      for (int part = 0; part < 2; ++part)
#pragma unroll
        for (int c = 0; c < 2; ++c) { const u32x4 w = *reinterpret_cast<const u32x4*>(Qw + 64 * s + 32 * part + 8 * c);
#pragma unroll
          for (int j = 0; j < 4; ++j) { const float a = bf_lo(w[j]), b = bf_hi(w[j]); y[s][16 * part + 8 * c + 2 * j] = a; y[s][16 * part + 8 * c + 2 * j + 1] = b; ss += a * a + b * b; } }
    ss += __shfl_xor(ss, 32);
    const float rstd = rsqrtf(ss * (1.f / HD) + EPS) * (16.f * QFRAC);
    const int t = t0 + wid * QBLK + r32;
#pragma unroll
    for (int s = 0; s < 2; ++s) { const int pos = s == 0 ? (t >> 6) : (t & 63);
#pragma unroll
      for (int c = 0; c < 4; ++c) { const int i0 = 16 * hi + 4 * c;
        const f32x4 g1 = *reinterpret_cast<const f32x4*>(qng + 64 * s + i0), g2 = *reinterpret_cast<const f32x4*>(qng + 64 * s + 32 + i0);
        const f32x4 c4 = *reinterpret_cast<const f32x4*>(cst + pos * 32 + i0), s4 = *reinterpret_cast<const f32x4*>(snt + pos * 32 + i0);
#pragma unroll
        for (int j = 0; j < 4; ++j) { const float x1 = y[s][4 * c + j] * rstd * g1[j], x2 = y[s][16 + 4 * c + j] * rstd * g2[j]; y[s][4 * c + j] = x1 * c4[j] - x2 * s4[j]; y[s][16 + 4 * c + j] = x1 * s4[j] + x2 * c4[j]; } }
#pragma unroll
      for (int w = 0; w < 8; ++w) qf[s][w] = pk4_fp8(y[s][4 * w], y[s][4 * w + 1], y[s][4 * w + 2], y[s][4 * w + 3]); }
  }
  const int krow = tid >> 3, kch = tid & 7, kst = k_lds(krow, kch), vst = v_lds(tid >> 2, tid & 3);
  const unsigned char* kg = K8 + (long)krow * 256 + kch * 16; const unsigned char* vg = VT + tid * 16;
  struct { u32x4 k, v; } sr_[2];
#define SLOAD(i, kt) do { sr_[i].k = *reinterpret_cast<const u32x4*>(kg + (long)(kt) * (KVBLK * 256)); sr_[i].v = *reinterpret_cast<const u32x4*>(vg + (long)(kt) * 8192); } while (0)
#define SWRITE(boff, i) do { *(u32x4*)(V_lds + (boff) + vst) = sr_[i].v; *(u32x4*)(K_lds + (boff) + kst) = sr_[i].k; } while (0)
#define SWAIT() asm volatile("s_waitcnt vmcnt(2)" ::: "memory")
#define RESC(a) do { if (__any((a) < 1.f)) { if (hi == 0) al_l[r32] = (a); asm volatile("s_waitcnt lgkmcnt(0)" ::: "memory"); \
    for (int d = 0; d < 4; ++d) for (int r = 0; r < 16; ++r) o[d][r] *= al_l[crow(r, hi)]; \
    for (int e = 0; e < 4; ++e) lacc[e] *= al_l[lrow + e]; } } while (0)
  f32x16 pA0, pA1, pB0, pB1; float alA, alB; v8i pa; const int NT = seq / KVBLK;
  constexpr int SE = 0, SO = 1;
  int o_m1 = 0, o_0 = SHM_K, o_p1 = 2 * SHM_K, o_p2 = 3 * SHM_K, o_p3 = 4 * SHM_K;
#define ROT() do { const int a_ = o_m1, b_ = o_0; o_m1 = o_p1; o_0 = o_p2; o_p1 = o_p3; o_p2 = a_; o_p3 = b_; } while (0)
#define VM0() asm volatile("s_waitcnt vmcnt(0)" ::: "memory")
  SLOAD(SE, 0); VM0(); SWRITE(0, SE); __syncthreads();
  qkt(pA0, pA1, K_lds, qf, nm, r32, hi); partialSM(pA0, pA1, m_ref, nm, alA, true);
  SLOAD(SO, 1); SLOAD(SE, 2);
  VM0(); SWRITE(SHM_K, SO); SWRITE(2 * SHM_K, SE);
  if (3 < NT) SLOAD(SE, 3); if (4 < NT) SLOAD(SO, 4);
  __syncthreads();
  for (int j = 1; j + 1 < NT; j += 2) {
    SBAR(); qkt(pB0, pB1, K_lds + o_0, qf, nm, r32, hi);
    finishSM(pA0, pA1, lacc, pa, bones); SBAR();
    pv(o, V_lds + o_m1, pa, r32, hi); partialSM(pB0, pB1, m_ref, nm, alB, false);
    if (j + 2 < NT) { if (j + 3 < NT) SWAIT(); else VM0(); SWRITE(o_p2, SE); }
    if (j + 4 < NT) SLOAD(SE, j + 4);
    RESC(alB); SBAR();
    qkt(pA0, pA1, K_lds + o_p1, qf, nm, r32, hi);
    finishSM(pB0, pB1, lacc, pa, bones); SBAR();
    pv(o, V_lds + o_0, pa, r32, hi); partialSM(pA0, pA1, m_ref, nm, alA, false);
    if (j + 3 < NT) { if (j + 4 < NT) SWAIT(); else VM0(); SWRITE(o_p3, SO); }
    if (j + 5 < NT) SLOAD(SO, j + 5);
    RESC(alA); __syncthreads(); ROT();
  }
  SBAR(); qkt(pB0, pB1, K_lds + o_0, qf, nm, r32, hi);
  finishSM(pA0, pA1, lacc, pa, bones); SBAR();
  pv(o, V_lds + o_m1, pa, r32, hi); partialSM(pB0, pB1, m_ref, nm, alB, false);
  RESC(alB);
  finishSM(pB0, pB1, lacc, pa, bones); SBAR();
  pv(o, V_lds + o_0, pa, r32, hi);
  __syncthreads();
#undef VM0
#undef ROT
  if (lj < 2) { li_l[lrow] = lacc[0]; li_l[lrow + 1] = lacc[1]; li_l[lrow + 2] = lacc[2]; li_l[lrow + 3] = lacc[3]; }
  asm volatile("s_waitcnt lgkmcnt(0)" ::: "memory");
  float rli[16];
#pragma unroll
  for (int r = 0; r < 16; ++r) rli[r] = __builtin_amdgcn_rcpf(16.f * li_l[crow(r, hi)]);
  { bf16_t* stg = (bf16_t*)(lds + OST_OFF) + wid * 4096;
#pragma unroll
    for (int r = 0; r < 16; ++r) { const int orow = crow(r, hi);
#pragma unroll
      for (int d0 = 0; d0 < 4; ++d0) stg[orow * 128 + d0 * 32 + r32] = (bf16_t)(cvt_pk_bf16(o[d0][r] * rli[r], 0.f) & 0xffffu); }
    asm volatile("s_waitcnt lgkmcnt(0)" ::: "memory");
    unsigned char* Ow = Ob + (long)(wid * QBLK) * LDO;
#pragma unroll
    for (int i = 0; i < 8; ++i) { const int row = i * 4 + (lane >> 4), ch = lane & 15; const u32x4 v = *(const u32x4*)(stg + row * 128 + ch * 8);
      u32x2 w8 = {(unsigned)pk4_fp8(bf_lo(v[0]) * 16.f, bf_hi(v[0]) * 16.f, bf_lo(v[1]) * 16.f, bf_hi(v[1]) * 16.f), (unsigned)pk4_fp8(bf_lo(v[2]) * 16.f, bf_hi(v[2]) * 16.f, bf_lo(v[3]) * 16.f, bf_hi(v[3]) * 16.f)};
      *(u32x2*)(Ow + (long)row * LDO + ch * 8) = w8; }
  }
  __syncthreads();
#undef SLOAD
#undef SWRITE
#undef SWAIT
#undef RESC
}
#undef SBAR
#undef MFMA8
}
constexpr size_t MiB = 1u << 20;
constexpr size_t WS_CTL = 0, CTL_ZERO_BYTES = 64 * 1024;
constexpr size_t WS_MOD = 1 * MiB;
constexpr size_t WS_ROPE = WS_MOD + 256 * 1024;
constexpr size_t WS_SBIAS = WS_MOD + 512 * 1024;
constexpr size_t WS_HC = 2 * MiB;
constexpr size_t WS_WIN = 6 * MiB;
constexpr size_t WS_WA = 17 * MiB, WS_WC = 19 * MiB, WS_WO = 21 * MiB;
constexpr size_t WS_WP = 23 * MiB;
constexpr size_t WS_UT = 27 * MiB, WS_VT = 59 * MiB;
constexpr size_t WS_TSCALE = 16 * MiB;
constexpr size_t WS_KB = 91 * MiB, WS_VB = 108 * MiB;
constexpr size_t WS_HX = 125 * MiB;
constexpr size_t WS_ATT8 = WS_HX + 32 * MiB;
constexpr size_t WS_Q = 189 * MiB;
constexpr size_t WS_G = 253 * MiB;
constexpr size_t WS_RT = 317 * MiB;
constexpr size_t WS_XSB = WS_RT;
constexpr size_t WS_SGC = 381 * MiB;
constexpr size_t WS_SC = 189 * MiB;
constexpr size_t WS_SSQ = 445 * MiB;
constexpr size_t WS_K8 = 447 * MiB;
constexpr size_t WS_VT8 = 456 * MiB;
constexpr size_t WS_PE = 465 * MiB, WS_PC = 481 * MiB;
constexpr size_t WS_END = 497 * MiB;

constexpr int NWAVES = 8;
constexpr int LDS_BYTES = 147456;

struct Args {
    const float *x, *c, *ctx, *c_ctx, *w_mod, *b_mod, *n1g, *n2g, *w_in, *qng, *kng, *w_ao, *cdw, *cb, *clg, *clb, *w_co, *w_o, *wq, *keys, *ut, *vt, *fg;
    float* out; unsigned char* ws; int ph_lo, ph_hi, dry, pad;
};

__host__ __device__ __forceinline__ int win_row(int n) {
    if (n < 1536) return n;
    const int base = n < 3584 ? 1536 : 3584, m = n - base, half = m >> 10, idx = m & 1023;
    return base + (idx >> 7) * 256 + half * 128 + (idx & 127);
}

__device__ __forceinline__ void task_mod(const Args& A, int task, int lane, const LAS float* sc) {
    const int n0 = task * 8, col = lane & 7, kg = lane >> 3;
    float acc[9];
#pragma unroll
    for (int b = 0; b < 9; ++b) acc[b] = 0.f;
    const float* wp = A.w_mod + (size_t)kg * NMOD + n0 + col;
    for (int i0 = 0; i0 < 128; i0 += 8) {
        float w[8];
#pragma unroll
        for (int u = 0; u < 8; ++u) w[u] = wp[(size_t)(i0 + u) * 8 * NMOD];
#pragma unroll
        for (int u = 0; u < 8; ++u) { const int k = kg + 8 * (i0 + u);
#pragma unroll
            for (int b = 0; b < 9; ++b) acc[b] += sc[b * D + k] * w[u]; }
    }
#pragma unroll
    for (int b = 0; b < 9; ++b) { float v = acc[b]; v += __shfl_xor(v, 8); v += __shfl_xor(v, 16); v += __shfl_xor(v, 32); acc[b] = v; }
    if (lane < 8) { float* mod = (float*)(A.ws + WS_MOD); const float bm = A.b_mod[n0 + col];
#pragma unroll
        for (int b = 0; b < 9; ++b) mod[b * NMOD + n0 + col] = acc[b] + bm; }
}
__device__ __forceinline__ void task_transpose_f8(const float* W, int K, int N, unsigned char* WT, int k0, int n0, int row0, LAS float* scr, int lane) {
#pragma unroll 8
    for (int i = 0; i < 32; ++i) { const int kk = 2 * i + (lane >> 5); scr[kk * 33 + (lane & 31)] = W[(size_t)(k0 + kk) * N + n0 + (lane & 31)]; }
    asm volatile("s_waitcnt lgkmcnt(0)" ::: "memory");
    const int c = lane & 7;
#pragma unroll
    for (int j = 0; j < 4; ++j) { const int n = (lane >> 3) + 8 * j; const LAS float* s = scr + (8 * c) * 33 + n;
        u32x2 o = {(unsigned)att::pk4_fp8(s[0 * 33] * 512.f, s[1 * 33] * 512.f, s[2 * 33] * 512.f, s[3 * 33] * 512.f), (unsigned)att::pk4_fp8(s[4 * 33] * 512.f, s[5 * 33] * 512.f, s[6 * 33] * 512.f, s[7 * 33] * 512.f)};
        *(u32x2*)(WT + (size_t)(row0 + n) * K + k0 + 8 * c) = o; }
    asm volatile("s_waitcnt lgkmcnt(0)" ::: "memory");
}
typedef float f32x16v __attribute__((ext_vector_type(16)));
typedef unsigned u32x6 __attribute__((ext_vector_type(6)));
constexpr int ROWB = 768;
constexpr int ROWB_V = 512;
__device__ __forceinline__ void task_quant_rows4_i4(const float* src, unsigned char* dst, float* scale_out, int lane) {
    const int g = lane & 31, hh = lane >> 5;
    f32x4 v[2][8];
#pragma unroll
    for (int r = 0; r < 2; ++r)
#pragma unroll
        for (int i = 0; i < 8; ++i) v[r][i] = *(const f32x4*)(src + (size_t)(2 * r + hh) * D + g * 32 + i * 4);
#pragma unroll
    for (int r = 0; r < 2; ++r) {
        float ss = 0.f;
#pragma unroll
        for (int i = 0; i < 8; ++i) ss += (v[r][i][0] * v[r][i][0] + v[r][i][1] * v[r][i][1]) + (v[r][i][2] * v[r][i][2] + v[r][i][3] * v[r][i][3]);
#pragma unroll
        for (int o = 1; o < 32; o <<= 1) ss += __shfl_xor(ss, o);
        const float s = 0.35f * sqrtf(ss * (1.f / D)), inv = s > 0.f ? 1.f / s : 0.f;
        unsigned w[4];
#pragma unroll
        for (int d = 0; d < 4; ++d) { unsigned t = 0u;
#pragma unroll
            for (int k = 0; k < 8; ++k) { const float f = v[r][2 * d + (k >> 2)][k & 3] * inv; const int q = (int)fminf(fmaxf(rintf(f), -8.f), 7.f); t |= ((unsigned)q & 15u) << (4 * k); }
            w[d] = t; }
        *(u32x4*)(dst + (size_t)(2 * r + hh) * ROWB_V + g * 16) = (u32x4){w[0], w[1], w[2], w[3]};
        if (g == 0) scale_out[2 * r + hh] = s;
    }
}
__device__ __forceinline__ void task_quant_rows4_fp4(const float* src, unsigned char* dst, float* scale_out, int lane) {
    const int g = lane & 31, hh = lane >> 5;
    f32x4 v[2][8];
#pragma unroll
    for (int r = 0; r < 2; ++r)
#pragma unroll
        for (int i = 0; i < 8; ++i) v[r][i] = *(const f32x4*)(src + (size_t)(2 * r + hh) * D + g * 32 + i * 4);
#pragma unroll
    for (int r = 0; r < 2; ++r) {
        float am = 0.f;
#pragma unroll
        for (int i = 0; i < 8; ++i) am = fmaxf(fmaxf(am, fmaxf(fabsf(v[r][i][0]), fabsf(v[r][i][1]))), fmaxf(fabsf(v[r][i][2]), fabsf(v[r][i][3])));
#pragma unroll
        for (int o = 1; o < 32; o <<= 1) am = fmaxf(am, __shfl_xor(am, o));
        const float inv = am > 0.f ? 6.f / am : 0.f;
        unsigned w[4];
#pragma unroll
        for (int d = 0; d < 4; ++d) {
            unsigned t = 0u; const f32x4 lo = v[r][2 * d], hi = v[r][2 * d + 1];
            t = __builtin_amdgcn_cvt_scalef32_pk_fp4_f32(t, lo[0] * inv, lo[1] * inv, 1.0f, 0); t = __builtin_amdgcn_cvt_scalef32_pk_fp4_f32(t, lo[2] * inv, lo[3] * inv, 1.0f, 1);
            t = __builtin_amdgcn_cvt_scalef32_pk_fp4_f32(t, hi[0] * inv, hi[1] * inv, 1.0f, 2); t = __builtin_amdgcn_cvt_scalef32_pk_fp4_f32(t, hi[2] * inv, hi[3] * inv, 1.0f, 3);
            w[d] = t; }
        *(u32x4*)(dst + (size_t)(2 * r + hh) * ROWB_V + g * 16) = (u32x4){w[0], w[1], w[2], w[3]};
        if (g == 0) scale_out[2 * r + hh] = am * (1.f / 6.f);
    }
}
__device__ __forceinline__ bf16x8 ld8_f32_bf16(const float* p) { const f32x4 a = *(const f32x4*)p, b = *(const f32x4*)(p + 4); u32x4 w = {cvt_pk_bf16(a[0], a[1]), cvt_pk_bf16(a[2], a[3]), cvt_pk_bf16(b[0], b[1]), cvt_pk_bf16(b[2], b[3])}; return *reinterpret_cast<bf16x8*>(&w); }
__device__ __forceinline__ void task_wprime(const Args& A, int id, int lane) {
    const int hp = id >> 7, rem = id & 127, n0 = (rem >> 5) * 32, k0 = (rem & 31) * 32, r32 = lane & 31, hi = lane >> 5;
    f32x16 acc = {};
    const float* ka = A.keys + ((size_t)(hp * 128 + n0 + r32)) * 128 + hi * 8;
    const float* wb = A.wq + (size_t)(k0 + r32) * PW + hp * 128 + hi * 8;
#pragma unroll
    for (int s = 0; s < 8; ++s) acc = __builtin_amdgcn_mfma_f32_32x32x16_bf16(ld8_f32_bf16(ka + s * 16), ld8_f32_bf16(wb + s * 16), acc, 0, 0, 0);
    bf16_t* o = (bf16_t*)(A.ws + WS_WP);
#pragma unroll
    for (int r = 0; r < 16; ++r) { const int n = (r & 3) + 8 * (r >> 2) + 4 * hi; o[(size_t)(hp * 128 + n0 + n) * D + k0 + r32] = (bf16_t)(cvt_pk_bf16(acc[r], 0.f) & 0xffffu); }
}
__device__ __forceinline__ void phase_prologue(const Args& A, LAS unsigned char* lds) {
    const int tid = threadIdx.x, lane = tid & 63, wave = __builtin_amdgcn_readfirstlane(tid >> 6);
    LAS float* sc = (LAS float*)lds;
    for (int i = tid; i < 9 * D; i += 512) { const float v = i < 8 * D ? A.c[i] : A.c_ctx[i - 8 * D]; sc[i] = v / (1.f + __expf(-v)); }
    __syncthreads();
    LAS float* scr = (LAS float*)(lds + 36864 + wave * 8448);
    constexpr int T_MOD = NMOD / 8, T_WIN = (D / 64) * (INW / 32), T_SQ = (D / 64) * (D / 32), T_UV = 2 * NEXP / 4, T_WP = 2048, T_ROPE = 1;
    constexpr int NT = T_MOD + T_WIN + 3 * T_SQ + T_UV + T_WP + T_ROPE;
    const int G = gridDim.x;
    for (int task = wave * G + blockIdx.x; task < NT; task += NWAVES * G) {
        int r = task;
        if (r < T_MOD) { task_mod(A, r, lane, sc); continue; } r -= T_MOD;
        if (r < T_WIN) { const int nblk = INW / 32, kb = r / nblk, nb = r % nblk; task_transpose_f8(A.w_in, D, INW, A.ws + WS_WIN, 64 * kb, 32 * nb, win_row(32 * nb), scr, lane); continue; } r -= T_WIN;
        if (r < 3 * T_SQ) { const int wsel = r / T_SQ, q = r % T_SQ, kb = q / 32, nb = q % 32;
            const float* W = wsel == 0 ? A.w_ao : (wsel == 1 ? A.w_co : A.w_o); unsigned char* WT = A.ws + (wsel == 0 ? WS_WA : (wsel == 1 ? WS_WC : WS_WO));
            task_transpose_f8(W, D, D, WT, 64 * kb, 32 * nb, 32 * nb, scr, lane); continue; } r -= 3 * T_SQ;
        if (r < T_UV) { const int tb = r / (NEXP / 4), row = (r % (NEXP / 4)) * 4; unsigned char* tbase = A.ws + (tb ? WS_VT : WS_UT);
            if (tb) task_quant_rows4_fp4(A.vt + (size_t)row * D, tbase + (size_t)row * ROWB_V, (float*)(tbase + WS_TSCALE) + row, lane);
            else task_quant_rows4_i4(A.ut + (size_t)row * D, tbase + (size_t)row * ROWB_V, (float*)(tbase + WS_TSCALE) + row, lane);
            continue; } r -= T_UV;
        if (r < T_WP) { task_wprime(A, r, lane); continue; } r -= T_WP;
        { float* cs = (float*)(A.ws + WS_ROPE); float* sn = cs + 2048;
          for (int e = lane; e < 2048; e += 64) { const int p = e >> 5, i = e & 31; const float inv = powf(10000.f, -(float)(2 * i) / 64.f); const float a = (float)p * inv; cs[e] = cosf(a); sn[e] = sinf(a); } }
    }
}
__device__ __forceinline__ void normmod_row(const float* xr, const float* g, const float* modr, int sh_off, int sc_off, unsigned char* orow, int lane) {
    f32x4 v[4]; float ss = 0.f;
#pragma unroll
    for (int i = 0; i < 4; ++i) { v[i] = *(const f32x4*)(xr + (i * 64 + lane) * 4); ss += (v[i][0] * v[i][0] + v[i][1] * v[i][1]) + (v[i][2] * v[i][2] + v[i][3] * v[i][3]); }
    const float r = rsqrtf(wave_sum(ss) * (1.f / D) + EPS);
#pragma unroll
    for (int i = 0; i < 4; ++i) { const int k = (i * 64 + lane) * 4; const f32x4 gg = *(const f32x4*)(g + k), s1 = *(const f32x4*)(modr + sc_off + k), h1 = *(const f32x4*)(modr + sh_off + k);
        float y[4];
#pragma unroll
        for (int j = 0; j < 4; ++j) y[j] = v[i][j] * r * gg[j] * (1.f + s1[j]) + h1[j];
        *(unsigned*)(orow + k) = (unsigned)att::pk4_fp8(y[0] * 16.f, y[1] * 16.f, y[2] * 16.f, y[3] * 16.f); }
}
__device__ __forceinline__ void phase_hx(const Args& A) {
    const int lane = threadIdx.x & 63, gw = blockIdx.x * NWAVES + (threadIdx.x >> 6), NGW = gridDim.x * NWAVES;
    const float* mod = (const float*)(A.ws + WS_MOD);
    for (int m = gw; m < M + MC; m += NGW) {
        if (m < M) normmod_row(A.x + (size_t)m * D, A.n1g, mod + (m >> 12) * NMOD, 0, D, A.ws + WS_HX + (size_t)m * D, lane);
        else { const int r = m - M; normmod_row(A.ctx + (size_t)r * D, A.n1g, mod + 8 * NMOD, 0, D, A.ws + WS_HC + (size_t)r * D, lane); }
    }
    const bf16_t* WP = (const bf16_t*)(A.ws + WS_WP); float* sb = (float*)(A.ws + WS_SBIAS);
    for (int col = gw; col < PW; col += NGW) {
        const u32x4 w0 = *(const u32x4*)(WP + (size_t)col * D + lane * 16), w1 = *(const u32x4*)(WP + (size_t)col * D + lane * 16 + 8);
        float wv[16];
#pragma unroll
        for (int j = 0; j < 4; ++j) { wv[2 * j] = bf_lo(w0[j]); wv[2 * j + 1] = bf_hi(w0[j]); wv[8 + 2 * j] = bf_lo(w1[j]); wv[8 + 2 * j + 1] = bf_hi(w1[j]); }
#pragma unroll 1
        for (int b = 0; b < NB; ++b) { const float* sh = mod + b * NMOD + 3 * D + lane * 16; float s = 0.f;
#pragma unroll
            for (int q = 0; q < 4; ++q) { const f32x4 v = *(const f32x4*)(sh + 4 * q); s += v[0] * wv[4 * q] + v[1] * wv[4 * q + 1] + v[2] * wv[4 * q + 2] + v[3] * wv[4 * q + 3]; }
            s = wave_sum(s); if (lane == 0) sb[b * PW + col] = s; }
    }
}
__device__ __forceinline__ void phase_kfix(const Args& A) {
    const int lane = threadIdx.x & 63, gw = blockIdx.x * NWAVES + (threadIdx.x >> 6), NGW = gridDim.x * NWAVES, li = lane & 15, sub = lane >> 4;
    const bf16_t* KB = (const bf16_t*)(A.ws + WS_KB); const float* cs = (const float*)(A.ws + WS_ROPE); const float* sn = cs + 2048;
    constexpr int NITEM = NB * SKV * HKV;
    const f32x4 g0 = *(const f32x4*)(A.kng + li * 8), g1 = *(const f32x4*)(A.kng + li * 8 + 4);
    const f32x4 p0 = *(const f32x4*)(A.kng + (li ^ 4) * 8), p1 = *(const f32x4*)(A.kng + (li ^ 4) * 8 + 4);
    u32x4 wn = {0u, 0u, 0u, 0u};
    { const int it0 = gw * 4 + sub; if (it0 < NITEM) wn = *(const u32x4*)(KB + (size_t)(it0 >> 1) * 256 + (it0 & 1) * HD + li * 8); }
    for (int it = gw * 4 + sub; it < NITEM; it += NGW * 4) {
        const int row = it >> 1, h = it & 1, t = row % SKV;
        const u32x4 w = wn;
        { const int itn = it + NGW * 4; if (itn < NITEM) wn = *(const u32x4*)(KB + (size_t)(itn >> 1) * 256 + (itn & 1) * HD + li * 8); }
        float x[8], xp[8]; float ss = 0.f;
#pragma unroll
        for (int j = 0; j < 4; ++j) { x[2 * j] = bf_lo(w[j]); x[2 * j + 1] = bf_hi(w[j]); ss += x[2 * j] * x[2 * j] + x[2 * j + 1] * x[2 * j + 1];
            const unsigned pw = (unsigned)__shfl_xor((int)w[j], 4); xp[2 * j] = bf_lo(pw); xp[2 * j + 1] = bf_hi(pw); }
        ss += __shfl_xor(ss, 1); ss += __shfl_xor(ss, 2); ss += __shfl_xor(ss, 4); ss += __shfl_xor(ss, 8);
        const float r = rsqrtf(ss * (1.f / HD) + EPS);
        float y[8];
#pragma unroll
        for (int j = 0; j < 8; ++j) { x[j] *= r * (j < 4 ? g0[j] : g1[j - 4]); xp[j] *= r * (j < 4 ? p0[j] : p1[j - 4]); y[j] = x[j]; }
        if (t < S) {
            const int blk = li >> 3, pos = blk == 0 ? (t >> 6) : (t & 63), second = (li >> 2) & 1, i0 = (li & 3) * 8;
            const f32x4 c0 = *(const f32x4*)(cs + pos * 32 + i0), c1 = *(const f32x4*)(cs + pos * 32 + i0 + 4), s0 = *(const f32x4*)(sn + pos * 32 + i0), s1 = *(const f32x4*)(sn + pos * 32 + i0 + 4);
#pragma unroll
            for (int j = 0; j < 8; ++j) { const float c = j < 4 ? c0[j] : c1[j - 4], s = j < 4 ? s0[j] : s1[j - 4];
                y[j] = second ? (xp[j] * s + x[j] * c) : (x[j] * c - xp[j] * s); }
        }
        u32x2 o = {(unsigned)att::pk4_fp8(y[0] * 16.f, y[1] * 16.f, y[2] * 16.f, y[3] * 16.f), (unsigned)att::pk4_fp8(y[4] * 16.f, y[5] * 16.f, y[6] * 16.f, y[7] * 16.f)};
        *(u32x2*)(A.ws + WS_K8 + (size_t)row * 256 + h * HD + li * 8) = o;
    }
}
__device__ __forceinline__ void phase_vt(const Args& A, LAS unsigned char* lds) {
    const int lane = threadIdx.x & 63, wave = threadIdx.x >> 6, gw = blockIdx.x * NWAVES + wave, NGW = gridDim.x * NWAVES;
    LAS unsigned char* tl = lds + wave * 4096;
    const bf16_t* VB = (const bf16_t*)(A.ws + WS_VB);
    const int kk = lane & 31, pos = 32 * ((kk >> 2) & 1) + (kk & 3) + 4 * (kk >> 3) + 16 * (lane >> 5);
    constexpr int NTILE = SKV / 64;
    for (int it2 = gw; it2 < NB * HKV * NTILE * 2; it2 += NGW) {
        const int dh = it2 & 1, it = it2 >> 1, j = it % NTILE, bk = it / NTILE, b = bk >> 1, kv = bk & 1;
        const bf16_t* src = VB + ((size_t)b * SKV + j * 64 + lane) * 256 + kv * HD + dh * 64;
        u32x4 w[8];
#pragma unroll
        for (int c = 0; c < 8; ++c) w[c] = *(const u32x4*)(src + c * 8);
#pragma unroll
        for (int c = 0; c < 8; ++c)
#pragma unroll
            for (int q = 0; q < 4; ++q) { const int pk = __builtin_amdgcn_cvt_pk_fp8_f32(bf_lo(w[c][q]) * 16.f, bf_hi(w[c][q]) * 16.f, 0, false);
                tl[(c * 8 + 2 * q) * 64 + pos] = (unsigned char)(pk & 0xff); tl[(c * 8 + 2 * q + 1) * 64 + pos] = (unsigned char)((pk >> 8) & 0xff); }
        asm volatile("s_waitcnt lgkmcnt(0)" ::: "memory");
        unsigned char* dst = A.ws + WS_VT8 + (size_t)it * 8192 + dh * 4096;
#pragma unroll
        for (int i = 0; i < 4; ++i) *(u32x4*)(dst + (i * 64 + lane) * 16) = *(const LAS u32x4*)(tl + (i * 64 + lane) * 16);
        asm volatile("s_waitcnt lgkmcnt(0)" ::: "memory");
    }
}
typedef _Float16 h16x2 __attribute__((ext_vector_type(2)));
template <int R> struct ConvRow {
    static __device__ __forceinline__ void run(const unsigned* gp, int tl0, h16x2 (&acc)[32], const h16x2 (&w)[31]) {
        const int tl = tl0 + R - 15;
        unsigned v = 0u; if (tl >= 0 && tl < S) v = gp[(long)(R - 15) * (D / 2)];
        const h16x2 ab = {(_Float16)bf_lo(v), (_Float16)bf_hi(v)};
#pragma unroll
        for (int t = (R - 30 > 0 ? R - 30 : 0); t <= (R < 31 ? R : 31); ++t) acc[t] = w[R - t] * ab + acc[t];
        if constexpr (R + 1 < 62) ConvRow<R + 1>::run(gp, tl0, acc, w);
    }
};
__device__ __forceinline__ void phase_conv(const Args& A, LAS unsigned char* lds) {
    const int tid = threadIdx.x, lane = tid & 63, wave = tid >> 6;
    LAS float* tile = (LAS float*)lds;
    const bf16_t* G = (const bf16_t*)(A.ws + WS_G); unsigned char* CV = A.ws + WS_HX;
    h16x2 w[31];
#pragma unroll
    for (int j = 0; j < 31; ++j) { const f32x2 t = *(const f32x2*)(A.cdw + j * D + 2 * tid); w[j] = (h16x2){(_Float16)t[0], (_Float16)t[1]}; }
    const f32x2 bias = *(const f32x2*)(A.cb + 2 * tid);
    const int tpw = (M / 32 + gridDim.x - 1) / gridDim.x;
    for (int tileid = blockIdx.x * tpw; tileid < M / 32 && tileid < (blockIdx.x + 1) * tpw; ++tileid) {
        const int row0 = tileid * 32, tl0 = row0 & (S - 1);
        h16x2 acc[32];
#pragma unroll
        for (int t = 0; t < 32; ++t) acc[t] = (h16x2){(_Float16)bias[0], (_Float16)bias[1]};
        ConvRow<0>::run((const unsigned*)(G + (size_t)row0 * D) + tid, tl0, acc, w);
        __syncthreads();
#pragma unroll
        for (int t = 0; t < 32; ++t) *(LAS f32x2*)(tile + t * D + 2 * tid) = (f32x2){(float)acc[t][0], (float)acc[t][1]};
        __syncthreads();
#pragma unroll
        for (int q = 0; q < 4; ++q) { const int t = wave * 4 + q; const LAS float* tr = tile + t * D;
            f32x4 v[4]; float s = 0.f;
#pragma unroll
            for (int i = 0; i < 4; ++i) { v[i] = *(const LAS f32x4*)(tr + (i * 64 + lane) * 4); s += (v[i][0] + v[i][1]) + (v[i][2] + v[i][3]); }
            const float mu = wave_sum(s) * (1.f / D); float qq = 0.f;
#pragma unroll
            for (int i = 0; i < 4; ++i) { v[i] = v[i] - mu; qq += (v[i][0] * v[i][0] + v[i][1] * v[i][1]) + (v[i][2] * v[i][2] + v[i][3] * v[i][3]); }
            const float rs = rsqrtf(wave_sum(qq) * (1.f / D) + EPS);
#pragma unroll
            for (int i = 0; i < 4; ++i) { const int k = (i * 64 + lane) * 4; const f32x4 gg = *(const f32x4*)(A.clg + k), bb = *(const f32x4*)(A.clb + k); float y[4];
#pragma unroll
                for (int j = 0; j < 4; ++j) { const float z = v[i][j] * rs * gg[j] + bb[j]; y[j] = z * fast_sigmoid(z); }
                *(unsigned*)(CV + (size_t)(row0 + t) * D + k) = (unsigned)att::pk4_fp8(y[0] * 16.f, y[1] * 16.f, y[2] * 16.f, y[3] * 16.f); }
        }
    }
}
typedef float f32x32v __attribute__((ext_vector_type(32)));
typedef _Float16 f16x32v __attribute__((ext_vector_type(32)));
typedef _Float16 f16x2v __attribute__((ext_vector_type(2)));
__device__ __forceinline__ unsigned pk_f16(float a, float b) { const f16x2v h = {(_Float16)a, (_Float16)b}; return __builtin_bit_cast(unsigned, h); }
struct EpiInProj {
    static constexpr bool PERM = true;
    unsigned char* ws;
    __device__ __forceinline__ void operator()(f32x4 (&acc)[2][2][4][2], const pg8::Unit& u, int wr, int wc, int fr, int fq) const {
        const int c8 = wc * 32 + 8 * fq;
#pragma unroll
        for (int ai = 0; ai < 2; ++ai)
#pragma unroll
            for (int m = 0; m < 4; ++m) {
                const int row = u.pm * 256 + ai * 128 + wr * 64 + m * 16 + fr;
                if (u.kind == 0) {
                    bf16_t* p = (bf16_t*)(ws + WS_Q) + (size_t)row * D + u.pn * 256 + c8;
#pragma unroll
                    for (int bj = 0; bj < 2; ++bj) { const f32x4 v0 = acc[ai][bj][m][0], v1 = acc[ai][bj][m][1];
                        u32x4 w = {cvt_pk_bf16(v0[0], v0[1]), cvt_pk_bf16(v0[2], v0[3]), cvt_pk_bf16(v1[0], v1[1]), cvt_pk_bf16(v1[2], v1[3])}; *(u32x4*)(p + bj * 128) = w; }
                } else if (u.kind == 1 || u.kind == 2 || u.kind == 5 || u.kind == 6) {
                    const bool ctxu = u.kind >= 5;
                    const int kvrow = ctxu ? (row >> 8) * SKV + S + (row & 255) : (row >> 12) * SKV + (row & (S - 1));
                    bf16_t* p = (bf16_t*)(ws + ((u.kind == 1 || u.kind == 5) ? WS_KB : WS_VB)) + (size_t)kvrow * 256 + c8;
#pragma unroll
                    for (int bj = 0; bj < 2; ++bj) { const f32x4 v0 = acc[ai][bj][m][0], v1 = acc[ai][bj][m][1];
                        u32x4 w = {cvt_pk_bf16(v0[0], v0[1]), cvt_pk_bf16(v0[2], v0[3]), cvt_pk_bf16(v1[0], v1[1]), cvt_pk_bf16(v1[2], v1[3])}; *(u32x4*)(p + bj * 128) = w; }
                } else if (u.kind == 3) {
                    float g[8];
#pragma unroll
                    for (int n = 0; n < 2; ++n)
#pragma unroll
                        for (int j = 0; j < 4; ++j) g[4 * n + j] = acc[ai][0][m][n][j] * fast_sigmoid(acc[ai][1][m][n][j]);
                    u32x4 w = {cvt_pk_bf16(g[0], g[1]), cvt_pk_bf16(g[2], g[3]), cvt_pk_bf16(g[4], g[5]), cvt_pk_bf16(g[6], g[7])};
                    *(u32x4*)((bf16_t*)(ws + WS_G) + (size_t)row * D + (u.pn - 6) * 128 + c8) = w;
                } else {
                    float rt[8], sg[8];
#pragma unroll
                    for (int n = 0; n < 2; ++n)
#pragma unroll
                        for (int j = 0; j < 4; ++j) { const float ea = __builtin_amdgcn_exp2f(-1.4426950408889634f * acc[ai][0][m][n][j]), ec = __builtin_amdgcn_exp2f(-1.4426950408889634f * acc[ai][1][m][n][j]);
                            sg[4 * n + j] = __builtin_amdgcn_rcpf(1.f + ec); rt[4 * n + j] = (1.f + ec) * __builtin_amdgcn_rcpf(1.f + ea); }
                    const size_t off = (size_t)row * D + (u.pn - 14) * 128 + c8;
                    u32x4 w = {cvt_pk_bf16(rt[0], rt[1]), cvt_pk_bf16(rt[2], rt[3]), cvt_pk_bf16(rt[4], rt[5]), cvt_pk_bf16(rt[6], rt[7])}; *(u32x4*)((bf16_t*)(ws + WS_RT) + off) = w;
                    u32x4 w2 = {cvt_pk_bf16(sg[0], sg[1]), cvt_pk_bf16(sg[2], sg[3]), cvt_pk_bf16(sg[4], sg[5]), cvt_pk_bf16(sg[6], sg[7])}; *(u32x4*)((bf16_t*)(ws + WS_SGC) + off) = w2;
                }
            }
    }
};
struct SchedInProj {
    const char* hx; const char* hc; const char* w; int G, c;
    __device__ __forceinline__ bool next(int i, pg8::Unit& u) const {
        constexpr int nM = M / 256, nN = INW / 256, NMAIN = nM * nN, NCTX = (MC / 256) * 2;
        const int L = i * G + c; if (L >= NMAIN + NCTX) return false;
        if (L < NMAIN) { pg8::tile_of(L, nM, nN, u.pm, u.pn); u.a = hx + (size_t)u.pm * 256 * D; u.kind = u.pn < 4 ? 0 : (u.pn == 4 ? 1 : (u.pn == 5 ? 2 : (u.pn < 14 ? 3 : 4))); }
        else { const int j = L - NMAIN; u.pm = j >> 1; u.pn = 4 + (j & 1); u.a = hc + (size_t)u.pm * 256 * D; u.kind = 5 + (j & 1); }
        u.b = w + (size_t)u.pn * 256 * D; u.keep = 0; return true;
    }
};
struct EpiMerge {
    static constexpr bool PERM = true;
    unsigned char* ws;
    __device__ __forceinline__ void operator()(f32x4 (&acc)[2][2][4][2], const pg8::Unit& u, int wr, int wc, int fr, int fq) const {
        const int c8 = u.pn * 256 + wc * 32 + 8 * fq;
        const bf16_t* __restrict__ F = (const bf16_t*)(ws + (u.kind == 0 ? WS_RT : WS_SGC));
#pragma unroll
        for (int ai = 0; ai < 2; ++ai)
#pragma unroll
            for (int m = 0; m < 4; ++m) { const size_t off = (size_t)(u.pm * 256 + ai * 128 + wr * 64 + m * 16 + fr) * D + c8;
#pragma unroll
                for (int bj = 0; bj < 2; ++bj) { const u32x4 f = *(const u32x4*)(F + off + bj * 128);
                    f32x4 v0 = acc[ai][bj][m][0], v1 = acc[ai][bj][m][1];
                    v0[0] *= bf_lo(f[0]); v0[1] *= bf_hi(f[0]); v0[2] *= bf_lo(f[1]); v0[3] *= bf_hi(f[1]); v1[0] *= bf_lo(f[2]); v1[1] *= bf_hi(f[2]); v1[2] *= bf_lo(f[3]); v1[3] *= bf_hi(f[3]);
                    if (u.kind == 0) { acc[ai][bj][m][0] = v0; acc[ai][bj][m][1] = v1; }
                    else { u32x2 w = {(unsigned)att::pk4_fp8(v0[0] * 16.f, v0[1] * 16.f, v0[2] * 16.f, v0[3] * 16.f), (unsigned)att::pk4_fp8(v1[0] * 16.f, v1[1] * 16.f, v1[2] * 16.f, v1[3] * 16.f)}; *(u32x2*)(ws + WS_G + off + bj * 128) = w; } } }
    }
};
struct SchedMerge {
    const char* att; const char* cv; const char* wa; const char* wc; int G, c;
    __device__ __forceinline__ bool next(int i, pg8::Unit& u) const {
        constexpr int nM = M / 256, nN = D / 256;
        const int L = (i >> 1) * G + c, sub = i & 1; if (L >= nM * nN) return false;
        pg8::tile_of(L, nM, nN, u.pm, u.pn);
        u.a = (sub ? cv : att) + (size_t)u.pm * 256 * D; u.b = (sub ? wc : wa) + (size_t)u.pn * 256 * D; u.kind = sub; u.keep = sub ^ 1; return true;
    }
};
struct SchedPlain {
    const char* a; const char* b; int nM, nN, G, c, rowb;
    __device__ __forceinline__ bool next(int i, pg8::Unit& u) const {
        const int L = i * G + c; if (L >= nM * nN) return false;
        pg8::tile_of(L, nM, nN, u.pm, u.pn); u.a = a + (size_t)u.pm * 256 * rowb; u.b = b + (size_t)u.pn * 256 * rowb; u.kind = 0; u.keep = 0; return true;
    }
};
struct EpiOut {
    static constexpr bool PERM = true;
    const float* __restrict__ x; const float* __restrict__ mod; const float* __restrict__ n2g; bf16_t* __restrict__ xs; bf16_t* __restrict__ xg; float* __restrict__ ssq;
    __device__ __forceinline__ void operator()(f32x4 (&acc)[2][2][4][2], const pg8::Unit& u, int wr, int wc, int fr, int fq) const {
        const int col0 = u.pn * 256 + wc * 32 + 8 * fq; const float* mb = mod + ((u.pm * 256) >> 12) * NMOD;
        f32x4 gv[2][2], nv[2][2];
#pragma unroll
        for (int bj = 0; bj < 2; ++bj)
#pragma unroll
            for (int n = 0; n < 2; ++n) { const int c = col0 + bj * 128 + n * 4; gv[bj][n] = *(const f32x4*)(mb + 2 * D + c); nv[bj][n] = *(const f32x4*)(n2g + c) * (*(const f32x4*)(mb + 4 * D + c) + 1.f); }
        f32x4 xa[2][2], xb[2][2];
#define XLOAD(dst, k) do { _Pragma("unroll") for (int bj = 0; bj < 2; ++bj) _Pragma("unroll") for (int n = 0; n < 2; ++n) \
            dst[bj][n] = *(const f32x4*)(x + (size_t)(u.pm * 256 + ((k) >> 2) * 128 + wr * 64 + ((k) & 3) * 16 + fr) * D + col0 + bj * 128 + n * 4); } while (0)
#define XDONE(src, k) do { const int ai = (k) >> 2, m = (k) & 3; const int row = u.pm * 256 + ai * 128 + wr * 64 + m * 16 + fr; const size_t off = (size_t)row * D + col0; float ss = 0.f; \
            _Pragma("unroll") for (int bj = 0; bj < 2; ++bj) { const f32x4 v0 = src[bj][0] + gv[bj][0] * acc[ai][bj][m][0], v1 = src[bj][1] + gv[bj][1] * acc[ai][bj][m][1]; \
                ss += ((v0[0] * v0[0] + v0[1] * v0[1]) + (v0[2] * v0[2] + v0[3] * v0[3])) + ((v1[0] * v1[0] + v1[1] * v1[1]) + (v1[2] * v1[2] + v1[3] * v1[3])); \
                u32x4 w = {cvt_pk_bf16(v0[0], v0[1]), cvt_pk_bf16(v0[2], v0[3]), cvt_pk_bf16(v1[0], v1[1]), cvt_pk_bf16(v1[2], v1[3])}; *(u32x4*)(xs + off + bj * 128) = w; \
                const f32x4 g0 = v0 * nv[bj][0], g1 = v1 * nv[bj][1]; \
                u32x4 w2 = {cvt_pk_bf16(g0[0], g0[1]), cvt_pk_bf16(g0[2], g0[3]), cvt_pk_bf16(g1[0], g1[1]), cvt_pk_bf16(g1[2], g1[3])}; *(u32x4*)(xg + off + bj * 128) = w2; } \
            ss += __shfl_xor(ss, 16); ss += __shfl_xor(ss, 32); if (fq == 0) ssq[(size_t)row * 16 + u.pn * 4 + wc] = ss; } while (0)
        XLOAD(xa, 0); XLOAD(xb, 1); XDONE(xa, 0); XLOAD(xa, 2); XDONE(xb, 1); XLOAD(xb, 3); XDONE(xa, 2); XLOAD(xa, 4); XDONE(xb, 3); XLOAD(xb, 5); XDONE(xa, 4); XLOAD(xa, 6); XDONE(xb, 5); XLOAD(xb, 7); XDONE(xa, 6); XDONE(xb, 7);
#undef XLOAD
#undef XDONE
    }
};
__device__ __forceinline__ float row_rstd(const float* ssq, int row) {
    const f32x4 a = *(const f32x4*)(ssq + (size_t)row * 16), b = *(const f32x4*)(ssq + (size_t)row * 16 + 4), c = *(const f32x4*)(ssq + (size_t)row * 16 + 8), d = *(const f32x4*)(ssq + (size_t)row * 16 + 12);
    const float s = ((a[0] + a[1]) + (a[2] + a[3])) + ((b[0] + b[1]) + (b[2] + b[3])) + ((c[0] + c[1]) + (c[2] + c[3])) + ((d[0] + d[1]) + (d[2] + d[3]));
    return rsqrtf(s * (1.f / D) + EPS);
}
struct EpiScores {
    static constexpr bool PERM = true;
    unsigned short* sc; const float* ssq; const float* sbias;
    __device__ __forceinline__ void operator()(f32x4 (&acc)[2][2][4][2], const pg8::Unit& u, int wr, int wc, int fr, int fq) const {
        const float* sb = sbias + ((u.pm * 256) >> 12) * PW + u.pn * 256 + wc * 32 + 8 * fq;
        f32x4 bv[2][2];
#pragma unroll
        for (int bj = 0; bj < 2; ++bj)
#pragma unroll
            for (int n = 0; n < 2; ++n) bv[bj][n] = *(const f32x4*)(sb + bj * 128 + n * 4);
#pragma unroll
        for (int ai = 0; ai < 2; ++ai)
#pragma unroll
            for (int m = 0; m < 4; ++m) { const int row = u.pm * 256 + ai * 128 + wr * 64 + m * 16 + fr; unsigned short* p = sc + (size_t)(row >> 2) * 8192 + (row & 3) * 8; const float rs = row_rstd(ssq, row);
#pragma unroll
                for (int bj = 0; bj < 2; ++bj) { const int grp = u.pn * 2 + bj, nq = wc * 4 + fq; const f32x4 v0 = acc[ai][bj][m][0] * rs + bv[bj][0], v1 = acc[ai][bj][m][1] * rs + bv[bj][1];
                    u32x4 w = {pk_f16(v0[0], v0[1]), pk_f16(v0[2], v0[3]), pk_f16(v1[0], v1[1]), pk_f16(v1[2], v1[3])}; *(u32x4*)(p + (grp * 16 + nq) * 32) = w; } }
    }
};

#ifndef PROBE_HALFKEYS
#define PROBE_HALFKEYS 0
#endif
__device__ __forceinline__ void phase_attn(const Args& A, unsigned char* lds) {
    const int G = gridDim.x, X = blockIdx.x & 7, j = blockIdx.x >> 3, perx = G >> 3;
    bf16_t* Q = (bf16_t*)(A.ws + WS_Q); const unsigned char* K8 = A.ws + WS_K8; const unsigned char* VT8 = A.ws + WS_VT8;
    const float* cs = (const float*)(A.ws + WS_ROPE); const float* sn = cs + 2048;
    for (int idx = j; idx < 128; idx += perx) {
        const int grp = 2 * X + (idx >> 6), uu = idx & 63, b = grp >> 1, kv = grp & 1, h = kv * 4 + (uu >> 4), qb = uu & 15;
        bf16_t* qp = Q + ((size_t)b * S + qb * 256) * D + h * HD;
        unsigned char* op = A.ws + WS_ATT8 + ((size_t)b * S + qb * 256) * D + h * HD;
        att::attn_unit(qp, K8 + (size_t)b * SKV * 256 + kv * HD, VT8 + (size_t)grp * (SKV / 64) * 8192, op, qb * 256, (A.dry && PROBE_HALFKEYS) ? SKV / 2 : SKV, A.qng, cs, sn, (char*)lds);
    }
}

__device__ __forceinline__ float gelu_exact(float v) {
    const float av = fabsf(v), t = __builtin_amdgcn_rcpf(av * 0.2316418882f + 1.0f);
    float q = t * 0.5307027145f + (-0.7265760135f); q = q * t + 0.7107068705f; q = q * t + (-0.142248368f); q = q * t + 0.127414796f; q = q * t;
    const float e = __builtin_amdgcn_exp2f((v * v) * (-0.72134752044f));
    const float m = v * (q * e);
    return v < 0.f ? m : v - m;
}
__device__ __forceinline__ int dot8z(int a, int b) { int r; asm("v_dot8_i32_i4 %0, %1, %2, 0" : "=v"(r) : "v"(a), "v"(b)); return r; }
__device__ __forceinline__ float dot2z(f16x2v a, f16x2v b) { float r; asm("v_dot2_f32_f16 %0, %1, %2, 0" : "=v"(r) : "v"(a), "v"(b)); return r; }
__device__ __forceinline__ void ins16(float (&t)[16], float v) {
#pragma unroll
    for (int i = 15; i >= 1; --i) t[i] = __builtin_amdgcn_fmed3f(t[i - 1], t[i], v);
    t[0] = fmaxf(t[0], v);
}

__device__ __forceinline__ float key_tag(float v, unsigned keepmask, unsigned tag) { return __uint_as_float((__float_as_uint(v) & keepmask) | tag); }
template <int I, int J> struct CandLoop {
    static __device__ __forceinline__ void run(const float (&a)[16], const float (&b)[16], float (&c)[16]) {
        if constexpr ((I + 1) * (J + 1) <= 16) { ins16(c, key_tag(a[I] + b[J], ~255u, 255u - (unsigned)(I * 16 + J))); CandLoop<I, J + 1>::run(a, b, c); }
        else if constexpr (I + 1 < 16) CandLoop<I + 1, 0>::run(a, b, c);
    }
};
__device__ __forceinline__ int pick_pack(int id, float cf) { return (int)((unsigned)id | ((unsigned)__builtin_bit_cast(unsigned short, (_Float16)cf) << 16)); }
__device__ __forceinline__ int pick_id(int w) { return w & 0xffff; }
__device__ __forceinline__ float pick_cf(int w) { return (float)__builtin_bit_cast(_Float16, (unsigned short)((unsigned)w >> 16)); }
__device__ __forceinline__ void phase_peer_u(const Args& A, LAS unsigned char* lds) {
    const int lane = threadIdx.x & 63, wave = threadIdx.x >> 6, gw = blockIdx.x * NWAVES + wave, NGW = gridDim.x * NWAVES;
    LAS unsigned char* wl = lds + wave * 10240;
    LAS float* topL = (LAS float*)wl; LAS int* eidA = (LAS int*)(wl + 4096); LAS float* wgtA = (LAS float*)(wl + 6144); LAS float* coefL = (LAS float*)(wl + 8192);
    LAS float* suL = (LAS float*)(wl + 8704); LAS float* svL = (LAS float*)(wl + 9216);
    const unsigned short* SC = (const unsigned short*)(A.ws + WS_SC); const bf16_t* HX = (const bf16_t*)(A.ws + WS_HX);
    const unsigned char* UT = A.ws + WS_UT; const float* SU = (const float*)(A.ws + WS_UT + WS_TSCALE); const float* SVs = (const float*)(A.ws + WS_VT + WS_TSCALE);
    const float* mod = (const float*)(A.ws + WS_MOD);
    int* PE = (int*)(A.ws + WS_PE); float* PC = (float*)(A.ws + WS_PC);
    const float NEG = -3.0e38f;
    const int h = lane >> 3, tk = (lane >> 1) & 3, p = lane & 1, grp = 2 * h + p;
    if (wave >= 4) { asm volatile("s_sleep 127\n\ts_sleep 127" ::: "memory"); }
    for (int pass = gw; pass < M / 4; pass += NGW) {
        {
            float t[16];
#pragma unroll
            for (int i = 0; i < 16; ++i) t[i] = NEG;
            const unsigned short* sp = SC + (size_t)pass * 8192 + (grp * 64 + tk) * 8;
            u32x4 sv[16];
#pragma unroll
            for (int i = 0; i < 16; ++i) sv[i] = *(const u32x4*)(sp + i * 32);
#pragma unroll
            for (int i = 0; i < 16; ++i)
#pragma unroll
                for (int q = 0; q < 4; ++q) { const unsigned w = sv[i][q]; const f16x2v hv = __builtin_bit_cast(f16x2v, w); const unsigned tg = 127u - (unsigned)(8 * i + 2 * q);
                    ins16(t, __uint_as_float(__float_as_uint((float)hv[0]) | tg)); ins16(t, __uint_as_float(__float_as_uint((float)hv[1]) | (tg - 1u))); }
            float pb[16];
#pragma unroll
            for (int i = 0; i < 16; ++i) { pb[i] = __shfl_xor(t[i], 1); topL[i * 64 + lane] = t[i]; }
            float c[16];
#pragma unroll
            for (int i = 0; i < 16; ++i) c[i] = NEG;
            CandLoop<0, 0>::run(t, pb, c);
            float e[16]; float es = 0.f;
#pragma unroll
            for (int k = 0; k < 16; ++k) { e[k] = __expf(c[k] - c[0]); es += e[k]; }
            const float inv = __builtin_amdgcn_rcpf(es);
            asm volatile("s_waitcnt lgkmcnt(0)" ::: "memory");
            if (p == 0) {
#pragma unroll
                for (int k = 0; k < 16; ++k) { const unsigned code = 255u - (__float_as_uint(c[k]) & 255u);
                    const unsigned ia = 127u - (__float_as_uint(topL[(code >> 4) * 64 + lane]) & 127u), ib = 127u - (__float_as_uint(topL[(code & 15u) * 64 + lane + 1]) & 127u);
                    eidA[tk * 128 + h * 16 + k] = (int)(ia * 128u + ib); wgtA[tk * 128 + h * 16 + k] = e[k] * inv; }
            }
            asm volatile("s_waitcnt lgkmcnt(0)" ::: "memory");
        }
        __builtin_amdgcn_s_setprio(1);
        const int g = lane & 31, hh = lane >> 5;
        const unsigned goff16 = (unsigned)g * 16u;
        u32x4 rb0[4], rb1[4], rb2[4], rb3[4];
#define LOAD8(buf, TB, hb) do { const u32x4 ids_ = *(const LAS u32x4*)(eidL + (hb) * 8 + hh * 4);     \
            _Pragma("unroll") for (int r = 0; r < 4; ++r) { const unsigned ro = __umul24(ids_[r], (unsigned)ROWB_V);     \
                buf[r] = *(const u32x4*)((TB) + (ro + goff16)); } } while (0)
        u32x4 xwn[4]; f32x4 sqn[4];
#define XPRE(tt) do { const bf16_t* xp_ = HX + (size_t)(tt) * D + g * 32; const float* sq_ = (const float*)(A.ws + WS_SSQ) + (size_t)(tt) * 16; \
            _Pragma("unroll") for (int c = 0; c < 4; ++c) { xwn[c] = *(const u32x4*)(xp_ + 8 * c); sqn[c] = *(const f32x4*)(sq_ + 4 * c); } } while (0)
        float nsu0, nsu1, nsv0, nsv1; { const int i0 = eidA[lane], i1 = eidA[64 + lane]; nsu0 = SU[i0]; nsu1 = SU[i1]; nsv0 = SVs[i0]; nsv1 = SVs[i1]; }
        XPRE(pass * 4);
        { const LAS int* eidL = eidA; LOAD8(rb0, UT, 0); LOAD8(rb1, UT, 1); LOAD8(rb2, UT, 2); }
        f32x4 shv[8];
        { const float* sh = mod + ((pass * 4) >> 12) * NMOD + 3 * D + g * 32;
#pragma unroll
          for (int i = 0; i < 8; ++i) shv[i] = *(const f32x4*)(sh + 4 * i) * (119.f / 8.f); }
#pragma unroll 1
        for (int tq = 0; tq < 4; ++tq) {
            const int t = pass * 4 + tq; const LAS int* eidL = eidA + tq * 128; const LAS float* wgtL = wgtA + tq * 128;
            unsigned xhi[4], xlo[4];
            { const float s16 = (((sqn[0][0] + sqn[0][1]) + (sqn[0][2] + sqn[0][3])) + ((sqn[1][0] + sqn[1][1]) + (sqn[1][2] + sqn[1][3]))) + (((sqn[2][0] + sqn[2][1]) + (sqn[2][2] + sqn[2][3])) + ((sqn[3][0] + sqn[3][1]) + (sqn[3][2] + sqn[3][3])));
              const float rs = rsqrtf(s16 * (1.f / D) + EPS) * (119.f / 8.f);
#pragma unroll
              for (int c = 0; c < 4; ++c) { const u32x4 w = xwn[c]; const f32x4 s0 = shv[2 * c], s1 = shv[2 * c + 1];
                float xf[8] = {bf_lo(w[0]) * rs + s0[0], bf_hi(w[0]) * rs + s0[1], bf_lo(w[1]) * rs + s0[2], bf_hi(w[1]) * rs + s0[3],
                               bf_lo(w[2]) * rs + s1[0], bf_hi(w[2]) * rs + s1[1], bf_lo(w[3]) * rs + s1[2], bf_hi(w[3]) * rs + s1[3]};
                unsigned th = 0u, tl = 0u;
#pragma unroll
                for (int k = 0; k < 8; ++k) { const int X = (int)fminf(fmaxf(rintf(xf[k]), -120.f), 119.f); const int lo = ((X + 8) & 15) - 8, hi4 = (X - lo) >> 4;
                    th |= ((unsigned)hi4 & 15u) << (4 * k); tl |= ((unsigned)lo & 15u) << (4 * k); }
                xhi[c] = th; xlo[c] = tl; } }
            suL[lane] = nsu0; suL[64 + lane] = nsu1; svL[lane] = nsv0; svL[64 + lane] = nsv1;
            if (tq < 3) { const LAS int* en = eidA + (tq + 1) * 128; const int i0 = en[lane], i1 = en[64 + lane]; nsu0 = SU[i0]; nsu1 = SU[i1]; nsv0 = SVs[i0]; nsv1 = SVs[i1]; }
#define DOT8(buf, off) do { _Pragma("unroll") for (int r = 0; r < 4; ++r) { const unsigned w0 = buf[r][0], w1 = buf[r][1], w2 = buf[r][2], w3 = buf[r][3]; \
                  \
                int ah = dot8z((int)w0, (int)xhi[0]), al = dot8z((int)w0, (int)xlo[0]);     \
                ah = __builtin_amdgcn_sdot8((int)w1, (int)xhi[1], ah, false); al = __builtin_amdgcn_sdot8((int)w1, (int)xlo[1], al, false); \
                ah = __builtin_amdgcn_sdot8((int)w2, (int)xhi[2], ah, false); al = __builtin_amdgcn_sdot8((int)w2, (int)xlo[2], al, false); \
                ah = __builtin_amdgcn_sdot8((int)w3, (int)xhi[3], ah, false); al = __builtin_amdgcn_sdot8((int)w3, (int)xlo[3], al, false); \
                pp[(off) + r] = (float)(ah * 16 + al); } } while (0)
#define REDUCE16(kb) do { \
            _Pragma("unroll") for (int e = 0; e < 4; ++e) { const bool up = lane & 16; const float keep = up ? pp[e + 4] : pp[e], send = up ? pp[e] : pp[e + 4]; pp[e] = keep + __shfl_xor(send, 16); } \
            _Pragma("unroll") for (int e = 0; e < 2; ++e) { const bool up = lane & 8; const float keep = up ? pp[e + 2] : pp[e], send = up ? pp[e] : pp[e + 2]; pp[e] = keep + __shfl_xor(send, 8); } \
            { const bool up = lane & 4; const float keep = up ? pp[1] : pp[0], send = up ? pp[0] : pp[1]; pp[0] = keep + __shfl_xor(send, 4); } \
            float hsum = pp[0]; hsum += __shfl_xor(hsum, 2); hsum += __shfl_xor(hsum, 1); \
            const int i_ = (lane >> 2) & 7, ke = (kb) * 16 + (i_ >> 2) * 8 + hh * 4 + (i_ & 3); const float su = suL[ke], sv = svL[ke];     \
            const float cf = wgtL[ke] * gelu_exact(hsum * (su * (8.f / 119.f))) * sv; if ((lane & 3) == 0) coefL[ke] = cf; } while (0)
            float pp[8];
            LOAD8(rb3, UT, 3); DOT8(rb0, 0);
            LOAD8(rb0, UT, 4); DOT8(rb1, 4); REDUCE16(0);
            LOAD8(rb1, UT, 5); DOT8(rb2, 0);
            LOAD8(rb2, UT, 6); DOT8(rb3, 4); REDUCE16(1);
            LOAD8(rb3, UT, 7); DOT8(rb0, 0);
            LOAD8(rb0, UT, 8); DOT8(rb1, 4); REDUCE16(2);
            LOAD8(rb1, UT, 9); DOT8(rb2, 0);
            LOAD8(rb2, UT, 10); DOT8(rb3, 4); REDUCE16(3);
            LOAD8(rb3, UT, 11); DOT8(rb0, 0);
            LOAD8(rb0, UT, 12); DOT8(rb1, 4); REDUCE16(4);
            LOAD8(rb1, UT, 13); DOT8(rb2, 0);
            LOAD8(rb2, UT, 14); DOT8(rb3, 4); REDUCE16(5);
            LOAD8(rb3, UT, 15); DOT8(rb0, 0);
            if (tq < 3) { XPRE(t + 1); const LAS int* eidC = eidL; eidL = eidC + 128; LOAD8(rb0, UT, 0); eidL = eidC; }
            DOT8(rb1, 4); REDUCE16(6);
            if (tq < 3) { const LAS int* eidC = eidL; eidL = eidC + 128; LOAD8(rb1, UT, 1); eidL = eidC; }
            DOT8(rb2, 0);
            if (tq < 3) { const LAS int* eidC = eidL; eidL = eidC + 128; LOAD8(rb2, UT, 2); eidL = eidC; }
            DOT8(rb3, 4); REDUCE16(7);
#undef XPRE
#undef LOAD8
#undef DOT8
#undef REDUCE16
            asm volatile("s_waitcnt lgkmcnt(0)" ::: "memory");
            PE[(size_t)t * 128 + lane] = pick_pack(eidL[lane], coefL[lane]); PE[(size_t)t * 128 + 64 + lane] = pick_pack(eidL[64 + lane], coefL[64 + lane]);
        }
        __builtin_amdgcn_s_setprio(0);
    }
}
__device__ __forceinline__ void phase_peer_v(const Args& A, LAS unsigned char* lds) {
    const int lane = threadIdx.x & 63, wave = threadIdx.x >> 6, gw = blockIdx.x * NWAVES + wave, NGW = gridDim.x * NWAVES;
    LAS unsigned char* wl = lds + wave * 2048;
    const unsigned char* VT = A.ws + WS_VT; const float* mod = (const float*)(A.ws + WS_MOD);
    const int* PE = (const int*)(A.ws + WS_PE); const float* PC = (const float*)(A.ws + WS_PC);
    const int g = lane & 31, hh = lane >> 5;
    const unsigned goff16 = (unsigned)g * 16u, goff8 = 512u + (unsigned)g * 8u;
    int pe0 = 0, pe1 = 0;
    u32x4 rb0[4], rb1[4], rb2[4], rb3[4];
#define LOAD8(buf, hb) do { const u32x4 ids_ = *(const LAS u32x4*)(eidL + (hb) * 8 + hh * 4);     \
            _Pragma("unroll") for (int r = 0; r < 4; ++r) { const unsigned ro = __umul24(ids_[r], (unsigned)ROWB_V); \
            buf[r] = *(const u32x4*)(VT + (ro + goff16)); } } while (0)
    f32x4 fgv[4];
#pragma unroll
    for (int q = 0; q < 4; ++q) fgv[q] = *(const f32x4*)(A.fg + g * 32 + hh * 16 + q * 4);
    int cur = 0;
    if (gw < M) { LAS int* eidL = (LAS int*)wl; LAS float* coefL = (LAS float*)(wl + 512);
        { const int w0 = PE[(size_t)gw * 128 + lane], w1 = PE[(size_t)gw * 128 + 64 + lane]; eidL[lane] = pick_id(w0); eidL[64 + lane] = pick_id(w1); coefL[lane] = pick_cf(w0); coefL[64 + lane] = pick_cf(w1); }
        asm volatile("s_waitcnt lgkmcnt(0)" ::: "memory");
        const int tn = gw + NGW < M ? gw + NGW : gw; pe0 = PE[(size_t)tn * 128 + lane]; pe1 = PE[(size_t)tn * 128 + 64 + lane];
        LOAD8(rb0, 0); LOAD8(rb1, 1); LOAD8(rb2, 2); }
    for (int t = gw; t < M; t += NGW) {
        LAS int* eidL = (LAS int*)(wl + cur * 1024); LAS float* coefL = (LAS float*)(wl + cur * 1024 + 512);
        LAS int* eidN = (LAS int*)(wl + (cur ^ 1) * 1024); LAS float* coefN = (LAS float*)(wl + (cur ^ 1) * 1024 + 512);
        f32x4 g2v[4];
        { const float* g2p = mod + (t >> 12) * NMOD + 5 * D + g * 32 + hh * 16;
#pragma unroll
          for (int q = 0; q < 4; ++q) g2v[q] = *(const f32x4*)(g2p + 4 * q); }
        u32x4 xsw[2];
        { const bf16_t* xrow = (const bf16_t*)(A.ws + WS_XSB) + (size_t)t * D + g * 32 + hh * 16; xsw[0] = *(const u32x4*)xrow; xsw[1] = *(const u32x4*)(xrow + 8); }
#define VACC8(buf, hb) do { const f32x4 cfs_ = *(const LAS f32x4*)(coefL + (hb) * 8 + hh * 4); \
            _Pragma("unroll") for (int r = 0; r < 4; ++r) { const _Float16 ch = (_Float16)cfs_[r]; const f16x2v cf2 = {ch, ch}; \
            _Pragma("unroll") for (int d = 0; d < 4; ++d) { const unsigned wd = buf[r][d]; \
                yh[4 * d] = cf2 * __builtin_amdgcn_cvt_scalef32_pk_f16_fp4(wd, 1.0f, 0) + yh[4 * d]; yh[4 * d + 1] = cf2 * __builtin_amdgcn_cvt_scalef32_pk_f16_fp4(wd, 1.0f, 1) + yh[4 * d + 1]; \
                yh[4 * d + 2] = cf2 * __builtin_amdgcn_cvt_scalef32_pk_f16_fp4(wd, 1.0f, 2) + yh[4 * d + 2]; yh[4 * d + 3] = cf2 * __builtin_amdgcn_cvt_scalef32_pk_f16_fp4(wd, 1.0f, 3) + yh[4 * d + 3]; } } } while (0)
        f16x2v yh[16];
#pragma unroll
        for (int j = 0; j < 16; ++j) yh[j] = (f16x2v){(_Float16)0.f, (_Float16)0.f};
        LOAD8(rb3, 3); VACC8(rb0, 0);
        LOAD8(rb0, 4); VACC8(rb1, 1);
        LOAD8(rb1, 5); VACC8(rb2, 2);
        LOAD8(rb2, 6); VACC8(rb3, 3);
        LOAD8(rb3, 7); VACC8(rb0, 4);
        LOAD8(rb0, 8); VACC8(rb1, 5);
        LOAD8(rb1, 9); VACC8(rb2, 6);
        LOAD8(rb2, 10); VACC8(rb3, 7);
        eidN[lane] = pick_id(pe0); eidN[64 + lane] = pick_id(pe1); coefN[lane] = pick_cf(pe0); coefN[64 + lane] = pick_cf(pe1);
        { const int tn = t + 2 * NGW < M ? t + 2 * NGW : t; pe0 = PE[(size_t)tn * 128 + lane]; pe1 = PE[(size_t)tn * 128 + 64 + lane]; }
        LOAD8(rb3, 11); VACC8(rb0, 8);
        LOAD8(rb0, 12); VACC8(rb1, 9);
        LOAD8(rb1, 13); VACC8(rb2, 10);
        LOAD8(rb2, 14); VACC8(rb3, 11);
        LOAD8(rb3, 15); VACC8(rb0, 12);
        asm volatile("s_waitcnt lgkmcnt(0)" ::: "memory");
        { LAS int* eidC = eidL; eidL = eidN; LOAD8(rb0, 0); eidL = eidC; }
        VACC8(rb1, 13);
        { LAS int* eidC = eidL; eidL = eidN; LOAD8(rb1, 1); eidL = eidC; }
        VACC8(rb2, 14);
        { LAS int* eidC = eidL; eidL = eidN; LOAD8(rb2, 2); eidL = eidC; }
        VACC8(rb3, 15);
        cur ^= 1;
#undef VACC8
        float yy[16];
#pragma unroll
        for (int j = 0; j < 16; ++j) { const float y0 = (float)yh[j][0], y1 = (float)yh[j][1]; const float a = y0 + __shfl_xor(y0, 32), b = y1 + __shfl_xor(y1, 32); if ((j >> 3) == hh) { yy[2 * (j & 7)] = a; yy[2 * (j & 7) + 1] = b; } }
        float* orow = A.out + (size_t)t * D;
        float z[16]; float ss = 0.f;
#pragma unroll
        for (int q = 0; q < 4; ++q) { const int k = g * 32 + hh * 16 + q * 4; const unsigned xw0 = xsw[q >> 1][2 * (q & 1)], xw1 = xsw[q >> 1][2 * (q & 1) + 1];
            const f32x4 xv = {bf_lo(xw0), bf_hi(xw0), bf_lo(xw1), bf_hi(xw1)}, gv = g2v[q];
#pragma unroll
            for (int j = 0; j < 4; ++j) { const float zz = xv[j] + gv[j] * yy[q * 4 + j]; z[q * 4 + j] = zz; ss += zz * zz; } }
        const float r = rsqrtf(wave_sum(ss) * (1.f / D) + EPS);
#pragma unroll
        for (int q = 0; q < 4; ++q) { const int k = g * 32 + hh * 16 + q * 4; const f32x4 fv = fgv[q];
            f32x4 o;
#pragma unroll
            for (int j = 0; j < 4; ++j) o[j] = z[q * 4 + j] * r * fv[j];
            if (!A.dry || r < 0.f) *(f32x4*)(orow + k) = o; }
    }
}
#undef LOAD8
#define XB_TMO      128
#define XB_XCNT(j)  (256  + 64 * (j))
#define XB_XSUB(j)  (1280 + 64 * (j))
#define XB_XGEN(j)  (2304 + 64 * (j))
#define XB_TOP      3328
#define XB_TOPGEN   3392
#define XCD_BAR_WORDS 3456
#define XB_SPIN_CAP (1u << 22)
__device__ __forceinline__ unsigned xb_ld(unsigned* p)              { return __hip_atomic_load(p, __ATOMIC_RELAXED, __HIP_MEMORY_SCOPE_AGENT); }
__device__ __forceinline__ unsigned xb_add(unsigned* p, unsigned v) { return __hip_atomic_fetch_add(p, v, __ATOMIC_RELAXED, __HIP_MEMORY_SCOPE_AGENT); }
__device__ __forceinline__ unsigned xb_xcc_id() { return (unsigned)__builtin_amdgcn_s_getreg((3 << 11) | 20) & 0xFu; }
#define XB_SPIN(cond, bar) do { unsigned _sp = 0; while (cond) { __builtin_amdgcn_s_sleep(1); \
    if ((++_sp & 255u) == 0u) { if (xb_ld(&(bar)[XB_TMO])) break; if (_sp > XB_SPIN_CAP) { atomicAdd(&(bar)[XB_TMO], 1u); break; } } } } while (0)
struct XcdBarrier { unsigned* bar; unsigned x; volatile LAS unsigned* st; };
__device__ __forceinline__ XcdBarrier xcd_barrier_post(unsigned* bar, volatile LAS unsigned* st) {
    XcdBarrier b; b.bar = bar; b.x = xb_xcc_id(); b.st = st;
    if (threadIdx.x == 0) (void)xb_add(&bar[XB_XCNT(b.x)], 1u);
    return b;
}
__device__ __forceinline__ void xcd_barrier_complete(unsigned* bar, unsigned x, unsigned& nloc, unsigned& nx) {
    const unsigned G = gridDim.x * gridDim.y * gridDim.z;
    unsigned sum, cnt, mine, sp = 0u;
    for (;;) {
        sum = 0u; cnt = 0u; mine = 0u;
#pragma unroll
        for (unsigned j = 0; j < 16; ++j) { const unsigned c = xb_ld(&bar[XB_XCNT(j)]); sum += c; cnt += (c > 0u) ? 1u : 0u; mine = (j == x) ? c : mine; }
        if (sum == G) break;
        __builtin_amdgcn_s_sleep(1);
        if ((++sp & 255u) == 0u) { if (xb_ld(&bar[XB_TMO])) break; if (sp > XB_SPIN_CAP) { atomicAdd(&bar[XB_TMO], 1u); break; } }
    }
    nloc = mine > 0u ? mine : 1u; nx = cnt > 0u ? cnt : 1u;
}
__device__ __forceinline__ void xcd_barrier(const XcdBarrier& b) {
    asm volatile("s_waitcnt vmcnt(0)" ::: "memory");
    __syncthreads();
    if (threadIdx.x == 0) {
        unsigned* bar = b.bar;
        __builtin_amdgcn_s_waitcnt(0);
        unsigned nloc = b.st[0], nx = b.st[1];
        if (nloc == 0u) { xcd_barrier_complete(bar, b.x, nloc, nx); b.st[0] = nloc; b.st[1] = nx; }
        const unsigned old = xb_add(&bar[XB_XSUB(b.x)], 1u);
        const unsigned gen = old / nloc;
        if (old + 1u == (gen + 1u) * nloc) {
            __builtin_amdgcn_fence(__ATOMIC_RELEASE, "agent");
            asm volatile("s_waitcnt vmcnt(0)" ::: "memory");
            const unsigned og = xb_add(&bar[XB_TOP], 1u);
            const unsigned tg = og / nx;
            if (og + 1u == (tg + 1u) * nx) xb_add(&bar[XB_TOPGEN], 1u);
            else XB_SPIN(xb_ld(&bar[XB_TOPGEN]) == tg, bar);
            __builtin_amdgcn_fence(__ATOMIC_ACQUIRE, "agent");
            xb_add(&bar[XB_XGEN(b.x)], 1u);
            asm volatile("s_waitcnt vmcnt(0)" ::: "memory");
        } else {
            XB_SPIN(xb_ld(&bar[XB_XGEN(b.x)]) == gen, bar);
            __builtin_amdgcn_fence(__ATOMIC_ACQUIRE, "agent");
            asm volatile("s_waitcnt vmcnt(0)" ::: "memory");
        }
    }
    __syncthreads();
}
constexpr int MISC_OFF = 135168;

constexpr int N_PHASES = 10;
__global__ void __launch_bounds__(NWAVES * 64, 2) mega_fwd(Args A) {
    extern __shared__ __attribute__((aligned(16))) unsigned char lds[];
    LAS unsigned char* L = (LAS unsigned char*)lds;
    cg::grid_group grid = cg::this_grid();
    const int lo = A.ph_lo, hi = A.ph_hi, G = gridDim.x, c = blockIdx.x;
#ifndef PH_MASK
#define PH_MASK 0x3FF
#endif
#define IN(k) (((PH_MASK >> (k)) & 1) && lo <= (k) && (k) < hi)
    unsigned* barw = (unsigned*)(A.ws + WS_CTL);
    volatile LAS unsigned* MISC = (volatile LAS unsigned*)(L + MISC_OFF);
    if (threadIdx.x < 2) MISC[threadIdx.x] = 0u;
    if (lo == 0 && hi > 1 && blockIdx.x == 0) for (int i = threadIdx.x; i < XCD_BAR_WORDS; i += NWAVES * 64) barw[i] = 0u;
    XcdBarrier xb; xb.bar = barw; xb.x = 0; xb.st = MISC;
#define SEAM(k) do { if (IN(k) && IN((k) + 1)) { if ((k) == 0) { grid.sync(); xb = xcd_barrier_post(barw, MISC); } else xcd_barrier(xb); } } while (0)
    if (IN(0)) phase_prologue(A, L);
    SEAM(0);
    if (IN(1)) phase_hx(A);
    SEAM(1);
    if (IN(2)) { SchedInProj Sd{(const char*)(A.ws + WS_HX), (const char*)(A.ws + WS_HC), (const char*)(A.ws + WS_WIN), G, c}; EpiInProj E{A.ws};
        pg8::gemm_phase<EpiInProj, SchedInProj, true, true>(L, D / 2, Sd, E); }
    SEAM(2);
    if (IN(3)) { phase_kfix(A); phase_vt(A, L); __syncthreads(); phase_conv(A, L); }
    SEAM(3);
    if (IN(4)) phase_attn(A, lds);
    SEAM(4);
    if (IN(5)) { SchedMerge Sd{(const char*)(A.ws + WS_ATT8), (const char*)(A.ws + WS_HX), (const char*)(A.ws + WS_WA), (const char*)(A.ws + WS_WC), G, c}; EpiMerge E{A.ws};
        pg8::gemm_phase<EpiMerge, SchedMerge, true, true>(L, D / 2, Sd, E); }
    SEAM(5);
    if (IN(6)) { SchedPlain Sd{(const char*)(A.ws + WS_G), (const char*)(A.ws + WS_WO), M / 256, D / 256, G, c, D};
        EpiOut E{A.x, (const float*)(A.ws + WS_MOD), A.n2g, (bf16_t*)(A.ws + WS_XSB), (bf16_t*)(A.ws + WS_HX), (float*)(A.ws + WS_SSQ)};
        pg8::gemm_phase<EpiOut, SchedPlain, true, true>(L, D / 2, Sd, E); }
    SEAM(6);
    if (IN(7)) { SchedPlain Sd{(const char*)(A.ws + WS_HX), (const char*)(A.ws + WS_WP), M / 256, PW / 256, G, c, 2 * D};
        EpiScores E{(unsigned short*)(A.ws + WS_SC), (const float*)(A.ws + WS_SSQ), (const float*)(A.ws + WS_SBIAS)};
        pg8::gemm_phase<EpiScores, SchedPlain, true>(L, D, Sd, E); }
    SEAM(7);
    if (IN(8)) phase_peer_u(A, L);
    SEAM(8);
    if (IN(9)) phase_peer_v(A, L);
#undef IN
#undef SEAM
}

#ifndef MK_ONE_LAUNCH
#define MK_ONE_LAUNCH 1
#endif
extern "C" void kernel_launch(void* const* d_in, const int* in_sizes, int n_in, void* d_out, int out_size, void* d_ws, size_t ws_size, hipStream_t stream) {
    static int grid = 0;
    if (grid == 0) {
        if (n_in != 23 || out_size != M * D || ws_size < WS_END) { fprintf(stderr, "kernel_launch: unexpected shapes (n_in %d out %d ws %zu)\n", n_in, out_size, ws_size); grid = -1; return; }
        int dev = 0, cus = 0, per_cu = 0;
        hipGetDevice(&dev); hipDeviceGetAttribute(&cus, hipDeviceAttributeMultiprocessorCount, dev);
        if (hipFuncSetAttribute((const void*)mega_fwd, hipFuncAttributeMaxDynamicSharedMemorySize, LDS_BYTES) != hipSuccess) { fprintf(stderr, "kernel_launch: hipFuncSetAttribute failed\n"); grid = -1; return; }
        if (hipOccupancyMaxActiveBlocksPerMultiprocessor(&per_cu, (const void*)mega_fwd, NWAVES * 64, LDS_BYTES) != hipSuccess || per_cu < 1) { fprintf(stderr, "kernel_launch: occupancy query says %d\n", per_cu); per_cu = 1; }
        (void)hipGetLastError();
        grid = cus * 1;
        if (per_cu < 1) grid = -1;
    }
    if (grid < 0) return;
    Args a{};
    const float** f = (const float**)&a;
    for (int i = 0; i < 23; ++i) f[i] = (const float*)d_in[i];
    a.out = (float*)d_out; a.ws = (unsigned char*)d_ws;
#if MK_ONE_LAUNCH
    a.ph_lo = 0; a.ph_hi = N_PHASES;
    void* args[] = {&a};
    hipError_t e = hipLaunchCooperativeKernel((const void*)mega_fwd, dim3(grid), dim3(NWAVES * 64), args, LDS_BYTES, stream);
    if (e != hipSuccess) fprintf(stderr, "cooperative launch failed: %s (grid %d)\n", hipGetErrorString(e), grid);
#else
#ifndef REPEAT_PH
#define REPEAT_PH -1
#endif
    for (int p = 0; p < N_PHASES; ++p) { a.ph_lo = p; a.ph_hi = p + 1;
        if (p == REPEAT_PH) { a.dry = 1; hipLaunchKernelGGL(mega_fwd, dim3(grid), dim3(NWAVES * 64), LDS_BYTES, stream, a); a.dry = 0; }
        hipLaunchKernelGGL(mega_fwd, dim3(grid), dim3(NWAVES * 64), LDS_BYTES, stream, a); }
#endif
}
```
